# Optimizing an MI355X kernel written in HIP

```python
import math
import jax
import jax.numpy as jnp
from jax import lax
import numpy as np

D_MODEL = 1024
BATCH = 1
SEQ = 16384
DEPTH = 1

N_META = 16
BLOCK = 128
WINDOW = 128
ATTN_PAD = BLOCK - N_META
ATTN_WIDTH = D_MODEL // 2
HEAD_DIM = 64
N_Q_HEADS = ATTN_WIDTH // HEAD_DIM
N_KV_HEADS = 2
GQA = N_Q_HEADS // N_KV_HEADS
KV_WIDTH = N_KV_HEADS * HEAD_DIM
SSM_WIDTH = D_MODEL - ATTN_WIDTH
SSM_CH = 16
SSM_GROUPS = SSM_WIDTH // SSM_CH
SSM_STATE = 64
DT_MIN = 0.001
DT_MAX = 0.1
IN_WIDTH = ATTN_WIDTH + 2 * KV_WIDTH + SSM_WIDTH
PEER_HEADS = 8
PEER_N_KEYS = 128
PEER_EXPERTS = PEER_N_KEYS * PEER_N_KEYS
PEER_TOPK = 16
PEER_DK = 256
PEER_HALF = PEER_DK // 2
PEER_CHUNK = 256

NORM_EPS = 1e-6
MASK_VALUE = -1e30

kernel_name = "hymba_swa_s5_peer_block"


def rms_norm(x, g):
    xf = x.astype(jnp.float32)
    y = xf * lax.rsqrt(jnp.mean(xf * xf, axis=-1, keepdims=True) + NORM_EPS)
    return (y * g.astype(jnp.float32)).astype(x.dtype)


def sliding_window_attention(q, k, v, q_norm_g, k_norm_g, sinks):
    B, L, _ = q.shape
    q = rms_norm(q.reshape(B, L, N_Q_HEADS, HEAD_DIM), q_norm_g).astype(jnp.float32)
    k = rms_norm(k.reshape(B, L, N_KV_HEADS, HEAD_DIM), k_norm_g).astype(jnp.float32)
    v = v.reshape(B, L, N_KV_HEADS, HEAD_DIM).astype(jnp.float32)
    k_meta, v_meta = k[:, :N_META], v[:, :N_META]
    pad = ((0, 0), (ATTN_PAD, 0), (0, 0), (0, 0))
    nb = (L + ATTN_PAD) // BLOCK
    qb = jnp.pad(q, pad).reshape(B, nb, BLOCK, N_KV_HEADS, GQA, HEAD_DIM)
    kb = jnp.pad(k, pad).reshape(B, nb, BLOCK, N_KV_HEADS, HEAD_DIM)
    vb = jnp.pad(v, pad).reshape(B, nb, BLOCK, N_KV_HEADS, HEAD_DIM)

    def with_prev(t):
        prev = jnp.concatenate([jnp.zeros_like(t[:, :1]), t[:, :-1]], axis=1)
        return jnp.concatenate([prev, t], axis=2)

    kb2, vb2 = with_prev(kb), with_prev(vb)
    scale = HEAD_DIM ** -0.5
    s_band = jnp.einsum('bnqhgd,bnkhd->bnhgqk', qb, kb2) * scale
    s_meta = jnp.einsum('bnqhgd,bmhd->bnhgqm', qb, k_meta) * scale

    qpos = jnp.arange(nb)[:, None] * BLOCK + jnp.arange(BLOCK)[None, :]
    kpos = jnp.arange(nb)[:, None] * BLOCK - BLOCK + jnp.arange(2 * BLOCK)[None]
    diff = qpos[:, :, None] - kpos[:, None, :]
    band_ok = (diff >= 0) & (diff < WINDOW) & (kpos[:, None, :] >= BLOCK)
    meta_ok = (ATTN_PAD + jnp.arange(N_META))[None, None, :] <= qpos[:, :, None]
    s_band = jnp.where(band_ok[None, :, None, None], s_band, MASK_VALUE)
    s_meta = jnp.where(meta_ok[None, :, None, None], s_meta, MASK_VALUE)
    sink = jnp.broadcast_to(sinks.astype(jnp.float32).reshape(1, 1, N_KV_HEADS, GQA, 1, 1),
                            s_band.shape[:-1] + (1,))
    p = jax.nn.softmax(jnp.concatenate([s_band, s_meta, sink], axis=-1), axis=-1)
    out = (jnp.einsum('bnhgqk,bnkhd->bnqhgd', p[..., :2 * BLOCK], vb2)
           + jnp.einsum('bnhgqm,bmhd->bnqhgd', p[..., 2 * BLOCK:2 * BLOCK + N_META], v_meta))
    out = out.reshape(B, nb * BLOCK, ATTN_WIDTH)[:, ATTN_PAD:]
    return out.astype(q.dtype)


def _complex_linear_combine(e1, e2):
    a1r, a1i, b1r, b1i = e1
    a2r, a2i, b2r, b2i = e2
    return (a2r * a1r - a2i * a1i,
            a2r * a1i + a2i * a1r,
            a2r * b1r - a2i * b1i + b2r,
            a2r * b1i + a2i * b1r + b2i)


def s5_ssm(u, a_re, a_im, log_dt, b_re, b_im, c_re, c_im, d, glu_w, glu_b):
    B, L, _ = u.shape
    uf = u.astype(jnp.float32).reshape(B, L, SSM_GROUPS, SSM_CH)
    dt = jnp.exp(log_dt.astype(jnp.float32))[:, None]
    lr, li = a_re.astype(jnp.float32), a_im.astype(jnp.float32)
    mag = jnp.exp(lr * dt)
    abar_r, abar_i = mag * jnp.cos(li * dt), mag * jnp.sin(li * dt)
    den = lr * lr + li * li
    nr, ni = abar_r - 1.0, abar_i
    coef_r = (nr * lr + ni * li) / den
    coef_i = (ni * lr - nr * li) / den
    br, bi = b_re.astype(jnp.float32), b_im.astype(jnp.float32)
    bbar_r = coef_r[..., None] * br - coef_i[..., None] * bi
    bbar_i = coef_r[..., None] * bi + coef_i[..., None] * br
    bu_r = jnp.einsum('blgp,gnp->blgn', uf, bbar_r)
    bu_i = jnp.einsum('blgp,gnp->blgn', uf, bbar_i)
    a_r = jnp.broadcast_to(abar_r[None, None], bu_r.shape)
    a_i = jnp.broadcast_to(abar_i[None, None], bu_i.shape)
    _, _, s_r, s_i = lax.associative_scan(_complex_linear_combine, (a_r, a_i, bu_r, bu_i), axis=1)
    y = (jnp.einsum('blgn,gpn->blgp', s_r, c_re.astype(jnp.float32))
         - jnp.einsum('blgn,gpn->blgp', s_i, c_im.astype(jnp.float32))
         + d.astype(jnp.float32).reshape(SSM_GROUPS, SSM_CH) * uf)
    z = jax.nn.gelu(y.reshape(B, L, SSM_WIDTH), approximate=False)
    z = z * jax.nn.sigmoid(z @ glu_w.astype(jnp.float32) + glu_b.astype(jnp.float32))
    return z.astype(u.dtype)


def peer_ffn(h, w_query, sub_keys, peer_u, peer_v):
    B, L, D = h.shape
    T = B * L
    n_chunks = -(-T // PEER_CHUNK)
    tok = jnp.pad(h.reshape(T, D), ((0, n_chunks * PEER_CHUNK - T), (0, 0)))
    tok = tok.reshape(n_chunks, PEER_CHUNK, D)
    keys1 = sub_keys[:, 0].astype(jnp.float32)
    keys2 = sub_keys[:, 1].astype(jnp.float32)

    def chunk_fn(hc):
        q = (hc @ w_query).astype(jnp.float32).reshape(PEER_CHUNK, PEER_HEADS, PEER_DK)
        s1 = jnp.einsum('chd,hkd->chk', q[..., :PEER_HALF], keys1)
        s2 = jnp.einsum('chd,hkd->chk', q[..., PEER_HALF:], keys2)
        v1, i1 = lax.top_k(s1, PEER_TOPK)
        v2, i2 = lax.top_k(s2, PEER_TOPK)
        cand = (v1[..., :, None] + v2[..., None, :]).reshape(PEER_CHUNK, PEER_HEADS, PEER_TOPK * PEER_TOPK)
        sc, ci = lax.top_k(cand, PEER_TOPK)
        idx = (jnp.take_along_axis(i1, ci // PEER_TOPK, axis=-1) * PEER_N_KEYS
               + jnp.take_along_axis(i2, ci % PEER_TOPK, axis=-1))
        g = jax.nn.softmax(sc, axis=-1)
        u_sel = peer_u[idx]
        act = jax.nn.gelu(jnp.einsum('chkd,cd->chk', u_sel, hc).astype(jnp.float32),
                          approximate=False) * g
        v_sel = peer_v[idx]
        return jnp.einsum('chk,chkd->cd', act.astype(hc.dtype), v_sel)

    out = lax.map(chunk_fn, tok).reshape(n_chunks * PEER_CHUNK, D)[:T]
    return out.reshape(B, L, D).astype(h.dtype)


def setup_inputs(seed: int = 0) -> dict:
    key = jax.random.key(seed)
    ks = jax.random.split(key, 26)
    nrm = jax.random.normal
    f32 = jnp.float32
    n_idx = jnp.arange(SSM_STATE, dtype=f32)
    return {
        "x": nrm(ks[0], (BATCH, SEQ, D_MODEL), f32),
        "meta_tokens": nrm(ks[1], (N_META, D_MODEL), f32),
        "norm1_g": 1.0 + 0.02 * nrm(ks[2], (DEPTH, D_MODEL), f32),
        "w_in": nrm(ks[3], (DEPTH, D_MODEL, IN_WIDTH), f32) * D_MODEL ** -0.5,
        "q_norm_g": 1.0 + 0.02 * nrm(ks[4], (DEPTH, HEAD_DIM), f32),
        "k_norm_g": 1.0 + 0.02 * nrm(ks[5], (DEPTH, HEAD_DIM), f32),
        "attn_sinks": 0.5 * nrm(ks[6], (DEPTH, N_Q_HEADS), f32),
        "ssm_a_re": -0.5 + 0.01 * nrm(ks[7], (DEPTH, SSM_GROUPS, SSM_STATE), f32),
        "ssm_a_im": math.pi * n_idx + 0.01 * nrm(ks[8], (DEPTH, SSM_GROUPS, SSM_STATE), f32),
        "ssm_log_dt": jax.random.uniform(ks[9], (DEPTH, SSM_GROUPS), f32,
                                         minval=math.log(DT_MIN), maxval=math.log(DT_MAX)),
        "ssm_b_re": nrm(ks[10], (DEPTH, SSM_GROUPS, SSM_STATE, SSM_CH), f32) * (2 * SSM_CH) ** -0.5,
        "ssm_b_im": nrm(ks[11], (DEPTH, SSM_GROUPS, SSM_STATE, SSM_CH), f32) * (2 * SSM_CH) ** -0.5,
        "ssm_c_re": nrm(ks[12], (DEPTH, SSM_GROUPS, SSM_CH, SSM_STATE), f32) * SSM_STATE ** -0.5,
        "ssm_c_im": nrm(ks[13], (DEPTH, SSM_GROUPS, SSM_CH, SSM_STATE), f32) * SSM_STATE ** -0.5,
        "ssm_d": nrm(ks[14], (DEPTH, SSM_WIDTH), f32),
        "ssm_glu_w": nrm(ks[15], (DEPTH, SSM_WIDTH, SSM_WIDTH), f32) * SSM_WIDTH ** -0.5,
        "ssm_glu_b": 0.02 * nrm(ks[16], (DEPTH, SSM_WIDTH), f32),
        "attn_out_g": 1.0 + 0.02 * nrm(ks[17], (DEPTH, ATTN_WIDTH), f32),
        "ssm_out_g": 1.0 + 0.02 * nrm(ks[18], (DEPTH, SSM_WIDTH), f32),
        "w_out": nrm(ks[19], (DEPTH, D_MODEL, D_MODEL), f32) * D_MODEL ** -0.5,
        "norm2_g": 1.0 + 0.02 * nrm(ks[20], (DEPTH, D_MODEL), f32),
        "peer_w_query": nrm(ks[21], (DEPTH, D_MODEL, PEER_HEADS * PEER_DK), f32) * D_MODEL ** -0.5,
        "peer_sub_keys": nrm(ks[22], (DEPTH, PEER_HEADS, 2, PEER_N_KEYS, PEER_HALF), f32) * PEER_HALF ** -0.5,
        "peer_u": nrm(ks[23], (DEPTH, PEER_EXPERTS, D_MODEL), f32) * D_MODEL ** -0.5,
        "peer_v": nrm(ks[24], (DEPTH, PEER_EXPERTS, D_MODEL), f32) * PEER_HEADS ** -0.5,
    }


def reference(x, meta_tokens, norm1_g, w_in, q_norm_g, k_norm_g, attn_sinks, ssm_a_re, ssm_a_im,
              ssm_log_dt, ssm_b_re, ssm_b_im, ssm_c_re, ssm_c_im, ssm_d, ssm_glu_w, ssm_glu_b,
              attn_out_g, ssm_out_g, w_out, norm2_g, peer_w_query, peer_sub_keys, peer_u, peer_v):
    B = x.shape[0]
    meta = jnp.broadcast_to(meta_tokens.astype(x.dtype)[None], (B, N_META, D_MODEL))
    h = jnp.concatenate([meta, x], axis=1)
    o_k = ATTN_WIDTH
    o_v = ATTN_WIDTH + KV_WIDTH
    o_u = ATTN_WIDTH + 2 * KV_WIDTH
    for l in range(DEPTH):
        proj = rms_norm(h, norm1_g[l]) @ w_in[l]
        attn = sliding_window_attention(proj[..., :o_k], proj[..., o_k:o_v], proj[..., o_v:o_u],
                                        q_norm_g[l], k_norm_g[l], attn_sinks[l])
        ssm = s5_ssm(proj[..., o_u:], ssm_a_re[l], ssm_a_im[l], ssm_log_dt[l], ssm_b_re[l], ssm_b_im[l],
                     ssm_c_re[l], ssm_c_im[l], ssm_d[l], ssm_glu_w[l], ssm_glu_b[l])
        mixed = jnp.concatenate([rms_norm(attn, attn_out_g[l]), rms_norm(ssm, ssm_out_g[l])], axis=-1)
        h = h + mixed @ w_out[l]
        h = h + peer_ffn(rms_norm(h, norm2_g[l]), peer_w_query[l], peer_sub_keys[l], peer_u[l], peer_v[l])
    return h[:, N_META:]
```

```cpp
#include <hip/hip_runtime.h>
#include <cstdio>
#include <cstdint>
#include <cmath>
namespace pg8 {
#define PG8_LAS __attribute__((address_space(3)))
typedef unsigned short bf16_t;
typedef short bf16x8 __attribute__((ext_vector_type(8)));
typedef float f32x4 __attribute__((ext_vector_type(4)));
typedef unsigned u32x4 __attribute__((ext_vector_type(4)));
constexpr int BM = 256, BK = 64, HALF = 128, HTB = HALF * BK * 2  , STAGE_BYTES = 8 * HTB, NXCD = 8, WGM = 8;

__host__ __device__ __forceinline__ int lds_byte(int r, int c) { const int st = (r >> 4) * 2 + (c >> 5), rr = r & 15, cc = c & 31, ob = rr * 64 + cc * 2; return st * 1024 + (ob ^ (((ob >> 9) & 1) << 5)); }
__host__ __device__ __forceinline__ void stage_rc(int b, int& R, int& C) { const int st = b / 1024, sb = b % 1024, swz = sb ^ (((sb >> 9) & 1) << 5); R = (st >> 1) * 16 + swz / 64; C = (st & 1) * 32 + (swz % 64) / 2; }
__host__ __device__ __forceinline__ int perm32(int rho) { const int n = rho >> 4, i = rho & 15; return 8 * (i >> 2) + 4 * n + (i & 3); }

struct Unit { int pm, pn; };
struct Gemm { const bf16_t* A; const bf16_t* Bt; int M, N, K; };

struct StaticOrder {
    int nM, nN, nwg, G, c;
    __host__ __device__ void init(int M, int N, int G_, int c_) { nM = M / BM; nN = N / BM; nwg = nM * nN; G = G_; c = c_; }
    __host__ __device__ bool next(int i, Unit& u) const {
        const long L = (long)i * G + c; if (L >= nwg) return false;
        int wgid = (int)L; { const int q = nwg / NXCD, r = nwg % NXCD, xcd = wgid % NXCD, off = wgid / NXCD; wgid = (xcd < r ? xcd * (q + 1) : r * (q + 1) + (xcd - r) * q) + off; }
        const int nig = WGM * nN, gid = wgid / nig, fm = gid * WGM, gsz = (nM - fm) < WGM ? (nM - fm) : WGM;
        u.pm = fm + ((wgid % nig) % gsz); u.pn = (wgid % nig) / gsz; return true;
    }
    __device__ __forceinline__ void a_ready(const Unit&) const {}
    __device__ __forceinline__ void done(const Unit&) const {}
};

__device__ __forceinline__ unsigned cvt_pk_bf16(float lo, float hi) { unsigned r; asm volatile("v_cvt_pk_bf16_f32 %0, %1, %2" : "=v"(r) : "v"(lo), "v"(hi)); return r; }
typedef float f32x2 __attribute__((ext_vector_type(2)));
__device__ __forceinline__ f32x2 gelu_pk(f32x2 v) {
    const f32x2 av = __builtin_elementwise_abs(v), d = av * 0.2316418882f + 1.0f;
    f32x2 t; t.x = __builtin_amdgcn_rcpf(d.x); t.y = __builtin_amdgcn_rcpf(d.y);
    f32x2 q = t * 0.5307027145f + (-0.7265760135f); q = q * t + 0.7107068705f; q = q * t + (-0.142248368f); q = q * t + 0.127414796f; q = q * t;
    const f32x2 s = (v * v) * (-0.72134752044f);
    f32x2 e; e.x = __builtin_amdgcn_exp2f(s.x); e.y = __builtin_amdgcn_exp2f(s.y);
    const f32x2 m = v * (q * e), r = v - m;
    f32x2 o; o.x = v.x < 0.f ? m.x : r.x; o.y = v.y < 0.f ? m.y : r.y; return o;
}

template <int ACT  > struct EpiBf16 {
    static constexpr bool PERM = true, AFTER_DRAIN = false; static_assert(ACT == 0 || ACT == 1, "EpiBf16: ACT is 0 (none) or 1 (gelu_pk)");
    bf16_t* O; int ldc; const float* bias; int split_cols; size_t split_stride; float scale0;
    __device__ __forceinline__ void operator()(const f32x4 (&acc)[2][2][4][2], const Unit& u, int wr, int wc, int fr, int fq) const {
        const int row0 = u.pm * BM + wr * 64 + fr; int colt = u.pn * BM; bf16_t* base = O;
        float sc = 1.f; if (split_cols) { const int t = colt / split_cols; base += (size_t)t * split_stride; colt -= t * split_cols; if (t == 0) sc = scale0; }
        const int col0 = colt + wc * 32 + 8 * fq, bcol0 = u.pn * BM + wc * 32 + 8 * fq;
        f32x4 bv[2][2];
#pragma unroll
        for (int bj = 0; bj < 2; ++bj)
#pragma unroll
            for (int n = 0; n < 2; ++n) bv[bj][n] = bias ? *(const f32x4*)(bias + bcol0 + bj * HALF + 4 * n) : (f32x4){0.f, 0.f, 0.f, 0.f};
#pragma unroll
        for (int ai = 0; ai < 2; ++ai)
#pragma unroll
            for (int m = 0; m < 4; ++m) { bf16_t* rowp = base + (size_t)(row0 + ai * HALF + m * 16) * ldc + col0;
#pragma unroll
                for (int bj = 0; bj < 2; ++bj) { f32x4 v0 = acc[ai][bj][m][0] + bv[bj][0], v1 = acc[ai][bj][m][1] + bv[bj][1];
                    if (ACT == 1) { f32x2 a = gelu_pk((f32x2){v0[0], v0[1]}), b = gelu_pk((f32x2){v0[2], v0[3]}), c = gelu_pk((f32x2){v1[0], v1[1]}), d = gelu_pk((f32x2){v1[2], v1[3]});
                        v0 = (f32x4){a.x, a.y, b.x, b.y}; v1 = (f32x4){c.x, c.y, d.x, d.y}; }
                    v0 = v0 * sc; v1 = v1 * sc; u32x4 w; w.x = cvt_pk_bf16(v0[0], v0[1]); w.y = cvt_pk_bf16(v0[2], v0[3]); w.z = cvt_pk_bf16(v1[0], v1[1]); w.w = cvt_pk_bf16(v1[2], v1[3]);
                    *(u32x4*)(rowp + bj * HALF) = w; } }
    }
};
template <class Epi, class Sched, bool ALIGN_EPI = false, bool SP2 = false>
__device__ __forceinline__ void gemm_phase(PG8_LAS unsigned char* lds, const Gemm g, const Sched& S, const Epi& E) {
    const int tid = threadIdx.x, wid = __builtin_amdgcn_readfirstlane(tid >> 6), lane = tid & 63, wr = wid >> 2, wc = wid & 3, fr = lane & 15, fq = lane >> 4;
    const int K = g.K, nt = K / BK;
    unsigned voffA[2], voffB[2];
#pragma unroll
    for (int i = 0; i < 2; ++i) { int R, C; stage_rc(tid * 16 + i * 8192, R, C); const int Rb = Epi::PERM ? ((R & ~31) + perm32(R & 31)) : R;
        voffA[i] = (unsigned)(R * K + C) * 2u; voffB[i] = (unsigned)(Rb * K + C) * 2u; }
    const size_t kstep = (size_t)(BK * 2);
    const size_t hstep = (size_t)HALF * K * 2;
    const size_t tstep = 2 * hstep;
    const unsigned ldsw = (unsigned)wid * 1024u;
    const int aoff = lds_byte(wr * 64 + fr, fq * 8), boff = lds_byte(wc * 32 + fr, fq * 8);
#define PG8_SA(b, h) (((b) * 2 + (h)) * HTB)
#define PG8_SB(b, h) ((4 + (b) * 2 + (h)) * HTB)
#define PG8_STAGE(bufoff, gbase, voff) do { _Pragma("unroll") for (int _i = 0; _i < 2; ++_i) \
        __builtin_amdgcn_global_load_lds((const unsigned*)((const char*)(gbase) + (voff)[_i]), (PG8_LAS unsigned*)(lds + (bufoff) + ldsw + _i * 8192), 16, 0, 0); } while (0)
#define PG8_LDA(dst, b, h) do { _Pragma("unroll") for (int m = 0; m < 4; ++m) _Pragma("unroll") for (int k = 0; k < 2; ++k) dst[m][k] = *(const PG8_LAS bf16x8*)(lds + PG8_SA(b, h) + aoff + m * 2048 + k * 1024); } while (0)
#define PG8_LDB(dst, b, h) do { _Pragma("unroll") for (int n = 0; n < 2; ++n) _Pragma("unroll") for (int k = 0; k < 2; ++k) dst[n][k] = *(const PG8_LAS bf16x8*)(lds + PG8_SB(b, h) + boff + n * 2048 + k * 1024); } while (0)
#define PG8_MMA(ai, bj, At, Bt) do { __builtin_amdgcn_s_setprio(1); _Pragma("unroll") for (int m = 0; m < 4; ++m) _Pragma("unroll") for (int n = 0; n < 2; ++n) _Pragma("unroll") for (int k = 0; k < 2; ++k) \
        acc[ai][bj][m][n] = __builtin_amdgcn_mfma_f32_16x16x32_bf16(Bt[n][k], At[m][k], acc[ai][bj][m][n], 0, 0, 0); __builtin_amdgcn_s_setprio(0); } while (0)
#define PG8_WAIT_V(n) asm volatile("s_waitcnt vmcnt(" #n ")" ::: "memory")
#define PG8_WAIT_L(n) asm volatile("s_waitcnt lgkmcnt(" #n ")" ::: "memory")
#define PG8_BAR __builtin_amdgcn_s_barrier()
#define PG8_SCHED __builtin_amdgcn_sched_barrier(0)
    Unit cur, nxt; int ui = 0;
    if (!S.next(0, cur)) return;
    f32x4 acc[2][2][4][2];
#pragma unroll
    for (int a = 0; a < 2; ++a)
#pragma unroll
        for (int b = 0; b < 2; ++b)
#pragma unroll
            for (int m = 0; m < 4; ++m)
#pragma unroll
                for (int n = 0; n < 2; ++n) acc[a][b][m][n] = (f32x4){0.f, 0.f, 0.f, 0.f};
    bf16x8 At[4][2], B0[2][2], B1[2][2];
    const char* cA = (const char*)g.A + (size_t)cur.pm * tstep; const char* cB = (const char*)g.Bt + (size_t)cur.pn * tstep;
    S.a_ready(cur);
    if constexpr (SP2) {
        PG8_STAGE(PG8_SB(0, 0), cB, voffB); PG8_STAGE(PG8_SB(0, 1), cB + hstep, voffB); PG8_STAGE(PG8_SA(0, 0), cA, voffA); PG8_STAGE(PG8_SA(0, 1), cA + hstep, voffA);
        if (wr == 1) PG8_BAR;
        PG8_WAIT_V(2); PG8_BAR;
        PG8_STAGE(PG8_SB(1, 0), cB + kstep, voffB); PG8_STAGE(PG8_SA(1, 0), cA + kstep, voffA); PG8_STAGE(PG8_SB(1, 1), cB + hstep + kstep, voffB);
        PG8_WAIT_V(6); PG8_BAR;
    } else {
        PG8_STAGE(PG8_SB(0, 0), cB, voffB); PG8_STAGE(PG8_SA(0, 0), cA, voffA); PG8_STAGE(PG8_SB(0, 1), cB + hstep, voffB); PG8_STAGE(PG8_SA(0, 1), cA + hstep, voffA);
        if (wr == 1) PG8_BAR;
        PG8_WAIT_V(4); PG8_BAR;
        PG8_STAGE(PG8_SB(1, 0), cB + kstep, voffB); PG8_STAGE(PG8_SA(1, 0), cA + kstep, voffA); PG8_STAGE(PG8_SB(1, 1), cB + hstep + kstep, voffB);
        PG8_WAIT_V(6); PG8_BAR;
    }
    for (;;) {
        const bool has_next = S.next(ui + 1, nxt);
        const char* nA = has_next ? (const char*)g.A + (size_t)nxt.pm * tstep : cA; const char* nB = has_next ? (const char*)g.Bt + (size_t)nxt.pn * tstep : cB;
        for (int t = 0; t < nt; t += 2) {
            const bool last = (t == nt - 2);
            const char* a1 = cA + (size_t)(t + 1) * kstep;
            const char* a2 = last ? nA : cA + (size_t)(t + 2) * kstep; const char* b2 = last ? nB : cB + (size_t)(t + 2) * kstep;
            const char* a3 = a2 + kstep; const char* b3 = b2 + kstep;
            if (last && has_next) S.a_ready(nxt);
            if constexpr (SP2) {
            PG8_LDB(B0, 0, 0); PG8_LDB(B1, 0, 1); PG8_SCHED; PG8_LDA(At, 0, 0); PG8_STAGE(PG8_SA(1, 1), a1 + hstep, voffA);
            PG8_WAIT_V(8); PG8_WAIT_L(0); PG8_BAR; PG8_MMA(0, 0, At, B0); PG8_MMA(0, 1, At, B1); PG8_BAR; PG8_SCHED;
            PG8_LDA(At, 0, 1); PG8_STAGE(PG8_SB(0, 0), b2, voffB); PG8_STAGE(PG8_SB(0, 1), b2 + hstep, voffB); PG8_STAGE(PG8_SA(0, 0), a2, voffA);
            PG8_WAIT_V(8); PG8_WAIT_L(0); PG8_BAR; PG8_MMA(1, 0, At, B0); PG8_MMA(1, 1, At, B1); PG8_BAR; PG8_SCHED;
            PG8_LDB(B0, 1, 0); PG8_LDB(B1, 1, 1); PG8_SCHED; PG8_LDA(At, 1, 0); PG8_STAGE(PG8_SA(0, 1), a2 + hstep, voffA);
            PG8_WAIT_V(8); PG8_WAIT_L(0); PG8_BAR; PG8_MMA(0, 0, At, B0); PG8_MMA(0, 1, At, B1); PG8_BAR; PG8_SCHED;
            PG8_LDA(At, 1, 1); PG8_STAGE(PG8_SB(1, 0), b3, voffB); PG8_STAGE(PG8_SB(1, 1), b3 + hstep, voffB); PG8_STAGE(PG8_SA(1, 0), a3, voffA);
            PG8_WAIT_V(8); PG8_WAIT_L(0); PG8_BAR; PG8_MMA(1, 0, At, B0); PG8_MMA(1, 1, At, B1); PG8_BAR; PG8_SCHED;
            } else {
            PG8_LDB(B0, 0, 0); PG8_SCHED; PG8_LDA(At, 0, 0); PG8_STAGE(PG8_SA(1, 1), a1 + hstep, voffA);
            PG8_WAIT_L(8); PG8_BAR; PG8_WAIT_L(0); PG8_MMA(0, 0, At, B0); PG8_BAR; PG8_SCHED;
            PG8_LDB(B1, 0, 1); PG8_STAGE(PG8_SB(0, 0), b2, voffB);
            PG8_BAR; PG8_WAIT_L(0); PG8_MMA(0, 1, At, B1); PG8_BAR;
            PG8_LDA(At, 0, 1); PG8_STAGE(PG8_SA(0, 0), a2, voffA);
            PG8_BAR; PG8_WAIT_L(0); PG8_MMA(1, 0, At, B0); PG8_BAR; PG8_SCHED;
            PG8_STAGE(PG8_SB(0, 1), b2 + hstep, voffB);
            PG8_WAIT_V(6); PG8_BAR; PG8_MMA(1, 1, At, B1); PG8_BAR;
            PG8_LDB(B0, 1, 0); PG8_SCHED; PG8_LDA(At, 1, 0); PG8_STAGE(PG8_SA(0, 1), a2 + hstep, voffA);
            PG8_WAIT_L(8); PG8_BAR; PG8_WAIT_L(0); PG8_MMA(0, 0, At, B0); PG8_BAR; PG8_SCHED;
            PG8_LDB(B1, 1, 1); PG8_STAGE(PG8_SB(1, 0), b3, voffB);
            PG8_BAR; PG8_WAIT_L(0); PG8_MMA(0, 1, At, B1); PG8_BAR;
            PG8_LDA(At, 1, 1); PG8_STAGE(PG8_SA(1, 0), a3, voffA);
            PG8_BAR; PG8_WAIT_L(0); PG8_MMA(1, 0, At, B0); PG8_BAR; PG8_SCHED;
            PG8_STAGE(PG8_SB(1, 1), b3 + hstep, voffB);
            PG8_WAIT_V(6); PG8_BAR; PG8_MMA(1, 1, At, B1); PG8_BAR;
            }
        }
        if constexpr (ALIGN_EPI) { if (wr == 0) PG8_BAR; }
        if constexpr (!Epi::AFTER_DRAIN) { E(acc, cur, wr, wc, fr, fq); S.done(cur); }
        if (!has_next) break;
#pragma unroll
        for (int a = 0; a < 2; ++a)
#pragma unroll
            for (int b = 0; b < 2; ++b)
#pragma unroll
                for (int m = 0; m < 4; ++m)
#pragma unroll
                    for (int n = 0; n < 2; ++n) acc[a][b][m][n] = (f32x4){0.f, 0.f, 0.f, 0.f};
        cur = nxt; cA = nA; cB = nB; ++ui;
        if constexpr (ALIGN_EPI) { if (wr == 1) PG8_BAR; }
    }
    PG8_WAIT_V(0);
    if constexpr (!ALIGN_EPI) { if (wr == 0) PG8_BAR; }
    PG8_BAR;
    if constexpr (Epi::AFTER_DRAIN) { E.fused(acc, cur, wr, wc, fr, fq, lds, wid, lane); S.done(cur); }
#undef PG8_SA
#undef PG8_SB
#undef PG8_STAGE
#undef PG8_LDA
#undef PG8_LDB
#undef PG8_MMA
#undef PG8_WAIT_V
#undef PG8_WAIT_L
#undef PG8_BAR
#undef PG8_SCHED
}
}

namespace mk {
#define LAS __attribute__((address_space(3)))
typedef unsigned short bf16_t;
typedef short bf16x8 __attribute__((ext_vector_type(8)));
typedef float f32x4 __attribute__((ext_vector_type(4)));
typedef float f32x16 __attribute__((ext_vector_type(16)));
typedef unsigned u32x4 __attribute__((ext_vector_type(4)));
typedef unsigned u32x2 __attribute__((ext_vector_type(2)));
typedef __bf16 bf16x2_t __attribute__((ext_vector_type(2)));
typedef float f32x2_t __attribute__((ext_vector_type(2)));
typedef unsigned u32;

constexpr int DM = 1024, SEQ = 16384, NMETA = 16, MPAD = 16640, INW = 1280;
constexpr int O_K = 512, O_V = 640, O_U = 768;
constexpr int NCH = 513;
constexpr float EPS = 1e-6f;
constexpr float LOG2E = 1.4426950408889634f;
constexpr int NWAVES = 8, NTHR = 512;
constexpr int LDS_BYTES = 147456;

constexpr size_t MiB = 1u << 20;
constexpr size_t WS_CTL = 0, CTL_BYTES = 1 * MiB;
constexpr size_t WS_WIN_T = 1 * MiB;
constexpr size_t WS_WOUT_T = 4 * MiB;
constexpr size_t WS_WQ_T = 6 * MiB;
constexpr size_t WS_GLU_T = 10 * MiB;
constexpr size_t WS_SUBK = 10 * MiB + 512 * 1024;
constexpr size_t WS_KT = 11 * MiB;
constexpr size_t WS_F = 12 * MiB;
constexpr size_t WS_E = 16 * MiB;
constexpr size_t WS_ABART = 20 * MiB;
constexpr size_t WS_SLOC = 21 * MiB;
constexpr size_t WS_CARRY = 30 * MiB;
constexpr size_t WS_BUFA = 39 * MiB;
constexpr size_t WS_PROJ = 72 * MiB;
constexpr size_t WS_ATTN = 113 * MiB;
constexpr size_t WS_Z = 129 * MiB;
constexpr size_t WS_SSMO = 145 * MiB;
constexpr size_t WS_QP = 72 * MiB;
constexpr size_t WS_IDX = 161 * MiB;
constexpr size_t WS_GW = 169 * MiB;
constexpr size_t WS_PU = 177 * MiB;
constexpr size_t WS_PV = 209 * MiB;
constexpr size_t WS_END = 241 * MiB;

struct Params { const float* in[25]; float* out; unsigned char* ws; int ph_lo, ph_hi; };
enum { I_X = 0, I_META, I_N1G, I_WIN, I_QNG, I_KNG, I_SINK, I_ARE, I_AIM, I_LDT, I_BRE, I_BIM, I_CRE, I_CIM, I_SD, I_GLUW, I_GLUB, I_AOG, I_SOG, I_WOUT, I_N2G, I_WQ, I_SUBK, I_PU, I_PV };

__device__ __forceinline__ unsigned pk2(float lo, float hi) { f32x2_t v = {lo, hi}; return __builtin_bit_cast(unsigned, __builtin_convertvector(v, bf16x2_t)); }
__device__ __forceinline__ float bflo(unsigned w) { return __uint_as_float(w << 16); }
__device__ __forceinline__ float bfhi(unsigned w) { return __uint_as_float(w & 0xffff0000u); }
__device__ __forceinline__ float wave_sum(float v) {
#pragma unroll
    for (int o = 1; o < 64; o <<= 1) v += __shfl_xor(v, o);
    return v;
}
#define LDS_WAIT() asm volatile("s_waitcnt lgkmcnt(0)" ::: "memory")
__device__ __forceinline__ float gelu_erf(float v) { return 0.5f * v * (1.0f + erff(v * 0.70710678118654752f)); }
__device__ __forceinline__ u32 f2ord(float f) { const u32 u = __float_as_uint(f); return (u & 0x80000000u) ? ~u : (u | 0x80000000u); }
__device__ __forceinline__ float ord2f(u32 o) { const u32 u = (o & 0x80000000u) ? (o & 0x7fffffffu) : ~o; return __uint_as_float(u); }
#define MFMA16(a, b, c) __builtin_amdgcn_mfma_f32_16x16x32_bf16((a), (b), (c), 0, 0, 0)
#define MFMA32(a, b, c) __builtin_amdgcn_mfma_f32_32x32x16_bf16((a), (b), (c), 0, 0, 0)

#define CEX(x, i, j) do { const u32 _a = x[i], _b = x[j]; x[i] = _a > _b ? _a : _b; x[j] = _a > _b ? _b : _a; } while (0)
__device__ __forceinline__ void sort16_desc(u32 (&x)[16]) {
#pragma unroll
    for (int k = 2; k <= 16; k <<= 1) {
#pragma unroll
        for (int j = k >> 1; j > 0; j >>= 1) {
#pragma unroll
            for (int i = 0; i < 16; ++i) { const int l = i ^ j; if (l > i) { if ((i & k) == 0) CEX(x, i, l); else CEX(x, l, i); } }
        }
    }
}
__device__ __forceinline__ void bmerge16_desc(u32 (&x)[16]) {
#pragma unroll
    for (int j = 8; j > 0; j >>= 1) {
#pragma unroll
        for (int i = 0; i < 16; ++i) { const int l = i ^ j; if (l > i) CEX(x, i, l); }
    }
}
__device__ __forceinline__ void merge_top16(u32 (&a)[16], const u32 (&b)[16]) {
#pragma unroll
    for (int i = 0; i < 16; ++i) a[i] = a[i] > b[15 - i] ? a[i] : b[15 - i];
    bmerge16_desc(a);
}
__device__ __forceinline__ void top16_of_64(u32 (&g0)[16], u32 (&g1)[16], u32 (&g2)[16], u32 (&g3)[16]) {
    sort16_desc(g0); sort16_desc(g1); sort16_desc(g2); sort16_desc(g3);
    merge_top16(g0, g1); merge_top16(g2, g3); merge_top16(g0, g2);
}
__device__ const unsigned char CAND_AB[64] = {0, 1, 2, 3, 4, 5, 6, 7, 8, 9, 10, 11, 12, 13, 14, 15, 16, 17, 18, 19, 20, 21, 22, 23, 32, 33, 34, 35, 36, 48, 49, 50, 51, 64, 65, 66, 80, 81, 96, 97, 112, 113, 128, 144, 160, 176, 192, 208, 224, 240, 0, 0, 0, 0, 0, 0, 0, 0, 0, 0, 0, 0, 0, 0};

struct Ctx { LAS unsigned char* lds; int tid, lane, wave, G, bid; };

__device__ __forceinline__ void transpose_item(const float* W, int K, int N, bf16_t* WT, LAS float* scr, int item, int lane) {
    const int nblk = N / 32, kb = item / nblk, nb = item % nblk, k0 = 64 * kb, n0 = 32 * nb;
#pragma unroll 8
    for (int i = 0; i < 32; ++i) { const int kk = 2 * i + (lane >> 5); scr[kk * 33 + (lane & 31)] = W[(size_t)(k0 + kk) * N + n0 + (lane & 31)]; }
    LDS_WAIT();
    const int c = lane & 7;
#pragma unroll
    for (int j = 0; j < 4; ++j) { const int n = (lane >> 3) + 8 * j; const LAS float* s = scr + (8 * c) * 33 + n;
        u32x4 o; o.x = pk2(s[0 * 33], s[1 * 33]); o.y = pk2(s[2 * 33], s[3 * 33]); o.z = pk2(s[4 * 33], s[5 * 33]); o.w = pk2(s[6 * 33], s[7 * 33]);
        *(u32x4*)(WT + (size_t)(n0 + n) * K + k0 + 8 * c) = o; }
    LDS_WAIT();
}

__device__ __forceinline__ void ssm_tables(const Ctx& C, const Params& P, int g) {
    LAS float* pwr = (LAS float*)C.lds;
    LAS float* pwi = pwr + 33 * 64;
    LAS float* bbr = pwi + 33 * 64;
    LAS float* bbi = bbr + 1024;
    LAS float* ccr = bbi + 1024;
    LAS float* cci = ccr + 1024;
    LAS float* cfr = cci + 1024;
    LAS float* cfi = cfr + 64;
    const int tid = C.tid;
    if (tid < 64) {
        const int n = tid;
        const float dt = expf(P.in[I_LDT][g]), lr = P.in[I_ARE][g * 64 + n], li = P.in[I_AIM][g * 64 + n];
        for (int l = 0; l <= 32; ++l) {
            const float x = lr * dt * (float)l, th = li * dt * (float)l, mag = expf(x);
            float s, c; sincosf(th, &s, &c);
            pwr[l * 64 + n] = mag * c; pwi[l * 64 + n] = mag * s;
        }
        const float x1 = lr * dt, th1 = li * dt, em1 = expm1f(x1);
        float s1, c1; sincosf(th1, &s1, &c1);
        const float sh = sinf(0.5f * th1);
        const float nr = em1 * c1 - 2.0f * sh * sh, ni = (em1 + 1.0f) * s1;
        const float den = lr * lr + li * li;
        cfr[n] = (nr * lr + ni * li) / den; cfi[n] = (ni * lr - nr * li) / den;
        float* abt = (float*)(P.ws + WS_ABART) + (g * 64 + n) * 2;
        abt[0] = pwr[32 * 64 + n]; abt[1] = pwi[32 * 64 + n];
    }
    __syncthreads();
    for (int e = tid; e < 1024; e += NTHR) {
        const int n = e >> 4;
        const float br = P.in[I_BRE][g * 1024 + e], bi = P.in[I_BIM][g * 1024 + e];
        bbr[e] = cfr[n] * br - cfi[n] * bi; bbi[e] = cfr[n] * bi + cfi[n] * br;
        ccr[e] = P.in[I_CRE][g * 1024 + e]; cci[e] = P.in[I_CIM][g * 1024 + e];
    }
    __syncthreads();
    bf16_t* Kt = (bf16_t*)(P.ws + WS_KT) + (size_t)g * 8448;
    for (int e = tid; e < 8448; e += NTHR) {
        const int li = e >> 8, p = (e >> 4) & 15, q = e & 15;
        float val = 0.f;
        if (li >= 1) {
            const int lag = li - 1;
            for (int n = 0; n < 64; ++n) {
                const float ar = pwr[lag * 64 + n], ai = pwi[lag * 64 + n], br = bbr[n * 16 + q], bi = bbi[n * 16 + q];
                const float wr = ar * br - ai * bi, wi = ar * bi + ai * br;
                val += ccr[p * 64 + n] * wr - cci[p * 64 + n] * wi;
            }
        }
        Kt[e] = (bf16_t)(pk2(val, 0.f) & 0xffffu);
    }
    bf16_t* F = (bf16_t*)(P.ws + WS_F) + (size_t)g * 65536;
    for (int e = tid; e < 65536; e += NTHR) {
        const int n2 = e >> 9, k = e & 511, j = k >> 4, q = k & 15, n = n2 & 63, l = 31 - j;
        const float ar = pwr[l * 64 + n], ai = pwi[l * 64 + n], br = bbr[n * 16 + q], bi = bbi[n * 16 + q];
        const float wr = ar * br - ai * bi, wi = ar * bi + ai * br;
        F[e] = (bf16_t)(pk2(n2 < 64 ? wr : wi, 0.f) & 0xffffu);
    }
    bf16_t* E = (bf16_t*)(P.ws + WS_E) + (size_t)g * 65536;
    for (int e = tid; e < 65536; e += NTHR) {
        const int row = e >> 7, n2 = e & 127, t = row >> 4, p = row & 15, n = n2 & 63;
        const float pr = pwr[(t + 1) * 64 + n], pi = pwi[(t + 1) * 64 + n], cr = ccr[p * 64 + n], ci = cci[p * 64 + n];
        const float cpr = cr * pr - ci * pi, cpi = cr * pi + ci * pr;
        E[e] = (bf16_t)(pk2(n2 < 64 ? cpr : -cpi, 0.f) & 0xffffu);
    }
    __syncthreads();
}

__device__ __forceinline__ void norm_row_to_bf16(const float* src, const float* gam, bf16_t* dst, int lane) {
    const f32x4* xr = (const f32x4*)src + lane; const f32x4* gr = (const f32x4*)gam + lane;
    f32x4 v[4]; float s = 0.f;
#pragma unroll
    for (int j = 0; j < 4; ++j) { v[j] = xr[64 * j]; s += (v[j].x * v[j].x + v[j].y * v[j].y) + (v[j].z * v[j].z + v[j].w * v[j].w); }
    const float rinv = 1.0f / sqrtf(wave_sum(s) * (1.0f / DM) + EPS);
    u32x2* o = (u32x2*)dst + lane;
#pragma unroll
    for (int j = 0; j < 4; ++j) { const f32x4 g = gr[64 * j]; u32x2 w; w.x = pk2(v[j].x * rinv * g.x, v[j].y * rinv * g.y); w.y = pk2(v[j].z * rinv * g.z, v[j].w * rinv * g.w); o[64 * j] = w; }
}

__device__ __forceinline__ void cvt8(const float* src, bf16_t* dst, size_t i) {
    const f32x4 a = ((const f32x4*)src)[2 * i], b = ((const f32x4*)src)[2 * i + 1];
    u32x4 o; o.x = pk2(a.x, a.y); o.y = pk2(a.z, a.w); o.z = pk2(b.x, b.y); o.w = pk2(b.z, b.w);
    ((u32x4*)dst)[i] = o;
}

__device__ __forceinline__ void phase_prologue(const Ctx& C, const Params& P) {
    for (int g = C.bid; g < 32; g += C.G) ssm_tables(C, P, g);
    __syncthreads();
    LAS float* scr = (LAS float*)(C.lds + C.wave * 16384);
    const int gw = C.bid * NWAVES + C.wave, NGW = C.G * NWAVES;
    constexpr int I_IN = 16 * 40, I_OUT = 16 * 32, I_Q = 16 * 64, I_GLU = 8 * 16, NITEMS = I_IN + I_OUT + I_Q + I_GLU;
    for (int it = gw; it < NITEMS; it += NGW) {
        int r = it;
        if (r < I_IN) { transpose_item(P.in[I_WIN], 1024, 1280, (bf16_t*)(P.ws + WS_WIN_T), scr, r, C.lane); continue; } r -= I_IN;
        if (r < I_OUT) { transpose_item(P.in[I_WOUT], 1024, 1024, (bf16_t*)(P.ws + WS_WOUT_T), scr, r, C.lane); continue; } r -= I_OUT;
        if (r < I_Q) { transpose_item(P.in[I_WQ], 1024, 2048, (bf16_t*)(P.ws + WS_WQ_T), scr, r, C.lane); continue; } r -= I_Q;
        transpose_item(P.in[I_GLUW], 512, 512, (bf16_t*)(P.ws + WS_GLU_T), scr, r, C.lane);
    }
    bf16_t* xn = (bf16_t*)(P.ws + WS_BUFA);
    for (int m = gw; m < MPAD; m += NGW) {
        if (m < SEQ) norm_row_to_bf16(P.in[I_X] + (size_t)m * DM, P.in[I_N1G], xn + (size_t)m * DM, C.lane);
        else if (m < SEQ + NMETA) norm_row_to_bf16(P.in[I_META] + (size_t)(m - SEQ) * DM, P.in[I_N1G], xn + (size_t)m * DM, C.lane);
        else { u32x4 z = {0u, 0u, 0u, 0u}; u32x4* o = (u32x4*)(xn + (size_t)m * DM); o[C.lane] = z; o[64 + C.lane] = z; }
    }
    const size_t gt = (size_t)C.bid * NTHR + C.tid, NT = (size_t)C.G * NTHR;
    constexpr size_t NTAB = (size_t)16384 * 1024 / 8;
    for (size_t i = gt; i < NTAB; i += NT) cvt8(P.in[I_PU], (bf16_t*)(P.ws + WS_PU), i);
    for (size_t i = gt; i < NTAB; i += NT) cvt8(P.in[I_PV], (bf16_t*)(P.ws + WS_PV), i);
    for (size_t i = gt; i < 262144 / 8; i += NT) cvt8(P.in[I_SUBK], (bf16_t*)(P.ws + WS_SUBK), i);
}

__device__ __forceinline__ bf16x8 u_frag(const bf16_t* proj, int ci, int j, int g, int half) {
    int row = 0; bool ok = true;
    if (ci == 0) { ok = (j >= 16); row = SEQ + j - 16; } else if (ci < NCH) row = (ci - 1) * 32 + j; else ok = false;
    bf16x8 z = {0, 0, 0, 0, 0, 0, 0, 0};
    if (!ok) return z;
    return *(const bf16x8*)(proj + (size_t)row * INW + O_U + g * 16 + half * 8);
}

__device__ __forceinline__ void phase_sloc(const Ctx& C, const Params& P) {
    const bf16_t* proj = (const bf16_t*)(P.ws + WS_PROJ);
    const bf16_t* Fall = (const bf16_t*)(P.ws + WS_F);
    float* SL = (float*)(P.ws + WS_SLOC);
    const int gw = C.bid * NWAVES + C.wave, NGW = C.G * NWAVES;
    const int n = C.lane & 15, kq = C.lane >> 4;
    for (int unit = gw; unit < 32 * 33; unit += NGW) {
        const int g = unit / 33, s = unit % 33, ci = 16 * s + n;
        bf16x8 Bf[16];
#pragma unroll
        for (int ks = 0; ks < 16; ++ks) Bf[ks] = u_frag(proj, ci, 2 * ks + (kq >> 1), g, kq & 1);
        const bf16_t* Fg = Fall + (size_t)g * 65536;
#pragma unroll 1
        for (int mt = 0; mt < 8; ++mt) {
            f32x4 acc = {0.f, 0.f, 0.f, 0.f};
#pragma unroll
            for (int ks = 0; ks < 16; ++ks) {
                const bf16x8 A = *(const bf16x8*)(Fg + (size_t)(mt * 16 + n) * 512 + 32 * ks + 8 * kq);
                acc = MFMA16(A, Bf[ks], acc);
            }
            if (ci < NCH) *(f32x4*)(SL + ((size_t)ci * 32 + g) * 128 + mt * 16 + 4 * kq) = acc;
        }
    }
}

__device__ __forceinline__ void carry_scan_block(const Ctx& C, const Params& P, int bk) {
    const float* SL = (const float*)(P.ws + WS_SLOC);
    float* CA = (float*)(P.ws + WS_CARRY);
    LAS float* Lr = (LAS float*)C.lds;
    LAS float* Li = Lr + 512;
    const int chan = bk * 32 + (C.tid & 31), g = chan >> 6, n = chan & 63, sg = C.tid >> 5;
    const float* abt = (const float*)(P.ws + WS_ABART) + (g * 64 + n) * 2;
    const float ar = abt[0], ai = abt[1];
    float sr = 0.f, si = 0.f;
#pragma unroll 8
    for (int i = 0; i < 32; ++i) {
        const int ci = 32 * sg + i; const size_t o = ((size_t)ci * 32 + g) * 128 + n;
        const float br = SL[o], bi = SL[o + 64];
        const float tr = ar * sr - ai * si + br, ti = ar * si + ai * sr + bi; sr = tr; si = ti;
    }
    Lr[sg * 32 + (C.tid & 31)] = sr; Li[sg * 32 + (C.tid & 31)] = si;
    float pr = ar, pi = ai;
#pragma unroll
    for (int k = 0; k < 5; ++k) { const float tr = pr * pr - pi * pi, ti = 2.f * pr * pi; pr = tr; pi = ti; }
    __syncthreads();
    float cr = 0.f, ci_ = 0.f;
    for (int s2 = 0; s2 < sg; ++s2) { const float lr = Lr[s2 * 32 + (C.tid & 31)], li = Li[s2 * 32 + (C.tid & 31)];
        const float tr = pr * cr - pi * ci_ + lr, ti = pr * ci_ + pi * cr + li; cr = tr; ci_ = ti; }
    sr = cr; si = ci_;
#pragma unroll 8
    for (int i = 0; i < 32; ++i) {
        const int ci = 32 * sg + i; const size_t o = ((size_t)ci * 32 + g) * 128 + n;
        CA[o] = sr; CA[o + 64] = si;
        const float br = SL[o], bi = SL[o + 64];
        const float tr = ar * sr - ai * si + br, ti = ar * si + ai * sr + bi; sr = tr; si = ti;
    }
    if (sg == 15) { const size_t o = ((size_t)512 * 32 + g) * 128 + n; CA[o] = sr; CA[o + 64] = si; }
    __syncthreads();
}

__device__ __forceinline__ void phase_ssm_y(const Ctx& C, const Params& P) {
    const bf16_t* proj = (const bf16_t*)(P.ws + WS_PROJ);
    const float* CA = (const float*)(P.ws + WS_CARRY);
    bf16_t* Z = (bf16_t*)(P.ws + WS_Z);
    const int n = C.lane & 15, kq = C.lane >> 4;
    for (int bu = C.bid; bu < 256; bu += C.G) {
        const int g = bu >> 3, cq = bu & 7;
        __syncthreads();
        { const u32x4* src = (const u32x4*)((const bf16_t*)(P.ws + WS_KT) + (size_t)g * 8448); LAS u32x4* dst = (LAS u32x4*)C.lds;
          for (int e = C.tid; e < 1056; e += NTHR) dst[e] = src[e]; }
        __syncthreads();
        const int ci = 1 + 64 * cq + 16 * (C.wave >> 1) + n, par = C.wave & 1;
        bf16x8 Uf[16], Cf[4];
#pragma unroll
        for (int ks = 0; ks < 16; ++ks) Uf[ks] = u_frag(proj, ci, 2 * ks + (kq >> 1), g, kq & 1);
#pragma unroll
        for (int k2 = 0; k2 < 4; ++k2) {
            const float* cp = CA + ((size_t)ci * 32 + g) * 128 + 32 * k2 + 8 * kq;
            const f32x4 a = *(const f32x4*)cp, b = *(const f32x4*)(cp + 4);
            u32x4 w; w.x = pk2(a.x, a.y); w.y = pk2(a.z, a.w); w.z = pk2(b.x, b.y); w.w = pk2(b.z, b.w);
            Cf[k2] = __builtin_bit_cast(bf16x8, w);
        }
        const bf16_t* Eg = (const bf16_t*)(P.ws + WS_E) + (size_t)g * 65536;
        const f32x4 dv = *(const f32x4*)(P.in[I_SD] + g * 16 + 4 * kq);
#pragma unroll 1
        for (int tt = 0; tt < 16; ++tt) {
            const int t = 2 * tt + par;
            f32x4 acc = {0.f, 0.f, 0.f, 0.f};
#pragma unroll
            for (int k2 = 0; k2 < 4; ++k2) {
                const bf16x8 A = *(const bf16x8*)(Eg + (size_t)(t * 16 + n) * 128 + 32 * k2 + 8 * kq);
                acc = MFMA16(A, Cf[k2], acc);
            }
#pragma unroll
            for (int ks = 0; ks < 16; ++ks) {
                if (ks <= tt) {
                    const int li = t - 2 * ks - (kq >> 1) + 1;
                    const bf16x8 A = *(const LAS bf16x8*)(C.lds + ((li * 16 + n) * 16 + 8 * (kq & 1)) * 2);
                    acc = MFMA16(A, Uf[ks], acc);
                }
            }
            const int row = (ci - 1) * 32 + t, ch = g * 16 + 4 * kq;
            const u32x2 uw = *(const u32x2*)(proj + (size_t)row * INW + O_U + ch);
            const float y0 = acc.x + dv.x * bflo(uw.x), y1 = acc.y + dv.y * bfhi(uw.x), y2 = acc.z + dv.z * bflo(uw.y), y3 = acc.w + dv.w * bfhi(uw.y);
            u32x2 o; o.x = pk2(gelu_erf(y0), gelu_erf(y1)); o.y = pk2(gelu_erf(y2), gelu_erf(y3));
            *(u32x2*)(Z + (size_t)row * 512 + ch) = o;
        }
    }
}

constexpr int VT_PITCH = 296;
__device__ __forceinline__ void attn_unit(const Ctx& C, const Params& P, int b, int hk) {
    const bf16_t* proj = (const bf16_t*)(P.ws + WS_PROJ);
    bf16_t* AO = (bf16_t*)(P.ws + WS_ATTN);
    LAS unsigned char* Ks = C.lds;
    LAS bf16_t* Vt = (LAS bf16_t*)(C.lds + 288 * 128);
    __syncthreads();
    for (int e = C.tid; e < 288 * 8; e += NTHR) {
        const int key = e >> 3, ch = e & 7;
        int row = -1;
        if (key < 256) { const int j = (b - 1) * 128 + key; if (j >= 0) row = j; } else if (key < 272) row = SEQ + key - 256;
        u32x4 kw = {0u, 0u, 0u, 0u}, vw = {0u, 0u, 0u, 0u};
        if (row >= 0) { kw = *(const u32x4*)(proj + (size_t)row * INW + O_K + hk * 64 + ch * 8); vw = *(const u32x4*)(proj + (size_t)row * INW + O_V + hk * 64 + ch * 8); }
        float kf[8] = {bflo(kw.x), bfhi(kw.x), bflo(kw.y), bfhi(kw.y), bflo(kw.z), bfhi(kw.z), bflo(kw.w), bfhi(kw.w)};
        float ss = 0.f;
#pragma unroll
        for (int i = 0; i < 8; ++i) ss += kf[i] * kf[i];
        ss += __shfl_xor(ss, 1); ss += __shfl_xor(ss, 2); ss += __shfl_xor(ss, 4);
        const float rinv = 1.0f / sqrtf(ss * (1.0f / 64.0f) + EPS);
        const f32x4 g0 = *(const f32x4*)(P.in[I_KNG] + ch * 8), g1 = *(const f32x4*)(P.in[I_KNG] + ch * 8 + 4);
        u32x4 o; o.x = pk2(kf[0] * rinv * g0.x, kf[1] * rinv * g0.y); o.y = pk2(kf[2] * rinv * g0.z, kf[3] * rinv * g0.w);
        o.z = pk2(kf[4] * rinv * g1.x, kf[5] * rinv * g1.y); o.w = pk2(kf[6] * rinv * g1.z, kf[7] * rinv * g1.w);
        *(LAS u32x4*)(Ks + key * 128 + ((ch ^ (key & 7)) * 16)) = o;
        const unsigned vv[4] = {vw.x, vw.y, vw.z, vw.w};
#pragma unroll
        for (int i = 0; i < 4; ++i) { Vt[(ch * 8 + 2 * i) * VT_PITCH + key] = (bf16_t)(vv[i] & 0xffffu); Vt[(ch * 8 + 2 * i + 1) * VT_PITCH + key] = (bf16_t)(vv[i] >> 16); }
    }
    __syncthreads();
    const int c = C.lane & 31, h = C.lane >> 5;
#pragma unroll 1
    for (int ti = C.wave; ti < 16; ti += NWAVES) {
        const int hql = ti >> 2, wq = ti & 3, hq = hk * 4 + hql;
        const int qi = wq * 32 + c, tok = b * 128 + qi;
        bf16x8 qf[4];
        {
            u32x4 qw[4]; float ss = 0.f;
#pragma unroll
            for (int ks = 0; ks < 4; ++ks) { qw[ks] = *(const u32x4*)(proj + (size_t)tok * INW + hq * 64 + 16 * ks + 8 * h);
                const unsigned w[4] = {qw[ks].x, qw[ks].y, qw[ks].z, qw[ks].w};
#pragma unroll
                for (int i = 0; i < 4; ++i) { const float a = bflo(w[i]), bb = bfhi(w[i]); ss += a * a + bb * bb; } }
            ss += __shfl_xor(ss, 32);
            const float rinv = (1.0f / sqrtf(ss * (1.0f / 64.0f) + EPS)) * (0.125f * LOG2E);
#pragma unroll
            for (int ks = 0; ks < 4; ++ks) {
                const f32x4 g0 = *(const f32x4*)(P.in[I_QNG] + 16 * ks + 8 * h), g1 = *(const f32x4*)(P.in[I_QNG] + 16 * ks + 8 * h + 4);
                u32x4 o; o.x = pk2(bflo(qw[ks].x) * rinv * g0.x, bfhi(qw[ks].x) * rinv * g0.y); o.y = pk2(bflo(qw[ks].y) * rinv * g0.z, bfhi(qw[ks].y) * rinv * g0.w);
                o.z = pk2(bflo(qw[ks].z) * rinv * g1.x, bfhi(qw[ks].z) * rinv * g1.y); o.w = pk2(bflo(qw[ks].w) * rinv * g1.z, bfhi(qw[ks].w) * rinv * g1.w);
                qf[ks] = __builtin_bit_cast(bf16x8, o);
            }
        }
        f32x16 S[6];
#pragma unroll
        for (int rb = 0; rb < 6; ++rb) {
            const int kb = (rb < 5) ? (wq + rb) : 8;
            const int key = kb * 32 + c;
            f32x16 acc = {0.f, 0.f, 0.f, 0.f, 0.f, 0.f, 0.f, 0.f, 0.f, 0.f, 0.f, 0.f, 0.f, 0.f, 0.f, 0.f};
#pragma unroll
            for (int ks = 0; ks < 4; ++ks) {
                const bf16x8 A = *(const LAS bf16x8*)(Ks + key * 128 + (((2 * ks + h) ^ (key & 7)) * 16));
                acc = MFMA32(A, qf[ks], acc);
            }
            S[rb] = acc;
            __builtin_amdgcn_sched_barrier(0);
        }
        const float sl = P.in[I_SINK][hq] * LOG2E;
        float mx = sl;
#pragma unroll
        for (int r = 0; r < 16; ++r) {
            const int kr = (r & 3) + 8 * (r >> 2) + 4 * h;
            const bool gt = kr > c;
            S[0][r] = gt ? S[0][r] : -1e30f;
            S[4][r] = gt ? -1e30f : S[4][r];
            if (r >= 8) S[5][r] = -1e30f;
        }
        if (b == 0) {
#pragma unroll
            for (int rb = 0; rb < 4; ++rb) if (wq + rb < 4) {
#pragma unroll
                for (int r = 0; r < 16; ++r) S[rb][r] = -1e30f;
            }
        }
#pragma unroll
        for (int rb = 0; rb < 6; ++rb)
#pragma unroll
            for (int r = 0; r < 16; ++r) mx = fmaxf(mx, S[rb][r]);
        mx = fmaxf(mx, __shfl_xor(mx, 32));
        float lsum = 0.f;
#pragma unroll
        for (int rb = 0; rb < 6; ++rb)
#pragma unroll
            for (int r = 0; r < 16; ++r) { const float p = exp2f(S[rb][r] - mx); S[rb][r] = p; lsum += p; }
        lsum += __shfl_xor(lsum, 32);
        lsum += exp2f(sl - mx);
        const float linv = 1.0f / lsum;
        f32x16 O[2];
#pragma unroll
        for (int db = 0; db < 2; ++db) O[db] = (f32x16){0.f, 0.f, 0.f, 0.f, 0.f, 0.f, 0.f, 0.f, 0.f, 0.f, 0.f, 0.f, 0.f, 0.f, 0.f, 0.f};
#pragma unroll
        for (int rb = 0; rb < 6; ++rb) {
            const int kb = (rb < 5) ? (wq + rb) : 8;
#pragma unroll
            for (int s = 0; s < 2; ++s) {
                if (rb == 5 && s == 1) continue;
                u32x4 pw; pw.x = pk2(S[rb][8 * s + 0], S[rb][8 * s + 1]); pw.y = pk2(S[rb][8 * s + 2], S[rb][8 * s + 3]);
                pw.z = pk2(S[rb][8 * s + 4], S[rb][8 * s + 5]); pw.w = pk2(S[rb][8 * s + 6], S[rb][8 * s + 7]);
                const bf16x8 Pf = __builtin_bit_cast(bf16x8, pw);
#pragma unroll
                for (int db = 0; db < 2; ++db) {
                    const LAS bf16_t* vp = Vt + (db * 32 + c) * VT_PITCH + kb * 32 + 16 * s + 4 * h;
                    const u32x2 lo = *(const LAS u32x2*)vp, hi2 = *(const LAS u32x2*)(vp + 8);
                    u32x4 vw; vw.x = lo.x; vw.y = lo.y; vw.z = hi2.x; vw.w = hi2.y;
                    O[db] = MFMA32(__builtin_bit_cast(bf16x8, vw), Pf, O[db]);
                }
                __builtin_amdgcn_sched_barrier(0);
            }
        }
#pragma unroll
        for (int db = 0; db < 2; ++db)
#pragma unroll
            for (int gq = 0; gq < 4; ++gq) {
                u32x2 o; o.x = pk2(O[db][4 * gq] * linv, O[db][4 * gq + 1] * linv); o.y = pk2(O[db][4 * gq + 2] * linv, O[db][4 * gq + 3] * linv);
                *(u32x2*)(AO + (size_t)tok * 512 + hq * 64 + db * 32 + 8 * gq + 4 * h) = o;
            }
    }
}

struct EpiGlu {
    static constexpr bool PERM = true, AFTER_DRAIN = false;
    const bf16_t* Z; bf16_t* O; const float* bias;
    __device__ __forceinline__ void operator()(const pg8::f32x4 (&acc)[2][2][4][2], const pg8::Unit& u, int wr, int wc, int fr, int fq) const {
        const int row0 = u.pm * 256 + wr * 64 + fr, col0 = u.pn * 256 + wc * 32 + 8 * fq;
#pragma unroll
        for (int ai = 0; ai < 2; ++ai)
#pragma unroll
            for (int m = 0; m < 4; ++m)
#pragma unroll
                for (int bj = 0; bj < 2; ++bj) {
                    const size_t off = (size_t)(row0 + ai * 128 + m * 16) * 512 + col0 + bj * 128;
                    const u32x4 zw = *(const u32x4*)(Z + off);
                    const f32x4 b0 = *(const f32x4*)(bias + col0 + bj * 128), b1 = *(const f32x4*)(bias + col0 + bj * 128 + 4);
                    const pg8::f32x4 v0 = acc[ai][bj][m][0], v1 = acc[ai][bj][m][1];
                    const float zf[8] = {bflo(zw.x), bfhi(zw.x), bflo(zw.y), bfhi(zw.y), bflo(zw.z), bfhi(zw.z), bflo(zw.w), bfhi(zw.w)};
                    const float pre[8] = {v0[0] + b0.x, v0[1] + b0.y, v0[2] + b0.z, v0[3] + b0.w, v1[0] + b1.x, v1[1] + b1.y, v1[2] + b1.z, v1[3] + b1.w};
                    float r[8];
#pragma unroll
                    for (int i = 0; i < 8; ++i) r[i] = zf[i] / (1.0f + __expf(-pre[i]));
                    u32x4 o; o.x = pk2(r[0], r[1]); o.y = pk2(r[2], r[3]); o.z = pk2(r[4], r[5]); o.w = pk2(r[6], r[7]);
                    *(u32x4*)(O + off) = o;
                }
    }
};
struct EpiRes {
    static constexpr bool PERM = false, AFTER_DRAIN = false;
    const float* base; float* out;
    __device__ __forceinline__ void operator()(const pg8::f32x4 (&acc)[2][2][4][2], const pg8::Unit& u, int wr, int wc, int fr, int fq) const {
        const int col0 = u.pn * 256 + wc * 32 + 4 * fq;
#pragma unroll
        for (int ai = 0; ai < 2; ++ai)
#pragma unroll
            for (int m = 0; m < 4; ++m) {
                const size_t off = (size_t)(u.pm * 256 + ai * 128 + wr * 64 + m * 16 + fr) * 1024 + col0;
#pragma unroll
                for (int bj = 0; bj < 2; ++bj)
#pragma unroll
                    for (int n = 0; n < 2; ++n) {
                        const f32x4 bs = *(const f32x4*)(base + off + bj * 128 + n * 16);
                        const pg8::f32x4 a = acc[ai][bj][m][n];
                        f32x4 o; o.x = bs.x + a[0]; o.y = bs.y + a[1]; o.z = bs.z + a[2]; o.w = bs.w + a[3];
                        *(f32x4*)(out + off + bj * 128 + n * 16) = o;
                    }
            }
    }
};

__device__ __forceinline__ void phase_mix_norm(const Ctx& C, const Params& P) {
    const bf16_t* AO = (const bf16_t*)(P.ws + WS_ATTN); const bf16_t* SO = (const bf16_t*)(P.ws + WS_SSMO);
    bf16_t* MX = (bf16_t*)(P.ws + WS_BUFA);
    const int gw = C.bid * NWAVES + C.wave, NGW = C.G * NWAVES;
    for (int m = gw; m < SEQ; m += NGW) {
#pragma unroll
        for (int part = 0; part < 2; ++part) {
            const bf16_t* src = (part ? SO : AO) + (size_t)m * 512 + 8 * C.lane;
            const float* gam = P.in[part ? I_SOG : I_AOG] + 8 * C.lane;
            const u32x4 w = *(const u32x4*)src;
            const float f[8] = {bflo(w.x), bfhi(w.x), bflo(w.y), bfhi(w.y), bflo(w.z), bfhi(w.z), bflo(w.w), bfhi(w.w)};
            float ss = 0.f;
#pragma unroll
            for (int i = 0; i < 8; ++i) ss += f[i] * f[i];
            const float rinv = 1.0f / sqrtf(wave_sum(ss) * (1.0f / 512.0f) + EPS);
            const f32x4 g0 = *(const f32x4*)gam, g1 = *(const f32x4*)(gam + 4);
            u32x4 o; o.x = pk2(f[0] * rinv * g0.x, f[1] * rinv * g0.y); o.y = pk2(f[2] * rinv * g0.z, f[3] * rinv * g0.w);
            o.z = pk2(f[4] * rinv * g1.x, f[5] * rinv * g1.y); o.w = pk2(f[6] * rinv * g1.z, f[7] * rinv * g1.w);
            *(u32x4*)(MX + (size_t)m * DM + part * 512 + 8 * C.lane) = o;
        }
    }
}
__device__ __forceinline__ void phase_norm2(const Ctx& C, const Params& P) {
    bf16_t* HN = (bf16_t*)(P.ws + WS_BUFA);
    const int gw = C.bid * NWAVES + C.wave, NGW = C.G * NWAVES;
    for (int m = gw; m < SEQ; m += NGW) norm_row_to_bf16(P.out + (size_t)m * DM, P.in[I_N2G], HN + (size_t)m * DM, C.lane);
}

__device__ __forceinline__ void peer_topk_tile(const Ctx& C, const Params& P, int tok0) {
    const bf16_t* QP = (const bf16_t*)(P.ws + WS_QP);
    const bf16_t* SK = (const bf16_t*)(P.ws + WS_SUBK);
    int* IDX = (int*)(P.ws + WS_IDX); float* GW = (float*)(P.ws + WS_GW);
    LAS u32* lists = (LAS u32*)C.lds;
    const int c = C.lane & 31, h = C.lane >> 5;
    __syncthreads();
#pragma unroll 1
    for (int task = C.wave; task < 32; task += NWAVES) {
        const int tgp = task & 1, hs = task >> 1;
        const int tl = tgp * 32 + c;
        const bf16_t* qrow = QP + (size_t)(tok0 + tl) * 2048 + hs * 128;
        bf16x8 qf[8];
#pragma unroll
        for (int ks = 0; ks < 8; ++ks) qf[ks] = *(const bf16x8*)(qrow + 16 * ks + 8 * h);
        u32 g[4][16];
#pragma unroll
        for (int kb = 0; kb < 4; ++kb) {
            f32x16 acc = {0.f, 0.f, 0.f, 0.f, 0.f, 0.f, 0.f, 0.f, 0.f, 0.f, 0.f, 0.f, 0.f, 0.f, 0.f, 0.f};
            const bf16_t* krow = SK + (size_t)(hs * 128 + kb * 32 + c) * 128;
#pragma unroll
            for (int ks = 0; ks < 8; ++ks) acc = MFMA32(*(const bf16x8*)(krow + 16 * ks + 8 * h), qf[ks], acc);
#pragma unroll
            for (int r = 0; r < 16; ++r) { const int key = kb * 32 + (r & 3) + 8 * (r >> 2) + 4 * h; g[kb][r] = (f2ord(acc[r]) & ~0x7Fu) | (u32)(127 - key); }
        }
        top16_of_64(g[0], g[1], g[2], g[3]);
        u32 pb[16];
#pragma unroll
        for (int i = 0; i < 16; ++i) pb[i] = (u32)__shfl_xor((int)g[0][i], 32);
        merge_top16(g[0], pb);
        if (h == 0) {
            LAS u32x4* dst = (LAS u32x4*)(lists + (tl * 16 + hs) * 16);
#pragma unroll
            for (int i = 0; i < 4; ++i) { u32x4 w; w.x = g[0][4 * i]; w.y = g[0][4 * i + 1]; w.z = g[0][4 * i + 2]; w.w = g[0][4 * i + 3]; dst[i] = w; }
        }
    }
    __syncthreads();
    {
        const int tl = C.tid & 63, hd = C.tid >> 6;
        const LAS u32* L1 = lists + (tl * 16 + hd * 2) * 16; const LAS u32* L2 = L1 + 16;
        float v1[16], v2[16];
#pragma unroll
        for (int i = 0; i < 16; ++i) { v1[i] = ord2f(L1[i] & ~0x7Fu); v2[i] = ord2f(L2[i] & ~0x7Fu); }
        u32 cd[4][16];
        { int cid = 0;
#pragma unroll
          for (int a = 0; a < 16; ++a)
#pragma unroll
              for (int b = 0; b < 16; ++b) if ((a + 1) * (b + 1) <= 16) { cd[cid >> 4][cid & 15] = (f2ord(v1[a] + v2[b]) & ~0x3Fu) | (u32)(63 - cid); ++cid; }
#pragma unroll
          for (int k = 50; k < 64; ++k) cd[k >> 4][k & 15] = 0u; }
        top16_of_64(cd[0], cd[1], cd[2], cd[3]);
        float sc[16]; int ix[16]; float mx = -1e30f;
#pragma unroll
        for (int k = 0; k < 16; ++k) {
            const int cid = 63 - (int)(cd[0][k] & 63u); const int ab = CAND_AB[cid];
            const u32 k1 = L1[ab >> 4], k2 = L2[ab & 15];
            sc[k] = ord2f(k1 & ~0x7Fu) + ord2f(k2 & ~0x7Fu);
            ix[k] = (127 - (int)(k1 & 0x7Fu)) * 128 + (127 - (int)(k2 & 0x7Fu));
            mx = fmaxf(mx, sc[k]);
        }
        float sum = 0.f;
#pragma unroll
        for (int k = 0; k < 16; ++k) { sc[k] = __expf(sc[k] - mx); sum += sc[k]; }
        const float inv = 1.0f / sum;
        int* io = IDX + (size_t)(tok0 + tl) * 128 + hd * 16; float* go = GW + (size_t)(tok0 + tl) * 128 + hd * 16;
#pragma unroll
        for (int k = 0; k < 16; k += 4) {
            *(int4*)(io + k) = make_int4(ix[k], ix[k + 1], ix[k + 2], ix[k + 3]);
            f32x4 gv = {sc[k] * inv, sc[k + 1] * inv, sc[k + 2] * inv, sc[k + 3] * inv}; *(f32x4*)(go + k) = gv;
        }
    }
    __syncthreads();
}

__device__ __forceinline__ void unpack16(const u32x4& a, const u32x4& b, float (&f)[16]) {
    f[0] = bflo(a.x); f[1] = bfhi(a.x); f[2] = bflo(a.y); f[3] = bfhi(a.y); f[4] = bflo(a.z); f[5] = bfhi(a.z); f[6] = bflo(a.w); f[7] = bfhi(a.w);
    f[8] = bflo(b.x); f[9] = bfhi(b.x); f[10] = bflo(b.y); f[11] = bfhi(b.y); f[12] = bflo(b.z); f[13] = bfhi(b.z); f[14] = bflo(b.w); f[15] = bfhi(b.w);
}
__device__ __forceinline__ void peer_gather_tile(const Ctx& C, const Params& P, int tok0) {
    const bf16_t* HN = (const bf16_t*)(P.ws + WS_BUFA);
    const bf16_t* PU = (const bf16_t*)(P.ws + WS_PU); const bf16_t* PV = (const bf16_t*)(P.ws + WS_PV);
    const int* IDX = (const int*)(P.ws + WS_IDX); const float* GW = (const float*)(P.ws + WS_GW);
    const int lane = C.lane;
#pragma unroll 1
    for (int i = 0; i < 8; ++i) {
        const int tok = tok0 + C.wave * 8 + i;
        const int ia = IDX[(size_t)tok * 128 + lane], ib = IDX[(size_t)tok * 128 + 64 + lane];
        const float ga = GW[(size_t)tok * 128 + lane], gb = GW[(size_t)tok * 128 + 64 + lane];
        float hf[16];
        { const u32x4 a = *(const u32x4*)(HN + (size_t)tok * DM + 8 * lane), b = *(const u32x4*)(HN + (size_t)tok * DM + 512 + 8 * lane); unpack16(a, b, hf); }
        float zA = 0.f, zB = 0.f;
#pragma unroll 1
        for (int e0 = 0; e0 < 128; e0 += 8) {
            const int isel = (e0 < 64) ? ia : ib;
            float part[8];
#pragma unroll
            for (int k = 0; k < 8; ++k) {
                const int ridx = __builtin_amdgcn_readlane(isel, (e0 + k) & 63);
                const bf16_t* ur = PU + (size_t)ridx * DM;
                const u32x4 a = *(const u32x4*)(ur + 8 * lane), b = *(const u32x4*)(ur + 512 + 8 * lane);
                float uf[16]; unpack16(a, b, uf);
                float s = 0.f;
#pragma unroll
                for (int d = 0; d < 16; ++d) s += hf[d] * uf[d];
                part[k] = s;
            }
#pragma unroll
            for (int k = 0; k < 8; ++k) {
                const float tot = wave_sum(part[k]);
                if (e0 < 64) { if (lane == ((e0 + k) & 63)) zA = tot; } else { if (lane == ((e0 + k) & 63)) zB = tot; }
            }
        }
        const float aA = gelu_erf(zA) * ga, aB = gelu_erf(zB) * gb;
        float acc[16];
#pragma unroll
        for (int d = 0; d < 16; ++d) acc[d] = 0.f;
#pragma unroll 1
        for (int e0 = 0; e0 < 128; e0 += 8) {
            const int isel = (e0 < 64) ? ia : ib; const float asel = (e0 < 64) ? aA : aB;
#pragma unroll
            for (int k = 0; k < 8; ++k) {
                const int ridx = __builtin_amdgcn_readlane(isel, (e0 + k) & 63);
                const float ae = __uint_as_float((u32)__builtin_amdgcn_readlane((int)__float_as_uint(asel), (e0 + k) & 63));
                const bf16_t* vr = PV + (size_t)ridx * DM;
                const u32x4 a = *(const u32x4*)(vr + 8 * lane), b = *(const u32x4*)(vr + 512 + 8 * lane);
                float vf[16]; unpack16(a, b, vf);
#pragma unroll
                for (int d = 0; d < 16; ++d) acc[d] += ae * vf[d];
            }
        }
        float* orow = P.out + (size_t)tok * DM;
#pragma unroll
        for (int part = 0; part < 2; ++part)
#pragma unroll
            for (int q = 0; q < 2; ++q) {
                f32x4* p = (f32x4*)(orow + part * 512 + 8 * lane + 4 * q);
                f32x4 v = *p; v.x += acc[part * 8 + 4 * q]; v.y += acc[part * 8 + 4 * q + 1]; v.z += acc[part * 8 + 4 * q + 2]; v.w += acc[part * 8 + 4 * q + 3]; *p = v;
            }
    }
}

constexpr int NPHASE = 11;
__global__ void __launch_bounds__(NTHR, 2) mk_fwd(Params P) {
    extern __shared__ __attribute__((aligned(16))) unsigned char lds_raw[];
    Ctx C; C.lds = (LAS unsigned char*)lds_raw; C.tid = threadIdx.x; C.lane = C.tid & 63; C.wave = __builtin_amdgcn_readfirstlane(C.tid >> 6); C.G = gridDim.x; C.bid = blockIdx.x;
    unsigned char* ws = P.ws;
#ifdef ONLY_PHASE
#define IN(k) ((k) == ONLY_PHASE && P.ph_lo <= (k) && (k) < P.ph_hi)
#else
#define IN(k) (P.ph_lo <= (k) && (k) < P.ph_hi)
#endif
    if (IN(0)) phase_prologue(C, P);
    if (IN(1)) {
        pg8::Gemm g{(const bf16_t*)(ws + WS_BUFA), (const bf16_t*)(ws + WS_WIN_T), MPAD, INW, DM}; pg8::StaticOrder S; S.init(MPAD, INW, C.G, C.bid);
        pg8::EpiBf16<0> E{(bf16_t*)(ws + WS_PROJ), INW, nullptr, 0, 0, 1.f};
        pg8::gemm_phase<pg8::EpiBf16<0>, pg8::StaticOrder, true, true>(C.lds, g, S, E);
    }
    if (IN(2)) phase_sloc(C, P);
    if (IN(3)) {
        for (int bk = C.bid; bk < 64; bk += C.G) carry_scan_block(C, P, bk);
        for (int u = C.bid; u < 256; u += C.G) attn_unit(C, P, u >> 1, u & 1);
    }
    if (IN(4)) phase_ssm_y(C, P);
    if (IN(5)) {
        pg8::Gemm g{(const bf16_t*)(ws + WS_Z), (const bf16_t*)(ws + WS_GLU_T), SEQ, 512, 512}; pg8::StaticOrder S; S.init(SEQ, 512, C.G, C.bid);
        EpiGlu E{(const bf16_t*)(ws + WS_Z), (bf16_t*)(ws + WS_SSMO), P.in[I_GLUB]};
        pg8::gemm_phase<EpiGlu, pg8::StaticOrder, true, true>(C.lds, g, S, E);
    }
    if (IN(6)) phase_mix_norm(C, P);
    if (IN(7)) {
        pg8::Gemm g{(const bf16_t*)(ws + WS_BUFA), (const bf16_t*)(ws + WS_WOUT_T), SEQ, DM, DM}; pg8::StaticOrder S; S.init(SEQ, DM, C.G, C.bid);
        EpiRes E{P.in[I_X], P.out};
        pg8::gemm_phase<EpiRes, pg8::StaticOrder, true, true>(C.lds, g, S, E);
    }
    if (IN(8)) phase_norm2(C, P);
    if (IN(9)) {
        pg8::Gemm g{(const bf16_t*)(ws + WS_BUFA), (const bf16_t*)(ws + WS_WQ_T), SEQ, 2048, DM}; pg8::StaticOrder S; S.init(SEQ, 2048, C.G, C.bid);
        pg8::EpiBf16<0> E{(bf16_t*)(ws + WS_QP), 2048, nullptr, 0, 0, 1.f};
        pg8::gemm_phase<pg8::EpiBf16<0>, pg8::StaticOrder, true, true>(C.lds, g, S, E);
    }
    if (IN(10)) {
        for (int tile = C.bid; tile < SEQ / 64; tile += C.G) { peer_topk_tile(C, P, tile * 64); peer_gather_tile(C, P, tile * 64); }
    }
#undef IN
}
}

extern "C" void kernel_launch(void* const* d_in, const int* in_sizes, int n_in, void* d_out, int out_size, void* d_ws, size_t ws_size, hipStream_t stream) {
    static int state = 0;
    if (state == 0) {
        if (n_in != 25 || out_size != mk::SEQ * mk::DM || ws_size < mk::WS_END) { fprintf(stderr, "kernel_launch: unexpected shapes (n_in %d out %d ws %zu)\n", n_in, out_size, ws_size); state = -1; return; }
        if (hipFuncSetAttribute((const void*)mk::mk_fwd, hipFuncAttributeMaxDynamicSharedMemorySize, mk::LDS_BYTES) != hipSuccess) { fprintf(stderr, "kernel_launch: hipFuncSetAttribute failed\n"); state = -1; return; }
        state = 1;
    }
    if (state < 0) return;
    mk::Params p{};
    for (int i = 0; i < 25; ++i) p.in[i] = (const float*)d_in[i];
    p.out = (float*)d_out; p.ws = (unsigned char*)d_ws;
    for (int ph = 0; ph < mk::NPHASE; ++ph) {
        p.ph_lo = ph; p.ph_hi = ph + 1;
        hipLaunchKernelGGL(mk::mk_fwd, dim3(256), dim3(mk::NTHR), mk::LDS_BYTES, stream, p);
    }
}
```

```cpp
#include <hip/hip_runtime.h>
#include <cstdio>
#include <cstdint>
#include <cmath>
namespace pg8 {
#define PG8_LAS __attribute__((address_space(3)))
typedef unsigned short bf16_t;
typedef short bf16x8 __attribute__((ext_vector_type(8)));
typedef float f32x4 __attribute__((ext_vector_type(4)));
typedef unsigned u32x4 __attribute__((ext_vector_type(4)));
constexpr int BM = 256, BK = 64, HALF = 128, HTB = HALF * BK * 2  , STAGE_BYTES = 8 * HTB, NXCD = 8, WGM = 8;

__host__ __device__ __forceinline__ int lds_byte(int r, int c) { const int st = (r >> 4) * 2 + (c >> 5), rr = r & 15, cc = c & 31, ob = rr * 64 + cc * 2; return st * 1024 + (ob ^ (((ob >> 9) & 1) << 5)); }
__host__ __device__ __forceinline__ void stage_rc(int b, int& R, int& C) { const int st = b / 1024, sb = b % 1024, swz = sb ^ (((sb >> 9) & 1) << 5); R = (st >> 1) * 16 + swz / 64; C = (st & 1) * 32 + (swz % 64) / 2; }
__host__ __device__ __forceinline__ int perm32(int rho) { const int n = rho >> 4, i = rho & 15; return 8 * (i >> 2) + 4 * n + (i & 3); }

struct Unit { int pm, pn; };
struct Gemm { const bf16_t* A; const bf16_t* Bt; int M, N, K; };

struct StaticOrder {
    int nM, nN, nwg, G, c;
    __host__ __device__ void init(int M, int N, int G_, int c_) { nM = M / BM; nN = N / BM; nwg = nM * nN; G = G_; c = c_; }
    __host__ __device__ bool next(int i, Unit& u) const {
        const long L = (long)i * G + c; if (L >= nwg) return false;
        int wgid = (int)L; { const int q = nwg / NXCD, r = nwg % NXCD, xcd = wgid % NXCD, off = wgid / NXCD; wgid = (xcd < r ? xcd * (q + 1) : r * (q + 1) + (xcd - r) * q) + off; }
        const int nig = WGM * nN, gid = wgid / nig, fm = gid * WGM, gsz = (nM - fm) < WGM ? (nM - fm) : WGM;
        u.pm = fm + ((wgid % nig) % gsz); u.pn = (wgid % nig) / gsz; return true;
    }
    __device__ __forceinline__ void a_ready(const Unit&) const {}
    __device__ __forceinline__ void done(const Unit&) const {}
};

__device__ __forceinline__ unsigned cvt_pk_bf16(float lo, float hi) { unsigned r; asm volatile("v_cvt_pk_bf16_f32 %0, %1, %2" : "=v"(r) : "v"(lo), "v"(hi)); return r; }
typedef float f32x2 __attribute__((ext_vector_type(2)));
__device__ __forceinline__ f32x2 gelu_pk(f32x2 v) {
    const f32x2 av = __builtin_elementwise_abs(v), d = av * 0.2316418882f + 1.0f;
    f32x2 t; t.x = __builtin_amdgcn_rcpf(d.x); t.y = __builtin_amdgcn_rcpf(d.y);
    f32x2 q = t * 0.5307027145f + (-0.7265760135f); q = q * t + 0.7107068705f; q = q * t + (-0.142248368f); q = q * t + 0.127414796f; q = q * t;
    const f32x2 s = (v * v) * (-0.72134752044f);
    f32x2 e; e.x = __builtin_amdgcn_exp2f(s.x); e.y = __builtin_amdgcn_exp2f(s.y);
    const f32x2 m = v * (q * e), r = v - m;
    f32x2 o; o.x = v.x < 0.f ? m.x : r.x; o.y = v.y < 0.f ? m.y : r.y; return o;
}

template <int ACT  > struct EpiBf16 {
    static constexpr bool PERM = true, AFTER_DRAIN = false; static_assert(ACT == 0 || ACT == 1, "EpiBf16: ACT is 0 (none) or 1 (gelu_pk)");
    bf16_t* O; int ldc; const float* bias; int split_cols; size_t split_stride; float scale0;
    __device__ __forceinline__ void operator()(const f32x4 (&acc)[2][2][4][2], const Unit& u, int wr, int wc, int fr, int fq) const {
        const int row0 = u.pm * BM + wr * 64 + fr; int colt = u.pn * BM; bf16_t* base = O;
        float sc = 1.f; if (split_cols) { const int t = colt / split_cols; base += (size_t)t * split_stride; colt -= t * split_cols; if (t == 0) sc = scale0; }
        const int col0 = colt + wc * 32 + 8 * fq, bcol0 = u.pn * BM + wc * 32 + 8 * fq;
        f32x4 bv[2][2];
#pragma unroll
        for (int bj = 0; bj < 2; ++bj)
#pragma unroll
            for (int n = 0; n < 2; ++n) bv[bj][n] = bias ? *(const f32x4*)(bias + bcol0 + bj * HALF + 4 * n) : (f32x4){0.f, 0.f, 0.f, 0.f};
#pragma unroll
        for (int ai = 0; ai < 2; ++ai)
#pragma unroll
            for (int m = 0; m < 4; ++m) { bf16_t* rowp = base + (size_t)(row0 + ai * HALF + m * 16) * ldc + col0;
#pragma unroll
                for (int bj = 0; bj < 2; ++bj) { f32x4 v0 = acc[ai][bj][m][0] + bv[bj][0], v1 = acc[ai][bj][m][1] + bv[bj][1];
                    if (ACT == 1) { f32x2 a = gelu_pk((f32x2){v0[0], v0[1]}), b = gelu_pk((f32x2){v0[2], v0[3]}), c = gelu_pk((f32x2){v1[0], v1[1]}), d = gelu_pk((f32x2){v1[2], v1[3]});
                        v0 = (f32x4){a.x, a.y, b.x, b.y}; v1 = (f32x4){c.x, c.y, d.x, d.y}; }
                    v0 = v0 * sc; v1 = v1 * sc; u32x4 w; w.x = cvt_pk_bf16(v0[0], v0[1]); w.y = cvt_pk_bf16(v0[2], v0[3]); w.z = cvt_pk_bf16(v1[0], v1[1]); w.w = cvt_pk_bf16(v1[2], v1[3]);
                    *(u32x4*)(rowp + bj * HALF) = w; } }
    }
};
template <class Epi, class Sched, bool ALIGN_EPI = false, bool SP2 = false>
__device__ __forceinline__ void gemm_phase(PG8_LAS unsigned char* lds, const Gemm g, const Sched& S, const Epi& E) {
    const int tid = threadIdx.x, wid = __builtin_amdgcn_readfirstlane(tid >> 6), lane = tid & 63, wr = wid >> 2, wc = wid & 3, fr = lane & 15, fq = lane >> 4;
    const int K = g.K, nt = K / BK;
    unsigned voffA[2], voffB[2];
#pragma unroll
    for (int i = 0; i < 2; ++i) { int R, C; stage_rc(tid * 16 + i * 8192, R, C); const int Rb = Epi::PERM ? ((R & ~31) + perm32(R & 31)) : R;
        voffA[i] = (unsigned)(R * K + C) * 2u; voffB[i] = (unsigned)(Rb * K + C) * 2u; }
    const size_t kstep = (size_t)(BK * 2);
    const size_t hstep = (size_t)HALF * K * 2;
    const size_t tstep = 2 * hstep;
    const unsigned ldsw = (unsigned)wid * 1024u;
    const int aoff = lds_byte(wr * 64 + fr, fq * 8), boff = lds_byte(wc * 32 + fr, fq * 8);
#define PG8_SA(b, h) (((b) * 2 + (h)) * HTB)
#define PG8_SB(b, h) ((4 + (b) * 2 + (h)) * HTB)
#define PG8_STAGE(bufoff, gbase, voff) do { _Pragma("unroll") for (int _i = 0; _i < 2; ++_i) \
        __builtin_amdgcn_global_load_lds((const unsigned*)((const char*)(gbase) + (voff)[_i]), (PG8_LAS unsigned*)(lds + (bufoff) + ldsw + _i * 8192), 16, 0, 0); } while (0)
#define PG8_LDA(dst, b, h) do { _Pragma("unroll") for (int m = 0; m < 4; ++m) _Pragma("unroll") for (int k = 0; k < 2; ++k) dst[m][k] = *(const PG8_LAS bf16x8*)(lds + PG8_SA(b, h) + aoff + m * 2048 + k * 1024); } while (0)
#define PG8_LDB(dst, b, h) do { _Pragma("unroll") for (int n = 0; n < 2; ++n) _Pragma("unroll") for (int k = 0; k < 2; ++k) dst[n][k] = *(const PG8_LAS bf16x8*)(lds + PG8_SB(b, h) + boff + n * 2048 + k * 1024); } while (0)
#define PG8_MMA(ai, bj, At, Bt) do { __builtin_amdgcn_s_setprio(1); _Pragma("unroll") for (int m = 0; m < 4; ++m) _Pragma("unroll") for (int n = 0; n < 2; ++n) _Pragma("unroll") for (int k = 0; k < 2; ++k) \
        acc[ai][bj][m][n] = __builtin_amdgcn_mfma_f32_16x16x32_bf16(Bt[n][k], At[m][k], acc[ai][bj][m][n], 0, 0, 0); __builtin_amdgcn_s_setprio(0); } while (0)
#define PG8_WAIT_V(n) asm volatile("s_waitcnt vmcnt(" #n ")" ::: "memory")
#define PG8_WAIT_L(n) asm volatile("s_waitcnt lgkmcnt(" #n ")" ::: "memory")
#define PG8_BAR __builtin_amdgcn_s_barrier()
#define PG8_SCHED __builtin_amdgcn_sched_barrier(0)
    Unit cur, nxt; int ui = 0;
    if (!S.next(0, cur)) return;
    f32x4 acc[2][2][4][2];
#pragma unroll
    for (int a = 0; a < 2; ++a)
#pragma unroll
        for (int b = 0; b < 2; ++b)
#pragma unroll
            for (int m = 0; m < 4; ++m)
#pragma unroll
                for (int n = 0; n < 2; ++n) acc[a][b][m][n] = (f32x4){0.f, 0.f, 0.f, 0.f};
    bf16x8 At[4][2], B0[2][2], B1[2][2];
    const char* cA = (const char*)g.A + (size_t)cur.pm * tstep; const char* cB = (const char*)g.Bt + (size_t)cur.pn * tstep;
    S.a_ready(cur);
    if constexpr (SP2) {
        PG8_STAGE(PG8_SB(0, 0), cB, voffB); PG8_STAGE(PG8_SB(0, 1), cB + hstep, voffB); PG8_STAGE(PG8_SA(0, 0), cA, voffA); PG8_STAGE(PG8_SA(0, 1), cA + hstep, voffA);
        if (wr == 1) PG8_BAR;
        PG8_WAIT_V(2); PG8_BAR;
        PG8_STAGE(PG8_SB(1, 0), cB + kstep, voffB); PG8_STAGE(PG8_SA(1, 0), cA + kstep, voffA); PG8_STAGE(PG8_SB(1, 1), cB + hstep + kstep, voffB);
        PG8_WAIT_V(6); PG8_BAR;
    } else {
        PG8_STAGE(PG8_SB(0, 0), cB, voffB); PG8_STAGE(PG8_SA(0, 0), cA, voffA); PG8_STAGE(PG8_SB(0, 1), cB + hstep, voffB); PG8_STAGE(PG8_SA(0, 1), cA + hstep, voffA);
        if (wr == 1) PG8_BAR;
        PG8_WAIT_V(4); PG8_BAR;
        PG8_STAGE(PG8_SB(1, 0), cB + kstep, voffB); PG8_STAGE(PG8_SA(1, 0), cA + kstep, voffA); PG8_STAGE(PG8_SB(1, 1), cB + hstep + kstep, voffB);
        PG8_WAIT_V(6); PG8_BAR;
    }
    for (;;) {
        const bool has_next = S.next(ui + 1, nxt);
        const char* nA = has_next ? (const char*)g.A + (size_t)nxt.pm * tstep : cA; const char* nB = has_next ? (const char*)g.Bt + (size_t)nxt.pn * tstep : cB;
        for (int t = 0; t < nt; t += 2) {
            const bool last = (t == nt - 2);
            const char* a1 = cA + (size_t)(t + 1) * kstep;
            const char* a2 = last ? nA : cA + (size_t)(t + 2) * kstep; const char* b2 = last ? nB : cB + (size_t)(t + 2) * kstep;
            const char* a3 = a2 + kstep; const char* b3 = b2 + kstep;
            if (last && has_next) S.a_ready(nxt);
            if constexpr (SP2) {
            PG8_LDB(B0, 0, 0); PG8_LDB(B1, 0, 1); PG8_SCHED; PG8_LDA(At, 0, 0); PG8_STAGE(PG8_SA(1, 1), a1 + hstep, voffA);
            PG8_WAIT_V(8); PG8_WAIT_L(0); PG8_BAR; PG8_MMA(0, 0, At, B0); PG8_MMA(0, 1, At, B1); PG8_BAR; PG8_SCHED;
            PG8_LDA(At, 0, 1); PG8_STAGE(PG8_SB(0, 0), b2, voffB); PG8_STAGE(PG8_SB(0, 1), b2 + hstep, voffB); PG8_STAGE(PG8_SA(0, 0), a2, voffA);
            PG8_WAIT_V(8); PG8_WAIT_L(0); PG8_BAR; PG8_MMA(1, 0, At, B0); PG8_MMA(1, 1, At, B1); PG8_BAR; PG8_SCHED;
            PG8_LDB(B0, 1, 0); PG8_LDB(B1, 1, 1); PG8_SCHED; PG8_LDA(At, 1, 0); PG8_STAGE(PG8_SA(0, 1), a2 + hstep, voffA);
            PG8_WAIT_V(8); PG8_WAIT_L(0); PG8_BAR; PG8_MMA(0, 0, At, B0); PG8_MMA(0, 1, At, B1); PG8_BAR; PG8_SCHED;
            PG8_LDA(At, 1, 1); PG8_STAGE(PG8_SB(1, 0), b3, voffB); PG8_STAGE(PG8_SB(1, 1), b3 + hstep, voffB); PG8_STAGE(PG8_SA(1, 0), a3, voffA);
            PG8_WAIT_V(8); PG8_WAIT_L(0); PG8_BAR; PG8_MMA(1, 0, At, B0); PG8_MMA(1, 1, At, B1); PG8_BAR; PG8_SCHED;
            } else {
            PG8_LDB(B0, 0, 0); PG8_SCHED; PG8_LDA(At, 0, 0); PG8_STAGE(PG8_SA(1, 1), a1 + hstep, voffA);
            PG8_WAIT_L(8); PG8_BAR; PG8_WAIT_L(0); PG8_MMA(0, 0, At, B0); PG8_BAR; PG8_SCHED;
            PG8_LDB(B1, 0, 1); PG8_STAGE(PG8_SB(0, 0), b2, voffB);
            PG8_BAR; PG8_WAIT_L(0); PG8_MMA(0, 1, At, B1); PG8_BAR;
            PG8_LDA(At, 0, 1); PG8_STAGE(PG8_SA(0, 0), a2, voffA);
            PG8_BAR; PG8_WAIT_L(0); PG8_MMA(1, 0, At, B0); PG8_BAR; PG8_SCHED;
            PG8_STAGE(PG8_SB(0, 1), b2 + hstep, voffB);
            PG8_WAIT_V(6); PG8_BAR; PG8_MMA(1, 1, At, B1); PG8_BAR;
            PG8_LDB(B0, 1, 0); PG8_SCHED; PG8_LDA(At, 1, 0); PG8_STAGE(PG8_SA(0, 1), a2 + hstep, voffA);
            PG8_WAIT_L(8); PG8_BAR; PG8_WAIT_L(0); PG8_MMA(0, 0, At, B0); PG8_BAR; PG8_SCHED;
            PG8_LDB(B1, 1, 1); PG8_STAGE(PG8_SB(1, 0), b3, voffB);
            PG8_BAR; PG8_WAIT_L(0); PG8_MMA(0, 1, At, B1); PG8_BAR;
            PG8_LDA(At, 1, 1); PG8_STAGE(PG8_SA(1, 0), a3, voffA);
            PG8_BAR; PG8_WAIT_L(0); PG8_MMA(1, 0, At, B0); PG8_BAR; PG8_SCHED;
            PG8_STAGE(PG8_SB(1, 1), b3 + hstep, voffB);
            PG8_WAIT_V(6); PG8_BAR; PG8_MMA(1, 1, At, B1); PG8_BAR;
            }
        }
        if constexpr (ALIGN_EPI) { if (wr == 0) PG8_BAR; }
        if constexpr (!Epi::AFTER_DRAIN) { E(acc, cur, wr, wc, fr, fq); S.done(cur); }
        if (!has_next) break;
#pragma unroll
        for (int a = 0; a < 2; ++a)
#pragma unroll
            for (int b = 0; b < 2; ++b)
#pragma unroll
                for (int m = 0; m < 4; ++m)
#pragma unroll
                    for (int n = 0; n < 2; ++n) acc[a][b][m][n] = (f32x4){0.f, 0.f, 0.f, 0.f};
        cur = nxt; cA = nA; cB = nB; ++ui;
        if constexpr (ALIGN_EPI) { if (wr == 1) PG8_BAR; }
    }
    PG8_WAIT_V(0);
    if constexpr (!ALIGN_EPI) { if (wr == 0) PG8_BAR; }
    PG8_BAR;
    if constexpr (Epi::AFTER_DRAIN) { E.fused(acc, cur, wr, wc, fr, fq, lds, wid, lane); S.done(cur); }
#undef PG8_SA
#undef PG8_SB
#undef PG8_STAGE
#undef PG8_LDA
#undef PG8_LDB
#undef PG8_MMA
#undef PG8_WAIT_V
#undef PG8_WAIT_L
#undef PG8_BAR
#undef PG8_SCHED
}
}

namespace mk {
#define LAS __attribute__((address_space(3)))
typedef unsigned short bf16_t;
typedef short bf16x8 __attribute__((ext_vector_type(8)));
typedef float f32x4 __attribute__((ext_vector_type(4)));
typedef float f32x16 __attribute__((ext_vector_type(16)));
typedef unsigned u32x4 __attribute__((ext_vector_type(4)));
typedef unsigned u32x2 __attribute__((ext_vector_type(2)));
typedef __bf16 bf16x2_t __attribute__((ext_vector_type(2)));
typedef float f32x2_t __attribute__((ext_vector_type(2)));
typedef unsigned u32;

constexpr int DM = 1024, SEQ = 16384, NMETA = 16, MPAD = 16640, INW = 1280;
constexpr int O_K = 512, O_V = 640, O_U = 768;
constexpr int NCH = 513;
constexpr float EPS = 1e-6f;
constexpr float LOG2E = 1.4426950408889634f;
constexpr int NWAVES = 8, NTHR = 512;
constexpr int LDS_BYTES = 147456;

constexpr size_t MiB = 1u << 20;
constexpr size_t WS_CTL = 0, CTL_BYTES = 1 * MiB;
constexpr size_t WS_WIN_T = 1 * MiB;
constexpr size_t WS_WOUT_T = 4 * MiB;
constexpr size_t WS_WQ_T = 6 * MiB;
constexpr size_t WS_GLU_T = 10 * MiB;
constexpr size_t WS_SUBK = 10 * MiB + 512 * 1024;
constexpr size_t WS_KT = 11 * MiB;
constexpr size_t WS_F = 12 * MiB;
constexpr size_t WS_E = 16 * MiB;
constexpr size_t WS_ABART = 20 * MiB;
constexpr size_t WS_SLOC = 21 * MiB;
constexpr size_t WS_CARRY = 30 * MiB;
constexpr size_t WS_BUFA = 39 * MiB;
constexpr size_t WS_PROJ = 72 * MiB;
constexpr size_t WS_ATTN = 113 * MiB;
constexpr size_t WS_Z = 129 * MiB;
constexpr size_t WS_SSMO = 145 * MiB;
constexpr size_t WS_QP = 72 * MiB;
constexpr size_t WS_IDX = 161 * MiB;
constexpr size_t WS_GW = 169 * MiB;
constexpr size_t WS_PU = 177 * MiB;
constexpr size_t WS_PV = 209 * MiB;
constexpr size_t WS_END = 241 * MiB;

struct Params { const float* in[25]; float* out; unsigned char* ws; int ph_lo, ph_hi; };
enum { I_X = 0, I_META, I_N1G, I_WIN, I_QNG, I_KNG, I_SINK, I_ARE, I_AIM, I_LDT, I_BRE, I_BIM, I_CRE, I_CIM, I_SD, I_GLUW, I_GLUB, I_AOG, I_SOG, I_WOUT, I_N2G, I_WQ, I_SUBK, I_PU, I_PV };

__device__ __forceinline__ unsigned pk2(float lo, float hi) { f32x2_t v = {lo, hi}; return __builtin_bit_cast(unsigned, __builtin_convertvector(v, bf16x2_t)); }
__device__ __forceinline__ float bflo(unsigned w) { return __uint_as_float(w << 16); }
__device__ __forceinline__ float bfhi(unsigned w) { return __uint_as_float(w & 0xffff0000u); }
__device__ __forceinline__ float wave_sum(float v) {
#pragma unroll
    for (int o = 1; o < 64; o <<= 1) v += __shfl_xor(v, o);
    return v;
}
#define LDS_WAIT() asm volatile("s_waitcnt lgkmcnt(0)" ::: "memory")
__device__ __forceinline__ float gelu_erf(float v) { return 0.5f * v * (1.0f + erff(v * 0.70710678118654752f)); }
__device__ __forceinline__ u32 f2ord(float f) { const u32 u = __float_as_uint(f); return (u & 0x80000000u) ? ~u : (u | 0x80000000u); }
__device__ __forceinline__ float ord2f(u32 o) { const u32 u = (o & 0x80000000u) ? (o & 0x7fffffffu) : ~o; return __uint_as_float(u); }
#define MFMA16(a, b, c) __builtin_amdgcn_mfma_f32_16x16x32_bf16((a), (b), (c), 0, 0, 0)
#define MFMA32(a, b, c) __builtin_amdgcn_mfma_f32_32x32x16_bf16((a), (b), (c), 0, 0, 0)

#define CEX(x, i, j) do { const u32 _a = x[i], _b = x[j]; x[i] = _a > _b ? _a : _b; x[j] = _a > _b ? _b : _a; } while (0)
__device__ __forceinline__ void sort16_desc(u32 (&x)[16]) {
#pragma unroll
    for (int k = 2; k <= 16; k <<= 1) {
#pragma unroll
        for (int j = k >> 1; j > 0; j >>= 1) {
#pragma unroll
            for (int i = 0; i < 16; ++i) { const int l = i ^ j; if (l > i) { if ((i & k) == 0) CEX(x, i, l); else CEX(x, l, i); } }
        }
    }
}
__device__ __forceinline__ void bmerge16_desc(u32 (&x)[16]) {
#pragma unroll
    for (int j = 8; j > 0; j >>= 1) {
#pragma unroll
        for (int i = 0; i < 16; ++i) { const int l = i ^ j; if (l > i) CEX(x, i, l); }
    }
}
__device__ __forceinline__ void merge_top16(u32 (&a)[16], const u32 (&b)[16]) {
#pragma unroll
    for (int i = 0; i < 16; ++i) a[i] = a[i] > b[15 - i] ? a[i] : b[15 - i];
    bmerge16_desc(a);
}
__device__ __forceinline__ void top16_of_64(u32 (&g0)[16], u32 (&g1)[16], u32 (&g2)[16], u32 (&g3)[16]) {
    sort16_desc(g0); sort16_desc(g1); sort16_desc(g2); sort16_desc(g3);
    merge_top16(g0, g1); merge_top16(g2, g3); merge_top16(g0, g2);
}
__device__ const unsigned char CAND_AB[64] = {0, 1, 2, 3, 4, 5, 6, 7, 8, 9, 10, 11, 12, 13, 14, 15, 16, 17, 18, 19, 20, 21, 22, 23, 32, 33, 34, 35, 36, 48, 49, 50, 51, 64, 65, 66, 80, 81, 96, 97, 112, 113, 128, 144, 160, 176, 192, 208, 224, 240, 0, 0, 0, 0, 0, 0, 0, 0, 0, 0, 0, 0, 0, 0};

struct Ctx { LAS unsigned char* lds; int tid, lane, wave, G, bid; };

__device__ __forceinline__ void transpose_item(const float* W, int K, int N, bf16_t* WT, LAS float* scr, int item, int lane) {
    const int nblk = N / 32, kb = item / nblk, nb = item % nblk, k0 = 64 * kb, n0 = 32 * nb;
#pragma unroll 8
    for (int i = 0; i < 32; ++i) { const int kk = 2 * i + (lane >> 5); scr[kk * 33 + (lane & 31)] = W[(size_t)(k0 + kk) * N + n0 + (lane & 31)]; }
    LDS_WAIT();
    const int c = lane & 7;
#pragma unroll
    for (int j = 0; j < 4; ++j) { const int n = (lane >> 3) + 8 * j; const LAS float* s = scr + (8 * c) * 33 + n;
        u32x4 o; o.x = pk2(s[0 * 33], s[1 * 33]); o.y = pk2(s[2 * 33], s[3 * 33]); o.z = pk2(s[4 * 33], s[5 * 33]); o.w = pk2(s[6 * 33], s[7 * 33]);
        *(u32x4*)(WT + (size_t)(n0 + n) * K + k0 + 8 * c) = o; }
    LDS_WAIT();
}

__device__ __forceinline__ void ssm_tables(const Ctx& C, const Params& P, int g) {
    LAS float* pwr = (LAS float*)C.lds;
    LAS float* pwi = pwr + 33 * 64;
    LAS float* bbr = pwi + 33 * 64;
    LAS float* bbi = bbr + 1024;
    LAS float* ccr = bbi + 1024;
    LAS float* cci = ccr + 1024;
    LAS float* cfr = cci + 1024;
    LAS float* cfi = cfr + 64;
    const int tid = C.tid;
    if (tid < 64) {
        const int n = tid;
        const float dt = expf(P.in[I_LDT][g]), lr = P.in[I_ARE][g * 64 + n], li = P.in[I_AIM][g * 64 + n];
        for (int l = 0; l <= 32; ++l) {
            const float x = lr * dt * (float)l, th = li * dt * (float)l, mag = expf(x);
            float s, c; sincosf(th, &s, &c);
            pwr[l * 64 + n] = mag * c; pwi[l * 64 + n] = mag * s;
        }
        const float x1 = lr * dt, th1 = li * dt, em1 = expm1f(x1);
        float s1, c1; sincosf(th1, &s1, &c1);
        const float sh = sinf(0.5f * th1);
        const float nr = em1 * c1 - 2.0f * sh * sh, ni = (em1 + 1.0f) * s1;
        const float den = lr * lr + li * li;
        cfr[n] = (nr * lr + ni * li) / den; cfi[n] = (ni * lr - nr * li) / den;
        float* abt = (float*)(P.ws + WS_ABART) + (g * 64 + n) * 2;
        abt[0] = pwr[32 * 64 + n]; abt[1] = pwi[32 * 64 + n];
    }
    __syncthreads();
    for (int e = tid; e < 1024; e += NTHR) {
        const int n = e >> 4;
        const float br = P.in[I_BRE][g * 1024 + e], bi = P.in[I_BIM][g * 1024 + e];
        bbr[e] = cfr[n] * br - cfi[n] * bi; bbi[e] = cfr[n] * bi + cfi[n] * br;
        ccr[e] = P.in[I_CRE][g * 1024 + e]; cci[e] = P.in[I_CIM][g * 1024 + e];
    }
    __syncthreads();
    bf16_t* Kt = (bf16_t*)(P.ws + WS_KT) + (size_t)g * 8448;
    for (int e = tid; e < 8448; e += NTHR) {
        const int li = e >> 8, p = (e >> 4) & 15, q = e & 15;
        float val = 0.f;
        if (li >= 1) {
            const int lag = li - 1;
            for (int n = 0; n < 64; ++n) {
                const float ar = pwr[lag * 64 + n], ai = pwi[lag * 64 + n], br = bbr[n * 16 + q], bi = bbi[n * 16 + q];
                const float wr = ar * br - ai * bi, wi = ar * bi + ai * br;
                val += ccr[p * 64 + n] * wr - cci[p * 64 + n] * wi;
            }
        }
        Kt[e] = (bf16_t)(pk2(val, 0.f) & 0xffffu);
    }
    bf16_t* F = (bf16_t*)(P.ws + WS_F) + (size_t)g * 65536;
    for (int e = tid; e < 65536; e += NTHR) {
        const int n2 = e >> 9, k = e & 511, j = k >> 4, q = k & 15, n = n2 & 63, l = 31 - j;
        const float ar = pwr[l * 64 + n], ai = pwi[l * 64 + n], br = bbr[n * 16 + q], bi = bbi[n * 16 + q];
        const float wr = ar * br - ai * bi, wi = ar * bi + ai * br;
        F[e] = (bf16_t)(pk2(n2 < 64 ? wr : wi, 0.f) & 0xffffu);
    }
    bf16_t* E = (bf16_t*)(P.ws + WS_E) + (size_t)g * 65536;
    for (int e = tid; e < 65536; e += NTHR) {
        const int row = e >> 7, n2 = e & 127, t = row >> 4, p = row & 15, n = n2 & 63;
        const float pr = pwr[(t + 1) * 64 + n], pi = pwi[(t + 1) * 64 + n], cr = ccr[p * 64 + n], ci = cci[p * 64 + n];
        const float cpr = cr * pr - ci * pi, cpi = cr * pi + ci * pr;
        E[e] = (bf16_t)(pk2(n2 < 64 ? cpr : -cpi, 0.f) & 0xffffu);
    }
    __syncthreads();
}

__device__ __forceinline__ void norm_row_to_bf16(const float* src, const float* gam, bf16_t* dst, int lane) {
    const f32x4* xr = (const f32x4*)src + lane; const f32x4* gr = (const f32x4*)gam + lane;
    f32x4 v[4]; float s = 0.f;
#pragma unroll
    for (int j = 0; j < 4; ++j) { v[j] = xr[64 * j]; s += (v[j].x * v[j].x + v[j].y * v[j].y) + (v[j].z * v[j].z + v[j].w * v[j].w); }
    const float rinv = 1.0f / sqrtf(wave_sum(s) * (1.0f / DM) + EPS);
    u32x2* o = (u32x2*)dst + lane;
#pragma unroll
    for (int j = 0; j < 4; ++j) { const f32x4 g = gr[64 * j]; u32x2 w; w.x = pk2(v[j].x * rinv * g.x, v[j].y * rinv * g.y); w.y = pk2(v[j].z * rinv * g.z, v[j].w * rinv * g.w); o[64 * j] = w; }
}

__device__ __forceinline__ void cvt8(const float* src, bf16_t* dst, size_t i) {
    const f32x4 a = ((const f32x4*)src)[2 * i], b = ((const f32x4*)src)[2 * i + 1];
    u32x4 o; o.x = pk2(a.x, a.y); o.y = pk2(a.z, a.w); o.z = pk2(b.x, b.y); o.w = pk2(b.z, b.w);
    ((u32x4*)dst)[i] = o;
}

__device__ __forceinline__ void phase_prologue(const Ctx& C, const Params& P) {
    for (int g = C.bid; g < 32; g += C.G) ssm_tables(C, P, g);
    __syncthreads();
    LAS float* scr = (LAS float*)(C.lds + C.wave * 16384);
    const int gw = C.bid * NWAVES + C.wave, NGW = C.G * NWAVES;
    constexpr int I_IN = 16 * 40, I_OUT = 16 * 32, I_Q = 16 * 64, I_GLU = 8 * 16, NITEMS = I_IN + I_OUT + I_Q + I_GLU;
    for (int it = gw; it < NITEMS; it += NGW) {
        int r = it;
        if (r < I_IN) { transpose_item(P.in[I_WIN], 1024, 1280, (bf16_t*)(P.ws + WS_WIN_T), scr, r, C.lane); continue; } r -= I_IN;
        if (r < I_OUT) { transpose_item(P.in[I_WOUT], 1024, 1024, (bf16_t*)(P.ws + WS_WOUT_T), scr, r, C.lane); continue; } r -= I_OUT;
        if (r < I_Q) { transpose_item(P.in[I_WQ], 1024, 2048, (bf16_t*)(P.ws + WS_WQ_T), scr, r, C.lane); continue; } r -= I_Q;
        transpose_item(P.in[I_GLUW], 512, 512, (bf16_t*)(P.ws + WS_GLU_T), scr, r, C.lane);
    }
    bf16_t* xn = (bf16_t*)(P.ws + WS_BUFA);
    for (int m = gw; m < MPAD; m += NGW) {
        if (m < SEQ) norm_row_to_bf16(P.in[I_X] + (size_t)m * DM, P.in[I_N1G], xn + (size_t)m * DM, C.lane);
        else if (m < SEQ + NMETA) norm_row_to_bf16(P.in[I_META] + (size_t)(m - SEQ) * DM, P.in[I_N1G], xn + (size_t)m * DM, C.lane);
        else { u32x4 z = {0u, 0u, 0u, 0u}; u32x4* o = (u32x4*)(xn + (size_t)m * DM); o[C.lane] = z; o[64 + C.lane] = z; }
    }
    const size_t gt = (size_t)C.bid * NTHR + C.tid, NT = (size_t)C.G * NTHR;
    constexpr size_t NTAB = (size_t)16384 * 1024 / 8;
    for (size_t i = gt; i < NTAB; i += NT) cvt8(P.in[I_PU], (bf16_t*)(P.ws + WS_PU), i);
    for (size_t i = gt; i < NTAB; i += NT) cvt8(P.in[I_PV], (bf16_t*)(P.ws + WS_PV), i);
    for (size_t i = gt; i < 262144 / 8; i += NT) cvt8(P.in[I_SUBK], (bf16_t*)(P.ws + WS_SUBK), i);
}

__device__ __forceinline__ bf16x8 u_frag(const bf16_t* proj, int ci, int j, int g, int half) {
    int row = 0; bool ok = true;
    if (ci == 0) { ok = (j >= 16); row = SEQ + j - 16; } else if (ci < NCH) row = (ci - 1) * 32 + j; else ok = false;
    bf16x8 z = {0, 0, 0, 0, 0, 0, 0, 0};
    if (!ok) return z;
    return *(const bf16x8*)(proj + (size_t)row * INW + O_U + g * 16 + half * 8);
}

__device__ __forceinline__ void phase_sloc(const Ctx& C, const Params& P) {
    const bf16_t* proj = (const bf16_t*)(P.ws + WS_PROJ);
    const bf16_t* Fall = (const bf16_t*)(P.ws + WS_F);
    float* SL = (float*)(P.ws + WS_SLOC);
    const int gw = C.bid * NWAVES + C.wave, NGW = C.G * NWAVES;
    const int n = C.lane & 15, kq = C.lane >> 4;
    for (int unit = gw; unit < 32 * 33; unit += NGW) {
        const int g = unit / 33, s = unit % 33, ci = 16 * s + n;
        bf16x8 Bf[16];
#pragma unroll
        for (int ks = 0; ks < 16; ++ks) Bf[ks] = u_frag(proj, ci, 2 * ks + (kq >> 1), g, kq & 1);
        const bf16_t* Fg = Fall + (size_t)g * 65536;
#pragma unroll 1
        for (int mt = 0; mt < 8; ++mt) {
            f32x4 acc = {0.f, 0.f, 0.f, 0.f};
#pragma unroll
            for (int ks = 0; ks < 16; ++ks) {
                const bf16x8 A = *(const bf16x8*)(Fg + (size_t)(mt * 16 + n) * 512 + 32 * ks + 8 * kq);
                acc = MFMA16(A, Bf[ks], acc);
            }
            if (ci < NCH) *(f32x4*)(SL + ((size_t)ci * 32 + g) * 128 + mt * 16 + 4 * kq) = acc;
        }
    }
}

__device__ __forceinline__ void carry_scan_block(const Ctx& C, const Params& P, int bk) {
    const float* SL = (const float*)(P.ws + WS_SLOC);
    float* CA = (float*)(P.ws + WS_CARRY);
    LAS float* Lr = (LAS float*)C.lds;
    LAS float* Li = Lr + 512;
    const int chan = bk * 32 + (C.tid & 31), g = chan >> 6, n = chan & 63, sg = C.tid >> 5;
    const float* abt = (const float*)(P.ws + WS_ABART) + (g * 64 + n) * 2;
    const float ar = abt[0], ai = abt[1];
    float sr = 0.f, si = 0.f;
#pragma unroll 8
    for (int i = 0; i < 32; ++i) {
        const int ci = 32 * sg + i; const size_t o = ((size_t)ci * 32 + g) * 128 + n;
        const float br = SL[o], bi = SL[o + 64];
        const float tr = ar * sr - ai * si + br, ti = ar * si + ai * sr + bi; sr = tr; si = ti;
    }
    Lr[sg * 32 + (C.tid & 31)] = sr; Li[sg * 32 + (C.tid & 31)] = si;
    float pr = ar, pi = ai;
#pragma unroll
    for (int k = 0; k < 5; ++k) { const float tr = pr * pr - pi * pi, ti = 2.f * pr * pi; pr = tr; pi = ti; }
    __syncthreads();
    float cr = 0.f, ci_ = 0.f;
    for (int s2 = 0; s2 < sg; ++s2) { const float lr = Lr[s2 * 32 + (C.tid & 31)], li = Li[s2 * 32 + (C.tid & 31)];
        const float tr = pr * cr - pi * ci_ + lr, ti = pr * ci_ + pi * cr + li; cr = tr; ci_ = ti; }
    sr = cr; si = ci_;
#pragma unroll 8
    for (int i = 0; i < 32; ++i) {
        const int ci = 32 * sg + i; const size_t o = ((size_t)ci * 32 + g) * 128 + n;
        CA[o] = sr; CA[o + 64] = si;
        const float br = SL[o], bi = SL[o + 64];
        const float tr = ar * sr - ai * si + br, ti = ar * si + ai * sr + bi; sr = tr; si = ti;
    }
    if (sg == 15) { const size_t o = ((size_t)512 * 32 + g) * 128 + n; CA[o] = sr; CA[o + 64] = si; }
    __syncthreads();
}

__device__ __forceinline__ void phase_ssm_y(const Ctx& C, const Params& P) {
    const bf16_t* proj = (const bf16_t*)(P.ws + WS_PROJ);
    const float* CA = (const float*)(P.ws + WS_CARRY);
    bf16_t* Z = (bf16_t*)(P.ws + WS_Z);
    const int n = C.lane & 15, kq = C.lane >> 4;
    for (int bu = C.bid; bu < 256; bu += C.G) {
        const int g = bu >> 3, cq = bu & 7;
        __syncthreads();
        { const u32x4* src = (const u32x4*)((const bf16_t*)(P.ws + WS_KT) + (size_t)g * 8448); LAS u32x4* dst = (LAS u32x4*)C.lds;
          for (int e = C.tid; e < 1056; e += NTHR) dst[e] = src[e]; }
        __syncthreads();
        const int ci = 1 + 64 * cq + 16 * (C.wave >> 1) + n, par = C.wave & 1;
        bf16x8 Uf[16], Cf[4];
#pragma unroll
        for (int ks = 0; ks < 16; ++ks) Uf[ks] = u_frag(proj, ci, 2 * ks + (kq >> 1), g, kq & 1);
#pragma unroll
        for (int k2 = 0; k2 < 4; ++k2) {
            const float* cp = CA + ((size_t)ci * 32 + g) * 128 + 32 * k2 + 8 * kq;
            const f32x4 a = *(const f32x4*)cp, b = *(const f32x4*)(cp + 4);
            u32x4 w; w.x = pk2(a.x, a.y); w.y = pk2(a.z, a.w); w.z = pk2(b.x, b.y); w.w = pk2(b.z, b.w);
            Cf[k2] = __builtin_bit_cast(bf16x8, w);
        }
        const bf16_t* Eg = (const bf16_t*)(P.ws + WS_E) + (size_t)g * 65536;
        const f32x4 dv = *(const f32x4*)(P.in[I_SD] + g * 16 + 4 * kq);
#pragma unroll 1
        for (int tt = 0; tt < 16; ++tt) {
            const int t = 2 * tt + par;
            f32x4 acc = {0.f, 0.f, 0.f, 0.f};
#pragma unroll
            for (int k2 = 0; k2 < 4; ++k2) {
                const bf16x8 A = *(const bf16x8*)(Eg + (size_t)(t * 16 + n) * 128 + 32 * k2 + 8 * kq);
                acc = MFMA16(A, Cf[k2], acc);
            }
#pragma unroll
            for (int ks = 0; ks < 16; ++ks) {
                if (ks <= tt) {
                    const int li = t - 2 * ks - (kq >> 1) + 1;
                    const bf16x8 A = *(const LAS bf16x8*)(C.lds + ((li * 16 + n) * 16 + 8 * (kq & 1)) * 2);
                    acc = MFMA16(A, Uf[ks], acc);
                }
            }
            const int row = (ci - 1) * 32 + t, ch = g * 16 + 4 * kq;
            const u32x2 uw = *(const u32x2*)(proj + (size_t)row * INW + O_U + ch);
            const float y0 = acc.x + dv.x * bflo(uw.x), y1 = acc.y + dv.y * bfhi(uw.x), y2 = acc.z + dv.z * bflo(uw.y), y3 = acc.w + dv.w * bfhi(uw.y);
            u32x2 o; o.x = pk2(gelu_erf(y0), gelu_erf(y1)); o.y = pk2(gelu_erf(y2), gelu_erf(y3));
            *(u32x2*)(Z + (size_t)row * 512 + ch) = o;
        }
    }
}

constexpr int VT_PITCH = 296;
__device__ __forceinline__ void attn_unit(const Ctx& C, const Params& P, int b, int hk) {
    const bf16_t* proj = (const bf16_t*)(P.ws + WS_PROJ);
    bf16_t* AO = (bf16_t*)(P.ws + WS_ATTN);
    LAS unsigned char* Ks = C.lds;
    LAS bf16_t* Vt = (LAS bf16_t*)(C.lds + 288 * 128);
    __syncthreads();
    for (int e = C.tid; e < 288 * 8; e += NTHR) {
        const int key = e >> 3, ch = e & 7;
        int row = -1;
        if (key < 256) { const int j = (b - 1) * 128 + key; if (j >= 0) row = j; } else if (key < 272) row = SEQ + key - 256;
        u32x4 kw = {0u, 0u, 0u, 0u}, vw = {0u, 0u, 0u, 0u};
        if (row >= 0) { kw = *(const u32x4*)(proj + (size_t)row * INW + O_K + hk * 64 + ch * 8); vw = *(const u32x4*)(proj + (size_t)row * INW + O_V + hk * 64 + ch * 8); }
        float kf[8] = {bflo(kw.x), bfhi(kw.x), bflo(kw.y), bfhi(kw.y), bflo(kw.z), bfhi(kw.z), bflo(kw.w), bfhi(kw.w)};
        float ss = 0.f;
#pragma unroll
        for (int i = 0; i < 8; ++i) ss += kf[i] * kf[i];
        ss += __shfl_xor(ss, 1); ss += __shfl_xor(ss, 2); ss += __shfl_xor(ss, 4);
        const float rinv = 1.0f / sqrtf(ss * (1.0f / 64.0f) + EPS);
        const f32x4 g0 = *(const f32x4*)(P.in[I_KNG] + ch * 8), g1 = *(const f32x4*)(P.in[I_KNG] + ch * 8 + 4);
        u32x4 o; o.x = pk2(kf[0] * rinv * g0.x, kf[1] * rinv * g0.y); o.y = pk2(kf[2] * rinv * g0.z, kf[3] * rinv * g0.w);
        o.z = pk2(kf[4] * rinv * g1.x, kf[5] * rinv * g1.y); o.w = pk2(kf[6] * rinv * g1.z, kf[7] * rinv * g1.w);
        *(LAS u32x4*)(Ks + key * 128 + ((ch ^ (key & 7)) * 16)) = o;
        const unsigned vv[4] = {vw.x, vw.y, vw.z, vw.w};
#pragma unroll
        for (int i = 0; i < 4; ++i) { Vt[(ch * 8 + 2 * i) * VT_PITCH + key] = (bf16_t)(vv[i] & 0xffffu); Vt[(ch * 8 + 2 * i + 1) * VT_PITCH + key] = (bf16_t)(vv[i] >> 16); }
    }
    __syncthreads();
    const int c = C.lane & 31, h = C.lane >> 5;
#pragma unroll 1
    for (int ti = C.wave; ti < 16; ti += NWAVES) {
        const int hql = ti >> 2, wq = ti & 3, hq = hk * 4 + hql;
        const int qi = wq * 32 + c, tok = b * 128 + qi;
        bf16x8 qf[4];
        {
            u32x4 qw[4]; float ss = 0.f;
#pragma unroll
            for (int ks = 0; ks < 4; ++ks) { qw[ks] = *(const u32x4*)(proj + (size_t)tok * INW + hq * 64 + 16 * ks + 8 * h);
                const unsigned w[4] = {qw[ks].x, qw[ks].y, qw[ks].z, qw[ks].w};
#pragma unroll
                for (int i = 0; i < 4; ++i) { const float a = bflo(w[i]), bb = bfhi(w[i]); ss += a * a + bb * bb; } }
            ss += __shfl_xor(ss, 32);
            const float rinv = (1.0f / sqrtf(ss * (1.0f / 64.0f) + EPS)) * (0.125f * LOG2E);
#pragma unroll
            for (int ks = 0; ks < 4; ++ks) {
                const f32x4 g0 = *(const f32x4*)(P.in[I_QNG] + 16 * ks + 8 * h), g1 = *(const f32x4*)(P.in[I_QNG] + 16 * ks + 8 * h + 4);
                u32x4 o; o.x = pk2(bflo(qw[ks].x) * rinv * g0.x, bfhi(qw[ks].x) * rinv * g0.y); o.y = pk2(bflo(qw[ks].y) * rinv * g0.z, bfhi(qw[ks].y) * rinv * g0.w);
                o.z = pk2(bflo(qw[ks].z) * rinv * g1.x, bfhi(qw[ks].z) * rinv * g1.y); o.w = pk2(bflo(qw[ks].w) * rinv * g1.z, bfhi(qw[ks].w) * rinv * g1.w);
                qf[ks] = __builtin_bit_cast(bf16x8, o);
            }
        }
        f32x16 S[6];
#pragma unroll
        for (int rb = 0; rb < 6; ++rb) {
            const int kb = (rb < 5) ? (wq + rb) : 8;
            const int key = kb * 32 + c;
            f32x16 acc = {0.f, 0.f, 0.f, 0.f, 0.f, 0.f, 0.f, 0.f, 0.f, 0.f, 0.f, 0.f, 0.f, 0.f, 0.f, 0.f};
#pragma unroll
            for (int ks = 0; ks < 4; ++ks) {
                const bf16x8 A = *(const LAS bf16x8*)(Ks + key * 128 + (((2 * ks + h) ^ (key & 7)) * 16));
                acc = MFMA32(A, qf[ks], acc);
            }
            S[rb] = acc;
            __builtin_amdgcn_sched_barrier(0);
        }
        const float sl = P.in[I_SINK][hq] * LOG2E;
        float mx = sl;
#pragma unroll
        for (int r = 0; r < 16; ++r) {
            const int kr = (r & 3) + 8 * (r >> 2) + 4 * h;
            const bool gt = kr > c;
            S[0][r] = gt ? S[0][r] : -1e30f;
            S[4][r] = gt ? -1e30f : S[4][r];
            if (r >= 8) S[5][r] = -1e30f;
        }
        if (b == 0) {
#pragma unroll
            for (int rb = 0; rb < 4; ++rb) if (wq + rb < 4) {
#pragma unroll
                for (int r = 0; r < 16; ++r) S[rb][r] = -1e30f;
            }
        }
#pragma unroll
        for (int rb = 0; rb < 6; ++rb)
#pragma unroll
            for (int r = 0; r < 16; ++r) mx = fmaxf(mx, S[rb][r]);
        mx = fmaxf(mx, __shfl_xor(mx, 32));
        float lsum = 0.f;
#pragma unroll
        for (int rb = 0; rb < 6; ++rb)
#pragma unroll
            for (int r = 0; r < 16; ++r) { const float p = exp2f(S[rb][r] - mx); S[rb][r] = p; lsum += p; }
        lsum += __shfl_xor(lsum, 32);
        lsum += exp2f(sl - mx);
        const float linv = 1.0f / lsum;
        f32x16 O[2];
#pragma unroll
        for (int db = 0; db < 2; ++db) O[db] = (f32x16){0.f, 0.f, 0.f, 0.f, 0.f, 0.f, 0.f, 0.f, 0.f, 0.f, 0.f, 0.f, 0.f, 0.f, 0.f, 0.f};
#pragma unroll
        for (int rb = 0; rb < 6; ++rb) {
            const int kb = (rb < 5) ? (wq + rb) : 8;
#pragma unroll
            for (int s = 0; s < 2; ++s) {
                if (rb == 5 && s == 1) continue;
                u32x4 pw; pw.x = pk2(S[rb][8 * s + 0], S[rb][8 * s + 1]); pw.y = pk2(S[rb][8 * s + 2], S[rb][8 * s + 3]);
                pw.z = pk2(S[rb][8 * s + 4], S[rb][8 * s + 5]); pw.w = pk2(S[rb][8 * s + 6], S[rb][8 * s + 7]);
                const bf16x8 Pf = __builtin_bit_cast(bf16x8, pw);
#pragma unroll
                for (int db = 0; db < 2; ++db) {
                    const LAS bf16_t* vp = Vt + (db * 32 + c) * VT_PITCH + kb * 32 + 16 * s + 4 * h;
                    const u32x2 lo = *(const LAS u32x2*)vp, hi2 = *(const LAS u32x2*)(vp + 8);
                    u32x4 vw; vw.x = lo.x; vw.y = lo.y; vw.z = hi2.x; vw.w = hi2.y;
                    O[db] = MFMA32(__builtin_bit_cast(bf16x8, vw), Pf, O[db]);
                }
                __builtin_amdgcn_sched_barrier(0);
            }
        }
#pragma unroll
        for (int db = 0; db < 2; ++db)
#pragma unroll
            for (int gq = 0; gq < 4; ++gq) {
                u32x2 o; o.x = pk2(O[db][4 * gq] * linv, O[db][4 * gq + 1] * linv); o.y = pk2(O[db][4 * gq + 2] * linv, O[db][4 * gq + 3] * linv);
                *(u32x2*)(AO + (size_t)tok * 512 + hq * 64 + db * 32 + 8 * gq + 4 * h) = o;
            }
    }
}

struct EpiGlu {
    static constexpr bool PERM = true, AFTER_DRAIN = false;
    const bf16_t* Z; bf16_t* O; const float* bias;
    __device__ __forceinline__ void operator()(const pg8::f32x4 (&acc)[2][2][4][2], const pg8::Unit& u, int wr, int wc, int fr, int fq) const {
        const int row0 = u.pm * 256 + wr * 64 + fr, col0 = u.pn * 256 + wc * 32 + 8 * fq;
#pragma unroll
        for (int ai = 0; ai < 2; ++ai)
#pragma unroll
            for (int m = 0; m < 4; ++m)
#pragma unroll
                for (int bj = 0; bj < 2; ++bj) {
                    const size_t off = (size_t)(row0 + ai * 128 + m * 16) * 512 + col0 + bj * 128;
                    const u32x4 zw = *(const u32x4*)(Z + off);
                    const f32x4 b0 = *(const f32x4*)(bias + col0 + bj * 128), b1 = *(const f32x4*)(bias + col0 + bj * 128 + 4);
                    const pg8::f32x4 v0 = acc[ai][bj][m][0], v1 = acc[ai][bj][m][1];
                    const float zf[8] = {bflo(zw.x), bfhi(zw.x), bflo(zw.y), bfhi(zw.y), bflo(zw.z), bfhi(zw.z), bflo(zw.w), bfhi(zw.w)};
                    const float pre[8] = {v0[0] + b0.x, v0[1] + b0.y, v0[2] + b0.z, v0[3] + b0.w, v1[0] + b1.x, v1[1] + b1.y, v1[2] + b1.z, v1[3] + b1.w};
                    float r[8];
#pragma unroll
                    for (int i = 0; i < 8; ++i) r[i] = zf[i] / (1.0f + __expf(-pre[i]));
                    u32x4 o; o.x = pk2(r[0], r[1]); o.y = pk2(r[2], r[3]); o.z = pk2(r[4], r[5]); o.w = pk2(r[6], r[7]);
                    *(u32x4*)(O + off) = o;
                }
    }
};
struct EpiRes {
    static constexpr bool PERM = false, AFTER_DRAIN = false;
    const float* base; float* out;
    __device__ __forceinline__ void operator()(const pg8::f32x4 (&acc)[2][2][4][2], const pg8::Unit& u, int wr, int wc, int fr, int fq) const {
        const int col0 = u.pn * 256 + wc * 32 + 4 * fq;
#pragma unroll
        for (int ai = 0; ai < 2; ++ai)
#pragma unroll
            for (int m = 0; m < 4; ++m) {
                const size_t off = (size_t)(u.pm * 256 + ai * 128 + wr * 64 + m * 16 + fr) * 1024 + col0;
#pragma unroll
                for (int bj = 0; bj < 2; ++bj)
#pragma unroll
                    for (int n = 0; n < 2; ++n) {
                        const f32x4 bs = *(const f32x4*)(base + off + bj * 128 + n * 16);
                        const pg8::f32x4 a = acc[ai][bj][m][n];
                        f32x4 o; o.x = bs.x + a[0]; o.y = bs.y + a[1]; o.z = bs.z + a[2]; o.w = bs.w + a[3];
                        *(f32x4*)(out + off + bj * 128 + n * 16) = o;
                    }
            }
    }
};

__device__ __forceinline__ void phase_mix_norm(const Ctx& C, const Params& P) {
    const bf16_t* AO = (const bf16_t*)(P.ws + WS_ATTN); const bf16_t* SO = (const bf16_t*)(P.ws + WS_SSMO);
    bf16_t* MX = (bf16_t*)(P.ws + WS_BUFA);
    const int gw = C.bid * NWAVES + C.wave, NGW = C.G * NWAVES;
    for (int m = gw; m < SEQ; m += NGW) {
#pragma unroll
        for (int part = 0; part < 2; ++part) {
            const bf16_t* src = (part ? SO : AO) + (size_t)m * 512 + 8 * C.lane;
            const float* gam = P.in[part ? I_SOG : I_AOG] + 8 * C.lane;
            const u32x4 w = *(const u32x4*)src;
            const float f[8] = {bflo(w.x), bfhi(w.x), bflo(w.y), bfhi(w.y), bflo(w.z), bfhi(w.z), bflo(w.w), bfhi(w.w)};
            float ss = 0.f;
#pragma unroll
            for (int i = 0; i < 8; ++i) ss += f[i] * f[i];
            const float rinv = 1.0f / sqrtf(wave_sum(ss) * (1.0f / 512.0f) + EPS);
            const f32x4 g0 = *(const f32x4*)gam, g1 = *(const f32x4*)(gam + 4);
            u32x4 o; o.x = pk2(f[0] * rinv * g0.x, f[1] * rinv * g0.y); o.y = pk2(f[2] * rinv * g0.z, f[3] * rinv * g0.w);
            o.z = pk2(f[4] * rinv * g1.x, f[5] * rinv * g1.y); o.w = pk2(f[6] * rinv * g1.z, f[7] * rinv * g1.w);
            *(u32x4*)(MX + (size_t)m * DM + part * 512 + 8 * C.lane) = o;
        }
    }
}
__device__ __forceinline__ void phase_norm2(const Ctx& C, const Params& P) {
    bf16_t* HN = (bf16_t*)(P.ws + WS_BUFA);
    const int gw = C.bid * NWAVES + C.wave, NGW = C.G * NWAVES;
    for (int m = gw; m < SEQ; m += NGW) norm_row_to_bf16(P.out + (size_t)m * DM, P.in[I_N2G], HN + (size_t)m * DM, C.lane);
}

__device__ __forceinline__ void peer_topk_tile(const Ctx& C, const Params& P, int tok0) {
    const bf16_t* QP = (const bf16_t*)(P.ws + WS_QP);
    const bf16_t* SK = (const bf16_t*)(P.ws + WS_SUBK);
    int* IDX = (int*)(P.ws + WS_IDX); float* GW = (float*)(P.ws + WS_GW);
    LAS u32* lists = (LAS u32*)C.lds;
    const int c = C.lane & 31, h = C.lane >> 5;
    __syncthreads();
#pragma unroll 1
    for (int task = C.wave; task < 32; task += NWAVES) {
        const int tgp = task & 1, hs = task >> 1;
        const int tl = tgp * 32 + c;
        const bf16_t* qrow = QP + (size_t)(tok0 + tl) * 2048 + hs * 128;
        bf16x8 qf[8];
#pragma unroll
        for (int ks = 0; ks < 8; ++ks) qf[ks] = *(const bf16x8*)(qrow + 16 * ks + 8 * h);
        u32 g[4][16];
#pragma unroll
        for (int kb = 0; kb < 4; ++kb) {
            f32x16 acc = {0.f, 0.f, 0.f, 0.f, 0.f, 0.f, 0.f, 0.f, 0.f, 0.f, 0.f, 0.f, 0.f, 0.f, 0.f, 0.f};
            const bf16_t* krow = SK + (size_t)(hs * 128 + kb * 32 + c) * 128;
#pragma unroll
            for (int ks = 0; ks < 8; ++ks) acc = MFMA32(*(const bf16x8*)(krow + 16 * ks + 8 * h), qf[ks], acc);
#pragma unroll
            for (int r = 0; r < 16; ++r) { const int key = kb * 32 + (r & 3) + 8 * (r >> 2) + 4 * h; g[kb][r] = (f2ord(acc[r]) & ~0x7Fu) | (u32)(127 - key); }
        }
        top16_of_64(g[0], g[1], g[2], g[3]);
        u32 pb[16];
#pragma unroll
        for (int i = 0; i < 16; ++i) pb[i] = (u32)__shfl_xor((int)g[0][i], 32);
        merge_top16(g[0], pb);
        if (h == 0) {
            LAS u32x4* dst = (LAS u32x4*)(lists + (tl * 16 + hs) * 16);
#pragma unroll
            for (int i = 0; i < 4; ++i) { u32x4 w; w.x = g[0][4 * i]; w.y = g[0][4 * i + 1]; w.z = g[0][4 * i + 2]; w.w = g[0][4 * i + 3]; dst[i] = w; }
        }
    }
    __syncthreads();
    {
        const int tl = C.tid & 63, hd = C.tid >> 6;
        const LAS u32* L1 = lists + (tl * 16 + hd * 2) * 16; const LAS u32* L2 = L1 + 16;
        float v1[16], v2[16];
#pragma unroll
        for (int i = 0; i < 16; ++i) { v1[i] = ord2f(L1[i] & ~0x7Fu); v2[i] = ord2f(L2[i] & ~0x7Fu); }
        u32 cd[4][16];
        { int cid = 0;
#pragma unroll
          for (int a = 0; a < 16; ++a)
#pragma unroll
              for (int b = 0; b < 16; ++b) if ((a + 1) * (b + 1) <= 16) { cd[cid >> 4][cid & 15] = (f2ord(v1[a] + v2[b]) & ~0x3Fu) | (u32)(63 - cid); ++cid; }
#pragma unroll
          for (int k = 50; k < 64; ++k) cd[k >> 4][k & 15] = 0u; }
        top16_of_64(cd[0], cd[1], cd[2], cd[3]);
        float sc[16]; int ix[16]; float mx = -1e30f;
#pragma unroll
        for (int k = 0; k < 16; ++k) {
            const int cid = 63 - (int)(cd[0][k] & 63u); const int ab = CAND_AB[cid];
            const u32 k1 = L1[ab >> 4], k2 = L2[ab & 15];
            sc[k] = ord2f(k1 & ~0x7Fu) + ord2f(k2 & ~0x7Fu);
            ix[k] = (127 - (int)(k1 & 0x7Fu)) * 128 + (127 - (int)(k2 & 0x7Fu));
            mx = fmaxf(mx, sc[k]);
        }
        float sum = 0.f;
#pragma unroll
        for (int k = 0; k < 16; ++k) { sc[k] = __expf(sc[k] - mx); sum += sc[k]; }
        const float inv = 1.0f / sum;
        int* io = IDX + (size_t)(tok0 + tl) * 128 + hd * 16; float* go = GW + (size_t)(tok0 + tl) * 128 + hd * 16;
#pragma unroll
        for (int k = 0; k < 16; k += 4) {
            *(int4*)(io + k) = make_int4(ix[k], ix[k + 1], ix[k + 2], ix[k + 3]);
            f32x4 gv = {sc[k] * inv, sc[k + 1] * inv, sc[k + 2] * inv, sc[k + 3] * inv}; *(f32x4*)(go + k) = gv;
        }
    }
    __syncthreads();
}

__device__ __forceinline__ void unpack16(const u32x4& a, const u32x4& b, float (&f)[16]) {
    f[0] = bflo(a.x); f[1] = bfhi(a.x); f[2] = bflo(a.y); f[3] = bfhi(a.y); f[4] = bflo(a.z); f[5] = bfhi(a.z); f[6] = bflo(a.w); f[7] = bfhi(a.w);
    f[8] = bflo(b.x); f[9] = bfhi(b.x); f[10] = bflo(b.y); f[11] = bfhi(b.y); f[12] = bflo(b.z); f[13] = bfhi(b.z); f[14] = bflo(b.w); f[15] = bfhi(b.w);
}
__device__ __forceinline__ void peer_gather_tile(const Ctx& C, const Params& P, int tok0) {
    const bf16_t* HN = (const bf16_t*)(P.ws + WS_BUFA);
    const bf16_t* PU = (const bf16_t*)(P.ws + WS_PU); const bf16_t* PV = (const bf16_t*)(P.ws + WS_PV);
    const int* IDX = (const int*)(P.ws + WS_IDX); const float* GW = (const float*)(P.ws + WS_GW);
    const int lane = C.lane;
#pragma unroll 1
    for (int i = 0; i < 8; ++i) {
        const int tok = tok0 + C.wave * 8 + i;
        const int ia = IDX[(size_t)tok * 128 + lane], ib = IDX[(size_t)tok * 128 + 64 + lane];
        const float ga = GW[(size_t)tok * 128 + lane], gb = GW[(size_t)tok * 128 + 64 + lane];
        float hf[16];
        { const u32x4 a = *(const u32x4*)(HN + (size_t)tok * DM + 8 * lane), b = *(const u32x4*)(HN + (size_t)tok * DM + 512 + 8 * lane); unpack16(a, b, hf); }
        float zA = 0.f, zB = 0.f;
#pragma unroll 1
        for (int e0 = 0; e0 < 128; e0 += 8) {
            const int isel = (e0 < 64) ? ia : ib;
            float part[8];
#pragma unroll
            for (int k = 0; k < 8; ++k) {
                const int ridx = __builtin_amdgcn_readlane(isel, (e0 + k) & 63);
                const bf16_t* ur = PU + (size_t)ridx * DM;
                const u32x4 a = *(const u32x4*)(ur + 8 * lane), b = *(const u32x4*)(ur + 512 + 8 * lane);
                float uf[16]; unpack16(a, b, uf);
                float s = 0.f;
#pragma unroll
                for (int d = 0; d < 16; ++d) s += hf[d] * uf[d];
                part[k] = s;
            }
#pragma unroll
            for (int k = 0; k < 8; ++k) {
                const float tot = wave_sum(part[k]);
                if (e0 < 64) { if (lane == ((e0 + k) & 63)) zA = tot; } else { if (lane == ((e0 + k) & 63)) zB = tot; }
            }
        }
        const float aA = gelu_erf(zA) * ga, aB = gelu_erf(zB) * gb;
        float acc[16];
#pragma unroll
        for (int d = 0; d < 16; ++d) acc[d] = 0.f;
#pragma unroll 1
        for (int e0 = 0; e0 < 128; e0 += 8) {
            const int isel = (e0 < 64) ? ia : ib; const float asel = (e0 < 64) ? aA : aB;
#pragma unroll
            for (int k = 0; k < 8; ++k) {
                const int ridx = __builtin_amdgcn_readlane(isel, (e0 + k) & 63);
                const float ae = __uint_as_float((u32)__builtin_amdgcn_readlane((int)__float_as_uint(asel), (e0 + k) & 63));
                const bf16_t* vr = PV + (size_t)ridx * DM;
                const u32x4 a = *(const u32x4*)(vr + 8 * lane), b = *(const u32x4*)(vr + 512 + 8 * lane);
                float vf[16]; unpack16(a, b, vf);
#pragma unroll
                for (int d = 0; d < 16; ++d) acc[d] += ae * vf[d];
            }
        }
        float* orow = P.out + (size_t)tok * DM;
#pragma unroll
        for (int part = 0; part < 2; ++part)
#pragma unroll
            for (int q = 0; q < 2; ++q) {
                f32x4* p = (f32x4*)(orow + part * 512 + 8 * lane + 4 * q);
                f32x4 v = *p; v.x += acc[part * 8 + 4 * q]; v.y += acc[part * 8 + 4 * q + 1]; v.z += acc[part * 8 + 4 * q + 2]; v.w += acc[part * 8 + 4 * q + 3]; *p = v;
            }
    }
}

#define GAS __attribute__((address_space(1)))
typedef GAS unsigned gu32;
#define RLX_AGENT __ATOMIC_RELAXED, __HIP_MEMORY_SCOPE_AGENT
#define XB_TMO      128
#define XB_XCNT(j)  (256  + 64 * (j))
#define XB_XSUB(j)  (1280 + 64 * (j))
#define XB_XGEN(j)  (2304 + 64 * (j))
#define XB_TOP      3328
#define XB_TOPGEN   3392
#define XCD_BAR_WORDS 3456
#define XB_SPIN_CAP (1u << 18)

__device__ __forceinline__ unsigned xb_ld(unsigned* p)              { return __hip_atomic_load(p, __ATOMIC_RELAXED, __HIP_MEMORY_SCOPE_AGENT); }
__device__ __forceinline__ unsigned xb_add(unsigned* p, unsigned v) { return __hip_atomic_fetch_add(p, v, __ATOMIC_RELAXED, __HIP_MEMORY_SCOPE_AGENT); }
__device__ __forceinline__ unsigned xb_xcc_id() { return (unsigned)__builtin_amdgcn_s_getreg((3 << 11) | 20) & 0xFu; }
#define XB_SPIN(cond, bar) do { unsigned _sp = 0; while (cond) { __builtin_amdgcn_s_sleep(1); \
    if ((++_sp & 255u) == 0u) { if (xb_ld(&(bar)[XB_TMO])) break; if (_sp > XB_SPIN_CAP) { atomicAdd(&(bar)[XB_TMO], 1u); break; } } } } while (0)

struct XcdBarrier {
    unsigned* bar; unsigned x;
    volatile LAS unsigned* st;
};

__device__ __forceinline__ XcdBarrier xcd_barrier_post(unsigned* bar, volatile LAS unsigned* st) {
    XcdBarrier b; b.bar = bar; b.x = xb_xcc_id(); b.st = st;
    if (threadIdx.x == 0) (void)xb_add(&bar[XB_XCNT(b.x)], 1u);
    return b;
}
__device__ __forceinline__ void xcd_barrier_complete(unsigned* bar, unsigned x, unsigned& nloc, unsigned& nx) {
    const unsigned G = gridDim.x * gridDim.y * gridDim.z;
    unsigned sum, cnt, mine, sp = 0u;
    for (;;) {
        sum = 0u; cnt = 0u; mine = 0u;
#pragma unroll
        for (unsigned j = 0; j < 16; ++j) { const unsigned c = xb_ld(&bar[XB_XCNT(j)]); sum += c; cnt += (c > 0u) ? 1u : 0u; mine = (j == x) ? c : mine; }
        if (sum == G) break;
        __builtin_amdgcn_s_sleep(1);
        if ((++sp & 255u) == 0u) { if (xb_ld(&bar[XB_TMO])) break; if (sp > XB_SPIN_CAP) { atomicAdd(&bar[XB_TMO], 1u); break; } }
    }
    nloc = mine > 0u ? mine : 1u; nx = cnt > 0u ? cnt : 1u;
}

__device__ __forceinline__ void xcd_barrier(const XcdBarrier& b) {
    asm volatile("s_waitcnt vmcnt(0)" ::: "memory");
    __syncthreads();
    if (threadIdx.x == 0) {
        unsigned* bar = b.bar;
        __builtin_amdgcn_s_waitcnt(0);
        unsigned nloc = b.st[0], nx = b.st[1];
        if (nloc == 0u) { xcd_barrier_complete(bar, b.x, nloc, nx); b.st[0] = nloc; b.st[1] = nx; }
        const unsigned old = xb_add(&bar[XB_XSUB(b.x)], 1u);
        const unsigned gen = old / nloc;
        if (old + 1u == (gen + 1u) * nloc) {
            __builtin_amdgcn_fence(__ATOMIC_RELEASE, "agent");
            asm volatile("s_waitcnt vmcnt(0)" ::: "memory");
            const unsigned og = xb_add(&bar[XB_TOP], 1u);
            const unsigned tg = og / nx;
            if (og + 1u == (tg + 1u) * nx) xb_add(&bar[XB_TOPGEN], 1u);
            else XB_SPIN(xb_ld(&bar[XB_TOPGEN]) == tg, bar);
            __builtin_amdgcn_fence(__ATOMIC_ACQUIRE, "agent");
            xb_add(&bar[XB_XGEN(b.x)], 1u);
            asm volatile("s_waitcnt vmcnt(0)" ::: "memory");
        } else {
            XB_SPIN(xb_ld(&bar[XB_XGEN(b.x)]) == gen, bar);
            __builtin_amdgcn_fence(__ATOMIC_ACQUIRE, "agent");
            asm volatile("s_waitcnt vmcnt(0)" ::: "memory");
        }
    }
    __syncthreads();
}

constexpr int NPHASE = 11;
__global__ void __launch_bounds__(NTHR, 2) mk_fwd(Params P) {
    extern __shared__ __attribute__((aligned(16))) unsigned char lds_raw[];
    Ctx C; C.lds = (LAS unsigned char*)lds_raw; C.tid = threadIdx.x; C.lane = C.tid & 63; C.wave = __builtin_amdgcn_readfirstlane(C.tid >> 6); C.G = gridDim.x; C.bid = blockIdx.x;
    unsigned char* ws = P.ws;
    volatile LAS unsigned* MISC = (volatile LAS unsigned*)(C.lds + 131072 + 320);
    if (C.tid < 32) MISC[C.tid] = 0u;
    __syncthreads();
    XcdBarrier bar = xcd_barrier_post((unsigned*)(ws + WS_CTL) + 4096, MISC + 8);
#define SEAM(k) do { if (IN(k) && IN((k) + 1)) xcd_barrier(bar); } while (0)
#ifdef ONLY_PHASE
#define IN(k) ((k) == ONLY_PHASE && P.ph_lo <= (k) && (k) < P.ph_hi)
#else
#define IN(k) (P.ph_lo <= (k) && (k) < P.ph_hi)
#endif
    if (IN(0)) phase_prologue(C, P);
    SEAM(0);
    if (IN(1)) {
        pg8::Gemm g{(const bf16_t*)(ws + WS_BUFA), (const bf16_t*)(ws + WS_WIN_T), MPAD, INW, DM}; pg8::StaticOrder S; S.init(MPAD, INW, C.G, C.bid);
        pg8::EpiBf16<0> E{(bf16_t*)(ws + WS_PROJ), INW, nullptr, 0, 0, 1.f};
        pg8::gemm_phase<pg8::EpiBf16<0>, pg8::StaticOrder, true, true>(C.lds, g, S, E);
    }
    SEAM(1);
    if (IN(2)) phase_sloc(C, P);
    SEAM(2);
    if (IN(3)) {
        for (int bk = C.bid; bk < 64; bk += C.G) carry_scan_block(C, P, bk);
        for (int u = C.bid; u < 256; u += C.G) attn_unit(C, P, u >> 1, u & 1);
    }
    SEAM(3);
    if (IN(4)) phase_ssm_y(C, P);
    SEAM(4);
    if (IN(5)) {
        pg8::Gemm g{(const bf16_t*)(ws + WS_Z), (const bf16_t*)(ws + WS_GLU_T), SEQ, 512, 512}; pg8::StaticOrder S; S.init(SEQ, 512, C.G, C.bid);
        EpiGlu E{(const bf16_t*)(ws + WS_Z), (bf16_t*)(ws + WS_SSMO), P.in[I_GLUB]};
        pg8::gemm_phase<EpiGlu, pg8::StaticOrder, true, true>(C.lds, g, S, E);
    }
    SEAM(5);
    if (IN(6)) phase_mix_norm(C, P);
    SEAM(6);
    if (IN(7)) {
        pg8::Gemm g{(const bf16_t*)(ws + WS_BUFA), (const bf16_t*)(ws + WS_WOUT_T), SEQ, DM, DM}; pg8::StaticOrder S; S.init(SEQ, DM, C.G, C.bid);
        EpiRes E{P.in[I_X], P.out};
        pg8::gemm_phase<EpiRes, pg8::StaticOrder, true, true>(C.lds, g, S, E);
    }
    SEAM(7);
    if (IN(8)) phase_norm2(C, P);
    SEAM(8);
    if (IN(9)) {
        pg8::Gemm g{(const bf16_t*)(ws + WS_BUFA), (const bf16_t*)(ws + WS_WQ_T), SEQ, 2048, DM}; pg8::StaticOrder S; S.init(SEQ, 2048, C.G, C.bid);
        pg8::EpiBf16<0> E{(bf16_t*)(ws + WS_QP), 2048, nullptr, 0, 0, 1.f};
        pg8::gemm_phase<pg8::EpiBf16<0>, pg8::StaticOrder, true, true>(C.lds, g, S, E);
    }
    SEAM(9);
    if (IN(10)) {
        for (int tile = C.bid; tile < SEQ / 64; tile += C.G) { peer_topk_tile(C, P, tile * 64); peer_gather_tile(C, P, tile * 64); }
    }
#undef IN
#undef SEAM
}
}

extern "C" void kernel_launch(void* const* d_in, const int* in_sizes, int n_in, void* d_out, int out_size, void* d_ws, size_t ws_size, hipStream_t stream) {
    static int state = 0, grid = 0;
    if (state == 0) {
        if (n_in != 25 || out_size != mk::SEQ * mk::DM || ws_size < mk::WS_END) { fprintf(stderr, "kernel_launch: unexpected shapes (n_in %d out %d ws %zu)\n", n_in, out_size, ws_size); state = -1; return; }
        if (hipFuncSetAttribute((const void*)mk::mk_fwd, hipFuncAttributeMaxDynamicSharedMemorySize, mk::LDS_BYTES) != hipSuccess) { fprintf(stderr, "kernel_launch: hipFuncSetAttribute failed\n"); state = -1; return; }
        int dev = 0, cus = 0, per_cu = 0;
        if (hipGetDevice(&dev) != hipSuccess || hipDeviceGetAttribute(&cus, hipDeviceAttributeMultiprocessorCount, dev) != hipSuccess) { fprintf(stderr, "kernel_launch: device query failed\n"); state = -1; return; }
        if (hipOccupancyMaxActiveBlocksPerMultiprocessor(&per_cu, (const void*)mk::mk_fwd, mk::NTHR, mk::LDS_BYTES) != hipSuccess || per_cu < 1) { fprintf(stderr, "kernel_launch: occupancy query failed (%d)\n", per_cu); state = -1; return; }
        grid = cus;
        state = 1;
    }
    if (state < 0) return;
    mk::Params p{};
    for (int i = 0; i < 25; ++i) p.in[i] = (const float*)d_in[i];
    p.out = (float*)d_out; p.ws = (unsigned char*)d_ws;
    if (hipMemsetAsync((char*)d_ws + mk::WS_CTL, 0, 65536, stream) != hipSuccess) { fprintf(stderr, "kernel_launch: memset failed\n"); return; }
    p.ph_lo = 0; p.ph_hi = mk::NPHASE;
    void* args[] = {&p};
    hipError_t e = hipLaunchCooperativeKernel((const void*)mk::mk_fwd, dim3(grid), dim3(mk::NTHR), args, mk::LDS_BYTES, stream);
    if (e != hipSuccess) fprintf(stderr, "kernel_launch: cooperative launch failed: %s (grid %d)\n", hipGetErrorString(e), grid);
}
```

```cpp
#include <hip/hip_runtime.h>
#include <cstdio>
#include <cstdint>
#include <cmath>
namespace pg8 {
#define PG8_LAS __attribute__((address_space(3)))
typedef unsigned short bf16_t;
typedef short bf16x8 __attribute__((ext_vector_type(8)));
typedef float f32x4 __attribute__((ext_vector_type(4)));
typedef unsigned u32x4 __attribute__((ext_vector_type(4)));
constexpr int BM = 256, BK = 64, HALF = 128, HTB = HALF * BK * 2  , STAGE_BYTES = 8 * HTB, NXCD = 8, WGM = 8;

__host__ __device__ __forceinline__ int lds_byte(int r, int c) { const int st = (r >> 4) * 2 + (c >> 5), rr = r & 15, cc = c & 31, ob = rr * 64 + cc * 2; return st * 1024 + (ob ^ (((ob >> 9) & 1) << 5)); }
__host__ __device__ __forceinline__ void stage_rc(int b, int& R, int& C) { const int st = b / 1024, sb = b % 1024, swz = sb ^ (((sb >> 9) & 1) << 5); R = (st >> 1) * 16 + swz / 64; C = (st & 1) * 32 + (swz % 64) / 2; }
__host__ __device__ __forceinline__ int perm32(int rho) { const int n = rho >> 4, i = rho & 15; return 8 * (i >> 2) + 4 * n + (i & 3); }

struct Unit { int pm, pn; };
struct Gemm { const bf16_t* A; const bf16_t* Bt; int M, N, K; };

struct StaticOrder {
    int nM, nN, nwg, G, c;
    __host__ __device__ void init(int M, int N, int G_, int c_) { nM = M / BM; nN = N / BM; nwg = nM * nN; G = G_; c = c_; }
    __host__ __device__ bool next(int i, Unit& u) const {
        const long L = (long)i * G + c; if (L >= nwg) return false;
        int wgid = (int)L; { const int q = nwg / NXCD, r = nwg % NXCD, xcd = wgid % NXCD, off = wgid / NXCD; wgid = (xcd < r ? xcd * (q + 1) : r * (q + 1) + (xcd - r) * q) + off; }
        const int nig = WGM * nN, gid = wgid / nig, fm = gid * WGM, gsz = (nM - fm) < WGM ? (nM - fm) : WGM;
        u.pm = fm + ((wgid % nig) % gsz); u.pn = (wgid % nig) / gsz; return true;
    }
    __device__ __forceinline__ void a_ready(const Unit&) const {}
    __device__ __forceinline__ void done(const Unit&) const {}
};

__device__ __forceinline__ unsigned cvt_pk_bf16(float lo, float hi) { unsigned r; asm volatile("v_cvt_pk_bf16_f32 %0, %1, %2" : "=v"(r) : "v"(lo), "v"(hi)); return r; }
typedef float f32x2 __attribute__((ext_vector_type(2)));
__device__ __forceinline__ f32x2 gelu_pk(f32x2 v) {
    const f32x2 av = __builtin_elementwise_abs(v), d = av * 0.2316418882f + 1.0f;
    f32x2 t; t.x = __builtin_amdgcn_rcpf(d.x); t.y = __builtin_amdgcn_rcpf(d.y);
    f32x2 q = t * 0.5307027145f + (-0.7265760135f); q = q * t + 0.7107068705f; q = q * t + (-0.142248368f); q = q * t + 0.127414796f; q = q * t;
    const f32x2 s = (v * v) * (-0.72134752044f);
    f32x2 e; e.x = __builtin_amdgcn_exp2f(s.x); e.y = __builtin_amdgcn_exp2f(s.y);
    const f32x2 m = v * (q * e), r = v - m;
    f32x2 o; o.x = v.x < 0.f ? m.x : r.x; o.y = v.y < 0.f ? m.y : r.y; return o;
}

template <int ACT  > struct EpiBf16 {
    static constexpr bool PERM = true, AFTER_DRAIN = false; static_assert(ACT == 0 || ACT == 1, "EpiBf16: ACT is 0 (none) or 1 (gelu_pk)");
    bf16_t* O; int ldc; const float* bias; int split_cols; size_t split_stride; float scale0;
    __device__ __forceinline__ void operator()(const f32x4 (&acc)[2][2][4][2], const Unit& u, int wr, int wc, int fr, int fq) const {
        const int row0 = u.pm * BM + wr * 64 + fr; int colt = u.pn * BM; bf16_t* base = O;
        float sc = 1.f; if (split_cols) { const int t = colt / split_cols; base += (size_t)t * split_stride; colt -= t * split_cols; if (t == 0) sc = scale0; }
        const int col0 = colt + wc * 32 + 8 * fq, bcol0 = u.pn * BM + wc * 32 + 8 * fq;
        f32x4 bv[2][2];
#pragma unroll
        for (int bj = 0; bj < 2; ++bj)
#pragma unroll
            for (int n = 0; n < 2; ++n) bv[bj][n] = bias ? *(const f32x4*)(bias + bcol0 + bj * HALF + 4 * n) : (f32x4){0.f, 0.f, 0.f, 0.f};
#pragma unroll
        for (int ai = 0; ai < 2; ++ai)
#pragma unroll
            for (int m = 0; m < 4; ++m) { bf16_t* rowp = base + (size_t)(row0 + ai * HALF + m * 16) * ldc + col0;
#pragma unroll
                for (int bj = 0; bj < 2; ++bj) { f32x4 v0 = acc[ai][bj][m][0] + bv[bj][0], v1 = acc[ai][bj][m][1] + bv[bj][1];
                    if (ACT == 1) { f32x2 a = gelu_pk((f32x2){v0[0], v0[1]}), b = gelu_pk((f32x2){v0[2], v0[3]}), c = gelu_pk((f32x2){v1[0], v1[1]}), d = gelu_pk((f32x2){v1[2], v1[3]});
                        v0 = (f32x4){a.x, a.y, b.x, b.y}; v1 = (f32x4){c.x, c.y, d.x, d.y}; }
                    v0 = v0 * sc; v1 = v1 * sc; u32x4 w; w.x = cvt_pk_bf16(v0[0], v0[1]); w.y = cvt_pk_bf16(v0[2], v0[3]); w.z = cvt_pk_bf16(v1[0], v1[1]); w.w = cvt_pk_bf16(v1[2], v1[3]);
                    *(u32x4*)(rowp + bj * HALF) = w; } }
    }
};
template <class Epi, class Sched, bool ALIGN_EPI = false, bool SP2 = false>
__device__ __forceinline__ void gemm_phase(PG8_LAS unsigned char* lds, const Gemm g, const Sched& S, const Epi& E) {
    const int tid = threadIdx.x, wid = __builtin_amdgcn_readfirstlane(tid >> 6), lane = tid & 63, wr = wid >> 2, wc = wid & 3, fr = lane & 15, fq = lane >> 4;
    const int K = g.K, nt = K / BK;
    unsigned voffA[2], voffB[2];
#pragma unroll
    for (int i = 0; i < 2; ++i) { int R, C; stage_rc(tid * 16 + i * 8192, R, C); const int Rb = Epi::PERM ? ((R & ~31) + perm32(R & 31)) : R;
        voffA[i] = (unsigned)(R * K + C) * 2u; voffB[i] = (unsigned)(Rb * K + C) * 2u; }
    const size_t kstep = (size_t)(BK * 2);
    const size_t hstep = (size_t)HALF * K * 2;
    const size_t tstep = 2 * hstep;
    const unsigned ldsw = (unsigned)wid * 1024u;
    const int aoff = lds_byte(wr * 64 + fr, fq * 8), boff = lds_byte(wc * 32 + fr, fq * 8);
#define PG8_SA(b, h) (((b) * 2 + (h)) * HTB)
#define PG8_SB(b, h) ((4 + (b) * 2 + (h)) * HTB)
#define PG8_STAGE(bufoff, gbase, voff) do { _Pragma("unroll") for (int _i = 0; _i < 2; ++_i) \
        __builtin_amdgcn_global_load_lds((const unsigned*)((const char*)(gbase) + (voff)[_i]), (PG8_LAS unsigned*)(lds + (bufoff) + ldsw + _i * 8192), 16, 0, 0); } while (0)
#define PG8_LDA(dst, b, h) do { _Pragma("unroll") for (int m = 0; m < 4; ++m) _Pragma("unroll") for (int k = 0; k < 2; ++k) dst[m][k] = *(const PG8_LAS bf16x8*)(lds + PG8_SA(b, h) + aoff + m * 2048 + k * 1024); } while (0)
#define PG8_LDB(dst, b, h) do { _Pragma("unroll") for (int n = 0; n < 2; ++n) _Pragma("unroll") for (int k = 0; k < 2; ++k) dst[n][k] = *(const PG8_LAS bf16x8*)(lds + PG8_SB(b, h) + boff + n * 2048 + k * 1024); } while (0)
#define PG8_MMA(ai, bj, At, Bt) do { __builtin_amdgcn_s_setprio(1); _Pragma("unroll") for (int m = 0; m < 4; ++m) _Pragma("unroll") for (int n = 0; n < 2; ++n) _Pragma("unroll") for (int k = 0; k < 2; ++k) \
        acc[ai][bj][m][n] = __builtin_amdgcn_mfma_f32_16x16x32_bf16(Bt[n][k], At[m][k], acc[ai][bj][m][n], 0, 0, 0); __builtin_amdgcn_s_setprio(0); } while (0)
#define PG8_WAIT_V(n) asm volatile("s_waitcnt vmcnt(" #n ")" ::: "memory")
#define PG8_WAIT_L(n) asm volatile("s_waitcnt lgkmcnt(" #n ")" ::: "memory")
#define PG8_BAR __builtin_amdgcn_s_barrier()
#define PG8_SCHED __builtin_amdgcn_sched_barrier(0)
    Unit cur, nxt; int ui = 0;
    if (!S.next(0, cur)) return;
    f32x4 acc[2][2][4][2];
#pragma unroll
    for (int a = 0; a < 2; ++a)
#pragma unroll
        for (int b = 0; b < 2; ++b)
#pragma unroll
            for (int m = 0; m < 4; ++m)
#pragma unroll
                for (int n = 0; n < 2; ++n) acc[a][b][m][n] = (f32x4){0.f, 0.f, 0.f, 0.f};
    bf16x8 At[4][2], B0[2][2], B1[2][2];
    const char* cA = (const char*)g.A + (size_t)cur.pm * tstep; const char* cB = (const char*)g.Bt + (size_t)cur.pn * tstep;
    S.a_ready(cur);
    if constexpr (SP2) {
        PG8_STAGE(PG8_SB(0, 0), cB, voffB); PG8_STAGE(PG8_SB(0, 1), cB + hstep, voffB); PG8_STAGE(PG8_SA(0, 0), cA, voffA); PG8_STAGE(PG8_SA(0, 1), cA + hstep, voffA);
        if (wr == 1) PG8_BAR;
        PG8_WAIT_V(2); PG8_BAR;
        PG8_STAGE(PG8_SB(1, 0), cB + kstep, voffB); PG8_STAGE(PG8_SA(1, 0), cA + kstep, voffA); PG8_STAGE(PG8_SB(1, 1), cB + hstep + kstep, voffB);
        PG8_WAIT_V(6); PG8_BAR;
    } else {
        PG8_STAGE(PG8_SB(0, 0), cB, voffB); PG8_STAGE(PG8_SA(0, 0), cA, voffA); PG8_STAGE(PG8_SB(0, 1), cB + hstep, voffB); PG8_STAGE(PG8_SA(0, 1), cA + hstep, voffA);
        if (wr == 1) PG8_BAR;
        PG8_WAIT_V(4); PG8_BAR;
        PG8_STAGE(PG8_SB(1, 0), cB + kstep, voffB); PG8_STAGE(PG8_SA(1, 0), cA + kstep, voffA); PG8_STAGE(PG8_SB(1, 1), cB + hstep + kstep, voffB);
        PG8_WAIT_V(6); PG8_BAR;
    }
    for (;;) {
        const bool has_next = S.next(ui + 1, nxt);
        const char* nA = has_next ? (const char*)g.A + (size_t)nxt.pm * tstep : cA; const char* nB = has_next ? (const char*)g.Bt + (size_t)nxt.pn * tstep : cB;
        for (int t = 0; t < nt; t += 2) {
            const bool last = (t == nt - 2);
            const char* a1 = cA + (size_t)(t + 1) * kstep;
            const char* a2 = last ? nA : cA + (size_t)(t + 2) * kstep; const char* b2 = last ? nB : cB + (size_t)(t + 2) * kstep;
            const char* a3 = a2 + kstep; const char* b3 = b2 + kstep;
            if (last && has_next) S.a_ready(nxt);
            if constexpr (SP2) {
            PG8_LDB(B0, 0, 0); PG8_LDB(B1, 0, 1); PG8_SCHED; PG8_LDA(At, 0, 0); PG8_STAGE(PG8_SA(1, 1), a1 + hstep, voffA);
            PG8_WAIT_V(8); PG8_WAIT_L(0); PG8_BAR; PG8_MMA(0, 0, At, B0); PG8_MMA(0, 1, At, B1); PG8_BAR; PG8_SCHED;
            PG8_LDA(At, 0, 1); PG8_STAGE(PG8_SB(0, 0), b2, voffB); PG8_STAGE(PG8_SB(0, 1), b2 + hstep, voffB); PG8_STAGE(PG8_SA(0, 0), a2, voffA);
            PG8_WAIT_V(8); PG8_WAIT_L(0); PG8_BAR; PG8_MMA(1, 0, At, B0); PG8_MMA(1, 1, At, B1); PG8_BAR; PG8_SCHED;
            PG8_LDB(B0, 1, 0); PG8_LDB(B1, 1, 1); PG8_SCHED; PG8_LDA(At, 1, 0); PG8_STAGE(PG8_SA(0, 1), a2 + hstep, voffA);
            PG8_WAIT_V(8); PG8_WAIT_L(0); PG8_BAR; PG8_MMA(0, 0, At, B0); PG8_MMA(0, 1, At, B1); PG8_BAR; PG8_SCHED;
            PG8_LDA(At, 1, 1); PG8_STAGE(PG8_SB(1, 0), b3, voffB); PG8_STAGE(PG8_SB(1, 1), b3 + hstep, voffB); PG8_STAGE(PG8_SA(1, 0), a3, voffA);
            PG8_WAIT_V(8); PG8_WAIT_L(0); PG8_BAR; PG8_MMA(1, 0, At, B0); PG8_MMA(1, 1, At, B1); PG8_BAR; PG8_SCHED;
            } else {
            PG8_LDB(B0, 0, 0); PG8_SCHED; PG8_LDA(At, 0, 0); PG8_STAGE(PG8_SA(1, 1), a1 + hstep, voffA);
            PG8_WAIT_L(8); PG8_BAR; PG8_WAIT_L(0); PG8_MMA(0, 0, At, B0); PG8_BAR; PG8_SCHED;
            PG8_LDB(B1, 0, 1); PG8_STAGE(PG8_SB(0, 0), b2, voffB);
            PG8_BAR; PG8_WAIT_L(0); PG8_MMA(0, 1, At, B1); PG8_BAR;
            PG8_LDA(At, 0, 1); PG8_STAGE(PG8_SA(0, 0), a2, voffA);
            PG8_BAR; PG8_WAIT_L(0); PG8_MMA(1, 0, At, B0); PG8_BAR; PG8_SCHED;
            PG8_STAGE(PG8_SB(0, 1), b2 + hstep, voffB);
            PG8_WAIT_V(6); PG8_BAR; PG8_MMA(1, 1, At, B1); PG8_BAR;
            PG8_LDB(B0, 1, 0); PG8_SCHED; PG8_LDA(At, 1, 0); PG8_STAGE(PG8_SA(0, 1), a2 + hstep, voffA);
            PG8_WAIT_L(8); PG8_BAR; PG8_WAIT_L(0); PG8_MMA(0, 0, At, B0); PG8_BAR; PG8_SCHED;
            PG8_LDB(B1, 1, 1); PG8_STAGE(PG8_SB(1, 0), b3, voffB);
            PG8_BAR; PG8_WAIT_L(0); PG8_MMA(0, 1, At, B1); PG8_BAR;
            PG8_LDA(At, 1, 1); PG8_STAGE(PG8_SA(1, 0), a3, voffA);
            PG8_BAR; PG8_WAIT_L(0); PG8_MMA(1, 0, At, B0); PG8_BAR; PG8_SCHED;
            PG8_STAGE(PG8_SB(1, 1), b3 + hstep, voffB);
            PG8_WAIT_V(6); PG8_BAR; PG8_MMA(1, 1, At, B1); PG8_BAR;
            }
        }
        if constexpr (ALIGN_EPI) { if (wr == 0) PG8_BAR; }
        if constexpr (!Epi::AFTER_DRAIN) { E(acc, cur, wr, wc, fr, fq); S.done(cur); }
        if (!has_next) break;
#pragma unroll
        for (int a = 0; a < 2; ++a)
#pragma unroll
            for (int b = 0; b < 2; ++b)
#pragma unroll
                for (int m = 0; m < 4; ++m)
#pragma unroll
                    for (int n = 0; n < 2; ++n) acc[a][b][m][n] = (f32x4){0.f, 0.f, 0.f, 0.f};
        cur = nxt; cA = nA; cB = nB; ++ui;
        if constexpr (ALIGN_EPI) { if (wr == 1) PG8_BAR; }
    }
    PG8_WAIT_V(0);
    if constexpr (!ALIGN_EPI) { if (wr == 0) PG8_BAR; }
    PG8_BAR;
    if constexpr (Epi::AFTER_DRAIN) { E.fused(acc, cur, wr, wc, fr, fq, lds, wid, lane); S.done(cur); }
#undef PG8_SA
#undef PG8_SB
#undef PG8_STAGE
#undef PG8_LDA
#undef PG8_LDB
#undef PG8_MMA
#undef PG8_WAIT_V
#undef PG8_WAIT_L
#undef PG8_BAR
#undef PG8_SCHED
}
}

namespace mk {
#define LAS __attribute__((address_space(3)))
typedef unsigned short bf16_t;
typedef short bf16x8 __attribute__((ext_vector_type(8)));
typedef float f32x4 __attribute__((ext_vector_type(4)));
typedef float f32x16 __attribute__((ext_vector_type(16)));
typedef unsigned u32x4 __attribute__((ext_vector_type(4)));
typedef unsigned u32x2 __attribute__((ext_vector_type(2)));
typedef __bf16 bf16x2_t __attribute__((ext_vector_type(2)));
typedef float f32x2_t __attribute__((ext_vector_type(2)));
typedef unsigned u32;

constexpr int DM = 1024, SEQ = 16384, NMETA = 16, MPAD = 16640, INW = 1280;
constexpr int O_K = 512, O_V = 640, O_U = 768;
constexpr int NCH = 513;
constexpr float EPS = 1e-6f;
constexpr float LOG2E = 1.4426950408889634f;
constexpr int NWAVES = 8, NTHR = 512;
constexpr int LDS_BYTES = 147456;

constexpr size_t MiB = 1u << 20;
constexpr size_t WS_CTL = 0, CTL_BYTES = 1 * MiB;
constexpr size_t WS_WIN_T = 1 * MiB;
constexpr size_t WS_WOUT_T = 4 * MiB;
constexpr size_t WS_WQ_T = 6 * MiB;
constexpr size_t WS_GLU_T = 10 * MiB;
constexpr size_t WS_SUBK = 10 * MiB + 512 * 1024;
constexpr size_t WS_KT = 11 * MiB;
constexpr size_t WS_F = 12 * MiB;
constexpr size_t WS_E = 16 * MiB;
constexpr size_t WS_ABART = 20 * MiB;
constexpr size_t WS_SLOC = 21 * MiB;
constexpr size_t WS_CARRY = 30 * MiB;
constexpr size_t WS_BUFA = 39 * MiB;
constexpr size_t WS_PROJ = 72 * MiB;
constexpr size_t WS_ATTN = 113 * MiB;
constexpr size_t WS_Z = 129 * MiB;
constexpr size_t WS_SSMO = 145 * MiB;
constexpr size_t WS_QP = 72 * MiB;
constexpr size_t WS_IDX = 161 * MiB;
constexpr size_t WS_GW = 169 * MiB;
constexpr size_t WS_PU = 177 * MiB;
constexpr size_t WS_PV = 193 * MiB;
constexpr size_t WS_SU = 209 * MiB;
constexpr size_t WS_SV = 209 * MiB + 65536;
constexpr size_t WS_END = 210 * MiB;

struct Params { const float* in[25]; float* out; unsigned char* ws; int ph_lo, ph_hi; float one, zero; };
enum { I_X = 0, I_META, I_N1G, I_WIN, I_QNG, I_KNG, I_SINK, I_ARE, I_AIM, I_LDT, I_BRE, I_BIM, I_CRE, I_CIM, I_SD, I_GLUW, I_GLUB, I_AOG, I_SOG, I_WOUT, I_N2G, I_WQ, I_SUBK, I_PU, I_PV };

__device__ __forceinline__ unsigned pk2(float lo, float hi) { f32x2_t v = {lo, hi}; return __builtin_bit_cast(unsigned, __builtin_convertvector(v, bf16x2_t)); }
__device__ __forceinline__ float bflo(unsigned w) { return __uint_as_float(w << 16); }
__device__ __forceinline__ float bfhi(unsigned w) { return __uint_as_float(w & 0xffff0000u); }
__device__ __forceinline__ float wave_sum(float v) {
#pragma unroll
    for (int o = 1; o < 64; o <<= 1) v += __shfl_xor(v, o);
    return v;
}
#define LDS_WAIT() asm volatile("s_waitcnt lgkmcnt(0)" ::: "memory")
__device__ __forceinline__ float gelu_erf(float v) { return 0.5f * v * (1.0f + erff(v * 0.70710678118654752f)); }
__device__ __forceinline__ u32 f2ord(float f) { const u32 u = __float_as_uint(f); return (u & 0x80000000u) ? ~u : (u | 0x80000000u); }
__device__ __forceinline__ float ord2f(u32 o) { const u32 u = (o & 0x80000000u) ? (o & 0x7fffffffu) : ~o; return __uint_as_float(u); }
#define MFMA16(a, b, c) __builtin_amdgcn_mfma_f32_16x16x32_bf16((a), (b), (c), 0, 0, 0)
#define MFMA32(a, b, c) __builtin_amdgcn_mfma_f32_32x32x16_bf16((a), (b), (c), 0, 0, 0)

#define CEX(x, i, j) do { const u32 _a = x[i], _b = x[j]; x[i] = _a > _b ? _a : _b; x[j] = _a > _b ? _b : _a; } while (0)
__device__ __forceinline__ void sort16_desc(u32 (&x)[16]) {
#pragma unroll
    for (int k = 2; k <= 16; k <<= 1) {
#pragma unroll
        for (int j = k >> 1; j > 0; j >>= 1) {
#pragma unroll
            for (int i = 0; i < 16; ++i) { const int l = i ^ j; if (l > i) { if ((i & k) == 0) CEX(x, i, l); else CEX(x, l, i); } }
        }
    }
}
__device__ __forceinline__ void bmerge16_desc(u32 (&x)[16]) {
#pragma unroll
    for (int j = 8; j > 0; j >>= 1) {
#pragma unroll
        for (int i = 0; i < 16; ++i) { const int l = i ^ j; if (l > i) CEX(x, i, l); }
    }
}
__device__ __forceinline__ void merge_top16(u32 (&a)[16], const u32 (&b)[16]) {
#pragma unroll
    for (int i = 0; i < 16; ++i) a[i] = a[i] > b[15 - i] ? a[i] : b[15 - i];
    bmerge16_desc(a);
}
__device__ __forceinline__ void top16_of_64(u32 (&g0)[16], u32 (&g1)[16], u32 (&g2)[16], u32 (&g3)[16]) {
    sort16_desc(g0); sort16_desc(g1); sort16_desc(g2); sort16_desc(g3);
    merge_top16(g0, g1); merge_top16(g2, g3); merge_top16(g0, g2);
}
__device__ const unsigned char CAND_AB[64] = {0, 1, 2, 3, 4, 5, 6, 7, 8, 9, 10, 11, 12, 13, 14, 15, 16, 17, 18, 19, 20, 21, 22, 23, 32, 33, 34, 35, 36, 48, 49, 50, 51, 64, 65, 66, 80, 81, 96, 97, 112, 113, 128, 144, 160, 176, 192, 208, 224, 240, 0, 0, 0, 0, 0, 0, 0, 0, 0, 0, 0, 0, 0, 0};

struct Ctx { LAS unsigned char* lds; int tid, lane, wave, G, bid; };

__device__ __forceinline__ void transpose_item(const float* W, int K, int N, bf16_t* WT, LAS float* scr, int item, int lane) {
    const int nblk = N / 32, kb = item / nblk, nb = item % nblk, k0 = 64 * kb, n0 = 32 * nb;
#pragma unroll 8
    for (int i = 0; i < 32; ++i) { const int kk = 2 * i + (lane >> 5); scr[kk * 33 + (lane & 31)] = W[(size_t)(k0 + kk) * N + n0 + (lane & 31)]; }
    LDS_WAIT();
    const int c = lane & 7;
#pragma unroll
    for (int j = 0; j < 4; ++j) { const int n = (lane >> 3) + 8 * j; const LAS float* s = scr + (8 * c) * 33 + n;
        u32x4 o; o.x = pk2(s[0 * 33], s[1 * 33]); o.y = pk2(s[2 * 33], s[3 * 33]); o.z = pk2(s[4 * 33], s[5 * 33]); o.w = pk2(s[6 * 33], s[7 * 33]);
        *(u32x4*)(WT + (size_t)(n0 + n) * K + k0 + 8 * c) = o; }
    LDS_WAIT();
}

__device__ __forceinline__ void ssm_tables(const Ctx& C, const Params& P, int g) {
    LAS float* pwr = (LAS float*)C.lds;
    LAS float* pwi = pwr + 33 * 64;
    LAS float* bbr = pwi + 33 * 64;
    LAS float* bbi = bbr + 1024;
    LAS float* ccr = bbi + 1024;
    LAS float* cci = ccr + 1024;
    LAS float* cfr = cci + 1024;
    LAS float* cfi = cfr + 64;
    const int tid = C.tid;
    if (tid < 64) {
        const int n = tid;
        const float dt = expf(P.in[I_LDT][g]), lr = P.in[I_ARE][g * 64 + n], li = P.in[I_AIM][g * 64 + n];
        for (int l = 0; l <= 32; ++l) {
            const float x = lr * dt * (float)l, th = li * dt * (float)l, mag = expf(x);
            float s, c; sincosf(th, &s, &c);
            pwr[l * 64 + n] = mag * c; pwi[l * 64 + n] = mag * s;
        }
        const float x1 = lr * dt, th1 = li * dt, em1 = expm1f(x1);
        float s1, c1; sincosf(th1, &s1, &c1);
        const float sh = sinf(0.5f * th1);
        const float nr = em1 * c1 - 2.0f * sh * sh, ni = (em1 + 1.0f) * s1;
        const float den = lr * lr + li * li;
        cfr[n] = (nr * lr + ni * li) / den; cfi[n] = (ni * lr - nr * li) / den;
        float* abt = (float*)(P.ws + WS_ABART) + (g * 64 + n) * 2;
        abt[0] = pwr[32 * 64 + n]; abt[1] = pwi[32 * 64 + n];
    }
    __syncthreads();
    for (int e = tid; e < 1024; e += NTHR) {
        const int n = e >> 4;
        const float br = P.in[I_BRE][g * 1024 + e], bi = P.in[I_BIM][g * 1024 + e];
        bbr[e] = cfr[n] * br - cfi[n] * bi; bbi[e] = cfr[n] * bi + cfi[n] * br;
        ccr[e] = P.in[I_CRE][g * 1024 + e]; cci[e] = P.in[I_CIM][g * 1024 + e];
    }
    __syncthreads();
    bf16_t* Kt = (bf16_t*)(P.ws + WS_KT) + (size_t)g * 8448;
    for (int e = tid; e < 8448; e += NTHR) {
        const int li = e >> 8, p = (e >> 4) & 15, q = e & 15;
        float val = 0.f;
        if (li >= 1) {
            const int lag = li - 1;
            for (int n = 0; n < 64; ++n) {
                const float ar = pwr[lag * 64 + n], ai = pwi[lag * 64 + n], br = bbr[n * 16 + q], bi = bbi[n * 16 + q];
                const float wr = ar * br - ai * bi, wi = ar * bi + ai * br;
                val += ccr[p * 64 + n] * wr - cci[p * 64 + n] * wi;
            }
        }
        Kt[e] = (bf16_t)(pk2(val, 0.f) & 0xffffu);
    }
    bf16_t* F = (bf16_t*)(P.ws + WS_F) + (size_t)g * 65536;
    for (int e = tid; e < 65536; e += NTHR) {
        const int n2 = e >> 9, k = e & 511, j = k >> 4, q = k & 15, n = n2 & 63, l = 31 - j;
        const float ar = pwr[l * 64 + n], ai = pwi[l * 64 + n], br = bbr[n * 16 + q], bi = bbi[n * 16 + q];
        const float wr = ar * br - ai * bi, wi = ar * bi + ai * br;
        F[e] = (bf16_t)(pk2(n2 < 64 ? wr : wi, 0.f) & 0xffffu);
    }
    bf16_t* E = (bf16_t*)(P.ws + WS_E) + (size_t)g * 65536;
    for (int e = tid; e < 65536; e += NTHR) {
        const int row = e >> 7, n2 = e & 127, t = row >> 4, p = row & 15, n = n2 & 63;
        const float pr = pwr[(t + 1) * 64 + n], pi = pwi[(t + 1) * 64 + n], cr = ccr[p * 64 + n], ci = cci[p * 64 + n];
        const float cpr = cr * pr - ci * pi, cpi = cr * pi + ci * pr;
        E[e] = (bf16_t)(pk2(n2 < 64 ? cpr : -cpi, 0.f) & 0xffffu);
    }
    __syncthreads();
}

__device__ __forceinline__ void norm_row_to_bf16(const float* src, const float* gam, bf16_t* dst, int lane) {
    const f32x4* xr = (const f32x4*)src + lane; const f32x4* gr = (const f32x4*)gam + lane;
    f32x4 v[4]; float s = 0.f;
#pragma unroll
    for (int j = 0; j < 4; ++j) { v[j] = xr[64 * j]; s += (v[j].x * v[j].x + v[j].y * v[j].y) + (v[j].z * v[j].z + v[j].w * v[j].w); }
    const float rinv = 1.0f / sqrtf(wave_sum(s) * (1.0f / DM) + EPS);
    u32x2* o = (u32x2*)dst + lane;
#pragma unroll
    for (int j = 0; j < 4; ++j) { const f32x4 g = gr[64 * j]; u32x2 w; w.x = pk2(v[j].x * rinv * g.x, v[j].y * rinv * g.y); w.y = pk2(v[j].z * rinv * g.z, v[j].w * rinv * g.w); o[64 * j] = w; }
}

__device__ __forceinline__ void cvt8(const float* src, bf16_t* dst, size_t i) {
    const f32x4 a = ((const f32x4*)src)[2 * i], b = ((const f32x4*)src)[2 * i + 1];
    u32x4 o; o.x = pk2(a.x, a.y); o.y = pk2(a.z, a.w); o.z = pk2(b.x, b.y); o.w = pk2(b.z, b.w);
    ((u32x4*)dst)[i] = o;
}

__device__ __forceinline__ void phase_prologue(const Ctx& C, const Params& P) {
    for (int g = C.bid; g < 32; g += C.G) ssm_tables(C, P, g);
    __syncthreads();
    LAS float* scr = (LAS float*)(C.lds + C.wave * 16384);
    const int gw = C.bid * NWAVES + C.wave, NGW = C.G * NWAVES;
    constexpr int I_IN = 16 * 40, I_OUT = 16 * 32, I_Q = 16 * 64, I_GLU = 8 * 16, NITEMS = I_IN + I_OUT + I_Q + I_GLU;
    for (int it = gw; it < NITEMS; it += NGW) {
        int r = it;
        if (r < I_IN) { transpose_item(P.in[I_WIN], 1024, 1280, (bf16_t*)(P.ws + WS_WIN_T), scr, r, C.lane); continue; } r -= I_IN;
        if (r < I_OUT) { transpose_item(P.in[I_WOUT], 1024, 1024, (bf16_t*)(P.ws + WS_WOUT_T), scr, r, C.lane); continue; } r -= I_OUT;
        if (r < I_Q) { transpose_item(P.in[I_WQ], 1024, 2048, (bf16_t*)(P.ws + WS_WQ_T), scr, r, C.lane); continue; } r -= I_Q;
        transpose_item(P.in[I_GLUW], 512, 512, (bf16_t*)(P.ws + WS_GLU_T), scr, r, C.lane);
    }
    bf16_t* xn = (bf16_t*)(P.ws + WS_BUFA);
    for (int m = gw; m < MPAD; m += NGW) {
        if (m < SEQ) norm_row_to_bf16(P.in[I_X] + (size_t)m * DM, P.in[I_N1G], xn + (size_t)m * DM, C.lane);
        else if (m < SEQ + NMETA) norm_row_to_bf16(P.in[I_META] + (size_t)(m - SEQ) * DM, P.in[I_N1G], xn + (size_t)m * DM, C.lane);
        else { u32x4 z = {0u, 0u, 0u, 0u}; u32x4* o = (u32x4*)(xn + (size_t)m * DM); o[C.lane] = z; o[64 + C.lane] = z; }
    }
    const size_t gt = (size_t)C.bid * NTHR + C.tid, NT = (size_t)C.G * NTHR;
    for (int r = gw; r < 2 * 16384; r += NGW) {
        const bool isv = r >= 16384; const int row = isv ? r - 16384 : r;
        const f32x4* src = (const f32x4*)((isv ? P.in[I_PV] : P.in[I_PU]) + (size_t)row * DM) + C.lane;
        f32x4 v[4]; float m = 0.f;
#pragma unroll
        for (int j = 0; j < 4; ++j) { v[j] = src[64 * j]; m = fmaxf(m, fmaxf(fmaxf(fabsf(v[j].x), fabsf(v[j].y)), fmaxf(fabsf(v[j].z), fabsf(v[j].w)))); }
#pragma unroll
        for (int o = 1; o < 64; o <<= 1) m = fmaxf(m, __shfl_xor(m, o));
        const float sc = (m > 0.f) ? m * (1.0f / 127.0f) : 1.0f, inv = (m > 0.f) ? 127.0f / m : 0.f;
        const int off = isv ? 128 : 0;
        u32x4 w;
#pragma unroll
        for (int j = 0; j < 4; ++j) {
            const int q0 = (int)rintf(v[j].x * inv) + off, q1 = (int)rintf(v[j].y * inv) + off, q2 = (int)rintf(v[j].z * inv) + off, q3 = (int)rintf(v[j].w * inv) + off;
            w[j] = (u32)(q0 & 255) | ((u32)(q1 & 255) << 8) | ((u32)(q2 & 255) << 16) | ((u32)(q3 & 255) << 24);
        }
        *(u32x4*)(P.ws + (isv ? WS_PV : WS_PU) + (size_t)row * 1024 + 16 * C.lane) = w;
        if (C.lane == 0) ((float*)(P.ws + (isv ? WS_SV : WS_SU)))[row] = sc;
    }
    for (size_t i = gt; i < 262144 / 8; i += NT) cvt8(P.in[I_SUBK], (bf16_t*)(P.ws + WS_SUBK), i);
}

__device__ __forceinline__ bf16x8 u_frag(const bf16_t* proj, int ci, int j, int g, int half) {
    int row = 0; bool ok = true;
    if (ci == 0) { ok = (j >= 16); row = SEQ + j - 16; } else if (ci < NCH) row = (ci - 1) * 32 + j; else ok = false;
    bf16x8 z = {0, 0, 0, 0, 0, 0, 0, 0};
    if (!ok) return z;
    return *(const bf16x8*)(proj + (size_t)row * INW + O_U + g * 16 + half * 8);
}

__device__ __forceinline__ void phase_sloc(const Ctx& C, const Params& P) {
    const bf16_t* proj = (const bf16_t*)(P.ws + WS_PROJ);
    const bf16_t* Fall = (const bf16_t*)(P.ws + WS_F);
    float* SL = (float*)(P.ws + WS_SLOC);
    const int gw = C.bid * NWAVES + C.wave, NGW = C.G * NWAVES;
    const int n = C.lane & 15, kq = C.lane >> 4;
    for (int unit = gw; unit < 32 * 33; unit += NGW) {
        const int g = unit / 33, s = unit % 33, ci = 16 * s + n;
        bf16x8 Bf[16];
#pragma unroll
        for (int ks = 0; ks < 16; ++ks) Bf[ks] = u_frag(proj, ci, 2 * ks + (kq >> 1), g, kq & 1);
        const bf16_t* Fg = Fall + (size_t)g * 65536;
#pragma unroll 1
        for (int mt = 0; mt < 8; ++mt) {
            f32x4 acc = {0.f, 0.f, 0.f, 0.f};
#pragma unroll
            for (int ks = 0; ks < 16; ++ks) {
                const bf16x8 A = *(const bf16x8*)(Fg + (size_t)(mt * 16 + n) * 512 + 32 * ks + 8 * kq);
                acc = MFMA16(A, Bf[ks], acc);
            }
            if (ci < NCH) *(f32x4*)(SL + ((size_t)ci * 32 + g) * 128 + mt * 16 + 4 * kq) = acc;
        }
    }
}

__device__ __forceinline__ void carry_scan_block(const Ctx& C, const Params& P, int bk) {
    const float* SL = (const float*)(P.ws + WS_SLOC);
    float* CA = (float*)(P.ws + WS_CARRY);
    LAS float* Lr = (LAS float*)C.lds;
    LAS float* Li = Lr + 512;
    const int chan = bk * 32 + (C.tid & 31), g = chan >> 6, n = chan & 63, sg = C.tid >> 5;
    const float* abt = (const float*)(P.ws + WS_ABART) + (g * 64 + n) * 2;
    const float ar = abt[0], ai = abt[1];
    float sr = 0.f, si = 0.f;
#pragma unroll 8
    for (int i = 0; i < 32; ++i) {
        const int ci = 32 * sg + i; const size_t o = ((size_t)ci * 32 + g) * 128 + n;
        const float br = SL[o], bi = SL[o + 64];
        const float tr = ar * sr - ai * si + br, ti = ar * si + ai * sr + bi; sr = tr; si = ti;
    }
    Lr[sg * 32 + (C.tid & 31)] = sr; Li[sg * 32 + (C.tid & 31)] = si;
    float pr = ar, pi = ai;
#pragma unroll
    for (int k = 0; k < 5; ++k) { const float tr = pr * pr - pi * pi, ti = 2.f * pr * pi; pr = tr; pi = ti; }
    __syncthreads();
    float cr = 0.f, ci_ = 0.f;
    for (int s2 = 0; s2 < sg; ++s2) { const float lr = Lr[s2 * 32 + (C.tid & 31)], li = Li[s2 * 32 + (C.tid & 31)];
        const float tr = pr * cr - pi * ci_ + lr, ti = pr * ci_ + pi * cr + li; cr = tr; ci_ = ti; }
    sr = cr; si = ci_;
#pragma unroll 8
    for (int i = 0; i < 32; ++i) {
        const int ci = 32 * sg + i; const size_t o = ((size_t)ci * 32 + g) * 128 + n;
        CA[o] = sr; CA[o + 64] = si;
        const float br = SL[o], bi = SL[o + 64];
        const float tr = ar * sr - ai * si + br, ti = ar * si + ai * sr + bi; sr = tr; si = ti;
    }
    if (sg == 15) { const size_t o = ((size_t)512 * 32 + g) * 128 + n; CA[o] = sr; CA[o + 64] = si; }
    __syncthreads();
}

__device__ __forceinline__ void phase_ssm_y(const Ctx& C, const Params& P) {
    const bf16_t* proj = (const bf16_t*)(P.ws + WS_PROJ);
    const float* CA = (const float*)(P.ws + WS_CARRY);
    bf16_t* Z = (bf16_t*)(P.ws + WS_Z);
    const int n = C.lane & 15, kq = C.lane >> 4;
    for (int bu = C.bid; bu < 256; bu += C.G) {
        const int g = bu >> 3, cq = bu & 7;
        __syncthreads();
        { const u32x4* src = (const u32x4*)((const bf16_t*)(P.ws + WS_KT) + (size_t)g * 8448); LAS u32x4* dst = (LAS u32x4*)C.lds;
          for (int e = C.tid; e < 1056; e += NTHR) dst[e] = src[e]; }
        __syncthreads();
        const int ci = 1 + 64 * cq + 16 * (C.wave >> 1) + n, par = C.wave & 1;
        bf16x8 Uf[16], Cf[4];
#pragma unroll
        for (int ks = 0; ks < 16; ++ks) Uf[ks] = u_frag(proj, ci, 2 * ks + (kq >> 1), g, kq & 1);
#pragma unroll
        for (int k2 = 0; k2 < 4; ++k2) {
            const float* cp = CA + ((size_t)ci * 32 + g) * 128 + 32 * k2 + 8 * kq;
            const f32x4 a = *(const f32x4*)cp, b = *(const f32x4*)(cp + 4);
            u32x4 w; w.x = pk2(a.x, a.y); w.y = pk2(a.z, a.w); w.z = pk2(b.x, b.y); w.w = pk2(b.z, b.w);
            Cf[k2] = __builtin_bit_cast(bf16x8, w);
        }
        const bf16_t* Eg = (const bf16_t*)(P.ws + WS_E) + (size_t)g * 65536;
        const f32x4 dv = *(const f32x4*)(P.in[I_SD] + g * 16 + 4 * kq);
#pragma unroll 1
        for (int tt = 0; tt < 16; ++tt) {
            const int t = 2 * tt + par;
            f32x4 acc = {0.f, 0.f, 0.f, 0.f};
#pragma unroll
            for (int k2 = 0; k2 < 4; ++k2) {
                const bf16x8 A = *(const bf16x8*)(Eg + (size_t)(t * 16 + n) * 128 + 32 * k2 + 8 * kq);
                acc = MFMA16(A, Cf[k2], acc);
            }
#pragma unroll
            for (int ks = 0; ks < 16; ++ks) {
                if (ks <= tt) {
                    const int li = t - 2 * ks - (kq >> 1) + 1;
                    const bf16x8 A = *(const LAS bf16x8*)(C.lds + ((li * 16 + n) * 16 + 8 * (kq & 1)) * 2);
                    acc = MFMA16(A, Uf[ks], acc);
                }
            }
            const int row = (ci - 1) * 32 + t, ch = g * 16 + 4 * kq;
            const u32x2 uw = *(const u32x2*)(proj + (size_t)row * INW + O_U + ch);
            const float y0 = acc.x + dv.x * bflo(uw.x), y1 = acc.y + dv.y * bfhi(uw.x), y2 = acc.z + dv.z * bflo(uw.y), y3 = acc.w + dv.w * bfhi(uw.y);
            u32x2 o; o.x = pk2(gelu_erf(y0), gelu_erf(y1)); o.y = pk2(gelu_erf(y2), gelu_erf(y3));
            *(u32x2*)(Z + (size_t)row * 512 + ch) = o;
        }
    }
}

constexpr int VT_PITCH = 296;
__device__ __forceinline__ void attn_unit(const Ctx& C, const Params& P, int b, int hk) {
    const bf16_t* proj = (const bf16_t*)(P.ws + WS_PROJ);
    bf16_t* AO = (bf16_t*)(P.ws + WS_ATTN);
    LAS unsigned char* Ks = C.lds;
    LAS bf16_t* Vt = (LAS bf16_t*)(C.lds + 288 * 128);
    __syncthreads();
    for (int e = C.tid; e < 288 * 8; e += NTHR) {
        const int key = e >> 3, ch = e & 7;
        int row = -1;
        if (key < 256) { const int j = (b - 1) * 128 + key; if (j >= 0) row = j; } else if (key < 272) row = SEQ + key - 256;
        u32x4 kw = {0u, 0u, 0u, 0u}, vw = {0u, 0u, 0u, 0u};
        if (row >= 0) { kw = *(const u32x4*)(proj + (size_t)row * INW + O_K + hk * 64 + ch * 8); vw = *(const u32x4*)(proj + (size_t)row * INW + O_V + hk * 64 + ch * 8); }
        float kf[8] = {bflo(kw.x), bfhi(kw.x), bflo(kw.y), bfhi(kw.y), bflo(kw.z), bfhi(kw.z), bflo(kw.w), bfhi(kw.w)};
        float ss = 0.f;
#pragma unroll
        for (int i = 0; i < 8; ++i) ss += kf[i] * kf[i];
        ss += __shfl_xor(ss, 1); ss += __shfl_xor(ss, 2); ss += __shfl_xor(ss, 4);
        const float rinv = 1.0f / sqrtf(ss * (1.0f / 64.0f) + EPS);
        const f32x4 g0 = *(const f32x4*)(P.in[I_KNG] + ch * 8), g1 = *(const f32x4*)(P.in[I_KNG] + ch * 8 + 4);
        u32x4 o; o.x = pk2(kf[0] * rinv * g0.x, kf[1] * rinv * g0.y); o.y = pk2(kf[2] * rinv * g0.z, kf[3] * rinv * g0.w);
        o.z = pk2(kf[4] * rinv * g1.x, kf[5] * rinv * g1.y); o.w = pk2(kf[6] * rinv * g1.z, kf[7] * rinv * g1.w);
        *(LAS u32x4*)(Ks + key * 128 + ((ch ^ (key & 7)) * 16)) = o;
        const unsigned vv[4] = {vw.x, vw.y, vw.z, vw.w};
#pragma unroll
        for (int i = 0; i < 4; ++i) { Vt[(ch * 8 + 2 * i) * VT_PITCH + key] = (bf16_t)(vv[i] & 0xffffu); Vt[(ch * 8 + 2 * i + 1) * VT_PITCH + key] = (bf16_t)(vv[i] >> 16); }
    }
    __syncthreads();
    const int c = C.lane & 31, h = C.lane >> 5;
#pragma unroll 1
    for (int ti = C.wave; ti < 16; ti += NWAVES) {
        const int hql = ti >> 2, wq = ti & 3, hq = hk * 4 + hql;
        const int qi = wq * 32 + c, tok = b * 128 + qi;
        bf16x8 qf[4];
        {
            u32x4 qw[4]; float ss = 0.f;
#pragma unroll
            for (int ks = 0; ks < 4; ++ks) { qw[ks] = *(const u32x4*)(proj + (size_t)tok * INW + hq * 64 + 16 * ks + 8 * h);
                const unsigned w[4] = {qw[ks].x, qw[ks].y, qw[ks].z, qw[ks].w};
#pragma unroll
                for (int i = 0; i < 4; ++i) { const float a = bflo(w[i]), bb = bfhi(w[i]); ss += a * a + bb * bb; } }
            ss += __shfl_xor(ss, 32);
            const float rinv = (1.0f / sqrtf(ss * (1.0f / 64.0f) + EPS)) * (0.125f * LOG2E);
#pragma unroll
            for (int ks = 0; ks < 4; ++ks) {
                const f32x4 g0 = *(const f32x4*)(P.in[I_QNG] + 16 * ks + 8 * h), g1 = *(const f32x4*)(P.in[I_QNG] + 16 * ks + 8 * h + 4);
                u32x4 o; o.x = pk2(bflo(qw[ks].x) * rinv * g0.x, bfhi(qw[ks].x) * rinv * g0.y); o.y = pk2(bflo(qw[ks].y) * rinv * g0.z, bfhi(qw[ks].y) * rinv * g0.w);
                o.z = pk2(bflo(qw[ks].z) * rinv * g1.x, bfhi(qw[ks].z) * rinv * g1.y); o.w = pk2(bflo(qw[ks].w) * rinv * g1.z, bfhi(qw[ks].w) * rinv * g1.w);
                qf[ks] = __builtin_bit_cast(bf16x8, o);
            }
        }
        f32x16 S[6];
#pragma unroll
        for (int rb = 0; rb < 6; ++rb) {
            const int kb = (rb < 5) ? (wq + rb) : 8;
            const int key = kb * 32 + c;
            f32x16 acc = {0.f, 0.f, 0.f, 0.f, 0.f, 0.f, 0.f, 0.f, 0.f, 0.f, 0.f, 0.f, 0.f, 0.f, 0.f, 0.f};
#pragma unroll
            for (int ks = 0; ks < 4; ++ks) {
                const bf16x8 A = *(const LAS bf16x8*)(Ks + key * 128 + (((2 * ks + h) ^ (key & 7)) * 16));
                acc = MFMA32(A, qf[ks], acc);
            }
            S[rb] = acc;
            __builtin_amdgcn_sched_barrier(0);
        }
        const float sl = P.in[I_SINK][hq] * LOG2E;
        float mx = sl;
#pragma unroll
        for (int r = 0; r < 16; ++r) {
            const int kr = (r & 3) + 8 * (r >> 2) + 4 * h;
            const bool gt = kr > c;
            S[0][r] = gt ? S[0][r] : -1e30f;
            S[4][r] = gt ? -1e30f : S[4][r];
            if (r >= 8) S[5][r] = -1e30f;
        }
        if (b == 0) {
#pragma unroll
            for (int rb = 0; rb < 4; ++rb) if (wq + rb < 4) {
#pragma unroll
                for (int r = 0; r < 16; ++r) S[rb][r] = -1e30f;
            }
        }
#pragma unroll
        for (int rb = 0; rb < 6; ++rb)
#pragma unroll
            for (int r = 0; r < 16; ++r) mx = fmaxf(mx, S[rb][r]);
        mx = fmaxf(mx, __shfl_xor(mx, 32));
        float lsum = 0.f;
#pragma unroll
        for (int rb = 0; rb < 6; ++rb)
#pragma unroll
            for (int r = 0; r < 16; ++r) { const float p = exp2f(S[rb][r] - mx); S[rb][r] = p; lsum += p; }
        lsum += __shfl_xor(lsum, 32);
        lsum += exp2f(sl - mx);
        const float linv = 1.0f / lsum;
        f32x16 O[2];
#pragma unroll
        for (int db = 0; db < 2; ++db) O[db] = (f32x16){0.f, 0.f, 0.f, 0.f, 0.f, 0.f, 0.f, 0.f, 0.f, 0.f, 0.f, 0.f, 0.f, 0.f, 0.f, 0.f};
#pragma unroll
        for (int rb = 0; rb < 6; ++rb) {
            const int kb = (rb < 5) ? (wq + rb) : 8;
#pragma unroll
            for (int s = 0; s < 2; ++s) {
                if (rb == 5 && s == 1) continue;
                u32x4 pw; pw.x = pk2(S[rb][8 * s + 0], S[rb][8 * s + 1]); pw.y = pk2(S[rb][8 * s + 2], S[rb][8 * s + 3]);
                pw.z = pk2(S[rb][8 * s + 4], S[rb][8 * s + 5]); pw.w = pk2(S[rb][8 * s + 6], S[rb][8 * s + 7]);
                const bf16x8 Pf = __builtin_bit_cast(bf16x8, pw);
#pragma unroll
                for (int db = 0; db < 2; ++db) {
                    const LAS bf16_t* vp = Vt + (db * 32 + c) * VT_PITCH + kb * 32 + 16 * s + 4 * h;
                    const u32x2 lo = *(const LAS u32x2*)vp, hi2 = *(const LAS u32x2*)(vp + 8);
                    u32x4 vw; vw.x = lo.x; vw.y = lo.y; vw.z = hi2.x; vw.w = hi2.y;
                    O[db] = MFMA32(__builtin_bit_cast(bf16x8, vw), Pf, O[db]);
                }
                __builtin_amdgcn_sched_barrier(0);
            }
        }
#pragma unroll
        for (int db = 0; db < 2; ++db)
#pragma unroll
            for (int gq = 0; gq < 4; ++gq) {
                u32x2 o; o.x = pk2(O[db][4 * gq] * linv, O[db][4 * gq + 1] * linv); o.y = pk2(O[db][4 * gq + 2] * linv, O[db][4 * gq + 3] * linv);
                *(u32x2*)(AO + (size_t)tok * 512 + hq * 64 + db * 32 + 8 * gq + 4 * h) = o;
            }
    }
}

struct EpiGlu {
    static constexpr bool PERM = true, AFTER_DRAIN = false;
    const bf16_t* Z; bf16_t* O; const float* bias;
    __device__ __forceinline__ void operator()(const pg8::f32x4 (&acc)[2][2][4][2], const pg8::Unit& u, int wr, int wc, int fr, int fq) const {
        const int row0 = u.pm * 256 + wr * 64 + fr, col0 = u.pn * 256 + wc * 32 + 8 * fq;
#pragma unroll
        for (int ai = 0; ai < 2; ++ai)
#pragma unroll
            for (int m = 0; m < 4; ++m)
#pragma unroll
                for (int bj = 0; bj < 2; ++bj) {
                    const size_t off = (size_t)(row0 + ai * 128 + m * 16) * 512 + col0 + bj * 128;
                    const u32x4 zw = *(const u32x4*)(Z + off);
                    const f32x4 b0 = *(const f32x4*)(bias + col0 + bj * 128), b1 = *(const f32x4*)(bias + col0 + bj * 128 + 4);
                    const pg8::f32x4 v0 = acc[ai][bj][m][0], v1 = acc[ai][bj][m][1];
                    const float zf[8] = {bflo(zw.x), bfhi(zw.x), bflo(zw.y), bfhi(zw.y), bflo(zw.z), bfhi(zw.z), bflo(zw.w), bfhi(zw.w)};
                    const float pre[8] = {v0[0] + b0.x, v0[1] + b0.y, v0[2] + b0.z, v0[3] + b0.w, v1[0] + b1.x, v1[1] + b1.y, v1[2] + b1.z, v1[3] + b1.w};
                    float r[8];
#pragma unroll
                    for (int i = 0; i < 8; ++i) r[i] = zf[i] / (1.0f + __expf(-pre[i]));
                    u32x4 o; o.x = pk2(r[0], r[1]); o.y = pk2(r[2], r[3]); o.z = pk2(r[4], r[5]); o.w = pk2(r[6], r[7]);
                    *(u32x4*)(O + off) = o;
                }
    }
};
struct EpiRes {
    static constexpr bool PERM = false, AFTER_DRAIN = false;
    const float* base; float* out;
    __device__ __forceinline__ void operator()(const pg8::f32x4 (&acc)[2][2][4][2], const pg8::Unit& u, int wr, int wc, int fr, int fq) const {
        const int col0 = u.pn * 256 + wc * 32 + 4 * fq;
#pragma unroll
        for (int ai = 0; ai < 2; ++ai)
#pragma unroll
            for (int m = 0; m < 4; ++m) {
                const size_t off = (size_t)(u.pm * 256 + ai * 128 + wr * 64 + m * 16 + fr) * 1024 + col0;
#pragma unroll
                for (int bj = 0; bj < 2; ++bj)
#pragma unroll
                    for (int n = 0; n < 2; ++n) {
                        const f32x4 bs = *(const f32x4*)(base + off + bj * 128 + n * 16);
                        const pg8::f32x4 a = acc[ai][bj][m][n];
                        f32x4 o; o.x = bs.x + a[0]; o.y = bs.y + a[1]; o.z = bs.z + a[2]; o.w = bs.w + a[3];
                        *(f32x4*)(out + off + bj * 128 + n * 16) = o;
                    }
            }
    }
};

__device__ __forceinline__ void phase_mix_norm(const Ctx& C, const Params& P) {
    const bf16_t* AO = (const bf16_t*)(P.ws + WS_ATTN); const bf16_t* SO = (const bf16_t*)(P.ws + WS_SSMO);
    bf16_t* MX = (bf16_t*)(P.ws + WS_BUFA);
    const int gw = C.bid * NWAVES + C.wave, NGW = C.G * NWAVES;
    for (int m = gw; m < SEQ; m += NGW) {
#pragma unroll
        for (int part = 0; part < 2; ++part) {
            const bf16_t* src = (part ? SO : AO) + (size_t)m * 512 + 8 * C.lane;
            const float* gam = P.in[part ? I_SOG : I_AOG] + 8 * C.lane;
            const u32x4 w = *(const u32x4*)src;
            const float f[8] = {bflo(w.x), bfhi(w.x), bflo(w.y), bfhi(w.y), bflo(w.z), bfhi(w.z), bflo(w.w), bfhi(w.w)};
            float ss = 0.f;
#pragma unroll
            for (int i = 0; i < 8; ++i) ss += f[i] * f[i];
            const float rinv = 1.0f / sqrtf(wave_sum(ss) * (1.0f / 512.0f) + EPS);
            const f32x4 g0 = *(const f32x4*)gam, g1 = *(const f32x4*)(gam + 4);
            u32x4 o; o.x = pk2(f[0] * rinv * g0.x, f[1] * rinv * g0.y); o.y = pk2(f[2] * rinv * g0.z, f[3] * rinv * g0.w);
            o.z = pk2(f[4] * rinv * g1.x, f[5] * rinv * g1.y); o.w = pk2(f[6] * rinv * g1.z, f[7] * rinv * g1.w);
            *(u32x4*)(MX + (size_t)m * DM + part * 512 + 8 * C.lane) = o;
        }
    }
}
__device__ __forceinline__ void phase_norm2(const Ctx& C, const Params& P) {
    bf16_t* HN = (bf16_t*)(P.ws + WS_BUFA);
    const int gw = C.bid * NWAVES + C.wave, NGW = C.G * NWAVES;
    for (int m = gw; m < SEQ; m += NGW) norm_row_to_bf16(P.out + (size_t)m * DM, P.in[I_N2G], HN + (size_t)m * DM, C.lane);
}

__device__ __forceinline__ void peer_topk_tile(const Ctx& C, const Params& P, int tok0) {
    const bf16_t* QP = (const bf16_t*)(P.ws + WS_QP);
    const bf16_t* SK = (const bf16_t*)(P.ws + WS_SUBK);
    int* IDX = (int*)(P.ws + WS_IDX); float* GW = (float*)(P.ws + WS_GW);
    LAS u32* lists = (LAS u32*)C.lds;
    const int c = C.lane & 31, h = C.lane >> 5;
    __syncthreads();
#pragma unroll 1
    for (int task = C.wave; task < 32; task += NWAVES) {
        const int tgp = task & 1, hs = task >> 1;
        const int tl = tgp * 32 + c;
        const bf16_t* qrow = QP + (size_t)(tok0 + tl) * 2048 + hs * 128;
        bf16x8 qf[8];
#pragma unroll
        for (int ks = 0; ks < 8; ++ks) qf[ks] = *(const bf16x8*)(qrow + 16 * ks + 8 * h);
        u32 g[4][16];
#pragma unroll
        for (int kb = 0; kb < 4; ++kb) {
            f32x16 acc = {0.f, 0.f, 0.f, 0.f, 0.f, 0.f, 0.f, 0.f, 0.f, 0.f, 0.f, 0.f, 0.f, 0.f, 0.f, 0.f};
            const bf16_t* krow = SK + (size_t)(hs * 128 + kb * 32 + c) * 128;
#pragma unroll
            for (int ks = 0; ks < 8; ++ks) acc = MFMA32(*(const bf16x8*)(krow + 16 * ks + 8 * h), qf[ks], acc);
#pragma unroll
            for (int r = 0; r < 16; ++r) { const int key = kb * 32 + (r & 3) + 8 * (r >> 2) + 4 * h; g[kb][r] = (f2ord(acc[r]) & ~0x7Fu) | (u32)(127 - key); }
        }
        top16_of_64(g[0], g[1], g[2], g[3]);
        u32 pb[16];
#pragma unroll
        for (int i = 0; i < 16; ++i) pb[i] = (u32)__shfl_xor((int)g[0][i], 32);
        merge_top16(g[0], pb);
        if (h == 0) {
            LAS u32x4* dst = (LAS u32x4*)(lists + (tl * 16 + hs) * 16);
#pragma unroll
            for (int i = 0; i < 4; ++i) { u32x4 w; w.x = g[0][4 * i]; w.y = g[0][4 * i + 1]; w.z = g[0][4 * i + 2]; w.w = g[0][4 * i + 3]; dst[i] = w; }
        }
    }
    __syncthreads();
    {
        const int tl = C.tid & 63, hd = C.tid >> 6;
        const LAS u32* L1 = lists + (tl * 16 + hd * 2) * 16; const LAS u32* L2 = L1 + 16;
        float v1[16], v2[16];
#pragma unroll
        for (int i = 0; i < 16; ++i) { v1[i] = ord2f(L1[i] & ~0x7Fu); v2[i] = ord2f(L2[i] & ~0x7Fu); }
        u32 cd[4][16];
        { int cid = 0;
#pragma unroll
          for (int a = 0; a < 16; ++a)
#pragma unroll
              for (int b = 0; b < 16; ++b) if ((a + 1) * (b + 1) <= 16) { cd[cid >> 4][cid & 15] = (f2ord(v1[a] + v2[b]) & ~0x3Fu) | (u32)(63 - cid); ++cid; }
#pragma unroll
          for (int k = 50; k < 64; ++k) cd[k >> 4][k & 15] = 0u; }
        top16_of_64(cd[0], cd[1], cd[2], cd[3]);
        float sc[16]; int ix[16]; float mx = -1e30f;
#pragma unroll
        for (int k = 0; k < 16; ++k) {
            const int cid = 63 - (int)(cd[0][k] & 63u); const int ab = CAND_AB[cid];
            const u32 k1 = L1[ab >> 4], k2 = L2[ab & 15];
            sc[k] = ord2f(k1 & ~0x7Fu) + ord2f(k2 & ~0x7Fu);
            ix[k] = (127 - (int)(k1 & 0x7Fu)) * 128 + (127 - (int)(k2 & 0x7Fu));
            mx = fmaxf(mx, sc[k]);
        }
        float sum = 0.f;
#pragma unroll
        for (int k = 0; k < 16; ++k) { sc[k] = __expf(sc[k] - mx); sum += sc[k]; }
        const float inv = 1.0f / sum;
        int* io = IDX + (size_t)(tok0 + tl) * 128 + hd * 16; float* go = GW + (size_t)(tok0 + tl) * 128 + hd * 16;
#pragma unroll
        for (int k = 0; k < 16; k += 4) {
            *(int4*)(io + k) = make_int4(ix[k], ix[k + 1], ix[k + 2], ix[k + 3]);
            f32x4 gv = {sc[k] * inv, sc[k + 1] * inv, sc[k + 2] * inv, sc[k + 3] * inv}; *(f32x4*)(go + k) = gv;
        }
    }
    __syncthreads();
}

__device__ __forceinline__ int reduce64(int (&r)[64], int lane) {
#pragma unroll
    for (int e = 0; e < 32; ++e) { const auto p = __builtin_amdgcn_permlane32_swap((u32)r[e], (u32)r[e + 32], false, false); r[e] = (int)p[0] + (int)p[1]; }
#pragma unroll
    for (int e = 0; e < 16; ++e) { const auto p = __builtin_amdgcn_permlane16_swap((u32)r[e], (u32)r[e + 16], false, false); r[e] = (int)p[0] + (int)p[1]; }
    const bool b3 = (lane & 8) != 0, b2 = (lane & 4) != 0, b1 = (lane & 2) != 0, b0 = (lane & 1) != 0;
#pragma unroll
    for (int e = 0; e < 8; ++e) { const int keep = b3 ? r[e + 8] : r[e], send = b3 ? r[e] : r[e + 8]; r[e] = keep + __builtin_amdgcn_update_dpp(0, send, 0x128, 0xf, 0xf, true); }
#pragma unroll
    for (int e = 0; e < 4; ++e) { const int keep = b2 ? r[e + 4] : r[e], send = b2 ? r[e] : r[e + 4];
        int t = __builtin_amdgcn_update_dpp(0, send, 0x104, 0xf, 0x5, false);
        t = __builtin_amdgcn_update_dpp(t, send, 0x114, 0xf, 0xA, false);
        r[e] = keep + t; }
#pragma unroll
    for (int e = 0; e < 2; ++e) { const int keep = b1 ? r[e + 2] : r[e], send = b1 ? r[e] : r[e + 2]; r[e] = keep + __builtin_amdgcn_update_dpp(0, send, 0x4E, 0xf, 0xf, true); }
    { const int keep = b0 ? r[1] : r[0], send = b0 ? r[0] : r[1]; r[0] = keep + __builtin_amdgcn_update_dpp(0, send, 0xB1, 0xf, 0xf, true); }
    return r[0];
}
__device__ __forceinline__ void peer_gather_tile(const Ctx& C, const Params& P, int tok0, float osc = 1.0f) {
    const bf16_t* HN = (const bf16_t*)(P.ws + WS_BUFA);
    const unsigned char* PU = P.ws + WS_PU; const unsigned char* PV = P.ws + WS_PV;
    const float* SU = (const float*)(P.ws + WS_SU); const float* SV = (const float*)(P.ws + WS_SV);
    const int* IDX = (const int*)(P.ws + WS_IDX); const float* GW = (const float*)(P.ws + WS_GW);
    const int lane = C.lane;
#pragma unroll 1
    for (int i = 0; i < 8; ++i) {
        const int tok = tok0 + C.wave * 8 + i;
        int idx[2]; float gwt[2];
        idx[0] = IDX[(size_t)tok * 128 + lane]; idx[1] = IDX[(size_t)tok * 128 + 64 + lane];
        gwt[0] = GW[(size_t)tok * 128 + lane]; gwt[1] = GW[(size_t)tok * 128 + 64 + lane];
        int qh[4]; float sh;
        {
            float hf[16]; float m = 0.f;
#pragma unroll
            for (int j = 0; j < 4; ++j) { const u32x2 w = *(const u32x2*)(HN + (size_t)tok * DM + 256 * j + 4 * lane);
                hf[4 * j] = bflo(w.x); hf[4 * j + 1] = bfhi(w.x); hf[4 * j + 2] = bflo(w.y); hf[4 * j + 3] = bfhi(w.y); }
#pragma unroll
            for (int d = 0; d < 16; ++d) m = fmaxf(m, fabsf(hf[d]));
#pragma unroll
            for (int o = 1; o < 64; o <<= 1) m = fmaxf(m, __shfl_xor(m, o));
            sh = (m > 0.f) ? m * (1.0f / 127.0f) : 1.0f; const float inv = (m > 0.f) ? 127.0f / m : 0.f;
#pragma unroll
            for (int j = 0; j < 4; ++j) {
                const int q0 = (int)rintf(hf[4 * j] * inv), q1 = (int)rintf(hf[4 * j + 1] * inv), q2 = (int)rintf(hf[4 * j + 2] * inv), q3 = (int)rintf(hf[4 * j + 3] * inv);
                qh[j] = (int)((u32)(q0 & 255) | ((u32)(q1 & 255) << 8) | ((u32)(q2 & 255) << 16) | ((u32)(q3 & 255) << 24));
            }
        }
        float cc[2];
#pragma unroll
        for (int hb = 0; hb < 2; ++hb) {
            int r[64];
#pragma unroll
            for (int e = 0; e < 64; ++e) {
                const int ridx = __builtin_amdgcn_readlane(idx[hb], e);
                const u32x4 w = *(const u32x4*)(PU + (size_t)ridx * 1024 + 16 * lane);
                int a = __builtin_amdgcn_sdot4((int)w.x, qh[0], 0, false);
                a = __builtin_amdgcn_sdot4((int)w.y, qh[1], a, false);
                a = __builtin_amdgcn_sdot4((int)w.z, qh[2], a, false);
                a = __builtin_amdgcn_sdot4((int)w.w, qh[3], a, false);
                r[e] = a;
            }
            const int isum = reduce64(r, lane);
            const float z = (float)isum * SU[idx[hb]] * sh;
            cc[hb] = gelu_erf(z) * gwt[hb] * SV[idx[hb]];
        }
        const float csum = wave_sum(cc[0] + cc[1]);
        float acc[16];
#pragma unroll
        for (int d = 0; d < 16; ++d) acc[d] = 0.f;
#pragma unroll
        for (int hb = 0; hb < 2; ++hb) {
#pragma unroll 1
            for (int e0 = 0; e0 < 64; e0 += 16) {
#pragma unroll
                for (int k = 0; k < 16; ++k) {
                    const int ridx = __builtin_amdgcn_readlane(idx[hb], e0 + k);
                    const float ce = __uint_as_float((u32)__builtin_amdgcn_readlane((int)__float_as_uint(cc[hb]), e0 + k));
                    const u32x4 w = *(const u32x4*)(PV + (size_t)ridx * 1024 + 16 * lane);
#pragma unroll
                    for (int j = 0; j < 4; ++j) {
                        acc[4 * j + 0] += ce * (float)(w[j] & 0xffu); acc[4 * j + 1] += ce * (float)((w[j] >> 8) & 0xffu);
                        acc[4 * j + 2] += ce * (float)((w[j] >> 16) & 0xffu); acc[4 * j + 3] += ce * (float)(w[j] >> 24);
                    }
                }
            }
        }
        float* orow = P.out + (size_t)tok * DM;
        const float corr = 128.0f * csum;
#pragma unroll
        for (int j = 0; j < 4; ++j) {
            f32x4* p = (f32x4*)(orow + 256 * j + 4 * lane);
            f32x4 v = *p; v.x += osc * (acc[4 * j] - corr); v.y += osc * (acc[4 * j + 1] - corr); v.z += osc * (acc[4 * j + 2] - corr); v.w += osc * (acc[4 * j + 3] - corr); *p = v;
        }
    }
}

#define GAS __attribute__((address_space(1)))
typedef GAS unsigned gu32;
#define RLX_AGENT __ATOMIC_RELAXED, __HIP_MEMORY_SCOPE_AGENT
#define XB_TMO      128
#define XB_XCNT(j)  (256  + 64 * (j))
#define XB_XSUB(j)  (1280 + 64 * (j))
#define XB_XGEN(j)  (2304 + 64 * (j))
#define XB_TOP      3328
#define XB_TOPGEN   3392
#define XCD_BAR_WORDS 3456
#define XB_SPIN_CAP (1u << 18)

__device__ __forceinline__ unsigned xb_ld(unsigned* p)              { return __hip_atomic_load(p, __ATOMIC_RELAXED, __HIP_MEMORY_SCOPE_AGENT); }
__device__ __forceinline__ unsigned xb_add(unsigned* p, unsigned v) { return __hip_atomic_fetch_add(p, v, __ATOMIC_RELAXED, __HIP_MEMORY_SCOPE_AGENT); }
__device__ __forceinline__ unsigned xb_xcc_id() { return (unsigned)__builtin_amdgcn_s_getreg((3 << 11) | 20) & 0xFu; }
#define XB_SPIN(cond, bar) do { unsigned _sp = 0; while (cond) { __builtin_amdgcn_s_sleep(1); \
    if ((++_sp & 255u) == 0u) { if (xb_ld(&(bar)[XB_TMO])) break; if (_sp > XB_SPIN_CAP) { atomicAdd(&(bar)[XB_TMO], 1u); break; } } } } while (0)

struct XcdBarrier {
    unsigned* bar; unsigned x;
    volatile LAS unsigned* st;
};

__device__ __forceinline__ XcdBarrier xcd_barrier_post(unsigned* bar, volatile LAS unsigned* st) {
    XcdBarrier b; b.bar = bar; b.x = xb_xcc_id(); b.st = st;
    if (threadIdx.x == 0) (void)xb_add(&bar[XB_XCNT(b.x)], 1u);
    return b;
}
__device__ __forceinline__ void xcd_barrier_complete(unsigned* bar, unsigned x, unsigned& nloc, unsigned& nx) {
    const unsigned G = gridDim.x * gridDim.y * gridDim.z;
    unsigned sum, cnt, mine, sp = 0u;
    for (;;) {
        sum = 0u; cnt = 0u; mine = 0u;
#pragma unroll
        for (unsigned j = 0; j < 16; ++j) { const unsigned c = xb_ld(&bar[XB_XCNT(j)]); sum += c; cnt += (c > 0u) ? 1u : 0u; mine = (j == x) ? c : mine; }
        if (sum == G) break;
        __builtin_amdgcn_s_sleep(1);
        if ((++sp & 255u) == 0u) { if (xb_ld(&bar[XB_TMO])) break; if (sp > XB_SPIN_CAP) { atomicAdd(&bar[XB_TMO], 1u); break; } }
    }
    nloc = mine > 0u ? mine : 1u; nx = cnt > 0u ? cnt : 1u;
}

__device__ __forceinline__ void xcd_barrier(const XcdBarrier& b) {
    asm volatile("s_waitcnt vmcnt(0)" ::: "memory");
    __syncthreads();
    if (threadIdx.x == 0) {
        unsigned* bar = b.bar;
        __builtin_amdgcn_s_waitcnt(0);
        unsigned nloc = b.st[0], nx = b.st[1];
        if (nloc == 0u) { xcd_barrier_complete(bar, b.x, nloc, nx); b.st[0] = nloc; b.st[1] = nx; }
        const unsigned old = xb_add(&bar[XB_XSUB(b.x)], 1u);
        const unsigned gen = old / nloc;
        if (old + 1u == (gen + 1u) * nloc) {
            __builtin_amdgcn_fence(__ATOMIC_RELEASE, "agent");
            asm volatile("s_waitcnt vmcnt(0)" ::: "memory");
            const unsigned og = xb_add(&bar[XB_TOP], 1u);
            const unsigned tg = og / nx;
            if (og + 1u == (tg + 1u) * nx) xb_add(&bar[XB_TOPGEN], 1u);
            else XB_SPIN(xb_ld(&bar[XB_TOPGEN]) == tg, bar);
            __builtin_amdgcn_fence(__ATOMIC_ACQUIRE, "agent");
            xb_add(&bar[XB_XGEN(b.x)], 1u);
            asm volatile("s_waitcnt vmcnt(0)" ::: "memory");
        } else {
            XB_SPIN(xb_ld(&bar[XB_XGEN(b.x)]) == gen, bar);
            __builtin_amdgcn_fence(__ATOMIC_ACQUIRE, "agent");
            asm volatile("s_waitcnt vmcnt(0)" ::: "memory");
        }
    }
    __syncthreads();
}

constexpr int NPHASE = 11;
__global__ void __launch_bounds__(NTHR, 2) mk_fwd(Params P) {
    extern __shared__ __attribute__((aligned(16))) unsigned char lds_raw[];
    Ctx C; C.lds = (LAS unsigned char*)lds_raw; C.tid = threadIdx.x; C.lane = C.tid & 63; C.wave = __builtin_amdgcn_readfirstlane(C.tid >> 6); C.G = gridDim.x; C.bid = blockIdx.x;
    unsigned char* ws = P.ws;
    volatile LAS unsigned* MISC = (volatile LAS unsigned*)(C.lds + 131072 + 320);
    if (C.tid < 32) MISC[C.tid] = 0u;
    __syncthreads();
    XcdBarrier bar = xcd_barrier_post((unsigned*)(ws + WS_CTL) + 4096, MISC + 8);
#define SEAM(k) do { if (IN(k) && IN((k) + 1)) xcd_barrier(bar); } while (0)
#ifndef REPMASK
#define REPMASK 0
#endif
#define NREP(k) (((REPMASK >> (k)) & 1) ? 2 : 1)
#ifdef ONLY_PHASE
#define IN(k) ((k) == ONLY_PHASE && P.ph_lo <= (k) && (k) < P.ph_hi)
#else
#define IN(k) (P.ph_lo <= (k) && (k) < P.ph_hi)
#endif
    for (int rep_ = 0; rep_ < NREP(0); ++rep_) { if (rep_) xcd_barrier(bar); if (IN(0)) phase_prologue(C, P); }
    SEAM(0);
    for (int rep_ = 0; rep_ < NREP(1); ++rep_) { if (rep_) xcd_barrier(bar);
    if (IN(1)) {
        pg8::Gemm g{(const bf16_t*)(ws + WS_BUFA), (const bf16_t*)(ws + WS_WIN_T), MPAD, INW, DM}; pg8::StaticOrder S; S.init(MPAD, INW, C.G, C.bid);
        pg8::EpiBf16<0> E{(bf16_t*)(ws + WS_PROJ), INW, nullptr, 0, 0, 1.f};
        pg8::gemm_phase<pg8::EpiBf16<0>, pg8::StaticOrder, true, true>(C.lds, g, S, E);
    }
    }
    SEAM(1);
    for (int rep_ = 0; rep_ < NREP(2); ++rep_) { if (rep_) xcd_barrier(bar); if (IN(2)) phase_sloc(C, P); }
    SEAM(2);
    for (int rep_ = 0; rep_ < NREP(3); ++rep_) { if (rep_) xcd_barrier(bar);
    if (IN(3)) {
        for (int bk = C.bid; bk < 64; bk += C.G) carry_scan_block(C, P, bk);
        for (int u = C.bid; u < 256; u += C.G) attn_unit(C, P, u >> 1, u & 1);
    }
    }
    SEAM(3);
    for (int rep_ = 0; rep_ < NREP(4); ++rep_) { if (rep_) xcd_barrier(bar); if (IN(4)) phase_ssm_y(C, P); }
    SEAM(4);
    for (int rep_ = 0; rep_ < NREP(5); ++rep_) { if (rep_) xcd_barrier(bar);
    if (IN(5)) {
        pg8::Gemm g{(const bf16_t*)(ws + WS_Z), (const bf16_t*)(ws + WS_GLU_T), SEQ, 512, 512}; pg8::StaticOrder S; S.init(SEQ, 512, C.G, C.bid);
        EpiGlu E{(const bf16_t*)(ws + WS_Z), (bf16_t*)(ws + WS_SSMO), P.in[I_GLUB]};
        pg8::gemm_phase<EpiGlu, pg8::StaticOrder, true, true>(C.lds, g, S, E);
    }
    }
    SEAM(5);
    for (int rep_ = 0; rep_ < NREP(6); ++rep_) { if (rep_) xcd_barrier(bar); if (IN(6)) phase_mix_norm(C, P); }
    SEAM(6);
    for (int rep_ = 0; rep_ < NREP(7); ++rep_) { if (rep_) xcd_barrier(bar);
    if (IN(7)) {
        pg8::Gemm g{(const bf16_t*)(ws + WS_BUFA), (const bf16_t*)(ws + WS_WOUT_T), SEQ, DM, DM}; pg8::StaticOrder S; S.init(SEQ, DM, C.G, C.bid);
        EpiRes E{P.in[I_X], P.out};
        pg8::gemm_phase<EpiRes, pg8::StaticOrder, true, true>(C.lds, g, S, E);
    }
    }
    SEAM(7);
    for (int rep_ = 0; rep_ < NREP(8); ++rep_) { if (rep_) xcd_barrier(bar); if (IN(8)) phase_norm2(C, P); }
    SEAM(8);
    for (int rep_ = 0; rep_ < NREP(9); ++rep_) { if (rep_) xcd_barrier(bar);
    if (IN(9)) {
        pg8::Gemm g{(const bf16_t*)(ws + WS_BUFA), (const bf16_t*)(ws + WS_WQ_T), SEQ, 2048, DM}; pg8::StaticOrder S; S.init(SEQ, 2048, C.G, C.bid);
        pg8::EpiBf16<0> E{(bf16_t*)(ws + WS_QP), 2048, nullptr, 0, 0, 1.f};
        pg8::gemm_phase<pg8::EpiBf16<0>, pg8::StaticOrder, true, true>(C.lds, g, S, E);
    }
    }
    SEAM(9);
    for (int rep_ = 0; rep_ < NREP(10); ++rep_) { if (rep_) xcd_barrier(bar);
    if (IN(10)) {
        for (int tile = C.bid; tile < SEQ / 64; tile += C.G) {
            peer_topk_tile(C, P, tile * 64);
            if ((REPMASK >> 11) & 1) peer_topk_tile(C, P, tile * 64);
            if ((REPMASK >> 12) & 1) peer_gather_tile(C, P, tile * 64, P.zero);
            peer_gather_tile(C, P, tile * 64, P.one);
        }
    }
    }
#undef IN
#undef SEAM
}
}

extern "C" void kernel_launch(void* const* d_in, const int* in_sizes, int n_in, void* d_out, int out_size, void* d_ws, size_t ws_size, hipStream_t stream) {
    static int state = 0, grid = 0;
    if (state == 0) {
        if (n_in != 25 || out_size != mk::SEQ * mk::DM || ws_size < mk::WS_END) { fprintf(stderr, "kernel_launch: unexpected shapes (n_in %d out %d ws %zu)\n", n_in, out_size, ws_size); state = -1; return; }
        if (hipFuncSetAttribute((const void*)mk::mk_fwd, hipFuncAttributeMaxDynamicSharedMemorySize, mk::LDS_BYTES) != hipSuccess) { fprintf(stderr, "kernel_launch: hipFuncSetAttribute failed\n"); state = -1; return; }
        int dev = 0, cus = 0, per_cu = 0;
        if (hipGetDevice(&dev) != hipSuccess || hipDeviceGetAttribute(&cus, hipDeviceAttributeMultiprocessorCount, dev) != hipSuccess) { fprintf(stderr, "kernel_launch: device query failed\n"); state = -1; return; }
        if (hipOccupancyMaxActiveBlocksPerMultiprocessor(&per_cu, (const void*)mk::mk_fwd, mk::NTHR, mk::LDS_BYTES) != hipSuccess || per_cu < 1) { fprintf(stderr, "kernel_launch: occupancy query failed (%d)\n", per_cu); state = -1; return; }
        grid = cus;
        state = 1;
    }
    if (state < 0) return;
    mk::Params p{};
    for (int i = 0; i < 25; ++i) p.in[i] = (const float*)d_in[i];
    p.out = (float*)d_out; p.ws = (unsigned char*)d_ws;
    if (hipMemsetAsync((char*)d_ws + mk::WS_CTL, 0, 65536, stream) != hipSuccess) { fprintf(stderr, "kernel_launch: memset failed\n"); return; }
    p.ph_lo = 0; p.ph_hi = mk::NPHASE; p.one = 1.0f; p.zero = 0.0f;
    void* args[] = {&p};
    hipError_t e = hipLaunchCooperativeKernel((const void*)mk::mk_fwd, dim3(grid), dim3(mk::NTHR), args, mk::LDS_BYTES, stream);
    if (e != hipSuccess) fprintf(stderr, "kernel_launch: cooperative launch failed: %s (grid %d)\n", hipGetErrorString(e), grid);
}
```

```cpp
#include <hip/hip_runtime.h>
#include <cstdio>
#include <cstdint>
#include <cmath>
namespace pg8 {
#define PG8_LAS __attribute__((address_space(3)))
typedef unsigned short bf16_t;
typedef short bf16x8 __attribute__((ext_vector_type(8)));
typedef float f32x4 __attribute__((ext_vector_type(4)));
typedef unsigned u32x4 __attribute__((ext_vector_type(4)));
constexpr int BM = 256, BK = 64, HALF = 128, HTB = HALF * BK * 2  , STAGE_BYTES = 8 * HTB, NXCD = 8, WGM = 8;

__host__ __device__ __forceinline__ int lds_byte(int r, int c) { const int st = (r >> 4) * 2 + (c >> 5), rr = r & 15, cc = c & 31, ob = rr * 64 + cc * 2; return st * 1024 + (ob ^ (((ob >> 9) & 1) << 5)); }
__host__ __device__ __forceinline__ void stage_rc(int b, int& R, int& C) { const int st = b / 1024, sb = b % 1024, swz = sb ^ (((sb >> 9) & 1) << 5); R = (st >> 1) * 16 + swz / 64; C = (st & 1) * 32 + (swz % 64) / 2; }
__host__ __device__ __forceinline__ int perm32(int rho) { const int n = rho >> 4, i = rho & 15; return 8 * (i >> 2) + 4 * n + (i & 3); }

struct Unit { int pm, pn; };
struct Gemm { const bf16_t* A; const bf16_t* Bt; int M, N, K; };

struct StaticOrder {
    int nM, nN, nwg, G, c;
    __host__ __device__ void init(int M, int N, int G_, int c_) { nM = M / BM; nN = N / BM; nwg = nM * nN; G = G_; c = c_; }
    __host__ __device__ bool next(int i, Unit& u) const {
        const long L = (long)i * G + c; if (L >= nwg) return false;
        int wgid = (int)L; { const int q = nwg / NXCD, r = nwg % NXCD, xcd = wgid % NXCD, off = wgid / NXCD; wgid = (xcd < r ? xcd * (q + 1) : r * (q + 1) + (xcd - r) * q) + off; }
        const int nig = WGM * nN, gid = wgid / nig, fm = gid * WGM, gsz = (nM - fm) < WGM ? (nM - fm) : WGM;
        u.pm = fm + ((wgid % nig) % gsz); u.pn = (wgid % nig) / gsz; return true;
    }
    __device__ __forceinline__ void a_ready(const Unit&) const {}
    __device__ __forceinline__ void done(const Unit&) const {}
};

__device__ __forceinline__ unsigned cvt_pk_bf16(float lo, float hi) { unsigned r; asm volatile("v_cvt_pk_bf16_f32 %0, %1, %2" : "=v"(r) : "v"(lo), "v"(hi)); return r; }
typedef float f32x2 __attribute__((ext_vector_type(2)));
__device__ __forceinline__ f32x2 gelu_pk(f32x2 v) {
    const f32x2 av = __builtin_elementwise_abs(v), d = av * 0.2316418882f + 1.0f;
    f32x2 t; t.x = __builtin_amdgcn_rcpf(d.x); t.y = __builtin_amdgcn_rcpf(d.y);
    f32x2 q = t * 0.5307027145f + (-0.7265760135f); q = q * t + 0.7107068705f; q = q * t + (-0.142248368f); q = q * t + 0.127414796f; q = q * t;
    const f32x2 s = (v * v) * (-0.72134752044f);
    f32x2 e; e.x = __builtin_amdgcn_exp2f(s.x); e.y = __builtin_amdgcn_exp2f(s.y);
    const f32x2 m = v * (q * e), r = v - m;
    f32x2 o; o.x = v.x < 0.f ? m.x : r.x; o.y = v.y < 0.f ? m.y : r.y; return o;
}

template <int ACT  > struct EpiBf16 {
    static constexpr bool PERM = true, AFTER_DRAIN = false; static_assert(ACT == 0 || ACT == 1, "EpiBf16: ACT is 0 (none) or 1 (gelu_pk)");
    bf16_t* O; int ldc; const float* bias; int split_cols; size_t split_stride; float scale0;
    __device__ __forceinline__ void operator()(const f32x4 (&acc)[2][2][4][2], const Unit& u, int wr, int wc, int fr, int fq) const {
        const int row0 = u.pm * BM + wr * 64 + fr; int colt = u.pn * BM; bf16_t* base = O;
        float sc = 1.f; if (split_cols) { const int t = colt / split_cols; base += (size_t)t * split_stride; colt -= t * split_cols; if (t == 0) sc = scale0; }
        const int col0 = colt + wc * 32 + 8 * fq, bcol0 = u.pn * BM + wc * 32 + 8 * fq;
        f32x4 bv[2][2];
#pragma unroll
        for (int bj = 0; bj < 2; ++bj)
#pragma unroll
            for (int n = 0; n < 2; ++n) bv[bj][n] = bias ? *(const f32x4*)(bias + bcol0 + bj * HALF + 4 * n) : (f32x4){0.f, 0.f, 0.f, 0.f};
#pragma unroll
        for (int ai = 0; ai < 2; ++ai)
#pragma unroll
            for (int m = 0; m < 4; ++m) { bf16_t* rowp = base + (size_t)(row0 + ai * HALF + m * 16) * ldc + col0;
#pragma unroll
                for (int bj = 0; bj < 2; ++bj) { f32x4 v0 = acc[ai][bj][m][0] + bv[bj][0], v1 = acc[ai][bj][m][1] + bv[bj][1];
                    if (ACT == 1) { f32x2 a = gelu_pk((f32x2){v0[0], v0[1]}), b = gelu_pk((f32x2){v0[2], v0[3]}), c = gelu_pk((f32x2){v1[0], v1[1]}), d = gelu_pk((f32x2){v1[2], v1[3]});
                        v0 = (f32x4){a.x, a.y, b.x, b.y}; v1 = (f32x4){c.x, c.y, d.x, d.y}; }
                    v0 = v0 * sc; v1 = v1 * sc; u32x4 w; w.x = cvt_pk_bf16(v0[0], v0[1]); w.y = cvt_pk_bf16(v0[2], v0[3]); w.z = cvt_pk_bf16(v1[0], v1[1]); w.w = cvt_pk_bf16(v1[2], v1[3]);
                    *(u32x4*)(rowp + bj * HALF) = w; } }
    }
};
template <class Epi, class Sched, bool ALIGN_EPI = false, bool SP2 = false>
__device__ __forceinline__ void gemm_phase(PG8_LAS unsigned char* lds, const Gemm g, const Sched& S, const Epi& E) {
    const int tid = threadIdx.x, wid = __builtin_amdgcn_readfirstlane(tid >> 6), lane = tid & 63, wr = wid >> 2, wc = wid & 3, fr = lane & 15, fq = lane >> 4;
    const int K = g.K, nt = K / BK;
    unsigned voffA[2], voffB[2];
#pragma unroll
    for (int i = 0; i < 2; ++i) { int R, C; stage_rc(tid * 16 + i * 8192, R, C); const int Rb = Epi::PERM ? ((R & ~31) + perm32(R & 31)) : R;
        voffA[i] = (unsigned)(R * K + C) * 2u; voffB[i] = (unsigned)(Rb * K + C) * 2u; }
    const size_t kstep = (size_t)(BK * 2);
    const size_t hstep = (size_t)HALF * K * 2;
    const size_t tstep = 2 * hstep;
    const unsigned ldsw = (unsigned)wid * 1024u;
    const int aoff = lds_byte(wr * 64 + fr, fq * 8), boff = lds_byte(wc * 32 + fr, fq * 8);
#define PG8_SA(b, h) (((b) * 2 + (h)) * HTB)
#define PG8_SB(b, h) ((4 + (b) * 2 + (h)) * HTB)
#define PG8_STAGE(bufoff, gbase, voff) do { _Pragma("unroll") for (int _i = 0; _i < 2; ++_i) \
        __builtin_amdgcn_global_load_lds((const unsigned*)((const char*)(gbase) + (voff)[_i]), (PG8_LAS unsigned*)(lds + (bufoff) + ldsw + _i * 8192), 16, 0, 0); } while (0)
#define PG8_LDA(dst, b, h) do { _Pragma("unroll") for (int m = 0; m < 4; ++m) _Pragma("unroll") for (int k = 0; k < 2; ++k) dst[m][k] = *(const PG8_LAS bf16x8*)(lds + PG8_SA(b, h) + aoff + m * 2048 + k * 1024); } while (0)
#define PG8_LDB(dst, b, h) do { _Pragma("unroll") for (int n = 0; n < 2; ++n) _Pragma("unroll") for (int k = 0; k < 2; ++k) dst[n][k] = *(const PG8_LAS bf16x8*)(lds + PG8_SB(b, h) + boff + n * 2048 + k * 1024); } while (0)
#define PG8_MMA(ai, bj, At, Bt) do { __builtin_amdgcn_s_setprio(1); _Pragma("unroll") for (int m = 0; m < 4; ++m) _Pragma("unroll") for (int n = 0; n < 2; ++n) _Pragma("unroll") for (int k = 0; k < 2; ++k) \
        acc[ai][bj][m][n] = __builtin_amdgcn_mfma_f32_16x16x32_bf16(Bt[n][k], At[m][k], acc[ai][bj][m][n], 0, 0, 0); __builtin_amdgcn_s_setprio(0); } while (0)
#define PG8_WAIT_V(n) asm volatile("s_waitcnt vmcnt(" #n ")" ::: "memory")
#define PG8_WAIT_L(n) asm volatile("s_waitcnt lgkmcnt(" #n ")" ::: "memory")
#define PG8_BAR __builtin_amdgcn_s_barrier()
#define PG8_SCHED __builtin_amdgcn_sched_barrier(0)
    Unit cur, nxt; int ui = 0;
    if (!S.next(0, cur)) return;
    f32x4 acc[2][2][4][2];
#pragma unroll
    for (int a = 0; a < 2; ++a)
#pragma unroll
        for (int b = 0; b < 2; ++b)
#pragma unroll
            for (int m = 0; m < 4; ++m)
#pragma unroll
                for (int n = 0; n < 2; ++n) acc[a][b][m][n] = (f32x4){0.f, 0.f, 0.f, 0.f};
    bf16x8 At[4][2], B0[2][2], B1[2][2];
    const char* cA = (const char*)g.A + (size_t)cur.pm * tstep; const char* cB = (const char*)g.Bt + (size_t)cur.pn * tstep;
    S.a_ready(cur);
    if constexpr (SP2) {
        PG8_STAGE(PG8_SB(0, 0), cB, voffB); PG8_STAGE(PG8_SB(0, 1), cB + hstep, voffB); PG8_STAGE(PG8_SA(0, 0), cA, voffA); PG8_STAGE(PG8_SA(0, 1), cA + hstep, voffA);
        if (wr == 1) PG8_BAR;
        PG8_WAIT_V(2); PG8_BAR;
        PG8_STAGE(PG8_SB(1, 0), cB + kstep, voffB); PG8_STAGE(PG8_SA(1, 0), cA + kstep, voffA); PG8_STAGE(PG8_SB(1, 1), cB + hstep + kstep, voffB);
        PG8_WAIT_V(6); PG8_BAR;
    } else {
        PG8_STAGE(PG8_SB(0, 0), cB, voffB); PG8_STAGE(PG8_SA(0, 0), cA, voffA); PG8_STAGE(PG8_SB(0, 1), cB + hstep, voffB); PG8_STAGE(PG8_SA(0, 1), cA + hstep, voffA);
        if (wr == 1) PG8_BAR;
        PG8_WAIT_V(4); PG8_BAR;
        PG8_STAGE(PG8_SB(1, 0), cB + kstep, voffB); PG8_STAGE(PG8_SA(1, 0), cA + kstep, voffA); PG8_STAGE(PG8_SB(1, 1), cB + hstep + kstep, voffB);
        PG8_WAIT_V(6); PG8_BAR;
    }
    for (;;) {
        const bool has_next = S.next(ui + 1, nxt);
        const char* nA = has_next ? (const char*)g.A + (size_t)nxt.pm * tstep : cA; const char* nB = has_next ? (const char*)g.Bt + (size_t)nxt.pn * tstep : cB;
        for (int t = 0; t < nt; t += 2) {
            const bool last = (t == nt - 2);
            const char* a1 = cA + (size_t)(t + 1) * kstep;
            const char* a2 = last ? nA : cA + (size_t)(t + 2) * kstep; const char* b2 = last ? nB : cB + (size_t)(t + 2) * kstep;
            const char* a3 = a2 + kstep; const char* b3 = b2 + kstep;
            if (last && has_next) S.a_ready(nxt);
            if constexpr (SP2) {
            PG8_LDB(B0, 0, 0); PG8_LDB(B1, 0, 1); PG8_SCHED; PG8_LDA(At, 0, 0); PG8_STAGE(PG8_SA(1, 1), a1 + hstep, voffA);
            PG8_WAIT_V(8); PG8_WAIT_L(0); PG8_BAR; PG8_MMA(0, 0, At, B0); PG8_MMA(0, 1, At, B1); PG8_BAR; PG8_SCHED;
            PG8_LDA(At, 0, 1); PG8_STAGE(PG8_SB(0, 0), b2, voffB); PG8_STAGE(PG8_SB(0, 1), b2 + hstep, voffB); PG8_STAGE(PG8_SA(0, 0), a2, voffA);
            PG8_WAIT_V(8); PG8_WAIT_L(0); PG8_BAR; PG8_MMA(1, 0, At, B0); PG8_MMA(1, 1, At, B1); PG8_BAR; PG8_SCHED;
            PG8_LDB(B0, 1, 0); PG8_LDB(B1, 1, 1); PG8_SCHED; PG8_LDA(At, 1, 0); PG8_STAGE(PG8_SA(0, 1), a2 + hstep, voffA);
            PG8_WAIT_V(8); PG8_WAIT_L(0); PG8_BAR; PG8_MMA(0, 0, At, B0); PG8_MMA(0, 1, At, B1); PG8_BAR; PG8_SCHED;
            PG8_LDA(At, 1, 1); PG8_STAGE(PG8_SB(1, 0), b3, voffB); PG8_STAGE(PG8_SB(1, 1), b3 + hstep, voffB); PG8_STAGE(PG8_SA(1, 0), a3, voffA);
            PG8_WAIT_V(8); PG8_WAIT_L(0); PG8_BAR; PG8_MMA(1, 0, At, B0); PG8_MMA(1, 1, At, B1); PG8_BAR; PG8_SCHED;
            } else {
            PG8_LDB(B0, 0, 0); PG8_SCHED; PG8_LDA(At, 0, 0); PG8_STAGE(PG8_SA(1, 1), a1 + hstep, voffA);
            PG8_WAIT_L(8); PG8_BAR; PG8_WAIT_L(0); PG8_MMA(0, 0, At, B0); PG8_BAR; PG8_SCHED;
            PG8_LDB(B1, 0, 1); PG8_STAGE(PG8_SB(0, 0), b2, voffB);
            PG8_BAR; PG8_WAIT_L(0); PG8_MMA(0, 1, At, B1); PG8_BAR;
            PG8_LDA(At, 0, 1); PG8_STAGE(PG8_SA(0, 0), a2, voffA);
            PG8_BAR; PG8_WAIT_L(0); PG8_MMA(1, 0, At, B0); PG8_BAR; PG8_SCHED;
            PG8_STAGE(PG8_SB(0, 1), b2 + hstep, voffB);
            PG8_WAIT_V(6); PG8_BAR; PG8_MMA(1, 1, At, B1); PG8_BAR;
            PG8_LDB(B0, 1, 0); PG8_SCHED; PG8_LDA(At, 1, 0); PG8_STAGE(PG8_SA(0, 1), a2 + hstep, voffA);
            PG8_WAIT_L(8); PG8_BAR; PG8_WAIT_L(0); PG8_MMA(0, 0, At, B0); PG8_BAR; PG8_SCHED;
            PG8_LDB(B1, 1, 1); PG8_STAGE(PG8_SB(1, 0), b3, voffB);
            PG8_BAR; PG8_WAIT_L(0); PG8_MMA(0, 1, At, B1); PG8_BAR;
            PG8_LDA(At, 1, 1); PG8_STAGE(PG8_SA(1, 0), a3, voffA);
            PG8_BAR; PG8_WAIT_L(0); PG8_MMA(1, 0, At, B0); PG8_BAR; PG8_SCHED;
            PG8_STAGE(PG8_SB(1, 1), b3 + hstep, voffB);
            PG8_WAIT_V(6); PG8_BAR; PG8_MMA(1, 1, At, B1); PG8_BAR;
            }
        }
        if constexpr (ALIGN_EPI) { if (wr == 0) PG8_BAR; }
        if constexpr (!Epi::AFTER_DRAIN) { E(acc, cur, wr, wc, fr, fq); S.done(cur); }
        if (!has_next) break;
#pragma unroll
        for (int a = 0; a < 2; ++a)
#pragma unroll
            for (int b = 0; b < 2; ++b)
#pragma unroll
                for (int m = 0; m < 4; ++m)
#pragma unroll
                    for (int n = 0; n < 2; ++n) acc[a][b][m][n] = (f32x4){0.f, 0.f, 0.f, 0.f};
        cur = nxt; cA = nA; cB = nB; ++ui;
        if constexpr (ALIGN_EPI) { if (wr == 1) PG8_BAR; }
    }
    PG8_WAIT_V(0);
    if constexpr (!ALIGN_EPI) { if (wr == 0) PG8_BAR; }
    PG8_BAR;
    if constexpr (Epi::AFTER_DRAIN) { E.fused(acc, cur, wr, wc, fr, fq, lds, wid, lane); S.done(cur); }
#undef PG8_SA
#undef PG8_SB
#undef PG8_STAGE
#undef PG8_LDA
#undef PG8_LDB
#undef PG8_MMA
#undef PG8_WAIT_V
#undef PG8_WAIT_L
#undef PG8_BAR
#undef PG8_SCHED
}
}

namespace mk {
#define LAS __attribute__((address_space(3)))
typedef unsigned short bf16_t;
typedef short bf16x8 __attribute__((ext_vector_type(8)));
typedef float f32x4 __attribute__((ext_vector_type(4)));
typedef float f32x16 __attribute__((ext_vector_type(16)));
typedef unsigned u32x4 __attribute__((ext_vector_type(4)));
typedef unsigned u32x2 __attribute__((ext_vector_type(2)));
typedef __bf16 bf16x2_t __attribute__((ext_vector_type(2)));
typedef float f32x2_t __attribute__((ext_vector_type(2)));
typedef unsigned u32;

constexpr int DM = 1024, SEQ = 16384, NMETA = 16, MPAD = 16640, INW = 1280;
constexpr int O_K = 512, O_V = 640, O_U = 768;
constexpr int NCH = 513;
constexpr float EPS = 1e-6f;
constexpr float LOG2E = 1.4426950408889634f;
constexpr int NWAVES = 8, NTHR = 512;
constexpr int LDS_BYTES = 163840;
constexpr int MISC_OFF = LDS_BYTES - 128;

constexpr size_t MiB = 1u << 20;
constexpr size_t WS_CTL = 0, CTL_BYTES = 1 * MiB;
constexpr size_t WS_WIN_T = 1 * MiB;
constexpr size_t WS_WOUT_T = 4 * MiB;
constexpr size_t WS_WQ_T = 6 * MiB;
constexpr size_t WS_GLU_T = 10 * MiB;
constexpr size_t WS_SUBK = 10 * MiB + 512 * 1024;
constexpr size_t WS_KT = 11 * MiB;
constexpr size_t WS_F = 12 * MiB;
constexpr size_t WS_E = 16 * MiB;
constexpr size_t WS_ABART = 20 * MiB;
constexpr size_t WS_SLOC = 21 * MiB;
constexpr size_t WS_CARRY = 30 * MiB;
constexpr size_t WS_BUFA = 39 * MiB;
constexpr size_t WS_PROJ = 72 * MiB;
constexpr size_t WS_ATTN = 113 * MiB;
constexpr size_t WS_Z = 129 * MiB;
constexpr size_t WS_SSMO = 145 * MiB;
constexpr size_t WS_QP = 72 * MiB;
constexpr size_t WS_IDX = 161 * MiB;
constexpr size_t WS_GW = 169 * MiB;
constexpr size_t WS_PU = 177 * MiB;
constexpr size_t WS_PV = 193 * MiB;
constexpr size_t WS_SU = 209 * MiB;
constexpr size_t WS_SV = 209 * MiB + 65536;
constexpr size_t WS_END = 210 * MiB;

struct Params { const float* in[25]; float* out; unsigned char* ws; int ph_lo, ph_hi; float one, zero; };
enum { I_X = 0, I_META, I_N1G, I_WIN, I_QNG, I_KNG, I_SINK, I_ARE, I_AIM, I_LDT, I_BRE, I_BIM, I_CRE, I_CIM, I_SD, I_GLUW, I_GLUB, I_AOG, I_SOG, I_WOUT, I_N2G, I_WQ, I_SUBK, I_PU, I_PV };

__device__ __forceinline__ unsigned pk2(float lo, float hi) { f32x2_t v = {lo, hi}; return __builtin_bit_cast(unsigned, __builtin_convertvector(v, bf16x2_t)); }
__device__ __forceinline__ float bflo(unsigned w) { return __uint_as_float(w << 16); }
__device__ __forceinline__ float bfhi(unsigned w) { return __uint_as_float(w & 0xffff0000u); }
__device__ __forceinline__ float wave_sum(float v) {
#pragma unroll
    for (int o = 1; o < 64; o <<= 1) v += __shfl_xor(v, o);
    return v;
}
#define LDS_WAIT() asm volatile("s_waitcnt lgkmcnt(0)" ::: "memory")
__device__ __forceinline__ float gelu_erf(float v) { return 0.5f * v * (1.0f + erff(v * 0.70710678118654752f)); }
__device__ __forceinline__ u32 f2ord(float f) { const u32 u = __float_as_uint(f); return (u & 0x80000000u) ? ~u : (u | 0x80000000u); }
__device__ __forceinline__ float ord2f(u32 o) { const u32 u = (o & 0x80000000u) ? (o & 0x7fffffffu) : ~o; return __uint_as_float(u); }
#define MFMA16(a, b, c) __builtin_amdgcn_mfma_f32_16x16x32_bf16((a), (b), (c), 0, 0, 0)
#define MFMA32(a, b, c) __builtin_amdgcn_mfma_f32_32x32x16_bf16((a), (b), (c), 0, 0, 0)

#define CEX(x, i, j) do { const u32 _a = x[i], _b = x[j]; x[i] = _a > _b ? _a : _b; x[j] = _a > _b ? _b : _a; } while (0)
__device__ __forceinline__ void sort16_desc(u32 (&x)[16]) {
#pragma unroll
    for (int k = 2; k <= 16; k <<= 1) {
#pragma unroll
        for (int j = k >> 1; j > 0; j >>= 1) {
#pragma unroll
            for (int i = 0; i < 16; ++i) { const int l = i ^ j; if (l > i) { if ((i & k) == 0) CEX(x, i, l); else CEX(x, l, i); } }
        }
    }
}
__device__ __forceinline__ void bmerge16_desc(u32 (&x)[16]) {
#pragma unroll
    for (int j = 8; j > 0; j >>= 1) {
#pragma unroll
        for (int i = 0; i < 16; ++i) { const int l = i ^ j; if (l > i) CEX(x, i, l); }
    }
}
__device__ __forceinline__ void merge_top16(u32 (&a)[16], const u32 (&b)[16]) {
#pragma unroll
    for (int i = 0; i < 16; ++i) a[i] = a[i] > b[15 - i] ? a[i] : b[15 - i];
    bmerge16_desc(a);
}
__device__ __forceinline__ void top16_of_64(u32 (&g0)[16], u32 (&g1)[16], u32 (&g2)[16], u32 (&g3)[16]) {
    sort16_desc(g0); sort16_desc(g1); sort16_desc(g2); sort16_desc(g3);
    merge_top16(g0, g1); merge_top16(g2, g3); merge_top16(g0, g2);
}
__device__ const unsigned char CAND_AB[64] = {0, 1, 2, 3, 4, 5, 6, 7, 8, 9, 10, 11, 12, 13, 14, 15, 16, 17, 18, 19, 20, 21, 22, 23, 32, 33, 34, 35, 36, 48, 49, 50, 51, 64, 65, 66, 80, 81, 96, 97, 112, 113, 128, 144, 160, 176, 192, 208, 224, 240, 0, 0, 0, 0, 0, 0, 0, 0, 0, 0, 0, 0, 0, 0};

struct Ctx { LAS unsigned char* lds; int tid, lane, wave, G, bid; };

__device__ __forceinline__ void transpose_item(const float* W, int K, int N, bf16_t* WT, LAS float* scr, int item, int lane) {
    const int nblk = N / 32, kb = item / nblk, nb = item % nblk, k0 = 64 * kb, n0 = 32 * nb;
#pragma unroll 8
    for (int i = 0; i < 32; ++i) { const int kk = 2 * i + (lane >> 5); scr[kk * 33 + (lane & 31)] = W[(size_t)(k0 + kk) * N + n0 + (lane & 31)]; }
    LDS_WAIT();
    const int c = lane & 7;
#pragma unroll
    for (int j = 0; j < 4; ++j) { const int n = (lane >> 3) + 8 * j; const LAS float* s = scr + (8 * c) * 33 + n;
        u32x4 o; o.x = pk2(s[0 * 33], s[1 * 33]); o.y = pk2(s[2 * 33], s[3 * 33]); o.z = pk2(s[4 * 33], s[5 * 33]); o.w = pk2(s[6 * 33], s[7 * 33]);
        *(u32x4*)(WT + (size_t)(n0 + n) * K + k0 + 8 * c) = o; }
    LDS_WAIT();
}

__device__ __forceinline__ void ssm_tables(const Ctx& C, const Params& P, int g) {
    LAS float* pwr = (LAS float*)C.lds;
    LAS float* pwi = pwr + 33 * 64;
    LAS float* bbr = pwi + 33 * 64;
    LAS float* bbi = bbr + 1024;
    LAS float* ccr = bbi + 1024;
    LAS float* cci = ccr + 1024;
    LAS float* cfr = cci + 1024;
    LAS float* cfi = cfr + 64;
    const int tid = C.tid;
    const float dt = expf(P.in[I_LDT][g]);
    for (int e = tid; e < 33 * 64; e += NTHR) {
        const int l = e >> 6, n = e & 63;
        const float lr = P.in[I_ARE][g * 64 + n], li = P.in[I_AIM][g * 64 + n];
        const float x = lr * dt * (float)l, th = li * dt * (float)l, mag = expf(x);
        float s, c; sincosf(th, &s, &c);
        pwr[e] = mag * c; pwi[e] = mag * s;
        if (l == 32) { float* abt = (float*)(P.ws + WS_ABART) + (g * 64 + n) * 2; abt[0] = mag * c; abt[1] = mag * s; }
    }
    if (tid < 64) {
        const int n = tid;
        const float lr = P.in[I_ARE][g * 64 + n], li = P.in[I_AIM][g * 64 + n];
        const float x1 = lr * dt, th1 = li * dt, em1 = expm1f(x1);
        float s1, c1; sincosf(th1, &s1, &c1);
        const float sh = sinf(0.5f * th1);
        const float nr = em1 * c1 - 2.0f * sh * sh, ni = (em1 + 1.0f) * s1;
        const float den = lr * lr + li * li;
        cfr[n] = (nr * lr + ni * li) / den; cfi[n] = (ni * lr - nr * li) / den;
    }
    __syncthreads();
    for (int e = tid; e < 1024; e += NTHR) {
        const int n = e >> 4;
        const float br = P.in[I_BRE][g * 1024 + e], bi = P.in[I_BIM][g * 1024 + e];
        bbr[e] = cfr[n] * br - cfi[n] * bi; bbi[e] = cfr[n] * bi + cfi[n] * br;
        ccr[e] = P.in[I_CRE][g * 1024 + e]; cci[e] = P.in[I_CIM][g * 1024 + e];
    }
    __syncthreads();
    bf16_t* Kt = (bf16_t*)(P.ws + WS_KT) + (size_t)g * 8448;
    {
        const int pq = tid & 255, p = pq >> 4, q = pq & 15, l0 = (tid >> 8) * 16;
        float cbr[64], cbi[64];
#pragma unroll
        for (int n = 0; n < 64; ++n) { const float cr = ccr[p * 64 + n], ci = cci[p * 64 + n], br = bbr[n * 16 + q], bi = bbi[n * 16 + q]; cbr[n] = cr * br - ci * bi; cbi[n] = cr * bi + ci * br; }
#pragma unroll 1
        for (int lg = l0; lg < l0 + 16; ++lg) {
            float val = 0.f;
#pragma unroll
            for (int n = 0; n < 64; n += 4) {
                const f32x4 ar = *(const LAS f32x4*)(pwr + lg * 64 + n), ai = *(const LAS f32x4*)(pwi + lg * 64 + n);
                val += cbr[n] * ar.x - cbi[n] * ai.x; val += cbr[n + 1] * ar.y - cbi[n + 1] * ai.y; val += cbr[n + 2] * ar.z - cbi[n + 2] * ai.z; val += cbr[n + 3] * ar.w - cbi[n + 3] * ai.w;
            }
            Kt[(lg + 1) * 256 + pq] = (bf16_t)(pk2(val, 0.f) & 0xffffu);
        }
        if (tid < 256) Kt[tid] = 0;
    }
    bf16_t* F = (bf16_t*)(P.ws + WS_F) + (size_t)g * 65536;
    for (int e8 = tid; e8 < 8192; e8 += NTHR) {
        const int n2 = e8 >> 6, k0 = (e8 & 63) * 8, j = k0 >> 4, q0 = k0 & 15, n = n2 & 63, l = 31 - j;
        const float ar = pwr[l * 64 + n], ai = pwi[l * 64 + n];
        float w[8];
#pragma unroll
        for (int i = 0; i < 8; ++i) { const float br = bbr[n * 16 + q0 + i], bi = bbi[n * 16 + q0 + i]; w[i] = (n2 < 64) ? (ar * br - ai * bi) : (ar * bi + ai * br); }
        u32x4 o; o.x = pk2(w[0], w[1]); o.y = pk2(w[2], w[3]); o.z = pk2(w[4], w[5]); o.w = pk2(w[6], w[7]);
        *(u32x4*)(F + (size_t)e8 * 8) = o;
    }
    bf16_t* E = (bf16_t*)(P.ws + WS_E) + (size_t)g * 65536;
    for (int e8 = tid; e8 < 8192; e8 += NTHR) {
        const int row = e8 >> 4, n20 = (e8 & 15) * 8, t = row >> 4, p = row & 15, n0 = n20 & 63;
        float w[8];
#pragma unroll
        for (int i = 0; i < 8; ++i) { const int n = n0 + i; const float pr = pwr[(t + 1) * 64 + n], pi = pwi[(t + 1) * 64 + n], cr = ccr[p * 64 + n], ci = cci[p * 64 + n];
            w[i] = (n20 < 64) ? (cr * pr - ci * pi) : -(cr * pi + ci * pr); }
        u32x4 o; o.x = pk2(w[0], w[1]); o.y = pk2(w[2], w[3]); o.z = pk2(w[4], w[5]); o.w = pk2(w[6], w[7]);
        *(u32x4*)(E + (size_t)e8 * 8) = o;
    }
    __syncthreads();
}

__device__ __forceinline__ void norm_row_to_bf16(const float* src, const float* gam, bf16_t* dst, int lane) {
    const f32x4* xr = (const f32x4*)src + lane; const f32x4* gr = (const f32x4*)gam + lane;
    f32x4 v[4]; float s = 0.f;
#pragma unroll
    for (int j = 0; j < 4; ++j) { v[j] = xr[64 * j]; s += (v[j].x * v[j].x + v[j].y * v[j].y) + (v[j].z * v[j].z + v[j].w * v[j].w); }
    const float rinv = 1.0f / sqrtf(wave_sum(s) * (1.0f / DM) + EPS);
    u32x2* o = (u32x2*)dst + lane;
#pragma unroll
    for (int j = 0; j < 4; ++j) { const f32x4 g = gr[64 * j]; u32x2 w; w.x = pk2(v[j].x * rinv * g.x, v[j].y * rinv * g.y); w.y = pk2(v[j].z * rinv * g.z, v[j].w * rinv * g.w); o[64 * j] = w; }
}

__device__ __forceinline__ void cvt8(const float* src, bf16_t* dst, size_t i) {
    const f32x4 a = ((const f32x4*)src)[2 * i], b = ((const f32x4*)src)[2 * i + 1];
    u32x4 o; o.x = pk2(a.x, a.y); o.y = pk2(a.z, a.w); o.z = pk2(b.x, b.y); o.w = pk2(b.z, b.w);
    ((u32x4*)dst)[i] = o;
}

__device__ __forceinline__ void quant_row(const Params& P, int r, int lane) {
    const bool isv = r >= 16384; const int row = isv ? r - 16384 : r;
    const f32x4* src = (const f32x4*)((isv ? P.in[I_PV] : P.in[I_PU]) + (size_t)row * DM) + lane;
    f32x4 v[4]; float m = 0.f;
#pragma unroll
    for (int j = 0; j < 4; ++j) { v[j] = src[64 * j]; m = fmaxf(m, fmaxf(fmaxf(fabsf(v[j].x), fabsf(v[j].y)), fmaxf(fabsf(v[j].z), fabsf(v[j].w)))); }
#pragma unroll
    for (int o = 1; o < 64; o <<= 1) m = fmaxf(m, __shfl_xor(m, o));
    const float sc = (m > 0.f) ? m * (1.0f / 127.0f) : 1.0f, inv = (m > 0.f) ? 127.0f / m : 0.f;
    const int off = isv ? 128 : 0;
    u32x4 w;
#pragma unroll
    for (int j = 0; j < 4; ++j) {
        const int q0 = (int)rintf(v[j].x * inv) + off, q1 = (int)rintf(v[j].y * inv) + off, q2 = (int)rintf(v[j].z * inv) + off, q3 = (int)rintf(v[j].w * inv) + off;
        w[j] = (u32)(q0 & 255) | ((u32)(q1 & 255) << 8) | ((u32)(q2 & 255) << 16) | ((u32)(q3 & 255) << 24);
    }
    *(u32x4*)(P.ws + (isv ? WS_PV : WS_PU) + (size_t)row * 1024 + 16 * lane) = w;
    if (lane == 0) ((float*)(P.ws + (isv ? WS_SV : WS_SU)))[row] = sc;
}
__device__ __forceinline__ void xn_row(const Params& P, int m, int lane) {
    bf16_t* xn = (bf16_t*)(P.ws + WS_BUFA);
    if (m < SEQ) norm_row_to_bf16(P.in[I_X] + (size_t)m * DM, P.in[I_N1G], xn + (size_t)m * DM, lane);
    else if (m < SEQ + NMETA) norm_row_to_bf16(P.in[I_META] + (size_t)(m - SEQ) * DM, P.in[I_N1G], xn + (size_t)m * DM, lane);
    else { u32x4 z = {0u, 0u, 0u, 0u}; u32x4* o = (u32x4*)(xn + (size_t)m * DM); o[lane] = z; o[64 + lane] = z; }
}
__device__ __forceinline__ void phase_prologue(const Ctx& C, const Params& P) {
    const bool dedicated = C.G >= 64;
    if (C.bid < 32 || !dedicated) { for (int g = C.bid; g < 32; g += C.G) ssm_tables(C, P, g); }
    if (dedicated && C.bid < 32) return;
    __syncthreads();
    const int b0 = dedicated ? 32 : 0;
    LAS float* scr = (LAS float*)(C.lds + C.wave * 16384);
    const int gw = (C.bid - b0) * NWAVES + C.wave, NGW = (C.G - b0) * NWAVES;
    constexpr int I_IN = 16 * 40, I_OUT = 16 * 32, I_Q = 16 * 64, I_GLU = 8 * 16, NITEMS = I_IN + I_OUT + I_Q + I_GLU;
    for (int it = gw; it < NITEMS; it += NGW) {
        int r = it;
        if (r < I_IN) { transpose_item(P.in[I_WIN], 1024, 1280, (bf16_t*)(P.ws + WS_WIN_T), scr, r, C.lane); continue; } r -= I_IN;
        if (r < I_OUT) { transpose_item(P.in[I_WOUT], 1024, 1024, (bf16_t*)(P.ws + WS_WOUT_T), scr, r, C.lane); continue; } r -= I_OUT;
        if (r < I_Q) { transpose_item(P.in[I_WQ], 1024, 2048, (bf16_t*)(P.ws + WS_WQ_T), scr, r, C.lane); continue; } r -= I_Q;
        transpose_item(P.in[I_GLUW], 512, 512, (bf16_t*)(P.ws + WS_GLU_T), scr, r, C.lane);
    }
    for (int m = gw; m < MPAD; m += 2 * NGW) { xn_row(P, m, C.lane); if (m + NGW < MPAD) xn_row(P, m + NGW, C.lane); }
    for (int r = gw; r < 2 * 16384; r += 2 * NGW) { quant_row(P, r, C.lane); if (r + NGW < 2 * 16384) quant_row(P, r + NGW, C.lane); }
    const size_t gt = (size_t)(C.bid - b0) * NTHR + C.tid, NT = (size_t)(C.G - b0) * NTHR;
    for (size_t i = gt; i < 262144 / 8; i += NT) cvt8(P.in[I_SUBK], (bf16_t*)(P.ws + WS_SUBK), i);
}

__device__ __forceinline__ bf16x8 u_frag(const bf16_t* proj, int ci, int j, int g, int half) {
    const bool ok = (ci == 0) ? (j >= 16) : (ci < NCH);
    int row = (ci == 0) ? (SEQ + j - 16) : ((ci - 1) * 32 + j);
    row = ok ? row : 0;
    const u32x4 w = *(const u32x4*)(proj + (size_t)row * INW + O_U + g * 16 + half * 8);
    u32x4 z; z.x = ok ? w.x : 0u; z.y = ok ? w.y : 0u; z.z = ok ? w.z : 0u; z.w = ok ? w.w : 0u;
    return __builtin_bit_cast(bf16x8, z);
}

constexpr int F_PITCH = 1040;
__device__ __forceinline__ void phase_sloc(const Ctx& C, const Params& P) {
    const bf16_t* proj = (const bf16_t*)(P.ws + WS_PROJ);
    float* SL = (float*)(P.ws + WS_SLOC);
    const int n = C.lane & 15, kq = C.lane >> 4;
    for (int bu = C.bid; bu < 160; bu += C.G) {
        const int g = bu / 5, qtr = bu % 5, s = qtr * 8 + C.wave, ci = 16 * s + n;
        bf16x8 Bf[16];
#pragma unroll
        for (int ks = 0; ks < 16; ++ks) Bf[ks] = u_frag(proj, (s < 33) ? ci : NCH, 2 * ks + (kq >> 1), g, kq & 1);
        __syncthreads();
        { const u32x4* src = (const u32x4*)((const bf16_t*)(P.ws + WS_F) + (size_t)g * 65536);
          u32x4 t[16];
#pragma unroll
          for (int i = 0; i < 16; ++i) t[i] = src[C.tid + NTHR * i];
#pragma unroll
          for (int i = 0; i < 16; ++i) { const int e = C.tid + NTHR * i; *(LAS u32x4*)(C.lds + (e >> 6) * F_PITCH + (e & 63) * 16) = t[i]; } }
        __syncthreads();
        if (s < 33) {
#pragma unroll 1
            for (int mt = 0; mt < 8; ++mt) {
                f32x4 acc = {0.f, 0.f, 0.f, 0.f};
#pragma unroll
                for (int ks = 0; ks < 16; ++ks) {
                    const bf16x8 A = *(const LAS bf16x8*)(C.lds + (mt * 16 + n) * F_PITCH + (32 * ks + 8 * kq) * 2);
                    acc = MFMA16(A, Bf[ks], acc);
                }
                if (ci < NCH) *(f32x4*)(SL + ((size_t)ci * 32 + g) * 128 + mt * 16 + 4 * kq) = acc;
            }
        }
    }
}

__device__ __forceinline__ void carry_scan_block(const Ctx& C, const Params& P, int bk) {
    const float* SL = (const float*)(P.ws + WS_SLOC);
    float* CA = (float*)(P.ws + WS_CARRY);
    LAS float* Lr = (LAS float*)C.lds;
    LAS float* Li = Lr + 512;
    const int chan = bk * 32 + (C.tid & 31), g = chan >> 6, n = chan & 63, sg = C.tid >> 5;
    const float* abt = (const float*)(P.ws + WS_ABART) + (g * 64 + n) * 2;
    const float ar = abt[0], ai = abt[1];
    float sr = 0.f, si = 0.f;
#pragma unroll 8
    for (int i = 0; i < 32; ++i) {
        const int ci = 32 * sg + i; const size_t o = ((size_t)ci * 32 + g) * 128 + n;
        const float br = SL[o], bi = SL[o + 64];
        const float tr = ar * sr - ai * si + br, ti = ar * si + ai * sr + bi; sr = tr; si = ti;
    }
    Lr[sg * 32 + (C.tid & 31)] = sr; Li[sg * 32 + (C.tid & 31)] = si;
    float pr = ar, pi = ai;
#pragma unroll
    for (int k = 0; k < 5; ++k) { const float tr = pr * pr - pi * pi, ti = 2.f * pr * pi; pr = tr; pi = ti; }
    __syncthreads();
    float cr = 0.f, ci_ = 0.f;
    for (int s2 = 0; s2 < sg; ++s2) { const float lr = Lr[s2 * 32 + (C.tid & 31)], li = Li[s2 * 32 + (C.tid & 31)];
        const float tr = pr * cr - pi * ci_ + lr, ti = pr * ci_ + pi * cr + li; cr = tr; ci_ = ti; }
    sr = cr; si = ci_;
#pragma unroll 8
    for (int i = 0; i < 32; ++i) {
        const int ci = 32 * sg + i; const size_t o = ((size_t)ci * 32 + g) * 128 + n;
        CA[o] = sr; CA[o + 64] = si;
        const float br = SL[o], bi = SL[o + 64];
        const float tr = ar * sr - ai * si + br, ti = ar * si + ai * sr + bi; sr = tr; si = ti;
    }
    if (sg == 15) { const size_t o = ((size_t)512 * 32 + g) * 128 + n; CA[o] = sr; CA[o + 64] = si; }
    __syncthreads();
}

constexpr int E_OFF = 16896, E_PITCH = 272;
__device__ __forceinline__ void phase_ssm_y(const Ctx& C, const Params& P) {
    const bf16_t* proj = (const bf16_t*)(P.ws + WS_PROJ);
    const float* CA = (const float*)(P.ws + WS_CARRY);
    bf16_t* Z = (bf16_t*)(P.ws + WS_Z);
    const int n = C.lane & 15, kq = C.lane >> 4;
    for (int bu = C.bid; bu < 256; bu += C.G) {
        const int g = bu >> 3, cq = bu & 7;
        __syncthreads();
        { const u32x4* src = (const u32x4*)((const bf16_t*)(P.ws + WS_KT) + (size_t)g * 8448); LAS u32x4* dst = (LAS u32x4*)C.lds;
          for (int e = C.tid; e < 1056; e += NTHR) dst[e] = src[e];
          const u32x4* esrc = (const u32x4*)((const bf16_t*)(P.ws + WS_E) + (size_t)g * 65536);
          u32x4 t[16];
#pragma unroll
          for (int i = 0; i < 16; ++i) t[i] = esrc[C.tid + NTHR * i];
#pragma unroll
          for (int i = 0; i < 16; ++i) { const int e = C.tid + NTHR * i; *(LAS u32x4*)(C.lds + E_OFF + (e >> 4) * E_PITCH + (e & 15) * 16) = t[i]; } }
        __syncthreads();
        const int ci = 1 + 64 * cq + 16 * (C.wave >> 1) + n, par = C.wave & 1;
        bf16x8 Uf[16], Cf[4];
#pragma unroll
        for (int ks = 0; ks < 16; ++ks) Uf[ks] = u_frag(proj, ci, 2 * ks + (kq >> 1), g, kq & 1);
#pragma unroll
        for (int k2 = 0; k2 < 4; ++k2) {
            const float* cp = CA + ((size_t)ci * 32 + g) * 128 + 32 * k2 + 8 * kq;
            const f32x4 a = *(const f32x4*)cp, b = *(const f32x4*)(cp + 4);
            u32x4 w; w.x = pk2(a.x, a.y); w.y = pk2(a.z, a.w); w.z = pk2(b.x, b.y); w.w = pk2(b.z, b.w);
            Cf[k2] = __builtin_bit_cast(bf16x8, w);
        }
        const f32x4 dv = *(const f32x4*)(P.in[I_SD] + g * 16 + 4 * kq);
#pragma unroll 1
        for (int tt = 0; tt < 16; ++tt) {
            const int t = 2 * tt + par;
            f32x4 acc = {0.f, 0.f, 0.f, 0.f};
#pragma unroll
            for (int k2 = 0; k2 < 4; ++k2) {
                const bf16x8 A = *(const LAS bf16x8*)(C.lds + E_OFF + (t * 16 + n) * E_PITCH + (32 * k2 + 8 * kq) * 2);
                acc = MFMA16(A, Cf[k2], acc);
            }
#pragma unroll
            for (int ks = 0; ks < 16; ++ks) {
                if (ks <= tt) {
                    const int li = t - 2 * ks - (kq >> 1) + 1;
                    const bf16x8 A = *(const LAS bf16x8*)(C.lds + ((li * 16 + n) * 16 + 8 * (kq & 1)) * 2);
                    acc = MFMA16(A, Uf[ks], acc);
                }
            }
            const int row = (ci - 1) * 32 + t, ch = g * 16 + 4 * kq;
            const u32x2 uw = *(const u32x2*)(proj + (size_t)row * INW + O_U + ch);
            const float y0 = acc.x + dv.x * bflo(uw.x), y1 = acc.y + dv.y * bfhi(uw.x), y2 = acc.z + dv.z * bflo(uw.y), y3 = acc.w + dv.w * bfhi(uw.y);
            u32x2 o; o.x = pk2(gelu_erf(y0), gelu_erf(y1)); o.y = pk2(gelu_erf(y2), gelu_erf(y3));
            *(u32x2*)(Z + (size_t)row * 512 + ch) = o;
        }
    }
}

constexpr int VT_PITCH = 296;
__device__ __forceinline__ void attn_unit(const Ctx& C, const Params& P, int b, int hk) {
    const bf16_t* proj = (const bf16_t*)(P.ws + WS_PROJ);
    bf16_t* AO = (bf16_t*)(P.ws + WS_ATTN);
    LAS unsigned char* Ks = C.lds;
    LAS bf16_t* Vt = (LAS bf16_t*)(C.lds + 288 * 128);
    __syncthreads();
    for (int e = C.tid; e < 288 * 8; e += NTHR) {
        const int key = e >> 3, ch = e & 7;
        int row = -1;
        if (key < 256) { const int j = (b - 1) * 128 + key; if (j >= 0) row = j; } else if (key < 272) row = SEQ + key - 256;
        u32x4 kw = {0u, 0u, 0u, 0u}, vw = {0u, 0u, 0u, 0u};
        if (row >= 0) { kw = *(const u32x4*)(proj + (size_t)row * INW + O_K + hk * 64 + ch * 8); vw = *(const u32x4*)(proj + (size_t)row * INW + O_V + hk * 64 + ch * 8); }
        float kf[8] = {bflo(kw.x), bfhi(kw.x), bflo(kw.y), bfhi(kw.y), bflo(kw.z), bfhi(kw.z), bflo(kw.w), bfhi(kw.w)};
        float ss = 0.f;
#pragma unroll
        for (int i = 0; i < 8; ++i) ss += kf[i] * kf[i];
        ss += __shfl_xor(ss, 1); ss += __shfl_xor(ss, 2); ss += __shfl_xor(ss, 4);
        const float rinv = 1.0f / sqrtf(ss * (1.0f / 64.0f) + EPS);
        const f32x4 g0 = *(const f32x4*)(P.in[I_KNG] + ch * 8), g1 = *(const f32x4*)(P.in[I_KNG] + ch * 8 + 4);
        u32x4 o; o.x = pk2(kf[0] * rinv * g0.x, kf[1] * rinv * g0.y); o.y = pk2(kf[2] * rinv * g0.z, kf[3] * rinv * g0.w);
        o.z = pk2(kf[4] * rinv * g1.x, kf[5] * rinv * g1.y); o.w = pk2(kf[6] * rinv * g1.z, kf[7] * rinv * g1.w);
        *(LAS u32x4*)(Ks + key * 128 + ((ch ^ (key & 7)) * 16)) = o;
        const unsigned vv[4] = {vw.x, vw.y, vw.z, vw.w};
#pragma unroll
        for (int i = 0; i < 4; ++i) { Vt[(ch * 8 + 2 * i) * VT_PITCH + key] = (bf16_t)(vv[i] & 0xffffu); Vt[(ch * 8 + 2 * i + 1) * VT_PITCH + key] = (bf16_t)(vv[i] >> 16); }
    }
    __syncthreads();
    const int c = C.lane & 31, h = C.lane >> 5;
#pragma unroll 1
    for (int ti = C.wave; ti < 16; ti += NWAVES) {
        const int hql = ti >> 2, wq = ti & 3, hq = hk * 4 + hql;
        const int qi = wq * 32 + c, tok = b * 128 + qi;
        bf16x8 qf[4];
        {
            u32x4 qw[4]; float ss = 0.f;
#pragma unroll
            for (int ks = 0; ks < 4; ++ks) { qw[ks] = *(const u32x4*)(proj + (size_t)tok * INW + hq * 64 + 16 * ks + 8 * h);
                const unsigned w[4] = {qw[ks].x, qw[ks].y, qw[ks].z, qw[ks].w};
#pragma unroll
                for (int i = 0; i < 4; ++i) { const float a = bflo(w[i]), bb = bfhi(w[i]); ss += a * a + bb * bb; } }
            ss += __shfl_xor(ss, 32);
            const float rinv = (1.0f / sqrtf(ss * (1.0f / 64.0f) + EPS)) * (0.125f * LOG2E);
#pragma unroll
            for (int ks = 0; ks < 4; ++ks) {
                const f32x4 g0 = *(const f32x4*)(P.in[I_QNG] + 16 * ks + 8 * h), g1 = *(const f32x4*)(P.in[I_QNG] + 16 * ks + 8 * h + 4);
                u32x4 o; o.x = pk2(bflo(qw[ks].x) * rinv * g0.x, bfhi(qw[ks].x) * rinv * g0.y); o.y = pk2(bflo(qw[ks].y) * rinv * g0.z, bfhi(qw[ks].y) * rinv * g0.w);
                o.z = pk2(bflo(qw[ks].z) * rinv * g1.x, bfhi(qw[ks].z) * rinv * g1.y); o.w = pk2(bflo(qw[ks].w) * rinv * g1.z, bfhi(qw[ks].w) * rinv * g1.w);
                qf[ks] = __builtin_bit_cast(bf16x8, o);
            }
        }
        f32x16 S[6];
#pragma unroll
        for (int rb = 0; rb < 6; ++rb) {
            const int kb = (rb < 5) ? (wq + rb) : 8;
            const int key = kb * 32 + c;
            f32x16 acc = {0.f, 0.f, 0.f, 0.f, 0.f, 0.f, 0.f, 0.f, 0.f, 0.f, 0.f, 0.f, 0.f, 0.f, 0.f, 0.f};
#pragma unroll
            for (int ks = 0; ks < 4; ++ks) {
                const bf16x8 A = *(const LAS bf16x8*)(Ks + key * 128 + (((2 * ks + h) ^ (key & 7)) * 16));
                acc = MFMA32(A, qf[ks], acc);
            }
            S[rb] = acc;
            __builtin_amdgcn_sched_barrier(0);
        }
        const float sl = P.in[I_SINK][hq] * LOG2E;
        float mx = sl;
#pragma unroll
        for (int r = 0; r < 16; ++r) {
            const int kr = (r & 3) + 8 * (r >> 2) + 4 * h;
            const bool gt = kr > c;
            S[0][r] = gt ? S[0][r] : -1e30f;
            S[4][r] = gt ? -1e30f : S[4][r];
            if (r >= 8) S[5][r] = -1e30f;
        }
        if (b == 0) {
#pragma unroll
            for (int rb = 0; rb < 4; ++rb) if (wq + rb < 4) {
#pragma unroll
                for (int r = 0; r < 16; ++r) S[rb][r] = -1e30f;
            }
        }
#pragma unroll
        for (int rb = 0; rb < 6; ++rb)
#pragma unroll
            for (int r = 0; r < 16; ++r) mx = fmaxf(mx, S[rb][r]);
        mx = fmaxf(mx, __shfl_xor(mx, 32));
        float lsum = 0.f;
#pragma unroll
        for (int rb = 0; rb < 6; ++rb)
#pragma unroll
            for (int r = 0; r < 16; ++r) { const float p = exp2f(S[rb][r] - mx); S[rb][r] = p; lsum += p; }
        lsum += __shfl_xor(lsum, 32);
        lsum += exp2f(sl - mx);
        const float linv = 1.0f / lsum;
        f32x16 O[2];
#pragma unroll
        for (int db = 0; db < 2; ++db) O[db] = (f32x16){0.f, 0.f, 0.f, 0.f, 0.f, 0.f, 0.f, 0.f, 0.f, 0.f, 0.f, 0.f, 0.f, 0.f, 0.f, 0.f};
#pragma unroll
        for (int rb = 0; rb < 6; ++rb) {
            const int kb = (rb < 5) ? (wq + rb) : 8;
#pragma unroll
            for (int s = 0; s < 2; ++s) {
                if (rb == 5 && s == 1) continue;
                u32x4 pw; pw.x = pk2(S[rb][8 * s + 0], S[rb][8 * s + 1]); pw.y = pk2(S[rb][8 * s + 2], S[rb][8 * s + 3]);
                pw.z = pk2(S[rb][8 * s + 4], S[rb][8 * s + 5]); pw.w = pk2(S[rb][8 * s + 6], S[rb][8 * s + 7]);
                const bf16x8 Pf = __builtin_bit_cast(bf16x8, pw);
#pragma unroll
                for (int db = 0; db < 2; ++db) {
                    const LAS bf16_t* vp = Vt + (db * 32 + c) * VT_PITCH + kb * 32 + 16 * s + 4 * h;
                    const u32x2 lo = *(const LAS u32x2*)vp, hi2 = *(const LAS u32x2*)(vp + 8);
                    u32x4 vw; vw.x = lo.x; vw.y = lo.y; vw.z = hi2.x; vw.w = hi2.y;
                    O[db] = MFMA32(__builtin_bit_cast(bf16x8, vw), Pf, O[db]);
                }
                __builtin_amdgcn_sched_barrier(0);
            }
        }
#pragma unroll
        for (int db = 0; db < 2; ++db)
#pragma unroll
            for (int gq = 0; gq < 4; ++gq) {
                u32x2 o; o.x = pk2(O[db][4 * gq] * linv, O[db][4 * gq + 1] * linv); o.y = pk2(O[db][4 * gq + 2] * linv, O[db][4 * gq + 3] * linv);
                *(u32x2*)(AO + (size_t)tok * 512 + hq * 64 + db * 32 + 8 * gq + 4 * h) = o;
            }
    }
}

struct EpiGlu {
    static constexpr bool PERM = true, AFTER_DRAIN = false;
    const bf16_t* Z; bf16_t* O; const float* bias;
    __device__ __forceinline__ void operator()(const pg8::f32x4 (&acc)[2][2][4][2], const pg8::Unit& u, int wr, int wc, int fr, int fq) const {
        const int row0 = u.pm * 256 + wr * 64 + fr, col0 = u.pn * 256 + wc * 32 + 8 * fq;
#pragma unroll
        for (int ai = 0; ai < 2; ++ai)
#pragma unroll
            for (int m = 0; m < 4; ++m)
#pragma unroll
                for (int bj = 0; bj < 2; ++bj) {
                    const size_t off = (size_t)(row0 + ai * 128 + m * 16) * 512 + col0 + bj * 128;
                    const u32x4 zw = *(const u32x4*)(Z + off);
                    const f32x4 b0 = *(const f32x4*)(bias + col0 + bj * 128), b1 = *(const f32x4*)(bias + col0 + bj * 128 + 4);
                    const pg8::f32x4 v0 = acc[ai][bj][m][0], v1 = acc[ai][bj][m][1];
                    const float zf[8] = {bflo(zw.x), bfhi(zw.x), bflo(zw.y), bfhi(zw.y), bflo(zw.z), bfhi(zw.z), bflo(zw.w), bfhi(zw.w)};
                    const float pre[8] = {v0[0] + b0.x, v0[1] + b0.y, v0[2] + b0.z, v0[3] + b0.w, v1[0] + b1.x, v1[1] + b1.y, v1[2] + b1.z, v1[3] + b1.w};
                    float r[8];
#pragma unroll
                    for (int i = 0; i < 8; ++i) r[i] = zf[i] / (1.0f + __expf(-pre[i]));
                    u32x4 o; o.x = pk2(r[0], r[1]); o.y = pk2(r[2], r[3]); o.z = pk2(r[4], r[5]); o.w = pk2(r[6], r[7]);
                    *(u32x4*)(O + off) = o;
                }
    }
};
struct EpiRes {
    static constexpr bool PERM = false, AFTER_DRAIN = false;
    const float* base; float* out;
    __device__ __forceinline__ void operator()(const pg8::f32x4 (&acc)[2][2][4][2], const pg8::Unit& u, int wr, int wc, int fr, int fq) const {
        const int col0 = u.pn * 256 + wc * 32 + 4 * fq;
#pragma unroll
        for (int ai = 0; ai < 2; ++ai)
#pragma unroll
            for (int m = 0; m < 4; ++m) {
                const size_t off = (size_t)(u.pm * 256 + ai * 128 + wr * 64 + m * 16 + fr) * 1024 + col0;
#pragma unroll
                for (int bj = 0; bj < 2; ++bj)
#pragma unroll
                    for (int n = 0; n < 2; ++n) {
                        const f32x4 bs = *(const f32x4*)(base + off + bj * 128 + n * 16);
                        const pg8::f32x4 a = acc[ai][bj][m][n];
                        f32x4 o; o.x = bs.x + a[0]; o.y = bs.y + a[1]; o.z = bs.z + a[2]; o.w = bs.w + a[3];
                        *(f32x4*)(out + off + bj * 128 + n * 16) = o;
                    }
            }
    }
};

__device__ __forceinline__ void phase_mix_norm(const Ctx& C, const Params& P) {
    const bf16_t* AO = (const bf16_t*)(P.ws + WS_ATTN); const bf16_t* SO = (const bf16_t*)(P.ws + WS_SSMO);
    bf16_t* MX = (bf16_t*)(P.ws + WS_BUFA);
    const int gw = C.bid * NWAVES + C.wave, NGW = C.G * NWAVES;
    for (int m = gw; m < SEQ; m += NGW) {
#pragma unroll
        for (int part = 0; part < 2; ++part) {
            const bf16_t* src = (part ? SO : AO) + (size_t)m * 512 + 8 * C.lane;
            const float* gam = P.in[part ? I_SOG : I_AOG] + 8 * C.lane;
            const u32x4 w = *(const u32x4*)src;
            const float f[8] = {bflo(w.x), bfhi(w.x), bflo(w.y), bfhi(w.y), bflo(w.z), bfhi(w.z), bflo(w.w), bfhi(w.w)};
            float ss = 0.f;
#pragma unroll
            for (int i = 0; i < 8; ++i) ss += f[i] * f[i];
            const float rinv = 1.0f / sqrtf(wave_sum(ss) * (1.0f / 512.0f) + EPS);
            const f32x4 g0 = *(const f32x4*)gam, g1 = *(const f32x4*)(gam + 4);
            u32x4 o; o.x = pk2(f[0] * rinv * g0.x, f[1] * rinv * g0.y); o.y = pk2(f[2] * rinv * g0.z, f[3] * rinv * g0.w);
            o.z = pk2(f[4] * rinv * g1.x, f[5] * rinv * g1.y); o.w = pk2(f[6] * rinv * g1.z, f[7] * rinv * g1.w);
            *(u32x4*)(MX + (size_t)m * DM + part * 512 + 8 * C.lane) = o;
        }
    }
}
__device__ __forceinline__ void phase_norm2(const Ctx& C, const Params& P) {
    bf16_t* HN = (bf16_t*)(P.ws + WS_BUFA);
    const int gw = C.bid * NWAVES + C.wave, NGW = C.G * NWAVES;
    for (int m = gw; m < SEQ; m += NGW) norm_row_to_bf16(P.out + (size_t)m * DM, P.in[I_N2G], HN + (size_t)m * DM, C.lane);
}

__device__ __forceinline__ void peer_topk_tile(const Ctx& C, const Params& P, int tok0) {
    const bf16_t* QP = (const bf16_t*)(P.ws + WS_QP);
    const bf16_t* SK = (const bf16_t*)(P.ws + WS_SUBK);
    int* IDX = (int*)(P.ws + WS_IDX); float* GW = (float*)(P.ws + WS_GW);
    LAS u32* lists = (LAS u32*)C.lds;
    const int c = C.lane & 31, h = C.lane >> 5;
    __syncthreads();
#pragma unroll 1
    for (int task = C.wave; task < 32; task += NWAVES) {
        const int tgp = task & 1, hs = task >> 1;
        const int tl = tgp * 32 + c;
        const bf16_t* qrow = QP + (size_t)(tok0 + tl) * 2048 + hs * 128;
        bf16x8 qf[8];
#pragma unroll
        for (int ks = 0; ks < 8; ++ks) qf[ks] = *(const bf16x8*)(qrow + 16 * ks + 8 * h);
        u32 g[4][16];
#pragma unroll
        for (int kb = 0; kb < 4; ++kb) {
            f32x16 acc = {0.f, 0.f, 0.f, 0.f, 0.f, 0.f, 0.f, 0.f, 0.f, 0.f, 0.f, 0.f, 0.f, 0.f, 0.f, 0.f};
            const bf16_t* krow = SK + (size_t)(hs * 128 + kb * 32 + c) * 128;
#pragma unroll
            for (int ks = 0; ks < 8; ++ks) acc = MFMA32(*(const bf16x8*)(krow + 16 * ks + 8 * h), qf[ks], acc);
#pragma unroll
            for (int r = 0; r < 16; ++r) { const int key = kb * 32 + (r & 3) + 8 * (r >> 2) + 4 * h; g[kb][r] = (f2ord(acc[r]) & ~0x7Fu) | (u32)(127 - key); }
        }
        top16_of_64(g[0], g[1], g[2], g[3]);
        u32 pb[16];
#pragma unroll
        for (int i = 0; i < 16; ++i) pb[i] = (u32)__shfl_xor((int)g[0][i], 32);
        merge_top16(g[0], pb);
        if (h == 0) {
            LAS u32x4* dst = (LAS u32x4*)(lists + (tl * 16 + hs) * 16);
#pragma unroll
            for (int i = 0; i < 4; ++i) { u32x4 w; w.x = g[0][4 * i]; w.y = g[0][4 * i + 1]; w.z = g[0][4 * i + 2]; w.w = g[0][4 * i + 3]; dst[i] = w; }
        }
    }
    __syncthreads();
    {
        const int tl = C.tid & 63, hd = C.tid >> 6;
        const LAS u32* L1 = lists + (tl * 16 + hd * 2) * 16; const LAS u32* L2 = L1 + 16;
        float v1[16], v2[16];
#pragma unroll
        for (int i = 0; i < 16; ++i) { v1[i] = ord2f(L1[i] & ~0x7Fu); v2[i] = ord2f(L2[i] & ~0x7Fu); }
        u32 cd[4][16];
        { int cid = 0;
#pragma unroll
          for (int a = 0; a < 16; ++a)
#pragma unroll
              for (int b = 0; b < 16; ++b) if ((a + 1) * (b + 1) <= 16) { cd[cid >> 4][cid & 15] = (f2ord(v1[a] + v2[b]) & ~0x3Fu) | (u32)(63 - cid); ++cid; }
#pragma unroll
          for (int k = 50; k < 64; ++k) cd[k >> 4][k & 15] = 0u; }
        top16_of_64(cd[0], cd[1], cd[2], cd[3]);
        float sc[16]; int ix[16]; float mx = -1e30f;
#pragma unroll
        for (int k = 0; k < 16; ++k) {
            const int cid = 63 - (int)(cd[0][k] & 63u); const int ab = CAND_AB[cid];
            const u32 k1 = L1[ab >> 4], k2 = L2[ab & 15];
            sc[k] = ord2f(k1 & ~0x7Fu) + ord2f(k2 & ~0x7Fu);
            ix[k] = (127 - (int)(k1 & 0x7Fu)) * 128 + (127 - (int)(k2 & 0x7Fu));
            mx = fmaxf(mx, sc[k]);
        }
        float sum = 0.f;
#pragma unroll
        for (int k = 0; k < 16; ++k) { sc[k] = __expf(sc[k] - mx); sum += sc[k]; }
        const float inv = 1.0f / sum;
        int* io = IDX + (size_t)(tok0 + tl) * 128 + hd * 16; float* go = GW + (size_t)(tok0 + tl) * 128 + hd * 16;
#pragma unroll
        for (int k = 0; k < 16; k += 4) {
            *(int4*)(io + k) = make_int4(ix[k], ix[k + 1], ix[k + 2], ix[k + 3]);
            f32x4 gv = {sc[k] * inv, sc[k + 1] * inv, sc[k + 2] * inv, sc[k + 3] * inv}; *(f32x4*)(go + k) = gv;
        }
    }
    __syncthreads();
}

__device__ __forceinline__ int reduce64(int (&r)[64], int lane) {
#pragma unroll
    for (int e = 0; e < 32; ++e) { const auto p = __builtin_amdgcn_permlane32_swap((u32)r[e], (u32)r[e + 32], false, false); r[e] = (int)p[0] + (int)p[1]; }
#pragma unroll
    for (int e = 0; e < 16; ++e) { const auto p = __builtin_amdgcn_permlane16_swap((u32)r[e], (u32)r[e + 16], false, false); r[e] = (int)p[0] + (int)p[1]; }
    const bool b3 = (lane & 8) != 0, b2 = (lane & 4) != 0, b1 = (lane & 2) != 0, b0 = (lane & 1) != 0;
#pragma unroll
    for (int e = 0; e < 8; ++e) { const int keep = b3 ? r[e + 8] : r[e], send = b3 ? r[e] : r[e + 8]; r[e] = keep + __builtin_amdgcn_update_dpp(0, send, 0x128, 0xf, 0xf, true); }
#pragma unroll
    for (int e = 0; e < 4; ++e) { const int keep = b2 ? r[e + 4] : r[e], send = b2 ? r[e] : r[e + 4];
        int t = __builtin_amdgcn_update_dpp(0, send, 0x104, 0xf, 0x5, false);
        t = __builtin_amdgcn_update_dpp(t, send, 0x114, 0xf, 0xA, false);
        r[e] = keep + t; }
#pragma unroll
    for (int e = 0; e < 2; ++e) { const int keep = b1 ? r[e + 2] : r[e], send = b1 ? r[e] : r[e + 2]; r[e] = keep + __builtin_amdgcn_update_dpp(0, send, 0x4E, 0xf, 0xf, true); }
    { const int keep = b0 ? r[1] : r[0], send = b0 ? r[0] : r[1]; r[0] = keep + __builtin_amdgcn_update_dpp(0, send, 0xB1, 0xf, 0xf, true); }
    return r[0];
}
__device__ __forceinline__ void peer_gather_tile(const Ctx& C, const Params& P, int tok0, float osc = 1.0f) {
    const bf16_t* HN = (const bf16_t*)(P.ws + WS_BUFA);
    const unsigned char* PU = P.ws + WS_PU; const unsigned char* PV = P.ws + WS_PV;
    const float* SU = (const float*)(P.ws + WS_SU); const float* SV = (const float*)(P.ws + WS_SV);
    const int* IDX = (const int*)(P.ws + WS_IDX); const float* GW = (const float*)(P.ws + WS_GW);
    const int lane = C.lane;
#pragma unroll 1
    for (int i = 0; i < 8; ++i) {
        const int tok = tok0 + C.wave * 8 + i;
        int idx[2]; float gwt[2];
        idx[0] = IDX[(size_t)tok * 128 + lane]; idx[1] = IDX[(size_t)tok * 128 + 64 + lane];
        gwt[0] = GW[(size_t)tok * 128 + lane]; gwt[1] = GW[(size_t)tok * 128 + 64 + lane];
        {
            u32 k[2] = {((u32)idx[0] << 7) | (u32)lane, ((u32)idx[1] << 7) | (u32)(64 + lane)};
#pragma unroll
            for (int size = 2; size <= 128; size <<= 1) {
#pragma unroll
                for (int j = size >> 1; j > 0; j >>= 1) {
                    u32 nk[2];
#pragma unroll
                    for (int r = 0; r < 2; ++r) {
                        const int ii = lane + 64 * r;
                        const bool asc = (ii & size) == 0, lower = (ii & j) == 0;
                        const u32 mine = k[r], other = (j == 64) ? k[r ^ 1] : (u32)__shfl_xor((int)k[r], j);
                        const u32 mn = mine < other ? mine : other, mx = mine < other ? other : mine;
                        nk[r] = (lower == asc) ? mn : mx;
                    }
                    k[0] = nk[0]; k[1] = nk[1];
                }
            }
            const float g0 = gwt[0], g1 = gwt[1];
#pragma unroll
            for (int r = 0; r < 2; ++r) {
                const int pos = (int)(k[r] & 127u);
                const float a = __shfl(g0, pos & 63), b = __shfl(g1, pos & 63);
                gwt[r] = (pos < 64) ? a : b; idx[r] = (int)(k[r] >> 7);
            }
        }
        int qh[4]; float sh;
        {
            float hf[16]; float m = 0.f;
#pragma unroll
            for (int j = 0; j < 4; ++j) { const u32x2 w = *(const u32x2*)(HN + (size_t)tok * DM + 256 * j + 4 * lane);
                hf[4 * j] = bflo(w.x); hf[4 * j + 1] = bfhi(w.x); hf[4 * j + 2] = bflo(w.y); hf[4 * j + 3] = bfhi(w.y); }
#pragma unroll
            for (int d = 0; d < 16; ++d) m = fmaxf(m, fabsf(hf[d]));
#pragma unroll
            for (int o = 1; o < 64; o <<= 1) m = fmaxf(m, __shfl_xor(m, o));
            sh = (m > 0.f) ? m * (1.0f / 127.0f) : 1.0f; const float inv = (m > 0.f) ? 127.0f / m : 0.f;
#pragma unroll
            for (int j = 0; j < 4; ++j) {
                const int q0 = (int)rintf(hf[4 * j] * inv), q1 = (int)rintf(hf[4 * j + 1] * inv), q2 = (int)rintf(hf[4 * j + 2] * inv), q3 = (int)rintf(hf[4 * j + 3] * inv);
                qh[j] = (int)((u32)(q0 & 255) | ((u32)(q1 & 255) << 8) | ((u32)(q2 & 255) << 16) | ((u32)(q3 & 255) << 24));
            }
        }
        float cc[2];
#pragma unroll
        for (int hb = 0; hb < 2; ++hb) {
            int r[64];
#pragma unroll
            for (int e = 0; e < 64; ++e) {
                const int ridx = __builtin_amdgcn_readlane(idx[hb], e);
                const u32x4 w = *(const u32x4*)(PU + (size_t)ridx * 1024 + 16 * lane);
                int a = __builtin_amdgcn_sdot4((int)w.x, qh[0], 0, false);
                a = __builtin_amdgcn_sdot4((int)w.y, qh[1], a, false);
                a = __builtin_amdgcn_sdot4((int)w.z, qh[2], a, false);
                a = __builtin_amdgcn_sdot4((int)w.w, qh[3], a, false);
                r[e] = a;
            }
            const int isum = reduce64(r, lane);
            const float z = (float)isum * SU[idx[hb]] * sh;
            cc[hb] = gelu_erf(z) * gwt[hb] * SV[idx[hb]];
        }
        const float csum = wave_sum(cc[0] + cc[1]);
        float acc[16];
#pragma unroll
        for (int d = 0; d < 16; ++d) acc[d] = 0.f;
#pragma unroll
        for (int hb = 0; hb < 2; ++hb) {
#pragma unroll 1
            for (int e0 = 0; e0 < 64; e0 += 16) {
#pragma unroll
                for (int k = 0; k < 16; ++k) {
                    const int ridx = __builtin_amdgcn_readlane(idx[hb], e0 + k);
                    const float ce = __uint_as_float((u32)__builtin_amdgcn_readlane((int)__float_as_uint(cc[hb]), e0 + k));
                    const u32x4 w = *(const u32x4*)(PV + (size_t)ridx * 1024 + 16 * lane);
#pragma unroll
                    for (int j = 0; j < 4; ++j) {
                        acc[4 * j + 0] += ce * (float)(w[j] & 0xffu); acc[4 * j + 1] += ce * (float)((w[j] >> 8) & 0xffu);
                        acc[4 * j + 2] += ce * (float)((w[j] >> 16) & 0xffu); acc[4 * j + 3] += ce * (float)(w[j] >> 24);
                    }
                }
            }
        }
        float* orow = P.out + (size_t)tok * DM;
        const float corr = 128.0f * csum;
#pragma unroll
        for (int j = 0; j < 4; ++j) {
            f32x4* p = (f32x4*)(orow + 256 * j + 4 * lane);
            f32x4 v = *p; v.x += osc * (acc[4 * j] - corr); v.y += osc * (acc[4 * j + 1] - corr); v.z += osc * (acc[4 * j + 2] - corr); v.w += osc * (acc[4 * j + 3] - corr); *p = v;
        }
    }
}

#define GAS __attribute__((address_space(1)))
typedef GAS unsigned gu32;
#define RLX_AGENT __ATOMIC_RELAXED, __HIP_MEMORY_SCOPE_AGENT
#define XB_TMO      128
#define XB_XCNT(j)  (256  + 64 * (j))
#define XB_XSUB(j)  (1280 + 64 * (j))
#define XB_XGEN(j)  (2304 + 64 * (j))
#define XB_TOP      3328
#define XB_TOPGEN   3392
#define XCD_BAR_WORDS 3456
#define XB_SPIN_CAP (1u << 18)

__device__ __forceinline__ unsigned xb_ld(unsigned* p)              { return __hip_atomic_load(p, __ATOMIC_RELAXED, __HIP_MEMORY_SCOPE_AGENT); }
__device__ __forceinline__ unsigned xb_add(unsigned* p, unsigned v) { return __hip_atomic_fetch_add(p, v, __ATOMIC_RELAXED, __HIP_MEMORY_SCOPE_AGENT); }
__device__ __forceinline__ unsigned xb_xcc_id() { return (unsigned)__builtin_amdgcn_s_getreg((3 << 11) | 20) & 0xFu; }
#define XB_SPIN(cond, bar) do { unsigned _sp = 0; while (cond) { __builtin_amdgcn_s_sleep(1); \
    if ((++_sp & 255u) == 0u) { if (xb_ld(&(bar)[XB_TMO])) break; if (_sp > XB_SPIN_CAP) { atomicAdd(&(bar)[XB_TMO], 1u); break; } } } } while (0)

struct XcdBarrier {
    unsigned* bar; unsigned x;
    volatile LAS unsigned* st;
};

__device__ __forceinline__ XcdBarrier xcd_barrier_post(unsigned* bar, volatile LAS unsigned* st) {
    XcdBarrier b; b.bar = bar; b.x = xb_xcc_id(); b.st = st;
    if (threadIdx.x == 0) (void)xb_add(&bar[XB_XCNT(b.x)], 1u);
    return b;
}
__device__ __forceinline__ void xcd_barrier_complete(unsigned* bar, unsigned x, unsigned& nloc, unsigned& nx) {
    const unsigned G = gridDim.x * gridDim.y * gridDim.z;
    unsigned sum, cnt, mine, sp = 0u;
    for (;;) {
        sum = 0u; cnt = 0u; mine = 0u;
#pragma unroll
        for (unsigned j = 0; j < 16; ++j) { const unsigned c = xb_ld(&bar[XB_XCNT(j)]); sum += c; cnt += (c > 0u) ? 1u : 0u; mine = (j == x) ? c : mine; }
        if (sum == G) break;
        __builtin_amdgcn_s_sleep(1);
        if ((++sp & 255u) == 0u) { if (xb_ld(&bar[XB_TMO])) break; if (sp > XB_SPIN_CAP) { atomicAdd(&bar[XB_TMO], 1u); break; } }
    }
    nloc = mine > 0u ? mine : 1u; nx = cnt > 0u ? cnt : 1u;
}

__device__ __forceinline__ void xcd_barrier(const XcdBarrier& b) {
    asm volatile("s_waitcnt vmcnt(0)" ::: "memory");
    __syncthreads();
    if (threadIdx.x == 0) {
        unsigned* bar = b.bar;
        __builtin_amdgcn_s_waitcnt(0);
        unsigned nloc = b.st[0], nx = b.st[1];
        if (nloc == 0u) { xcd_barrier_complete(bar, b.x, nloc, nx); b.st[0] = nloc; b.st[1] = nx; }
        const unsigned old = xb_add(&bar[XB_XSUB(b.x)], 1u);
        const unsigned gen = old / nloc;
        if (old + 1u == (gen + 1u) * nloc) {
            __builtin_amdgcn_fence(__ATOMIC_RELEASE, "agent");
            asm volatile("s_waitcnt vmcnt(0)" ::: "memory");
            const unsigned og = xb_add(&bar[XB_TOP], 1u);
            const unsigned tg = og / nx;
            if (og + 1u == (tg + 1u) * nx) xb_add(&bar[XB_TOPGEN], 1u);
            else XB_SPIN(xb_ld(&bar[XB_TOPGEN]) == tg, bar);
            __builtin_amdgcn_fence(__ATOMIC_ACQUIRE, "agent");
            xb_add(&bar[XB_XGEN(b.x)], 1u);
            asm volatile("s_waitcnt vmcnt(0)" ::: "memory");
        } else {
            XB_SPIN(xb_ld(&bar[XB_XGEN(b.x)]) == gen, bar);
            __builtin_amdgcn_fence(__ATOMIC_ACQUIRE, "agent");
            asm volatile("s_waitcnt vmcnt(0)" ::: "memory");
        }
    }
    __syncthreads();
}

constexpr int NPHASE = 11;
__global__ void __launch_bounds__(NTHR, 2) mk_fwd(Params P) {
    extern __shared__ __attribute__((aligned(16))) unsigned char lds_raw[];
    Ctx C; C.lds = (LAS unsigned char*)lds_raw; C.tid = threadIdx.x; C.lane = C.tid & 63; C.wave = __builtin_amdgcn_readfirstlane(C.tid >> 6); C.G = gridDim.x; C.bid = blockIdx.x;
    unsigned char* ws = P.ws;
    volatile LAS unsigned* MISC = (volatile LAS unsigned*)(C.lds + MISC_OFF);
    if (C.tid < 32) MISC[C.tid] = 0u;
    __syncthreads();
    XcdBarrier bar = xcd_barrier_post((unsigned*)(ws + WS_CTL) + 4096, MISC + 8);
#define SEAM(k) do { if (IN(k) && IN((k) + 1)) xcd_barrier(bar); } while (0)
#ifndef REPMASK
#define REPMASK 0
#endif
#define NREP(k) (((REPMASK >> (k)) & 1) ? 2 : 1)
#ifdef ONLY_PHASE
#define IN(k) ((k) == ONLY_PHASE && P.ph_lo <= (k) && (k) < P.ph_hi)
#else
#define IN(k) (P.ph_lo <= (k) && (k) < P.ph_hi)
#endif
    for (int rep_ = 0; rep_ < NREP(0); ++rep_) { if (rep_) xcd_barrier(bar); if (IN(0)) phase_prologue(C, P); }
    SEAM(0);
    for (int rep_ = 0; rep_ < NREP(1); ++rep_) { if (rep_) xcd_barrier(bar);
    if (IN(1)) {
        pg8::Gemm g{(const bf16_t*)(ws + WS_BUFA), (const bf16_t*)(ws + WS_WIN_T), MPAD, INW, DM}; pg8::StaticOrder S; S.init(MPAD, INW, C.G, C.bid);
        pg8::EpiBf16<0> E{(bf16_t*)(ws + WS_PROJ), INW, nullptr, 0, 0, 1.f};
        pg8::gemm_phase<pg8::EpiBf16<0>, pg8::StaticOrder, true, true>(C.lds, g, S, E);
    }
    }
    SEAM(1);
#ifdef EXTRA_BARS
    for (int xb_ = 0; xb_ < EXTRA_BARS; ++xb_) xcd_barrier(bar);
#endif
    for (int rep_ = 0; rep_ < NREP(2); ++rep_) { if (rep_) xcd_barrier(bar); if (IN(2)) phase_sloc(C, P); }
    SEAM(2);
    for (int rep_ = 0; rep_ < NREP(3); ++rep_) { if (rep_) xcd_barrier(bar);
    if (IN(3)) {
        for (int bk = C.bid; bk < 64; bk += C.G) carry_scan_block(C, P, bk);
        for (int u = C.bid; u < 256; u += C.G) attn_unit(C, P, u >> 1, u & 1);
    }
    }
    SEAM(3);
    for (int rep_ = 0; rep_ < NREP(4); ++rep_) { if (rep_) xcd_barrier(bar); if (IN(4)) phase_ssm_y(C, P); }
    SEAM(4);
    for (int rep_ = 0; rep_ < NREP(5); ++rep_) { if (rep_) xcd_barrier(bar);
    if (IN(5)) {
        pg8::Gemm g{(const bf16_t*)(ws + WS_Z), (const bf16_t*)(ws + WS_GLU_T), SEQ, 512, 512}; pg8::StaticOrder S; S.init(SEQ, 512, C.G, C.bid);
        EpiGlu E{(const bf16_t*)(ws + WS_Z), (bf16_t*)(ws + WS_SSMO), P.in[I_GLUB]};
        pg8::gemm_phase<EpiGlu, pg8::StaticOrder, true, true>(C.lds, g, S, E);
    }
    }
    SEAM(5);
    for (int rep_ = 0; rep_ < NREP(6); ++rep_) { if (rep_) xcd_barrier(bar); if (IN(6)) phase_mix_norm(C, P); }
    SEAM(6);
    for (int rep_ = 0; rep_ < NREP(7); ++rep_) { if (rep_) xcd_barrier(bar);
    if (IN(7)) {
        pg8::Gemm g{(const bf16_t*)(ws + WS_BUFA), (const bf16_t*)(ws + WS_WOUT_T), SEQ, DM, DM}; pg8::StaticOrder S; S.init(SEQ, DM, C.G, C.bid);
        EpiRes E{P.in[I_X], P.out};
        pg8::gemm_phase<EpiRes, pg8::StaticOrder, true, true>(C.lds, g, S, E);
    }
    }
    SEAM(7);
    for (int rep_ = 0; rep_ < NREP(8); ++rep_) { if (rep_) xcd_barrier(bar); if (IN(8)) phase_norm2(C, P); }
    SEAM(8);
    for (int rep_ = 0; rep_ < NREP(9); ++rep_) { if (rep_) xcd_barrier(bar);
    if (IN(9)) {
        pg8::Gemm g{(const bf16_t*)(ws + WS_BUFA), (const bf16_t*)(ws + WS_WQ_T), SEQ, 2048, DM}; pg8::StaticOrder S; S.init(SEQ, 2048, C.G, C.bid);
        pg8::EpiBf16<0> E{(bf16_t*)(ws + WS_QP), 2048, nullptr, 0, 0, 1.f};
        pg8::gemm_phase<pg8::EpiBf16<0>, pg8::StaticOrder, true, true>(C.lds, g, S, E);
    }
    }
    SEAM(9);
    for (int rep_ = 0; rep_ < NREP(10); ++rep_) { if (rep_) xcd_barrier(bar);
    if (IN(10)) {
        for (int tile = C.bid; tile < SEQ / 64; tile += C.G) {
            peer_topk_tile(C, P, tile * 64);
            if ((REPMASK >> 11) & 1) peer_topk_tile(C, P, tile * 64);
            if ((REPMASK >> 12) & 1) peer_gather_tile(C, P, tile * 64, P.zero);
            peer_gather_tile(C, P, tile * 64, P.one);
        }
    }
    }
#undef IN
#undef SEAM
}
}

extern "C" void kernel_launch(void* const* d_in, const int* in_sizes, int n_in, void* d_out, int out_size, void* d_ws, size_t ws_size, hipStream_t stream) {
    static int state = 0, grid = 0;
    if (state == 0) {
        if (n_in != 25 || out_size != mk::SEQ * mk::DM || ws_size < mk::WS_END) { fprintf(stderr, "kernel_launch: unexpected shapes (n_in %d out %d ws %zu)\n", n_in, out_size, ws_size); state = -1; return; }
        if (hipFuncSetAttribute((const void*)mk::mk_fwd, hipFuncAttributeMaxDynamicSharedMemorySize, mk::LDS_BYTES) != hipSuccess) { fprintf(stderr, "kernel_launch: hipFuncSetAttribute failed\n"); state = -1; return; }
        int dev = 0, cus = 0, per_cu = 0;
        if (hipGetDevice(&dev) != hipSuccess || hipDeviceGetAttribute(&cus, hipDeviceAttributeMultiprocessorCount, dev) != hipSuccess) { fprintf(stderr, "kernel_launch: device query failed\n"); state = -1; return; }
        if (hipOccupancyMaxActiveBlocksPerMultiprocessor(&per_cu, (const void*)mk::mk_fwd, mk::NTHR, mk::LDS_BYTES) != hipSuccess || per_cu < 1) { fprintf(stderr, "kernel_launch: occupancy query failed (%d)\n", per_cu); state = -1; return; }
        grid = cus;
        state = 1;
    }
    if (state < 0) return;
    mk::Params p{};
    for (int i = 0; i < 25; ++i) p.in[i] = (const float*)d_in[i];
    p.out = (float*)d_out; p.ws = (unsigned char*)d_ws;
    if (hipMemsetAsync((char*)d_ws + mk::WS_CTL, 0, 65536, stream) != hipSuccess) { fprintf(stderr, "kernel_launch: memset failed\n"); return; }
    p.ph_lo = 0; p.ph_hi = mk::NPHASE; p.one = 1.0f; p.zero = 0.0f;
    void* args[] = {&p};
    hipError_t e = hipLaunchCooperativeKernel((const void*)mk::mk_fwd, dim3(grid), dim3(mk::NTHR), args, mk::LDS_BYTES, stream);
    if (e != hipSuccess) fprintf(stderr, "kernel_launch: cooperative launch failed: %s (grid %d)\n", hipGetErrorString(e), grid);
}
```

```cpp
#include <hip/hip_runtime.h>
#include <cstdio>
#include <cstdint>
#include <cmath>
namespace pg8 {
#define PG8_LAS __attribute__((address_space(3)))
typedef unsigned short bf16_t;
typedef short bf16x8 __attribute__((ext_vector_type(8)));
typedef float f32x4 __attribute__((ext_vector_type(4)));
typedef unsigned u32x4 __attribute__((ext_vector_type(4)));
constexpr int BM = 256, BK = 64, HALF = 128, HTB = HALF * BK * 2  , STAGE_BYTES = 8 * HTB, NXCD = 8, WGM = 8;

__host__ __device__ __forceinline__ int lds_byte(int r, int c) { const int st = (r >> 4) * 2 + (c >> 5), rr = r & 15, cc = c & 31, ob = rr * 64 + cc * 2; return st * 1024 + (ob ^ (((ob >> 9) & 1) << 5)); }
__host__ __device__ __forceinline__ void stage_rc(int b, int& R, int& C) { const int st = b / 1024, sb = b % 1024, swz = sb ^ (((sb >> 9) & 1) << 5); R = (st >> 1) * 16 + swz / 64; C = (st & 1) * 32 + (swz % 64) / 2; }
__host__ __device__ __forceinline__ int perm32(int rho) { const int n = rho >> 4, i = rho & 15; return 8 * (i >> 2) + 4 * n + (i & 3); }

struct Unit { int pm, pn; };
struct Gemm { const bf16_t* A; const bf16_t* Bt; int M, N, K; };

struct StaticOrder {
    int nM, nN, nwg, G, c;
    __host__ __device__ void init(int M, int N, int G_, int c_) { nM = M / BM; nN = N / BM; nwg = nM * nN; G = G_; c = c_; }
    __host__ __device__ bool next(int i, Unit& u) const {
        const long L = (long)i * G + c; if (L >= nwg) return false;
        int wgid = (int)L; { const int q = nwg / NXCD, r = nwg % NXCD, xcd = wgid % NXCD, off = wgid / NXCD; wgid = (xcd < r ? xcd * (q + 1) : r * (q + 1) + (xcd - r) * q) + off; }
        const int nig = WGM * nN, gid = wgid / nig, fm = gid * WGM, gsz = (nM - fm) < WGM ? (nM - fm) : WGM;
        u.pm = fm + ((wgid % nig) % gsz); u.pn = (wgid % nig) / gsz; return true;
    }
    __device__ __forceinline__ void a_ready(const Unit&) const {}
    __device__ __forceinline__ void done(const Unit&) const {}
};

__device__ __forceinline__ unsigned cvt_pk_bf16(float lo, float hi) { unsigned r; asm volatile("v_cvt_pk_bf16_f32 %0, %1, %2" : "=v"(r) : "v"(lo), "v"(hi)); return r; }
typedef float f32x2 __attribute__((ext_vector_type(2)));
__device__ __forceinline__ f32x2 gelu_pk(f32x2 v) {
    const f32x2 av = __builtin_elementwise_abs(v), d = av * 0.2316418882f + 1.0f;
    f32x2 t; t.x = __builtin_amdgcn_rcpf(d.x); t.y = __builtin_amdgcn_rcpf(d.y);
    f32x2 q = t * 0.5307027145f + (-0.7265760135f); q = q * t + 0.7107068705f; q = q * t + (-0.142248368f); q = q * t + 0.127414796f; q = q * t;
    const f32x2 s = (v * v) * (-0.72134752044f);
    f32x2 e; e.x = __builtin_amdgcn_exp2f(s.x); e.y = __builtin_amdgcn_exp2f(s.y);
    const f32x2 m = v * (q * e), r = v - m;
    f32x2 o; o.x = v.x < 0.f ? m.x : r.x; o.y = v.y < 0.f ? m.y : r.y; return o;
}

template <int ACT  > struct EpiBf16 {
    static constexpr bool PERM = true, AFTER_DRAIN = false, HAS_MID = false; static_assert(ACT == 0 || ACT == 1, "EpiBf16: ACT is 0 (none) or 1 (gelu_pk)");
    bf16_t* O; int ldc; const float* bias; int split_cols; size_t split_stride; float scale0;
    __device__ __forceinline__ void operator()(const f32x4 (&acc)[2][2][4][2], const Unit& u, int wr, int wc, int fr, int fq) const {
        const int row0 = u.pm * BM + wr * 64 + fr; int colt = u.pn * BM; bf16_t* base = O;
        float sc = 1.f; if (split_cols) { const int t = colt / split_cols; base += (size_t)t * split_stride; colt -= t * split_cols; if (t == 0) sc = scale0; }
        const int col0 = colt + wc * 32 + 8 * fq, bcol0 = u.pn * BM + wc * 32 + 8 * fq;
        f32x4 bv[2][2];
#pragma unroll
        for (int bj = 0; bj < 2; ++bj)
#pragma unroll
            for (int n = 0; n < 2; ++n) bv[bj][n] = bias ? *(const f32x4*)(bias + bcol0 + bj * HALF + 4 * n) : (f32x4){0.f, 0.f, 0.f, 0.f};
#pragma unroll
        for (int ai = 0; ai < 2; ++ai)
#pragma unroll
            for (int m = 0; m < 4; ++m) { bf16_t* rowp = base + (size_t)(row0 + ai * HALF + m * 16) * ldc + col0;
#pragma unroll
                for (int bj = 0; bj < 2; ++bj) { f32x4 v0 = acc[ai][bj][m][0] + bv[bj][0], v1 = acc[ai][bj][m][1] + bv[bj][1];
                    if (ACT == 1) { f32x2 a = gelu_pk((f32x2){v0[0], v0[1]}), b = gelu_pk((f32x2){v0[2], v0[3]}), c = gelu_pk((f32x2){v1[0], v1[1]}), d = gelu_pk((f32x2){v1[2], v1[3]});
                        v0 = (f32x4){a.x, a.y, b.x, b.y}; v1 = (f32x4){c.x, c.y, d.x, d.y}; }
                    v0 = v0 * sc; v1 = v1 * sc; u32x4 w; w.x = cvt_pk_bf16(v0[0], v0[1]); w.y = cvt_pk_bf16(v0[2], v0[3]); w.z = cvt_pk_bf16(v1[0], v1[1]); w.w = cvt_pk_bf16(v1[2], v1[3]);
                    *(u32x4*)(rowp + bj * HALF) = w; } }
    }
};
template <class Epi, class Sched, bool ALIGN_EPI = false, bool SP2 = false>
__device__ __forceinline__ void gemm_phase(PG8_LAS unsigned char* lds, const Gemm g, const Sched& S, const Epi& E) {
    const int tid = threadIdx.x, wid = __builtin_amdgcn_readfirstlane(tid >> 6), lane = tid & 63, wr = wid >> 2, wc = wid & 3, fr = lane & 15, fq = lane >> 4;
    const int K = g.K, nt = K / BK;
    unsigned voffA[2], voffB[2];
#pragma unroll
    for (int i = 0; i < 2; ++i) { int R, C; stage_rc(tid * 16 + i * 8192, R, C); const int Rb = Epi::PERM ? ((R & ~31) + perm32(R & 31)) : R;
        voffA[i] = (unsigned)(R * K + C) * 2u; voffB[i] = (unsigned)(Rb * K + C) * 2u; }
    const size_t kstep = (size_t)(BK * 2);
    const size_t hstep = (size_t)HALF * K * 2;
    const size_t tstep = 2 * hstep;
    const unsigned ldsw = (unsigned)wid * 1024u;
    const int aoff = lds_byte(wr * 64 + fr, fq * 8), boff = lds_byte(wc * 32 + fr, fq * 8);
#define PG8_SA(b, h) (((b) * 2 + (h)) * HTB)
#define PG8_SB(b, h) ((4 + (b) * 2 + (h)) * HTB)
#define PG8_STAGE(bufoff, gbase, voff) do { _Pragma("unroll") for (int _i = 0; _i < 2; ++_i) \
        __builtin_amdgcn_global_load_lds((const unsigned*)((const char*)(gbase) + (voff)[_i]), (PG8_LAS unsigned*)(lds + (bufoff) + ldsw + _i * 8192), 16, 0, 0); } while (0)
#define PG8_LDA(dst, b, h) do { _Pragma("unroll") for (int m = 0; m < 4; ++m) _Pragma("unroll") for (int k = 0; k < 2; ++k) dst[m][k] = *(const PG8_LAS bf16x8*)(lds + PG8_SA(b, h) + aoff + m * 2048 + k * 1024); } while (0)
#define PG8_LDB(dst, b, h) do { _Pragma("unroll") for (int n = 0; n < 2; ++n) _Pragma("unroll") for (int k = 0; k < 2; ++k) dst[n][k] = *(const PG8_LAS bf16x8*)(lds + PG8_SB(b, h) + boff + n * 2048 + k * 1024); } while (0)
#define PG8_MMA(ai, bj, At, Bt) do { __builtin_amdgcn_s_setprio(1); _Pragma("unroll") for (int m = 0; m < 4; ++m) _Pragma("unroll") for (int n = 0; n < 2; ++n) _Pragma("unroll") for (int k = 0; k < 2; ++k) \
        acc[ai][bj][m][n] = __builtin_amdgcn_mfma_f32_16x16x32_bf16(Bt[n][k], At[m][k], acc[ai][bj][m][n], 0, 0, 0); __builtin_amdgcn_s_setprio(0); } while (0)
#define PG8_WAIT_V(n) asm volatile("s_waitcnt vmcnt(" #n ")" ::: "memory")
#define PG8_WAIT_L(n) asm volatile("s_waitcnt lgkmcnt(" #n ")" ::: "memory")
#define PG8_BAR __builtin_amdgcn_s_barrier()
#define PG8_SCHED __builtin_amdgcn_sched_barrier(0)
    Unit cur, nxt; int ui = 0;
    if (!S.next(0, cur)) return;
    f32x4 acc[2][2][4][2];
#pragma unroll
    for (int a = 0; a < 2; ++a)
#pragma unroll
        for (int b = 0; b < 2; ++b)
#pragma unroll
            for (int m = 0; m < 4; ++m)
#pragma unroll
                for (int n = 0; n < 2; ++n) acc[a][b][m][n] = (f32x4){0.f, 0.f, 0.f, 0.f};
    bf16x8 At[4][2], B0[2][2], B1[2][2];
    const char* cA = (const char*)g.A + (size_t)cur.pm * tstep; const char* cB = (const char*)g.Bt + (size_t)cur.pn * tstep;
    S.a_ready(cur);
    if constexpr (SP2) {
        PG8_STAGE(PG8_SB(0, 0), cB, voffB); PG8_STAGE(PG8_SB(0, 1), cB + hstep, voffB); PG8_STAGE(PG8_SA(0, 0), cA, voffA); PG8_STAGE(PG8_SA(0, 1), cA + hstep, voffA);
        if (wr == 1) PG8_BAR;
        PG8_WAIT_V(2); PG8_BAR;
        PG8_STAGE(PG8_SB(1, 0), cB + kstep, voffB); PG8_STAGE(PG8_SA(1, 0), cA + kstep, voffA); PG8_STAGE(PG8_SB(1, 1), cB + hstep + kstep, voffB);
        PG8_WAIT_V(6); PG8_BAR;
    } else {
        PG8_STAGE(PG8_SB(0, 0), cB, voffB); PG8_STAGE(PG8_SA(0, 0), cA, voffA); PG8_STAGE(PG8_SB(0, 1), cB + hstep, voffB); PG8_STAGE(PG8_SA(0, 1), cA + hstep, voffA);
        if (wr == 1) PG8_BAR;
        PG8_WAIT_V(4); PG8_BAR;
        PG8_STAGE(PG8_SB(1, 0), cB + kstep, voffB); PG8_STAGE(PG8_SA(1, 0), cA + kstep, voffA); PG8_STAGE(PG8_SB(1, 1), cB + hstep + kstep, voffB);
        PG8_WAIT_V(6); PG8_BAR;
    }
    for (;;) {
        const bool has_next = S.next(ui + 1, nxt);
        const char* nA = has_next ? (const char*)g.A + (size_t)nxt.pm * tstep : cA; const char* nB = has_next ? (const char*)g.Bt + (size_t)nxt.pn * tstep : cB;
        for (int t = 0; t < nt; t += 2) {
            const bool last = (t == nt - 2);
            if constexpr (Epi::HAS_MID) { if (t == nt / 2) E.mid(acc, cur, wr, wc, fr, fq, lds); }
            const char* a1 = cA + (size_t)(t + 1) * kstep;
            const char* a2 = last ? nA : cA + (size_t)(t + 2) * kstep; const char* b2 = last ? nB : cB + (size_t)(t + 2) * kstep;
            const char* a3 = a2 + kstep; const char* b3 = b2 + kstep;
            if (last && has_next) S.a_ready(nxt);
            if constexpr (SP2) {
            PG8_LDB(B0, 0, 0); PG8_LDB(B1, 0, 1); PG8_SCHED; PG8_LDA(At, 0, 0); PG8_STAGE(PG8_SA(1, 1), a1 + hstep, voffA);
            PG8_WAIT_V(8); PG8_WAIT_L(0); PG8_BAR; PG8_MMA(0, 0, At, B0); PG8_MMA(0, 1, At, B1); PG8_BAR; PG8_SCHED;
            PG8_LDA(At, 0, 1); PG8_STAGE(PG8_SB(0, 0), b2, voffB); PG8_STAGE(PG8_SB(0, 1), b2 + hstep, voffB); PG8_STAGE(PG8_SA(0, 0), a2, voffA);
            PG8_WAIT_V(8); PG8_WAIT_L(0); PG8_BAR; PG8_MMA(1, 0, At, B0); PG8_MMA(1, 1, At, B1); PG8_BAR; PG8_SCHED;
            PG8_LDB(B0, 1, 0); PG8_LDB(B1, 1, 1); PG8_SCHED; PG8_LDA(At, 1, 0); PG8_STAGE(PG8_SA(0, 1), a2 + hstep, voffA);
            PG8_WAIT_V(8); PG8_WAIT_L(0); PG8_BAR; PG8_MMA(0, 0, At, B0); PG8_MMA(0, 1, At, B1); PG8_BAR; PG8_SCHED;
            PG8_LDA(At, 1, 1); PG8_STAGE(PG8_SB(1, 0), b3, voffB); PG8_STAGE(PG8_SB(1, 1), b3 + hstep, voffB); PG8_STAGE(PG8_SA(1, 0), a3, voffA);
            PG8_WAIT_V(8); PG8_WAIT_L(0); PG8_BAR; PG8_MMA(1, 0, At, B0); PG8_MMA(1, 1, At, B1); PG8_BAR; PG8_SCHED;
            } else {
            PG8_LDB(B0, 0, 0); PG8_SCHED; PG8_LDA(At, 0, 0); PG8_STAGE(PG8_SA(1, 1), a1 + hstep, voffA);
            PG8_WAIT_L(8); PG8_BAR; PG8_WAIT_L(0); PG8_MMA(0, 0, At, B0); PG8_BAR; PG8_SCHED;
            PG8_LDB(B1, 0, 1); PG8_STAGE(PG8_SB(0, 0), b2, voffB);
            PG8_BAR; PG8_WAIT_L(0); PG8_MMA(0, 1, At, B1); PG8_BAR;
            PG8_LDA(At, 0, 1); PG8_STAGE(PG8_SA(0, 0), a2, voffA);
            PG8_BAR; PG8_WAIT_L(0); PG8_MMA(1, 0, At, B0); PG8_BAR; PG8_SCHED;
            PG8_STAGE(PG8_SB(0, 1), b2 + hstep, voffB);
            PG8_WAIT_V(6); PG8_BAR; PG8_MMA(1, 1, At, B1); PG8_BAR;
            PG8_LDB(B0, 1, 0); PG8_SCHED; PG8_LDA(At, 1, 0); PG8_STAGE(PG8_SA(0, 1), a2 + hstep, voffA);
            PG8_WAIT_L(8); PG8_BAR; PG8_WAIT_L(0); PG8_MMA(0, 0, At, B0); PG8_BAR; PG8_SCHED;
            PG8_LDB(B1, 1, 1); PG8_STAGE(PG8_SB(1, 0), b3, voffB);
            PG8_BAR; PG8_WAIT_L(0); PG8_MMA(0, 1, At, B1); PG8_BAR;
            PG8_LDA(At, 1, 1); PG8_STAGE(PG8_SA(1, 0), a3, voffA);
            PG8_BAR; PG8_WAIT_L(0); PG8_MMA(1, 0, At, B0); PG8_BAR; PG8_SCHED;
            PG8_STAGE(PG8_SB(1, 1), b3 + hstep, voffB);
            PG8_WAIT_V(6); PG8_BAR; PG8_MMA(1, 1, At, B1); PG8_BAR;
            }
        }
        if constexpr (ALIGN_EPI) { if (wr == 0) PG8_BAR; }
        if constexpr (!Epi::AFTER_DRAIN) { E(acc, cur, wr, wc, fr, fq); S.done(cur); }
        if (!has_next) break;
#pragma unroll
        for (int a = 0; a < 2; ++a)
#pragma unroll
            for (int b = 0; b < 2; ++b)
#pragma unroll
                for (int m = 0; m < 4; ++m)
#pragma unroll
                    for (int n = 0; n < 2; ++n) acc[a][b][m][n] = (f32x4){0.f, 0.f, 0.f, 0.f};
        cur = nxt; cA = nA; cB = nB; ++ui;
        if constexpr (ALIGN_EPI) { if (wr == 1) PG8_BAR; }
    }
    PG8_WAIT_V(0);
    if constexpr (!ALIGN_EPI) { if (wr == 0) PG8_BAR; }
    PG8_BAR;
    if constexpr (Epi::AFTER_DRAIN) { E.fused(acc, cur, wr, wc, fr, fq, lds, wid, lane); S.done(cur); }
#undef PG8_SA
#undef PG8_SB
#undef PG8_STAGE
#undef PG8_LDA
#undef PG8_LDB
#undef PG8_MMA
#undef PG8_WAIT_V
#undef PG8_WAIT_L
#undef PG8_BAR
#undef PG8_SCHED
}
}

namespace mk {
#define LAS __attribute__((address_space(3)))
typedef unsigned short bf16_t;
typedef short bf16x8 __attribute__((ext_vector_type(8)));
typedef float f32x4 __attribute__((ext_vector_type(4)));
typedef float f32x16 __attribute__((ext_vector_type(16)));
typedef unsigned u32x4 __attribute__((ext_vector_type(4)));
typedef unsigned u32x2 __attribute__((ext_vector_type(2)));
typedef __bf16 bf16x2_t __attribute__((ext_vector_type(2)));
typedef float f32x2_t __attribute__((ext_vector_type(2)));
typedef unsigned u32;

constexpr int DM = 1024, SEQ = 16384, NMETA = 16, MPAD = 16640, INW = 1280;
constexpr int O_K = 512, O_V = 640, O_U = 768;
constexpr int NCH = 513;
constexpr float EPS = 1e-6f;
constexpr float LOG2E = 1.4426950408889634f;
constexpr int NWAVES = 8, NTHR = 512;
constexpr int LDS_BYTES = 163840;
constexpr int MISC_OFF = LDS_BYTES - 128;

constexpr size_t MiB = 1u << 20;
constexpr size_t WS_CTL = 0, CTL_BYTES = 1 * MiB;
constexpr size_t WS_WIN_T = 1 * MiB;
constexpr size_t WS_WOUT_T = 4 * MiB;
constexpr size_t WS_WQ_T = 6 * MiB;
constexpr size_t WS_GLU_T = 10 * MiB;
constexpr size_t WS_SUBK = 10 * MiB + 512 * 1024;
constexpr size_t WS_KT = 11 * MiB;
constexpr size_t WS_F = 12 * MiB;
constexpr size_t WS_E = 16 * MiB;
constexpr size_t WS_ABART = 20 * MiB;
constexpr size_t WS_SLOC = 21 * MiB;
constexpr size_t WS_CARRY = 30 * MiB;
constexpr size_t WS_BUFA = 39 * MiB;
constexpr size_t WS_PROJ = 72 * MiB;
constexpr size_t WS_ATTN = 113 * MiB;
constexpr size_t WS_Z = 129 * MiB;
constexpr size_t WS_SSMO = 145 * MiB;
constexpr size_t WS_QP = 72 * MiB;
constexpr size_t WS_IDX = 161 * MiB;
constexpr size_t WS_GW = 169 * MiB;
constexpr size_t WS_PU = 177 * MiB;
constexpr size_t WS_PV = 193 * MiB;
constexpr size_t WS_SU = 209 * MiB;
constexpr size_t WS_SV = 209 * MiB + 65536;
constexpr size_t WS_HB = 210 * MiB;
constexpr size_t WS_SSA = 242 * MiB;
constexpr size_t WS_SSS = 242 * MiB + 512 * 1024;
constexpr size_t WS_SSH = 243 * MiB;
constexpr size_t WS_END = 245 * MiB;

struct Params { const float* in[25]; float* out; unsigned char* ws; int ph_lo, ph_hi; float one, zero; };
enum { I_X = 0, I_META, I_N1G, I_WIN, I_QNG, I_KNG, I_SINK, I_ARE, I_AIM, I_LDT, I_BRE, I_BIM, I_CRE, I_CIM, I_SD, I_GLUW, I_GLUB, I_AOG, I_SOG, I_WOUT, I_N2G, I_WQ, I_SUBK, I_PU, I_PV };

__device__ __forceinline__ unsigned pk2(float lo, float hi) { f32x2_t v = {lo, hi}; return __builtin_bit_cast(unsigned, __builtin_convertvector(v, bf16x2_t)); }
__device__ __forceinline__ float bflo(unsigned w) { return __uint_as_float(w << 16); }
__device__ __forceinline__ float bfhi(unsigned w) { return __uint_as_float(w & 0xffff0000u); }
__device__ __forceinline__ float wave_sum(float v) {
#pragma unroll
    for (int o = 1; o < 64; o <<= 1) v += __shfl_xor(v, o);
    return v;
}
#define LDS_WAIT() asm volatile("s_waitcnt lgkmcnt(0)" ::: "memory")
__device__ __forceinline__ float gelu_erf(float v) { return 0.5f * v * (1.0f + erff(v * 0.70710678118654752f)); }
__device__ __forceinline__ u32 f2ord(float f) { const u32 u = __float_as_uint(f); return (u & 0x80000000u) ? ~u : (u | 0x80000000u); }
__device__ __forceinline__ float ord2f(u32 o) { const u32 u = (o & 0x80000000u) ? (o & 0x7fffffffu) : ~o; return __uint_as_float(u); }
#define MFMA16(a, b, c) __builtin_amdgcn_mfma_f32_16x16x32_bf16((a), (b), (c), 0, 0, 0)
#define MFMA32(a, b, c) __builtin_amdgcn_mfma_f32_32x32x16_bf16((a), (b), (c), 0, 0, 0)

#define CEX(x, i, j) do { const u32 _a = x[i], _b = x[j]; x[i] = _a > _b ? _a : _b; x[j] = _a > _b ? _b : _a; } while (0)
__device__ __forceinline__ void sort16_desc(u32 (&x)[16]) {
#pragma unroll
    for (int k = 2; k <= 16; k <<= 1) {
#pragma unroll
        for (int j = k >> 1; j > 0; j >>= 1) {
#pragma unroll
            for (int i = 0; i < 16; ++i) { const int l = i ^ j; if (l > i) { if ((i & k) == 0) CEX(x, i, l); else CEX(x, l, i); } }
        }
    }
}
__device__ __forceinline__ void bmerge16_desc(u32 (&x)[16]) {
#pragma unroll
    for (int j = 8; j > 0; j >>= 1) {
#pragma unroll
        for (int i = 0; i < 16; ++i) { const int l = i ^ j; if (l > i) CEX(x, i, l); }
    }
}
__device__ __forceinline__ void merge_top16(u32 (&a)[16], const u32 (&b)[16]) {
#pragma unroll
    for (int i = 0; i < 16; ++i) a[i] = a[i] > b[15 - i] ? a[i] : b[15 - i];
    bmerge16_desc(a);
}
__device__ __forceinline__ void top16_of_64(u32 (&g0)[16], u32 (&g1)[16], u32 (&g2)[16], u32 (&g3)[16]) {
    sort16_desc(g0); sort16_desc(g1); sort16_desc(g2); sort16_desc(g3);
    merge_top16(g0, g1); merge_top16(g2, g3); merge_top16(g0, g2);
}
__device__ const unsigned char CAND_AB[64] = {0, 1, 2, 3, 4, 5, 6, 7, 8, 9, 10, 11, 12, 13, 14, 15, 16, 17, 18, 19, 20, 21, 22, 23, 32, 33, 34, 35, 36, 48, 49, 50, 51, 64, 65, 66, 80, 81, 96, 97, 112, 113, 128, 144, 160, 176, 192, 208, 224, 240, 0, 0, 0, 0, 0, 0, 0, 0, 0, 0, 0, 0, 0, 0};

struct Ctx { LAS unsigned char* lds; int tid, lane, wave, G, bid; };

__device__ __forceinline__ void transpose_item(const float* W, int K, int N, bf16_t* WT, LAS float* scr, int item, int lane, const float* ks0 = nullptr, const float* ks1 = nullptr, int ksplit = 0) {
    const int nblk = N / 32, kb = item / nblk, nb = item % nblk, k0 = 64 * kb, n0 = 32 * nb;
#pragma unroll 8
    for (int i = 0; i < 32; ++i) { const int kk = 2 * i + (lane >> 5); float w = W[(size_t)(k0 + kk) * N + n0 + (lane & 31)];
        if (ks0) { const int k = k0 + kk; w *= (ksplit && k >= ksplit) ? ks1[k - ksplit] : ks0[k]; }
        scr[kk * 33 + (lane & 31)] = w; }
    LDS_WAIT();
    const int c = lane & 7;
#pragma unroll
    for (int j = 0; j < 4; ++j) { const int n = (lane >> 3) + 8 * j; const LAS float* s = scr + (8 * c) * 33 + n;
        u32x4 o; o.x = pk2(s[0 * 33], s[1 * 33]); o.y = pk2(s[2 * 33], s[3 * 33]); o.z = pk2(s[4 * 33], s[5 * 33]); o.w = pk2(s[6 * 33], s[7 * 33]);
        *(u32x4*)(WT + (size_t)(n0 + n) * K + k0 + 8 * c) = o; }
    LDS_WAIT();
}

__device__ __forceinline__ void ssm_tables(const Ctx& C, const Params& P, int g) {
    LAS float* pwr = (LAS float*)C.lds;
    LAS float* pwi = pwr + 33 * 64;
    LAS float* bbr = pwi + 33 * 64;
    LAS float* bbi = bbr + 1024;
    LAS float* ccr = bbi + 1024;
    LAS float* cci = ccr + 1024;
    LAS float* cfr = cci + 1024;
    LAS float* cfi = cfr + 64;
    const int tid = C.tid;
    const float dt = expf(P.in[I_LDT][g]);
    for (int e = tid; e < 33 * 64; e += NTHR) {
        const int l = e >> 6, n = e & 63;
        const float lr = P.in[I_ARE][g * 64 + n], li = P.in[I_AIM][g * 64 + n];
        const float x = lr * dt * (float)l, th = li * dt * (float)l, mag = expf(x);
        float s, c; sincosf(th, &s, &c);
        pwr[e] = mag * c; pwi[e] = mag * s;
        if (l == 32) { float* abt = (float*)(P.ws + WS_ABART) + (g * 64 + n) * 2; abt[0] = mag * c; abt[1] = mag * s; }
    }
    if (tid < 64) {
        const int n = tid;
        const float lr = P.in[I_ARE][g * 64 + n], li = P.in[I_AIM][g * 64 + n];
        const float x1 = lr * dt, th1 = li * dt, em1 = expm1f(x1);
        float s1, c1; sincosf(th1, &s1, &c1);
        const float sh = sinf(0.5f * th1);
        const float nr = em1 * c1 - 2.0f * sh * sh, ni = (em1 + 1.0f) * s1;
        const float den = lr * lr + li * li;
        cfr[n] = (nr * lr + ni * li) / den; cfi[n] = (ni * lr - nr * li) / den;
    }
    __syncthreads();
    for (int e = tid; e < 1024; e += NTHR) {
        const int n = e >> 4;
        const float br = P.in[I_BRE][g * 1024 + e], bi = P.in[I_BIM][g * 1024 + e];
        bbr[e] = cfr[n] * br - cfi[n] * bi; bbi[e] = cfr[n] * bi + cfi[n] * br;
        ccr[e] = P.in[I_CRE][g * 1024 + e]; cci[e] = P.in[I_CIM][g * 1024 + e];
    }
    __syncthreads();
    bf16_t* Kt = (bf16_t*)(P.ws + WS_KT) + (size_t)g * 8448;
    {
        const int pq = tid & 255, p = pq >> 4, q = pq & 15, l0 = (tid >> 8) * 16;
        float cbr[64], cbi[64];
#pragma unroll
        for (int n = 0; n < 64; ++n) { const float cr = ccr[p * 64 + n], ci = cci[p * 64 + n], br = bbr[n * 16 + q], bi = bbi[n * 16 + q]; cbr[n] = cr * br - ci * bi; cbi[n] = cr * bi + ci * br; }
#pragma unroll 1
        for (int lg = l0; lg < l0 + 16; ++lg) {
            float val = 0.f;
#pragma unroll
            for (int n = 0; n < 64; n += 4) {
                const f32x4 ar = *(const LAS f32x4*)(pwr + lg * 64 + n), ai = *(const LAS f32x4*)(pwi + lg * 64 + n);
                val += cbr[n] * ar.x - cbi[n] * ai.x; val += cbr[n + 1] * ar.y - cbi[n + 1] * ai.y; val += cbr[n + 2] * ar.z - cbi[n + 2] * ai.z; val += cbr[n + 3] * ar.w - cbi[n + 3] * ai.w;
            }
            Kt[(lg + 1) * 256 + pq] = (bf16_t)(pk2(val, 0.f) & 0xffffu);
        }
        if (tid < 256) Kt[tid] = 0;
    }
    bf16_t* F = (bf16_t*)(P.ws + WS_F) + (size_t)g * 65536;
    for (int e8 = tid; e8 < 8192; e8 += NTHR) {
        const int n2 = e8 >> 6, k0 = (e8 & 63) * 8, j = k0 >> 4, q0 = k0 & 15, n = n2 & 63, l = 31 - j;
        const float ar = pwr[l * 64 + n], ai = pwi[l * 64 + n];
        float w[8];
#pragma unroll
        for (int i = 0; i < 8; ++i) { const float br = bbr[n * 16 + q0 + i], bi = bbi[n * 16 + q0 + i]; w[i] = (n2 < 64) ? (ar * br - ai * bi) : (ar * bi + ai * br); }
        u32x4 o; o.x = pk2(w[0], w[1]); o.y = pk2(w[2], w[3]); o.z = pk2(w[4], w[5]); o.w = pk2(w[6], w[7]);
        *(u32x4*)(F + (size_t)e8 * 8) = o;
    }
    bf16_t* E = (bf16_t*)(P.ws + WS_E) + (size_t)g * 65536;
    for (int e8 = tid; e8 < 8192; e8 += NTHR) {
        const int row = e8 >> 4, n20 = (e8 & 15) * 8, t = row >> 4, p = row & 15, n0 = n20 & 63;
        float w[8];
#pragma unroll
        for (int i = 0; i < 8; ++i) { const int n = n0 + i; const float pr = pwr[(t + 1) * 64 + n], pi = pwi[(t + 1) * 64 + n], cr = ccr[p * 64 + n], ci = cci[p * 64 + n];
            w[i] = (n20 < 64) ? (cr * pr - ci * pi) : -(cr * pi + ci * pr); }
        u32x4 o; o.x = pk2(w[0], w[1]); o.y = pk2(w[2], w[3]); o.z = pk2(w[4], w[5]); o.w = pk2(w[6], w[7]);
        *(u32x4*)(E + (size_t)e8 * 8) = o;
    }
    __syncthreads();
}

__device__ __forceinline__ void norm_row_to_bf16(const float* src, const float* gam, bf16_t* dst, int lane) {
    const f32x4* xr = (const f32x4*)src + lane; const f32x4* gr = (const f32x4*)gam + lane;
    f32x4 v[4]; float s = 0.f;
#pragma unroll
    for (int j = 0; j < 4; ++j) { v[j] = xr[64 * j]; s += (v[j].x * v[j].x + v[j].y * v[j].y) + (v[j].z * v[j].z + v[j].w * v[j].w); }
    const float rinv = 1.0f / sqrtf(wave_sum(s) * (1.0f / DM) + EPS);
    u32x2* o = (u32x2*)dst + lane;
#pragma unroll
    for (int j = 0; j < 4; ++j) { const f32x4 g = gr[64 * j]; u32x2 w; w.x = pk2(v[j].x * rinv * g.x, v[j].y * rinv * g.y); w.y = pk2(v[j].z * rinv * g.z, v[j].w * rinv * g.w); o[64 * j] = w; }
}

__device__ __forceinline__ void cvt8(const float* src, bf16_t* dst, size_t i) {
    const f32x4 a = ((const f32x4*)src)[2 * i], b = ((const f32x4*)src)[2 * i + 1];
    u32x4 o; o.x = pk2(a.x, a.y); o.y = pk2(a.z, a.w); o.z = pk2(b.x, b.y); o.w = pk2(b.z, b.w);
    ((u32x4*)dst)[i] = o;
}

__device__ __forceinline__ float wave_max(float m) {
    m = fmaxf(m, __builtin_bit_cast(float, __builtin_amdgcn_update_dpp(0, __builtin_bit_cast(int, m), 0xB1, 0xf, 0xf, true)));
    m = fmaxf(m, __builtin_bit_cast(float, __builtin_amdgcn_update_dpp(0, __builtin_bit_cast(int, m), 0x4E, 0xf, 0xf, true)));
    m = fmaxf(m, __builtin_bit_cast(float, __builtin_amdgcn_update_dpp(0, __builtin_bit_cast(int, m), 0x141, 0xf, 0xf, true)));
    m = fmaxf(m, __builtin_bit_cast(float, __builtin_amdgcn_update_dpp(0, __builtin_bit_cast(int, m), 0x140, 0xf, 0xf, true)));
    u32 x = __builtin_bit_cast(u32, m);
    { u32 b = x; asm volatile("" : "+v"(b)); const auto p = __builtin_amdgcn_permlane16_swap(x, b, false, false); x = p[0] > p[1] ? p[0] : p[1]; }
    { u32 b = x; asm volatile("" : "+v"(b)); const auto p = __builtin_amdgcn_permlane32_swap(x, b, false, false); x = p[0] > p[1] ? p[0] : p[1]; }
    m = __builtin_bit_cast(float, x);
    return m;
}
template <int NR> __device__ __forceinline__ void quant_rows(const Params& P, const int (&rr)[NR], int lane) {
    f32x4 v[NR][4]; float m[NR];
#pragma unroll
    for (int i = 0; i < NR; ++i) {
        const bool isv = rr[i] >= 16384; const int row = isv ? rr[i] - 16384 : rr[i];
        const f32x4* src = (const f32x4*)((isv ? P.in[I_PV] : P.in[I_PU]) + (size_t)row * DM) + lane;
#pragma unroll
        for (int j = 0; j < 4; ++j) v[i][j] = __builtin_nontemporal_load(src + 64 * j);
    }
#pragma unroll
    for (int i = 0; i < NR; ++i) {
        float mm = 0.f;
#pragma unroll
        for (int j = 0; j < 4; ++j) mm = fmaxf(mm, fmaxf(fmaxf(fabsf(v[i][j].x), fabsf(v[i][j].y)), fmaxf(fabsf(v[i][j].z), fabsf(v[i][j].w))));
        m[i] = wave_max(mm);
    }
#pragma unroll
    for (int i = 0; i < NR; ++i) {
        const bool isv = rr[i] >= 16384; const int row = isv ? rr[i] - 16384 : rr[i];
        const float sc = (m[i] > 0.f) ? m[i] * (1.0f / 127.0f) : 1.0f, inv = (m[i] > 0.f) ? 127.0f / m[i] : 0.f;
        const int off = isv ? 128 : 0;
        u32x4 w;
#pragma unroll
        for (int j = 0; j < 4; ++j) {
            const int q0 = (int)rintf(v[i][j].x * inv) + off, q1 = (int)rintf(v[i][j].y * inv) + off, q2 = (int)rintf(v[i][j].z * inv) + off, q3 = (int)rintf(v[i][j].w * inv) + off;
            w[j] = (u32)(q0 & 255) | ((u32)(q1 & 255) << 8) | ((u32)(q2 & 255) << 16) | ((u32)(q3 & 255) << 24);
        }
        *(u32x4*)(P.ws + (isv ? WS_PV : WS_PU) + (size_t)row * 1024 + 16 * lane) = w;
        if (lane == 0) ((float*)(P.ws + (isv ? WS_SV : WS_SU)))[row] = sc;
    }
}
__device__ __forceinline__ void xn_row(const Params& P, int m, int lane) {
    bf16_t* xn = (bf16_t*)(P.ws + WS_BUFA);
    if (m < SEQ) norm_row_to_bf16(P.in[I_X] + (size_t)m * DM, P.in[I_N1G], xn + (size_t)m * DM, lane);
    else if (m < SEQ + NMETA) norm_row_to_bf16(P.in[I_META] + (size_t)(m - SEQ) * DM, P.in[I_N1G], xn + (size_t)m * DM, lane);
    else { u32x4 z = {0u, 0u, 0u, 0u}; u32x4* o = (u32x4*)(xn + (size_t)m * DM); o[lane] = z; o[64 + lane] = z; }
}
__device__ __forceinline__ void phase_prologue(const Ctx& C, const Params& P) {
    LAS float* scr = (LAS float*)(C.lds + C.wave * 16384);
    const int gw = C.bid * NWAVES + C.wave, NGW = C.G * NWAVES;
    for (int it = gw; it < 16 * 40; it += NGW) transpose_item(P.in[I_WIN], 1024, 1280, (bf16_t*)(P.ws + WS_WIN_T), scr, it, C.lane);
    for (int m = gw; m < MPAD; m += 2 * NGW) { xn_row(P, m, C.lane); if (m + NGW < MPAD) xn_row(P, m + NGW, C.lane); }
}
__device__ __forceinline__ void deferred_a(const Ctx& C, const Params& P, int ib, int nib) {
    __syncthreads();
    const int nssm = (nib >= 64) ? 32 : 0;
    if (nssm) { if (ib < 32) { ssm_tables(C, P, ib); return; } }
    else { for (int g = ib; g < 32; g += nib) ssm_tables(C, P, g); }
    __syncthreads();
    LAS float* scr = (LAS float*)(C.lds + C.wave * 16384);
    const int gw = (ib - nssm) * NWAVES + C.wave, NGW = (nib - nssm) * NWAVES;
    for (int it = gw; it < 8 * 16; it += NGW) transpose_item(P.in[I_GLUW], 512, 512, (bf16_t*)(P.ws + WS_GLU_T), scr, it, C.lane);
    for (int r = gw; r < 2 * 16384; r += 4 * NGW) {
        if (r + 3 * NGW < 2 * 16384) { const int rr[4] = {r, r + NGW, r + 2 * NGW, r + 3 * NGW}; quant_rows<4>(P, rr, C.lane); }
        else { for (int q = r; q < 2 * 16384; q += NGW) { const int rr[1] = {q}; quant_rows<1>(P, rr, C.lane); } }
    }
    const size_t gt = (size_t)(ib - nssm) * NTHR + C.tid, NT = (size_t)(nib - nssm) * NTHR;
    for (size_t i = gt; i < 262144 / 8; i += NT) cvt8(P.in[I_SUBK], (bf16_t*)(P.ws + WS_SUBK), i);
}
__device__ __forceinline__ void deferred_b(const Ctx& C, const Params& P, int ib, int nib) {
    __syncthreads();
    LAS float* scr = (LAS float*)(C.lds + C.wave * 16384);
    const int gw = ib * NWAVES + C.wave, NGW = nib * NWAVES;
    constexpr int I_OUT = 16 * 32, I_Q = 16 * 64;
    for (int it = gw; it < I_OUT + I_Q; it += NGW) {
        if (it < I_OUT) transpose_item(P.in[I_WOUT], 1024, 1024, (bf16_t*)(P.ws + WS_WOUT_T), scr, it, C.lane, P.in[I_AOG], P.in[I_SOG], 512);
        else transpose_item(P.in[I_WQ], 1024, 2048, (bf16_t*)(P.ws + WS_WQ_T), scr, it - I_OUT, C.lane, P.in[I_N2G]);
    }
}

__device__ __forceinline__ bf16x8 u_frag(const bf16_t* proj, int ci, int j, int g, int half) {
    const bool ok = (ci == 0) ? (j >= 16) : (ci < NCH);
    int row = (ci == 0) ? (SEQ + j - 16) : ((ci - 1) * 32 + j);
    row = ok ? row : 0;
    const u32x4 w = *(const u32x4*)(proj + (size_t)row * INW + O_U + g * 16 + half * 8);
    u32x4 z; z.x = ok ? w.x : 0u; z.y = ok ? w.y : 0u; z.z = ok ? w.z : 0u; z.w = ok ? w.w : 0u;
    return __builtin_bit_cast(bf16x8, z);
}

constexpr int F_PITCH = 1040;
__device__ __forceinline__ void phase_sloc(const Ctx& C, const Params& P) {
    const bf16_t* proj = (const bf16_t*)(P.ws + WS_PROJ);
    float* SL = (float*)(P.ws + WS_SLOC);
    const int n = C.lane & 15, kq = C.lane >> 4;
    for (int bu = C.bid; bu < 160; bu += C.G) {
        const int g = bu / 5, qtr = bu % 5, s = qtr * 8 + C.wave, ci = 16 * s + n;
        bf16x8 Bf[16];
#pragma unroll
        for (int ks = 0; ks < 16; ++ks) Bf[ks] = u_frag(proj, (s < 33) ? ci : NCH, 2 * ks + (kq >> 1), g, kq & 1);
        __syncthreads();
        { const u32x4* src = (const u32x4*)((const bf16_t*)(P.ws + WS_F) + (size_t)g * 65536);
          u32x4 t[16];
#pragma unroll
          for (int i = 0; i < 16; ++i) t[i] = src[C.tid + NTHR * i];
#pragma unroll
          for (int i = 0; i < 16; ++i) { const int e = C.tid + NTHR * i; *(LAS u32x4*)(C.lds + (e >> 6) * F_PITCH + (e & 63) * 16) = t[i]; } }
        __syncthreads();
        if (s < 33) {
#pragma unroll 1
            for (int mt = 0; mt < 8; ++mt) {
                f32x4 acc = {0.f, 0.f, 0.f, 0.f};
#pragma unroll
                for (int ks = 0; ks < 16; ++ks) {
                    const bf16x8 A = *(const LAS bf16x8*)(C.lds + (mt * 16 + n) * F_PITCH + (32 * ks + 8 * kq) * 2);
                    acc = MFMA16(A, Bf[ks], acc);
                }
                if (ci < NCH) *(f32x4*)(SL + ((size_t)ci * 32 + g) * 128 + mt * 16 + 4 * kq) = acc;
            }
        }
    }
}

__device__ __forceinline__ void carry_scan_block(const Ctx& C, const Params& P, int bk) {
    const float* SL = (const float*)(P.ws + WS_SLOC);
    float* CA = (float*)(P.ws + WS_CARRY);
    LAS float* Lr = (LAS float*)C.lds;
    LAS float* Li = Lr + 512;
    const int chan = bk * 32 + (C.tid & 31), g = chan >> 6, n = chan & 63, sg = C.tid >> 5;
    const float* abt = (const float*)(P.ws + WS_ABART) + (g * 64 + n) * 2;
    const float ar = abt[0], ai = abt[1];
    float sr = 0.f, si = 0.f;
#pragma unroll 8
    for (int i = 0; i < 32; ++i) {
        const int ci = 32 * sg + i; const size_t o = ((size_t)ci * 32 + g) * 128 + n;
        const float br = SL[o], bi = SL[o + 64];
        const float tr = ar * sr - ai * si + br, ti = ar * si + ai * sr + bi; sr = tr; si = ti;
    }
    Lr[sg * 32 + (C.tid & 31)] = sr; Li[sg * 32 + (C.tid & 31)] = si;
    float pr = ar, pi = ai;
#pragma unroll
    for (int k = 0; k < 5; ++k) { const float tr = pr * pr - pi * pi, ti = 2.f * pr * pi; pr = tr; pi = ti; }
    __syncthreads();
    float cr = 0.f, ci_ = 0.f;
    for (int s2 = 0; s2 < sg; ++s2) { const float lr = Lr[s2 * 32 + (C.tid & 31)], li = Li[s2 * 32 + (C.tid & 31)];
        const float tr = pr * cr - pi * ci_ + lr, ti = pr * ci_ + pi * cr + li; cr = tr; ci_ = ti; }
    sr = cr; si = ci_;
#pragma unroll 8
    for (int i = 0; i < 32; ++i) {
        const int ci = 32 * sg + i; const size_t o = ((size_t)ci * 32 + g) * 128 + n;
        CA[o] = sr; CA[o + 64] = si;
        const float br = SL[o], bi = SL[o + 64];
        const float tr = ar * sr - ai * si + br, ti = ar * si + ai * sr + bi; sr = tr; si = ti;
    }
    if (sg == 15) { const size_t o = ((size_t)512 * 32 + g) * 128 + n; CA[o] = sr; CA[o + 64] = si; }
    __syncthreads();
}

constexpr int E_OFF = 16896, E_PITCH = 272;
__device__ __forceinline__ void phase_ssm_y(const Ctx& C, const Params& P) {
    const bf16_t* proj = (const bf16_t*)(P.ws + WS_PROJ);
    const float* CA = (const float*)(P.ws + WS_CARRY);
    bf16_t* Z = (bf16_t*)(P.ws + WS_Z);
    const int n = C.lane & 15, kq = C.lane >> 4;
    for (int bu = C.bid; bu < 256; bu += C.G) {
        const int g = bu >> 3, cq = bu & 7;
        __syncthreads();
        { const u32x4* src = (const u32x4*)((const bf16_t*)(P.ws + WS_KT) + (size_t)g * 8448); LAS u32x4* dst = (LAS u32x4*)C.lds;
          for (int e = C.tid; e < 1056; e += NTHR) dst[e] = src[e];
          const u32x4* esrc = (const u32x4*)((const bf16_t*)(P.ws + WS_E) + (size_t)g * 65536);
          u32x4 t[16];
#pragma unroll
          for (int i = 0; i < 16; ++i) t[i] = esrc[C.tid + NTHR * i];
#pragma unroll
          for (int i = 0; i < 16; ++i) { const int e = C.tid + NTHR * i; *(LAS u32x4*)(C.lds + E_OFF + (e >> 4) * E_PITCH + (e & 15) * 16) = t[i]; } }
        __syncthreads();
        const int ci = 1 + 64 * cq + 16 * (C.wave >> 1) + n, par = C.wave & 1;
        bf16x8 Uf[16], Cf[4];
#pragma unroll
        for (int ks = 0; ks < 16; ++ks) Uf[ks] = u_frag(proj, ci, 2 * ks + (kq >> 1), g, kq & 1);
#pragma unroll
        for (int k2 = 0; k2 < 4; ++k2) {
            const float* cp = CA + ((size_t)ci * 32 + g) * 128 + 32 * k2 + 8 * kq;
            const f32x4 a = *(const f32x4*)cp, b = *(const f32x4*)(cp + 4);
            u32x4 w; w.x = pk2(a.x, a.y); w.y = pk2(a.z, a.w); w.z = pk2(b.x, b.y); w.w = pk2(b.z, b.w);
            Cf[k2] = __builtin_bit_cast(bf16x8, w);
        }
        const f32x4 dv = *(const f32x4*)(P.in[I_SD] + g * 16 + 4 * kq);
#pragma unroll 1
        for (int tt = 0; tt < 16; ++tt) {
            const int t = 2 * tt + par;
            f32x4 acc = {0.f, 0.f, 0.f, 0.f};
#pragma unroll
            for (int k2 = 0; k2 < 4; ++k2) {
                const bf16x8 A = *(const LAS bf16x8*)(C.lds + E_OFF + (t * 16 + n) * E_PITCH + (32 * k2 + 8 * kq) * 2);
                acc = MFMA16(A, Cf[k2], acc);
            }
#pragma unroll
            for (int ks = 0; ks < 16; ++ks) {
                if (ks <= tt) {
                    const int li = t - 2 * ks - (kq >> 1) + 1;
                    const bf16x8 A = *(const LAS bf16x8*)(C.lds + ((li * 16 + n) * 16 + 8 * (kq & 1)) * 2);
                    acc = MFMA16(A, Uf[ks], acc);
                }
            }
            const int row = (ci - 1) * 32 + t, ch = g * 16 + 4 * kq;
            const u32x2 uw = *(const u32x2*)(proj + (size_t)row * INW + O_U + ch);
            const float y0 = acc.x + dv.x * bflo(uw.x), y1 = acc.y + dv.y * bfhi(uw.x), y2 = acc.z + dv.z * bflo(uw.y), y3 = acc.w + dv.w * bfhi(uw.y);
            u32x2 o; o.x = pk2(gelu_erf(y0), gelu_erf(y1)); o.y = pk2(gelu_erf(y2), gelu_erf(y3));
            *(u32x2*)(Z + (size_t)row * 512 + ch) = o;
        }
    }
}

constexpr int VT_PITCH = 296;
__device__ __forceinline__ void attn_unit(const Ctx& C, const Params& P, int b, int hk) {
    const bf16_t* proj = (const bf16_t*)(P.ws + WS_PROJ);
    bf16_t* AO = (bf16_t*)(P.ws + WS_BUFA);
    float* SSA = (float*)(P.ws + WS_SSA);
    LAS unsigned char* Ks = C.lds;
    LAS bf16_t* Vt = (LAS bf16_t*)(C.lds + 288 * 128);
    __syncthreads();
    for (int e = C.tid; e < 288 * 8; e += NTHR) {
        const int key = e >> 3, ch = e & 7;
        int row = -1;
        if (key < 256) { const int j = (b - 1) * 128 + key; if (j >= 0) row = j; } else if (key < 272) row = SEQ + key - 256;
        u32x4 kw = {0u, 0u, 0u, 0u}, vw = {0u, 0u, 0u, 0u};
        if (row >= 0) { kw = *(const u32x4*)(proj + (size_t)row * INW + O_K + hk * 64 + ch * 8); vw = *(const u32x4*)(proj + (size_t)row * INW + O_V + hk * 64 + ch * 8); }
        float kf[8] = {bflo(kw.x), bfhi(kw.x), bflo(kw.y), bfhi(kw.y), bflo(kw.z), bfhi(kw.z), bflo(kw.w), bfhi(kw.w)};
        float ss = 0.f;
#pragma unroll
        for (int i = 0; i < 8; ++i) ss += kf[i] * kf[i];
        ss += __shfl_xor(ss, 1); ss += __shfl_xor(ss, 2); ss += __shfl_xor(ss, 4);
        const float rinv = 1.0f / sqrtf(ss * (1.0f / 64.0f) + EPS);
        const f32x4 g0 = *(const f32x4*)(P.in[I_KNG] + ch * 8), g1 = *(const f32x4*)(P.in[I_KNG] + ch * 8 + 4);
        u32x4 o; o.x = pk2(kf[0] * rinv * g0.x, kf[1] * rinv * g0.y); o.y = pk2(kf[2] * rinv * g0.z, kf[3] * rinv * g0.w);
        o.z = pk2(kf[4] * rinv * g1.x, kf[5] * rinv * g1.y); o.w = pk2(kf[6] * rinv * g1.z, kf[7] * rinv * g1.w);
        *(LAS u32x4*)(Ks + key * 128 + ((ch ^ (key & 7)) * 16)) = o;
        const unsigned vv[4] = {vw.x, vw.y, vw.z, vw.w};
#pragma unroll
        for (int i = 0; i < 4; ++i) { Vt[(ch * 8 + 2 * i) * VT_PITCH + key] = (bf16_t)(vv[i] & 0xffffu); Vt[(ch * 8 + 2 * i + 1) * VT_PITCH + key] = (bf16_t)(vv[i] >> 16); }
    }
    __syncthreads();
    const int c = C.lane & 31, h = C.lane >> 5;
#pragma unroll 1
    for (int ti = C.wave; ti < 16; ti += NWAVES) {
        const int hql = ti >> 2, wq = ti & 3, hq = hk * 4 + hql;
        const int qi = wq * 32 + c, tok = b * 128 + qi;
        bf16x8 qf[4];
        {
            u32x4 qw[4]; float ss = 0.f;
#pragma unroll
            for (int ks = 0; ks < 4; ++ks) { qw[ks] = *(const u32x4*)(proj + (size_t)tok * INW + hq * 64 + 16 * ks + 8 * h);
                const unsigned w[4] = {qw[ks].x, qw[ks].y, qw[ks].z, qw[ks].w};
#pragma unroll
                for (int i = 0; i < 4; ++i) { const float a = bflo(w[i]), bb = bfhi(w[i]); ss += a * a + bb * bb; } }
            ss += __shfl_xor(ss, 32);
            const float rinv = (1.0f / sqrtf(ss * (1.0f / 64.0f) + EPS)) * (0.125f * LOG2E);
#pragma unroll
            for (int ks = 0; ks < 4; ++ks) {
                const f32x4 g0 = *(const f32x4*)(P.in[I_QNG] + 16 * ks + 8 * h), g1 = *(const f32x4*)(P.in[I_QNG] + 16 * ks + 8 * h + 4);
                u32x4 o; o.x = pk2(bflo(qw[ks].x) * rinv * g0.x, bfhi(qw[ks].x) * rinv * g0.y); o.y = pk2(bflo(qw[ks].y) * rinv * g0.z, bfhi(qw[ks].y) * rinv * g0.w);
                o.z = pk2(bflo(qw[ks].z) * rinv * g1.x, bfhi(qw[ks].z) * rinv * g1.y); o.w = pk2(bflo(qw[ks].w) * rinv * g1.z, bfhi(qw[ks].w) * rinv * g1.w);
                qf[ks] = __builtin_bit_cast(bf16x8, o);
            }
        }
        f32x16 S[6];
#pragma unroll
        for (int rb = 0; rb < 6; ++rb) {
            const int kb = (rb < 5) ? (wq + rb) : 8;
            const int key = kb * 32 + c;
            f32x16 acc = {0.f, 0.f, 0.f, 0.f, 0.f, 0.f, 0.f, 0.f, 0.f, 0.f, 0.f, 0.f, 0.f, 0.f, 0.f, 0.f};
#pragma unroll
            for (int ks = 0; ks < 4; ++ks) {
                const bf16x8 A = *(const LAS bf16x8*)(Ks + key * 128 + (((2 * ks + h) ^ (key & 7)) * 16));
                acc = MFMA32(A, qf[ks], acc);
            }
            S[rb] = acc;
            __builtin_amdgcn_sched_barrier(0);
        }
        const float sl = P.in[I_SINK][hq] * LOG2E;
        float mx = sl;
#pragma unroll
        for (int r = 0; r < 16; ++r) {
            const int kr = (r & 3) + 8 * (r >> 2) + 4 * h;
            const bool gt = kr > c;
            S[0][r] = gt ? S[0][r] : -1e30f;
            S[4][r] = gt ? -1e30f : S[4][r];
            if (r >= 8) S[5][r] = -1e30f;
        }
        if (b == 0) {
#pragma unroll
            for (int rb = 0; rb < 4; ++rb) if (wq + rb < 4) {
#pragma unroll
                for (int r = 0; r < 16; ++r) S[rb][r] = -1e30f;
            }
        }
#pragma unroll
        for (int rb = 0; rb < 6; ++rb)
#pragma unroll
            for (int r = 0; r < 16; ++r) mx = fmaxf(mx, S[rb][r]);
        mx = fmaxf(mx, __shfl_xor(mx, 32));
        float lsum = 0.f;
#pragma unroll
        for (int rb = 0; rb < 6; ++rb)
#pragma unroll
            for (int r = 0; r < 16; ++r) { const float p = exp2f(S[rb][r] - mx); S[rb][r] = p; lsum += p; }
        lsum += __shfl_xor(lsum, 32);
        lsum += exp2f(sl - mx);
        const float linv = 1.0f / lsum;
        f32x16 O[2];
#pragma unroll
        for (int db = 0; db < 2; ++db) O[db] = (f32x16){0.f, 0.f, 0.f, 0.f, 0.f, 0.f, 0.f, 0.f, 0.f, 0.f, 0.f, 0.f, 0.f, 0.f, 0.f, 0.f};
#pragma unroll
        for (int rb = 0; rb < 6; ++rb) {
            const int kb = (rb < 5) ? (wq + rb) : 8;
#pragma unroll
            for (int s = 0; s < 2; ++s) {
                if (rb == 5 && s == 1) continue;
                u32x4 pw; pw.x = pk2(S[rb][8 * s + 0], S[rb][8 * s + 1]); pw.y = pk2(S[rb][8 * s + 2], S[rb][8 * s + 3]);
                pw.z = pk2(S[rb][8 * s + 4], S[rb][8 * s + 5]); pw.w = pk2(S[rb][8 * s + 6], S[rb][8 * s + 7]);
                const bf16x8 Pf = __builtin_bit_cast(bf16x8, pw);
#pragma unroll
                for (int db = 0; db < 2; ++db) {
                    const LAS bf16_t* vp = Vt + (db * 32 + c) * VT_PITCH + kb * 32 + 16 * s + 4 * h;
                    const u32x2 lo = *(const LAS u32x2*)vp, hi2 = *(const LAS u32x2*)(vp + 8);
                    u32x4 vw; vw.x = lo.x; vw.y = lo.y; vw.z = hi2.x; vw.w = hi2.y;
                    O[db] = MFMA32(__builtin_bit_cast(bf16x8, vw), Pf, O[db]);
                }
                __builtin_amdgcn_sched_barrier(0);
            }
        }
        float ssq = 0.f;
#pragma unroll
        for (int db = 0; db < 2; ++db)
#pragma unroll
            for (int gq = 0; gq < 4; ++gq) {
                const float o0 = O[db][4 * gq] * linv, o1 = O[db][4 * gq + 1] * linv, o2 = O[db][4 * gq + 2] * linv, o3 = O[db][4 * gq + 3] * linv;
                ssq += (o0 * o0 + o1 * o1) + (o2 * o2 + o3 * o3);
                u32x2 o; o.x = pk2(o0, o1); o.y = pk2(o2, o3);
                *(u32x2*)(AO + (size_t)tok * 1024 + hq * 64 + db * 32 + 8 * gq + 4 * h) = o;
            }
        ssq += __shfl_xor(ssq, 32);
        if (h == 0) SSA[(size_t)tok * 8 + hq] = ssq;
    }
}

struct EpiGlu {
    static constexpr bool PERM = true, AFTER_DRAIN = false, HAS_MID = false;
    const bf16_t* Z; bf16_t* O; const float* bias; float* SSS;
    __device__ __forceinline__ void operator()(const pg8::f32x4 (&acc)[2][2][4][2], const pg8::Unit& u, int wr, int wc, int fr, int fq) const {
        const int row0 = u.pm * 256 + wr * 64 + fr, col0 = u.pn * 256 + wc * 32 + 8 * fq;
#pragma unroll
        for (int ai = 0; ai < 2; ++ai)
#pragma unroll
            for (int m = 0; m < 4; ++m) {
                const int row = row0 + ai * 128 + m * 16; float ssq = 0.f;
#pragma unroll
                for (int bj = 0; bj < 2; ++bj) {
                    const u32x4 zw = *(const u32x4*)(Z + (size_t)row * 512 + col0 + bj * 128);
                    const f32x4 b0 = *(const f32x4*)(bias + col0 + bj * 128), b1 = *(const f32x4*)(bias + col0 + bj * 128 + 4);
                    const pg8::f32x4 v0 = acc[ai][bj][m][0], v1 = acc[ai][bj][m][1];
                    const float zf[8] = {bflo(zw.x), bfhi(zw.x), bflo(zw.y), bfhi(zw.y), bflo(zw.z), bfhi(zw.z), bflo(zw.w), bfhi(zw.w)};
                    const float pre[8] = {v0[0] + b0.x, v0[1] + b0.y, v0[2] + b0.z, v0[3] + b0.w, v1[0] + b1.x, v1[1] + b1.y, v1[2] + b1.z, v1[3] + b1.w};
                    float r[8];
#pragma unroll
                    for (int i = 0; i < 8; ++i) { r[i] = zf[i] / (1.0f + __expf(-pre[i])); ssq += r[i] * r[i]; }
                    u32x4 o; o.x = pk2(r[0], r[1]); o.y = pk2(r[2], r[3]); o.z = pk2(r[4], r[5]); o.w = pk2(r[6], r[7]);
                    *(u32x4*)(O + (size_t)row * 1024 + 512 + col0 + bj * 128) = o;
                }
                ssq += __shfl_xor(ssq, 16); ssq += __shfl_xor(ssq, 32);
                if (fq == 0) SSS[(size_t)row * 8 + u.pn * 4 + wc] = ssq;
            }
    }
};
constexpr int FAC_OFF = 131072;
struct EpiMix {
    static constexpr bool PERM = true, AFTER_DRAIN = false, HAS_MID = true;
    const float* X; bf16_t* HB; float* SSH;
    __device__ __forceinline__ void mid(pg8::f32x4 (&acc)[2][2][4][2], const pg8::Unit& u, int wr, int wc, int fr, int fq, LAS unsigned char* lds) const {
#pragma unroll
        for (int ai = 0; ai < 2; ++ai)
#pragma unroll
            for (int m = 0; m < 4; ++m) {
                const float f = ((const LAS float*)(lds + FAC_OFF))[2 * (ai * 128 + wr * 64 + m * 16 + fr)];
#pragma unroll
                for (int bj = 0; bj < 2; ++bj)
#pragma unroll
                    for (int n = 0; n < 2; ++n) acc[ai][bj][m][n] *= f;
            }
    }
    __device__ __forceinline__ void operator()(const pg8::f32x4 (&acc)[2][2][4][2], const pg8::Unit& u, int wr, int wc, int fr, int fq) const {
        extern __shared__ __attribute__((aligned(16))) unsigned char lds_raw_[];
        const LAS float* fac = (const LAS float*)((LAS unsigned char*)lds_raw_ + FAC_OFF);
        const int row0 = u.pm * 256 + wr * 64 + fr, col0 = u.pn * 256 + wc * 32 + 8 * fq;
#pragma unroll
        for (int ai = 0; ai < 2; ++ai)
#pragma unroll
            for (int m = 0; m < 4; ++m) {
                const int rl = ai * 128 + wr * 64 + m * 16 + fr, row = u.pm * 256 + rl; (void)row0;
                const float rs = fac[2 * rl + 1]; float ssq = 0.f;
#pragma unroll
                for (int bj = 0; bj < 2; ++bj) {
                    const size_t off = (size_t)row * 1024 + col0 + bj * 128;
                    const f32x4 x0 = *(const f32x4*)(X + off), x1 = *(const f32x4*)(X + off + 4);
                    const pg8::f32x4 v0 = acc[ai][bj][m][0], v1 = acc[ai][bj][m][1];
                    const float hv[8] = {x0.x + rs * v0[0], x0.y + rs * v0[1], x0.z + rs * v0[2], x0.w + rs * v0[3], x1.x + rs * v1[0], x1.y + rs * v1[1], x1.z + rs * v1[2], x1.w + rs * v1[3]};
#pragma unroll
                    for (int i = 0; i < 8; ++i) ssq += hv[i] * hv[i];
                    u32x4 o; o.x = pk2(hv[0], hv[1]); o.y = pk2(hv[2], hv[3]); o.z = pk2(hv[4], hv[5]); o.w = pk2(hv[6], hv[7]);
                    *(u32x4*)(HB + off) = o;
                }
                ssq += __shfl_xor(ssq, 16); ssq += __shfl_xor(ssq, 32);
                if (fq == 0) SSH[(size_t)row * 16 + u.pn * 4 + wc] = ssq;
            }
    }
};
struct EpiQ {
    static constexpr bool PERM = true, AFTER_DRAIN = false, HAS_MID = false;
    bf16_t* O; const float* SSH;
    __device__ __forceinline__ void operator()(const pg8::f32x4 (&acc)[2][2][4][2], const pg8::Unit& u, int wr, int wc, int fr, int fq) const {
        const int col0 = u.pn * 256 + wc * 32 + 8 * fq;
#pragma unroll
        for (int ai = 0; ai < 2; ++ai)
#pragma unroll
            for (int m = 0; m < 4; ++m) {
                const int row = u.pm * 256 + ai * 128 + wr * 64 + m * 16 + fr;
                const f32x4* sp = (const f32x4*)(SSH + (size_t)row * 16);
                const f32x4 s0 = sp[0], s1 = sp[1], s2 = sp[2], s3 = sp[3];
                const float ss = ((s0.x + s0.y) + (s0.z + s0.w)) + ((s1.x + s1.y) + (s1.z + s1.w)) + ((s2.x + s2.y) + (s2.z + s2.w)) + ((s3.x + s3.y) + (s3.z + s3.w));
                const float ri = 1.0f / sqrtf(ss * (1.0f / 1024.0f) + EPS);
#pragma unroll
                for (int bj = 0; bj < 2; ++bj) {
                    const pg8::f32x4 v0 = acc[ai][bj][m][0], v1 = acc[ai][bj][m][1];
                    u32x4 o; o.x = pk2(v0[0] * ri, v0[1] * ri); o.y = pk2(v0[2] * ri, v0[3] * ri); o.z = pk2(v1[0] * ri, v1[1] * ri); o.w = pk2(v1[2] * ri, v1[3] * ri);
                    *(u32x4*)(O + (size_t)row * 2048 + col0 + bj * 128) = o;
                }
            }
    }
};

__device__ __forceinline__ void peer_topk_tile(const Ctx& C, const Params& P, int tok0) {
    const bf16_t* QP = (const bf16_t*)(P.ws + WS_QP);
    const bf16_t* SK = (const bf16_t*)(P.ws + WS_SUBK);
    int* IDX = (int*)(P.ws + WS_IDX); float* GW = (float*)(P.ws + WS_GW);
    LAS u32* lists = (LAS u32*)C.lds;
    const int c = C.lane & 31, h = C.lane >> 5;
    __syncthreads();
#pragma unroll 1
    for (int task = C.wave; task < 32; task += NWAVES) {
        const int tgp = task & 1, hs = task >> 1;
        const int tl = tgp * 32 + c;
        const bf16_t* qrow = QP + (size_t)(tok0 + tl) * 2048 + hs * 128;
        bf16x8 qf[8];
#pragma unroll
        for (int ks = 0; ks < 8; ++ks) qf[ks] = *(const bf16x8*)(qrow + 16 * ks + 8 * h);
        u32 g[4][16];
#pragma unroll
        for (int kb = 0; kb < 4; ++kb) {
            f32x16 acc = {0.f, 0.f, 0.f, 0.f, 0.f, 0.f, 0.f, 0.f, 0.f, 0.f, 0.f, 0.f, 0.f, 0.f, 0.f, 0.f};
            const bf16_t* krow = SK + (size_t)(hs * 128 + kb * 32 + c) * 128;
#pragma unroll
            for (int ks = 0; ks < 8; ++ks) acc = MFMA32(*(const bf16x8*)(krow + 16 * ks + 8 * h), qf[ks], acc);
#pragma unroll
            for (int r = 0; r < 16; ++r) { const int key = kb * 32 + (r & 3) + 8 * (r >> 2) + 4 * h; g[kb][r] = (f2ord(acc[r]) & ~0x7Fu) | (u32)(127 - key); }
        }
        top16_of_64(g[0], g[1], g[2], g[3]);
        u32 pb[16];
#pragma unroll
        for (int i = 0; i < 16; ++i) pb[i] = (u32)__shfl_xor((int)g[0][i], 32);
        merge_top16(g[0], pb);
        if (h == 0) {
            LAS u32x4* dst = (LAS u32x4*)(lists + (tl * 16 + hs) * 16);
#pragma unroll
            for (int i = 0; i < 4; ++i) { u32x4 w; w.x = g[0][4 * i]; w.y = g[0][4 * i + 1]; w.z = g[0][4 * i + 2]; w.w = g[0][4 * i + 3]; dst[i] = w; }
        }
    }
    __syncthreads();
    {
        const int tl = C.tid & 63, hd = C.tid >> 6;
        const LAS u32* L1 = lists + (tl * 16 + hd * 2) * 16; const LAS u32* L2 = L1 + 16;
        float v1[16], v2[16];
#pragma unroll
        for (int i = 0; i < 16; ++i) { v1[i] = ord2f(L1[i] & ~0x7Fu); v2[i] = ord2f(L2[i] & ~0x7Fu); }
        u32 cd[4][16];
        { int cid = 0;
#pragma unroll
          for (int a = 0; a < 16; ++a)
#pragma unroll
              for (int b = 0; b < 16; ++b) if ((a + 1) * (b + 1) <= 16) { cd[cid >> 4][cid & 15] = (f2ord(v1[a] + v2[b]) & ~0x3Fu) | (u32)(63 - cid); ++cid; }
#pragma unroll
          for (int k = 50; k < 64; ++k) cd[k >> 4][k & 15] = 0u; }
        top16_of_64(cd[0], cd[1], cd[2], cd[3]);
        float sc[16]; int ix[16]; float mx = -1e30f;
#pragma unroll
        for (int k = 0; k < 16; ++k) {
            const int cid = 63 - (int)(cd[0][k] & 63u); const int ab = CAND_AB[cid];
            const u32 k1 = L1[ab >> 4], k2 = L2[ab & 15];
            sc[k] = ord2f(k1 & ~0x7Fu) + ord2f(k2 & ~0x7Fu);
            ix[k] = (127 - (int)(k1 & 0x7Fu)) * 128 + (127 - (int)(k2 & 0x7Fu));
            mx = fmaxf(mx, sc[k]);
        }
        float sum = 0.f;
#pragma unroll
        for (int k = 0; k < 16; ++k) { sc[k] = __expf(sc[k] - mx); sum += sc[k]; }
        const float inv = 1.0f / sum;
        int* io = IDX + (size_t)(tok0 + tl) * 128 + hd * 16; float* go = GW + (size_t)(tok0 + tl) * 128 + hd * 16;
#pragma unroll
        for (int k = 0; k < 16; k += 4) {
            *(int4*)(io + k) = make_int4(ix[k], ix[k + 1], ix[k + 2], ix[k + 3]);
            f32x4 gv = {sc[k] * inv, sc[k + 1] * inv, sc[k + 2] * inv, sc[k + 3] * inv}; *(f32x4*)(go + k) = gv;
        }
    }
    __syncthreads();
}

__device__ __forceinline__ int reduce64(int (&r)[64], int lane) {
#pragma unroll
    for (int e = 0; e < 32; ++e) { const auto p = __builtin_amdgcn_permlane32_swap((u32)r[e], (u32)r[e + 32], false, false); r[e] = (int)p[0] + (int)p[1]; }
#pragma unroll
    for (int e = 0; e < 16; ++e) { const auto p = __builtin_amdgcn_permlane16_swap((u32)r[e], (u32)r[e + 16], false, false); r[e] = (int)p[0] + (int)p[1]; }
    const bool b3 = (lane & 8) != 0, b2 = (lane & 4) != 0, b1 = (lane & 2) != 0, b0 = (lane & 1) != 0;
#pragma unroll
    for (int e = 0; e < 8; ++e) { const int keep = b3 ? r[e + 8] : r[e], send = b3 ? r[e] : r[e + 8]; r[e] = keep + __builtin_amdgcn_update_dpp(0, send, 0x128, 0xf, 0xf, true); }
#pragma unroll
    for (int e = 0; e < 4; ++e) { const int keep = b2 ? r[e + 4] : r[e], send = b2 ? r[e] : r[e + 4];
        int t = __builtin_amdgcn_update_dpp(0, send, 0x104, 0xf, 0x5, false);
        t = __builtin_amdgcn_update_dpp(t, send, 0x114, 0xf, 0xA, false);
        r[e] = keep + t; }
#pragma unroll
    for (int e = 0; e < 2; ++e) { const int keep = b1 ? r[e + 2] : r[e], send = b1 ? r[e] : r[e + 2]; r[e] = keep + __builtin_amdgcn_update_dpp(0, send, 0x4E, 0xf, 0xf, true); }
    { const int keep = b0 ? r[1] : r[0], send = b0 ? r[0] : r[1]; r[0] = keep + __builtin_amdgcn_update_dpp(0, send, 0xB1, 0xf, 0xf, true); }
    return r[0];
}
constexpr int GQ_LDS_PER_WAVE = 8192;
#define GQ_FMA16(A, ce, w) do { _Pragma("unroll") for (int j_ = 0; j_ < 4; ++j_) { \
        A[4 * j_ + 0] += (ce) * (float)((w)[j_] & 0xffu); A[4 * j_ + 1] += (ce) * (float)(((w)[j_] >> 8) & 0xffu); \
        A[4 * j_ + 2] += (ce) * (float)(((w)[j_] >> 16) & 0xffu); A[4 * j_ + 3] += (ce) * (float)((w)[j_] >> 24); } } while (0)
__device__ __forceinline__ void peer_gather_quad(const Ctx& C, const Params& P, int tokq, float osc) {
    const bf16_t* HN = (const bf16_t*)(P.ws + WS_HB); const float* SSH = (const float*)(P.ws + WS_SSH);
    const unsigned char* PU = P.ws + WS_PU; const unsigned char* PV = P.ws + WS_PV;
    const float* SU = (const float*)(P.ws + WS_SU); const float* SV = (const float*)(P.ws + WS_SV);
    const int* IDX = (const int*)(P.ws + WS_IDX); const float* GW = (const float*)(P.ws + WS_GW);
    const int lane = C.lane;
    LAS unsigned char* qhl = C.lds + C.wave * GQ_LDS_PER_WAVE;
    LAS u32* keyl = (LAS u32*)(qhl + 4096);
    u32 k[8];
#pragma unroll
    for (int s = 0; s < 4; ++s)
#pragma unroll
        for (int hb = 0; hb < 2; ++hb) k[2 * s + hb] = ((u32)IDX[(size_t)(tokq + s) * 128 + 64 * hb + lane] << 9) | (u32)(s << 7) | (u32)(64 * hb + lane);
#pragma unroll
    for (int size = 2; size <= 512; size <<= 1) {
#pragma unroll
        for (int j = size >> 1; j > 0; j >>= 1) {
            u32 nk[8];
#pragma unroll
            for (int r = 0; r < 8; ++r) {
                const int ii = lane + 64 * r;
                const bool asc = (ii & size) == 0, lower = (ii & j) == 0;
                const u32 mine = k[r], other = (j >= 64) ? k[r ^ (j >> 6)] : (u32)__shfl_xor((int)k[r], j);
                const u32 mn = mine < other ? mine : other, mx = mine < other ? other : mine;
                nk[r] = (lower == asc) ? mn : mx;
            }
#pragma unroll
            for (int r = 0; r < 8; ++r) k[r] = nk[r];
        }
    }
#pragma unroll
    for (int r = 0; r < 8; ++r) keyl[64 * r + lane] = k[r];
    float shs[4];
    f32x4 g2v[4];
#pragma unroll
    for (int j = 0; j < 4; ++j) g2v[j] = *(const f32x4*)(P.in[I_N2G] + 256 * j + 4 * lane);
#pragma unroll
    for (int s = 0; s < 4; ++s) {
        float hf[16]; float m = 0.f;
        const float ssp = (lane < 16) ? SSH[(size_t)(tokq + s) * 16 + lane] : 0.f;
#pragma unroll
        for (int j = 0; j < 4; ++j) { const u32x2 w = *(const u32x2*)(HN + (size_t)(tokq + s) * DM + 256 * j + 4 * lane);
            hf[4 * j] = bflo(w.x) * g2v[j].x; hf[4 * j + 1] = bfhi(w.x) * g2v[j].y; hf[4 * j + 2] = bflo(w.y) * g2v[j].z; hf[4 * j + 3] = bfhi(w.y) * g2v[j].w; }
        const float rinv_t = 1.0f / sqrtf(wave_sum(ssp) * (1.0f / 1024.0f) + EPS);
#pragma unroll
        for (int d = 0; d < 16; ++d) m = fmaxf(m, fabsf(hf[d]));
#pragma unroll
        for (int o = 1; o < 64; o <<= 1) m = fmaxf(m, __shfl_xor(m, o));
        shs[s] = ((m > 0.f) ? m * (1.0f / 127.0f) : 1.0f) * rinv_t; const float inv = (m > 0.f) ? 127.0f / m : 0.f;
        u32x4 q;
#pragma unroll
        for (int j = 0; j < 4; ++j) {
            const int q0 = (int)rintf(hf[4 * j] * inv), q1 = (int)rintf(hf[4 * j + 1] * inv), q2 = (int)rintf(hf[4 * j + 2] * inv), q3 = (int)rintf(hf[4 * j + 3] * inv);
            q[j] = (u32)(q0 & 255) | ((u32)(q1 & 255) << 8) | ((u32)(q2 & 255) << 16) | ((u32)(q3 & 255) << 24);
        }
        *(LAS u32x4*)(qhl + s * 1024 + 16 * lane) = q;
    }
    LDS_WAIT();
    LAS float* cvl = (LAS float*)(qhl + 6144);
    float cs0 = 0.f, cs1 = 0.f, cs2 = 0.f, cs3 = 0.f;
#pragma unroll 1
    for (int c = 0; c < 8; ++c) {
        const u32 kk = keyl[64 * c + lane];
        const int e_l = (int)(kk >> 9), slot_l = (int)((kk >> 7) & 3u), pos_l = (int)(kk & 127u);
        const float g_l = GW[(size_t)(tokq + slot_l) * 128 + pos_l], su_l = SU[e_l], sv_l = SV[e_l];
        int r[64];
#pragma unroll
        for (int p = 0; p < 64; ++p) {
            const u32 kp = (u32)__builtin_amdgcn_readlane((int)kk, p);
            const u32x4 w = *(const u32x4*)(PU + (size_t)(kp >> 9) * 1024 + 16 * lane);
            const u32x4 hq = *(const LAS u32x4*)(qhl + ((kp >> 7) & 3u) * 1024 + 16 * lane);
            int a = __builtin_amdgcn_sdot4((int)w.x, (int)hq.x, 0, false);
            a = __builtin_amdgcn_sdot4((int)w.y, (int)hq.y, a, false);
            a = __builtin_amdgcn_sdot4((int)w.z, (int)hq.z, a, false);
            a = __builtin_amdgcn_sdot4((int)w.w, (int)hq.w, a, false);
            r[p] = a;
        }
        const int isum = reduce64(r, lane);
        const float sh_l = (slot_l == 0) ? shs[0] : (slot_l == 1) ? shs[1] : (slot_l == 2) ? shs[2] : shs[3];
        const float z = (float)isum * su_l * sh_l;
        const float c_l = gelu_erf(z) * g_l * sv_l;
        cs0 += (slot_l == 0) ? c_l : 0.f; cs1 += (slot_l == 1) ? c_l : 0.f; cs2 += (slot_l == 2) ? c_l : 0.f; cs3 += (slot_l == 3) ? c_l : 0.f;
        cvl[64 * c + lane] = c_l;
    }
    LDS_WAIT();
    float acc0[16], acc1[16], acc2[16], acc3[16];
#pragma unroll
    for (int d = 0; d < 16; ++d) { acc0[d] = 0.f; acc1[d] = 0.f; acc2[d] = 0.f; acc3[d] = 0.f; }
#define GQ_ISSUE(W, KP, CE, kreg, creg, p0) do { _Pragma("unroll") for (int q = 0; q < 8; ++q) { \
        KP[q] = (u32)__builtin_amdgcn_readlane((int)(kreg), (p0) + q); CE[q] = __uint_as_float((u32)__builtin_amdgcn_readlane((int)__float_as_uint(creg), (p0) + q)); \
        W[q] = *(const u32x4*)(PV + (size_t)(KP[q] >> 9) * 1024 + 16 * lane); } } while (0)
#define GQ_CONSUME(W, KP, CE) do { _Pragma("unroll") for (int q = 0; q < 8; ++q) { const u32 sl = (KP[q] >> 7) & 3u; \
        if (sl == 0u) GQ_FMA16(acc0, CE[q], W[q]); else if (sl == 1u) GQ_FMA16(acc1, CE[q], W[q]); else if (sl == 2u) GQ_FMA16(acc2, CE[q], W[q]); else GQ_FMA16(acc3, CE[q], W[q]); } } while (0)
    {
        u32x4 wA[8], wB[8]; u32 kA[8], kB[8]; float cA[8], cB[8];
        u32 kk = keyl[lane]; float cc = cvl[lane];
        GQ_ISSUE(wA, kA, cA, kk, cc, 0);
#pragma unroll 1
        for (int c = 0; c < 8; ++c) {
            const int cn = (c < 7) ? c + 1 : 7;
            const u32 kkn = keyl[64 * cn + lane]; const float ccn = cvl[64 * cn + lane];
#pragma unroll 1
            for (int p0 = 0; p0 < 64; p0 += 16) {
                GQ_ISSUE(wB, kB, cB, kk, cc, p0 + 8);
                GQ_CONSUME(wA, kA, cA);
                if (p0 < 48) GQ_ISSUE(wA, kA, cA, kk, cc, p0 + 16); else GQ_ISSUE(wA, kA, cA, kkn, ccn, 0);
                GQ_CONSUME(wB, kB, cB);
            }
            kk = kkn; cc = ccn;
        }
    }
#undef GQ_ISSUE
#undef GQ_CONSUME
    const float corr0 = 128.0f * wave_sum(cs0), corr1 = 128.0f * wave_sum(cs1), corr2 = 128.0f * wave_sum(cs2), corr3 = 128.0f * wave_sum(cs3);
#define GQ_OUT(s, A, corr) do { float* orow = P.out + (size_t)(tokq + (s)) * DM; _Pragma("unroll") for (int j = 0; j < 4; ++j) { f32x4* p = (f32x4*)(orow + 256 * j + 4 * lane); \
        const u32x2 hw = *(const u32x2*)(HN + (size_t)(tokq + (s)) * DM + 256 * j + 4 * lane); \
        f32x4 v; v.x = bflo(hw.x) + osc * (A[4 * j] - corr); v.y = bfhi(hw.x) + osc * (A[4 * j + 1] - corr); v.z = bflo(hw.y) + osc * (A[4 * j + 2] - corr); v.w = bfhi(hw.y) + osc * (A[4 * j + 3] - corr); *p = v; } } while (0)
    GQ_OUT(0, acc0, corr0); GQ_OUT(1, acc1, corr1); GQ_OUT(2, acc2, corr2); GQ_OUT(3, acc3, corr3);
#undef GQ_OUT
}
__device__ __forceinline__ void peer_gather_tile(const Ctx& C, const Params& P, int tok0, float osc = 1.0f) {
    __syncthreads();
#pragma unroll 1
    for (int hq = 0; hq < 2; ++hq) peer_gather_quad(C, P, tok0 + 32 * hq + 4 * C.wave, osc);
}

#define GAS __attribute__((address_space(1)))
typedef GAS unsigned gu32;
#define RLX_AGENT __ATOMIC_RELAXED, __HIP_MEMORY_SCOPE_AGENT
#define XB_TMO      128
#define XB_XCNT(j)  (256  + 64 * (j))
#define XB_XSUB(j)  (1280 + 64 * (j))
#define XB_XGEN(j)  (2304 + 64 * (j))
#define XB_TOP      3328
#define XB_TOPGEN   3392
#define XCD_BAR_WORDS 3456
#define XB_SPIN_CAP (1u << 18)

__device__ __forceinline__ unsigned xb_ld(unsigned* p)              { return __hip_atomic_load(p, __ATOMIC_RELAXED, __HIP_MEMORY_SCOPE_AGENT); }
__device__ __forceinline__ unsigned xb_add(unsigned* p, unsigned v) { return __hip_atomic_fetch_add(p, v, __ATOMIC_RELAXED, __HIP_MEMORY_SCOPE_AGENT); }
__device__ __forceinline__ unsigned xb_xcc_id() { return (unsigned)__builtin_amdgcn_s_getreg((3 << 11) | 20) & 0xFu; }
#define XB_SPIN(cond, bar) do { unsigned _sp = 0; while (cond) { __builtin_amdgcn_s_sleep(1); \
    if ((++_sp & 255u) == 0u) { if (xb_ld(&(bar)[XB_TMO])) break; if (_sp > XB_SPIN_CAP) { atomicAdd(&(bar)[XB_TMO], 1u); break; } } } } while (0)

struct XcdBarrier {
    unsigned* bar; unsigned x;
    volatile LAS unsigned* st;
};

__device__ __forceinline__ XcdBarrier xcd_barrier_post(unsigned* bar, volatile LAS unsigned* st) {
    XcdBarrier b; b.bar = bar; b.x = xb_xcc_id(); b.st = st;
    if (threadIdx.x == 0) (void)xb_add(&bar[XB_XCNT(b.x)], 1u);
    return b;
}
__device__ __forceinline__ void xcd_barrier_complete(unsigned* bar, unsigned x, unsigned& nloc, unsigned& nx) {
    const unsigned G = gridDim.x * gridDim.y * gridDim.z;
    unsigned sum, cnt, mine, sp = 0u;
    for (;;) {
        sum = 0u; cnt = 0u; mine = 0u;
#pragma unroll
        for (unsigned j = 0; j < 16; ++j) { const unsigned c = xb_ld(&bar[XB_XCNT(j)]); sum += c; cnt += (c > 0u) ? 1u : 0u; mine = (j == x) ? c : mine; }
        if (sum == G) break;
        __builtin_amdgcn_s_sleep(1);
        if ((++sp & 255u) == 0u) { if (xb_ld(&bar[XB_TMO])) break; if (sp > XB_SPIN_CAP) { atomicAdd(&bar[XB_TMO], 1u); break; } }
    }
    nloc = mine > 0u ? mine : 1u; nx = cnt > 0u ? cnt : 1u;
}

__device__ __forceinline__ void xcd_barrier(const XcdBarrier& b) {
    asm volatile("s_waitcnt vmcnt(0)" ::: "memory");
    __syncthreads();
    if (threadIdx.x == 0) {
        unsigned* bar = b.bar;
        __builtin_amdgcn_s_waitcnt(0);
        unsigned nloc = b.st[0], nx = b.st[1];
        if (nloc == 0u) { xcd_barrier_complete(bar, b.x, nloc, nx); b.st[0] = nloc; b.st[1] = nx; }
        const unsigned old = xb_add(&bar[XB_XSUB(b.x)], 1u);
        const unsigned gen = old / nloc;
        if (old + 1u == (gen + 1u) * nloc) {
            __builtin_amdgcn_fence(__ATOMIC_RELEASE, "agent");
            asm volatile("s_waitcnt vmcnt(0)" ::: "memory");
            const unsigned og = xb_add(&bar[XB_TOP], 1u);
            const unsigned tg = og / nx;
            if (og + 1u == (tg + 1u) * nx) xb_add(&bar[XB_TOPGEN], 1u);
            else XB_SPIN(xb_ld(&bar[XB_TOPGEN]) == tg, bar);
            __builtin_amdgcn_fence(__ATOMIC_ACQUIRE, "agent");
            xb_add(&bar[XB_XGEN(b.x)], 1u);
            asm volatile("s_waitcnt vmcnt(0)" ::: "memory");
        } else {
            XB_SPIN(xb_ld(&bar[XB_XGEN(b.x)]) == gen, bar);
            __builtin_amdgcn_fence(__ATOMIC_ACQUIRE, "agent");
            asm volatile("s_waitcnt vmcnt(0)" ::: "memory");
        }
    }
    __syncthreads();
}

constexpr int NPHASE = 9;
__global__ void __launch_bounds__(NTHR, 2) mk_fwd(Params P) {
    extern __shared__ __attribute__((aligned(16))) unsigned char lds_raw[];
    Ctx C; C.lds = (LAS unsigned char*)lds_raw; C.tid = threadIdx.x; C.lane = C.tid & 63; C.wave = __builtin_amdgcn_readfirstlane(C.tid >> 6); C.G = gridDim.x; C.bid = blockIdx.x;
    unsigned char* ws = P.ws;
    volatile LAS unsigned* MISC = (volatile LAS unsigned*)(C.lds + MISC_OFF);
    if (C.tid < 32) MISC[C.tid] = 0u;
    __syncthreads();
    XcdBarrier bar = xcd_barrier_post((unsigned*)(ws + WS_CTL) + 4096, MISC + 8);
#define SEAM(k) do { if (IN(k) && IN((k) + 1)) xcd_barrier(bar); FRESH(); } while (0)
#define FRESH() do { int t_ = (int)threadIdx.x; asm volatile("" : "+v"(t_)); C.tid = t_; C.lane = t_ & 63; } while (0)
#ifndef REPMASK
#define REPMASK 0
#endif
#define NREP(k) (((REPMASK >> (k)) & 1) ? 2 : 1)
#ifdef ONLY_PHASE
#define IN(k) ((k) == ONLY_PHASE && P.ph_lo <= (k) && (k) < P.ph_hi)
#else
#define IN(k) (P.ph_lo <= (k) && (k) < P.ph_hi)
#endif
    for (int rep_ = 0; rep_ < NREP(0); ++rep_) { if (rep_) xcd_barrier(bar); if (IN(0)) phase_prologue(C, P); }
    SEAM(0);
    for (int rep_ = 0; rep_ < NREP(1); ++rep_) { if (rep_) xcd_barrier(bar);
    if (IN(1)) {
        pg8::Gemm g{(const bf16_t*)(ws + WS_BUFA), (const bf16_t*)(ws + WS_WIN_T), MPAD, INW, DM}; pg8::StaticOrder S; S.init(MPAD, INW, C.G, C.bid);
        pg8::EpiBf16<0> E{(bf16_t*)(ws + WS_PROJ), INW, nullptr, 0, 0, 1.f};
        pg8::gemm_phase<pg8::EpiBf16<0>, pg8::StaticOrder, true, true>(C.lds, g, S, E);
        { const int ntile = (MPAD / 256) * (INW / 256), nbusy = ntile % C.G;
          if (ntile > C.G && nbusy > 0) { if (C.bid >= nbusy) deferred_a(C, P, C.bid - nbusy, C.G - nbusy); }
          else deferred_a(C, P, C.bid, C.G); }
    }
    }
    SEAM(1);
#ifdef EXTRA_BARS
    for (int xb_ = 0; xb_ < EXTRA_BARS; ++xb_) xcd_barrier(bar);
#endif
    for (int rep_ = 0; rep_ < NREP(2); ++rep_) { if (rep_) xcd_barrier(bar); if (IN(2)) phase_sloc(C, P); }
    SEAM(2);
    for (int rep_ = 0; rep_ < NREP(3); ++rep_) { if (rep_) xcd_barrier(bar);
    if (IN(3)) {
        for (int bk = C.bid; bk < 64; bk += C.G) carry_scan_block(C, P, bk);
        for (int u = C.bid; u < 256; u += C.G) attn_unit(C, P, u >> 1, u & 1);
    }
    }
    SEAM(3);
    for (int rep_ = 0; rep_ < NREP(4); ++rep_) { if (rep_) xcd_barrier(bar); if (IN(4)) phase_ssm_y(C, P); }
    SEAM(4);
    if (IN(5)) {
        pg8::Gemm g{(const bf16_t*)(ws + WS_Z), (const bf16_t*)(ws + WS_GLU_T), SEQ, 512, 512}; pg8::StaticOrder S; S.init(SEQ, 512, C.G, C.bid);
        EpiGlu E{(const bf16_t*)(ws + WS_Z), (bf16_t*)(ws + WS_BUFA), P.in[I_GLUB], (float*)(ws + WS_SSS)};
        pg8::gemm_phase<EpiGlu, pg8::StaticOrder, true, true>(C.lds, g, S, E);
        { const int ntile = (SEQ / 256) * 2;
          if (ntile < C.G) { if (C.bid >= ntile) deferred_b(C, P, C.bid - ntile, C.G - ntile); }
          else deferred_b(C, P, C.bid, C.G); }
    }
    SEAM(5);
    if (IN(6)) {
        __syncthreads();
        if (C.tid < 256) {
            pg8::StaticOrder S0; S0.init(SEQ, DM, C.G, C.bid); pg8::Unit u0; S0.next(0, u0);
            const int row = u0.pm * 256 + C.tid;
            const f32x4* pa = (const f32x4*)((const float*)(ws + WS_SSA) + (size_t)row * 8); const f32x4* ps = (const f32x4*)((const float*)(ws + WS_SSS) + (size_t)row * 8);
            const f32x4 a0 = pa[0], a1 = pa[1], s0 = ps[0], s1 = ps[1];
            const float ra = 1.0f / sqrtf((((a0.x + a0.y) + (a0.z + a0.w)) + ((a1.x + a1.y) + (a1.z + a1.w))) * (1.0f / 512.0f) + EPS);
            const float rs = 1.0f / sqrtf((((s0.x + s0.y) + (s0.z + s0.w)) + ((s1.x + s1.y) + (s1.z + s1.w))) * (1.0f / 512.0f) + EPS);
            LAS float* fac = (LAS float*)(C.lds + FAC_OFF); fac[2 * C.tid] = ra / rs; fac[2 * C.tid + 1] = rs;
        }
        __syncthreads();
        pg8::Gemm g{(const bf16_t*)(ws + WS_BUFA), (const bf16_t*)(ws + WS_WOUT_T), SEQ, DM, DM}; pg8::StaticOrder S; S.init(SEQ, DM, C.G, C.bid);
        EpiMix E{P.in[I_X], (bf16_t*)(ws + WS_HB), (float*)(ws + WS_SSH)};
        pg8::gemm_phase<EpiMix, pg8::StaticOrder, true, true>(C.lds, g, S, E);
    }
    SEAM(6);
    if (IN(7)) {
        pg8::Gemm g{(const bf16_t*)(ws + WS_HB), (const bf16_t*)(ws + WS_WQ_T), SEQ, 2048, DM}; pg8::StaticOrder S; S.init(SEQ, 2048, C.G, C.bid);
        EpiQ E{(bf16_t*)(ws + WS_QP), (const float*)(ws + WS_SSH)};
        pg8::gemm_phase<EpiQ, pg8::StaticOrder, true, true>(C.lds, g, S, E);
    }
    SEAM(7);
    {
    if (IN(8)) {
        for (int tile = C.bid; tile < SEQ / 64; tile += C.G) {
            peer_topk_tile(C, P, tile * 64);
            if ((REPMASK >> 11) & 1) peer_topk_tile(C, P, tile * 64);
            if ((REPMASK >> 12) & 1) peer_gather_tile(C, P, tile * 64, P.zero);
            peer_gather_tile(C, P, tile * 64, P.one);
        }
    }
    }
#undef IN
#undef SEAM
}
}

extern "C" void kernel_launch(void* const* d_in, const int* in_sizes, int n_in, void* d_out, int out_size, void* d_ws, size_t ws_size, hipStream_t stream) {
    static int state = 0, grid = 0;
    if (state == 0) {
        if (n_in != 25 || out_size != mk::SEQ * mk::DM || ws_size < mk::WS_END) { fprintf(stderr, "kernel_launch: unexpected shapes (n_in %d out %d ws %zu)\n", n_in, out_size, ws_size); state = -1; return; }
        if (hipFuncSetAttribute((const void*)mk::mk_fwd, hipFuncAttributeMaxDynamicSharedMemorySize, mk::LDS_BYTES) != hipSuccess) { fprintf(stderr, "kernel_launch: hipFuncSetAttribute failed\n"); state = -1; return; }
        int dev = 0, cus = 0, per_cu = 0;
        if (hipGetDevice(&dev) != hipSuccess || hipDeviceGetAttribute(&cus, hipDeviceAttributeMultiprocessorCount, dev) != hipSuccess) { fprintf(stderr, "kernel_launch: device query failed\n"); state = -1; return; }
        if (hipOccupancyMaxActiveBlocksPerMultiprocessor(&per_cu, (const void*)mk::mk_fwd, mk::NTHR, mk::LDS_BYTES) != hipSuccess || per_cu < 1) { fprintf(stderr, "kernel_launch: occupancy query failed (%d)\n", per_cu); state = -1; return; }
        grid = cus;
        state = 1;
    }
    if (state < 0) return;
    mk::Params p{};
    for (int i = 0; i < 25; ++i) p.in[i] = (const float*)d_in[i];
    p.out = (float*)d_out; p.ws = (unsigned char*)d_ws;
    if (hipMemsetAsync((char*)d_ws + mk::WS_CTL, 0, 65536, stream) != hipSuccess) { fprintf(stderr, "kernel_launch: memset failed\n"); return; }
    p.ph_lo = 0; p.ph_hi = mk::NPHASE; p.one = 1.0f; p.zero = 0.0f;
    void* args[] = {&p};
    hipError_t e = hipLaunchCooperativeKernel((const void*)mk::mk_fwd, dim3(grid), dim3(mk::NTHR), args, mk::LDS_BYTES, stream);
    if (e != hipSuccess) fprintf(stderr, "kernel_launch: cooperative launch failed: %s (grid %d)\n", hipGetErrorString(e), grid);
}
```

```cpp
#include <hip/hip_runtime.h>
#include <cstdio>
#include <cstdint>
#include <cmath>
namespace pg8 {
#define PG8_LAS __attribute__((address_space(3)))
typedef unsigned short bf16_t;
typedef short bf16x8 __attribute__((ext_vector_type(8)));
typedef float f32x4 __attribute__((ext_vector_type(4)));
typedef unsigned u32x4 __attribute__((ext_vector_type(4)));
constexpr int BM = 256, BK = 64, HALF = 128, HTB = HALF * BK * 2  , STAGE_BYTES = 8 * HTB, NXCD = 8, WGM = 8;

__host__ __device__ __forceinline__ int lds_byte(int r, int c) { const int st = (r >> 4) * 2 + (c >> 5), rr = r & 15, cc = c & 31, ob = rr * 64 + cc * 2; return st * 1024 + (ob ^ (((ob >> 9) & 1) << 5)); }
__host__ __device__ __forceinline__ void stage_rc(int b, int& R, int& C) { const int st = b / 1024, sb = b % 1024, swz = sb ^ (((sb >> 9) & 1) << 5); R = (st >> 1) * 16 + swz / 64; C = (st & 1) * 32 + (swz % 64) / 2; }
__host__ __device__ __forceinline__ int perm32(int rho) { const int n = rho >> 4, i = rho & 15; return 8 * (i >> 2) + 4 * n + (i & 3); }

struct Unit { int pm, pn; };
struct Gemm { const bf16_t* A; const bf16_t* Bt; int M, N, K; };

struct StaticOrder {
    int nM, nN, nwg, G, c;
    __host__ __device__ __forceinline__ void init(int M, int N, int G_, int c_) { nM = M / BM; nN = N / BM; nwg = nM * nN; G = G_; c = c_; }
    __host__ __device__ __forceinline__ bool next(int i, Unit& u) const {
        const long L = (long)i * G + c; if (L >= nwg) return false;
        int wgid = (int)L; { const int q = nwg / NXCD, r = nwg % NXCD, xcd = wgid % NXCD, off = wgid / NXCD; wgid = (xcd < r ? xcd * (q + 1) : r * (q + 1) + (xcd - r) * q) + off; }
        const int nig = WGM * nN, gid = wgid / nig, fm = gid * WGM, gsz = (nM - fm) < WGM ? (nM - fm) : WGM;
        u.pm = fm + ((wgid % nig) % gsz); u.pn = (wgid % nig) / gsz; return true;
    }
    __device__ __forceinline__ void a_ready(const Unit&) const {}
    __device__ __forceinline__ void done(const Unit&) const {}
};

__device__ __forceinline__ unsigned cvt_pk_bf16(float lo, float hi) { unsigned r; asm volatile("v_cvt_pk_bf16_f32 %0, %1, %2" : "=v"(r) : "v"(lo), "v"(hi)); return r; }
typedef float f32x2 __attribute__((ext_vector_type(2)));
__device__ __forceinline__ f32x2 gelu_pk(f32x2 v) {
    const f32x2 av = __builtin_elementwise_abs(v), d = av * 0.2316418882f + 1.0f;
    f32x2 t; t.x = __builtin_amdgcn_rcpf(d.x); t.y = __builtin_amdgcn_rcpf(d.y);
    f32x2 q = t * 0.5307027145f + (-0.7265760135f); q = q * t + 0.7107068705f; q = q * t + (-0.142248368f); q = q * t + 0.127414796f; q = q * t;
    const f32x2 s = (v * v) * (-0.72134752044f);
    f32x2 e; e.x = __builtin_amdgcn_exp2f(s.x); e.y = __builtin_amdgcn_exp2f(s.y);
    const f32x2 m = v * (q * e), r = v - m;
    f32x2 o; o.x = v.x < 0.f ? m.x : r.x; o.y = v.y < 0.f ? m.y : r.y; return o;
}

template <int ACT  > struct EpiBf16 {
    static constexpr bool PERM = true, AFTER_DRAIN = false, HAS_MID = false; static_assert(ACT == 0 || ACT == 1, "EpiBf16: ACT is 0 (none) or 1 (gelu_pk)");
    bf16_t* O; int ldc; const float* bias; int split_cols; size_t split_stride; float scale0;
    __device__ __forceinline__ void operator()(const f32x4 (&acc)[2][2][4][2], const Unit& u, int wr, int wc, int fr, int fq) const {
        const int row0 = u.pm * BM + wr * 64 + fr; int colt = u.pn * BM; bf16_t* base = O;
        float sc = 1.f; if (split_cols) { const int t = colt / split_cols; base += (size_t)t * split_stride; colt -= t * split_cols; if (t == 0) sc = scale0; }
        const int col0 = colt + wc * 32 + 8 * fq, bcol0 = u.pn * BM + wc * 32 + 8 * fq;
        f32x4 bv[2][2];
#pragma unroll
        for (int bj = 0; bj < 2; ++bj)
#pragma unroll
            for (int n = 0; n < 2; ++n) bv[bj][n] = bias ? *(const f32x4*)(bias + bcol0 + bj * HALF + 4 * n) : (f32x4){0.f, 0.f, 0.f, 0.f};
#pragma unroll
        for (int ai = 0; ai < 2; ++ai)
#pragma unroll
            for (int m = 0; m < 4; ++m) { bf16_t* rowp = base + (size_t)(row0 + ai * HALF + m * 16) * ldc + col0;
#pragma unroll
                for (int bj = 0; bj < 2; ++bj) { f32x4 v0 = acc[ai][bj][m][0] + bv[bj][0], v1 = acc[ai][bj][m][1] + bv[bj][1];
                    if (ACT == 1) { f32x2 a = gelu_pk((f32x2){v0[0], v0[1]}), b = gelu_pk((f32x2){v0[2], v0[3]}), c = gelu_pk((f32x2){v1[0], v1[1]}), d = gelu_pk((f32x2){v1[2], v1[3]});
                        v0 = (f32x4){a.x, a.y, b.x, b.y}; v1 = (f32x4){c.x, c.y, d.x, d.y}; }
                    v0 = v0 * sc; v1 = v1 * sc; u32x4 w; w.x = cvt_pk_bf16(v0[0], v0[1]); w.y = cvt_pk_bf16(v0[2], v0[3]); w.z = cvt_pk_bf16(v1[0], v1[1]); w.w = cvt_pk_bf16(v1[2], v1[3]);
                    *(u32x4*)(rowp + bj * HALF) = w; } }
    }
};
template <class Epi, class Sched, bool ALIGN_EPI = false, bool SP2 = false>
__device__ __forceinline__ void gemm_phase(PG8_LAS unsigned char* lds, const Gemm g, const Sched& S, const Epi& E) {
    const int tid = threadIdx.x, wid = __builtin_amdgcn_readfirstlane(tid >> 6), lane = tid & 63, wr = wid >> 2, wc = wid & 3, fr = lane & 15, fq = lane >> 4;
    const int K = g.K, nt = K / BK;
    unsigned voffA[2], voffB[2];
#pragma unroll
    for (int i = 0; i < 2; ++i) { int R, C; stage_rc(tid * 16 + i * 8192, R, C); const int Rb = Epi::PERM ? ((R & ~31) + perm32(R & 31)) : R;
        voffA[i] = (unsigned)(R * K + C) * 2u; voffB[i] = (unsigned)(Rb * K + C) * 2u; }
    const size_t kstep = (size_t)(BK * 2);
    const size_t hstep = (size_t)HALF * K * 2;
    const size_t tstep = 2 * hstep;
    const unsigned ldsw = (unsigned)wid * 1024u;
    const int aoff = lds_byte(wr * 64 + fr, fq * 8), boff = lds_byte(wc * 32 + fr, fq * 8);
#define PG8_SA(b, h) (((b) * 2 + (h)) * HTB)
#define PG8_SB(b, h) ((4 + (b) * 2 + (h)) * HTB)
#define PG8_STAGE(bufoff, gbase, voff) do { _Pragma("unroll") for (int _i = 0; _i < 2; ++_i) \
        __builtin_amdgcn_global_load_lds((const unsigned*)((const char*)(gbase) + (voff)[_i]), (PG8_LAS unsigned*)(lds + (bufoff) + ldsw + _i * 8192), 16, 0, 0); } while (0)
#define PG8_LDA(dst, b, h) do { _Pragma("unroll") for (int m = 0; m < 4; ++m) _Pragma("unroll") for (int k = 0; k < 2; ++k) dst[m][k] = *(const PG8_LAS bf16x8*)(lds + PG8_SA(b, h) + aoff + m * 2048 + k * 1024); } while (0)
#define PG8_LDB(dst, b, h) do { _Pragma("unroll") for (int n = 0; n < 2; ++n) _Pragma("unroll") for (int k = 0; k < 2; ++k) dst[n][k] = *(const PG8_LAS bf16x8*)(lds + PG8_SB(b, h) + boff + n * 2048 + k * 1024); } while (0)
#define PG8_MMA(ai, bj, At, Bt) do { __builtin_amdgcn_s_setprio(1); _Pragma("unroll") for (int m = 0; m < 4; ++m) _Pragma("unroll") for (int n = 0; n < 2; ++n) _Pragma("unroll") for (int k = 0; k < 2; ++k) \
        acc[ai][bj][m][n] = __builtin_amdgcn_mfma_f32_16x16x32_bf16(Bt[n][k], At[m][k], acc[ai][bj][m][n], 0, 0, 0); __builtin_amdgcn_s_setprio(0); } while (0)
#define PG8_WAIT_V(n) asm volatile("s_waitcnt vmcnt(" #n ")" ::: "memory")
#define PG8_WAIT_L(n) asm volatile("s_waitcnt lgkmcnt(" #n ")" ::: "memory")
#define PG8_BAR __builtin_amdgcn_s_barrier()
#define PG8_SCHED __builtin_amdgcn_sched_barrier(0)
    Unit cur, nxt; int ui = 0;
    if (!S.next(0, cur)) return;
    f32x4 acc[2][2][4][2];
#pragma unroll
    for (int a = 0; a < 2; ++a)
#pragma unroll
        for (int b = 0; b < 2; ++b)
#pragma unroll
            for (int m = 0; m < 4; ++m)
#pragma unroll
                for (int n = 0; n < 2; ++n) acc[a][b][m][n] = (f32x4){0.f, 0.f, 0.f, 0.f};
    bf16x8 At[4][2], B0[2][2], B1[2][2];
    const char* cA = (const char*)g.A + (size_t)cur.pm * tstep; const char* cB = (const char*)g.Bt + (size_t)cur.pn * tstep;
    S.a_ready(cur);
    if constexpr (SP2) {
        PG8_STAGE(PG8_SB(0, 0), cB, voffB); PG8_STAGE(PG8_SB(0, 1), cB + hstep, voffB); PG8_STAGE(PG8_SA(0, 0), cA, voffA); PG8_STAGE(PG8_SA(0, 1), cA + hstep, voffA);
        if (wr == 1) PG8_BAR;
        PG8_WAIT_V(2); PG8_BAR;
        PG8_STAGE(PG8_SB(1, 0), cB + kstep, voffB); PG8_STAGE(PG8_SA(1, 0), cA + kstep, voffA); PG8_STAGE(PG8_SB(1, 1), cB + hstep + kstep, voffB);
        PG8_WAIT_V(6); PG8_BAR;
    } else {
        PG8_STAGE(PG8_SB(0, 0), cB, voffB); PG8_STAGE(PG8_SA(0, 0), cA, voffA); PG8_STAGE(PG8_SB(0, 1), cB + hstep, voffB); PG8_STAGE(PG8_SA(0, 1), cA + hstep, voffA);
        if (wr == 1) PG8_BAR;
        PG8_WAIT_V(4); PG8_BAR;
        PG8_STAGE(PG8_SB(1, 0), cB + kstep, voffB); PG8_STAGE(PG8_SA(1, 0), cA + kstep, voffA); PG8_STAGE(PG8_SB(1, 1), cB + hstep + kstep, voffB);
        PG8_WAIT_V(6); PG8_BAR;
    }
    for (;;) {
        const bool has_next = S.next(ui + 1, nxt);
        const char* nA = has_next ? (const char*)g.A + (size_t)nxt.pm * tstep : cA; const char* nB = has_next ? (const char*)g.Bt + (size_t)nxt.pn * tstep : cB;
        for (int t = 0; t < nt; t += 2) {
            const bool last = (t == nt - 2);
            if constexpr (Epi::HAS_MID) { if (t == nt / 2) E.mid(acc, cur, wr, wc, fr, fq, lds); }
            const char* a1 = cA + (size_t)(t + 1) * kstep;
            const char* a2 = last ? nA : cA + (size_t)(t + 2) * kstep; const char* b2 = last ? nB : cB + (size_t)(t + 2) * kstep;
            const char* a3 = a2 + kstep; const char* b3 = b2 + kstep;
            if (last && has_next) S.a_ready(nxt);
            if constexpr (SP2) {
            PG8_LDB(B0, 0, 0); PG8_LDB(B1, 0, 1); PG8_SCHED; PG8_LDA(At, 0, 0); PG8_STAGE(PG8_SA(1, 1), a1 + hstep, voffA);
            PG8_WAIT_V(8); PG8_WAIT_L(0); PG8_BAR; PG8_MMA(0, 0, At, B0); PG8_MMA(0, 1, At, B1); PG8_BAR; PG8_SCHED;
            PG8_LDA(At, 0, 1); PG8_STAGE(PG8_SB(0, 0), b2, voffB); PG8_STAGE(PG8_SB(0, 1), b2 + hstep, voffB); PG8_STAGE(PG8_SA(0, 0), a2, voffA);
            PG8_WAIT_V(8); PG8_WAIT_L(0); PG8_BAR; PG8_MMA(1, 0, At, B0); PG8_MMA(1, 1, At, B1); PG8_BAR; PG8_SCHED;
            PG8_LDB(B0, 1, 0); PG8_LDB(B1, 1, 1); PG8_SCHED; PG8_LDA(At, 1, 0); PG8_STAGE(PG8_SA(0, 1), a2 + hstep, voffA);
            PG8_WAIT_V(8); PG8_WAIT_L(0); PG8_BAR; PG8_MMA(0, 0, At, B0); PG8_MMA(0, 1, At, B1); PG8_BAR; PG8_SCHED;
            PG8_LDA(At, 1, 1); PG8_STAGE(PG8_SB(1, 0), b3, voffB); PG8_STAGE(PG8_SB(1, 1), b3 + hstep, voffB); PG8_STAGE(PG8_SA(1, 0), a3, voffA);
            PG8_WAIT_V(8); PG8_WAIT_L(0); PG8_BAR; PG8_MMA(1, 0, At, B0); PG8_MMA(1, 1, At, B1); PG8_BAR; PG8_SCHED;
            } else {
            PG8_LDB(B0, 0, 0); PG8_SCHED; PG8_LDA(At, 0, 0); PG8_STAGE(PG8_SA(1, 1), a1 + hstep, voffA);
            PG8_WAIT_L(8); PG8_BAR; PG8_WAIT_L(0); PG8_MMA(0, 0, At, B0); PG8_BAR; PG8_SCHED;
            PG8_LDB(B1, 0, 1); PG8_STAGE(PG8_SB(0, 0), b2, voffB);
            PG8_BAR; PG8_WAIT_L(0); PG8_MMA(0, 1, At, B1); PG8_BAR;
            PG8_LDA(At, 0, 1); PG8_STAGE(PG8_SA(0, 0), a2, voffA);
            PG8_BAR; PG8_WAIT_L(0); PG8_MMA(1, 0, At, B0); PG8_BAR; PG8_SCHED;
            PG8_STAGE(PG8_SB(0, 1), b2 + hstep, voffB);
            PG8_WAIT_V(6); PG8_BAR; PG8_MMA(1, 1, At, B1); PG8_BAR;
            PG8_LDB(B0, 1, 0); PG8_SCHED; PG8_LDA(At, 1, 0); PG8_STAGE(PG8_SA(0, 1), a2 + hstep, voffA);
            PG8_WAIT_L(8); PG8_BAR; PG8_WAIT_L(0); PG8_MMA(0, 0, At, B0); PG8_BAR; PG8_SCHED;
            PG8_LDB(B1, 1, 1); PG8_STAGE(PG8_SB(1, 0), b3, voffB);
            PG8_BAR; PG8_WAIT_L(0); PG8_MMA(0, 1, At, B1); PG8_BAR;
            PG8_LDA(At, 1, 1); PG8_STAGE(PG8_SA(1, 0), a3, voffA);
            PG8_BAR; PG8_WAIT_L(0); PG8_MMA(1, 0, At, B0); PG8_BAR; PG8_SCHED;
            PG8_STAGE(PG8_SB(1, 1), b3 + hstep, voffB);
            PG8_WAIT_V(6); PG8_BAR; PG8_MMA(1, 1, At, B1); PG8_BAR;
            }
        }
        if constexpr (ALIGN_EPI) { if (wr == 0) PG8_BAR; }
        if constexpr (!Epi::AFTER_DRAIN) { E(acc, cur, wr, wc, fr, fq); S.done(cur); }
        if (!has_next) break;
#pragma unroll
        for (int a = 0; a < 2; ++a)
#pragma unroll
            for (int b = 0; b < 2; ++b)
#pragma unroll
                for (int m = 0; m < 4; ++m)
#pragma unroll
                    for (int n = 0; n < 2; ++n) acc[a][b][m][n] = (f32x4){0.f, 0.f, 0.f, 0.f};
        cur = nxt; cA = nA; cB = nB; ++ui;
        if constexpr (ALIGN_EPI) { if (wr == 1) PG8_BAR; }
    }
    PG8_WAIT_V(0);
    if constexpr (!ALIGN_EPI) { if (wr == 0) PG8_BAR; }
    PG8_BAR;
    if constexpr (Epi::AFTER_DRAIN) { E.fused(acc, cur, wr, wc, fr, fq, lds, wid, lane); S.done(cur); }
#undef PG8_SA
#undef PG8_SB
#undef PG8_STAGE
#undef PG8_LDA
#undef PG8_LDB
#undef PG8_MMA
#undef PG8_WAIT_V
#undef PG8_WAIT_L
#undef PG8_BAR
#undef PG8_SCHED
}
}

namespace mk {
#define LAS __attribute__((address_space(3)))
typedef unsigned short bf16_t;
typedef short bf16x8 __attribute__((ext_vector_type(8)));
typedef float f32x4 __attribute__((ext_vector_type(4)));
typedef float f32x16 __attribute__((ext_vector_type(16)));
typedef unsigned u32x4 __attribute__((ext_vector_type(4)));
typedef unsigned u32x2 __attribute__((ext_vector_type(2)));
typedef __bf16 bf16x2_t __attribute__((ext_vector_type(2)));
typedef float f32x2_t __attribute__((ext_vector_type(2)));
typedef unsigned u32;

constexpr int DM = 1024, SEQ = 16384, NMETA = 16, MPAD = 16640, INW = 1280;
constexpr int O_K = 512, O_V = 640, O_U = 768;
constexpr int NCH = 513;
constexpr float EPS = 1e-6f;
constexpr float LOG2E = 1.4426950408889634f;
constexpr int NWAVES = 8, NTHR = 512;
constexpr int LDS_BYTES = 163840;
constexpr int MISC_OFF = LDS_BYTES - 128;

constexpr size_t MiB = 1u << 20;
constexpr size_t WS_CTL = 0, CTL_BYTES = 1 * MiB;
constexpr size_t WS_WIN_T = 1 * MiB;
constexpr size_t WS_WOUT_T = 4 * MiB;
constexpr size_t WS_WQ_T = 6 * MiB;
constexpr size_t WS_GLU_T = 10 * MiB;
constexpr size_t WS_SUBK = 10 * MiB + 512 * 1024;
constexpr size_t WS_KT = 11 * MiB;
constexpr size_t WS_F = 12 * MiB;
constexpr size_t WS_E = 16 * MiB;
constexpr size_t WS_ABART = 20 * MiB;
constexpr size_t WS_SLOC = 21 * MiB;
constexpr size_t WS_CARRY = 30 * MiB;
constexpr size_t WS_BUFA = 39 * MiB;
constexpr size_t WS_PROJ = 72 * MiB;
constexpr size_t WS_ATTN = 113 * MiB;
constexpr size_t WS_Z = 129 * MiB;
constexpr size_t WS_SSMO = 145 * MiB;
constexpr size_t WS_QP = 72 * MiB;
constexpr size_t WS_IDX = 161 * MiB;
constexpr size_t WS_GW = 169 * MiB;
constexpr size_t WS_PU = 177 * MiB;
constexpr size_t WS_PV = 193 * MiB;
constexpr size_t WS_SU = 209 * MiB;
constexpr size_t WS_SV = 209 * MiB + 65536;
constexpr size_t WS_HB = 210 * MiB;
constexpr size_t WS_SSA = 242 * MiB;
constexpr size_t WS_SSS = 242 * MiB + 512 * 1024;
constexpr size_t WS_SSH = 243 * MiB;
constexpr size_t WS_END = 245 * MiB;

struct Params { const float* in[25]; float* out; unsigned char* ws; int ph_lo, ph_hi; float one, zero; };
enum { I_X = 0, I_META, I_N1G, I_WIN, I_QNG, I_KNG, I_SINK, I_ARE, I_AIM, I_LDT, I_BRE, I_BIM, I_CRE, I_CIM, I_SD, I_GLUW, I_GLUB, I_AOG, I_SOG, I_WOUT, I_N2G, I_WQ, I_SUBK, I_PU, I_PV };

__device__ __forceinline__ unsigned pk2(float lo, float hi) { f32x2_t v = {lo, hi}; return __builtin_bit_cast(unsigned, __builtin_convertvector(v, bf16x2_t)); }
__device__ __forceinline__ float bflo(unsigned w) { return __uint_as_float(w << 16); }
__device__ __forceinline__ float bfhi(unsigned w) { return __uint_as_float(w & 0xffff0000u); }
__device__ __forceinline__ float wave_sum(float v) {
#pragma unroll
    for (int o = 1; o < 64; o <<= 1) v += __shfl_xor(v, o);
    return v;
}
#define LDS_WAIT() asm volatile("s_waitcnt lgkmcnt(0)" ::: "memory")
__device__ __forceinline__ float gelu_erf(float v) { return 0.5f * v * (1.0f + erff(v * 0.70710678118654752f)); }
__device__ __forceinline__ u32 f2ord(float f) { const u32 u = __float_as_uint(f); return (u & 0x80000000u) ? ~u : (u | 0x80000000u); }
__device__ __forceinline__ float ord2f(u32 o) { const u32 u = (o & 0x80000000u) ? (o & 0x7fffffffu) : ~o; return __uint_as_float(u); }
#define MFMA16(a, b, c) __builtin_amdgcn_mfma_f32_16x16x32_bf16((a), (b), (c), 0, 0, 0)
#define MFMA32(a, b, c) __builtin_amdgcn_mfma_f32_32x32x16_bf16((a), (b), (c), 0, 0, 0)

#define CEX(x, i, j) do { const u32 _a = x[i], _b = x[j]; x[i] = _a > _b ? _a : _b; x[j] = _a > _b ? _b : _a; } while (0)
__device__ __forceinline__ void sort16_desc(u32 (&x)[16]) {
#pragma unroll
    for (int k = 2; k <= 16; k <<= 1) {
#pragma unroll
        for (int j = k >> 1; j > 0; j >>= 1) {
#pragma unroll
            for (int i = 0; i < 16; ++i) { const int l = i ^ j; if (l > i) { if ((i & k) == 0) CEX(x, i, l); else CEX(x, l, i); } }
        }
    }
}
__device__ __forceinline__ void bmerge16_desc(u32 (&x)[16]) {
#pragma unroll
    for (int j = 8; j > 0; j >>= 1) {
#pragma unroll
        for (int i = 0; i < 16; ++i) { const int l = i ^ j; if (l > i) CEX(x, i, l); }
    }
}
__device__ __forceinline__ void merge_top16(u32 (&a)[16], const u32 (&b)[16]) {
#pragma unroll
    for (int i = 0; i < 16; ++i) a[i] = a[i] > b[15 - i] ? a[i] : b[15 - i];
    bmerge16_desc(a);
}
__device__ __forceinline__ void top16_of_64(u32 (&g0)[16], u32 (&g1)[16], u32 (&g2)[16], u32 (&g3)[16]) {
    sort16_desc(g0); sort16_desc(g1); sort16_desc(g2); sort16_desc(g3);
    merge_top16(g0, g1); merge_top16(g2, g3); merge_top16(g0, g2);
}
__device__ const unsigned char CAND_AB[64] = {0, 1, 2, 3, 4, 5, 6, 7, 8, 9, 10, 11, 12, 13, 14, 15, 16, 17, 18, 19, 20, 21, 22, 23, 32, 33, 34, 35, 36, 48, 49, 50, 51, 64, 65, 66, 80, 81, 96, 97, 112, 113, 128, 144, 160, 176, 192, 208, 224, 240, 0, 0, 0, 0, 0, 0, 0, 0, 0, 0, 0, 0, 0, 0};

struct Ctx { LAS unsigned char* lds; int tid, lane, wave, G, bid; };

__device__ __forceinline__ void transpose_item(const float* W, int K, int N, bf16_t* WT, LAS float* scr, int item, int lane, const float* ks0 = nullptr, const float* ks1 = nullptr, int ksplit = 0) {
    const int nblk = N / 32, kb = item / nblk, nb = item % nblk, k0 = 64 * kb, n0 = 32 * nb;
#pragma unroll 8
    for (int i = 0; i < 32; ++i) { const int kk = 2 * i + (lane >> 5); float w = W[(size_t)(k0 + kk) * N + n0 + (lane & 31)];
        if (ks0) { const int k = k0 + kk; w *= (ksplit && k >= ksplit) ? ks1[k - ksplit] : ks0[k]; }
        scr[kk * 33 + (lane & 31)] = w; }
    LDS_WAIT();
    const int c = lane & 7;
#pragma unroll
    for (int j = 0; j < 4; ++j) { const int n = (lane >> 3) + 8 * j; const LAS float* s = scr + (8 * c) * 33 + n;
        u32x4 o; o.x = pk2(s[0 * 33], s[1 * 33]); o.y = pk2(s[2 * 33], s[3 * 33]); o.z = pk2(s[4 * 33], s[5 * 33]); o.w = pk2(s[6 * 33], s[7 * 33]);
        *(u32x4*)(WT + (size_t)(n0 + n) * K + k0 + 8 * c) = o; }
    LDS_WAIT();
}

__device__ __forceinline__ void ssm_tables(const Ctx& C, const Params& P, int g) {
    LAS float* pwr = (LAS float*)C.lds;
    LAS float* pwi = pwr + 33 * 64;
    LAS float* bbr = pwi + 33 * 64;
    LAS float* bbi = bbr + 1024;
    LAS float* ccr = bbi + 1024;
    LAS float* cci = ccr + 1024;
    LAS float* cfr = cci + 1024;
    LAS float* cfi = cfr + 64;
    const int tid = C.tid;
    const float dt = expf(P.in[I_LDT][g]);
    for (int e = tid; e < 33 * 64; e += NTHR) {
        const int l = e >> 6, n = e & 63;
        const float lr = P.in[I_ARE][g * 64 + n], li = P.in[I_AIM][g * 64 + n];
        const float x = lr * dt * (float)l, th = li * dt * (float)l, mag = expf(x);
        float s, c; sincosf(th, &s, &c);
        pwr[e] = mag * c; pwi[e] = mag * s;
        if (l == 32) { float* abt = (float*)(P.ws + WS_ABART) + (g * 64 + n) * 2; abt[0] = mag * c; abt[1] = mag * s; }
    }
    if (tid < 64) {
        const int n = tid;
        const float lr = P.in[I_ARE][g * 64 + n], li = P.in[I_AIM][g * 64 + n];
        const float x1 = lr * dt, th1 = li * dt, em1 = expm1f(x1);
        float s1, c1; sincosf(th1, &s1, &c1);
        const float sh = sinf(0.5f * th1);
        const float nr = em1 * c1 - 2.0f * sh * sh, ni = (em1 + 1.0f) * s1;
        const float den = lr * lr + li * li;
        cfr[n] = (nr * lr + ni * li) / den; cfi[n] = (ni * lr - nr * li) / den;
    }
    __syncthreads();
    for (int e = tid; e < 1024; e += NTHR) {
        const int n = e >> 4;
        const float br = P.in[I_BRE][g * 1024 + e], bi = P.in[I_BIM][g * 1024 + e];
        bbr[e] = cfr[n] * br - cfi[n] * bi; bbi[e] = cfr[n] * bi + cfi[n] * br;
        ccr[e] = P.in[I_CRE][g * 1024 + e]; cci[e] = P.in[I_CIM][g * 1024 + e];
    }
    __syncthreads();
    bf16_t* Kt = (bf16_t*)(P.ws + WS_KT) + (size_t)g * 8448;
    {
        const int pq = tid & 255, p = pq >> 4, q = pq & 15, l0 = (tid >> 8) * 16;
        float cbr[64], cbi[64];
#pragma unroll
        for (int n = 0; n < 64; ++n) { const float cr = ccr[p * 64 + n], ci = cci[p * 64 + n], br = bbr[n * 16 + q], bi = bbi[n * 16 + q]; cbr[n] = cr * br - ci * bi; cbi[n] = cr * bi + ci * br; }
#pragma unroll 1
        for (int lg = l0; lg < l0 + 16; ++lg) {
            float val = 0.f;
#pragma unroll
            for (int n = 0; n < 64; n += 4) {
                const f32x4 ar = *(const LAS f32x4*)(pwr + lg * 64 + n), ai = *(const LAS f32x4*)(pwi + lg * 64 + n);
                val += cbr[n] * ar.x - cbi[n] * ai.x; val += cbr[n + 1] * ar.y - cbi[n + 1] * ai.y; val += cbr[n + 2] * ar.z - cbi[n + 2] * ai.z; val += cbr[n + 3] * ar.w - cbi[n + 3] * ai.w;
            }
            Kt[(lg + 1) * 256 + pq] = (bf16_t)(pk2(val, 0.f) & 0xffffu);
        }
        if (tid < 256) Kt[tid] = 0;
    }
    bf16_t* F = (bf16_t*)(P.ws + WS_F) + (size_t)g * 65536;
    for (int e8 = tid; e8 < 8192; e8 += NTHR) {
        const int n2 = e8 >> 6, k0 = (e8 & 63) * 8, j = k0 >> 4, q0 = k0 & 15, n = n2 & 63, l = 31 - j;
        const float ar = pwr[l * 64 + n], ai = pwi[l * 64 + n];
        float w[8];
#pragma unroll
        for (int i = 0; i < 8; ++i) { const float br = bbr[n * 16 + q0 + i], bi = bbi[n * 16 + q0 + i]; w[i] = (n2 < 64) ? (ar * br - ai * bi) : (ar * bi + ai * br); }
        u32x4 o; o.x = pk2(w[0], w[1]); o.y = pk2(w[2], w[3]); o.z = pk2(w[4], w[5]); o.w = pk2(w[6], w[7]);
        *(u32x4*)(F + (size_t)e8 * 8) = o;
    }
    bf16_t* E = (bf16_t*)(P.ws + WS_E) + (size_t)g * 65536;
    for (int e8 = tid; e8 < 8192; e8 += NTHR) {
        const int row = e8 >> 4, n20 = (e8 & 15) * 8, t = row >> 4, p = row & 15, n0 = n20 & 63;
        float w[8];
#pragma unroll
        for (int i = 0; i < 8; ++i) { const int n = n0 + i; const float pr = pwr[(t + 1) * 64 + n], pi = pwi[(t + 1) * 64 + n], cr = ccr[p * 64 + n], ci = cci[p * 64 + n];
            w[i] = (n20 < 64) ? (cr * pr - ci * pi) : -(cr * pi + ci * pr); }
        u32x4 o; o.x = pk2(w[0], w[1]); o.y = pk2(w[2], w[3]); o.z = pk2(w[4], w[5]); o.w = pk2(w[6], w[7]);
        *(u32x4*)(E + (size_t)e8 * 8) = o;
    }
    __syncthreads();
}

__device__ __forceinline__ void norm_row_to_bf16(const float* src, const float* gam, bf16_t* dst, int lane) {
    const f32x4* xr = (const f32x4*)src + lane; const f32x4* gr = (const f32x4*)gam + lane;
    f32x4 v[4]; float s = 0.f;
#pragma unroll
    for (int j = 0; j < 4; ++j) { v[j] = xr[64 * j]; s += (v[j].x * v[j].x + v[j].y * v[j].y) + (v[j].z * v[j].z + v[j].w * v[j].w); }
    const float rinv = 1.0f / sqrtf(wave_sum(s) * (1.0f / DM) + EPS);
    u32x2* o = (u32x2*)dst + lane;
#pragma unroll
    for (int j = 0; j < 4; ++j) { const f32x4 g = gr[64 * j]; u32x2 w; w.x = pk2(v[j].x * rinv * g.x, v[j].y * rinv * g.y); w.y = pk2(v[j].z * rinv * g.z, v[j].w * rinv * g.w); o[64 * j] = w; }
}

__device__ __forceinline__ void cvt8(const float* src, bf16_t* dst, size_t i) {
    const f32x4 a = ((const f32x4*)src)[2 * i], b = ((const f32x4*)src)[2 * i + 1];
    u32x4 o; o.x = pk2(a.x, a.y); o.y = pk2(a.z, a.w); o.z = pk2(b.x, b.y); o.w = pk2(b.z, b.w);
    ((u32x4*)dst)[i] = o;
}

__device__ __forceinline__ float wave_max(float m) {
    m = fmaxf(m, __builtin_bit_cast(float, __builtin_amdgcn_update_dpp(0, __builtin_bit_cast(int, m), 0xB1, 0xf, 0xf, true)));
    m = fmaxf(m, __builtin_bit_cast(float, __builtin_amdgcn_update_dpp(0, __builtin_bit_cast(int, m), 0x4E, 0xf, 0xf, true)));
    m = fmaxf(m, __builtin_bit_cast(float, __builtin_amdgcn_update_dpp(0, __builtin_bit_cast(int, m), 0x141, 0xf, 0xf, true)));
    m = fmaxf(m, __builtin_bit_cast(float, __builtin_amdgcn_update_dpp(0, __builtin_bit_cast(int, m), 0x140, 0xf, 0xf, true)));
    u32 x = __builtin_bit_cast(u32, m);
    { u32 b = x; asm volatile("" : "+v"(b)); const auto p = __builtin_amdgcn_permlane16_swap(x, b, false, false); x = p[0] > p[1] ? p[0] : p[1]; }
    { u32 b = x; asm volatile("" : "+v"(b)); const auto p = __builtin_amdgcn_permlane32_swap(x, b, false, false); x = p[0] > p[1] ? p[0] : p[1]; }
    m = __builtin_bit_cast(float, x);
    return m;
}
template <int NR> __device__ __forceinline__ void quant_rows(const Params& P, const int (&rr)[NR], int lane) {
    f32x4 v[NR][4]; float m[NR];
#pragma unroll
    for (int i = 0; i < NR; ++i) {
        const bool isv = rr[i] >= 16384; const int row = isv ? rr[i] - 16384 : rr[i];
        const f32x4* src = (const f32x4*)((isv ? P.in[I_PV] : P.in[I_PU]) + (size_t)row * DM) + lane;
#pragma unroll
        for (int j = 0; j < 4; ++j) v[i][j] = __builtin_nontemporal_load(src + 64 * j);
    }
#pragma unroll
    for (int i = 0; i < NR; ++i) {
        float mm = 0.f;
#pragma unroll
        for (int j = 0; j < 4; ++j) mm = fmaxf(mm, fmaxf(fmaxf(fabsf(v[i][j].x), fabsf(v[i][j].y)), fmaxf(fabsf(v[i][j].z), fabsf(v[i][j].w))));
        m[i] = wave_max(mm);
    }
#pragma unroll
    for (int i = 0; i < NR; ++i) {
        const bool isv = rr[i] >= 16384; const int row = isv ? rr[i] - 16384 : rr[i];
        const float top = isv ? 416.0f : 127.0f;
        const float sc = (m[i] > 0.f) ? m[i] / top : 1.0f, inv = (m[i] > 0.f) ? top / m[i] : 0.f;
        u32x4 w;
#pragma unroll
        for (int j = 0; j < 4; ++j) {
            if (isv) {
                int t = __builtin_amdgcn_cvt_pk_fp8_f32(v[i][j].x * inv, v[i][j].y * inv, 0, false);
                t = __builtin_amdgcn_cvt_pk_fp8_f32(v[i][j].z * inv, v[i][j].w * inv, t, true);
                w[j] = (u32)t;
            } else {
                const int q0 = (int)rintf(v[i][j].x * inv), q1 = (int)rintf(v[i][j].y * inv), q2 = (int)rintf(v[i][j].z * inv), q3 = (int)rintf(v[i][j].w * inv);
                w[j] = (u32)(q0 & 255) | ((u32)(q1 & 255) << 8) | ((u32)(q2 & 255) << 16) | ((u32)(q3 & 255) << 24);
            }
        }
        *(u32x4*)(P.ws + (isv ? WS_PV : WS_PU) + (size_t)row * 1024 + 16 * lane) = w;
        if (lane == 0) ((float*)(P.ws + (isv ? WS_SV : WS_SU)))[row] = sc;
    }
}
template <int NR> __device__ __forceinline__ void xn_rows(const Params& P, const int (&mm)[NR], int lane) {
    bf16_t* xn = (bf16_t*)(P.ws + WS_BUFA);
    f32x4 v[NR][4]; f32x4 g[4];
#pragma unroll
    for (int j = 0; j < 4; ++j) g[j] = ((const f32x4*)P.in[I_N1G])[64 * j + lane];
#pragma unroll
    for (int i = 0; i < NR; ++i) {
        const int m = mm[i];
        const float* src = (m < SEQ) ? P.in[I_X] + (size_t)m * DM : P.in[I_META] + (size_t)((m < SEQ + NMETA) ? (m - SEQ) : 0) * DM;
#pragma unroll
        for (int j = 0; j < 4; ++j) v[i][j] = ((const f32x4*)src)[64 * j + lane];
    }
#pragma unroll
    for (int i = 0; i < NR; ++i) {
        const int m = mm[i];
        float ss = 0.f;
#pragma unroll
        for (int j = 0; j < 4; ++j) ss += (v[i][j].x * v[i][j].x + v[i][j].y * v[i][j].y) + (v[i][j].z * v[i][j].z + v[i][j].w * v[i][j].w);
        float rinv = 1.0f / sqrtf(wave_sum(ss) * (1.0f / DM) + EPS);
        if (m >= SEQ + NMETA) rinv = 0.f;
        u32x2* o = (u32x2*)(xn + (size_t)m * DM) + lane;
#pragma unroll
        for (int j = 0; j < 4; ++j) { u32x2 w; w.x = pk2(v[i][j].x * rinv * g[j].x, v[i][j].y * rinv * g[j].y); w.y = pk2(v[i][j].z * rinv * g[j].z, v[i][j].w * rinv * g[j].w); o[64 * j] = w; }
    }
}
__device__ __forceinline__ void phase_prologue(const Ctx& C, const Params& P) {
    LAS float* scr = (LAS float*)(C.lds + C.wave * 16384);
    const int gw = C.bid * NWAVES + C.wave, NGW = C.G * NWAVES;
    for (int it = gw; it < 16 * 40; it += NGW) transpose_item(P.in[I_WIN], 1024, 1280, (bf16_t*)(P.ws + WS_WIN_T), scr, it, C.lane);
    for (int m = gw; m < MPAD; m += 4 * NGW) {
        if (m + 3 * NGW < MPAD) { const int mm[4] = {m, m + NGW, m + 2 * NGW, m + 3 * NGW}; xn_rows<4>(P, mm, C.lane); }
        else { for (int q = m; q < MPAD; q += NGW) { const int mm[1] = {q}; xn_rows<1>(P, mm, C.lane); } }
    }
}
__device__ __forceinline__ void deferred_a(const Ctx& C, const Params& P, int ib, int nib) {
    __syncthreads();
    const int nssm = (nib >= 64) ? 32 : 0;
    if (nssm) { if (ib < 32) { ssm_tables(C, P, ib); return; } }
    else { for (int g = ib; g < 32; g += nib) ssm_tables(C, P, g); }
    __syncthreads();
    LAS float* scr = (LAS float*)(C.lds + C.wave * 16384);
    const int gw = (ib - nssm) * NWAVES + C.wave, NGW = (nib - nssm) * NWAVES;
    for (int it = gw; it < 8 * 16; it += NGW) transpose_item(P.in[I_GLUW], 512, 512, (bf16_t*)(P.ws + WS_GLU_T), scr, it, C.lane);
    for (int r = gw; r < 2 * 16384; r += 4 * NGW) {
        if (r + 3 * NGW < 2 * 16384) { const int rr[4] = {r, r + NGW, r + 2 * NGW, r + 3 * NGW}; quant_rows<4>(P, rr, C.lane); }
        else { for (int q = r; q < 2 * 16384; q += NGW) { const int rr[1] = {q}; quant_rows<1>(P, rr, C.lane); } }
    }
    const size_t gt = (size_t)(ib - nssm) * NTHR + C.tid, NT = (size_t)(nib - nssm) * NTHR;
    for (size_t i = gt; i < 262144 / 8; i += NT) cvt8(P.in[I_SUBK], (bf16_t*)(P.ws + WS_SUBK), i);
}
__device__ __forceinline__ void deferred_b(const Ctx& C, const Params& P, int ib, int nib) {
    __syncthreads();
    LAS float* scr = (LAS float*)(C.lds + C.wave * 16384);
    const int gw = ib * NWAVES + C.wave, NGW = nib * NWAVES;
    constexpr int I_OUT = 16 * 32, I_Q = 16 * 64;
    for (int it = gw; it < I_OUT + I_Q; it += NGW) {
        if (it < I_OUT) transpose_item(P.in[I_WOUT], 1024, 1024, (bf16_t*)(P.ws + WS_WOUT_T), scr, it, C.lane, P.in[I_AOG], P.in[I_SOG], 512);
        else transpose_item(P.in[I_WQ], 1024, 2048, (bf16_t*)(P.ws + WS_WQ_T), scr, it - I_OUT, C.lane, P.in[I_N2G]);
    }
}

__device__ __forceinline__ bf16x8 u_frag(const bf16_t* proj, int ci, int j, int g, int half) {
    const bool ok = (ci == 0) ? (j >= 16) : (ci < NCH);
    int row = (ci == 0) ? (SEQ + j - 16) : ((ci - 1) * 32 + j);
    row = ok ? row : 0;
    const u32x4 w = *(const u32x4*)(proj + (size_t)row * INW + O_U + g * 16 + half * 8);
    u32x4 z; z.x = ok ? w.x : 0u; z.y = ok ? w.y : 0u; z.z = ok ? w.z : 0u; z.w = ok ? w.w : 0u;
    return __builtin_bit_cast(bf16x8, z);
}

constexpr int F_PITCH = 1040;
__device__ __forceinline__ void phase_sloc(const Ctx& C, const Params& P) {
    const bf16_t* proj = (const bf16_t*)(P.ws + WS_PROJ);
    float* SL = (float*)(P.ws + WS_SLOC);
    const int n = C.lane & 15, kq = C.lane >> 4;
    for (int bu = C.bid; bu < 160; bu += C.G) {
        const int g = bu / 5, qtr = bu % 5, s = qtr * 8 + C.wave, ci = 16 * s + n;
        bf16x8 Bf[16];
#pragma unroll
        for (int ks = 0; ks < 16; ++ks) Bf[ks] = u_frag(proj, (s < 33) ? ci : NCH, 2 * ks + (kq >> 1), g, kq & 1);
        __syncthreads();
        { const u32x4* src = (const u32x4*)((const bf16_t*)(P.ws + WS_F) + (size_t)g * 65536);
          u32x4 t[16];
#pragma unroll
          for (int i = 0; i < 16; ++i) t[i] = src[C.tid + NTHR * i];
#pragma unroll
          for (int i = 0; i < 16; ++i) { const int e = C.tid + NTHR * i; *(LAS u32x4*)(C.lds + (e >> 6) * F_PITCH + (e & 63) * 16) = t[i]; } }
        __syncthreads();
        if (s < 33) {
#pragma unroll 1
            for (int mt = 0; mt < 8; ++mt) {
                f32x4 acc = {0.f, 0.f, 0.f, 0.f};
#pragma unroll
                for (int ks = 0; ks < 16; ++ks) {
                    const bf16x8 A = *(const LAS bf16x8*)(C.lds + (mt * 16 + n) * F_PITCH + (32 * ks + 8 * kq) * 2);
                    acc = MFMA16(A, Bf[ks], acc);
                }
                if (ci < NCH) *(f32x4*)(SL + ((size_t)ci * 32 + g) * 128 + mt * 16 + 4 * kq) = acc;
            }
        }
    }
}

__device__ __forceinline__ void carry_scan_block(const Ctx& C, const Params& P, int bk) {
    const float* SL = (const float*)(P.ws + WS_SLOC);
    float* CA = (float*)(P.ws + WS_CARRY);
    LAS float* Lr = (LAS float*)C.lds;
    LAS float* Li = Lr + 512;
    const int chan = bk * 32 + (C.tid & 31), g = chan >> 6, n = chan & 63, sg = C.tid >> 5;
    const float* abt = (const float*)(P.ws + WS_ABART) + (g * 64 + n) * 2;
    const float ar = abt[0], ai = abt[1];
    float sr = 0.f, si = 0.f;
#pragma unroll 8
    for (int i = 0; i < 32; ++i) {
        const int ci = 32 * sg + i; const size_t o = ((size_t)ci * 32 + g) * 128 + n;
        const float br = SL[o], bi = SL[o + 64];
        const float tr = ar * sr - ai * si + br, ti = ar * si + ai * sr + bi; sr = tr; si = ti;
    }
    Lr[sg * 32 + (C.tid & 31)] = sr; Li[sg * 32 + (C.tid & 31)] = si;
    float pr = ar, pi = ai;
#pragma unroll
    for (int k = 0; k < 5; ++k) { const float tr = pr * pr - pi * pi, ti = 2.f * pr * pi; pr = tr; pi = ti; }
    __syncthreads();
    float cr = 0.f, ci_ = 0.f;
    for (int s2 = 0; s2 < sg; ++s2) { const float lr = Lr[s2 * 32 + (C.tid & 31)], li = Li[s2 * 32 + (C.tid & 31)];
        const float tr = pr * cr - pi * ci_ + lr, ti = pr * ci_ + pi * cr + li; cr = tr; ci_ = ti; }
    sr = cr; si = ci_;
#pragma unroll 8
    for (int i = 0; i < 32; ++i) {
        const int ci = 32 * sg + i; const size_t o = ((size_t)ci * 32 + g) * 128 + n;
        CA[o] = sr; CA[o + 64] = si;
        const float br = SL[o], bi = SL[o + 64];
        const float tr = ar * sr - ai * si + br, ti = ar * si + ai * sr + bi; sr = tr; si = ti;
    }
    if (sg == 15) { const size_t o = ((size_t)512 * 32 + g) * 128 + n; CA[o] = sr; CA[o + 64] = si; }
    __syncthreads();
}

constexpr int E_OFF = 16896, E_PITCH = 272;
__device__ __forceinline__ void phase_ssm_y(const Ctx& C, const Params& P) {
    const bf16_t* proj = (const bf16_t*)(P.ws + WS_PROJ);
    const float* CA = (const float*)(P.ws + WS_CARRY);
    bf16_t* Z = (bf16_t*)(P.ws + WS_Z);
    const int n = C.lane & 15, kq = C.lane >> 4;
    for (int bu = C.bid; bu < 256; bu += C.G) {
        const int g = bu >> 3, cq = bu & 7;
        __syncthreads();
        { const u32x4* src = (const u32x4*)((const bf16_t*)(P.ws + WS_KT) + (size_t)g * 8448); LAS u32x4* dst = (LAS u32x4*)C.lds;
          for (int e = C.tid; e < 1056; e += NTHR) dst[e] = src[e];
          const u32x4* esrc = (const u32x4*)((const bf16_t*)(P.ws + WS_E) + (size_t)g * 65536);
          u32x4 t[16];
#pragma unroll
          for (int i = 0; i < 16; ++i) t[i] = esrc[C.tid + NTHR * i];
#pragma unroll
          for (int i = 0; i < 16; ++i) { const int e = C.tid + NTHR * i; *(LAS u32x4*)(C.lds + E_OFF + (e >> 4) * E_PITCH + (e & 15) * 16) = t[i]; } }
        __syncthreads();
        const int ci = 1 + 64 * cq + 16 * (C.wave >> 1) + n, par = C.wave & 1;
        bf16x8 Uf[16], Cf[4];
#pragma unroll
        for (int ks = 0; ks < 16; ++ks) Uf[ks] = u_frag(proj, ci, 2 * ks + (kq >> 1), g, kq & 1);
#pragma unroll
        for (int k2 = 0; k2 < 4; ++k2) {
            const float* cp = CA + ((size_t)ci * 32 + g) * 128 + 32 * k2 + 8 * kq;
            const f32x4 a = *(const f32x4*)cp, b = *(const f32x4*)(cp + 4);
            u32x4 w; w.x = pk2(a.x, a.y); w.y = pk2(a.z, a.w); w.z = pk2(b.x, b.y); w.w = pk2(b.z, b.w);
            Cf[k2] = __builtin_bit_cast(bf16x8, w);
        }
        const f32x4 dv = *(const f32x4*)(P.in[I_SD] + g * 16 + 4 * kq);
#pragma unroll 1
        for (int tt = 0; tt < 16; ++tt) {
            const int t = 2 * tt + par;
            f32x4 acc = {0.f, 0.f, 0.f, 0.f};
#pragma unroll
            for (int k2 = 0; k2 < 4; ++k2) {
                const bf16x8 A = *(const LAS bf16x8*)(C.lds + E_OFF + (t * 16 + n) * E_PITCH + (32 * k2 + 8 * kq) * 2);
                acc = MFMA16(A, Cf[k2], acc);
            }
#pragma unroll
            for (int ks = 0; ks < 16; ++ks) {
                if (ks <= tt) {
                    const int li = t - 2 * ks - (kq >> 1) + 1;
                    const bf16x8 A = *(const LAS bf16x8*)(C.lds + ((li * 16 + n) * 16 + 8 * (kq & 1)) * 2);
                    acc = MFMA16(A, Uf[ks], acc);
                }
            }
            const int row = (ci - 1) * 32 + t, ch = g * 16 + 4 * kq;
            const u32x2 uw = *(const u32x2*)(proj + (size_t)row * INW + O_U + ch);
            const float y0 = acc.x + dv.x * bflo(uw.x), y1 = acc.y + dv.y * bfhi(uw.x), y2 = acc.z + dv.z * bflo(uw.y), y3 = acc.w + dv.w * bfhi(uw.y);
            u32x2 o; o.x = pk2(gelu_erf(y0), gelu_erf(y1)); o.y = pk2(gelu_erf(y2), gelu_erf(y3));
            *(u32x2*)(Z + (size_t)row * 512 + ch) = o;
        }
    }
}

constexpr int VT_PITCH = 296;
__device__ __forceinline__ void attn_unit(const Ctx& C, const Params& P, int b, int hk) {
    const bf16_t* proj = (const bf16_t*)(P.ws + WS_PROJ);
    bf16_t* AO = (bf16_t*)(P.ws + WS_BUFA);
    float* SSA = (float*)(P.ws + WS_SSA);
    LAS unsigned char* Ks = C.lds;
    LAS bf16_t* Vt = (LAS bf16_t*)(C.lds + 288 * 128);
    __syncthreads();
    for (int e = C.tid; e < 288 * 8; e += NTHR) {
        const int key = e >> 3, ch = e & 7;
        int row = -1;
        if (key < 256) { const int j = (b - 1) * 128 + key; if (j >= 0) row = j; } else if (key < 272) row = SEQ + key - 256;
        u32x4 kw = {0u, 0u, 0u, 0u}, vw = {0u, 0u, 0u, 0u};
        if (row >= 0) { kw = *(const u32x4*)(proj + (size_t)row * INW + O_K + hk * 64 + ch * 8); vw = *(const u32x4*)(proj + (size_t)row * INW + O_V + hk * 64 + ch * 8); }
        float kf[8] = {bflo(kw.x), bfhi(kw.x), bflo(kw.y), bfhi(kw.y), bflo(kw.z), bfhi(kw.z), bflo(kw.w), bfhi(kw.w)};
        float ss = 0.f;
#pragma unroll
        for (int i = 0; i < 8; ++i) ss += kf[i] * kf[i];
        ss += __shfl_xor(ss, 1); ss += __shfl_xor(ss, 2); ss += __shfl_xor(ss, 4);
        const float rinv = 1.0f / sqrtf(ss * (1.0f / 64.0f) + EPS);
        const f32x4 g0 = *(const f32x4*)(P.in[I_KNG] + ch * 8), g1 = *(const f32x4*)(P.in[I_KNG] + ch * 8 + 4);
        u32x4 o; o.x = pk2(kf[0] * rinv * g0.x, kf[1] * rinv * g0.y); o.y = pk2(kf[2] * rinv * g0.z, kf[3] * rinv * g0.w);
        o.z = pk2(kf[4] * rinv * g1.x, kf[5] * rinv * g1.y); o.w = pk2(kf[6] * rinv * g1.z, kf[7] * rinv * g1.w);
        *(LAS u32x4*)(Ks + key * 128 + ((ch ^ (key & 7)) * 16)) = o;
        const unsigned vv[4] = {vw.x, vw.y, vw.z, vw.w};
#pragma unroll
        for (int i = 0; i < 4; ++i) { Vt[(ch * 8 + 2 * i) * VT_PITCH + key] = (bf16_t)(vv[i] & 0xffffu); Vt[(ch * 8 + 2 * i + 1) * VT_PITCH + key] = (bf16_t)(vv[i] >> 16); }
    }
    __syncthreads();
    const int c = C.lane & 31, h = C.lane >> 5;
#pragma unroll 1
    for (int ti = C.wave; ti < 16; ti += NWAVES) {
        const int hql = ti >> 2, wq = ti & 3, hq = hk * 4 + hql;
        const int qi = wq * 32 + c, tok = b * 128 + qi;
        bf16x8 qf[4];
        {
            u32x4 qw[4]; float ss = 0.f;
#pragma unroll
            for (int ks = 0; ks < 4; ++ks) { qw[ks] = *(const u32x4*)(proj + (size_t)tok * INW + hq * 64 + 16 * ks + 8 * h);
                const unsigned w[4] = {qw[ks].x, qw[ks].y, qw[ks].z, qw[ks].w};
#pragma unroll
                for (int i = 0; i < 4; ++i) { const float a = bflo(w[i]), bb = bfhi(w[i]); ss += a * a + bb * bb; } }
            ss += __shfl_xor(ss, 32);
            const float rinv = (1.0f / sqrtf(ss * (1.0f / 64.0f) + EPS)) * (0.125f * LOG2E);
#pragma unroll
            for (int ks = 0; ks < 4; ++ks) {
                const f32x4 g0 = *(const f32x4*)(P.in[I_QNG] + 16 * ks + 8 * h), g1 = *(const f32x4*)(P.in[I_QNG] + 16 * ks + 8 * h + 4);
                u32x4 o; o.x = pk2(bflo(qw[ks].x) * rinv * g0.x, bfhi(qw[ks].x) * rinv * g0.y); o.y = pk2(bflo(qw[ks].y) * rinv * g0.z, bfhi(qw[ks].y) * rinv * g0.w);
                o.z = pk2(bflo(qw[ks].z) * rinv * g1.x, bfhi(qw[ks].z) * rinv * g1.y); o.w = pk2(bflo(qw[ks].w) * rinv * g1.z, bfhi(qw[ks].w) * rinv * g1.w);
                qf[ks] = __builtin_bit_cast(bf16x8, o);
            }
        }
        f32x16 S[6];
#pragma unroll
        for (int rb = 0; rb < 6; ++rb) {
            const int kb = (rb < 5) ? (wq + rb) : 8;
            const int key = kb * 32 + c;
            f32x16 acc = {0.f, 0.f, 0.f, 0.f, 0.f, 0.f, 0.f, 0.f, 0.f, 0.f, 0.f, 0.f, 0.f, 0.f, 0.f, 0.f};
#pragma unroll
            for (int ks = 0; ks < 4; ++ks) {
                const bf16x8 A = *(const LAS bf16x8*)(Ks + key * 128 + (((2 * ks + h) ^ (key & 7)) * 16));
                acc = MFMA32(A, qf[ks], acc);
            }
            S[rb] = acc;
            __builtin_amdgcn_sched_barrier(0);
        }
        const float sl = P.in[I_SINK][hq] * LOG2E;
        float mx = sl;
#pragma unroll
        for (int r = 0; r < 16; ++r) {
            const int kr = (r & 3) + 8 * (r >> 2) + 4 * h;
            const bool gt = kr > c;
            S[0][r] = gt ? S[0][r] : -1e30f;
            S[4][r] = gt ? -1e30f : S[4][r];
            if (r >= 8) S[5][r] = -1e30f;
        }
        if (b == 0) {
#pragma unroll
            for (int rb = 0; rb < 4; ++rb) if (wq + rb < 4) {
#pragma unroll
                for (int r = 0; r < 16; ++r) S[rb][r] = -1e30f;
            }
        }
#pragma unroll
        for (int rb = 0; rb < 6; ++rb)
#pragma unroll
            for (int r = 0; r < 16; ++r) mx = fmaxf(mx, S[rb][r]);
        mx = fmaxf(mx, __shfl_xor(mx, 32));
        float lsum = 0.f;
#pragma unroll
        for (int rb = 0; rb < 6; ++rb)
#pragma unroll
            for (int r = 0; r < 16; ++r) { const float p = exp2f(S[rb][r] - mx); S[rb][r] = p; lsum += p; }
        lsum += __shfl_xor(lsum, 32);
        lsum += exp2f(sl - mx);
        const float linv = 1.0f / lsum;
        f32x16 O[2];
#pragma unroll
        for (int db = 0; db < 2; ++db) O[db] = (f32x16){0.f, 0.f, 0.f, 0.f, 0.f, 0.f, 0.f, 0.f, 0.f, 0.f, 0.f, 0.f, 0.f, 0.f, 0.f, 0.f};
#pragma unroll
        for (int rb = 0; rb < 6; ++rb) {
            const int kb = (rb < 5) ? (wq + rb) : 8;
#pragma unroll
            for (int s = 0; s < 2; ++s) {
                if (rb == 5 && s == 1) continue;
                u32x4 pw; pw.x = pk2(S[rb][8 * s + 0], S[rb][8 * s + 1]); pw.y = pk2(S[rb][8 * s + 2], S[rb][8 * s + 3]);
                pw.z = pk2(S[rb][8 * s + 4], S[rb][8 * s + 5]); pw.w = pk2(S[rb][8 * s + 6], S[rb][8 * s + 7]);
                const bf16x8 Pf = __builtin_bit_cast(bf16x8, pw);
#pragma unroll
                for (int db = 0; db < 2; ++db) {
                    const LAS bf16_t* vp = Vt + (db * 32 + c) * VT_PITCH + kb * 32 + 16 * s + 4 * h;
                    const u32x2 lo = *(const LAS u32x2*)vp, hi2 = *(const LAS u32x2*)(vp + 8);
                    u32x4 vw; vw.x = lo.x; vw.y = lo.y; vw.z = hi2.x; vw.w = hi2.y;
                    O[db] = MFMA32(__builtin_bit_cast(bf16x8, vw), Pf, O[db]);
                }
                __builtin_amdgcn_sched_barrier(0);
            }
        }
        float ssq = 0.f;
#pragma unroll
        for (int db = 0; db < 2; ++db)
#pragma unroll
            for (int gq = 0; gq < 4; ++gq) {
                const float o0 = O[db][4 * gq] * linv, o1 = O[db][4 * gq + 1] * linv, o2 = O[db][4 * gq + 2] * linv, o3 = O[db][4 * gq + 3] * linv;
                ssq += (o0 * o0 + o1 * o1) + (o2 * o2 + o3 * o3);
                u32x2 o; o.x = pk2(o0, o1); o.y = pk2(o2, o3);
                *(u32x2*)(AO + (size_t)tok * 1024 + hq * 64 + db * 32 + 8 * gq + 4 * h) = o;
            }
        ssq += __shfl_xor(ssq, 32);
        if (h == 0) SSA[(size_t)tok * 8 + hq] = ssq;
    }
}

struct EpiGlu {
    static constexpr bool PERM = true, AFTER_DRAIN = false, HAS_MID = false;
    const bf16_t* Z; bf16_t* O; const float* bias; float* SSS;
    __device__ __forceinline__ void operator()(const pg8::f32x4 (&acc)[2][2][4][2], const pg8::Unit& u, int wr, int wc, int fr, int fq) const {
        const int row0 = u.pm * 256 + wr * 64 + fr, col0 = u.pn * 256 + wc * 32 + 8 * fq;
        f32x4 bb[2][2];
#pragma unroll
        for (int bj = 0; bj < 2; ++bj) { bb[bj][0] = *(const f32x4*)(bias + col0 + bj * 128); bb[bj][1] = *(const f32x4*)(bias + col0 + bj * 128 + 4); }
#pragma unroll
        for (int ai = 0; ai < 2; ++ai) {
            u32x4 zw[4][2];
#pragma unroll
            for (int m = 0; m < 4; ++m)
#pragma unroll
                for (int bj = 0; bj < 2; ++bj) zw[m][bj] = *(const u32x4*)(Z + (size_t)(row0 + ai * 128 + m * 16) * 512 + col0 + bj * 128);
#pragma unroll
            for (int m = 0; m < 4; ++m) {
                const int row = row0 + ai * 128 + m * 16; float ssq = 0.f;
#pragma unroll
                for (int bj = 0; bj < 2; ++bj) {
                    const f32x4 b0 = bb[bj][0], b1 = bb[bj][1]; const u32x4 z4 = zw[m][bj];
                    const pg8::f32x4 v0 = acc[ai][bj][m][0], v1 = acc[ai][bj][m][1];
                    const float zf[8] = {bflo(z4.x), bfhi(z4.x), bflo(z4.y), bfhi(z4.y), bflo(z4.z), bfhi(z4.z), bflo(z4.w), bfhi(z4.w)};
                    const float pre[8] = {v0[0] + b0.x, v0[1] + b0.y, v0[2] + b0.z, v0[3] + b0.w, v1[0] + b1.x, v1[1] + b1.y, v1[2] + b1.z, v1[3] + b1.w};
                    float r[8];
#pragma unroll
                    for (int i = 0; i < 8; ++i) { r[i] = zf[i] / (1.0f + __expf(-pre[i])); ssq += r[i] * r[i]; }
                    u32x4 o; o.x = pk2(r[0], r[1]); o.y = pk2(r[2], r[3]); o.z = pk2(r[4], r[5]); o.w = pk2(r[6], r[7]);
                    *(u32x4*)(O + (size_t)row * 1024 + 512 + col0 + bj * 128) = o;
                }
                ssq += __shfl_xor(ssq, 16); ssq += __shfl_xor(ssq, 32);
                if (fq == 0) SSS[(size_t)row * 8 + u.pn * 4 + wc] = ssq;
            }
        }
    }
};
constexpr int FAC_OFF = 131072;
struct EpiMix {
    static constexpr bool PERM = true, AFTER_DRAIN = false, HAS_MID = true;
    const float* X; bf16_t* HB; float* SSH;
    __device__ __forceinline__ void mid(pg8::f32x4 (&acc)[2][2][4][2], const pg8::Unit& u, int wr, int wc, int fr, int fq, LAS unsigned char* lds) const {
#pragma unroll
        for (int ai = 0; ai < 2; ++ai)
#pragma unroll
            for (int m = 0; m < 4; ++m) {
                const float f = ((const LAS float*)(lds + FAC_OFF))[2 * (ai * 128 + wr * 64 + m * 16 + fr)];
#pragma unroll
                for (int bj = 0; bj < 2; ++bj)
#pragma unroll
                    for (int n = 0; n < 2; ++n) acc[ai][bj][m][n] *= f;
            }
    }
    __device__ __forceinline__ void operator()(const pg8::f32x4 (&acc)[2][2][4][2], const pg8::Unit& u, int wr, int wc, int fr, int fq) const {
        extern __shared__ __attribute__((aligned(16))) unsigned char lds_raw_[];
        const LAS float* fac = (const LAS float*)((LAS unsigned char*)lds_raw_ + FAC_OFF);
        const int col0 = u.pn * 256 + wc * 32 + 8 * fq;
#pragma unroll
        for (int ai = 0; ai < 2; ++ai) {
            f32x4 xv[4][2][2];
#pragma unroll
            for (int m = 0; m < 4; ++m)
#pragma unroll
                for (int bj = 0; bj < 2; ++bj) { const size_t off = (size_t)(u.pm * 256 + ai * 128 + wr * 64 + m * 16 + fr) * 1024 + col0 + bj * 128;
                    xv[m][bj][0] = *(const f32x4*)(X + off); xv[m][bj][1] = *(const f32x4*)(X + off + 4); }
#pragma unroll
            for (int m = 0; m < 4; ++m) {
                const int rl = ai * 128 + wr * 64 + m * 16 + fr, row = u.pm * 256 + rl;
                const float rs = fac[2 * rl + 1]; float ssq = 0.f;
#pragma unroll
                for (int bj = 0; bj < 2; ++bj) {
                    const size_t off = (size_t)row * 1024 + col0 + bj * 128;
                    const f32x4 x0 = xv[m][bj][0], x1 = xv[m][bj][1];
                    const pg8::f32x4 v0 = acc[ai][bj][m][0], v1 = acc[ai][bj][m][1];
                    const float hv[8] = {x0.x + rs * v0[0], x0.y + rs * v0[1], x0.z + rs * v0[2], x0.w + rs * v0[3], x1.x + rs * v1[0], x1.y + rs * v1[1], x1.z + rs * v1[2], x1.w + rs * v1[3]};
#pragma unroll
                    for (int i = 0; i < 8; ++i) ssq += hv[i] * hv[i];
                    u32x4 o; o.x = pk2(hv[0], hv[1]); o.y = pk2(hv[2], hv[3]); o.z = pk2(hv[4], hv[5]); o.w = pk2(hv[6], hv[7]);
                    *(u32x4*)(HB + off) = o;
                }
                ssq += __shfl_xor(ssq, 16); ssq += __shfl_xor(ssq, 32);
                if (fq == 0) SSH[(size_t)row * 16 + u.pn * 4 + wc] = ssq;
            }
        }
    }
};
struct EpiQ {
    static constexpr bool PERM = true, AFTER_DRAIN = false, HAS_MID = false;
    bf16_t* O; const float* SSH;
    __device__ __forceinline__ void operator()(const pg8::f32x4 (&acc)[2][2][4][2], const pg8::Unit& u, int wr, int wc, int fr, int fq) const {
        const int col0 = u.pn * 256 + wc * 32 + 8 * fq;
        float ri[2][4];
#pragma unroll
        for (int ai = 0; ai < 2; ++ai)
#pragma unroll
            for (int m = 0; m < 4; ++m) {
                const int row = u.pm * 256 + ai * 128 + wr * 64 + m * 16 + fr;
                const f32x4* sp = (const f32x4*)(SSH + (size_t)row * 16);
                const f32x4 s0 = sp[0], s1 = sp[1], s2 = sp[2], s3 = sp[3];
                const float ss = ((s0.x + s0.y) + (s0.z + s0.w)) + ((s1.x + s1.y) + (s1.z + s1.w)) + ((s2.x + s2.y) + (s2.z + s2.w)) + ((s3.x + s3.y) + (s3.z + s3.w));
                ri[ai][m] = 1.0f / sqrtf(ss * (1.0f / 1024.0f) + EPS);
            }
#pragma unroll
        for (int ai = 0; ai < 2; ++ai)
#pragma unroll
            for (int m = 0; m < 4; ++m) {
                const int row = u.pm * 256 + ai * 128 + wr * 64 + m * 16 + fr; const float r = ri[ai][m];
#pragma unroll
                for (int bj = 0; bj < 2; ++bj) {
                    const pg8::f32x4 v0 = acc[ai][bj][m][0], v1 = acc[ai][bj][m][1];
                    u32x4 o; o.x = pk2(v0[0] * r, v0[1] * r); o.y = pk2(v0[2] * r, v0[3] * r); o.z = pk2(v1[0] * r, v1[1] * r); o.w = pk2(v1[2] * r, v1[3] * r);
                    *(u32x4*)(O + (size_t)row * 2048 + col0 + bj * 128) = o;
                }
            }
    }
};

__device__ __forceinline__ void peer_topk_tile(const Ctx& C, const Params& P, int tok0) {
    const bf16_t* QP = (const bf16_t*)(P.ws + WS_QP);
    const bf16_t* SK = (const bf16_t*)(P.ws + WS_SUBK);
    int* IDX = (int*)(P.ws + WS_IDX); float* GW = (float*)(P.ws + WS_GW);
    LAS u32* lists = (LAS u32*)C.lds;
    const int c = C.lane & 31, h = C.lane >> 5;
    __syncthreads();
#pragma unroll 1
    for (int task = C.wave; task < 32; task += NWAVES) {
        const int tgp = task & 1, hs = task >> 1;
        const int tl = tgp * 32 + c;
        const bf16_t* qrow = QP + (size_t)(tok0 + tl) * 2048 + hs * 128;
        bf16x8 qf[8];
#pragma unroll
        for (int ks = 0; ks < 8; ++ks) qf[ks] = *(const bf16x8*)(qrow + 16 * ks + 8 * h);
        u32 g[4][16];
#pragma unroll
        for (int kb = 0; kb < 4; ++kb) {
            f32x16 acc = {0.f, 0.f, 0.f, 0.f, 0.f, 0.f, 0.f, 0.f, 0.f, 0.f, 0.f, 0.f, 0.f, 0.f, 0.f, 0.f};
            const bf16_t* krow = SK + (size_t)(hs * 128 + kb * 32 + c) * 128;
#pragma unroll
            for (int ks = 0; ks < 8; ++ks) acc = MFMA32(*(const bf16x8*)(krow + 16 * ks + 8 * h), qf[ks], acc);
#pragma unroll
            for (int r = 0; r < 16; ++r) { const int key = kb * 32 + (r & 3) + 8 * (r >> 2) + 4 * h; g[kb][r] = (f2ord(acc[r]) & ~0x7Fu) | (u32)(127 - key); }
        }
        top16_of_64(g[0], g[1], g[2], g[3]);
        u32 pb[16];
#pragma unroll
        for (int i = 0; i < 16; ++i) pb[i] = (u32)__shfl_xor((int)g[0][i], 32);
        merge_top16(g[0], pb);
        if (h == 0) {
            LAS u32x4* dst = (LAS u32x4*)(lists + (tl * 16 + hs) * 16);
#pragma unroll
            for (int i = 0; i < 4; ++i) { u32x4 w; w.x = g[0][4 * i]; w.y = g[0][4 * i + 1]; w.z = g[0][4 * i + 2]; w.w = g[0][4 * i + 3]; dst[i] = w; }
        }
    }
    __syncthreads();
    {
        const int tl = C.tid & 63, hd = C.tid >> 6;
        const LAS u32* L1 = lists + (tl * 16 + hd * 2) * 16; const LAS u32* L2 = L1 + 16;
        float v1[16], v2[16];
#pragma unroll
        for (int i = 0; i < 16; ++i) { v1[i] = ord2f(L1[i] & ~0x7Fu); v2[i] = ord2f(L2[i] & ~0x7Fu); }
        u32 cd[4][16];
        { int cid = 0;
#pragma unroll
          for (int a = 0; a < 16; ++a)
#pragma unroll
              for (int b = 0; b < 16; ++b) if ((a + 1) * (b + 1) <= 16) { cd[cid >> 4][cid & 15] = (f2ord(v1[a] + v2[b]) & ~0x3Fu) | (u32)(63 - cid); ++cid; }
#pragma unroll
          for (int k = 50; k < 64; ++k) cd[k >> 4][k & 15] = 0u; }
        top16_of_64(cd[0], cd[1], cd[2], cd[3]);
        float sc[16]; int ix[16]; float mx = -1e30f;
#pragma unroll
        for (int k = 0; k < 16; ++k) {
            const int cid = 63 - (int)(cd[0][k] & 63u); const int ab = CAND_AB[cid];
            const u32 k1 = L1[ab >> 4], k2 = L2[ab & 15];
            sc[k] = ord2f(k1 & ~0x7Fu) + ord2f(k2 & ~0x7Fu);
            ix[k] = (127 - (int)(k1 & 0x7Fu)) * 128 + (127 - (int)(k2 & 0x7Fu));
            mx = fmaxf(mx, sc[k]);
        }
        float sum = 0.f;
#pragma unroll
        for (int k = 0; k < 16; ++k) { sc[k] = __expf(sc[k] - mx); sum += sc[k]; }
        const float inv = 1.0f / sum;
        int* io = IDX + (size_t)(tok0 + tl) * 128 + hd * 16; float* go = GW + (size_t)(tok0 + tl) * 128 + hd * 16;
#pragma unroll
        for (int k = 0; k < 16; k += 4) {
            *(int4*)(io + k) = make_int4(ix[k], ix[k + 1], ix[k + 2], ix[k + 3]);
            f32x4 gv = {sc[k] * inv, sc[k + 1] * inv, sc[k + 2] * inv, sc[k + 3] * inv}; *(f32x4*)(go + k) = gv;
        }
    }
    __syncthreads();
}

__device__ __forceinline__ int reduce64(int (&r)[64], int lane) {
#pragma unroll
    for (int e = 0; e < 32; ++e) { const auto p = __builtin_amdgcn_permlane32_swap((u32)r[e], (u32)r[e + 32], false, false); r[e] = (int)p[0] + (int)p[1]; }
#pragma unroll
    for (int e = 0; e < 16; ++e) { const auto p = __builtin_amdgcn_permlane16_swap((u32)r[e], (u32)r[e + 16], false, false); r[e] = (int)p[0] + (int)p[1]; }
    const bool b3 = (lane & 8) != 0, b2 = (lane & 4) != 0, b1 = (lane & 2) != 0, b0 = (lane & 1) != 0;
#pragma unroll
    for (int e = 0; e < 8; ++e) { const int keep = b3 ? r[e + 8] : r[e], send = b3 ? r[e] : r[e + 8]; r[e] = keep + __builtin_amdgcn_update_dpp(0, send, 0x128, 0xf, 0xf, true); }
#pragma unroll
    for (int e = 0; e < 4; ++e) { const int keep = b2 ? r[e + 4] : r[e], send = b2 ? r[e] : r[e + 4];
        int t = __builtin_amdgcn_update_dpp(0, send, 0x104, 0xf, 0x5, false);
        t = __builtin_amdgcn_update_dpp(t, send, 0x114, 0xf, 0xA, false);
        r[e] = keep + t; }
#pragma unroll
    for (int e = 0; e < 2; ++e) { const int keep = b1 ? r[e + 2] : r[e], send = b1 ? r[e] : r[e + 2]; r[e] = keep + __builtin_amdgcn_update_dpp(0, send, 0x4E, 0xf, 0xf, true); }
    { const int keep = b0 ? r[1] : r[0], send = b0 ? r[0] : r[1]; r[0] = keep + __builtin_amdgcn_update_dpp(0, send, 0xB1, 0xf, 0xf, true); }
    return r[0];
}
constexpr int GQ_LDS_PER_WAVE = 8192;
#define GQ_FMA16(A, ce, w) do { _Pragma("unroll") for (int j_ = 0; j_ < 4; ++j_) { \
        const f32x2_t lo_ = __builtin_amdgcn_cvt_pk_f32_fp8((int)(w)[j_], false), hi_ = __builtin_amdgcn_cvt_pk_f32_fp8((int)(w)[j_], true); \
        A[4 * j_ + 0] += (ce) * lo_.x; A[4 * j_ + 1] += (ce) * lo_.y; A[4 * j_ + 2] += (ce) * hi_.x; A[4 * j_ + 3] += (ce) * hi_.y; } } while (0)
__device__ __forceinline__ void peer_gather_quad(const Ctx& C, const Params& P, int tokq, float osc) {
    const bf16_t* HN = (const bf16_t*)(P.ws + WS_HB); const float* SSH = (const float*)(P.ws + WS_SSH);
    const unsigned char* PU = P.ws + WS_PU; const unsigned char* PV = P.ws + WS_PV;
    const float* SU = (const float*)(P.ws + WS_SU); const float* SV = (const float*)(P.ws + WS_SV);
    const int* IDX = (const int*)(P.ws + WS_IDX); const float* GW = (const float*)(P.ws + WS_GW);
    const int lane = C.lane;
    LAS unsigned char* qhl = C.lds + C.wave * GQ_LDS_PER_WAVE;
    LAS u32* keyl = (LAS u32*)(qhl + 4096);
    u32 k[8];
#pragma unroll
    for (int s = 0; s < 4; ++s)
#pragma unroll
        for (int hb = 0; hb < 2; ++hb) k[2 * s + hb] = ((u32)IDX[(size_t)(tokq + s) * 128 + 64 * hb + lane] << 9) | (u32)(s << 7) | (u32)(64 * hb + lane);
#pragma unroll
    for (int size = 2; size <= 512; size <<= 1) {
#pragma unroll
        for (int j = size >> 1; j > 0; j >>= 1) {
            u32 nk[8];
#pragma unroll
            for (int r = 0; r < 8; ++r) {
                const int ii = lane + 64 * r;
                const bool asc = (ii & size) == 0, lower = (ii & j) == 0;
                const u32 mine = k[r], other = (j >= 64) ? k[r ^ (j >> 6)] : (u32)__shfl_xor((int)k[r], j);
                const u32 mn = mine < other ? mine : other, mx = mine < other ? other : mine;
                nk[r] = (lower == asc) ? mn : mx;
            }
#pragma unroll
            for (int r = 0; r < 8; ++r) k[r] = nk[r];
        }
    }
#pragma unroll
    for (int r = 0; r < 8; ++r) keyl[64 * r + lane] = k[r];
    float shs[4];
    f32x4 g2v[4];
#pragma unroll
    for (int j = 0; j < 4; ++j) g2v[j] = *(const f32x4*)(P.in[I_N2G] + 256 * j + 4 * lane);
#pragma unroll
    for (int s = 0; s < 4; ++s) {
        float hf[16]; float m = 0.f;
        const float ssp = (lane < 16) ? SSH[(size_t)(tokq + s) * 16 + lane] : 0.f;
#pragma unroll
        for (int j = 0; j < 4; ++j) { const u32x2 w = *(const u32x2*)(HN + (size_t)(tokq + s) * DM + 256 * j + 4 * lane);
            hf[4 * j] = bflo(w.x) * g2v[j].x; hf[4 * j + 1] = bfhi(w.x) * g2v[j].y; hf[4 * j + 2] = bflo(w.y) * g2v[j].z; hf[4 * j + 3] = bfhi(w.y) * g2v[j].w; }
        const float rinv_t = 1.0f / sqrtf(wave_sum(ssp) * (1.0f / 1024.0f) + EPS);
#pragma unroll
        for (int d = 0; d < 16; ++d) m = fmaxf(m, fabsf(hf[d]));
#pragma unroll
        for (int o = 1; o < 64; o <<= 1) m = fmaxf(m, __shfl_xor(m, o));
        shs[s] = ((m > 0.f) ? m * (1.0f / 127.0f) : 1.0f) * rinv_t; const float inv = (m > 0.f) ? 127.0f / m : 0.f;
        u32x4 q;
#pragma unroll
        for (int j = 0; j < 4; ++j) {
            const int q0 = (int)rintf(hf[4 * j] * inv), q1 = (int)rintf(hf[4 * j + 1] * inv), q2 = (int)rintf(hf[4 * j + 2] * inv), q3 = (int)rintf(hf[4 * j + 3] * inv);
            q[j] = (u32)(q0 & 255) | ((u32)(q1 & 255) << 8) | ((u32)(q2 & 255) << 16) | ((u32)(q3 & 255) << 24);
        }
        *(LAS u32x4*)(qhl + s * 1024 + 16 * lane) = q;
    }
    LDS_WAIT();
    LAS float* cvl = (LAS float*)(qhl + 6144);
    float cs0 = 0.f, cs1 = 0.f, cs2 = 0.f, cs3 = 0.f;
#pragma unroll 1
    for (int c = 0; c < 8; ++c) {
        const u32 kk = keyl[64 * c + lane];
        const int e_l = (int)(kk >> 9), slot_l = (int)((kk >> 7) & 3u), pos_l = (int)(kk & 127u);
        const float g_l = GW[(size_t)(tokq + slot_l) * 128 + pos_l], su_l = SU[e_l], sv_l = SV[e_l];
        int r[64];
#pragma unroll
        for (int p = 0; p < 64; ++p) {
            const u32 kp = (u32)__builtin_amdgcn_readlane((int)kk, p);
            const u32x4 w = *(const u32x4*)(PU + (size_t)(kp >> 9) * 1024 + 16 * lane);
            const u32x4 hq = *(const LAS u32x4*)(qhl + ((kp >> 7) & 3u) * 1024 + 16 * lane);
            int a = __builtin_amdgcn_sdot4((int)w.x, (int)hq.x, 0, false);
            a = __builtin_amdgcn_sdot4((int)w.y, (int)hq.y, a, false);
            a = __builtin_amdgcn_sdot4((int)w.z, (int)hq.z, a, false);
            a = __builtin_amdgcn_sdot4((int)w.w, (int)hq.w, a, false);
            r[p] = a;
        }
        const int isum = reduce64(r, lane);
        const float sh_l = (slot_l == 0) ? shs[0] : (slot_l == 1) ? shs[1] : (slot_l == 2) ? shs[2] : shs[3];
        const float z = (float)isum * su_l * sh_l;
        const float c_l = gelu_erf(z) * g_l * sv_l;
        cs0 += (slot_l == 0) ? c_l : 0.f; cs1 += (slot_l == 1) ? c_l : 0.f; cs2 += (slot_l == 2) ? c_l : 0.f; cs3 += (slot_l == 3) ? c_l : 0.f;
        cvl[64 * c + lane] = c_l;
    }
    LDS_WAIT();
    float acc0[16], acc1[16], acc2[16], acc3[16];
#pragma unroll
    for (int d = 0; d < 16; ++d) { acc0[d] = 0.f; acc1[d] = 0.f; acc2[d] = 0.f; acc3[d] = 0.f; }
#define GQ_ISSUE(W, KP, CE, kreg, creg, p0) do { _Pragma("unroll") for (int q = 0; q < 8; ++q) { \
        KP[q] = (u32)__builtin_amdgcn_readlane((int)(kreg), (p0) + q); CE[q] = __uint_as_float((u32)__builtin_amdgcn_readlane((int)__float_as_uint(creg), (p0) + q)); \
        W[q] = *(const u32x4*)(PV + (size_t)(KP[q] >> 9) * 1024 + 16 * lane); } } while (0)
#define GQ_CONSUME(W, KP, CE) do { _Pragma("unroll") for (int q = 0; q < 8; ++q) { const u32 sl = (KP[q] >> 7) & 3u; \
        if (sl == 0u) GQ_FMA16(acc0, CE[q], W[q]); else if (sl == 1u) GQ_FMA16(acc1, CE[q], W[q]); else if (sl == 2u) GQ_FMA16(acc2, CE[q], W[q]); else GQ_FMA16(acc3, CE[q], W[q]); } } while (0)
    {
        u32x4 wA[8], wB[8]; u32 kA[8], kB[8]; float cA[8], cB[8];
        u32 kk = keyl[lane]; float cc = cvl[lane];
        GQ_ISSUE(wA, kA, cA, kk, cc, 0);
#pragma unroll 1
        for (int c = 0; c < 8; ++c) {
            const int cn = (c < 7) ? c + 1 : 7;
            const u32 kkn = keyl[64 * cn + lane]; const float ccn = cvl[64 * cn + lane];
#pragma unroll 1
            for (int p0 = 0; p0 < 64; p0 += 16) {
                GQ_ISSUE(wB, kB, cB, kk, cc, p0 + 8);
                GQ_CONSUME(wA, kA, cA);
                if (p0 < 48) GQ_ISSUE(wA, kA, cA, kk, cc, p0 + 16); else GQ_ISSUE(wA, kA, cA, kkn, ccn, 0);
                GQ_CONSUME(wB, kB, cB);
            }
            kk = kkn; cc = ccn;
        }
    }
#undef GQ_ISSUE
#undef GQ_CONSUME
    const float corr0 = 0.f, corr1 = 0.f, corr2 = 0.f, corr3 = 0.f; (void)cs0; (void)cs1; (void)cs2; (void)cs3;
    u32x2 hw[4][4];
#pragma unroll
    for (int s = 0; s < 4; ++s)
#pragma unroll
        for (int j = 0; j < 4; ++j) hw[s][j] = *(const u32x2*)(HN + (size_t)(tokq + s) * DM + 256 * j + 4 * lane);
#define GQ_OUT(s, A, corr) do { float* orow = P.out + (size_t)(tokq + (s)) * DM; _Pragma("unroll") for (int j = 0; j < 4; ++j) { f32x4* p = (f32x4*)(orow + 256 * j + 4 * lane); \
        f32x4 v; v.x = bflo(hw[s][j].x) + osc * (A[4 * j] - corr); v.y = bfhi(hw[s][j].x) + osc * (A[4 * j + 1] - corr); v.z = bflo(hw[s][j].y) + osc * (A[4 * j + 2] - corr); v.w = bfhi(hw[s][j].y) + osc * (A[4 * j + 3] - corr); *p = v; } } while (0)
    GQ_OUT(0, acc0, corr0); GQ_OUT(1, acc1, corr1); GQ_OUT(2, acc2, corr2); GQ_OUT(3, acc3, corr3);
#undef GQ_OUT
}
__device__ __forceinline__ void peer_gather_tile(const Ctx& C, const Params& P, int tok0, float osc = 1.0f) {
    __syncthreads();
#pragma unroll 1
    for (int hq = 0; hq < 2; ++hq) peer_gather_quad(C, P, tok0 + 32 * hq + 4 * C.wave, osc);
}

#define GAS __attribute__((address_space(1)))
typedef GAS unsigned gu32;
#define RLX_AGENT __ATOMIC_RELAXED, __HIP_MEMORY_SCOPE_AGENT
#define XB_TMO      128
#define XB_XCNT(j)  (256  + 64 * (j))
#define XB_XSUB(j)  (1280 + 64 * (j))
#define XB_XGEN(j)  (2304 + 64 * (j))
#define XB_TOP      3328
#define XB_TOPGEN   3392
#define XCD_BAR_WORDS 3456
#define XB_SPIN_CAP (1u << 18)

__device__ __forceinline__ unsigned xb_ld(unsigned* p)              { return __hip_atomic_load(p, __ATOMIC_RELAXED, __HIP_MEMORY_SCOPE_AGENT); }
__device__ __forceinline__ unsigned xb_add(unsigned* p, unsigned v) { return __hip_atomic_fetch_add(p, v, __ATOMIC_RELAXED, __HIP_MEMORY_SCOPE_AGENT); }
__device__ __forceinline__ unsigned xb_xcc_id() { return (unsigned)__builtin_amdgcn_s_getreg((3 << 11) | 20) & 0xFu; }
#define XB_SPIN(cond, bar) do { unsigned _sp = 0; while (cond) { __builtin_amdgcn_s_sleep(1); \
    if ((++_sp & 255u) == 0u) { if (xb_ld(&(bar)[XB_TMO])) break; if (_sp > XB_SPIN_CAP) { atomicAdd(&(bar)[XB_TMO], 1u); break; } } } } while (0)

struct XcdBarrier {
    unsigned* bar; unsigned x;
    volatile LAS unsigned* st;
};

__device__ __forceinline__ XcdBarrier xcd_barrier_post(unsigned* bar, volatile LAS unsigned* st) {
    XcdBarrier b; b.bar = bar; b.x = xb_xcc_id(); b.st = st;
    if (threadIdx.x == 0) (void)xb_add(&bar[XB_XCNT(b.x)], 1u);
    return b;
}
__device__ __forceinline__ void xcd_barrier_complete(unsigned* bar, unsigned x, unsigned& nloc, unsigned& nx) {
    const unsigned G = gridDim.x * gridDim.y * gridDim.z;
    unsigned sum, cnt, mine, sp = 0u;
    for (;;) {
        sum = 0u; cnt = 0u; mine = 0u;
#pragma unroll
        for (unsigned j = 0; j < 16; ++j) { const unsigned c = xb_ld(&bar[XB_XCNT(j)]); sum += c; cnt += (c > 0u) ? 1u : 0u; mine = (j == x) ? c : mine; }
        if (sum == G) break;
        __builtin_amdgcn_s_sleep(1);
        if ((++sp & 255u) == 0u) { if (xb_ld(&bar[XB_TMO])) break; if (sp > XB_SPIN_CAP) { atomicAdd(&bar[XB_TMO], 1u); break; } }
    }
    nloc = mine > 0u ? mine : 1u; nx = cnt > 0u ? cnt : 1u;
}

__device__ __forceinline__ void xcd_barrier(const XcdBarrier& b) {
    asm volatile("s_waitcnt vmcnt(0)" ::: "memory");
    __syncthreads();
    if (threadIdx.x == 0) {
        unsigned* bar = b.bar;
        __builtin_amdgcn_s_waitcnt(0);
        unsigned nloc = b.st[0], nx = b.st[1];
        if (nloc == 0u) { xcd_barrier_complete(bar, b.x, nloc, nx); b.st[0] = nloc; b.st[1] = nx; }
        const unsigned old = xb_add(&bar[XB_XSUB(b.x)], 1u);
        const unsigned gen = old / nloc;
        if (old + 1u == (gen + 1u) * nloc) {
            __builtin_amdgcn_fence(__ATOMIC_RELEASE, "agent");
            asm volatile("s_waitcnt vmcnt(0)" ::: "memory");
            const unsigned og = xb_add(&bar[XB_TOP], 1u);
            const unsigned tg = og / nx;
            if (og + 1u == (tg + 1u) * nx) xb_add(&bar[XB_TOPGEN], 1u);
            else XB_SPIN(xb_ld(&bar[XB_TOPGEN]) == tg, bar);
            __builtin_amdgcn_fence(__ATOMIC_ACQUIRE, "agent");
            xb_add(&bar[XB_XGEN(b.x)], 1u);
            asm volatile("s_waitcnt vmcnt(0)" ::: "memory");
        } else {
            XB_SPIN(xb_ld(&bar[XB_XGEN(b.x)]) == gen, bar);
            __builtin_amdgcn_fence(__ATOMIC_ACQUIRE, "agent");
            asm volatile("s_waitcnt vmcnt(0)" ::: "memory");
        }
    }
    __syncthreads();
}

constexpr int NPHASE = 9;
__global__ void __launch_bounds__(NTHR, 2) mk_fwd(Params P) {
    extern __shared__ __attribute__((aligned(16))) unsigned char lds_raw[];
    Ctx C; C.lds = (LAS unsigned char*)lds_raw; C.tid = threadIdx.x; C.lane = C.tid & 63; C.wave = __builtin_amdgcn_readfirstlane(C.tid >> 6); C.G = gridDim.x; C.bid = blockIdx.x;
    unsigned char* ws = P.ws;
    volatile LAS unsigned* MISC = (volatile LAS unsigned*)(C.lds + MISC_OFF);
    if (C.tid < 32) MISC[C.tid] = 0u;
    __syncthreads();
    XcdBarrier bar = xcd_barrier_post((unsigned*)(ws + WS_CTL) + 4096, MISC + 8);
#define SEAM(k) do { if (IN(k) && IN((k) + 1)) xcd_barrier(bar); FRESH(); } while (0)
#define FRESH() do { int t_ = (int)threadIdx.x; asm volatile("" : "+v"(t_)); C.tid = t_; C.lane = t_ & 63; } while (0)
#ifndef REPMASK
#define REPMASK 0
#endif
#define NREP(k) (((REPMASK >> (k)) & 1) ? 2 : 1)
#ifdef ONLY_PHASE
#define IN(k) ((k) == ONLY_PHASE && P.ph_lo <= (k) && (k) < P.ph_hi)
#else
#define IN(k) (P.ph_lo <= (k) && (k) < P.ph_hi)
#endif
    for (int rep_ = 0; rep_ < NREP(0); ++rep_) { if (rep_) xcd_barrier(bar); if (IN(0)) phase_prologue(C, P); }
    SEAM(0);
    for (int rep_ = 0; rep_ < NREP(1); ++rep_) { if (rep_) xcd_barrier(bar);
    if (IN(1)) {
        pg8::Gemm g{(const bf16_t*)(ws + WS_BUFA), (const bf16_t*)(ws + WS_WIN_T), MPAD, INW, DM}; pg8::StaticOrder S; S.init(MPAD, INW, C.G, C.bid);
        pg8::EpiBf16<0> E{(bf16_t*)(ws + WS_PROJ), INW, nullptr, 0, 0, 1.f};
        pg8::gemm_phase<pg8::EpiBf16<0>, pg8::StaticOrder, true, true>(C.lds, g, S, E);
        { const int ntile = (MPAD / 256) * (INW / 256), nbusy = ntile % C.G;
          if (ntile > C.G && nbusy > 0) { if (C.bid >= nbusy) deferred_a(C, P, C.bid - nbusy, C.G - nbusy); }
          else deferred_a(C, P, C.bid, C.G); }
    }
    }
    SEAM(1);
#ifdef EXTRA_BARS
    for (int xb_ = 0; xb_ < EXTRA_BARS; ++xb_) xcd_barrier(bar);
#endif
    for (int rep_ = 0; rep_ < NREP(2); ++rep_) { if (rep_) xcd_barrier(bar); if (IN(2)) phase_sloc(C, P); }
    SEAM(2);
    for (int rep_ = 0; rep_ < NREP(3); ++rep_) { if (rep_) xcd_barrier(bar);
    if (IN(3)) {
        for (int bk = C.bid; bk < 64; bk += C.G) carry_scan_block(C, P, bk);
        for (int u = C.bid; u < 256; u += C.G) attn_unit(C, P, u >> 1, u & 1);
    }
    }
    SEAM(3);
    for (int rep_ = 0; rep_ < NREP(4); ++rep_) { if (rep_) xcd_barrier(bar); if (IN(4)) phase_ssm_y(C, P); }
    SEAM(4);
    if (IN(5)) {
        pg8::Gemm g{(const bf16_t*)(ws + WS_Z), (const bf16_t*)(ws + WS_GLU_T), SEQ, 512, 512}; pg8::StaticOrder S; S.init(SEQ, 512, C.G, C.bid);
        EpiGlu E{(const bf16_t*)(ws + WS_Z), (bf16_t*)(ws + WS_BUFA), P.in[I_GLUB], (float*)(ws + WS_SSS)};
        pg8::gemm_phase<EpiGlu, pg8::StaticOrder, true, true>(C.lds, g, S, E);
        { const int ntile = (SEQ / 256) * 2;
          if (ntile < C.G) { if (C.bid >= ntile) deferred_b(C, P, C.bid - ntile, C.G - ntile); }
          else deferred_b(C, P, C.bid, C.G); }
    }
    SEAM(5);
    if (IN(6)) {
        __syncthreads();
        if (C.tid < 256) {
            pg8::StaticOrder S0; S0.init(SEQ, DM, C.G, C.bid); pg8::Unit u0; S0.next(0, u0);
            const int row = u0.pm * 256 + C.tid;
            const f32x4* pa = (const f32x4*)((const float*)(ws + WS_SSA) + (size_t)row * 8); const f32x4* ps = (const f32x4*)((const float*)(ws + WS_SSS) + (size_t)row * 8);
            const f32x4 a0 = pa[0], a1 = pa[1], s0 = ps[0], s1 = ps[1];
            const float ra = 1.0f / sqrtf((((a0.x + a0.y) + (a0.z + a0.w)) + ((a1.x + a1.y) + (a1.z + a1.w))) * (1.0f / 512.0f) + EPS);
            const float rs = 1.0f / sqrtf((((s0.x + s0.y) + (s0.z + s0.w)) + ((s1.x + s1.y) + (s1.z + s1.w))) * (1.0f / 512.0f) + EPS);
            LAS float* fac = (LAS float*)(C.lds + FAC_OFF); fac[2 * C.tid] = ra / rs; fac[2 * C.tid + 1] = rs;
        }
        __syncthreads();
        pg8::Gemm g{(const bf16_t*)(ws + WS_BUFA), (const bf16_t*)(ws + WS_WOUT_T), SEQ, DM, DM}; pg8::StaticOrder S; S.init(SEQ, DM, C.G, C.bid);
        EpiMix E{P.in[I_X], (bf16_t*)(ws + WS_HB), (float*)(ws + WS_SSH)};
        pg8::gemm_phase<EpiMix, pg8::StaticOrder, true, true>(C.lds, g, S, E);
    }
    SEAM(6);
    if (IN(7)) {
        pg8::Gemm g{(const bf16_t*)(ws + WS_HB), (const bf16_t*)(ws + WS_WQ_T), SEQ, 2048, DM}; pg8::StaticOrder S; S.init(SEQ, 2048, C.G, C.bid);
        EpiQ E{(bf16_t*)(ws + WS_QP), (const float*)(ws + WS_SSH)};
        pg8::gemm_phase<EpiQ, pg8::StaticOrder, true, true>(C.lds, g, S, E);
    }
    SEAM(7);
    {
    if (IN(8)) {
        for (int tile = C.bid; tile < SEQ / 64; tile += C.G) {
            peer_topk_tile(C, P, tile * 64);
            if ((REPMASK >> 11) & 1) peer_topk_tile(C, P, tile * 64);
            if ((REPMASK >> 12) & 1) peer_gather_tile(C, P, tile * 64, P.zero);
            peer_gather_tile(C, P, tile * 64, P.one);
        }
    }
    }
#undef IN
#undef SEAM
}
}

extern "C" void kernel_launch(void* const* d_in, const int* in_sizes, int n_in, void* d_out, int out_size, void* d_ws, size_t ws_size, hipStream_t stream) {
    static int state = 0, grid = 0;
    if (state == 0) {
        if (n_in != 25 || out_size != mk::SEQ * mk::DM || ws_size < mk::WS_END) { fprintf(stderr, "kernel_launch: unexpected shapes (n_in %d out %d ws %zu)\n", n_in, out_size, ws_size); state = -1; return; }
        if (hipFuncSetAttribute((const void*)mk::mk_fwd, hipFuncAttributeMaxDynamicSharedMemorySize, mk::LDS_BYTES) != hipSuccess) { fprintf(stderr, "kernel_launch: hipFuncSetAttribute failed\n"); state = -1; return; }
        int dev = 0, cus = 0, per_cu = 0;
        if (hipGetDevice(&dev) != hipSuccess || hipDeviceGetAttribute(&cus, hipDeviceAttributeMultiprocessorCount, dev) != hipSuccess) { fprintf(stderr, "kernel_launch: device query failed\n"); state = -1; return; }
        if (hipOccupancyMaxActiveBlocksPerMultiprocessor(&per_cu, (const void*)mk::mk_fwd, mk::NTHR, mk::LDS_BYTES) != hipSuccess || per_cu < 1) { fprintf(stderr, "kernel_launch: occupancy query failed (%d)\n", per_cu); state = -1; return; }
        grid = cus;
        state = 1;
    }
    if (state < 0) return;
    mk::Params p{};
    for (int i = 0; i < 25; ++i) p.in[i] = (const float*)d_in[i];
    p.out = (float*)d_out; p.ws = (unsigned char*)d_ws;
    if (hipMemsetAsync((char*)d_ws + mk::WS_CTL, 0, 65536, stream) != hipSuccess) { fprintf(stderr, "kernel_launch: memset failed\n"); return; }
    p.ph_lo = 0; p.ph_hi = mk::NPHASE; p.one = 1.0f; p.zero = 0.0f;
    void* args[] = {&p};
    hipError_t e = hipLaunchCooperativeKernel((const void*)mk::mk_fwd, dim3(grid), dim3(mk::NTHR), args, mk::LDS_BYTES, stream);
    if (e != hipSuccess) fprintf(stderr, "kernel_launch: cooperative launch failed: %s (grid %d)\n", hipGetErrorString(e), grid);
}
```

```cpp
#include <hip/hip_runtime.h>
#include <cstdio>
#include <cstdint>
#include <cmath>
namespace pg8 {
#define PG8_LAS __attribute__((address_space(3)))
typedef unsigned short bf16_t;
typedef short bf16x8 __attribute__((ext_vector_type(8)));
typedef float f32x4 __attribute__((ext_vector_type(4)));
typedef unsigned u32x4 __attribute__((ext_vector_type(4)));
constexpr int BM = 256, BK = 64, HALF = 128, HTB = HALF * BK * 2  , STAGE_BYTES = 8 * HTB, NXCD = 8, WGM = 8;

__host__ __device__ __forceinline__ int lds_byte(int r, int c) { const int st = (r >> 4) * 2 + (c >> 5), rr = r & 15, cc = c & 31, ob = rr * 64 + cc * 2; return st * 1024 + (ob ^ (((ob >> 9) & 1) << 5)); }
__host__ __device__ __forceinline__ void stage_rc(int b, int& R, int& C) { const int st = b / 1024, sb = b % 1024, swz = sb ^ (((sb >> 9) & 1) << 5); R = (st >> 1) * 16 + swz / 64; C = (st & 1) * 32 + (swz % 64) / 2; }
__host__ __device__ __forceinline__ int perm32(int rho) { const int n = rho >> 4, i = rho & 15; return 8 * (i >> 2) + 4 * n + (i & 3); }

struct Unit { int pm, pn; };
struct Gemm { const bf16_t* A; const bf16_t* Bt; int M, N, K; };

struct StaticOrder {
    int nM, nN, nwg, G, c;
    __host__ __device__ __forceinline__ void init(int M, int N, int G_, int c_) { nM = M / BM; nN = N / BM; nwg = nM * nN; G = G_; c = c_; }
    __host__ __device__ __forceinline__ bool next(int i, Unit& u) const {
        const long L = (long)i * G + c; if (L >= nwg) return false;
        int wgid = (int)L; { const int q = nwg / NXCD, r = nwg % NXCD, xcd = wgid % NXCD, off = wgid / NXCD; wgid = (xcd < r ? xcd * (q + 1) : r * (q + 1) + (xcd - r) * q) + off; }
        const int nig = WGM * nN, gid = wgid / nig, fm = gid * WGM, gsz = (nM - fm) < WGM ? (nM - fm) : WGM;
        u.pm = fm + ((wgid % nig) % gsz); u.pn = (wgid % nig) / gsz; return true;
    }
    __device__ __forceinline__ void a_ready(const Unit&) const {}
    __device__ __forceinline__ void done(const Unit&) const {}
};

__device__ __forceinline__ unsigned cvt_pk_bf16(float lo, float hi) { unsigned r; asm volatile("v_cvt_pk_bf16_f32 %0, %1, %2" : "=v"(r) : "v"(lo), "v"(hi)); return r; }
typedef float f32x2 __attribute__((ext_vector_type(2)));
__device__ __forceinline__ f32x2 gelu_pk(f32x2 v) {
    const f32x2 av = __builtin_elementwise_abs(v), d = av * 0.2316418882f + 1.0f;
    f32x2 t; t.x = __builtin_amdgcn_rcpf(d.x); t.y = __builtin_amdgcn_rcpf(d.y);
    f32x2 q = t * 0.5307027145f + (-0.7265760135f); q = q * t + 0.7107068705f; q = q * t + (-0.142248368f); q = q * t + 0.127414796f; q = q * t;
    const f32x2 s = (v * v) * (-0.72134752044f);
    f32x2 e; e.x = __builtin_amdgcn_exp2f(s.x); e.y = __builtin_amdgcn_exp2f(s.y);
    const f32x2 m = v * (q * e), r = v - m;
    f32x2 o; o.x = v.x < 0.f ? m.x : r.x; o.y = v.y < 0.f ? m.y : r.y; return o;
}

template <int ACT  > struct EpiBf16 {
    static constexpr bool PERM = true, AFTER_DRAIN = false, HAS_MID = false; static_assert(ACT == 0 || ACT == 1, "EpiBf16: ACT is 0 (none) or 1 (gelu_pk)");
    bf16_t* O; int ldc; const float* bias; int split_cols; size_t split_stride; float scale0;
    __device__ __forceinline__ void operator()(const f32x4 (&acc)[2][2][4][2], const Unit& u, int wr, int wc, int fr, int fq) const {
        const int row0 = u.pm * BM + wr * 64 + fr; int colt = u.pn * BM; bf16_t* base = O;
        float sc = 1.f; if (split_cols) { const int t = colt / split_cols; base += (size_t)t * split_stride; colt -= t * split_cols; if (t == 0) sc = scale0; }
        const int col0 = colt + wc * 32 + 8 * fq, bcol0 = u.pn * BM + wc * 32 + 8 * fq;
        f32x4 bv[2][2];
#pragma unroll
        for (int bj = 0; bj < 2; ++bj)
#pragma unroll
            for (int n = 0; n < 2; ++n) bv[bj][n] = bias ? *(const f32x4*)(bias + bcol0 + bj * HALF + 4 * n) : (f32x4){0.f, 0.f, 0.f, 0.f};
#pragma unroll
        for (int ai = 0; ai < 2; ++ai)
#pragma unroll
            for (int m = 0; m < 4; ++m) { bf16_t* rowp = base + (size_t)(row0 + ai * HALF + m * 16) * ldc + col0;
#pragma unroll
                for (int bj = 0; bj < 2; ++bj) { f32x4 v0 = acc[ai][bj][m][0] + bv[bj][0], v1 = acc[ai][bj][m][1] + bv[bj][1];
                    if (ACT == 1) { f32x2 a = gelu_pk((f32x2){v0[0], v0[1]}), b = gelu_pk((f32x2){v0[2], v0[3]}), c = gelu_pk((f32x2){v1[0], v1[1]}), d = gelu_pk((f32x2){v1[2], v1[3]});
                        v0 = (f32x4){a.x, a.y, b.x, b.y}; v1 = (f32x4){c.x, c.y, d.x, d.y}; }
                    v0 = v0 * sc; v1 = v1 * sc; u32x4 w; w.x = cvt_pk_bf16(v0[0], v0[1]); w.y = cvt_pk_bf16(v0[2], v0[3]); w.z = cvt_pk_bf16(v1[0], v1[1]); w.w = cvt_pk_bf16(v1[2], v1[3]);
                    *(u32x4*)(rowp + bj * HALF) = w; } }
    }
};
template <class Epi, class Sched, bool ALIGN_EPI = false, bool SP2 = false>
__device__ __forceinline__ void gemm_phase(PG8_LAS unsigned char* lds, const Gemm g, const Sched& S, const Epi& E) {
    const int tid = threadIdx.x, wid = __builtin_amdgcn_readfirstlane(tid >> 6), lane = tid & 63, wr = wid >> 2, wc = wid & 3, fr = lane & 15, fq = lane >> 4;
    const int K = g.K, nt = K / BK;
    unsigned voffA[2], voffB[2];
#pragma unroll
    for (int i = 0; i < 2; ++i) { int R, C; stage_rc(tid * 16 + i * 8192, R, C); const int Rb = Epi::PERM ? ((R & ~31) + perm32(R & 31)) : R;
        voffA[i] = (unsigned)(R * K + C) * 2u; voffB[i] = (unsigned)(Rb * K + C) * 2u; }
    const size_t kstep = (size_t)(BK * 2);
    const size_t hstep = (size_t)HALF * K * 2;
    const size_t tstep = 2 * hstep;
    const unsigned ldsw = (unsigned)wid * 1024u;
    const int aoff = lds_byte(wr * 64 + fr, fq * 8), boff = lds_byte(wc * 32 + fr, fq * 8);
#define PG8_SA(b, h) (((b) * 2 + (h)) * HTB)
#define PG8_SB(b, h) ((4 + (b) * 2 + (h)) * HTB)
#define PG8_STAGE(bufoff, gbase, voff) do { _Pragma("unroll") for (int _i = 0; _i < 2; ++_i) \
        __builtin_amdgcn_global_load_lds((const unsigned*)((const char*)(gbase) + (voff)[_i]), (PG8_LAS unsigned*)(lds + (bufoff) + ldsw + _i * 8192), 16, 0, 0); } while (0)
#define PG8_LDA(dst, b, h) do { _Pragma("unroll") for (int m = 0; m < 4; ++m) _Pragma("unroll") for (int k = 0; k < 2; ++k) dst[m][k] = *(const PG8_LAS bf16x8*)(lds + PG8_SA(b, h) + aoff + m * 2048 + k * 1024); } while (0)
#define PG8_LDB(dst, b, h) do { _Pragma("unroll") for (int n = 0; n < 2; ++n) _Pragma("unroll") for (int k = 0; k < 2; ++k) dst[n][k] = *(const PG8_LAS bf16x8*)(lds + PG8_SB(b, h) + boff + n * 2048 + k * 1024); } while (0)
#define PG8_MMA(ai, bj, At, Bt) do { __builtin_amdgcn_s_setprio(1); _Pragma("unroll") for (int m = 0; m < 4; ++m) _Pragma("unroll") for (int n = 0; n < 2; ++n) _Pragma("unroll") for (int k = 0; k < 2; ++k) \
        acc[ai][bj][m][n] = __builtin_amdgcn_mfma_f32_16x16x32_bf16(Bt[n][k], At[m][k], acc[ai][bj][m][n], 0, 0, 0); __builtin_amdgcn_s_setprio(0); } while (0)
#define PG8_WAIT_V(n) asm volatile("s_waitcnt vmcnt(" #n ")" ::: "memory")
#define PG8_WAIT_L(n) asm volatile("s_waitcnt lgkmcnt(" #n ")" ::: "memory")
#define PG8_BAR __builtin_amdgcn_s_barrier()
#define PG8_SCHED __builtin_amdgcn_sched_barrier(0)
    Unit cur, nxt; int ui = 0;
    if (!S.next(0, cur)) return;
    f32x4 acc[2][2][4][2];
#pragma unroll
    for (int a = 0; a < 2; ++a)
#pragma unroll
        for (int b = 0; b < 2; ++b)
#pragma unroll
            for (int m = 0; m < 4; ++m)
#pragma unroll
                for (int n = 0; n < 2; ++n) acc[a][b][m][n] = (f32x4){0.f, 0.f, 0.f, 0.f};
    bf16x8 At[4][2], B0[2][2], B1[2][2];
    const char* cA = (const char*)g.A + (size_t)cur.pm * tstep; const char* cB = (const char*)g.Bt + (size_t)cur.pn * tstep;
    S.a_ready(cur);
    if constexpr (SP2) {
        PG8_STAGE(PG8_SB(0, 0), cB, voffB); PG8_STAGE(PG8_SB(0, 1), cB + hstep, voffB); PG8_STAGE(PG8_SA(0, 0), cA, voffA); PG8_STAGE(PG8_SA(0, 1), cA + hstep, voffA);
        if (wr == 1) PG8_BAR;
        PG8_WAIT_V(2); PG8_BAR;
        PG8_STAGE(PG8_SB(1, 0), cB + kstep, voffB); PG8_STAGE(PG8_SA(1, 0), cA + kstep, voffA); PG8_STAGE(PG8_SB(1, 1), cB + hstep + kstep, voffB);
        PG8_WAIT_V(6); PG8_BAR;
    } else {
        PG8_STAGE(PG8_SB(0, 0), cB, voffB); PG8_STAGE(PG8_SA(0, 0), cA, voffA); PG8_STAGE(PG8_SB(0, 1), cB + hstep, voffB); PG8_STAGE(PG8_SA(0, 1), cA + hstep, voffA);
        if (wr == 1) PG8_BAR;
        PG8_WAIT_V(4); PG8_BAR;
        PG8_STAGE(PG8_SB(1, 0), cB + kstep, voffB); PG8_STAGE(PG8_SA(1, 0), cA + kstep, voffA); PG8_STAGE(PG8_SB(1, 1), cB + hstep + kstep, voffB);
        PG8_WAIT_V(6); PG8_BAR;
    }
    for (;;) {
        const bool has_next = S.next(ui + 1, nxt);
        const char* nA = has_next ? (const char*)g.A + (size_t)nxt.pm * tstep : cA; const char* nB = has_next ? (const char*)g.Bt + (size_t)nxt.pn * tstep : cB;
        for (int t = 0; t < nt; t += 2) {
            const bool last = (t == nt - 2);
            if constexpr (Epi::HAS_MID) { if (t == nt / 2) E.mid(acc, cur, wr, wc, fr, fq, lds); }
            const char* a1 = cA + (size_t)(t + 1) * kstep;
            const char* a2 = last ? nA : cA + (size_t)(t + 2) * kstep; const char* b2 = last ? nB : cB + (size_t)(t + 2) * kstep;
            const char* a3 = a2 + kstep; const char* b3 = b2 + kstep;
            if (last && has_next) S.a_ready(nxt);
            if constexpr (SP2) {
            PG8_LDB(B0, 0, 0); PG8_LDB(B1, 0, 1); PG8_SCHED; PG8_LDA(At, 0, 0); PG8_STAGE(PG8_SA(1, 1), a1 + hstep, voffA);
            PG8_WAIT_V(8); PG8_WAIT_L(0); PG8_BAR; PG8_MMA(0, 0, At, B0); PG8_MMA(0, 1, At, B1); PG8_BAR; PG8_SCHED;
            PG8_LDA(At, 0, 1); PG8_STAGE(PG8_SB(0, 0), b2, voffB); PG8_STAGE(PG8_SB(0, 1), b2 + hstep, voffB); PG8_STAGE(PG8_SA(0, 0), a2, voffA);
            PG8_WAIT_V(8); PG8_WAIT_L(0); PG8_BAR; PG8_MMA(1, 0, At, B0); PG8_MMA(1, 1, At, B1); PG8_BAR; PG8_SCHED;
            PG8_LDB(B0, 1, 0); PG8_LDB(B1, 1, 1); PG8_SCHED; PG8_LDA(At, 1, 0); PG8_STAGE(PG8_SA(0, 1), a2 + hstep, voffA);
            PG8_WAIT_V(8); PG8_WAIT_L(0); PG8_BAR; PG8_MMA(0, 0, At, B0); PG8_MMA(0, 1, At, B1); PG8_BAR; PG8_SCHED;
            PG8_LDA(At, 1, 1); PG8_STAGE(PG8_SB(1, 0), b3, voffB); PG8_STAGE(PG8_SB(1, 1), b3 + hstep, voffB); PG8_STAGE(PG8_SA(1, 0), a3, voffA);
            PG8_WAIT_V(8); PG8_WAIT_L(0); PG8_BAR; PG8_MMA(1, 0, At, B0); PG8_MMA(1, 1, At, B1); PG8_BAR; PG8_SCHED;
            } else {
            PG8_LDB(B0, 0, 0); PG8_SCHED; PG8_LDA(At, 0, 0); PG8_STAGE(PG8_SA(1, 1), a1 + hstep, voffA);
            PG8_WAIT_L(8); PG8_BAR; PG8_WAIT_L(0); PG8_MMA(0, 0, At, B0); PG8_BAR; PG8_SCHED;
            PG8_LDB(B1, 0, 1); PG8_STAGE(PG8_SB(0, 0), b2, voffB);
            PG8_BAR; PG8_WAIT_L(0); PG8_MMA(0, 1, At, B1); PG8_BAR;
            PG8_LDA(At, 0, 1); PG8_STAGE(PG8_SA(0, 0), a2, voffA);
            PG8_BAR; PG8_WAIT_L(0); PG8_MMA(1, 0, At, B0); PG8_BAR; PG8_SCHED;
            PG8_STAGE(PG8_SB(0, 1), b2 + hstep, voffB);
            PG8_WAIT_V(6); PG8_BAR; PG8_MMA(1, 1, At, B1); PG8_BAR;
            PG8_LDB(B0, 1, 0); PG8_SCHED; PG8_LDA(At, 1, 0); PG8_STAGE(PG8_SA(0, 1), a2 + hstep, voffA);
            PG8_WAIT_L(8); PG8_BAR; PG8_WAIT_L(0); PG8_MMA(0, 0, At, B0); PG8_BAR; PG8_SCHED;
            PG8_LDB(B1, 1, 1); PG8_STAGE(PG8_SB(1, 0), b3, voffB);
            PG8_BAR; PG8_WAIT_L(0); PG8_MMA(0, 1, At, B1); PG8_BAR;
            PG8_LDA(At, 1, 1); PG8_STAGE(PG8_SA(1, 0), a3, voffA);
            PG8_BAR; PG8_WAIT_L(0); PG8_MMA(1, 0, At, B0); PG8_BAR; PG8_SCHED;
            PG8_STAGE(PG8_SB(1, 1), b3 + hstep, voffB);
            PG8_WAIT_V(6); PG8_BAR; PG8_MMA(1, 1, At, B1); PG8_BAR;
            }
        }
        if constexpr (ALIGN_EPI) { if (wr == 0) PG8_BAR; }
        if constexpr (!Epi::AFTER_DRAIN) { E(acc, cur, wr, wc, fr, fq); S.done(cur); }
        if (!has_next) break;
#pragma unroll
        for (int a = 0; a < 2; ++a)
#pragma unroll
            for (int b = 0; b < 2; ++b)
#pragma unroll
                for (int m = 0; m < 4; ++m)
#pragma unroll
                    for (int n = 0; n < 2; ++n) acc[a][b][m][n] = (f32x4){0.f, 0.f, 0.f, 0.f};
        cur = nxt; cA = nA; cB = nB; ++ui;
        if constexpr (ALIGN_EPI) { if (wr == 1) PG8_BAR; }
    }
    PG8_WAIT_V(0);
    if constexpr (!ALIGN_EPI) { if (wr == 0) PG8_BAR; }
    PG8_BAR;
    if constexpr (Epi::AFTER_DRAIN) { E.fused(acc, cur, wr, wc, fr, fq, lds, wid, lane); S.done(cur); }
#undef PG8_SA
#undef PG8_SB
#undef PG8_STAGE
#undef PG8_LDA
#undef PG8_LDB
#undef PG8_MMA
#undef PG8_WAIT_V
#undef PG8_WAIT_L
#undef PG8_BAR
#undef PG8_SCHED
}
}

namespace mk {
#define LAS __attribute__((address_space(3)))
typedef unsigned short bf16_t;
typedef short bf16x8 __attribute__((ext_vector_type(8)));
typedef float f32x4 __attribute__((ext_vector_type(4)));
typedef float f32x16 __attribute__((ext_vector_type(16)));
typedef unsigned u32x4 __attribute__((ext_vector_type(4)));
typedef unsigned u32x2 __attribute__((ext_vector_type(2)));
typedef __bf16 bf16x2_t __attribute__((ext_vector_type(2)));
typedef float f32x2_t __attribute__((ext_vector_type(2)));
typedef unsigned u32;

constexpr int DM = 1024, SEQ = 16384, NMETA = 16, MPAD = 16640, INW = 1280;
constexpr int O_K = 512, O_V = 640, O_U = 768;
constexpr int NCH = 513;
constexpr float EPS = 1e-6f;
constexpr float LOG2E = 1.4426950408889634f;
constexpr int NWAVES = 8, NTHR = 512;
constexpr int LDS_BYTES = 163840;
constexpr int MISC_OFF = LDS_BYTES - 128;

constexpr size_t MiB = 1u << 20;
constexpr size_t WS_CTL = 0, CTL_BYTES = 1 * MiB;
constexpr size_t WS_WIN_T = 1 * MiB;
constexpr size_t WS_WOUT_T = 4 * MiB;
constexpr size_t WS_WQ_T = 6 * MiB;
constexpr size_t WS_GLU_T = 10 * MiB;
constexpr size_t WS_SUBK = 10 * MiB + 512 * 1024;
constexpr size_t WS_KT = 11 * MiB;
constexpr size_t WS_F = 12 * MiB;
constexpr size_t WS_E = 16 * MiB;
constexpr size_t WS_ABART = 20 * MiB;
constexpr size_t WS_SLOC = 21 * MiB;
constexpr size_t WS_CARRY = 30 * MiB;
constexpr size_t WS_BUFA = 39 * MiB;
constexpr size_t WS_PROJ = 72 * MiB;
constexpr size_t WS_ATTN = 113 * MiB;
constexpr size_t WS_Z = 129 * MiB;
constexpr size_t WS_SSMO = 145 * MiB;
constexpr size_t WS_QP = 72 * MiB;
constexpr size_t WS_IDX = 161 * MiB;
constexpr size_t WS_GW = 169 * MiB;
constexpr size_t WS_PU = 177 * MiB;
constexpr size_t WS_PV = 193 * MiB;
constexpr size_t WS_SU = 209 * MiB;
constexpr size_t WS_SV = 209 * MiB + 65536;
constexpr size_t WS_HB = 210 * MiB;
constexpr size_t WS_SSA = 242 * MiB;
constexpr size_t WS_SSS = 242 * MiB + 512 * 1024;
constexpr size_t WS_SSH = 243 * MiB;
constexpr size_t WS_END = 245 * MiB;

struct Params { const float* in[25]; float* out; unsigned char* ws; int ph_lo, ph_hi; float one, zero; };
enum { I_X = 0, I_META, I_N1G, I_WIN, I_QNG, I_KNG, I_SINK, I_ARE, I_AIM, I_LDT, I_BRE, I_BIM, I_CRE, I_CIM, I_SD, I_GLUW, I_GLUB, I_AOG, I_SOG, I_WOUT, I_N2G, I_WQ, I_SUBK, I_PU, I_PV };

__device__ __forceinline__ unsigned pk2(float lo, float hi) { f32x2_t v = {lo, hi}; return __builtin_bit_cast(unsigned, __builtin_convertvector(v, bf16x2_t)); }
__device__ __forceinline__ float bflo(unsigned w) { return __uint_as_float(w << 16); }
__device__ __forceinline__ float bfhi(unsigned w) { return __uint_as_float(w & 0xffff0000u); }
__device__ __forceinline__ float wave_sum(float v) {
#pragma unroll
    for (int o = 1; o < 64; o <<= 1) v += __shfl_xor(v, o);
    return v;
}
#define LDS_WAIT() asm volatile("s_waitcnt lgkmcnt(0)" ::: "memory")
__device__ __forceinline__ float gelu_erf(float v) { return 0.5f * v * (1.0f + erff(v * 0.70710678118654752f)); }
__device__ __forceinline__ u32 f2ord(float f) { const u32 u = __float_as_uint(f); return (u & 0x80000000u) ? ~u : (u | 0x80000000u); }
__device__ __forceinline__ float ord2f(u32 o) { const u32 u = (o & 0x80000000u) ? (o & 0x7fffffffu) : ~o; return __uint_as_float(u); }
#define MFMA16(a, b, c) __builtin_amdgcn_mfma_f32_16x16x32_bf16((a), (b), (c), 0, 0, 0)
#define MFMA32(a, b, c) __builtin_amdgcn_mfma_f32_32x32x16_bf16((a), (b), (c), 0, 0, 0)

#define CEX(x, i, j) do { const u32 _a = x[i], _b = x[j]; x[i] = _a > _b ? _a : _b; x[j] = _a > _b ? _b : _a; } while (0)
__device__ __forceinline__ void sort16_desc(u32 (&x)[16]) {
#pragma unroll
    for (int k = 2; k <= 16; k <<= 1) {
#pragma unroll
        for (int j = k >> 1; j > 0; j >>= 1) {
#pragma unroll
            for (int i = 0; i < 16; ++i) { const int l = i ^ j; if (l > i) { if ((i & k) == 0) CEX(x, i, l); else CEX(x, l, i); } }
        }
    }
}
__device__ __forceinline__ void bmerge16_desc(u32 (&x)[16]) {
#pragma unroll
    for (int j = 8; j > 0; j >>= 1) {
#pragma unroll
        for (int i = 0; i < 16; ++i) { const int l = i ^ j; if (l > i) CEX(x, i, l); }
    }
}
__device__ __forceinline__ void merge_top16(u32 (&a)[16], const u32 (&b)[16]) {
#pragma unroll
    for (int i = 0; i < 16; ++i) a[i] = a[i] > b[15 - i] ? a[i] : b[15 - i];
    bmerge16_desc(a);
}
__device__ __forceinline__ void top16_of_64(u32 (&g0)[16], u32 (&g1)[16], u32 (&g2)[16], u32 (&g3)[16]) {
    sort16_desc(g0); sort16_desc(g1); sort16_desc(g2); sort16_desc(g3);
    merge_top16(g0, g1); merge_top16(g2, g3); merge_top16(g0, g2);
}
__device__ const unsigned char CAND_AB[64] = {0, 1, 2, 3, 4, 5, 6, 7, 8, 9, 10, 11, 12, 13, 14, 15, 16, 17, 18, 19, 20, 21, 22, 23, 32, 33, 34, 35, 36, 48, 49, 50, 51, 64, 65, 66, 80, 81, 96, 97, 112, 113, 128, 144, 160, 176, 192, 208, 224, 240, 0, 0, 0, 0, 0, 0, 0, 0, 0, 0, 0, 0, 0, 0};

struct Ctx { LAS unsigned char* lds; int tid, lane, wave, G, bid; };

__device__ __forceinline__ void transpose_item(const float* W, int K, int N, bf16_t* WT, LAS float* scr, int item, int lane, const float* ks0 = nullptr, const float* ks1 = nullptr, int ksplit = 0) {
    const int nblk = N / 32, kb = item / nblk, nb = item % nblk, k0 = 64 * kb, n0 = 32 * nb;
#pragma unroll 8
    for (int i = 0; i < 32; ++i) { const int kk = 2 * i + (lane >> 5); float w = W[(size_t)(k0 + kk) * N + n0 + (lane & 31)];
        if (ks0) { const int k = k0 + kk; w *= (ksplit && k >= ksplit) ? ks1[k - ksplit] : ks0[k]; }
        scr[kk * 33 + (lane & 31)] = w; }
    LDS_WAIT();
    const int c = lane & 7;
#pragma unroll
    for (int j = 0; j < 4; ++j) { const int n = (lane >> 3) + 8 * j; const LAS float* s = scr + (8 * c) * 33 + n;
        u32x4 o; o.x = pk2(s[0 * 33], s[1 * 33]); o.y = pk2(s[2 * 33], s[3 * 33]); o.z = pk2(s[4 * 33], s[5 * 33]); o.w = pk2(s[6 * 33], s[7 * 33]);
        *(u32x4*)(WT + (size_t)(n0 + n) * K + k0 + 8 * c) = o; }
    LDS_WAIT();
}

__device__ __forceinline__ void ssm_tables(const Ctx& C, const Params& P, int g) {
    LAS float* pwr = (LAS float*)C.lds;
    LAS float* pwi = pwr + 33 * 64;
    LAS float* bbr = pwi + 33 * 64;
    LAS float* bbi = bbr + 1024;
    LAS float* ccr = bbi + 1024;
    LAS float* cci = ccr + 1024;
    LAS float* cfr = cci + 1024;
    LAS float* cfi = cfr + 64;
    const int tid = C.tid;
    const float dt = expf(P.in[I_LDT][g]);
    for (int e = tid; e < 33 * 64; e += NTHR) {
        const int l = e >> 6, n = e & 63;
        const float lr = P.in[I_ARE][g * 64 + n], li = P.in[I_AIM][g * 64 + n];
        const float x = lr * dt * (float)l, th = li * dt * (float)l, mag = expf(x);
        float s, c; sincosf(th, &s, &c);
        pwr[e] = mag * c; pwi[e] = mag * s;
        if (l == 32) { float* abt = (float*)(P.ws + WS_ABART) + (g * 64 + n) * 2; abt[0] = mag * c; abt[1] = mag * s; }
    }
    if (tid < 64) {
        const int n = tid;
        const float lr = P.in[I_ARE][g * 64 + n], li = P.in[I_AIM][g * 64 + n];
        const float x1 = lr * dt, th1 = li * dt, em1 = expm1f(x1);
        float s1, c1; sincosf(th1, &s1, &c1);
        const float sh = sinf(0.5f * th1);
        const float nr = em1 * c1 - 2.0f * sh * sh, ni = (em1 + 1.0f) * s1;
        const float den = lr * lr + li * li;
        cfr[n] = (nr * lr + ni * li) / den; cfi[n] = (ni * lr - nr * li) / den;
    }
    __syncthreads();
    for (int e = tid; e < 1024; e += NTHR) {
        const int n = e >> 4;
        const float br = P.in[I_BRE][g * 1024 + e], bi = P.in[I_BIM][g * 1024 + e];
        bbr[e] = cfr[n] * br - cfi[n] * bi; bbi[e] = cfr[n] * bi + cfi[n] * br;
        ccr[e] = P.in[I_CRE][g * 1024 + e]; cci[e] = P.in[I_CIM][g * 1024 + e];
    }
    __syncthreads();
    bf16_t* Kt = (bf16_t*)(P.ws + WS_KT) + (size_t)g * 8448;
    {
        const int pq = tid & 255, p = pq >> 4, q = pq & 15, l0 = (tid >> 8) * 16;
        float cbr[64], cbi[64];
#pragma unroll
        for (int n = 0; n < 64; ++n) { const float cr = ccr[p * 64 + n], ci = cci[p * 64 + n], br = bbr[n * 16 + q], bi = bbi[n * 16 + q]; cbr[n] = cr * br - ci * bi; cbi[n] = cr * bi + ci * br; }
#pragma unroll 1
        for (int lg = l0; lg < l0 + 16; ++lg) {
            float val = 0.f;
#pragma unroll
            for (int n = 0; n < 64; n += 4) {
                const f32x4 ar = *(const LAS f32x4*)(pwr + lg * 64 + n), ai = *(const LAS f32x4*)(pwi + lg * 64 + n);
                val += cbr[n] * ar.x - cbi[n] * ai.x; val += cbr[n + 1] * ar.y - cbi[n + 1] * ai.y; val += cbr[n + 2] * ar.z - cbi[n + 2] * ai.z; val += cbr[n + 3] * ar.w - cbi[n + 3] * ai.w;
            }
            Kt[(lg + 1) * 256 + pq] = (bf16_t)(pk2(val, 0.f) & 0xffffu);
        }
        if (tid < 256) Kt[tid] = 0;
    }
    bf16_t* F = (bf16_t*)(P.ws + WS_F) + (size_t)g * 65536;
    for (int e8 = tid; e8 < 8192; e8 += NTHR) {
        const int n2 = e8 >> 6, k0 = (e8 & 63) * 8, j = k0 >> 4, q0 = k0 & 15, n = n2 & 63, l = 31 - j;
        const float ar = pwr[l * 64 + n], ai = pwi[l * 64 + n];
        float w[8];
#pragma unroll
        for (int i = 0; i < 8; ++i) { const float br = bbr[n * 16 + q0 + i], bi = bbi[n * 16 + q0 + i]; w[i] = (n2 < 64) ? (ar * br - ai * bi) : (ar * bi + ai * br); }
        u32x4 o; o.x = pk2(w[0], w[1]); o.y = pk2(w[2], w[3]); o.z = pk2(w[4], w[5]); o.w = pk2(w[6], w[7]);
        *(u32x4*)(F + (size_t)e8 * 8) = o;
    }
    bf16_t* E = (bf16_t*)(P.ws + WS_E) + (size_t)g * 65536;
    for (int e8 = tid; e8 < 8192; e8 += NTHR) {
        const int row = e8 >> 4, n20 = (e8 & 15) * 8, t = row >> 4, p = row & 15, n0 = n20 & 63;
        float w[8];
#pragma unroll
        for (int i = 0; i < 8; ++i) { const int n = n0 + i; const float pr = pwr[(t + 1) * 64 + n], pi = pwi[(t + 1) * 64 + n], cr = ccr[p * 64 + n], ci = cci[p * 64 + n];
            w[i] = (n20 < 64) ? (cr * pr - ci * pi) : -(cr * pi + ci * pr); }
        u32x4 o; o.x = pk2(w[0], w[1]); o.y = pk2(w[2], w[3]); o.z = pk2(w[4], w[5]); o.w = pk2(w[6], w[7]);
        *(u32x4*)(E + (size_t)e8 * 8) = o;
    }
    __syncthreads();
}

__device__ __forceinline__ void norm_row_to_bf16(const float* src, const float* gam, bf16_t* dst, int lane) {
    const f32x4* xr = (const f32x4*)src + lane; const f32x4* gr = (const f32x4*)gam + lane;
    f32x4 v[4]; float s = 0.f;
#pragma unroll
    for (int j = 0; j < 4; ++j) { v[j] = xr[64 * j]; s += (v[j].x * v[j].x + v[j].y * v[j].y) + (v[j].z * v[j].z + v[j].w * v[j].w); }
    const float rinv = 1.0f / sqrtf(wave_sum(s) * (1.0f / DM) + EPS);
    u32x2* o = (u32x2*)dst + lane;
#pragma unroll
    for (int j = 0; j < 4; ++j) { const f32x4 g = gr[64 * j]; u32x2 w; w.x = pk2(v[j].x * rinv * g.x, v[j].y * rinv * g.y); w.y = pk2(v[j].z * rinv * g.z, v[j].w * rinv * g.w); o[64 * j] = w; }
}

__device__ __forceinline__ void cvt8(const float* src, bf16_t* dst, size_t i) {
    const f32x4 a = ((const f32x4*)src)[2 * i], b = ((const f32x4*)src)[2 * i + 1];
    u32x4 o; o.x = pk2(a.x, a.y); o.y = pk2(a.z, a.w); o.z = pk2(b.x, b.y); o.w = pk2(b.z, b.w);
    ((u32x4*)dst)[i] = o;
}

__device__ __forceinline__ float wave_max(float m) {
    m = fmaxf(m, __builtin_bit_cast(float, __builtin_amdgcn_update_dpp(0, __builtin_bit_cast(int, m), 0xB1, 0xf, 0xf, true)));
    m = fmaxf(m, __builtin_bit_cast(float, __builtin_amdgcn_update_dpp(0, __builtin_bit_cast(int, m), 0x4E, 0xf, 0xf, true)));
    m = fmaxf(m, __builtin_bit_cast(float, __builtin_amdgcn_update_dpp(0, __builtin_bit_cast(int, m), 0x141, 0xf, 0xf, true)));
    m = fmaxf(m, __builtin_bit_cast(float, __builtin_amdgcn_update_dpp(0, __builtin_bit_cast(int, m), 0x140, 0xf, 0xf, true)));
    u32 x = __builtin_bit_cast(u32, m);
    { u32 b = x; asm volatile("" : "+v"(b)); const auto p = __builtin_amdgcn_permlane16_swap(x, b, false, false); x = p[0] > p[1] ? p[0] : p[1]; }
    { u32 b = x; asm volatile("" : "+v"(b)); const auto p = __builtin_amdgcn_permlane32_swap(x, b, false, false); x = p[0] > p[1] ? p[0] : p[1]; }
    m = __builtin_bit_cast(float, x);
    return m;
}
template <int NR> __device__ __forceinline__ void quant_rows(const Params& P, const int (&rr)[NR], int lane) {
    f32x4 v[NR][4]; float m[NR];
#pragma unroll
    for (int i = 0; i < NR; ++i) {
        const bool isv = rr[i] >= 16384; const int row = isv ? rr[i] - 16384 : rr[i];
        const f32x4* src = (const f32x4*)((isv ? P.in[I_PV] : P.in[I_PU]) + (size_t)row * DM) + lane;
#pragma unroll
        for (int j = 0; j < 4; ++j) v[i][j] = __builtin_nontemporal_load(src + 64 * j);
    }
#pragma unroll
    for (int i = 0; i < NR; ++i) {
        float mm = 0.f;
#pragma unroll
        for (int j = 0; j < 4; ++j) mm = fmaxf(mm, fmaxf(fmaxf(fabsf(v[i][j].x), fabsf(v[i][j].y)), fmaxf(fabsf(v[i][j].z), fabsf(v[i][j].w))));
        m[i] = wave_max(mm);
    }
#pragma unroll
    for (int i = 0; i < NR; ++i) {
        const bool isv = rr[i] >= 16384; const int row = isv ? rr[i] - 16384 : rr[i];
        const float top = isv ? 416.0f : 127.0f;
        const float sc = (m[i] > 0.f) ? m[i] / top : 1.0f, inv = (m[i] > 0.f) ? top / m[i] : 0.f;
        u32x4 w;
#pragma unroll
        for (int j = 0; j < 4; ++j) {
            if (isv) {
                int t = __builtin_amdgcn_cvt_pk_fp8_f32(v[i][j].x * inv, v[i][j].y * inv, 0, false);
                t = __builtin_amdgcn_cvt_pk_fp8_f32(v[i][j].z * inv, v[i][j].w * inv, t, true);
                w[j] = (u32)t;
            } else {
                const int q0 = (int)rintf(v[i][j].x * inv), q1 = (int)rintf(v[i][j].y * inv), q2 = (int)rintf(v[i][j].z * inv), q3 = (int)rintf(v[i][j].w * inv);
                w[j] = (u32)(q0 & 255) | ((u32)(q1 & 255) << 8) | ((u32)(q2 & 255) << 16) | ((u32)(q3 & 255) << 24);
            }
        }
        *(u32x4*)(P.ws + (isv ? WS_PV : WS_PU) + (size_t)row * 1024 + 16 * lane) = w;
        if (lane == 0) ((float*)(P.ws + (isv ? WS_SV : WS_SU)))[row] = sc;
    }
}
template <int NR> __device__ __forceinline__ void xn_rows(const Params& P, const int (&mm)[NR], int lane) {
    bf16_t* xn = (bf16_t*)(P.ws + WS_BUFA);
    f32x4 v[NR][4]; f32x4 g[4];
#pragma unroll
    for (int j = 0; j < 4; ++j) g[j] = ((const f32x4*)P.in[I_N1G])[64 * j + lane];
#pragma unroll
    for (int i = 0; i < NR; ++i) {
        const int m = mm[i];
        const float* src = (m < SEQ) ? P.in[I_X] + (size_t)m * DM : P.in[I_META] + (size_t)((m < SEQ + NMETA) ? (m - SEQ) : 0) * DM;
#pragma unroll
        for (int j = 0; j < 4; ++j) v[i][j] = ((const f32x4*)src)[64 * j + lane];
    }
#pragma unroll
    for (int i = 0; i < NR; ++i) {
        const int m = mm[i];
        float ss = 0.f;
#pragma unroll
        for (int j = 0; j < 4; ++j) ss += (v[i][j].x * v[i][j].x + v[i][j].y * v[i][j].y) + (v[i][j].z * v[i][j].z + v[i][j].w * v[i][j].w);
        float rinv = 1.0f / sqrtf(wave_sum(ss) * (1.0f / DM) + EPS);
        if (m >= SEQ + NMETA) rinv = 0.f;
        u32x2* o = (u32x2*)(xn + (size_t)m * DM) + lane;
#pragma unroll
        for (int j = 0; j < 4; ++j) { u32x2 w; w.x = pk2(v[i][j].x * rinv * g[j].x, v[i][j].y * rinv * g[j].y); w.y = pk2(v[i][j].z * rinv * g[j].z, v[i][j].w * rinv * g[j].w); o[64 * j] = w; }
    }
}
__device__ __forceinline__ void phase_prologue(const Ctx& C, const Params& P) {
    LAS float* scr = (LAS float*)(C.lds + C.wave * 16384);
    const int gw = C.bid * NWAVES + C.wave, NGW = C.G * NWAVES;
    for (int it = gw; it < 16 * 40; it += NGW) transpose_item(P.in[I_WIN], 1024, 1280, (bf16_t*)(P.ws + WS_WIN_T), scr, it, C.lane);
    for (int m = gw; m < MPAD; m += 4 * NGW) {
        if (m + 3 * NGW < MPAD) { const int mm[4] = {m, m + NGW, m + 2 * NGW, m + 3 * NGW}; xn_rows<4>(P, mm, C.lane); }
        else { for (int q = m; q < MPAD; q += NGW) { const int mm[1] = {q}; xn_rows<1>(P, mm, C.lane); } }
    }
}
__device__ __forceinline__ void deferred_a(const Ctx& C, const Params& P, int ib, int nib) {
    __syncthreads();
    const int nssm = (nib >= 64) ? 32 : 0;
    if (nssm) { if (ib < 32) { ssm_tables(C, P, ib); return; } }
    else { for (int g = ib; g < 32; g += nib) ssm_tables(C, P, g); }
    __syncthreads();
    LAS float* scr = (LAS float*)(C.lds + C.wave * 16384);
    const int gw = (ib - nssm) * NWAVES + C.wave, NGW = (nib - nssm) * NWAVES;
    for (int it = gw; it < 8 * 16; it += NGW) transpose_item(P.in[I_GLUW], 512, 512, (bf16_t*)(P.ws + WS_GLU_T), scr, it, C.lane);
    for (int r = gw; r < 2 * 16384; r += 4 * NGW) {
        if (r + 3 * NGW < 2 * 16384) { const int rr[4] = {r, r + NGW, r + 2 * NGW, r + 3 * NGW}; quant_rows<4>(P, rr, C.lane); }
        else { for (int q = r; q < 2 * 16384; q += NGW) { const int rr[1] = {q}; quant_rows<1>(P, rr, C.lane); } }
    }
    const size_t gt = (size_t)(ib - nssm) * NTHR + C.tid, NT = (size_t)(nib - nssm) * NTHR;
    for (size_t i = gt; i < 262144 / 8; i += NT) cvt8(P.in[I_SUBK], (bf16_t*)(P.ws + WS_SUBK), i);
}
__device__ __forceinline__ void deferred_b(const Ctx& C, const Params& P, int ib, int nib) {
    __syncthreads();
    LAS float* scr = (LAS float*)(C.lds + C.wave * 16384);
    const int gw = ib * NWAVES + C.wave, NGW = nib * NWAVES;
    constexpr int I_OUT = 16 * 32, I_Q = 16 * 64;
    for (int it = gw; it < I_OUT + I_Q; it += NGW) {
        if (it < I_OUT) transpose_item(P.in[I_WOUT], 1024, 1024, (bf16_t*)(P.ws + WS_WOUT_T), scr, it, C.lane, P.in[I_AOG], P.in[I_SOG], 512);
        else transpose_item(P.in[I_WQ], 1024, 2048, (bf16_t*)(P.ws + WS_WQ_T), scr, it - I_OUT, C.lane, P.in[I_N2G]);
    }
}

__device__ __forceinline__ bf16x8 u_frag(const bf16_t* proj, int ci, int j, int g, int half) {
    const bool ok = (ci == 0) ? (j >= 16) : (ci < NCH);
    int row = (ci == 0) ? (SEQ + j - 16) : ((ci - 1) * 32 + j);
    row = ok ? row : 0;
    const u32x4 w = *(const u32x4*)(proj + (size_t)row * INW + O_U + g * 16 + half * 8);
    u32x4 z; z.x = ok ? w.x : 0u; z.y = ok ? w.y : 0u; z.z = ok ? w.z : 0u; z.w = ok ? w.w : 0u;
    return __builtin_bit_cast(bf16x8, z);
}

constexpr int F_PITCH = 1040;
__device__ __forceinline__ void phase_sloc(const Ctx& C, const Params& P) {
    const bf16_t* proj = (const bf16_t*)(P.ws + WS_PROJ);
    float* SL = (float*)(P.ws + WS_SLOC);
    const int n = C.lane & 15, kq = C.lane >> 4;
    for (int bu = C.bid; bu < 160; bu += C.G) {
        const int g = bu / 5, qtr = bu % 5, s = qtr * 8 + C.wave, ci = 16 * s + n;
        bf16x8 Bf[16];
#pragma unroll
        for (int ks = 0; ks < 16; ++ks) Bf[ks] = u_frag(proj, (s < 33) ? ci : NCH, 2 * ks + (kq >> 1), g, kq & 1);
        __syncthreads();
        { const u32x4* src = (const u32x4*)((const bf16_t*)(P.ws + WS_F) + (size_t)g * 65536);
          u32x4 t[16];
#pragma unroll
          for (int i = 0; i < 16; ++i) t[i] = src[C.tid + NTHR * i];
#pragma unroll
          for (int i = 0; i < 16; ++i) { const int e = C.tid + NTHR * i; *(LAS u32x4*)(C.lds + (e >> 6) * F_PITCH + (e & 63) * 16) = t[i]; } }
        __syncthreads();
        if (s < 33) {
#pragma unroll 1
            for (int mt = 0; mt < 8; ++mt) {
                f32x4 acc = {0.f, 0.f, 0.f, 0.f};
#pragma unroll
                for (int ks = 0; ks < 16; ++ks) {
                    const bf16x8 A = *(const LAS bf16x8*)(C.lds + (mt * 16 + n) * F_PITCH + (32 * ks + 8 * kq) * 2);
                    acc = MFMA16(A, Bf[ks], acc);
                }
                if (ci < NCH) *(f32x4*)(SL + ((size_t)ci * 32 + g) * 128 + mt * 16 + 4 * kq) = acc;
            }
        }
    }
}

__device__ __forceinline__ void carry_scan_block(const Ctx& C, const Params& P, int bk) {
    const float* SL = (const float*)(P.ws + WS_SLOC);
    float* CA = (float*)(P.ws + WS_CARRY);
    LAS float* Lr = (LAS float*)C.lds;
    LAS float* Li = Lr + 512;
    const int chan = bk * 32 + (C.tid & 31), g = chan >> 6, n = chan & 63, sg = C.tid >> 5;
    const float* abt = (const float*)(P.ws + WS_ABART) + (g * 64 + n) * 2;
    const float ar = abt[0], ai = abt[1];
    float sr = 0.f, si = 0.f;
#pragma unroll 8
    for (int i = 0; i < 32; ++i) {
        const int ci = 32 * sg + i; const size_t o = ((size_t)ci * 32 + g) * 128 + n;
        const float br = SL[o], bi = SL[o + 64];
        const float tr = ar * sr - ai * si + br, ti = ar * si + ai * sr + bi; sr = tr; si = ti;
    }
    Lr[sg * 32 + (C.tid & 31)] = sr; Li[sg * 32 + (C.tid & 31)] = si;
    float pr = ar, pi = ai;
#pragma unroll
    for (int k = 0; k < 5; ++k) { const float tr = pr * pr - pi * pi, ti = 2.f * pr * pi; pr = tr; pi = ti; }
    __syncthreads();
    float cr = 0.f, ci_ = 0.f;
    for (int s2 = 0; s2 < sg; ++s2) { const float lr = Lr[s2 * 32 + (C.tid & 31)], li = Li[s2 * 32 + (C.tid & 31)];
        const float tr = pr * cr - pi * ci_ + lr, ti = pr * ci_ + pi * cr + li; cr = tr; ci_ = ti; }
    sr = cr; si = ci_;
#pragma unroll 8
    for (int i = 0; i < 32; ++i) {
        const int ci = 32 * sg + i; const size_t o = ((size_t)ci * 32 + g) * 128 + n;
        CA[o] = sr; CA[o + 64] = si;
        const float br = SL[o], bi = SL[o + 64];
        const float tr = ar * sr - ai * si + br, ti = ar * si + ai * sr + bi; sr = tr; si = ti;
    }
    if (sg == 15) { const size_t o = ((size_t)512 * 32 + g) * 128 + n; CA[o] = sr; CA[o + 64] = si; }
    __syncthreads();
}

constexpr int E_OFF = 16896, E_PITCH = 272;
__device__ __forceinline__ void phase_ssm_y(const Ctx& C, const Params& P) {
    const bf16_t* proj = (const bf16_t*)(P.ws + WS_PROJ);
    const float* CA = (const float*)(P.ws + WS_CARRY);
    bf16_t* Z = (bf16_t*)(P.ws + WS_Z);
    const int n = C.lane & 15, kq = C.lane >> 4;
    for (int bu = C.bid; bu < 256; bu += C.G) {
        const int g = bu >> 3, cq = bu & 7;
        __syncthreads();
        { const u32x4* src = (const u32x4*)((const bf16_t*)(P.ws + WS_KT) + (size_t)g * 8448); LAS u32x4* dst = (LAS u32x4*)C.lds;
          for (int e = C.tid; e < 1056; e += NTHR) dst[e] = src[e];
          const u32x4* esrc = (const u32x4*)((const bf16_t*)(P.ws + WS_E) + (size_t)g * 65536);
          u32x4 t[16];
#pragma unroll
          for (int i = 0; i < 16; ++i) t[i] = esrc[C.tid + NTHR * i];
#pragma unroll
          for (int i = 0; i < 16; ++i) { const int e = C.tid + NTHR * i; *(LAS u32x4*)(C.lds + E_OFF + (e >> 4) * E_PITCH + (e & 15) * 16) = t[i]; } }
        __syncthreads();
        const int ci = 1 + 64 * cq + 16 * (C.wave >> 1) + n, par = C.wave & 1;
        bf16x8 Uf[16], Cf[4];
#pragma unroll
        for (int ks = 0; ks < 16; ++ks) Uf[ks] = u_frag(proj, ci, 2 * ks + (kq >> 1), g, kq & 1);
#pragma unroll
        for (int k2 = 0; k2 < 4; ++k2) {
            const float* cp = CA + ((size_t)ci * 32 + g) * 128 + 32 * k2 + 8 * kq;
            const f32x4 a = *(const f32x4*)cp, b = *(const f32x4*)(cp + 4);
            u32x4 w; w.x = pk2(a.x, a.y); w.y = pk2(a.z, a.w); w.z = pk2(b.x, b.y); w.w = pk2(b.z, b.w);
            Cf[k2] = __builtin_bit_cast(bf16x8, w);
        }
        const f32x4 dv = *(const f32x4*)(P.in[I_SD] + g * 16 + 4 * kq);
#pragma unroll 1
        for (int tt = 0; tt < 16; ++tt) {
            const int t = 2 * tt + par;
            f32x4 acc = {0.f, 0.f, 0.f, 0.f};
#pragma unroll
            for (int k2 = 0; k2 < 4; ++k2) {
                const bf16x8 A = *(const LAS bf16x8*)(C.lds + E_OFF + (t * 16 + n) * E_PITCH + (32 * k2 + 8 * kq) * 2);
                acc = MFMA16(A, Cf[k2], acc);
            }
#pragma unroll
            for (int ks = 0; ks < 16; ++ks) {
                if (ks <= tt) {
                    const int li = t - 2 * ks - (kq >> 1) + 1;
                    const bf16x8 A = *(const LAS bf16x8*)(C.lds + ((li * 16 + n) * 16 + 8 * (kq & 1)) * 2);
                    acc = MFMA16(A, Uf[ks], acc);
                }
            }
            const int row = (ci - 1) * 32 + t, ch = g * 16 + 4 * kq;
            const u32x2 uw = *(const u32x2*)(proj + (size_t)row * INW + O_U + ch);
            const float y0 = acc.x + dv.x * bflo(uw.x), y1 = acc.y + dv.y * bfhi(uw.x), y2 = acc.z + dv.z * bflo(uw.y), y3 = acc.w + dv.w * bfhi(uw.y);
            u32x2 o; o.x = pk2(gelu_erf(y0), gelu_erf(y1)); o.y = pk2(gelu_erf(y2), gelu_erf(y3));
            *(u32x2*)(Z + (size_t)row * 512 + ch) = o;
        }
    }
}

constexpr int VT_PITCH = 296;
__device__ __forceinline__ void attn_unit(const Ctx& C, const Params& P, int b, int hk) {
    const bf16_t* proj = (const bf16_t*)(P.ws + WS_PROJ);
    bf16_t* AO = (bf16_t*)(P.ws + WS_BUFA);
    float* SSA = (float*)(P.ws + WS_SSA);
    LAS unsigned char* Ks = C.lds;
    LAS bf16_t* Vt = (LAS bf16_t*)(C.lds + 288 * 128);
    __syncthreads();
    for (int e = C.tid; e < 288 * 8; e += NTHR) {
        const int key = e >> 3, ch = e & 7;
        int row = -1;
        if (key < 256) { const int j = (b - 1) * 128 + key; if (j >= 0) row = j; } else if (key < 272) row = SEQ + key - 256;
        u32x4 kw = {0u, 0u, 0u, 0u}, vw = {0u, 0u, 0u, 0u};
        if (row >= 0) { kw = *(const u32x4*)(proj + (size_t)row * INW + O_K + hk * 64 + ch * 8); vw = *(const u32x4*)(proj + (size_t)row * INW + O_V + hk * 64 + ch * 8); }
        float kf[8] = {bflo(kw.x), bfhi(kw.x), bflo(kw.y), bfhi(kw.y), bflo(kw.z), bfhi(kw.z), bflo(kw.w), bfhi(kw.w)};
        float ss = 0.f;
#pragma unroll
        for (int i = 0; i < 8; ++i) ss += kf[i] * kf[i];
        ss += __shfl_xor(ss, 1); ss += __shfl_xor(ss, 2); ss += __shfl_xor(ss, 4);
        const float rinv = 1.0f / sqrtf(ss * (1.0f / 64.0f) + EPS);
        const f32x4 g0 = *(const f32x4*)(P.in[I_KNG] + ch * 8), g1 = *(const f32x4*)(P.in[I_KNG] + ch * 8 + 4);
        u32x4 o; o.x = pk2(kf[0] * rinv * g0.x, kf[1] * rinv * g0.y); o.y = pk2(kf[2] * rinv * g0.z, kf[3] * rinv * g0.w);
        o.z = pk2(kf[4] * rinv * g1.x, kf[5] * rinv * g1.y); o.w = pk2(kf[6] * rinv * g1.z, kf[7] * rinv * g1.w);
        *(LAS u32x4*)(Ks + key * 128 + ((ch ^ (key & 7)) * 16)) = o;
        const unsigned vv[4] = {vw.x, vw.y, vw.z, vw.w};
#pragma unroll
        for (int i = 0; i < 4; ++i) { Vt[(ch * 8 + 2 * i) * VT_PITCH + key] = (bf16_t)(vv[i] & 0xffffu); Vt[(ch * 8 + 2 * i + 1) * VT_PITCH + key] = (bf16_t)(vv[i] >> 16); }
    }
    __syncthreads();
    const int c = C.lane & 31, h = C.lane >> 5;
#pragma unroll 1
    for (int ti = C.wave; ti < 16; ti += NWAVES) {
        const int hql = ti >> 2, wq = ti & 3, hq = hk * 4 + hql;
        const int qi = wq * 32 + c, tok = b * 128 + qi;
        bf16x8 qf[4];
        {
            u32x4 qw[4]; float ss = 0.f;
#pragma unroll
            for (int ks = 0; ks < 4; ++ks) { qw[ks] = *(const u32x4*)(proj + (size_t)tok * INW + hq * 64 + 16 * ks + 8 * h);
                const unsigned w[4] = {qw[ks].x, qw[ks].y, qw[ks].z, qw[ks].w};
#pragma unroll
                for (int i = 0; i < 4; ++i) { const float a = bflo(w[i]), bb = bfhi(w[i]); ss += a * a + bb * bb; } }
            ss += __shfl_xor(ss, 32);
            const float rinv = (1.0f / sqrtf(ss * (1.0f / 64.0f) + EPS)) * (0.125f * LOG2E);
#pragma unroll
            for (int ks = 0; ks < 4; ++ks) {
                const f32x4 g0 = *(const f32x4*)(P.in[I_QNG] + 16 * ks + 8 * h), g1 = *(const f32x4*)(P.in[I_QNG] + 16 * ks + 8 * h + 4);
                u32x4 o; o.x = pk2(bflo(qw[ks].x) * rinv * g0.x, bfhi(qw[ks].x) * rinv * g0.y); o.y = pk2(bflo(qw[ks].y) * rinv * g0.z, bfhi(qw[ks].y) * rinv * g0.w);
                o.z = pk2(bflo(qw[ks].z) * rinv * g1.x, bfhi(qw[ks].z) * rinv * g1.y); o.w = pk2(bflo(qw[ks].w) * rinv * g1.z, bfhi(qw[ks].w) * rinv * g1.w);
                qf[ks] = __builtin_bit_cast(bf16x8, o);
            }
        }
        f32x16 S[6];
#pragma unroll
        for (int rb = 0; rb < 6; ++rb) {
            const int kb = (rb < 5) ? (wq + rb) : 8;
            const int key = kb * 32 + c;
            f32x16 acc = {0.f, 0.f, 0.f, 0.f, 0.f, 0.f, 0.f, 0.f, 0.f, 0.f, 0.f, 0.f, 0.f, 0.f, 0.f, 0.f};
#pragma unroll
            for (int ks = 0; ks < 4; ++ks) {
                const bf16x8 A = *(const LAS bf16x8*)(Ks + key * 128 + (((2 * ks + h) ^ (key & 7)) * 16));
                acc = MFMA32(A, qf[ks], acc);
            }
            S[rb] = acc;
            __builtin_amdgcn_sched_barrier(0);
        }
        const float sl = P.in[I_SINK][hq] * LOG2E;
        float mx = sl;
#pragma unroll
        for (int r = 0; r < 16; ++r) {
            const int kr = (r & 3) + 8 * (r >> 2) + 4 * h;
            const bool gt = kr > c;
            S[0][r] = gt ? S[0][r] : -1e30f;
            S[4][r] = gt ? -1e30f : S[4][r];
            if (r >= 8) S[5][r] = -1e30f;
        }
        if (b == 0) {
#pragma unroll
            for (int rb = 0; rb < 4; ++rb) if (wq + rb < 4) {
#pragma unroll
                for (int r = 0; r < 16; ++r) S[rb][r] = -1e30f;
            }
        }
#pragma unroll
        for (int rb = 0; rb < 6; ++rb)
#pragma unroll
            for (int r = 0; r < 16; ++r) mx = fmaxf(mx, S[rb][r]);
        mx = fmaxf(mx, __shfl_xor(mx, 32));
        float lsum = 0.f;
#pragma unroll
        for (int rb = 0; rb < 6; ++rb)
#pragma unroll
            for (int r = 0; r < 16; ++r) { const float p = exp2f(S[rb][r] - mx); S[rb][r] = p; lsum += p; }
        lsum += __shfl_xor(lsum, 32);
        lsum += exp2f(sl - mx);
        const float linv = 1.0f / lsum;
        f32x16 O[2];
#pragma unroll
        for (int db = 0; db < 2; ++db) O[db] = (f32x16){0.f, 0.f, 0.f, 0.f, 0.f, 0.f, 0.f, 0.f, 0.f, 0.f, 0.f, 0.f, 0.f, 0.f, 0.f, 0.f};
#pragma unroll
        for (int rb = 0; rb < 6; ++rb) {
            const int kb = (rb < 5) ? (wq + rb) : 8;
#pragma unroll
            for (int s = 0; s < 2; ++s) {
                if (rb == 5 && s == 1) continue;
                u32x4 pw; pw.x = pk2(S[rb][8 * s + 0], S[rb][8 * s + 1]); pw.y = pk2(S[rb][8 * s + 2], S[rb][8 * s + 3]);
                pw.z = pk2(S[rb][8 * s + 4], S[rb][8 * s + 5]); pw.w = pk2(S[rb][8 * s + 6], S[rb][8 * s + 7]);
                const bf16x8 Pf = __builtin_bit_cast(bf16x8, pw);
#pragma unroll
                for (int db = 0; db < 2; ++db) {
                    const LAS bf16_t* vp = Vt + (db * 32 + c) * VT_PITCH + kb * 32 + 16 * s + 4 * h;
                    const u32x2 lo = *(const LAS u32x2*)vp, hi2 = *(const LAS u32x2*)(vp + 8);
                    u32x4 vw; vw.x = lo.x; vw.y = lo.y; vw.z = hi2.x; vw.w = hi2.y;
                    O[db] = MFMA32(__builtin_bit_cast(bf16x8, vw), Pf, O[db]);
                }
                __builtin_amdgcn_sched_barrier(0);
            }
        }
        float ssq = 0.f;
#pragma unroll
        for (int db = 0; db < 2; ++db)
#pragma unroll
            for (int gq = 0; gq < 4; ++gq) {
                const float o0 = O[db][4 * gq] * linv, o1 = O[db][4 * gq + 1] * linv, o2 = O[db][4 * gq + 2] * linv, o3 = O[db][4 * gq + 3] * linv;
                ssq += (o0 * o0 + o1 * o1) + (o2 * o2 + o3 * o3);
                u32x2 o; o.x = pk2(o0, o1); o.y = pk2(o2, o3);
                *(u32x2*)(AO + (size_t)tok * 1024 + hq * 64 + db * 32 + 8 * gq + 4 * h) = o;
            }
        ssq += __shfl_xor(ssq, 32);
        if (h == 0) SSA[(size_t)tok * 8 + hq] = ssq;
    }
}

struct EpiGlu {
    static constexpr bool PERM = true, AFTER_DRAIN = false, HAS_MID = false;
    const bf16_t* Z; bf16_t* O; const float* bias; float* SSS;
    __device__ __forceinline__ void operator()(const pg8::f32x4 (&acc)[2][2][4][2], const pg8::Unit& u, int wr, int wc, int fr, int fq) const {
        const int row0 = u.pm * 256 + wr * 64 + fr, col0 = u.pn * 256 + wc * 32 + 8 * fq;
        f32x4 bb[2][2];
#pragma unroll
        for (int bj = 0; bj < 2; ++bj) { bb[bj][0] = *(const f32x4*)(bias + col0 + bj * 128); bb[bj][1] = *(const f32x4*)(bias + col0 + bj * 128 + 4); }
#pragma unroll
        for (int ai = 0; ai < 2; ++ai) {
            u32x4 zw[4][2];
#pragma unroll
            for (int m = 0; m < 4; ++m)
#pragma unroll
                for (int bj = 0; bj < 2; ++bj) zw[m][bj] = *(const u32x4*)(Z + (size_t)(row0 + ai * 128 + m * 16) * 512 + col0 + bj * 128);
#pragma unroll
            for (int m = 0; m < 4; ++m) {
                const int row = row0 + ai * 128 + m * 16; float ssq = 0.f;
#pragma unroll
                for (int bj = 0; bj < 2; ++bj) {
                    const f32x4 b0 = bb[bj][0], b1 = bb[bj][1]; const u32x4 z4 = zw[m][bj];
                    const pg8::f32x4 v0 = acc[ai][bj][m][0], v1 = acc[ai][bj][m][1];
                    const float zf[8] = {bflo(z4.x), bfhi(z4.x), bflo(z4.y), bfhi(z4.y), bflo(z4.z), bfhi(z4.z), bflo(z4.w), bfhi(z4.w)};
                    const float pre[8] = {v0[0] + b0.x, v0[1] + b0.y, v0[2] + b0.z, v0[3] + b0.w, v1[0] + b1.x, v1[1] + b1.y, v1[2] + b1.z, v1[3] + b1.w};
                    float r[8];
#pragma unroll
                    for (int i = 0; i < 8; ++i) { r[i] = zf[i] / (1.0f + __expf(-pre[i])); ssq += r[i] * r[i]; }
                    u32x4 o; o.x = pk2(r[0], r[1]); o.y = pk2(r[2], r[3]); o.z = pk2(r[4], r[5]); o.w = pk2(r[6], r[7]);
                    *(u32x4*)(O + (size_t)row * 1024 + 512 + col0 + bj * 128) = o;
                }
                ssq += __shfl_xor(ssq, 16); ssq += __shfl_xor(ssq, 32);
                if (fq == 0) SSS[(size_t)row * 8 + u.pn * 4 + wc] = ssq;
            }
        }
    }
};
constexpr int FAC_OFF = 131072;
struct EpiMix {
    static constexpr bool PERM = true, AFTER_DRAIN = false, HAS_MID = true;
    const float* X; bf16_t* HB; float* SSH;
    __device__ __forceinline__ void mid(pg8::f32x4 (&acc)[2][2][4][2], const pg8::Unit& u, int wr, int wc, int fr, int fq, LAS unsigned char* lds) const {
#pragma unroll
        for (int ai = 0; ai < 2; ++ai)
#pragma unroll
            for (int m = 0; m < 4; ++m) {
                const float f = ((const LAS float*)(lds + FAC_OFF))[2 * (ai * 128 + wr * 64 + m * 16 + fr)];
#pragma unroll
                for (int bj = 0; bj < 2; ++bj)
#pragma unroll
                    for (int n = 0; n < 2; ++n) acc[ai][bj][m][n] *= f;
            }
    }
    __device__ __forceinline__ void operator()(const pg8::f32x4 (&acc)[2][2][4][2], const pg8::Unit& u, int wr, int wc, int fr, int fq) const {
        extern __shared__ __attribute__((aligned(16))) unsigned char lds_raw_[];
        const LAS float* fac = (const LAS float*)((LAS unsigned char*)lds_raw_ + FAC_OFF);
        const int col0 = u.pn * 256 + wc * 32 + 8 * fq;
#pragma unroll
        for (int ai = 0; ai < 2; ++ai) {
            f32x4 xv[4][2][2];
#pragma unroll
            for (int m = 0; m < 4; ++m)
#pragma unroll
                for (int bj = 0; bj < 2; ++bj) { const size_t off = (size_t)(u.pm * 256 + ai * 128 + wr * 64 + m * 16 + fr) * 1024 + col0 + bj * 128;
                    xv[m][bj][0] = *(const f32x4*)(X + off); xv[m][bj][1] = *(const f32x4*)(X + off + 4); }
#pragma unroll
            for (int m = 0; m < 4; ++m) {
                const int rl = ai * 128 + wr * 64 + m * 16 + fr, row = u.pm * 256 + rl;
                const float rs = fac[2 * rl + 1]; float ssq = 0.f;
#pragma unroll
                for (int bj = 0; bj < 2; ++bj) {
                    const size_t off = (size_t)row * 1024 + col0 + bj * 128;
                    const f32x4 x0 = xv[m][bj][0], x1 = xv[m][bj][1];
                    const pg8::f32x4 v0 = acc[ai][bj][m][0], v1 = acc[ai][bj][m][1];
                    const float hv[8] = {x0.x + rs * v0[0], x0.y + rs * v0[1], x0.z + rs * v0[2], x0.w + rs * v0[3], x1.x + rs * v1[0], x1.y + rs * v1[1], x1.z + rs * v1[2], x1.w + rs * v1[3]};
#pragma unroll
                    for (int i = 0; i < 8; ++i) ssq += hv[i] * hv[i];
                    u32x4 o; o.x = pk2(hv[0], hv[1]); o.y = pk2(hv[2], hv[3]); o.z = pk2(hv[4], hv[5]); o.w = pk2(hv[6], hv[7]);
                    *(u32x4*)(HB + off) = o;
                }
                ssq += __shfl_xor(ssq, 16); ssq += __shfl_xor(ssq, 32);
                if (fq == 0) SSH[(size_t)row * 16 + u.pn * 4 + wc] = ssq;
            }
        }
    }
};
struct EpiQ {
    static constexpr bool PERM = true, AFTER_DRAIN = false, HAS_MID = false;
    bf16_t* O; const float* SSH;
    __device__ __forceinline__ void operator()(const pg8::f32x4 (&acc)[2][2][4][2], const pg8::Unit& u, int wr, int wc, int fr, int fq) const {
        const int col0 = u.pn * 256 + wc * 32 + 8 * fq;
        float ri[2][4];
#pragma unroll
        for (int ai = 0; ai < 2; ++ai)
#pragma unroll
            for (int m = 0; m < 4; ++m) {
                const int row = u.pm * 256 + ai * 128 + wr * 64 + m * 16 + fr;
                const f32x4* sp = (const f32x4*)(SSH + (size_t)row * 16);
                const f32x4 s0 = sp[0], s1 = sp[1], s2 = sp[2], s3 = sp[3];
                const float ss = ((s0.x + s0.y) + (s0.z + s0.w)) + ((s1.x + s1.y) + (s1.z + s1.w)) + ((s2.x + s2.y) + (s2.z + s2.w)) + ((s3.x + s3.y) + (s3.z + s3.w));
                ri[ai][m] = 1.0f / sqrtf(ss * (1.0f / 1024.0f) + EPS);
            }
#pragma unroll
        for (int ai = 0; ai < 2; ++ai)
#pragma unroll
            for (int m = 0; m < 4; ++m) {
                const int row = u.pm * 256 + ai * 128 + wr * 64 + m * 16 + fr; const float r = ri[ai][m];
#pragma unroll
                for (int bj = 0; bj < 2; ++bj) {
                    const pg8::f32x4 v0 = acc[ai][bj][m][0], v1 = acc[ai][bj][m][1];
                    u32x4 o; o.x = pk2(v0[0] * r, v0[1] * r); o.y = pk2(v0[2] * r, v0[3] * r); o.z = pk2(v1[0] * r, v1[1] * r); o.w = pk2(v1[2] * r, v1[3] * r);
                    *(u32x4*)(O + (size_t)row * 2048 + col0 + bj * 128) = o;
                }
            }
    }
};

__device__ __forceinline__ void peer_topk_tile(const Ctx& C, const Params& P, int tok0) {
    const bf16_t* QP = (const bf16_t*)(P.ws + WS_QP);
    const bf16_t* SK = (const bf16_t*)(P.ws + WS_SUBK);
    int* IDX = (int*)(P.ws + WS_IDX); float* GW = (float*)(P.ws + WS_GW);
    LAS u32* lists = (LAS u32*)C.lds;
    const int c = C.lane & 31, h = C.lane >> 5;
    __syncthreads();
#pragma unroll 1
    for (int hs = C.wave; hs < 16; hs += NWAVES) {
        bf16x8 qf[2][8];
#pragma unroll
        for (int tg = 0; tg < 2; ++tg) { const bf16_t* qrow = QP + (size_t)(tok0 + tg * 32 + c) * 2048 + hs * 128;
#pragma unroll
            for (int ks = 0; ks < 8; ++ks) qf[tg][ks] = *(const bf16x8*)(qrow + 16 * ks + 8 * h); }
        u32 best[2][16];
#pragma unroll 1
        for (int kb = 0; kb < 4; ++kb) {
            bf16x8 kf[8];
            const bf16_t* krow = SK + (size_t)(hs * 128 + kb * 32 + c) * 128;
#pragma unroll
            for (int ks = 0; ks < 8; ++ks) kf[ks] = *(const bf16x8*)(krow + 16 * ks + 8 * h);
            f32x16 acc0 = {0.f, 0.f, 0.f, 0.f, 0.f, 0.f, 0.f, 0.f, 0.f, 0.f, 0.f, 0.f, 0.f, 0.f, 0.f, 0.f}, acc1 = acc0;
#pragma unroll
            for (int ks = 0; ks < 8; ++ks) { acc0 = MFMA32(kf[ks], qf[0][ks], acc0); acc1 = MFMA32(kf[ks], qf[1][ks], acc1); }
            u32 g0[16], g1[16];
#pragma unroll
            for (int r = 0; r < 16; ++r) { const u32 kx = (u32)(127 - (kb * 32 + (r & 3) + 8 * (r >> 2) + 4 * h));
                g0[r] = (f2ord(acc0[r]) & ~0x7Fu) | kx; g1[r] = (f2ord(acc1[r]) & ~0x7Fu) | kx; }
            sort16_desc(g0); sort16_desc(g1);
            if (kb == 0) {
#pragma unroll
                for (int i = 0; i < 16; ++i) { best[0][i] = g0[i]; best[1][i] = g1[i]; }
            } else { merge_top16(best[0], g0); merge_top16(best[1], g1); }
        }
#pragma unroll
        for (int tg = 0; tg < 2; ++tg) {
            u32 pb[16];
#pragma unroll
            for (int i = 0; i < 16; ++i) pb[i] = (u32)__shfl_xor((int)best[tg][i], 32);
            merge_top16(best[tg], pb);
            if (h == 0) {
                LAS u32x4* dst = (LAS u32x4*)(lists + (tg * 32 + c) * 260 + hs * 16);
#pragma unroll
                for (int i = 0; i < 4; ++i) { u32x4 w; w.x = best[tg][4 * i]; w.y = best[tg][4 * i + 1]; w.z = best[tg][4 * i + 2]; w.w = best[tg][4 * i + 3]; dst[i] = w; }
            }
        }
    }
    __syncthreads();
    {
        const int tl = C.tid & 63, hd = C.tid >> 6;
        const LAS u32* L1 = lists + tl * 260 + hd * 32; const LAS u32* L2 = L1 + 16;
        float v1[16], v2[16];
#pragma unroll
        for (int i = 0; i < 16; ++i) { v1[i] = ord2f(L1[i] & ~0x7Fu); v2[i] = ord2f(L2[i] & ~0x7Fu); }
        u32 cd[4][16];
        { int cid = 0;
#pragma unroll
          for (int a = 0; a < 16; ++a)
#pragma unroll
              for (int b = 0; b < 16; ++b) if ((a + 1) * (b + 1) <= 16) { cd[cid >> 4][cid & 15] = (f2ord(v1[a] + v2[b]) & ~0x3Fu) | (u32)(63 - cid); ++cid; }
#pragma unroll
          for (int k = 50; k < 64; ++k) cd[k >> 4][k & 15] = 0u; }
        top16_of_64(cd[0], cd[1], cd[2], cd[3]);
        float sc[16]; int ix[16]; float mx = -1e30f;
#pragma unroll
        for (int k = 0; k < 16; ++k) {
            const int cid = 63 - (int)(cd[0][k] & 63u); const int ab = CAND_AB[cid];
            const u32 k1 = L1[ab >> 4], k2 = L2[ab & 15];
            sc[k] = ord2f(k1 & ~0x7Fu) + ord2f(k2 & ~0x7Fu);
            ix[k] = (127 - (int)(k1 & 0x7Fu)) * 128 + (127 - (int)(k2 & 0x7Fu));
            mx = fmaxf(mx, sc[k]);
        }
        float sum = 0.f;
#pragma unroll
        for (int k = 0; k < 16; ++k) { sc[k] = __expf(sc[k] - mx); sum += sc[k]; }
        const float inv = 1.0f / sum;
        int* io = IDX + (size_t)(tok0 + tl) * 128 + hd * 16; float* go = GW + (size_t)(tok0 + tl) * 128 + hd * 16;
#pragma unroll
        for (int k = 0; k < 16; k += 4) {
            *(int4*)(io + k) = make_int4(ix[k], ix[k + 1], ix[k + 2], ix[k + 3]);
            f32x4 gv = {sc[k] * inv, sc[k + 1] * inv, sc[k + 2] * inv, sc[k + 3] * inv}; *(f32x4*)(go + k) = gv;
        }
    }
    __syncthreads();
}

__device__ __forceinline__ int reduce64(int (&r)[64], int lane) {
#pragma unroll
    for (int e = 0; e < 32; ++e) { const auto p = __builtin_amdgcn_permlane32_swap((u32)r[e], (u32)r[e + 32], false, false); r[e] = (int)p[0] + (int)p[1]; }
#pragma unroll
    for (int e = 0; e < 16; ++e) { const auto p = __builtin_amdgcn_permlane16_swap((u32)r[e], (u32)r[e + 16], false, false); r[e] = (int)p[0] + (int)p[1]; }
    const bool b3 = (lane & 8) != 0, b2 = (lane & 4) != 0, b1 = (lane & 2) != 0, b0 = (lane & 1) != 0;
#pragma unroll
    for (int e = 0; e < 8; ++e) { const int keep = b3 ? r[e + 8] : r[e], send = b3 ? r[e] : r[e + 8]; r[e] = keep + __builtin_amdgcn_update_dpp(0, send, 0x128, 0xf, 0xf, true); }
#pragma unroll
    for (int e = 0; e < 4; ++e) { const int keep = b2 ? r[e + 4] : r[e], send = b2 ? r[e] : r[e + 4];
        int t = __builtin_amdgcn_update_dpp(0, send, 0x104, 0xf, 0x5, false);
        t = __builtin_amdgcn_update_dpp(t, send, 0x114, 0xf, 0xA, false);
        r[e] = keep + t; }
#pragma unroll
    for (int e = 0; e < 2; ++e) { const int keep = b1 ? r[e + 2] : r[e], send = b1 ? r[e] : r[e + 2]; r[e] = keep + __builtin_amdgcn_update_dpp(0, send, 0x4E, 0xf, 0xf, true); }
    { const int keep = b0 ? r[1] : r[0], send = b0 ? r[0] : r[1]; r[0] = keep + __builtin_amdgcn_update_dpp(0, send, 0xB1, 0xf, 0xf, true); }
    return r[0];
}
constexpr int GQ_LDS_PER_WAVE = 8192;
#define GQ_FMA16(A, ce, w) do { _Pragma("unroll") for (int j_ = 0; j_ < 4; ++j_) { \
        const f32x2_t lo_ = __builtin_amdgcn_cvt_pk_f32_fp8((int)(w)[j_], false), hi_ = __builtin_amdgcn_cvt_pk_f32_fp8((int)(w)[j_], true); \
        A[4 * j_ + 0] += (ce) * lo_.x; A[4 * j_ + 1] += (ce) * lo_.y; A[4 * j_ + 2] += (ce) * hi_.x; A[4 * j_ + 3] += (ce) * hi_.y; } } while (0)
__device__ __forceinline__ void peer_gather_quad(const Ctx& C, const Params& P, int tokq, float osc) {
    const bf16_t* HN = (const bf16_t*)(P.ws + WS_HB); const float* SSH = (const float*)(P.ws + WS_SSH);
    const unsigned char* PU = P.ws + WS_PU; const unsigned char* PV = P.ws + WS_PV;
    const float* SU = (const float*)(P.ws + WS_SU); const float* SV = (const float*)(P.ws + WS_SV);
    const int* IDX = (const int*)(P.ws + WS_IDX); const float* GW = (const float*)(P.ws + WS_GW);
    const int lane = C.lane;
    LAS unsigned char* qhl = C.lds + C.wave * GQ_LDS_PER_WAVE;
    LAS u32* keyl = (LAS u32*)(qhl + 4096);
    u32 k[8];
#pragma unroll
    for (int s = 0; s < 4; ++s)
#pragma unroll
        for (int hb = 0; hb < 2; ++hb) k[2 * s + hb] = ((u32)IDX[(size_t)(tokq + s) * 128 + 64 * hb + lane] << 9) | (u32)(s << 7) | (u32)(64 * hb + lane);
#pragma unroll
    for (int size = 2; size <= 512; size <<= 1) {
#pragma unroll
        for (int j = size >> 1; j > 0; j >>= 1) {
            u32 nk[8];
#pragma unroll
            for (int r = 0; r < 8; ++r) {
                const int ii = lane + 64 * r;
                const bool asc = (ii & size) == 0, lower = (ii & j) == 0;
                const u32 mine = k[r], other = (j >= 64) ? k[r ^ (j >> 6)] : (u32)__shfl_xor((int)k[r], j);
                const u32 mn = mine < other ? mine : other, mx = mine < other ? other : mine;
                nk[r] = (lower == asc) ? mn : mx;
            }
#pragma unroll
            for (int r = 0; r < 8; ++r) k[r] = nk[r];
        }
    }
#pragma unroll
    for (int r = 0; r < 8; ++r) keyl[64 * r + lane] = k[r];
    float shs[4];
    f32x4 g2v[4];
#pragma unroll
    for (int j = 0; j < 4; ++j) g2v[j] = *(const f32x4*)(P.in[I_N2G] + 256 * j + 4 * lane);
#pragma unroll
    for (int s = 0; s < 4; ++s) {
        float hf[16]; float m = 0.f;
        const float ssp = (lane < 16) ? SSH[(size_t)(tokq + s) * 16 + lane] : 0.f;
#pragma unroll
        for (int j = 0; j < 4; ++j) { const u32x2 w = *(const u32x2*)(HN + (size_t)(tokq + s) * DM + 256 * j + 4 * lane);
            hf[4 * j] = bflo(w.x) * g2v[j].x; hf[4 * j + 1] = bfhi(w.x) * g2v[j].y; hf[4 * j + 2] = bflo(w.y) * g2v[j].z; hf[4 * j + 3] = bfhi(w.y) * g2v[j].w; }
        const float rinv_t = 1.0f / sqrtf(wave_sum(ssp) * (1.0f / 1024.0f) + EPS);
#pragma unroll
        for (int d = 0; d < 16; ++d) m = fmaxf(m, fabsf(hf[d]));
#pragma unroll
        for (int o = 1; o < 64; o <<= 1) m = fmaxf(m, __shfl_xor(m, o));
        shs[s] = ((m > 0.f) ? m * (1.0f / 127.0f) : 1.0f) * rinv_t; const float inv = (m > 0.f) ? 127.0f / m : 0.f;
        u32x4 q;
#pragma unroll
        for (int j = 0; j < 4; ++j) {
            const int q0 = (int)rintf(hf[4 * j] * inv), q1 = (int)rintf(hf[4 * j + 1] * inv), q2 = (int)rintf(hf[4 * j + 2] * inv), q3 = (int)rintf(hf[4 * j + 3] * inv);
            q[j] = (u32)(q0 & 255) | ((u32)(q1 & 255) << 8) | ((u32)(q2 & 255) << 16) | ((u32)(q3 & 255) << 24);
        }
        *(LAS u32x4*)(qhl + s * 1024 + 16 * lane) = q;
    }
    LDS_WAIT();
    LAS float* cvl = (LAS float*)(qhl + 6144);
    float cs0 = 0.f, cs1 = 0.f, cs2 = 0.f, cs3 = 0.f;
#pragma unroll 1
    for (int c = 0; c < 8; ++c) {
        const u32 kk = keyl[64 * c + lane];
        const int e_l = (int)(kk >> 9), slot_l = (int)((kk >> 7) & 3u), pos_l = (int)(kk & 127u);
        const float g_l = GW[(size_t)(tokq + slot_l) * 128 + pos_l], su_l = SU[e_l], sv_l = SV[e_l];
        int r[64];
#pragma unroll
        for (int p = 0; p < 64; ++p) {
            const u32 kp = (u32)__builtin_amdgcn_readlane((int)kk, p);
            const u32x4 w = *(const u32x4*)(PU + (size_t)(kp >> 9) * 1024 + 16 * lane);
            const u32x4 hq = *(const LAS u32x4*)(qhl + ((kp >> 7) & 3u) * 1024 + 16 * lane);
            int a = __builtin_amdgcn_sdot4((int)w.x, (int)hq.x, 0, false);
            a = __builtin_amdgcn_sdot4((int)w.y, (int)hq.y, a, false);
            a = __builtin_amdgcn_sdot4((int)w.z, (int)hq.z, a, false);
            a = __builtin_amdgcn_sdot4((int)w.w, (int)hq.w, a, false);
            r[p] = a;
        }
        const int isum = reduce64(r, lane);
        const float sh_l = (slot_l == 0) ? shs[0] : (slot_l == 1) ? shs[1] : (slot_l == 2) ? shs[2] : shs[3];
        const float z = (float)isum * su_l * sh_l;
        const float c_l = gelu_erf(z) * g_l * sv_l;
        cs0 += (slot_l == 0) ? c_l : 0.f; cs1 += (slot_l == 1) ? c_l : 0.f; cs2 += (slot_l == 2) ? c_l : 0.f; cs3 += (slot_l == 3) ? c_l : 0.f;
        cvl[64 * c + lane] = c_l;
    }
    LDS_WAIT();
    float acc0[16], acc1[16], acc2[16], acc3[16];
#pragma unroll
    for (int d = 0; d < 16; ++d) { acc0[d] = 0.f; acc1[d] = 0.f; acc2[d] = 0.f; acc3[d] = 0.f; }
#define GQ_ISSUE(W, KP, CE, kreg, creg, p0) do { _Pragma("unroll") for (int q = 0; q < 8; ++q) { \
        KP[q] = (u32)__builtin_amdgcn_readlane((int)(kreg), (p0) + q); CE[q] = __uint_as_float((u32)__builtin_amdgcn_readlane((int)__float_as_uint(creg), (p0) + q)); \
        W[q] = *(const u32x4*)(PV + (size_t)(KP[q] >> 9) * 1024 + 16 * lane); } } while (0)
#define GQ_CONSUME(W, KP, CE) do { _Pragma("unroll") for (int q = 0; q < 8; ++q) { const u32 sl = (KP[q] >> 7) & 3u; \
        if (sl == 0u) GQ_FMA16(acc0, CE[q], W[q]); else if (sl == 1u) GQ_FMA16(acc1, CE[q], W[q]); else if (sl == 2u) GQ_FMA16(acc2, CE[q], W[q]); else GQ_FMA16(acc3, CE[q], W[q]); } } while (0)
    {
        u32x4 wA[8], wB[8]; u32 kA[8], kB[8]; float cA[8], cB[8];
        u32 kk = keyl[lane]; float cc = cvl[lane];
        GQ_ISSUE(wA, kA, cA, kk, cc, 0);
#pragma unroll 1
        for (int c = 0; c < 8; ++c) {
            const int cn = (c < 7) ? c + 1 : 7;
            const u32 kkn = keyl[64 * cn + lane]; const float ccn = cvl[64 * cn + lane];
#pragma unroll 1
            for (int p0 = 0; p0 < 64; p0 += 16) {
                GQ_ISSUE(wB, kB, cB, kk, cc, p0 + 8);
                GQ_CONSUME(wA, kA, cA);
                if (p0 < 48) GQ_ISSUE(wA, kA, cA, kk, cc, p0 + 16); else GQ_ISSUE(wA, kA, cA, kkn, ccn, 0);
                GQ_CONSUME(wB, kB, cB);
            }
            kk = kkn; cc = ccn;
        }
    }
#undef GQ_ISSUE
#undef GQ_CONSUME
    const float corr0 = 0.f, corr1 = 0.f, corr2 = 0.f, corr3 = 0.f; (void)cs0; (void)cs1; (void)cs2; (void)cs3;
    u32x2 hw[4][4];
#pragma unroll
    for (int s = 0; s < 4; ++s)
#pragma unroll
        for (int j = 0; j < 4; ++j) hw[s][j] = *(const u32x2*)(HN + (size_t)(tokq + s) * DM + 256 * j + 4 * lane);
#define GQ_OUT(s, A, corr) do { float* orow = P.out + (size_t)(tokq + (s)) * DM; _Pragma("unroll") for (int j = 0; j < 4; ++j) { f32x4* p = (f32x4*)(orow + 256 * j + 4 * lane); \
        f32x4 v; v.x = bflo(hw[s][j].x) + osc * (A[4 * j] - corr); v.y = bfhi(hw[s][j].x) + osc * (A[4 * j + 1] - corr); v.z = bflo(hw[s][j].y) + osc * (A[4 * j + 2] - corr); v.w = bfhi(hw[s][j].y) + osc * (A[4 * j + 3] - corr); *p = v; } } while (0)
    GQ_OUT(0, acc0, corr0); GQ_OUT(1, acc1, corr1); GQ_OUT(2, acc2, corr2); GQ_OUT(3, acc3, corr3);
#undef GQ_OUT
}
__device__ __forceinline__ void peer_gather_tile(const Ctx& C, const Params& P, int tok0, float osc = 1.0f) {
    __syncthreads();
#pragma unroll 1
    for (int hq = 0; hq < 2; ++hq) peer_gather_quad(C, P, tok0 + 32 * hq + 4 * C.wave, osc);
}

#define GAS __attribute__((address_space(1)))
typedef GAS unsigned gu32;
#define RLX_AGENT __ATOMIC_RELAXED, __HIP_MEMORY_SCOPE_AGENT
#define XB_TMO      128
#define XB_XCNT(j)  (256  + 64 * (j))
#define XB_XSUB(j)  (1280 + 64 * (j))
#define XB_XGEN(j)  (2304 + 64 * (j))
#define XB_TOP      3328
#define XB_TOPGEN   3392
#define XCD_BAR_WORDS 3456
#define XB_SPIN_CAP (1u << 18)

__device__ __forceinline__ unsigned xb_ld(unsigned* p)              { return __hip_atomic_load(p, __ATOMIC_RELAXED, __HIP_MEMORY_SCOPE_AGENT); }
__device__ __forceinline__ unsigned xb_add(unsigned* p, unsigned v) { return __hip_atomic_fetch_add(p, v, __ATOMIC_RELAXED, __HIP_MEMORY_SCOPE_AGENT); }
__device__ __forceinline__ unsigned xb_xcc_id() { return (unsigned)__builtin_amdgcn_s_getreg((3 << 11) | 20) & 0xFu; }
#define XB_SPIN(cond, bar) do { unsigned _sp = 0; while (cond) { __builtin_amdgcn_s_sleep(1); \
    if ((++_sp & 255u) == 0u) { if (xb_ld(&(bar)[XB_TMO])) break; if (_sp > XB_SPIN_CAP) { atomicAdd(&(bar)[XB_TMO], 1u); break; } } } } while (0)

struct XcdBarrier {
    unsigned* bar; unsigned x;
    volatile LAS unsigned* st;
};

__device__ __forceinline__ XcdBarrier xcd_barrier_post(unsigned* bar, volatile LAS unsigned* st) {
    XcdBarrier b; b.bar = bar; b.x = xb_xcc_id(); b.st = st;
    if (threadIdx.x == 0) (void)xb_add(&bar[XB_XCNT(b.x)], 1u);
    return b;
}
__device__ __forceinline__ void xcd_barrier_complete(unsigned* bar, unsigned x, unsigned& nloc, unsigned& nx) {
    const unsigned G = gridDim.x * gridDim.y * gridDim.z;
    unsigned sum, cnt, mine, sp = 0u;
    for (;;) {
        sum = 0u; cnt = 0u; mine = 0u;
#pragma unroll
        for (unsigned j = 0; j < 16; ++j) { const unsigned c = xb_ld(&bar[XB_XCNT(j)]); sum += c; cnt += (c > 0u) ? 1u : 0u; mine = (j == x) ? c : mine; }
        if (sum == G) break;
        __builtin_amdgcn_s_sleep(1);
        if ((++sp & 255u) == 0u) { if (xb_ld(&bar[XB_TMO])) break; if (sp > XB_SPIN_CAP) { atomicAdd(&bar[XB_TMO], 1u); break; } }
    }
    nloc = mine > 0u ? mine : 1u; nx = cnt > 0u ? cnt : 1u;
}

__device__ __forceinline__ void xcd_barrier(const XcdBarrier& b) {
    asm volatile("s_waitcnt vmcnt(0)" ::: "memory");
    __syncthreads();
    if (threadIdx.x == 0) {
        unsigned* bar = b.bar;
        __builtin_amdgcn_s_waitcnt(0);
        unsigned nloc = b.st[0], nx = b.st[1];
        if (nloc == 0u) { xcd_barrier_complete(bar, b.x, nloc, nx); b.st[0] = nloc; b.st[1] = nx; }
        const unsigned old = xb_add(&bar[XB_XSUB(b.x)], 1u);
        const unsigned gen = old / nloc;
        if (old + 1u == (gen + 1u) * nloc) {
            __builtin_amdgcn_fence(__ATOMIC_RELEASE, "agent");
            asm volatile("s_waitcnt vmcnt(0)" ::: "memory");
            const unsigned og = xb_add(&bar[XB_TOP], 1u);
            const unsigned tg = og / nx;
            if (og + 1u == (tg + 1u) * nx) xb_add(&bar[XB_TOPGEN], 1u);
            else XB_SPIN(xb_ld(&bar[XB_TOPGEN]) == tg, bar);
            __builtin_amdgcn_fence(__ATOMIC_ACQUIRE, "agent");
            xb_add(&bar[XB_XGEN(b.x)], 1u);
            asm volatile("s_waitcnt vmcnt(0)" ::: "memory");
        } else {
            XB_SPIN(xb_ld(&bar[XB_XGEN(b.x)]) == gen, bar);
            __builtin_amdgcn_fence(__ATOMIC_ACQUIRE, "agent");
            asm volatile("s_waitcnt vmcnt(0)" ::: "memory");
        }
    }
    __syncthreads();
}

constexpr int NPHASE = 9;
__global__ void __launch_bounds__(NTHR, 2) mk_fwd(Params P) {
    extern __shared__ __attribute__((aligned(16))) unsigned char lds_raw[];
    Ctx C; C.lds = (LAS unsigned char*)lds_raw; C.tid = threadIdx.x; C.lane = C.tid & 63; C.wave = __builtin_amdgcn_readfirstlane(C.tid >> 6); C.G = gridDim.x; C.bid = blockIdx.x;
    unsigned char* ws = P.ws;
    volatile LAS unsigned* MISC = (volatile LAS unsigned*)(C.lds + MISC_OFF);
    if (C.tid < 32) MISC[C.tid] = 0u;
    __syncthreads();
    XcdBarrier bar = xcd_barrier_post((unsigned*)(ws + WS_CTL) + 4096, MISC + 8);
#define SEAM(k) do { if (IN(k) && IN((k) + 1)) xcd_barrier(bar); FRESH(); } while (0)
#define FRESH() do { int t_ = (int)threadIdx.x; asm volatile("" : "+v"(t_)); C.tid = t_; C.lane = t_ & 63; } while (0)
#ifndef REPMASK
#define REPMASK 0
#endif
#define NREP(k) (((REPMASK >> (k)) & 1) ? 2 : 1)
#ifdef ONLY_PHASE
#define IN(k) ((k) == ONLY_PHASE && P.ph_lo <= (k) && (k) < P.ph_hi)
#else
#define IN(k) (P.ph_lo <= (k) && (k) < P.ph_hi)
#endif
    for (int rep_ = 0; rep_ < NREP(0); ++rep_) { if (rep_) xcd_barrier(bar); if (IN(0)) phase_prologue(C, P); }
    SEAM(0);
    for (int rep_ = 0; rep_ < NREP(1); ++rep_) { if (rep_) xcd_barrier(bar);
    if (IN(1)) {
        pg8::Gemm g{(const bf16_t*)(ws + WS_BUFA), (const bf16_t*)(ws + WS_WIN_T), MPAD, INW, DM}; pg8::StaticOrder S; S.init(MPAD, INW, C.G, C.bid);
        pg8::EpiBf16<0> E{(bf16_t*)(ws + WS_PROJ), INW, nullptr, 0, 0, 1.f};
        pg8::gemm_phase<pg8::EpiBf16<0>, pg8::StaticOrder, true, true>(C.lds, g, S, E);
        { const int ntile = (MPAD / 256) * (INW / 256), nbusy = ntile % C.G;
          if (ntile > C.G && nbusy > 0) { if (C.bid >= nbusy) deferred_a(C, P, C.bid - nbusy, C.G - nbusy); }
          else deferred_a(C, P, C.bid, C.G); }
    }
    }
    SEAM(1);
#ifdef EXTRA_BARS
    for (int xb_ = 0; xb_ < EXTRA_BARS; ++xb_) xcd_barrier(bar);
#endif
    for (int rep_ = 0; rep_ < NREP(2); ++rep_) { if (rep_) xcd_barrier(bar); if (IN(2)) phase_sloc(C, P); }
    SEAM(2);
    for (int rep_ = 0; rep_ < NREP(3); ++rep_) { if (rep_) xcd_barrier(bar);
    if (IN(3)) {
        for (int bk = C.bid; bk < 64; bk += C.G) carry_scan_block(C, P, bk);
        for (int u = C.bid; u < 256; u += C.G) attn_unit(C, P, u >> 1, u & 1);
    }
    }
    SEAM(3);
    for (int rep_ = 0; rep_ < NREP(4); ++rep_) { if (rep_) xcd_barrier(bar); if (IN(4)) phase_ssm_y(C, P); }
    SEAM(4);
    if (IN(5)) {
        pg8::Gemm g{(const bf16_t*)(ws + WS_Z), (const bf16_t*)(ws + WS_GLU_T), SEQ, 512, 512}; pg8::StaticOrder S; S.init(SEQ, 512, C.G, C.bid);
        EpiGlu E{(const bf16_t*)(ws + WS_Z), (bf16_t*)(ws + WS_BUFA), P.in[I_GLUB], (float*)(ws + WS_SSS)};
        pg8::gemm_phase<EpiGlu, pg8::StaticOrder, true, true>(C.lds, g, S, E);
        { const int ntile = (SEQ / 256) * 2;
          if (ntile < C.G) { if (C.bid >= ntile) deferred_b(C, P, C.bid - ntile, C.G - ntile); }
          else deferred_b(C, P, C.bid, C.G); }
    }
    SEAM(5);
    if (IN(6)) {
        __syncthreads();
        if (C.tid < 256) {
            pg8::StaticOrder S0; S0.init(SEQ, DM, C.G, C.bid); pg8::Unit u0; S0.next(0, u0);
            const int row = u0.pm * 256 + C.tid;
            const f32x4* pa = (const f32x4*)((const float*)(ws + WS_SSA) + (size_t)row * 8); const f32x4* ps = (const f32x4*)((const float*)(ws + WS_SSS) + (size_t)row * 8);
            const f32x4 a0 = pa[0], a1 = pa[1], s0 = ps[0], s1 = ps[1];
            const float ra = 1.0f / sqrtf((((a0.x + a0.y) + (a0.z + a0.w)) + ((a1.x + a1.y) + (a1.z + a1.w))) * (1.0f / 512.0f) + EPS);
            const float rs = 1.0f / sqrtf((((s0.x + s0.y) + (s0.z + s0.w)) + ((s1.x + s1.y) + (s1.z + s1.w))) * (1.0f / 512.0f) + EPS);
            LAS float* fac = (LAS float*)(C.lds + FAC_OFF); fac[2 * C.tid] = ra / rs; fac[2 * C.tid + 1] = rs;
        }
        __syncthreads();
        pg8::Gemm g{(const bf16_t*)(ws + WS_BUFA), (const bf16_t*)(ws + WS_WOUT_T), SEQ, DM, DM}; pg8::StaticOrder S; S.init(SEQ, DM, C.G, C.bid);
        EpiMix E{P.in[I_X], (bf16_t*)(ws + WS_HB), (float*)(ws + WS_SSH)};
        pg8::gemm_phase<EpiMix, pg8::StaticOrder, true, true>(C.lds, g, S, E);
    }
    SEAM(6);
    if (IN(7)) {
        pg8::Gemm g{(const bf16_t*)(ws + WS_HB), (const bf16_t*)(ws + WS_WQ_T), SEQ, 2048, DM}; pg8::StaticOrder S; S.init(SEQ, 2048, C.G, C.bid);
        EpiQ E{(bf16_t*)(ws + WS_QP), (const float*)(ws + WS_SSH)};
        pg8::gemm_phase<EpiQ, pg8::StaticOrder, true, true>(C.lds, g, S, E);
    }
    SEAM(7);
    {
    if (IN(8)) {
        for (int tile = C.bid; tile < SEQ / 64; tile += C.G) {
            peer_topk_tile(C, P, tile * 64);
            if ((REPMASK >> 11) & 1) peer_topk_tile(C, P, tile * 64);
            if ((REPMASK >> 12) & 1) peer_gather_tile(C, P, tile * 64, P.zero);
            peer_gather_tile(C, P, tile * 64, P.one);
        }
    }
    }
#undef IN
#undef SEAM
}
}

extern "C" void kernel_launch(void* const* d_in, const int* in_sizes, int n_in, void* d_out, int out_size, void* d_ws, size_t ws_size, hipStream_t stream) {
    static int state = 0, grid = 0;
    if (state == 0) {
        if (n_in != 25 || out_size != mk::SEQ * mk::DM || ws_size < mk::WS_END) { fprintf(stderr, "kernel_launch: unexpected shapes (n_in %d out %d ws %zu)\n", n_in, out_size, ws_size); state = -1; return; }
        if (hipFuncSetAttribute((const void*)mk::mk_fwd, hipFuncAttributeMaxDynamicSharedMemorySize, mk::LDS_BYTES) != hipSuccess) { fprintf(stderr, "kernel_launch: hipFuncSetAttribute failed\n"); state = -1; return; }
        int dev = 0, cus = 0, per_cu = 0;
        if (hipGetDevice(&dev) != hipSuccess || hipDeviceGetAttribute(&cus, hipDeviceAttributeMultiprocessorCount, dev) != hipSuccess) { fprintf(stderr, "kernel_launch: device query failed\n"); state = -1; return; }
        if (hipOccupancyMaxActiveBlocksPerMultiprocessor(&per_cu, (const void*)mk::mk_fwd, mk::NTHR, mk::LDS_BYTES) != hipSuccess || per_cu < 1) { fprintf(stderr, "kernel_launch: occupancy query failed (%d)\n", per_cu); state = -1; return; }
        grid = cus;
        state = 1;
    }
    if (state < 0) return;
    mk::Params p{};
    for (int i = 0; i < 25; ++i) p.in[i] = (const float*)d_in[i];
    p.out = (float*)d_out; p.ws = (unsigned char*)d_ws;
    if (hipMemsetAsync((char*)d_ws + mk::WS_CTL, 0, 65536, stream) != hipSuccess) { fprintf(stderr, "kernel_launch: memset failed\n"); return; }
    p.ph_lo = 0; p.ph_hi = mk::NPHASE; p.one = 1.0f; p.zero = 0.0f;
    void* args[] = {&p};
    hipError_t e = hipLaunchCooperativeKernel((const void*)mk::mk_fwd, dim3(grid), dim3(mk::NTHR), args, mk::LDS_BYTES, stream);
    if (e != hipSuccess) fprintf(stderr, "kernel_launch: cooperative launch failed: %s (grid %d)\n", hipGetErrorString(e), grid);
}
```

```cpp
#include <hip/hip_runtime.h>
#include <cstdio>
#include <cstdint>
#include <cmath>
namespace pg8 {
#define PG8_LAS __attribute__((address_space(3)))
typedef unsigned short bf16_t;
typedef short bf16x8 __attribute__((ext_vector_type(8)));
typedef float f32x4 __attribute__((ext_vector_type(4)));
typedef unsigned u32x4 __attribute__((ext_vector_type(4)));
constexpr int BM = 256, BK = 64, HALF = 128, HTB = HALF * BK * 2  , STAGE_BYTES = 8 * HTB, NXCD = 8, WGM = 8;

__host__ __device__ __forceinline__ int lds_byte(int r, int c) { const int st = (r >> 4) * 2 + (c >> 5), rr = r & 15, cc = c & 31, ob = rr * 64 + cc * 2; return st * 1024 + (ob ^ (((ob >> 9) & 1) << 5)); }
__host__ __device__ __forceinline__ void stage_rc(int b, int& R, int& C) { const int st = b / 1024, sb = b % 1024, swz = sb ^ (((sb >> 9) & 1) << 5); R = (st >> 1) * 16 + swz / 64; C = (st & 1) * 32 + (swz % 64) / 2; }
__host__ __device__ __forceinline__ int perm32(int rho) { const int n = rho >> 4, i = rho & 15; return 8 * (i >> 2) + 4 * n + (i & 3); }

struct Unit { int pm, pn; };
struct Gemm { const bf16_t* A; const bf16_t* Bt; int M, N, K; };

struct StaticOrder {
    int nM, nN, nwg, G, c;
    __host__ __device__ __forceinline__ void init(int M, int N, int G_, int c_) { nM = M / BM; nN = N / BM; nwg = nM * nN; G = G_; c = c_; }
    __host__ __device__ __forceinline__ bool next(int i, Unit& u) const {
        const long L = (long)i * G + c; if (L >= nwg) return false;
        int wgid = (int)L; { const int q = nwg / NXCD, r = nwg % NXCD, xcd = wgid % NXCD, off = wgid / NXCD; wgid = (xcd < r ? xcd * (q + 1) : r * (q + 1) + (xcd - r) * q) + off; }
        const int nig = WGM * nN, gid = wgid / nig, fm = gid * WGM, gsz = (nM - fm) < WGM ? (nM - fm) : WGM;
        u.pm = fm + ((wgid % nig) % gsz); u.pn = (wgid % nig) / gsz; return true;
    }
    __device__ __forceinline__ void a_ready(const Unit&) const {}
    __device__ __forceinline__ void done(const Unit&) const {}
};

__device__ __forceinline__ unsigned cvt_pk_bf16(float lo, float hi) { unsigned r; asm volatile("v_cvt_pk_bf16_f32 %0, %1, %2" : "=v"(r) : "v"(lo), "v"(hi)); return r; }
typedef float f32x2 __attribute__((ext_vector_type(2)));
__device__ __forceinline__ f32x2 gelu_pk(f32x2 v) {
    const f32x2 av = __builtin_elementwise_abs(v), d = av * 0.2316418882f + 1.0f;
    f32x2 t; t.x = __builtin_amdgcn_rcpf(d.x); t.y = __builtin_amdgcn_rcpf(d.y);
    f32x2 q = t * 0.5307027145f + (-0.7265760135f); q = q * t + 0.7107068705f; q = q * t + (-0.142248368f); q = q * t + 0.127414796f; q = q * t;
    const f32x2 s = (v * v) * (-0.72134752044f);
    f32x2 e; e.x = __builtin_amdgcn_exp2f(s.x); e.y = __builtin_amdgcn_exp2f(s.y);
    const f32x2 m = v * (q * e), r = v - m;
    f32x2 o; o.x = v.x < 0.f ? m.x : r.x; o.y = v.y < 0.f ? m.y : r.y; return o;
}

template <int ACT  > struct EpiBf16 {
    static constexpr bool PERM = true, AFTER_DRAIN = false, HAS_MID = false; static_assert(ACT == 0 || ACT == 1, "EpiBf16: ACT is 0 (none) or 1 (gelu_pk)");
    bf16_t* O; int ldc; const float* bias; int split_cols; size_t split_stride; float scale0;
    __device__ __forceinline__ void operator()(const f32x4 (&acc)[2][2][4][2], const Unit& u, int wr, int wc, int fr, int fq) const {
        const int row0 = u.pm * BM + wr * 64 + fr; int colt = u.pn * BM; bf16_t* base = O;
        float sc = 1.f; if (split_cols) { const int t = colt / split_cols; base += (size_t)t * split_stride; colt -= t * split_cols; if (t == 0) sc = scale0; }
        const int col0 = colt + wc * 32 + 8 * fq, bcol0 = u.pn * BM + wc * 32 + 8 * fq;
        f32x4 bv[2][2];
#pragma unroll
        for (int bj = 0; bj < 2; ++bj)
#pragma unroll
            for (int n = 0; n < 2; ++n) bv[bj][n] = bias ? *(const f32x4*)(bias + bcol0 + bj * HALF + 4 * n) : (f32x4){0.f, 0.f, 0.f, 0.f};
#pragma unroll
        for (int ai = 0; ai < 2; ++ai)
#pragma unroll
            for (int m = 0; m < 4; ++m) { bf16_t* rowp = base + (size_t)(row0 + ai * HALF + m * 16) * ldc + col0;
#pragma unroll
                for (int bj = 0; bj < 2; ++bj) { f32x4 v0 = acc[ai][bj][m][0] + bv[bj][0], v1 = acc[ai][bj][m][1] + bv[bj][1];
                    if (ACT == 1) { f32x2 a = gelu_pk((f32x2){v0[0], v0[1]}), b = gelu_pk((f32x2){v0[2], v0[3]}), c = gelu_pk((f32x2){v1[0], v1[1]}), d = gelu_pk((f32x2){v1[2], v1[3]});
                        v0 = (f32x4){a.x, a.y, b.x, b.y}; v1 = (f32x4){c.x, c.y, d.x, d.y}; }
                    v0 = v0 * sc; v1 = v1 * sc; u32x4 w; w.x = cvt_pk_bf16(v0[0], v0[1]); w.y = cvt_pk_bf16(v0[2], v0[3]); w.z = cvt_pk_bf16(v1[0], v1[1]); w.w = cvt_pk_bf16(v1[2], v1[3]);
                    *(u32x4*)(rowp + bj * HALF) = w; } }
    }
};
template <class Epi, class Sched, bool ALIGN_EPI = false, bool SP2 = false>
__device__ __forceinline__ void gemm_phase(PG8_LAS unsigned char* lds, const Gemm g, const Sched& S, const Epi& E) {
    const int tid = threadIdx.x, wid = __builtin_amdgcn_readfirstlane(tid >> 6), lane = tid & 63, wr = wid >> 2, wc = wid & 3, fr = lane & 15, fq = lane >> 4;
    const int K = g.K, nt = K / BK;
    unsigned voffA[2], voffB[2];
#pragma unroll
    for (int i = 0; i < 2; ++i) { int R, C; stage_rc(tid * 16 + i * 8192, R, C); const int Rb = Epi::PERM ? ((R & ~31) + perm32(R & 31)) : R;
        voffA[i] = (unsigned)(R * K + C) * 2u; voffB[i] = (unsigned)(Rb * K + C) * 2u; }
    const size_t kstep = (size_t)(BK * 2);
    const size_t hstep = (size_t)HALF * K * 2;
    const size_t tstep = 2 * hstep;
    const unsigned ldsw = (unsigned)wid * 1024u;
    const int aoff = lds_byte(wr * 64 + fr, fq * 8), boff = lds_byte(wc * 32 + fr, fq * 8);
#define PG8_SA(b, h) (((b) * 2 + (h)) * HTB)
#define PG8_SB(b, h) ((4 + (b) * 2 + (h)) * HTB)
#define PG8_STAGE(bufoff, gbase, voff) do { _Pragma("unroll") for (int _i = 0; _i < 2; ++_i) \
        __builtin_amdgcn_global_load_lds((const unsigned*)((const char*)(gbase) + (voff)[_i]), (PG8_LAS unsigned*)(lds + (bufoff) + ldsw + _i * 8192), 16, 0, 0); } while (0)
#define PG8_LDA(dst, b, h) do { _Pragma("unroll") for (int m = 0; m < 4; ++m) _Pragma("unroll") for (int k = 0; k < 2; ++k) dst[m][k] = *(const PG8_LAS bf16x8*)(lds + PG8_SA(b, h) + aoff + m * 2048 + k * 1024); } while (0)
#define PG8_LDB(dst, b, h) do { _Pragma("unroll") for (int n = 0; n < 2; ++n) _Pragma("unroll") for (int k = 0; k < 2; ++k) dst[n][k] = *(const PG8_LAS bf16x8*)(lds + PG8_SB(b, h) + boff + n * 2048 + k * 1024); } while (0)
#define PG8_MMA(ai, bj, At, Bt) do { __builtin_amdgcn_s_setprio(1); _Pragma("unroll") for (int m = 0; m < 4; ++m) _Pragma("unroll") for (int n = 0; n < 2; ++n) _Pragma("unroll") for (int k = 0; k < 2; ++k) \
        acc[ai][bj][m][n] = __builtin_amdgcn_mfma_f32_16x16x32_bf16(Bt[n][k], At[m][k], acc[ai][bj][m][n], 0, 0, 0); __builtin_amdgcn_s_setprio(0); } while (0)
#define PG8_WAIT_V(n) asm volatile("s_waitcnt vmcnt(" #n ")" ::: "memory")
#define PG8_WAIT_L(n) asm volatile("s_waitcnt lgkmcnt(" #n ")" ::: "memory")
#define PG8_BAR __builtin_amdgcn_s_barrier()
#define PG8_SCHED __builtin_amdgcn_sched_barrier(0)
    Unit cur, nxt; int ui = 0;
    if (!S.next(0, cur)) return;
    f32x4 acc[2][2][4][2];
#pragma unroll
    for (int a = 0; a < 2; ++a)
#pragma unroll
        for (int b = 0; b < 2; ++b)
#pragma unroll
            for (int m = 0; m < 4; ++m)
#pragma unroll
                for (int n = 0; n < 2; ++n) acc[a][b][m][n] = (f32x4){0.f, 0.f, 0.f, 0.f};
    bf16x8 At[4][2], B0[2][2], B1[2][2];
    const char* cA = (const char*)g.A + (size_t)cur.pm * tstep; const char* cB = (const char*)g.Bt + (size_t)cur.pn * tstep;
    S.a_ready(cur);
    if constexpr (SP2) {
        PG8_STAGE(PG8_SB(0, 0), cB, voffB); PG8_STAGE(PG8_SB(0, 1), cB + hstep, voffB); PG8_STAGE(PG8_SA(0, 0), cA, voffA); PG8_STAGE(PG8_SA(0, 1), cA + hstep, voffA);
        if (wr == 1) PG8_BAR;
        PG8_WAIT_V(2); PG8_BAR;
        PG8_STAGE(PG8_SB(1, 0), cB + kstep, voffB); PG8_STAGE(PG8_SA(1, 0), cA + kstep, voffA); PG8_STAGE(PG8_SB(1, 1), cB + hstep + kstep, voffB);
        PG8_WAIT_V(6); PG8_BAR;
    } else {
        PG8_STAGE(PG8_SB(0, 0), cB, voffB); PG8_STAGE(PG8_SA(0, 0), cA, voffA); PG8_STAGE(PG8_SB(0, 1), cB + hstep, voffB); PG8_STAGE(PG8_SA(0, 1), cA + hstep, voffA);
        if (wr == 1) PG8_BAR;
        PG8_WAIT_V(4); PG8_BAR;
        PG8_STAGE(PG8_SB(1, 0), cB + kstep, voffB); PG8_STAGE(PG8_SA(1, 0), cA + kstep, voffA); PG8_STAGE(PG8_SB(1, 1), cB + hstep + kstep, voffB);
        PG8_WAIT_V(6); PG8_BAR;
    }
    for (;;) {
        const bool has_next = S.next(ui + 1, nxt);
        const char* nA = has_next ? (const char*)g.A + (size_t)nxt.pm * tstep : cA; const char* nB = has_next ? (const char*)g.Bt + (size_t)nxt.pn * tstep : cB;
        for (int t = 0; t < nt; t += 2) {
            const bool last = (t == nt - 2);
            if constexpr (Epi::HAS_MID) { if (t == nt / 2) E.mid(acc, cur, wr, wc, fr, fq, lds); }
            const char* a1 = cA + (size_t)(t + 1) * kstep;
            const char* a2 = last ? nA : cA + (size_t)(t + 2) * kstep; const char* b2 = last ? nB : cB + (size_t)(t + 2) * kstep;
            const char* a3 = a2 + kstep; const char* b3 = b2 + kstep;
            if (last && has_next) S.a_ready(nxt);
            if constexpr (SP2) {
            PG8_LDB(B0, 0, 0); PG8_LDB(B1, 0, 1); PG8_SCHED; PG8_LDA(At, 0, 0); PG8_STAGE(PG8_SA(1, 1), a1 + hstep, voffA);
            PG8_WAIT_V(8); PG8_WAIT_L(0); PG8_BAR; PG8_MMA(0, 0, At, B0); PG8_MMA(0, 1, At, B1); PG8_BAR; PG8_SCHED;
            PG8_LDA(At, 0, 1); PG8_STAGE(PG8_SB(0, 0), b2, voffB); PG8_STAGE(PG8_SB(0, 1), b2 + hstep, voffB); PG8_STAGE(PG8_SA(0, 0), a2, voffA);
            PG8_WAIT_V(8); PG8_WAIT_L(0); PG8_BAR; PG8_MMA(1, 0, At, B0); PG8_MMA(1, 1, At, B1); PG8_BAR; PG8_SCHED;
            PG8_LDB(B0, 1, 0); PG8_LDB(B1, 1, 1); PG8_SCHED; PG8_LDA(At, 1, 0); PG8_STAGE(PG8_SA(0, 1), a2 + hstep, voffA);
            PG8_WAIT_V(8); PG8_WAIT_L(0); PG8_BAR; PG8_MMA(0, 0, At, B0); PG8_MMA(0, 1, At, B1); PG8_BAR; PG8_SCHED;
            PG8_LDA(At, 1, 1); PG8_STAGE(PG8_SB(1, 0), b3, voffB); PG8_STAGE(PG8_SB(1, 1), b3 + hstep, voffB); PG8_STAGE(PG8_SA(1, 0), a3, voffA);
            PG8_WAIT_V(8); PG8_WAIT_L(0); PG8_BAR; PG8_MMA(1, 0, At, B0); PG8_MMA(1, 1, At, B1); PG8_BAR; PG8_SCHED;
            } else {
            PG8_LDB(B0, 0, 0); PG8_SCHED; PG8_LDA(At, 0, 0); PG8_STAGE(PG8_SA(1, 1), a1 + hstep, voffA);
            PG8_WAIT_L(8); PG8_BAR; PG8_WAIT_L(0); PG8_MMA(0, 0, At, B0); PG8_BAR; PG8_SCHED;
            PG8_LDB(B1, 0, 1); PG8_STAGE(PG8_SB(0, 0), b2, voffB);
            PG8_BAR; PG8_WAIT_L(0); PG8_MMA(0, 1, At, B1); PG8_BAR;
            PG8_LDA(At, 0, 1); PG8_STAGE(PG8_SA(0, 0), a2, voffA);
            PG8_BAR; PG8_WAIT_L(0); PG8_MMA(1, 0, At, B0); PG8_BAR; PG8_SCHED;
            PG8_STAGE(PG8_SB(0, 1), b2 + hstep, voffB);
            PG8_WAIT_V(6); PG8_BAR; PG8_MMA(1, 1, At, B1); PG8_BAR;
            PG8_LDB(B0, 1, 0); PG8_SCHED; PG8_LDA(At, 1, 0); PG8_STAGE(PG8_SA(0, 1), a2 + hstep, voffA);
            PG8_WAIT_L(8); PG8_BAR; PG8_WAIT_L(0); PG8_MMA(0, 0, At, B0); PG8_BAR; PG8_SCHED;
            PG8_LDB(B1, 1, 1); PG8_STAGE(PG8_SB(1, 0), b3, voffB);
            PG8_BAR; PG8_WAIT_L(0); PG8_MMA(0, 1, At, B1); PG8_BAR;
            PG8_LDA(At, 1, 1); PG8_STAGE(PG8_SA(1, 0), a3, voffA);
            PG8_BAR; PG8_WAIT_L(0); PG8_MMA(1, 0, At, B0); PG8_BAR; PG8_SCHED;
            PG8_STAGE(PG8_SB(1, 1), b3 + hstep, voffB);
            PG8_WAIT_V(6); PG8_BAR; PG8_MMA(1, 1, At, B1); PG8_BAR;
            }
        }
        if constexpr (ALIGN_EPI) { if (wr == 0) PG8_BAR; }
        if constexpr (!Epi::AFTER_DRAIN) { E(acc, cur, wr, wc, fr, fq); S.done(cur); }
        if (!has_next) break;
#pragma unroll
        for (int a = 0; a < 2; ++a)
#pragma unroll
            for (int b = 0; b < 2; ++b)
#pragma unroll
                for (int m = 0; m < 4; ++m)
#pragma unroll
                    for (int n = 0; n < 2; ++n) acc[a][b][m][n] = (f32x4){0.f, 0.f, 0.f, 0.f};
        cur = nxt; cA = nA; cB = nB; ++ui;
        if constexpr (ALIGN_EPI) { if (wr == 1) PG8_BAR; }
    }
    PG8_WAIT_V(0);
    if constexpr (!ALIGN_EPI) { if (wr == 0) PG8_BAR; }
    PG8_BAR;
    if constexpr (Epi::AFTER_DRAIN) { E.fused(acc, cur, wr, wc, fr, fq, lds, wid, lane); S.done(cur); }
#undef PG8_SA
#undef PG8_SB
#undef PG8_STAGE
#undef PG8_LDA
#undef PG8_LDB
#undef PG8_MMA
#undef PG8_WAIT_V
#undef PG8_WAIT_L
#undef PG8_BAR
#undef PG8_SCHED
}
}

namespace mk {
#define LAS __attribute__((address_space(3)))
typedef unsigned short bf16_t;
typedef short bf16x8 __attribute__((ext_vector_type(8)));
typedef float f32x4 __attribute__((ext_vector_type(4)));
typedef float f32x16 __attribute__((ext_vector_type(16)));
typedef unsigned u32x4 __attribute__((ext_vector_type(4)));
typedef unsigned u32x2 __attribute__((ext_vector_type(2)));
typedef __bf16 bf16x2_t __attribute__((ext_vector_type(2)));
typedef float f32x2_t __attribute__((ext_vector_type(2)));
typedef unsigned u32;

constexpr int DM = 1024, SEQ = 16384, NMETA = 16, MPAD = 16640, INW = 1280;
constexpr int O_K = 512, O_V = 640, O_U = 768;
constexpr int NCH = 513;
constexpr float EPS = 1e-6f;
constexpr float LOG2E = 1.4426950408889634f;
constexpr int NWAVES = 8, NTHR = 512;
constexpr int LDS_BYTES = 163840;
constexpr int MISC_OFF = LDS_BYTES - 128;

constexpr size_t MiB = 1u << 20;
constexpr size_t WS_CTL = 0, CTL_BYTES = 1 * MiB;
constexpr size_t WS_WIN_T = 1 * MiB;
constexpr size_t WS_WOUT_T = 4 * MiB;
constexpr size_t WS_WQ_T = 6 * MiB;
constexpr size_t WS_GLU_T = 10 * MiB;
constexpr size_t WS_SUBK = 10 * MiB + 512 * 1024;
constexpr size_t WS_KT = 11 * MiB;
constexpr size_t WS_F = 12 * MiB;
constexpr size_t WS_E = 16 * MiB;
constexpr size_t WS_ABART = 20 * MiB;
constexpr size_t WS_SLOC = 21 * MiB;
constexpr size_t WS_CARRY = 30 * MiB;
constexpr size_t WS_BUFA = 39 * MiB;
constexpr size_t WS_PROJ = 72 * MiB;
constexpr size_t WS_ATTN = 113 * MiB;
constexpr size_t WS_Z = 129 * MiB;
constexpr size_t WS_SSMO = 145 * MiB;
constexpr size_t WS_QP = 72 * MiB;
constexpr size_t WS_IDX = 161 * MiB;
constexpr size_t WS_GW = 169 * MiB;
constexpr size_t WS_PU = 177 * MiB;
constexpr size_t WS_PV = 193 * MiB;
constexpr size_t WS_SU = 209 * MiB;
constexpr size_t WS_SV = 209 * MiB + 65536;
constexpr size_t WS_HB = 210 * MiB;
constexpr size_t WS_SSA = 242 * MiB;
constexpr size_t WS_SSS = 242 * MiB + 512 * 1024;
constexpr size_t WS_SSH = 243 * MiB;
constexpr size_t WS_END = 245 * MiB;

struct Params { const float* in[25]; float* out; unsigned char* ws; int ph_lo, ph_hi; };
enum { I_X = 0, I_META, I_N1G, I_WIN, I_QNG, I_KNG, I_SINK, I_ARE, I_AIM, I_LDT, I_BRE, I_BIM, I_CRE, I_CIM, I_SD, I_GLUW, I_GLUB, I_AOG, I_SOG, I_WOUT, I_N2G, I_WQ, I_SUBK, I_PU, I_PV };

__device__ __forceinline__ unsigned pk2(float lo, float hi) { f32x2_t v = {lo, hi}; return __builtin_bit_cast(unsigned, __builtin_convertvector(v, bf16x2_t)); }
__device__ __forceinline__ float bflo(unsigned w) { return __uint_as_float(w << 16); }
__device__ __forceinline__ float bfhi(unsigned w) { return __uint_as_float(w & 0xffff0000u); }
__device__ __forceinline__ float wave_sum(float v) {
#pragma unroll
    for (int o = 1; o < 64; o <<= 1) v += __shfl_xor(v, o);
    return v;
}
#define LDS_WAIT() asm volatile("s_waitcnt lgkmcnt(0)" ::: "memory")
__device__ __forceinline__ float gelu_erf(float v) { return 0.5f * v * (1.0f + erff(v * 0.70710678118654752f)); }
__device__ __forceinline__ u32 f2ord(float f) { const u32 u = __float_as_uint(f); return (u & 0x80000000u) ? ~u : (u | 0x80000000u); }
__device__ __forceinline__ float ord2f(u32 o) { const u32 u = (o & 0x80000000u) ? (o & 0x7fffffffu) : ~o; return __uint_as_float(u); }
#define MFMA16(a, b, c) __builtin_amdgcn_mfma_f32_16x16x32_bf16((a), (b), (c), 0, 0, 0)
#define MFMA32(a, b, c) __builtin_amdgcn_mfma_f32_32x32x16_bf16((a), (b), (c), 0, 0, 0)

#define CEX(x, i, j) do { const u32 _a = x[i], _b = x[j]; x[i] = _a > _b ? _a : _b; x[j] = _a > _b ? _b : _a; } while (0)
__device__ __forceinline__ void sort16_desc(u32 (&x)[16]) {
#pragma unroll
    for (int k = 2; k <= 16; k <<= 1) {
#pragma unroll
        for (int j = k >> 1; j > 0; j >>= 1) {
#pragma unroll
            for (int i = 0; i < 16; ++i) { const int l = i ^ j; if (l > i) { if ((i & k) == 0) CEX(x, i, l); else CEX(x, l, i); } }
        }
    }
}
__device__ __forceinline__ void bmerge16_desc(u32 (&x)[16]) {
#pragma unroll
    for (int j = 8; j > 0; j >>= 1) {
#pragma unroll
        for (int i = 0; i < 16; ++i) { const int l = i ^ j; if (l > i) CEX(x, i, l); }
    }
}
__device__ __forceinline__ void merge_top16(u32 (&a)[16], const u32 (&b)[16]) {
#pragma unroll
    for (int i = 0; i < 16; ++i) a[i] = a[i] > b[15 - i] ? a[i] : b[15 - i];
    bmerge16_desc(a);
}
__device__ __forceinline__ void top16_of_64(u32 (&g0)[16], u32 (&g1)[16], u32 (&g2)[16], u32 (&g3)[16]) {
    sort16_desc(g0); sort16_desc(g1); sort16_desc(g2); sort16_desc(g3);
    merge_top16(g0, g1); merge_top16(g2, g3); merge_top16(g0, g2);
}
__device__ const unsigned char CAND_AB[64] = {0, 1, 2, 3, 4, 5, 6, 7, 8, 9, 10, 11, 12, 13, 14, 15, 16, 17, 18, 19, 20, 21, 22, 23, 32, 33, 34, 35, 36, 48, 49, 50, 51, 64, 65, 66, 80, 81, 96, 97, 112, 113, 128, 144, 160, 176, 192, 208, 224, 240, 0, 0, 0, 0, 0, 0, 0, 0, 0, 0, 0, 0, 0, 0};

struct Ctx { LAS unsigned char* lds; int tid, lane, wave, G, bid; };

__device__ __forceinline__ void transpose_item(const float* W, int K, int N, bf16_t* WT, LAS float* scr, int item, int lane, const float* ks0 = nullptr, const float* ks1 = nullptr, int ksplit = 0) {
    const int nblk = N / 32, kb = item / nblk, nb = item % nblk, k0 = 64 * kb, n0 = 32 * nb;
#pragma unroll 8
    for (int i = 0; i < 32; ++i) { const int kk = 2 * i + (lane >> 5); float w = W[(size_t)(k0 + kk) * N + n0 + (lane & 31)];
        if (ks0) { const int k = k0 + kk; w *= (ksplit && k >= ksplit) ? ks1[k - ksplit] : ks0[k]; }
        scr[kk * 33 + (lane & 31)] = w; }
    LDS_WAIT();
    const int c = lane & 7;
#pragma unroll
    for (int j = 0; j < 4; ++j) { const int n = (lane >> 3) + 8 * j; const LAS float* s = scr + (8 * c) * 33 + n;
        u32x4 o; o.x = pk2(s[0 * 33], s[1 * 33]); o.y = pk2(s[2 * 33], s[3 * 33]); o.z = pk2(s[4 * 33], s[5 * 33]); o.w = pk2(s[6 * 33], s[7 * 33]);
        *(u32x4*)(WT + (size_t)(n0 + n) * K + k0 + 8 * c) = o; }
    LDS_WAIT();
}

__device__ __forceinline__ void ssm_tables(const Ctx& C, const Params& P, int g) {
    LAS float* pwr = (LAS float*)C.lds;
    LAS float* pwi = pwr + 33 * 64;
    LAS float* bbr = pwi + 33 * 64;
    LAS float* bbi = bbr + 1024;
    LAS float* ccr = bbi + 1024;
    LAS float* cci = ccr + 1024;
    LAS float* cfr = cci + 1024;
    LAS float* cfi = cfr + 64;
    const int tid = C.tid;
    const float dt = expf(P.in[I_LDT][g]);
    for (int e = tid; e < 33 * 64; e += NTHR) {
        const int l = e >> 6, n = e & 63;
        const float lr = P.in[I_ARE][g * 64 + n], li = P.in[I_AIM][g * 64 + n];
        const float x = lr * dt * (float)l, th = li * dt * (float)l, mag = expf(x);
        float s, c; sincosf(th, &s, &c);
        pwr[e] = mag * c; pwi[e] = mag * s;
        if (l == 32) { float* abt = (float*)(P.ws + WS_ABART) + (g * 64 + n) * 2; abt[0] = mag * c; abt[1] = mag * s; }
    }
    if (tid < 64) {
        const int n = tid;
        const float lr = P.in[I_ARE][g * 64 + n], li = P.in[I_AIM][g * 64 + n];
        const float x1 = lr * dt, th1 = li * dt, em1 = expm1f(x1);
        float s1, c1; sincosf(th1, &s1, &c1);
        const float sh = sinf(0.5f * th1);
        const float nr = em1 * c1 - 2.0f * sh * sh, ni = (em1 + 1.0f) * s1;
        const float den = lr * lr + li * li;
        cfr[n] = (nr * lr + ni * li) / den; cfi[n] = (ni * lr - nr * li) / den;
    }
    __syncthreads();
    for (int e = tid; e < 1024; e += NTHR) {
        const int n = e >> 4;
        const float br = P.in[I_BRE][g * 1024 + e], bi = P.in[I_BIM][g * 1024 + e];
        bbr[e] = cfr[n] * br - cfi[n] * bi; bbi[e] = cfr[n] * bi + cfi[n] * br;
        ccr[e] = P.in[I_CRE][g * 1024 + e]; cci[e] = P.in[I_CIM][g * 1024 + e];
    }
    __syncthreads();
    bf16_t* Kt = (bf16_t*)(P.ws + WS_KT) + (size_t)g * 8448;
    {
        const int pq = tid & 255, p = pq >> 4, q = pq & 15, l0 = (tid >> 8) * 16;
        float val[16];
#pragma unroll
        for (int i = 0; i < 16; ++i) val[i] = 0.f;
#pragma unroll
        for (int n0 = 0; n0 < 64; n0 += 16) {
            float cbr[16], cbi[16];
#pragma unroll
            for (int n = 0; n < 16; ++n) { const float cr = ccr[p * 64 + n0 + n], ci = cci[p * 64 + n0 + n], br = bbr[(n0 + n) * 16 + q], bi = bbi[(n0 + n) * 16 + q]; cbr[n] = cr * br - ci * bi; cbi[n] = cr * bi + ci * br; }
#pragma unroll
            for (int i = 0; i < 16; ++i) {
                const int lg = l0 + i;
#pragma unroll
                for (int n = 0; n < 16; n += 4) {
                    const f32x4 ar = *(const LAS f32x4*)(pwr + lg * 64 + n0 + n), ai = *(const LAS f32x4*)(pwi + lg * 64 + n0 + n);
                    val[i] += cbr[n] * ar.x - cbi[n] * ai.x; val[i] += cbr[n + 1] * ar.y - cbi[n + 1] * ai.y; val[i] += cbr[n + 2] * ar.z - cbi[n + 2] * ai.z; val[i] += cbr[n + 3] * ar.w - cbi[n + 3] * ai.w;
                }
            }
        }
#pragma unroll
        for (int i = 0; i < 16; ++i) Kt[(l0 + i + 1) * 256 + pq] = (bf16_t)(pk2(val[i], 0.f) & 0xffffu);
        if (tid < 256) Kt[tid] = 0;
    }
    bf16_t* F = (bf16_t*)(P.ws + WS_F) + (size_t)g * 65536;
    for (int e8 = tid; e8 < 8192; e8 += NTHR) {
        const int n2 = e8 >> 6, k0 = (e8 & 63) * 8, j = k0 >> 4, q0 = k0 & 15, n = n2 & 63, l = 31 - j;
        const float ar = pwr[l * 64 + n], ai = pwi[l * 64 + n];
        float w[8];
#pragma unroll
        for (int i = 0; i < 8; ++i) { const float br = bbr[n * 16 + q0 + i], bi = bbi[n * 16 + q0 + i]; w[i] = (n2 < 64) ? (ar * br - ai * bi) : (ar * bi + ai * br); }
        u32x4 o; o.x = pk2(w[0], w[1]); o.y = pk2(w[2], w[3]); o.z = pk2(w[4], w[5]); o.w = pk2(w[6], w[7]);
        *(u32x4*)(F + (size_t)e8 * 8) = o;
    }
    bf16_t* E = (bf16_t*)(P.ws + WS_E) + (size_t)g * 65536;
    for (int e8 = tid; e8 < 8192; e8 += NTHR) {
        const int row = e8 >> 4, n20 = (e8 & 15) * 8, t = row >> 4, p = row & 15, n0 = n20 & 63;
        float w[8];
#pragma unroll
        for (int i = 0; i < 8; ++i) { const int n = n0 + i; const float pr = pwr[(t + 1) * 64 + n], pi = pwi[(t + 1) * 64 + n], cr = ccr[p * 64 + n], ci = cci[p * 64 + n];
            w[i] = (n20 < 64) ? (cr * pr - ci * pi) : -(cr * pi + ci * pr); }
        u32x4 o; o.x = pk2(w[0], w[1]); o.y = pk2(w[2], w[3]); o.z = pk2(w[4], w[5]); o.w = pk2(w[6], w[7]);
        *(u32x4*)(E + (size_t)e8 * 8) = o;
    }
    __syncthreads();
}

__device__ __forceinline__ void norm_row_to_bf16(const float* src, const float* gam, bf16_t* dst, int lane) {
    const f32x4* xr = (const f32x4*)src + lane; const f32x4* gr = (const f32x4*)gam + lane;
    f32x4 v[4]; float s = 0.f;
#pragma unroll
    for (int j = 0; j < 4; ++j) { v[j] = xr[64 * j]; s += (v[j].x * v[j].x + v[j].y * v[j].y) + (v[j].z * v[j].z + v[j].w * v[j].w); }
    const float rinv = 1.0f / sqrtf(wave_sum(s) * (1.0f / DM) + EPS);
    u32x2* o = (u32x2*)dst + lane;
#pragma unroll
    for (int j = 0; j < 4; ++j) { const f32x4 g = gr[64 * j]; u32x2 w; w.x = pk2(v[j].x * rinv * g.x, v[j].y * rinv * g.y); w.y = pk2(v[j].z * rinv * g.z, v[j].w * rinv * g.w); o[64 * j] = w; }
}

__device__ __forceinline__ void cvt8(const float* src, bf16_t* dst, size_t i) {
    const f32x4 a = ((const f32x4*)src)[2 * i], b = ((const f32x4*)src)[2 * i + 1];
    u32x4 o; o.x = pk2(a.x, a.y); o.y = pk2(a.z, a.w); o.z = pk2(b.x, b.y); o.w = pk2(b.z, b.w);
    ((u32x4*)dst)[i] = o;
}

__device__ __forceinline__ float wave_max(float m) {
    m = fmaxf(m, __builtin_bit_cast(float, __builtin_amdgcn_update_dpp(0, __builtin_bit_cast(int, m), 0xB1, 0xf, 0xf, true)));
    m = fmaxf(m, __builtin_bit_cast(float, __builtin_amdgcn_update_dpp(0, __builtin_bit_cast(int, m), 0x4E, 0xf, 0xf, true)));
    m = fmaxf(m, __builtin_bit_cast(float, __builtin_amdgcn_update_dpp(0, __builtin_bit_cast(int, m), 0x141, 0xf, 0xf, true)));
    m = fmaxf(m, __builtin_bit_cast(float, __builtin_amdgcn_update_dpp(0, __builtin_bit_cast(int, m), 0x140, 0xf, 0xf, true)));
    u32 x = __builtin_bit_cast(u32, m);
    { u32 b = x; asm volatile("" : "+v"(b)); const auto p = __builtin_amdgcn_permlane16_swap(x, b, false, false); x = p[0] > p[1] ? p[0] : p[1]; }
    { u32 b = x; asm volatile("" : "+v"(b)); const auto p = __builtin_amdgcn_permlane32_swap(x, b, false, false); x = p[0] > p[1] ? p[0] : p[1]; }
    m = __builtin_bit_cast(float, x);
    return m;
}
template <int NR> __device__ __forceinline__ void quant_rows(const Params& P, const int (&rr)[NR], int lane) {
    f32x4 v[NR][4]; float m[NR];
#pragma unroll
    for (int i = 0; i < NR; ++i) {
        const bool isv = rr[i] >= 16384; const int row = isv ? rr[i] - 16384 : rr[i];
        const f32x4* src = (const f32x4*)((isv ? P.in[I_PV] : P.in[I_PU]) + (size_t)row * DM) + lane;
#pragma unroll
        for (int j = 0; j < 4; ++j) v[i][j] = __builtin_nontemporal_load(src + 64 * j);
    }
#pragma unroll
    for (int i = 0; i < NR; ++i) {
        float mm = 0.f;
#pragma unroll
        for (int j = 0; j < 4; ++j) mm = fmaxf(mm, fmaxf(fmaxf(fabsf(v[i][j].x), fabsf(v[i][j].y)), fmaxf(fabsf(v[i][j].z), fabsf(v[i][j].w))));
        m[i] = wave_max(mm);
    }
#pragma unroll
    for (int i = 0; i < NR; ++i) {
        const bool isv = rr[i] >= 16384; const int row = isv ? rr[i] - 16384 : rr[i];
        const float top = isv ? 416.0f : 127.0f;
        const float sc = (m[i] > 0.f) ? m[i] / top : 1.0f, inv = (m[i] > 0.f) ? top / m[i] : 0.f;
        u32x4 w;
#pragma unroll
        for (int j = 0; j < 4; ++j) {
            if (isv) {
                int t = __builtin_amdgcn_cvt_pk_fp8_f32(v[i][j].x * inv, v[i][j].y * inv, 0, false);
                t = __builtin_amdgcn_cvt_pk_fp8_f32(v[i][j].z * inv, v[i][j].w * inv, t, true);
                w[j] = (u32)t;
            } else {
                const int q0 = (int)rintf(v[i][j].x * inv), q1 = (int)rintf(v[i][j].y * inv), q2 = (int)rintf(v[i][j].z * inv), q3 = (int)rintf(v[i][j].w * inv);
                w[j] = (u32)(q0 & 255) | ((u32)(q1 & 255) << 8) | ((u32)(q2 & 255) << 16) | ((u32)(q3 & 255) << 24);
            }
        }
        *(u32x4*)(P.ws + (isv ? WS_PV : WS_PU) + (size_t)row * 1024 + 16 * lane) = w;
        if (lane == 0) ((float*)(P.ws + (isv ? WS_SV : WS_SU)))[row] = sc;
    }
}
template <int NR> __device__ __forceinline__ void xn_rows(const Params& P, const int (&mm)[NR], int lane) {
    bf16_t* xn = (bf16_t*)(P.ws + WS_BUFA);
    f32x4 v[NR][4]; f32x4 g[4];
#pragma unroll
    for (int j = 0; j < 4; ++j) g[j] = ((const f32x4*)P.in[I_N1G])[64 * j + lane];
#pragma unroll
    for (int i = 0; i < NR; ++i) {
        const int m = mm[i];
        const float* src = (m < SEQ) ? P.in[I_X] + (size_t)m * DM : P.in[I_META] + (size_t)((m < SEQ + NMETA) ? (m - SEQ) : 0) * DM;
#pragma unroll
        for (int j = 0; j < 4; ++j) v[i][j] = ((const f32x4*)src)[64 * j + lane];
    }
#pragma unroll
    for (int i = 0; i < NR; ++i) {
        const int m = mm[i];
        float ss = 0.f;
#pragma unroll
        for (int j = 0; j < 4; ++j) ss += (v[i][j].x * v[i][j].x + v[i][j].y * v[i][j].y) + (v[i][j].z * v[i][j].z + v[i][j].w * v[i][j].w);
        float rinv = 1.0f / sqrtf(wave_sum(ss) * (1.0f / DM) + EPS);
        if (m >= SEQ + NMETA) rinv = 0.f;
        u32x2* o = (u32x2*)(xn + (size_t)m * DM) + lane;
#pragma unroll
        for (int j = 0; j < 4; ++j) { u32x2 w; w.x = pk2(v[i][j].x * rinv * g[j].x, v[i][j].y * rinv * g[j].y); w.y = pk2(v[i][j].z * rinv * g[j].z, v[i][j].w * rinv * g[j].w); o[64 * j] = w; }
    }
}
__device__ __forceinline__ void phase_prologue(const Ctx& C, const Params& P) {
    LAS float* scr = (LAS float*)(C.lds + C.wave * 16384);
    const int gw = C.bid * NWAVES + C.wave, NGW = C.G * NWAVES;
    for (int it = gw; it < 16 * 40; it += NGW) transpose_item(P.in[I_WIN], 1024, 1280, (bf16_t*)(P.ws + WS_WIN_T), scr, it, C.lane);
    for (int m = gw; m < MPAD; m += 4 * NGW) {
        if (m + 3 * NGW < MPAD) { const int mm[4] = {m, m + NGW, m + 2 * NGW, m + 3 * NGW}; xn_rows<4>(P, mm, C.lane); }
        else { for (int q = m; q < MPAD; q += NGW) { const int mm[1] = {q}; xn_rows<1>(P, mm, C.lane); } }
    }
}
__device__ __forceinline__ void deferred_a(const Ctx& C0, const Params& P, int ib, int nib) {
    Ctx C = C0; asm volatile("" : "+v"(C.tid), "+v"(C.lane));
    __syncthreads();
    const int nssm = (nib >= 64) ? 32 : 0;
    if (!nssm || ib < 32) { for (int g = ib; g < 32; g += (nssm ? 32 : nib)) ssm_tables(C, P, g); }
    if (nssm && ib < 32) return;
    __syncthreads();
    LAS float* scr = (LAS float*)(C.lds + C.wave * 16384);
    const int gw = (ib - nssm) * NWAVES + C.wave, NGW = (nib - nssm) * NWAVES;
    for (int it = gw; it < 8 * 16; it += NGW) transpose_item(P.in[I_GLUW], 512, 512, (bf16_t*)(P.ws + WS_GLU_T), scr, it, C.lane);
    for (int r = gw; r < 2 * 16384; r += 4 * NGW) {
        if (r + 3 * NGW < 2 * 16384) { const int rr[4] = {r, r + NGW, r + 2 * NGW, r + 3 * NGW}; quant_rows<4>(P, rr, C.lane); }
        else { for (int q = r; q < 2 * 16384; q += NGW) { const int rr[1] = {q}; quant_rows<1>(P, rr, C.lane); } }
    }
    const size_t gt = (size_t)(ib - nssm) * NTHR + C.tid, NT = (size_t)(nib - nssm) * NTHR;
    for (size_t i = gt; i < 262144 / 8; i += NT) cvt8(P.in[I_SUBK], (bf16_t*)(P.ws + WS_SUBK), i);
}
__device__ __forceinline__ void deferred_b(const Ctx& C0, const Params& P, int ib, int nib) {
    Ctx C = C0; asm volatile("" : "+v"(C.tid), "+v"(C.lane));
    __syncthreads();
    LAS float* scr = (LAS float*)(C.lds + C.wave * 16384);
    const int gw = ib * NWAVES + C.wave, NGW = nib * NWAVES;
    constexpr int I_OUT = 16 * 32, I_Q = 16 * 64;
    for (int it = gw; it < I_OUT + I_Q; it += NGW) {
        if (it < I_OUT) transpose_item(P.in[I_WOUT], 1024, 1024, (bf16_t*)(P.ws + WS_WOUT_T), scr, it, C.lane, P.in[I_AOG], P.in[I_SOG], 512);
        else transpose_item(P.in[I_WQ], 1024, 2048, (bf16_t*)(P.ws + WS_WQ_T), scr, it - I_OUT, C.lane, P.in[I_N2G]);
    }
}

__device__ __forceinline__ bf16x8 u_frag(const bf16_t* proj, int ci, int j, int g, int half) {
    const bool ok = (ci == 0) ? (j >= 16) : (ci < NCH);
    int row = (ci == 0) ? (SEQ + j - 16) : ((ci - 1) * 32 + j);
    row = ok ? row : 0;
    const u32x4 w = *(const u32x4*)(proj + (size_t)row * INW + O_U + g * 16 + half * 8);
    u32x4 z; z.x = ok ? w.x : 0u; z.y = ok ? w.y : 0u; z.z = ok ? w.z : 0u; z.w = ok ? w.w : 0u;
    return __builtin_bit_cast(bf16x8, z);
}

constexpr int F_PITCH = 1040;
__device__ __forceinline__ void phase_sloc(const Ctx& C, const Params& P) {
    const bf16_t* proj = (const bf16_t*)(P.ws + WS_PROJ);
    float* SL = (float*)(P.ws + WS_SLOC);
    const int n = C.lane & 15, kq = C.lane >> 4;
    for (int bu = C.bid; bu < 160; bu += C.G) {
        const int g = bu / 5, qtr = bu % 5, s = qtr * 8 + C.wave, ci = 16 * s + n;
        bf16x8 Bf[16];
#pragma unroll
        for (int ks = 0; ks < 16; ++ks) Bf[ks] = u_frag(proj, (s < 33) ? ci : NCH, 2 * ks + (kq >> 1), g, kq & 1);
        __syncthreads();
        { const u32x4* src = (const u32x4*)((const bf16_t*)(P.ws + WS_F) + (size_t)g * 65536);
          u32x4 t[16];
#pragma unroll
          for (int i = 0; i < 16; ++i) t[i] = src[C.tid + NTHR * i];
#pragma unroll
          for (int i = 0; i < 16; ++i) { const int e = C.tid + NTHR * i; *(LAS u32x4*)(C.lds + (e >> 6) * F_PITCH + (e & 63) * 16) = t[i]; } }
        __syncthreads();
        if (s < 33) {
#pragma unroll 1
            for (int mt = 0; mt < 8; ++mt) {
                f32x4 acc = {0.f, 0.f, 0.f, 0.f};
#pragma unroll
                for (int ks = 0; ks < 16; ++ks) {
                    const bf16x8 A = *(const LAS bf16x8*)(C.lds + (mt * 16 + n) * F_PITCH + (32 * ks + 8 * kq) * 2);
                    acc = MFMA16(A, Bf[ks], acc);
                }
                if (ci < NCH) *(f32x4*)(SL + ((size_t)ci * 32 + g) * 128 + mt * 16 + 4 * kq) = acc;
            }
        }
    }
}

__device__ __forceinline__ void carry_scan_block(const Ctx& C, const Params& P, int bk) {
    const float* SL = (const float*)(P.ws + WS_SLOC);
    float* CA = (float*)(P.ws + WS_CARRY);
    LAS float* Lr = (LAS float*)C.lds;
    LAS float* Li = Lr + 512;
    const int chan = bk * 32 + (C.tid & 31), g = chan >> 6, n = chan & 63, sg = C.tid >> 5;
    const float* abt = (const float*)(P.ws + WS_ABART) + (g * 64 + n) * 2;
    const float ar = abt[0], ai = abt[1];
    float sr = 0.f, si = 0.f;
#pragma unroll 8
    for (int i = 0; i < 32; ++i) {
        const int ci = 32 * sg + i; const size_t o = ((size_t)ci * 32 + g) * 128 + n;
        const float br = SL[o], bi = SL[o + 64];
        const float tr = ar * sr - ai * si + br, ti = ar * si + ai * sr + bi; sr = tr; si = ti;
    }
    Lr[sg * 32 + (C.tid & 31)] = sr; Li[sg * 32 + (C.tid & 31)] = si;
    float pr = ar, pi = ai;
#pragma unroll
    for (int k = 0; k < 5; ++k) { const float tr = pr * pr - pi * pi, ti = 2.f * pr * pi; pr = tr; pi = ti; }
    __syncthreads();
    float cr = 0.f, ci_ = 0.f;
    for (int s2 = 0; s2 < sg; ++s2) { const float lr = Lr[s2 * 32 + (C.tid & 31)], li = Li[s2 * 32 + (C.tid & 31)];
        const float tr = pr * cr - pi * ci_ + lr, ti = pr * ci_ + pi * cr + li; cr = tr; ci_ = ti; }
    sr = cr; si = ci_;
#pragma unroll 8
    for (int i = 0; i < 32; ++i) {
        const int ci = 32 * sg + i; const size_t o = ((size_t)ci * 32 + g) * 128 + n;
        CA[o] = sr; CA[o + 64] = si;
        const float br = SL[o], bi = SL[o + 64];
        const float tr = ar * sr - ai * si + br, ti = ar * si + ai * sr + bi; sr = tr; si = ti;
    }
    if (sg == 15) { const size_t o = ((size_t)512 * 32 + g) * 128 + n; CA[o] = sr; CA[o + 64] = si; }
    __syncthreads();
}

constexpr int E_OFF = 16896, E_PITCH = 272;
__device__ __forceinline__ void phase_ssm_y(const Ctx& C, const Params& P) {
    const bf16_t* proj = (const bf16_t*)(P.ws + WS_PROJ);
    const float* CA = (const float*)(P.ws + WS_CARRY);
    bf16_t* Z = (bf16_t*)(P.ws + WS_Z);
    const int n = C.lane & 15, kq = C.lane >> 4;
    for (int bu = C.bid; bu < 256; bu += C.G) {
        const int g = bu >> 3, cq = bu & 7;
        __syncthreads();
        { const u32x4* src = (const u32x4*)((const bf16_t*)(P.ws + WS_KT) + (size_t)g * 8448); LAS u32x4* dst = (LAS u32x4*)C.lds;
          for (int e = C.tid; e < 1056; e += NTHR) dst[e] = src[e];
          const u32x4* esrc = (const u32x4*)((const bf16_t*)(P.ws + WS_E) + (size_t)g * 65536);
          u32x4 t[16];
#pragma unroll
          for (int i = 0; i < 16; ++i) t[i] = esrc[C.tid + NTHR * i];
#pragma unroll
          for (int i = 0; i < 16; ++i) { const int e = C.tid + NTHR * i; *(LAS u32x4*)(C.lds + E_OFF + (e >> 4) * E_PITCH + (e & 15) * 16) = t[i]; } }
        __syncthreads();
        const int ci = 1 + 64 * cq + 16 * (C.wave >> 1) + n, par = C.wave & 1;
        bf16x8 Uf[16], Cf[4];
#pragma unroll
        for (int ks = 0; ks < 16; ++ks) Uf[ks] = u_frag(proj, ci, 2 * ks + (kq >> 1), g, kq & 1);
#pragma unroll
        for (int k2 = 0; k2 < 4; ++k2) {
            const float* cp = CA + ((size_t)ci * 32 + g) * 128 + 32 * k2 + 8 * kq;
            const f32x4 a = *(const f32x4*)cp, b = *(const f32x4*)(cp + 4);
            u32x4 w; w.x = pk2(a.x, a.y); w.y = pk2(a.z, a.w); w.z = pk2(b.x, b.y); w.w = pk2(b.z, b.w);
            Cf[k2] = __builtin_bit_cast(bf16x8, w);
        }
        const f32x4 dv = *(const f32x4*)(P.in[I_SD] + g * 16 + 4 * kq);
#pragma unroll 1
        for (int tt = 0; tt < 16; ++tt) {
            const int t = 2 * tt + par;
            f32x4 acc = {0.f, 0.f, 0.f, 0.f};
#pragma unroll
            for (int k2 = 0; k2 < 4; ++k2) {
                const bf16x8 A = *(const LAS bf16x8*)(C.lds + E_OFF + (t * 16 + n) * E_PITCH + (32 * k2 + 8 * kq) * 2);
                acc = MFMA16(A, Cf[k2], acc);
            }
#pragma unroll
            for (int ks = 0; ks < 16; ++ks) {
                if (ks <= tt) {
                    const int li = t - 2 * ks - (kq >> 1) + 1;
                    const bf16x8 A = *(const LAS bf16x8*)(C.lds + ((li * 16 + n) * 16 + 8 * (kq & 1)) * 2);
                    acc = MFMA16(A, Uf[ks], acc);
                }
            }
            const int row = (ci - 1) * 32 + t, ch = g * 16 + 4 * kq;
            const u32x2 uw = *(const u32x2*)(proj + (size_t)row * INW + O_U + ch);
            const float y0 = acc.x + dv.x * bflo(uw.x), y1 = acc.y + dv.y * bfhi(uw.x), y2 = acc.z + dv.z * bflo(uw.y), y3 = acc.w + dv.w * bfhi(uw.y);
            u32x2 o; o.x = pk2(gelu_erf(y0), gelu_erf(y1)); o.y = pk2(gelu_erf(y2), gelu_erf(y3));
            *(u32x2*)(Z + (size_t)row * 512 + ch) = o;
        }
    }
}

constexpr int VT_PITCH = 296;
__device__ __forceinline__ void attn_unit(const Ctx& C, const Params& P, int b, int hk) {
    const bf16_t* proj = (const bf16_t*)(P.ws + WS_PROJ);
    bf16_t* AO = (bf16_t*)(P.ws + WS_BUFA);
    float* SSA = (float*)(P.ws + WS_SSA);
    LAS unsigned char* Ks = C.lds;
    LAS bf16_t* Vt = (LAS bf16_t*)(C.lds + 288 * 128);
    __syncthreads();
    for (int e = C.tid; e < 288 * 8; e += NTHR) {
        const int key = e >> 3, ch = e & 7;
        int row = -1;
        if (key < 256) { const int j = (b - 1) * 128 + key; if (j >= 0) row = j; } else if (key < 272) row = SEQ + key - 256;
        u32x4 kw = {0u, 0u, 0u, 0u}, vw = {0u, 0u, 0u, 0u};
        if (row >= 0) { kw = *(const u32x4*)(proj + (size_t)row * INW + O_K + hk * 64 + ch * 8); vw = *(const u32x4*)(proj + (size_t)row * INW + O_V + hk * 64 + ch * 8); }
        float kf[8] = {bflo(kw.x), bfhi(kw.x), bflo(kw.y), bfhi(kw.y), bflo(kw.z), bfhi(kw.z), bflo(kw.w), bfhi(kw.w)};
        float ss = 0.f;
#pragma unroll
        for (int i = 0; i < 8; ++i) ss += kf[i] * kf[i];
        ss += __shfl_xor(ss, 1); ss += __shfl_xor(ss, 2); ss += __shfl_xor(ss, 4);
        const float rinv = 1.0f / sqrtf(ss * (1.0f / 64.0f) + EPS);
        const f32x4 g0 = *(const f32x4*)(P.in[I_KNG] + ch * 8), g1 = *(const f32x4*)(P.in[I_KNG] + ch * 8 + 4);
        u32x4 o; o.x = pk2(kf[0] * rinv * g0.x, kf[1] * rinv * g0.y); o.y = pk2(kf[2] * rinv * g0.z, kf[3] * rinv * g0.w);
        o.z = pk2(kf[4] * rinv * g1.x, kf[5] * rinv * g1.y); o.w = pk2(kf[6] * rinv * g1.z, kf[7] * rinv * g1.w);
        *(LAS u32x4*)(Ks + key * 128 + ((ch ^ (key & 7)) * 16)) = o;
        const unsigned vv[4] = {vw.x, vw.y, vw.z, vw.w};
#pragma unroll
        for (int i = 0; i < 4; ++i) { Vt[(ch * 8 + 2 * i) * VT_PITCH + key] = (bf16_t)(vv[i] & 0xffffu); Vt[(ch * 8 + 2 * i + 1) * VT_PITCH + key] = (bf16_t)(vv[i] >> 16); }
    }
    __syncthreads();
    const int c = C.lane & 31, h = C.lane >> 5;
#pragma unroll 1
    for (int ti = C.wave; ti < 16; ti += NWAVES) {
        const int hql = ti >> 2, wq = ti & 3, hq = hk * 4 + hql;
        const int qi = wq * 32 + c, tok = b * 128 + qi;
        bf16x8 qf[4];
        {
            u32x4 qw[4]; float ss = 0.f;
#pragma unroll
            for (int ks = 0; ks < 4; ++ks) { qw[ks] = *(const u32x4*)(proj + (size_t)tok * INW + hq * 64 + 16 * ks + 8 * h);
                const unsigned w[4] = {qw[ks].x, qw[ks].y, qw[ks].z, qw[ks].w};
#pragma unroll
                for (int i = 0; i < 4; ++i) { const float a = bflo(w[i]), bb = bfhi(w[i]); ss += a * a + bb * bb; } }
            ss += __shfl_xor(ss, 32);
            const float rinv = (1.0f / sqrtf(ss * (1.0f / 64.0f) + EPS)) * (0.125f * LOG2E);
#pragma unroll
            for (int ks = 0; ks < 4; ++ks) {
                const f32x4 g0 = *(const f32x4*)(P.in[I_QNG] + 16 * ks + 8 * h), g1 = *(const f32x4*)(P.in[I_QNG] + 16 * ks + 8 * h + 4);
                u32x4 o; o.x = pk2(bflo(qw[ks].x) * rinv * g0.x, bfhi(qw[ks].x) * rinv * g0.y); o.y = pk2(bflo(qw[ks].y) * rinv * g0.z, bfhi(qw[ks].y) * rinv * g0.w);
                o.z = pk2(bflo(qw[ks].z) * rinv * g1.x, bfhi(qw[ks].z) * rinv * g1.y); o.w = pk2(bflo(qw[ks].w) * rinv * g1.z, bfhi(qw[ks].w) * rinv * g1.w);
                qf[ks] = __builtin_bit_cast(bf16x8, o);
            }
        }
        f32x16 S[6];
#pragma unroll
        for (int rb = 0; rb < 6; ++rb) {
            const int kb = (rb < 5) ? (wq + rb) : 8;
            const int key = kb * 32 + c;
            f32x16 acc = {0.f, 0.f, 0.f, 0.f, 0.f, 0.f, 0.f, 0.f, 0.f, 0.f, 0.f, 0.f, 0.f, 0.f, 0.f, 0.f};
#pragma unroll
            for (int ks = 0; ks < 4; ++ks) {
                const bf16x8 A = *(const LAS bf16x8*)(Ks + key * 128 + (((2 * ks + h) ^ (key & 7)) * 16));
                acc = MFMA32(A, qf[ks], acc);
            }
            S[rb] = acc;
            __builtin_amdgcn_sched_barrier(0);
        }
        const float sl = P.in[I_SINK][hq] * LOG2E;
        float mx = sl;
#pragma unroll
        for (int r = 0; r < 16; ++r) {
            const int kr = (r & 3) + 8 * (r >> 2) + 4 * h;
            const bool gt = kr > c;
            S[0][r] = gt ? S[0][r] : -1e30f;
            S[4][r] = gt ? -1e30f : S[4][r];
            if (r >= 8) S[5][r] = -1e30f;
        }
        if (b == 0) {
#pragma unroll
            for (int rb = 0; rb < 4; ++rb) if (wq + rb < 4) {
#pragma unroll
                for (int r = 0; r < 16; ++r) S[rb][r] = -1e30f;
            }
        }
#pragma unroll
        for (int rb = 0; rb < 6; ++rb)
#pragma unroll
            for (int r = 0; r < 16; ++r) mx = fmaxf(mx, S[rb][r]);
        mx = fmaxf(mx, __shfl_xor(mx, 32));
        float lsum = 0.f;
#pragma unroll
        for (int rb = 0; rb < 6; ++rb)
#pragma unroll
            for (int r = 0; r < 16; ++r) { const float p = exp2f(S[rb][r] - mx); S[rb][r] = p; lsum += p; }
        lsum += __shfl_xor(lsum, 32);
        lsum += exp2f(sl - mx);
        const float linv = 1.0f / lsum;
        f32x16 O[2];
#pragma unroll
        for (int db = 0; db < 2; ++db) O[db] = (f32x16){0.f, 0.f, 0.f, 0.f, 0.f, 0.f, 0.f, 0.f, 0.f, 0.f, 0.f, 0.f, 0.f, 0.f, 0.f, 0.f};
#pragma unroll
        for (int rb = 0; rb < 6; ++rb) {
            const int kb = (rb < 5) ? (wq + rb) : 8;
#pragma unroll
            for (int s = 0; s < 2; ++s) {
                if (rb == 5 && s == 1) continue;
                u32x4 pw; pw.x = pk2(S[rb][8 * s + 0], S[rb][8 * s + 1]); pw.y = pk2(S[rb][8 * s + 2], S[rb][8 * s + 3]);
                pw.z = pk2(S[rb][8 * s + 4], S[rb][8 * s + 5]); pw.w = pk2(S[rb][8 * s + 6], S[rb][8 * s + 7]);
                const bf16x8 Pf = __builtin_bit_cast(bf16x8, pw);
#pragma unroll
                for (int db = 0; db < 2; ++db) {
                    const LAS bf16_t* vp = Vt + (db * 32 + c) * VT_PITCH + kb * 32 + 16 * s + 4 * h;
                    const u32x2 lo = *(const LAS u32x2*)vp, hi2 = *(const LAS u32x2*)(vp + 8);
                    u32x4 vw; vw.x = lo.x; vw.y = lo.y; vw.z = hi2.x; vw.w = hi2.y;
                    O[db] = MFMA32(__builtin_bit_cast(bf16x8, vw), Pf, O[db]);
                }
                __builtin_amdgcn_sched_barrier(0);
            }
        }
        float ssq = 0.f;
#pragma unroll
        for (int db = 0; db < 2; ++db)
#pragma unroll
            for (int gq = 0; gq < 4; ++gq) {
                const float o0 = O[db][4 * gq] * linv, o1 = O[db][4 * gq + 1] * linv, o2 = O[db][4 * gq + 2] * linv, o3 = O[db][4 * gq + 3] * linv;
                ssq += (o0 * o0 + o1 * o1) + (o2 * o2 + o3 * o3);
                u32x2 o; o.x = pk2(o0, o1); o.y = pk2(o2, o3);
                *(u32x2*)(AO + (size_t)tok * 1024 + hq * 64 + db * 32 + 8 * gq + 4 * h) = o;
            }
        ssq += __shfl_xor(ssq, 32);
        if (h == 0) SSA[(size_t)tok * 8 + hq] = ssq;
    }
}

struct EpiGlu {
    static constexpr bool PERM = true, AFTER_DRAIN = false, HAS_MID = false;
    const bf16_t* Z; bf16_t* O; const float* bias; float* SSS;
    __device__ __forceinline__ void operator()(const pg8::f32x4 (&acc)[2][2][4][2], const pg8::Unit& u, int wr, int wc, int fr, int fq) const {
        const int row0 = u.pm * 256 + wr * 64 + fr, col0 = u.pn * 256 + wc * 32 + 8 * fq;
        f32x4 bb[2][2];
#pragma unroll
        for (int bj = 0; bj < 2; ++bj) { bb[bj][0] = *(const f32x4*)(bias + col0 + bj * 128); bb[bj][1] = *(const f32x4*)(bias + col0 + bj * 128 + 4); }
#pragma unroll
        for (int ai = 0; ai < 2; ++ai) {
            u32x4 zw[4][2];
#pragma unroll
            for (int m = 0; m < 4; ++m)
#pragma unroll
                for (int bj = 0; bj < 2; ++bj) zw[m][bj] = *(const u32x4*)(Z + (size_t)(row0 + ai * 128 + m * 16) * 512 + col0 + bj * 128);
#pragma unroll
            for (int m = 0; m < 4; ++m) {
                const int row = row0 + ai * 128 + m * 16; float ssq = 0.f;
#pragma unroll
                for (int bj = 0; bj < 2; ++bj) {
                    const f32x4 b0 = bb[bj][0], b1 = bb[bj][1]; const u32x4 z4 = zw[m][bj];
                    const pg8::f32x4 v0 = acc[ai][bj][m][0], v1 = acc[ai][bj][m][1];
                    const float zf[8] = {bflo(z4.x), bfhi(z4.x), bflo(z4.y), bfhi(z4.y), bflo(z4.z), bfhi(z4.z), bflo(z4.w), bfhi(z4.w)};
                    const float pre[8] = {v0[0] + b0.x, v0[1] + b0.y, v0[2] + b0.z, v0[3] + b0.w, v1[0] + b1.x, v1[1] + b1.y, v1[2] + b1.z, v1[3] + b1.w};
                    float r[8];
#pragma unroll
                    for (int i = 0; i < 8; ++i) { r[i] = zf[i] / (1.0f + __expf(-pre[i])); ssq += r[i] * r[i]; }
                    u32x4 o; o.x = pk2(r[0], r[1]); o.y = pk2(r[2], r[3]); o.z = pk2(r[4], r[5]); o.w = pk2(r[6], r[7]);
                    *(u32x4*)(O + (size_t)row * 1024 + 512 + col0 + bj * 128) = o;
                }
                ssq += __shfl_xor(ssq, 16); ssq += __shfl_xor(ssq, 32);
                if (fq == 0) SSS[(size_t)row * 8 + u.pn * 4 + wc] = ssq;
            }
        }
    }
};
constexpr int FAC_OFF = 131072;
struct EpiMix {
    static constexpr bool PERM = true, AFTER_DRAIN = false, HAS_MID = true;
    const float* X; bf16_t* HB; float* SSH;
    __device__ __forceinline__ void mid(pg8::f32x4 (&acc)[2][2][4][2], const pg8::Unit& u, int wr, int wc, int fr, int fq, LAS unsigned char* lds) const {
#pragma unroll
        for (int ai = 0; ai < 2; ++ai)
#pragma unroll
            for (int m = 0; m < 4; ++m) {
                const float f = ((const LAS float*)(lds + FAC_OFF))[2 * (ai * 128 + wr * 64 + m * 16 + fr)];
#pragma unroll
                for (int bj = 0; bj < 2; ++bj)
#pragma unroll
                    for (int n = 0; n < 2; ++n) acc[ai][bj][m][n] *= f;
            }
    }
    __device__ __forceinline__ void operator()(const pg8::f32x4 (&acc)[2][2][4][2], const pg8::Unit& u, int wr, int wc, int fr, int fq) const {
        extern __shared__ __attribute__((aligned(16))) unsigned char lds_raw_[];
        const LAS float* fac = (const LAS float*)((LAS unsigned char*)lds_raw_ + FAC_OFF);
        const int col0 = u.pn * 256 + wc * 32 + 8 * fq;
#pragma unroll
        for (int ai = 0; ai < 2; ++ai) {
            f32x4 xv[4][2][2];
#pragma unroll
            for (int m = 0; m < 4; ++m)
#pragma unroll
                for (int bj = 0; bj < 2; ++bj) { const size_t off = (size_t)(u.pm * 256 + ai * 128 + wr * 64 + m * 16 + fr) * 1024 + col0 + bj * 128;
                    xv[m][bj][0] = *(const f32x4*)(X + off); xv[m][bj][1] = *(const f32x4*)(X + off + 4); }
#pragma unroll
            for (int m = 0; m < 4; ++m) {
                const int rl = ai * 128 + wr * 64 + m * 16 + fr, row = u.pm * 256 + rl;
                const float rs = fac[2 * rl + 1]; float ssq = 0.f;
#pragma unroll
                for (int bj = 0; bj < 2; ++bj) {
                    const size_t off = (size_t)row * 1024 + col0 + bj * 128;
                    const f32x4 x0 = xv[m][bj][0], x1 = xv[m][bj][1];
                    const pg8::f32x4 v0 = acc[ai][bj][m][0], v1 = acc[ai][bj][m][1];
                    const float hv[8] = {x0.x + rs * v0[0], x0.y + rs * v0[1], x0.z + rs * v0[2], x0.w + rs * v0[3], x1.x + rs * v1[0], x1.y + rs * v1[1], x1.z + rs * v1[2], x1.w + rs * v1[3]};
#pragma unroll
                    for (int i = 0; i < 8; ++i) ssq += hv[i] * hv[i];
                    u32x4 o; o.x = pk2(hv[0], hv[1]); o.y = pk2(hv[2], hv[3]); o.z = pk2(hv[4], hv[5]); o.w = pk2(hv[6], hv[7]);
                    *(u32x4*)(HB + off) = o;
                }
                ssq += __shfl_xor(ssq, 16); ssq += __shfl_xor(ssq, 32);
                if (fq == 0) SSH[(size_t)row * 16 + u.pn * 4 + wc] = ssq;
            }
        }
    }
};
struct EpiQ {
    static constexpr bool PERM = true, AFTER_DRAIN = false, HAS_MID = false;
    bf16_t* O; const float* SSH;
    __device__ __forceinline__ void operator()(const pg8::f32x4 (&acc)[2][2][4][2], const pg8::Unit& u, int wr, int wc, int fr, int fq) const {
        const int col0 = u.pn * 256 + wc * 32 + 8 * fq;
        float ri[2][4];
#pragma unroll
        for (int ai = 0; ai < 2; ++ai)
#pragma unroll
            for (int m = 0; m < 4; ++m) {
                const int row = u.pm * 256 + ai * 128 + wr * 64 + m * 16 + fr;
                const f32x4* sp = (const f32x4*)(SSH + (size_t)row * 16);
                const f32x4 s0 = sp[0], s1 = sp[1], s2 = sp[2], s3 = sp[3];
                const float ss = ((s0.x + s0.y) + (s0.z + s0.w)) + ((s1.x + s1.y) + (s1.z + s1.w)) + ((s2.x + s2.y) + (s2.z + s2.w)) + ((s3.x + s3.y) + (s3.z + s3.w));
                ri[ai][m] = 1.0f / sqrtf(ss * (1.0f / 1024.0f) + EPS);
            }
#pragma unroll
        for (int ai = 0; ai < 2; ++ai)
#pragma unroll
            for (int m = 0; m < 4; ++m) {
                const int row = u.pm * 256 + ai * 128 + wr * 64 + m * 16 + fr; const float r = ri[ai][m];
#pragma unroll
                for (int bj = 0; bj < 2; ++bj) {
                    const pg8::f32x4 v0 = acc[ai][bj][m][0], v1 = acc[ai][bj][m][1];
                    u32x4 o; o.x = pk2(v0[0] * r, v0[1] * r); o.y = pk2(v0[2] * r, v0[3] * r); o.z = pk2(v1[0] * r, v1[1] * r); o.w = pk2(v1[2] * r, v1[3] * r);
                    *(u32x4*)(O + (size_t)row * 2048 + col0 + bj * 128) = o;
                }
            }
    }
};

__device__ __forceinline__ void peer_topk_tile(const Ctx& C, const Params& P, int tok0) {
    const bf16_t* QP = (const bf16_t*)(P.ws + WS_QP);
    const bf16_t* SK = (const bf16_t*)(P.ws + WS_SUBK);
    int* IDX = (int*)(P.ws + WS_IDX); float* GW = (float*)(P.ws + WS_GW);
    LAS u32* lists = (LAS u32*)C.lds;
    const int c = C.lane & 31, h = C.lane >> 5;
    __syncthreads();
#pragma unroll 1
    for (int hs = C.wave; hs < 16; hs += NWAVES) {
        bf16x8 qf[2][8];
#pragma unroll
        for (int tg = 0; tg < 2; ++tg) { const bf16_t* qrow = QP + (size_t)(tok0 + tg * 32 + c) * 2048 + hs * 128;
#pragma unroll
            for (int ks = 0; ks < 8; ++ks) qf[tg][ks] = *(const bf16x8*)(qrow + 16 * ks + 8 * h); }
        u32 best[2][16];
#pragma unroll 1
        for (int kb = 0; kb < 4; ++kb) {
            bf16x8 kf[8];
            const bf16_t* krow = SK + (size_t)(hs * 128 + kb * 32 + c) * 128;
#pragma unroll
            for (int ks = 0; ks < 8; ++ks) kf[ks] = *(const bf16x8*)(krow + 16 * ks + 8 * h);
            f32x16 acc0 = {0.f, 0.f, 0.f, 0.f, 0.f, 0.f, 0.f, 0.f, 0.f, 0.f, 0.f, 0.f, 0.f, 0.f, 0.f, 0.f}, acc1 = acc0;
#pragma unroll
            for (int ks = 0; ks < 8; ++ks) { acc0 = MFMA32(kf[ks], qf[0][ks], acc0); acc1 = MFMA32(kf[ks], qf[1][ks], acc1); }
            u32 g0[16], g1[16];
#pragma unroll
            for (int r = 0; r < 16; ++r) { const u32 kx = (u32)(127 - (kb * 32 + (r & 3) + 8 * (r >> 2) + 4 * h));
                g0[r] = (f2ord(acc0[r]) & ~0x7Fu) | kx; g1[r] = (f2ord(acc1[r]) & ~0x7Fu) | kx; }
            sort16_desc(g0); sort16_desc(g1);
            if (kb == 0) {
#pragma unroll
                for (int i = 0; i < 16; ++i) { best[0][i] = g0[i]; best[1][i] = g1[i]; }
            } else { merge_top16(best[0], g0); merge_top16(best[1], g1); }
        }
#pragma unroll
        for (int tg = 0; tg < 2; ++tg) {
            u32 pb[16];
#pragma unroll
            for (int i = 0; i < 16; ++i) pb[i] = (u32)__shfl_xor((int)best[tg][i], 32);
            merge_top16(best[tg], pb);
            if (h == 0) {
                LAS u32x4* dst = (LAS u32x4*)(lists + (tg * 32 + c) * 260 + hs * 16);
#pragma unroll
                for (int i = 0; i < 4; ++i) { u32x4 w; w.x = best[tg][4 * i]; w.y = best[tg][4 * i + 1]; w.z = best[tg][4 * i + 2]; w.w = best[tg][4 * i + 3]; dst[i] = w; }
            }
        }
    }
    __syncthreads();
    {
        const int tl = C.tid & 63, hd = C.tid >> 6;
        const LAS u32* L1 = lists + tl * 260 + hd * 32; const LAS u32* L2 = L1 + 16;
        float v1[16], v2[16];
#pragma unroll
        for (int i = 0; i < 16; ++i) { v1[i] = ord2f(L1[i] & ~0x7Fu); v2[i] = ord2f(L2[i] & ~0x7Fu); }
        u32 cd[4][16];
        { int cid = 0;
#pragma unroll
          for (int a = 0; a < 16; ++a)
#pragma unroll
              for (int b = 0; b < 16; ++b) if ((a + 1) * (b + 1) <= 16) { cd[cid >> 4][cid & 15] = (f2ord(v1[a] + v2[b]) & ~0x3Fu) | (u32)(63 - cid); ++cid; }
#pragma unroll
          for (int k = 50; k < 64; ++k) cd[k >> 4][k & 15] = 0u; }
        top16_of_64(cd[0], cd[1], cd[2], cd[3]);
        float sc[16]; int ix[16]; float mx = -1e30f;
#pragma unroll
        for (int k = 0; k < 16; ++k) {
            const int cid = 63 - (int)(cd[0][k] & 63u); const int ab = CAND_AB[cid];
            const u32 k1 = L1[ab >> 4], k2 = L2[ab & 15];
            sc[k] = ord2f(k1 & ~0x7Fu) + ord2f(k2 & ~0x7Fu);
            ix[k] = (127 - (int)(k1 & 0x7Fu)) * 128 + (127 - (int)(k2 & 0x7Fu));
            mx = fmaxf(mx, sc[k]);
        }
        float sum = 0.f;
#pragma unroll
        for (int k = 0; k < 16; ++k) { sc[k] = __expf(sc[k] - mx); sum += sc[k]; }
        const float inv = 1.0f / sum;
        int* io = IDX + (size_t)(tok0 + tl) * 128 + hd * 16; float* go = GW + (size_t)(tok0 + tl) * 128 + hd * 16;
#pragma unroll
        for (int k = 0; k < 16; k += 4) {
            *(int4*)(io + k) = make_int4(ix[k], ix[k + 1], ix[k + 2], ix[k + 3]);
            f32x4 gv = {sc[k] * inv, sc[k + 1] * inv, sc[k + 2] * inv, sc[k + 3] * inv}; *(f32x4*)(go + k) = gv;
        }
    }
    __syncthreads();
}

template <int J> __device__ __forceinline__ u32 xor_lane(u32 v, int lane) {
    if constexpr (J == 1) return (u32)__builtin_amdgcn_update_dpp(0, (int)v, 0xB1, 0xf, 0xf, true);
    else if constexpr (J == 2) return (u32)__builtin_amdgcn_update_dpp(0, (int)v, 0x4E, 0xf, 0xf, true);
    else if constexpr (J == 4) { int t = __builtin_amdgcn_update_dpp(0, (int)v, 0x104, 0xf, 0x5, false); return (u32)__builtin_amdgcn_update_dpp(t, (int)v, 0x114, 0xf, 0xA, false); }
    else if constexpr (J == 8) return (u32)__builtin_amdgcn_update_dpp(0, (int)v, 0x128, 0xf, 0xf, true);
    else if constexpr (J == 16) { u32 b = v; asm volatile("" : "+v"(b)); const auto p = __builtin_amdgcn_permlane16_swap(v, b, false, false); return (lane & 16) ? p[0] : p[1]; }
    else { u32 b = v; asm volatile("" : "+v"(b)); const auto p = __builtin_amdgcn_permlane32_swap(v, b, false, false); return (lane & 32) ? p[0] : p[1]; }
}
__device__ __forceinline__ int reduce64(int (&r)[64], int lane) {
#pragma unroll
    for (int e = 0; e < 32; ++e) { const auto p = __builtin_amdgcn_permlane32_swap((u32)r[e], (u32)r[e + 32], false, false); r[e] = (int)p[0] + (int)p[1]; }
#pragma unroll
    for (int e = 0; e < 16; ++e) { const auto p = __builtin_amdgcn_permlane16_swap((u32)r[e], (u32)r[e + 16], false, false); r[e] = (int)p[0] + (int)p[1]; }
    const bool b3 = (lane & 8) != 0, b2 = (lane & 4) != 0, b1 = (lane & 2) != 0, b0 = (lane & 1) != 0;
#pragma unroll
    for (int e = 0; e < 8; ++e) { const int keep = b3 ? r[e + 8] : r[e], send = b3 ? r[e] : r[e + 8]; r[e] = keep + __builtin_amdgcn_update_dpp(0, send, 0x128, 0xf, 0xf, true); }
#pragma unroll
    for (int e = 0; e < 4; ++e) { const int keep = b2 ? r[e + 4] : r[e], send = b2 ? r[e] : r[e + 4];
        int t = __builtin_amdgcn_update_dpp(0, send, 0x104, 0xf, 0x5, false);
        t = __builtin_amdgcn_update_dpp(t, send, 0x114, 0xf, 0xA, false);
        r[e] = keep + t; }
#pragma unroll
    for (int e = 0; e < 2; ++e) { const int keep = b1 ? r[e + 2] : r[e], send = b1 ? r[e] : r[e + 2]; r[e] = keep + __builtin_amdgcn_update_dpp(0, send, 0x4E, 0xf, 0xf, true); }
    { const int keep = b0 ? r[1] : r[0], send = b0 ? r[0] : r[1]; r[0] = keep + __builtin_amdgcn_update_dpp(0, send, 0xB1, 0xf, 0xf, true); }
    return r[0];
}
constexpr int GQ_LDS_PER_WAVE = 8192;
#define GQ_FMA16(A, ce, w) do { _Pragma("unroll") for (int j_ = 0; j_ < 4; ++j_) { \
        const f32x2_t lo_ = __builtin_amdgcn_cvt_pk_f32_fp8((int)(w)[j_], false), hi_ = __builtin_amdgcn_cvt_pk_f32_fp8((int)(w)[j_], true); \
        A[4 * j_ + 0] += (ce) * lo_.x; A[4 * j_ + 1] += (ce) * lo_.y; A[4 * j_ + 2] += (ce) * hi_.x; A[4 * j_ + 3] += (ce) * hi_.y; } } while (0)
__device__ __forceinline__ void peer_gather_quad(const Ctx& C, const Params& P, int tokq) {
    const bf16_t* HN = (const bf16_t*)(P.ws + WS_HB); const float* SSH = (const float*)(P.ws + WS_SSH);
    const unsigned char* PU = P.ws + WS_PU; const unsigned char* PV = P.ws + WS_PV;
    const float* SU = (const float*)(P.ws + WS_SU); const float* SV = (const float*)(P.ws + WS_SV);
    const int* IDX = (const int*)(P.ws + WS_IDX); const float* GW = (const float*)(P.ws + WS_GW);
    const int lane = C.lane;
    LAS unsigned char* qhl = C.lds + C.wave * GQ_LDS_PER_WAVE;
    LAS u32* keyl = (LAS u32*)(qhl + 4096);
    u32 k[8];
#pragma unroll
    for (int s = 0; s < 4; ++s)
#pragma unroll
        for (int hb = 0; hb < 2; ++hb) k[2 * s + hb] = ((u32)IDX[(size_t)(tokq + s) * 128 + 64 * hb + lane] << 9) | (u32)(s << 7) | (u32)(64 * hb + lane);
#pragma unroll
    for (int size = 2; size <= 512; size <<= 1) {
#pragma unroll
        for (int j = size >> 1; j > 0; j >>= 1) {
            u32 nk[8];
#pragma unroll
            for (int r = 0; r < 8; ++r) {
                const int ii = lane + 64 * r;
                const bool asc = (ii & size) == 0, lower = (ii & j) == 0;
                const u32 mine = k[r];
                u32 other;
                if (j >= 64) other = k[r ^ (j >> 6)];
                else if (j == 1) other = xor_lane<1>(mine, lane); else if (j == 2) other = xor_lane<2>(mine, lane); else if (j == 4) other = xor_lane<4>(mine, lane);
                else if (j == 8) other = xor_lane<8>(mine, lane); else if (j == 16) other = xor_lane<16>(mine, lane); else other = xor_lane<32>(mine, lane);
                const u32 mn = mine < other ? mine : other, mx = mine < other ? other : mine;
                nk[r] = (lower == asc) ? mn : mx;
            }
#pragma unroll
            for (int r = 0; r < 8; ++r) k[r] = nk[r];
        }
    }
#pragma unroll
    for (int r = 0; r < 8; ++r) keyl[64 * r + lane] = k[r];
    float shs[4];
    f32x4 g2v[4];
#pragma unroll
    for (int j = 0; j < 4; ++j) g2v[j] = *(const f32x4*)(P.in[I_N2G] + 256 * j + 4 * lane);
#pragma unroll
    for (int s = 0; s < 4; ++s) {
        float hf[16]; float m = 0.f;
        const float ssp = (lane < 16) ? SSH[(size_t)(tokq + s) * 16 + lane] : 0.f;
#pragma unroll
        for (int j = 0; j < 4; ++j) { const u32x2 w = *(const u32x2*)(HN + (size_t)(tokq + s) * DM + 256 * j + 4 * lane);
            hf[4 * j] = bflo(w.x) * g2v[j].x; hf[4 * j + 1] = bfhi(w.x) * g2v[j].y; hf[4 * j + 2] = bflo(w.y) * g2v[j].z; hf[4 * j + 3] = bfhi(w.y) * g2v[j].w; }
        const float rinv_t = 1.0f / sqrtf(wave_sum(ssp) * (1.0f / 1024.0f) + EPS);
#pragma unroll
        for (int d = 0; d < 16; ++d) m = fmaxf(m, fabsf(hf[d]));
#pragma unroll
        for (int o = 1; o < 64; o <<= 1) m = fmaxf(m, __shfl_xor(m, o));
        shs[s] = ((m > 0.f) ? m * (1.0f / 127.0f) : 1.0f) * rinv_t; const float inv = (m > 0.f) ? 127.0f / m : 0.f;
        u32x4 q;
#pragma unroll
        for (int j = 0; j < 4; ++j) {
            const int q0 = (int)rintf(hf[4 * j] * inv), q1 = (int)rintf(hf[4 * j + 1] * inv), q2 = (int)rintf(hf[4 * j + 2] * inv), q3 = (int)rintf(hf[4 * j + 3] * inv);
            q[j] = (u32)(q0 & 255) | ((u32)(q1 & 255) << 8) | ((u32)(q2 & 255) << 16) | ((u32)(q3 & 255) << 24);
        }
        *(LAS u32x4*)(qhl + s * 1024 + 16 * lane) = q;
    }
    LDS_WAIT();
    LAS float* cvl = (LAS float*)(qhl + 6144);
#pragma unroll 1
    for (int c = 0; c < 8; ++c) {
        const u32 kk = keyl[64 * c + lane];
        const int e_l = (int)(kk >> 9), slot_l = (int)((kk >> 7) & 3u), pos_l = (int)(kk & 127u);
        const float g_l = GW[(size_t)(tokq + slot_l) * 128 + pos_l], su_l = SU[e_l], sv_l = SV[e_l];
        int r[64];
#pragma unroll
        for (int p = 0; p < 64; ++p) {
            const u32 kp = (u32)__builtin_amdgcn_readlane((int)kk, p);
            const u32x4 w = *(const u32x4*)(PU + (size_t)(kp >> 9) * 1024 + 16 * lane);
            const u32x4 hq = *(const LAS u32x4*)(qhl + ((kp >> 7) & 3u) * 1024 + 16 * lane);
            int a = __builtin_amdgcn_sdot4((int)w.x, (int)hq.x, 0, false);
            a = __builtin_amdgcn_sdot4((int)w.y, (int)hq.y, a, false);
            a = __builtin_amdgcn_sdot4((int)w.z, (int)hq.z, a, false);
            a = __builtin_amdgcn_sdot4((int)w.w, (int)hq.w, a, false);
            r[p] = a;
        }
        const int isum = reduce64(r, lane);
        const float sh_l = (slot_l == 0) ? shs[0] : (slot_l == 1) ? shs[1] : (slot_l == 2) ? shs[2] : shs[3];
        const float z = (float)isum * su_l * sh_l;
        const float c_l = gelu_erf(z) * g_l * sv_l;
        cvl[64 * c + lane] = c_l;
    }
    LDS_WAIT();
    float acc0[16], acc1[16], acc2[16], acc3[16];
#pragma unroll
    for (int d = 0; d < 16; ++d) { acc0[d] = 0.f; acc1[d] = 0.f; acc2[d] = 0.f; acc3[d] = 0.f; }
#define GQ_ISSUE(W, KP, CE, kreg, creg, p0) do { _Pragma("unroll") for (int q = 0; q < 8; ++q) { \
        KP[q] = (u32)__builtin_amdgcn_readlane((int)(kreg), (p0) + q); CE[q] = __uint_as_float((u32)__builtin_amdgcn_readlane((int)__float_as_uint(creg), (p0) + q)); \
        W[q] = *(const u32x4*)(PV + (size_t)(KP[q] >> 9) * 1024 + 16 * lane); } } while (0)
#define GQ_CONSUME(W, KP, CE) do { _Pragma("unroll") for (int q = 0; q < 8; ++q) { const u32 sl = (KP[q] >> 7) & 3u; \
        if (sl == 0u) GQ_FMA16(acc0, CE[q], W[q]); else if (sl == 1u) GQ_FMA16(acc1, CE[q], W[q]); else if (sl == 2u) GQ_FMA16(acc2, CE[q], W[q]); else GQ_FMA16(acc3, CE[q], W[q]); } } while (0)
    {
        u32x4 wA[8], wB[8]; u32 kA[8], kB[8]; float cA[8], cB[8];
        u32 kk = keyl[lane]; float cc = cvl[lane];
        GQ_ISSUE(wA, kA, cA, kk, cc, 0);
#pragma unroll 1
        for (int c = 0; c < 8; ++c) {
            const int cn = (c < 7) ? c + 1 : 7;
            const u32 kkn = keyl[64 * cn + lane]; const float ccn = cvl[64 * cn + lane];
#pragma unroll 1
            for (int p0 = 0; p0 < 64; p0 += 16) {
                GQ_ISSUE(wB, kB, cB, kk, cc, p0 + 8);
                GQ_CONSUME(wA, kA, cA);
                if (p0 < 48) GQ_ISSUE(wA, kA, cA, kk, cc, p0 + 16); else GQ_ISSUE(wA, kA, cA, kkn, ccn, 0);
                GQ_CONSUME(wB, kB, cB);
            }
            kk = kkn; cc = ccn;
        }
    }
#undef GQ_ISSUE
#undef GQ_CONSUME
    u32x2 hw[4][4];
#pragma unroll
    for (int s = 0; s < 4; ++s)
#pragma unroll
        for (int j = 0; j < 4; ++j) hw[s][j] = *(const u32x2*)(HN + (size_t)(tokq + s) * DM + 256 * j + 4 * lane);
#define GQ_OUT(s, A) do { float* orow = P.out + (size_t)(tokq + (s)) * DM; _Pragma("unroll") for (int j = 0; j < 4; ++j) { f32x4* p = (f32x4*)(orow + 256 * j + 4 * lane); \
        f32x4 v; v.x = bflo(hw[s][j].x) + A[4 * j]; v.y = bfhi(hw[s][j].x) + A[4 * j + 1]; v.z = bflo(hw[s][j].y) + A[4 * j + 2]; v.w = bfhi(hw[s][j].y) + A[4 * j + 3]; *p = v; } } while (0)
    GQ_OUT(0, acc0); GQ_OUT(1, acc1); GQ_OUT(2, acc2); GQ_OUT(3, acc3);
#undef GQ_OUT
}
__device__ __forceinline__ void peer_gather_tile(const Ctx& C, const Params& P, int tok0) {
    __syncthreads();
#pragma unroll 1
    for (int hq = 0; hq < 2; ++hq) peer_gather_quad(C, P, tok0 + 32 * hq + 4 * C.wave);
}

#define GAS __attribute__((address_space(1)))
typedef GAS unsigned gu32;
#define RLX_AGENT __ATOMIC_RELAXED, __HIP_MEMORY_SCOPE_AGENT
#define XB_TMO      128
#define XB_XCNT(j)  (256  + 64 * (j))
#define XB_XSUB(j)  (1280 + 64 * (j))
#define XB_XGEN(j)  (2304 + 64 * (j))
#define XB_TOP      3328
#define XB_TOPGEN   3392
#define XCD_BAR_WORDS 3456
#define XB_SPIN_CAP (1u << 18)

__device__ __forceinline__ unsigned xb_ld(unsigned* p)              { return __hip_atomic_load(p, __ATOMIC_RELAXED, __HIP_MEMORY_SCOPE_AGENT); }
__device__ __forceinline__ unsigned xb_add(unsigned* p, unsigned v) { return __hip_atomic_fetch_add(p, v, __ATOMIC_RELAXED, __HIP_MEMORY_SCOPE_AGENT); }
__device__ __forceinline__ unsigned xb_xcc_id() { return (unsigned)__builtin_amdgcn_s_getreg((3 << 11) | 20) & 0xFu; }
#define XB_SPIN(cond, bar) do { unsigned _sp = 0; while (cond) { __builtin_amdgcn_s_sleep(1); \
    if ((++_sp & 255u) == 0u) { if (xb_ld(&(bar)[XB_TMO])) break; if (_sp > XB_SPIN_CAP) { atomicAdd(&(bar)[XB_TMO], 1u); break; } } } } while (0)

struct XcdBarrier {
    unsigned* bar; unsigned x;
    volatile LAS unsigned* st;
};

__device__ __forceinline__ XcdBarrier xcd_barrier_post(unsigned* bar, volatile LAS unsigned* st) {
    XcdBarrier b; b.bar = bar; b.x = xb_xcc_id(); b.st = st;
    if (threadIdx.x == 0) (void)xb_add(&bar[XB_XCNT(b.x)], 1u);
    return b;
}
__device__ __forceinline__ void xcd_barrier_complete(unsigned* bar, unsigned x, unsigned& nloc, unsigned& nx) {
    const unsigned G = gridDim.x * gridDim.y * gridDim.z;
    unsigned sum, cnt, mine, sp = 0u;
    for (;;) {
        sum = 0u; cnt = 0u; mine = 0u;
#pragma unroll
        for (unsigned j = 0; j < 16; ++j) { const unsigned c = xb_ld(&bar[XB_XCNT(j)]); sum += c; cnt += (c > 0u) ? 1u : 0u; mine = (j == x) ? c : mine; }
        if (sum == G) break;
        __builtin_amdgcn_s_sleep(1);
        if ((++sp & 255u) == 0u) { if (xb_ld(&bar[XB_TMO])) break; if (sp > XB_SPIN_CAP) { atomicAdd(&bar[XB_TMO], 1u); break; } }
    }
    nloc = mine > 0u ? mine : 1u; nx = cnt > 0u ? cnt : 1u;
}

__device__ __forceinline__ void xcd_barrier(const XcdBarrier& b) {
    asm volatile("s_waitcnt vmcnt(0)" ::: "memory");
    __syncthreads();
    if (threadIdx.x == 0) {
        unsigned* bar = b.bar;
        __builtin_amdgcn_s_waitcnt(0);
        unsigned nloc = b.st[0], nx = b.st[1];
        if (nloc == 0u) { xcd_barrier_complete(bar, b.x, nloc, nx); b.st[0] = nloc; b.st[1] = nx; }
        const unsigned old = xb_add(&bar[XB_XSUB(b.x)], 1u);
        const unsigned gen = old / nloc;
        if (old + 1u == (gen + 1u) * nloc) {
            __builtin_amdgcn_fence(__ATOMIC_RELEASE, "agent");
            asm volatile("s_waitcnt vmcnt(0)" ::: "memory");
            const unsigned og = xb_add(&bar[XB_TOP], 1u);
            const unsigned tg = og / nx;
            if (og + 1u == (tg + 1u) * nx) xb_add(&bar[XB_TOPGEN], 1u);
            else XB_SPIN(xb_ld(&bar[XB_TOPGEN]) == tg, bar);
            __builtin_amdgcn_fence(__ATOMIC_ACQUIRE, "agent");
            xb_add(&bar[XB_XGEN(b.x)], 1u);
            asm volatile("s_waitcnt vmcnt(0)" ::: "memory");
        } else {
            XB_SPIN(xb_ld(&bar[XB_XGEN(b.x)]) == gen, bar);
            __builtin_amdgcn_fence(__ATOMIC_ACQUIRE, "agent");
            asm volatile("s_waitcnt vmcnt(0)" ::: "memory");
        }
    }
    __syncthreads();
}

constexpr int NPHASE = 9;
__global__ void __launch_bounds__(NTHR, 2) mk_fwd(Params P) {
    extern __shared__ __attribute__((aligned(16))) unsigned char lds_raw[];
    Ctx C; C.lds = (LAS unsigned char*)lds_raw; C.tid = threadIdx.x; C.lane = C.tid & 63; C.wave = __builtin_amdgcn_readfirstlane(C.tid >> 6); C.G = gridDim.x; C.bid = blockIdx.x;
    unsigned char* ws = P.ws;
    volatile LAS unsigned* MISC = (volatile LAS unsigned*)(C.lds + MISC_OFF);
    if (C.tid < 32) MISC[C.tid] = 0u;
    __syncthreads();
    XcdBarrier bar = xcd_barrier_post((unsigned*)(ws + WS_CTL) + 4096, MISC + 8);
#define SEAM(k) do { if (IN(k) && IN((k) + 1)) xcd_barrier(bar); FRESH(); } while (0)
#define FRESH() do { int t_ = (int)threadIdx.x; asm volatile("" : "+v"(t_)); C.tid = t_; C.lane = t_ & 63; } while (0)
#ifdef ONLY_PHASE
#define IN(k) ((k) == ONLY_PHASE && P.ph_lo <= (k) && (k) < P.ph_hi)
#else
#define IN(k) (P.ph_lo <= (k) && (k) < P.ph_hi)
#endif
    if (IN(0)) phase_prologue(C, P);
    SEAM(0);
    if (IN(1)) {
        pg8::Gemm g{(const bf16_t*)(ws + WS_BUFA), (const bf16_t*)(ws + WS_WIN_T), MPAD, INW, DM}; pg8::StaticOrder S; S.init(MPAD, INW, C.G, C.bid);
        pg8::EpiBf16<0> E{(bf16_t*)(ws + WS_PROJ), INW, nullptr, 0, 0, 1.f};
        pg8::gemm_phase<pg8::EpiBf16<0>, pg8::StaticOrder, true, true>(C.lds, g, S, E);
        { const int ntile = (MPAD / 256) * (INW / 256), nbusy = ntile % C.G;
          if (ntile > C.G && nbusy > 0) { if (C.bid >= nbusy) deferred_a(C, P, C.bid - nbusy, C.G - nbusy); }
          else deferred_a(C, P, C.bid, C.G); }
    }
    SEAM(1);
    if (IN(2)) phase_sloc(C, P);
    SEAM(2);
    if (IN(3)) {
        for (int bk = C.bid; bk < 64; bk += C.G) carry_scan_block(C, P, bk);
        for (int u = C.bid; u < 256; u += C.G) attn_unit(C, P, u >> 1, u & 1);
    }
    SEAM(3);
    if (IN(4)) phase_ssm_y(C, P);
    SEAM(4);
    if (IN(5)) {
        pg8::Gemm g{(const bf16_t*)(ws + WS_Z), (const bf16_t*)(ws + WS_GLU_T), SEQ, 512, 512}; pg8::StaticOrder S; S.init(SEQ, 512, C.G, C.bid);
        EpiGlu E{(const bf16_t*)(ws + WS_Z), (bf16_t*)(ws + WS_BUFA), P.in[I_GLUB], (float*)(ws + WS_SSS)};
        pg8::gemm_phase<EpiGlu, pg8::StaticOrder, true, true>(C.lds, g, S, E);
        { const int ntile = (SEQ / 256) * 2;
          if (ntile < C.G) { if (C.bid >= ntile) deferred_b(C, P, C.bid - ntile, C.G - ntile); }
          else deferred_b(C, P, C.bid, C.G); }
    }
    SEAM(5);
    if (IN(6)) {
        __syncthreads();
        if (C.tid < 256) {
            pg8::StaticOrder S0; S0.init(SEQ, DM, C.G, C.bid); pg8::Unit u0; S0.next(0, u0);
            const int row = u0.pm * 256 + C.tid;
            const f32x4* pa = (const f32x4*)((const float*)(ws + WS_SSA) + (size_t)row * 8); const f32x4* ps = (const f32x4*)((const float*)(ws + WS_SSS) + (size_t)row * 8);
            const f32x4 a0 = pa[0], a1 = pa[1], s0 = ps[0], s1 = ps[1];
            const float ra = 1.0f / sqrtf((((a0.x + a0.y) + (a0.z + a0.w)) + ((a1.x + a1.y) + (a1.z + a1.w))) * (1.0f / 512.0f) + EPS);
            const float rs = 1.0f / sqrtf((((s0.x + s0.y) + (s0.z + s0.w)) + ((s1.x + s1.y) + (s1.z + s1.w))) * (1.0f / 512.0f) + EPS);
            LAS float* fac = (LAS float*)(C.lds + FAC_OFF); fac[2 * C.tid] = ra / rs; fac[2 * C.tid + 1] = rs;
        }
        __syncthreads();
        pg8::Gemm g{(const bf16_t*)(ws + WS_BUFA), (const bf16_t*)(ws + WS_WOUT_T), SEQ, DM, DM}; pg8::StaticOrder S; S.init(SEQ, DM, C.G, C.bid);
        EpiMix E{P.in[I_X], (bf16_t*)(ws + WS_HB), (float*)(ws + WS_SSH)};
        pg8::gemm_phase<EpiMix, pg8::StaticOrder, true, true>(C.lds, g, S, E);
    }
    SEAM(6);
    if (IN(7)) {
        pg8::Gemm g{(const bf16_t*)(ws + WS_HB), (const bf16_t*)(ws + WS_WQ_T), SEQ, 2048, DM}; pg8::StaticOrder S; S.init(SEQ, 2048, C.G, C.bid);
        EpiQ E{(bf16_t*)(ws + WS_QP), (const float*)(ws + WS_SSH)};
        pg8::gemm_phase<EpiQ, pg8::StaticOrder, true, true>(C.lds, g, S, E);
    }
    SEAM(7);
    {
    if (IN(8)) {
        for (int tile = C.bid; tile < SEQ / 64; tile += C.G) {
            peer_topk_tile(C, P, tile * 64);
            peer_gather_tile(C, P, tile * 64);
        }
    }
    }
#undef IN
#undef SEAM
}
}

extern "C" void kernel_launch(void* const* d_in, const int* in_sizes, int n_in, void* d_out, int out_size, void* d_ws, size_t ws_size, hipStream_t stream) {
    static int state = 0, grid = 0;
    if (state == 0) {
        if (n_in != 25 || out_size != mk::SEQ * mk::DM || ws_size < mk::WS_END) { fprintf(stderr, "kernel_launch: unexpected shapes (n_in %d out %d ws %zu)\n", n_in, out_size, ws_size); state = -1; return; }
        if (hipFuncSetAttribute((const void*)mk::mk_fwd, hipFuncAttributeMaxDynamicSharedMemorySize, mk::LDS_BYTES) != hipSuccess) { fprintf(stderr, "kernel_launch: hipFuncSetAttribute failed\n"); state = -1; return; }
        int dev = 0, cus = 0, per_cu = 0;
        if (hipGetDevice(&dev) != hipSuccess || hipDeviceGetAttribute(&cus, hipDeviceAttributeMultiprocessorCount, dev) != hipSuccess) { fprintf(stderr, "kernel_launch: device query failed\n"); state = -1; return; }
        if (hipOccupancyMaxActiveBlocksPerMultiprocessor(&per_cu, (const void*)mk::mk_fwd, mk::NTHR, mk::LDS_BYTES) != hipSuccess || per_cu < 1) { fprintf(stderr, "kernel_launch: occupancy query failed (%d)\n", per_cu); state = -1; return; }
        grid = cus;
        state = 1;
    }
    if (state < 0) return;
    mk::Params p{};
    for (int i = 0; i < 25; ++i) p.in[i] = (const float*)d_in[i];
    p.out = (float*)d_out; p.ws = (unsigned char*)d_ws;
    if (hipMemsetAsync((char*)d_ws + mk::WS_CTL, 0, 65536, stream) != hipSuccess) { fprintf(stderr, "kernel_launch: memset failed\n"); return; }
    p.ph_lo = 0; p.ph_hi = mk::NPHASE;
    void* args[] = {&p};
    hipError_t e = hipLaunchCooperativeKernel((const void*)mk::mk_fwd, dim3(grid), dim3(mk::NTHR), args, mk::LDS_BYTES, stream);
    if (e != hipSuccess) fprintf(stderr, "kernel_launch: cooperative launch failed: %s (grid %d)\n", hipGetErrorString(e), grid);
}
```

```cpp
#include <hip/hip_runtime.h>
#include <cstdio>
#include <cstdint>
#include <cmath>
namespace pg8 {
#define PG8_LAS __attribute__((address_space(3)))
typedef unsigned short bf16_t;
typedef short bf16x8 __attribute__((ext_vector_type(8)));
typedef float f32x4 __attribute__((ext_vector_type(4)));
typedef unsigned u32x4 __attribute__((ext_vector_type(4)));
constexpr int BM = 256, BK = 64, HALF = 128, HTB = HALF * BK * 2  , STAGE_BYTES = 8 * HTB, NXCD = 8, WGM = 8;

__host__ __device__ __forceinline__ int lds_byte(int r, int c) { const int st = (r >> 4) * 2 + (c >> 5), rr = r & 15, cc = c & 31, ob = rr * 64 + cc * 2; return st * 1024 + (ob ^ (((ob >> 9) & 1) << 5)); }
__host__ __device__ __forceinline__ void stage_rc(int b, int& R, int& C) { const int st = b / 1024, sb = b % 1024, swz = sb ^ (((sb >> 9) & 1) << 5); R = (st >> 1) * 16 + swz / 64; C = (st & 1) * 32 + (swz % 64) / 2; }
__host__ __device__ __forceinline__ int perm32(int rho) { const int n = rho >> 4, i = rho & 15; return 8 * (i >> 2) + 4 * n + (i & 3); }

struct Unit { int pm, pn; };
struct Gemm { const bf16_t* A; const bf16_t* Bt; int M, N, K; };

struct StaticOrder {
    int nM, nN, nwg, G, c;
    __host__ __device__ __forceinline__ void init(int M, int N, int G_, int c_) { nM = M / BM; nN = N / BM; nwg = nM * nN; G = G_; c = c_; }
    __host__ __device__ __forceinline__ bool next(int i, Unit& u) const {
        const long L = (long)i * G + c; if (L >= nwg) return false;
        int wgid = (int)L; { const int q = nwg / NXCD, r = nwg % NXCD, xcd = wgid % NXCD, off = wgid / NXCD; wgid = (xcd < r ? xcd * (q + 1) : r * (q + 1) + (xcd - r) * q) + off; }
        const int nig = WGM * nN, gid = wgid / nig, fm = gid * WGM, gsz = (nM - fm) < WGM ? (nM - fm) : WGM;
        u.pm = fm + ((wgid % nig) % gsz); u.pn = (wgid % nig) / gsz; return true;
    }
    __device__ __forceinline__ void a_ready(const Unit&) const {}
    __device__ __forceinline__ void done(const Unit&) const {}
};

__device__ __forceinline__ unsigned cvt_pk_bf16(float lo, float hi) { unsigned r; asm volatile("v_cvt_pk_bf16_f32 %0, %1, %2" : "=v"(r) : "v"(lo), "v"(hi)); return r; }
typedef float f32x2 __attribute__((ext_vector_type(2)));
__device__ __forceinline__ f32x2 gelu_pk(f32x2 v) {
    const f32x2 av = __builtin_elementwise_abs(v), d = av * 0.2316418882f + 1.0f;
    f32x2 t; t.x = __builtin_amdgcn_rcpf(d.x); t.y = __builtin_amdgcn_rcpf(d.y);
    f32x2 q = t * 0.5307027145f + (-0.7265760135f); q = q * t + 0.7107068705f; q = q * t + (-0.142248368f); q = q * t + 0.127414796f; q = q * t;
    const f32x2 s = (v * v) * (-0.72134752044f);
    f32x2 e; e.x = __builtin_amdgcn_exp2f(s.x); e.y = __builtin_amdgcn_exp2f(s.y);
    const f32x2 m = v * (q * e), r = v - m;
    f32x2 o; o.x = v.x < 0.f ? m.x : r.x; o.y = v.y < 0.f ? m.y : r.y; return o;
}

template <int ACT  > struct EpiBf16 {
    static constexpr bool PERM = true, AFTER_DRAIN = false, HAS_MID = false; static_assert(ACT == 0 || ACT == 1, "EpiBf16: ACT is 0 (none) or 1 (gelu_pk)");
    bf16_t* O; int ldc; const float* bias; int split_cols; size_t split_stride; float scale0;
    __device__ __forceinline__ void operator()(const f32x4 (&acc)[2][2][4][2], const Unit& u, int wr, int wc, int fr, int fq) const {
        const int row0 = u.pm * BM + wr * 64 + fr; int colt = u.pn * BM; bf16_t* base = O;
        float sc = 1.f; if (split_cols) { const int t = colt / split_cols; base += (size_t)t * split_stride; colt -= t * split_cols; if (t == 0) sc = scale0; }
        const int col0 = colt + wc * 32 + 8 * fq, bcol0 = u.pn * BM + wc * 32 + 8 * fq;
        f32x4 bv[2][2];
#pragma unroll
        for (int bj = 0; bj < 2; ++bj)
#pragma unroll
            for (int n = 0; n < 2; ++n) bv[bj][n] = bias ? *(const f32x4*)(bias + bcol0 + bj * HALF + 4 * n) : (f32x4){0.f, 0.f, 0.f, 0.f};
#pragma unroll
        for (int ai = 0; ai < 2; ++ai)
#pragma unroll
            for (int m = 0; m < 4; ++m) { bf16_t* rowp = base + (size_t)(row0 + ai * HALF + m * 16) * ldc + col0;
#pragma unroll
                for (int bj = 0; bj < 2; ++bj) { f32x4 v0 = acc[ai][bj][m][0] + bv[bj][0], v1 = acc[ai][bj][m][1] + bv[bj][1];
                    if (ACT == 1) { f32x2 a = gelu_pk((f32x2){v0[0], v0[1]}), b = gelu_pk((f32x2){v0[2], v0[3]}), c = gelu_pk((f32x2){v1[0], v1[1]}), d = gelu_pk((f32x2){v1[2], v1[3]});
                        v0 = (f32x4){a.x, a.y, b.x, b.y}; v1 = (f32x4){c.x, c.y, d.x, d.y}; }
                    v0 = v0 * sc; v1 = v1 * sc; u32x4 w; w.x = cvt_pk_bf16(v0[0], v0[1]); w.y = cvt_pk_bf16(v0[2], v0[3]); w.z = cvt_pk_bf16(v1[0], v1[1]); w.w = cvt_pk_bf16(v1[2], v1[3]);
                    *(u32x4*)(rowp + bj * HALF) = w; } }
    }
};
template <class Epi, class Sched, bool ALIGN_EPI = false, bool SP2 = false>
__device__ __forceinline__ void gemm_phase(PG8_LAS unsigned char* lds, const Gemm g, const Sched& S, const Epi& E) {
    const int tid = threadIdx.x, wid = __builtin_amdgcn_readfirstlane(tid >> 6), lane = tid & 63, wr = wid >> 2, wc = wid & 3, fr = lane & 15, fq = lane >> 4;
    const int K = g.K, nt = K / BK;
    unsigned voffA[2], voffB[2];
#pragma unroll
    for (int i = 0; i < 2; ++i) { int R, C; stage_rc(tid * 16 + i * 8192, R, C); const int Rb = Epi::PERM ? ((R & ~31) + perm32(R & 31)) : R;
        voffA[i] = (unsigned)(R * K + C) * 2u; voffB[i] = (unsigned)(Rb * K + C) * 2u; }
    const size_t kstep = (size_t)(BK * 2);
    const size_t hstep = (size_t)HALF * K * 2;
    const size_t tstep = 2 * hstep;
    const unsigned ldsw = (unsigned)wid * 1024u;
    const int aoff = lds_byte(wr * 64 + fr, fq * 8), boff = lds_byte(wc * 32 + fr, fq * 8);
#define PG8_SA(b, h) (((b) * 2 + (h)) * HTB)
#define PG8_SB(b, h) ((4 + (b) * 2 + (h)) * HTB)
#define PG8_STAGE(bufoff, gbase, voff) do { _Pragma("unroll") for (int _i = 0; _i < 2; ++_i) \
        __builtin_amdgcn_global_load_lds((const unsigned*)((const char*)(gbase) + (voff)[_i]), (PG8_LAS unsigned*)(lds + (bufoff) + ldsw + _i * 8192), 16, 0, 0); } while (0)
#define PG8_LDA(dst, b, h) do { _Pragma("unroll") for (int m = 0; m < 4; ++m) _Pragma("unroll") for (int k = 0; k < 2; ++k) dst[m][k] = *(const PG8_LAS bf16x8*)(lds + PG8_SA(b, h) + aoff + m * 2048 + k * 1024); } while (0)
#define PG8_LDB(dst, b, h) do { _Pragma("unroll") for (int n = 0; n < 2; ++n) _Pragma("unroll") for (int k = 0; k < 2; ++k) dst[n][k] = *(const PG8_LAS bf16x8*)(lds + PG8_SB(b, h) + boff + n * 2048 + k * 1024); } while (0)
#define PG8_MMA(ai, bj, At, Bt) do { __builtin_amdgcn_s_setprio(1); _Pragma("unroll") for (int m = 0; m < 4; ++m) _Pragma("unroll") for (int n = 0; n < 2; ++n) _Pragma("unroll") for (int k = 0; k < 2; ++k) \
        acc[ai][bj][m][n] = __builtin_amdgcn_mfma_f32_16x16x32_bf16(Bt[n][k], At[m][k], acc[ai][bj][m][n], 0, 0, 0); __builtin_amdgcn_s_setprio(0); } while (0)
#define PG8_WAIT_V(n) asm volatile("s_waitcnt vmcnt(" #n ")" ::: "memory")
#define PG8_WAIT_L(n) asm volatile("s_waitcnt lgkmcnt(" #n ")" ::: "memory")
#define PG8_BAR __builtin_amdgcn_s_barrier()
#define PG8_SCHED __builtin_amdgcn_sched_barrier(0)
    Unit cur, nxt; int ui = 0;
    if (!S.next(0, cur)) return;
    f32x4 acc[2][2][4][2];
#pragma unroll
    for (int a = 0; a < 2; ++a)
#pragma unroll
        for (int b = 0; b < 2; ++b)
#pragma unroll
            for (int m = 0; m < 4; ++m)
#pragma unroll
                for (int n = 0; n < 2; ++n) acc[a][b][m][n] = (f32x4){0.f, 0.f, 0.f, 0.f};
    bf16x8 At[4][2], B0[2][2], B1[2][2];
    const char* cA = (const char*)g.A + (size_t)cur.pm * tstep; const char* cB = (const char*)g.Bt + (size_t)cur.pn * tstep;
    S.a_ready(cur);
    if constexpr (SP2) {
        PG8_STAGE(PG8_SB(0, 0), cB, voffB); PG8_STAGE(PG8_SB(0, 1), cB + hstep, voffB); PG8_STAGE(PG8_SA(0, 0), cA, voffA); PG8_STAGE(PG8_SA(0, 1), cA + hstep, voffA);
        if (wr == 1) PG8_BAR;
        PG8_WAIT_V(2); PG8_BAR;
        PG8_STAGE(PG8_SB(1, 0), cB + kstep, voffB); PG8_STAGE(PG8_SA(1, 0), cA + kstep, voffA); PG8_STAGE(PG8_SB(1, 1), cB + hstep + kstep, voffB);
        PG8_WAIT_V(6); PG8_BAR;
    } else {
        PG8_STAGE(PG8_SB(0, 0), cB, voffB); PG8_STAGE(PG8_SA(0, 0), cA, voffA); PG8_STAGE(PG8_SB(0, 1), cB + hstep, voffB); PG8_STAGE(PG8_SA(0, 1), cA + hstep, voffA);
        if (wr == 1) PG8_BAR;
        PG8_WAIT_V(4); PG8_BAR;
        PG8_STAGE(PG8_SB(1, 0), cB + kstep, voffB); PG8_STAGE(PG8_SA(1, 0), cA + kstep, voffA); PG8_STAGE(PG8_SB(1, 1), cB + hstep + kstep, voffB);
        PG8_WAIT_V(6); PG8_BAR;
    }
    for (;;) {
        const bool has_next = S.next(ui + 1, nxt);
        const char* nA = has_next ? (const char*)g.A + (size_t)nxt.pm * tstep : cA; const char* nB = has_next ? (const char*)g.Bt + (size_t)nxt.pn * tstep : cB;
        for (int t = 0; t < nt; t += 2) {
            const bool last = (t == nt - 2);
            if constexpr (Epi::HAS_MID) { if (t == nt / 2) E.mid(acc, cur, wr, wc, fr, fq, lds); }
            const char* a1 = cA + (size_t)(t + 1) * kstep;
            const char* a2 = last ? nA : cA + (size_t)(t + 2) * kstep; const char* b2 = last ? nB : cB + (size_t)(t + 2) * kstep;
            const char* a3 = a2 + kstep; const char* b3 = b2 + kstep;
            if (last && has_next) S.a_ready(nxt);
            if constexpr (SP2) {
            PG8_LDB(B0, 0, 0); PG8_LDB(B1, 0, 1); PG8_SCHED; PG8_LDA(At, 0, 0); PG8_STAGE(PG8_SA(1, 1), a1 + hstep, voffA);
            PG8_WAIT_V(8); PG8_WAIT_L(0); PG8_BAR; PG8_MMA(0, 0, At, B0); PG8_MMA(0, 1, At, B1); PG8_BAR; PG8_SCHED;
            PG8_LDA(At, 0, 1); PG8_STAGE(PG8_SB(0, 0), b2, voffB); PG8_STAGE(PG8_SB(0, 1), b2 + hstep, voffB); PG8_STAGE(PG8_SA(0, 0), a2, voffA);
            PG8_WAIT_V(8); PG8_WAIT_L(0); PG8_BAR; PG8_MMA(1, 0, At, B0); PG8_MMA(1, 1, At, B1); PG8_BAR; PG8_SCHED;
            PG8_LDB(B0, 1, 0); PG8_LDB(B1, 1, 1); PG8_SCHED; PG8_LDA(At, 1, 0); PG8_STAGE(PG8_SA(0, 1), a2 + hstep, voffA);
            PG8_WAIT_V(8); PG8_WAIT_L(0); PG8_BAR; PG8_MMA(0, 0, At, B0); PG8_MMA(0, 1, At, B1); PG8_BAR; PG8_SCHED;
            PG8_LDA(At, 1, 1); PG8_STAGE(PG8_SB(1, 0), b3, voffB); PG8_STAGE(PG8_SB(1, 1), b3 + hstep, voffB); PG8_STAGE(PG8_SA(1, 0), a3, voffA);
            PG8_WAIT_V(8); PG8_WAIT_L(0); PG8_BAR; PG8_MMA(1, 0, At, B0); PG8_MMA(1, 1, At, B1); PG8_BAR; PG8_SCHED;
            } else {
            PG8_LDB(B0, 0, 0); PG8_SCHED; PG8_LDA(At, 0, 0); PG8_STAGE(PG8_SA(1, 1), a1 + hstep, voffA);
            PG8_WAIT_L(8); PG8_BAR; PG8_WAIT_L(0); PG8_MMA(0, 0, At, B0); PG8_BAR; PG8_SCHED;
            PG8_LDB(B1, 0, 1); PG8_STAGE(PG8_SB(0, 0), b2, voffB);
            PG8_BAR; PG8_WAIT_L(0); PG8_MMA(0, 1, At, B1); PG8_BAR;
            PG8_LDA(At, 0, 1); PG8_STAGE(PG8_SA(0, 0), a2, voffA);
            PG8_BAR; PG8_WAIT_L(0); PG8_MMA(1, 0, At, B0); PG8_BAR; PG8_SCHED;
            PG8_STAGE(PG8_SB(0, 1), b2 + hstep, voffB);
            PG8_WAIT_V(6); PG8_BAR; PG8_MMA(1, 1, At, B1); PG8_BAR;
            PG8_LDB(B0, 1, 0); PG8_SCHED; PG8_LDA(At, 1, 0); PG8_STAGE(PG8_SA(0, 1), a2 + hstep, voffA);
            PG8_WAIT_L(8); PG8_BAR; PG8_WAIT_L(0); PG8_MMA(0, 0, At, B0); PG8_BAR; PG8_SCHED;
            PG8_LDB(B1, 1, 1); PG8_STAGE(PG8_SB(1, 0), b3, voffB);
            PG8_BAR; PG8_WAIT_L(0); PG8_MMA(0, 1, At, B1); PG8_BAR;
            PG8_LDA(At, 1, 1); PG8_STAGE(PG8_SA(1, 0), a3, voffA);
            PG8_BAR; PG8_WAIT_L(0); PG8_MMA(1, 0, At, B0); PG8_BAR; PG8_SCHED;
            PG8_STAGE(PG8_SB(1, 1), b3 + hstep, voffB);
            PG8_WAIT_V(6); PG8_BAR; PG8_MMA(1, 1, At, B1); PG8_BAR;
            }
        }
        if constexpr (ALIGN_EPI) { if (wr == 0) PG8_BAR; }
        if constexpr (!Epi::AFTER_DRAIN) { E(acc, cur, wr, wc, fr, fq); S.done(cur); }
        if (!has_next) break;
#pragma unroll
        for (int a = 0; a < 2; ++a)
#pragma unroll
            for (int b = 0; b < 2; ++b)
#pragma unroll
                for (int m = 0; m < 4; ++m)
#pragma unroll
                    for (int n = 0; n < 2; ++n) acc[a][b][m][n] = (f32x4){0.f, 0.f, 0.f, 0.f};
        cur = nxt; cA = nA; cB = nB; ++ui;
        if constexpr (ALIGN_EPI) { if (wr == 1) PG8_BAR; }
    }
    PG8_WAIT_V(0);
    if constexpr (!ALIGN_EPI) { if (wr == 0) PG8_BAR; }
    PG8_BAR;
    if constexpr (Epi::AFTER_DRAIN) { E.fused(acc, cur, wr, wc, fr, fq, lds, wid, lane); S.done(cur); }
#undef PG8_SA
#undef PG8_SB
#undef PG8_STAGE
#undef PG8_LDA
#undef PG8_LDB
#undef PG8_MMA
#undef PG8_WAIT_V
#undef PG8_WAIT_L
#undef PG8_BAR
#undef PG8_SCHED
}
}

namespace mk {
#define LAS __attribute__((address_space(3)))
typedef unsigned short bf16_t;
typedef short bf16x8 __attribute__((ext_vector_type(8)));
typedef float f32x4 __attribute__((ext_vector_type(4)));
typedef float f32x16 __attribute__((ext_vector_type(16)));
typedef unsigned u32x4 __attribute__((ext_vector_type(4)));
typedef unsigned u32x2 __attribute__((ext_vector_type(2)));
typedef __bf16 bf16x2_t __attribute__((ext_vector_type(2)));
typedef float f32x2_t __attribute__((ext_vector_type(2)));
typedef unsigned u32;

constexpr int DM = 1024, SEQ = 16384, NMETA = 16, MPAD = 16640, INW = 1280;
constexpr int O_K = 512, O_V = 640, O_U = 768;
constexpr int NCH = 513;
constexpr float EPS = 1e-6f;
constexpr float LOG2E = 1.4426950408889634f;
constexpr int NWAVES = 8, NTHR = 512;
constexpr int LDS_BYTES = 163840;
constexpr int MISC_OFF = LDS_BYTES - 128;

constexpr size_t MiB = 1u << 20;
constexpr size_t WS_CTL = 0, CTL_BYTES = 1 * MiB;
constexpr size_t WS_WIN_T = 1 * MiB;
constexpr size_t WS_WOUT_T = 4 * MiB;
constexpr size_t WS_WQ_T = 6 * MiB;
constexpr size_t WS_GLU_T = 10 * MiB;
constexpr size_t WS_SUBK = 10 * MiB + 512 * 1024;
constexpr size_t WS_KT = 11 * MiB;
constexpr size_t WS_F = 12 * MiB;
constexpr size_t WS_E = 16 * MiB;
constexpr size_t WS_ABART = 20 * MiB;
constexpr size_t WS_SLOC = 21 * MiB;
constexpr size_t WS_CARRY = 30 * MiB;
constexpr size_t WS_BUFA = 39 * MiB;
constexpr size_t WS_PROJ = 72 * MiB;
constexpr size_t WS_ATTN = 113 * MiB;
constexpr size_t WS_Z = 129 * MiB;
constexpr size_t WS_SSMO = 145 * MiB;
constexpr size_t WS_QP = 72 * MiB;
constexpr size_t WS_IDX = 161 * MiB;
constexpr size_t WS_GW = 169 * MiB;
constexpr size_t WS_PU = 177 * MiB;
constexpr size_t WS_PV = 193 * MiB;
constexpr size_t WS_SU = 209 * MiB;
constexpr size_t WS_SV = 209 * MiB + 65536;
constexpr size_t WS_HB = 210 * MiB;
constexpr size_t WS_SSA = 242 * MiB;
constexpr size_t WS_SSS = 242 * MiB + 512 * 1024;
constexpr size_t WS_SSH = 243 * MiB;
constexpr size_t WS_END = 245 * MiB;

struct Params { const float* in[25]; float* out; unsigned char* ws; int ph_lo, ph_hi; };
enum { I_X = 0, I_META, I_N1G, I_WIN, I_QNG, I_KNG, I_SINK, I_ARE, I_AIM, I_LDT, I_BRE, I_BIM, I_CRE, I_CIM, I_SD, I_GLUW, I_GLUB, I_AOG, I_SOG, I_WOUT, I_N2G, I_WQ, I_SUBK, I_PU, I_PV };

__device__ __forceinline__ unsigned pk2(float lo, float hi) { f32x2_t v = {lo, hi}; return __builtin_bit_cast(unsigned, __builtin_convertvector(v, bf16x2_t)); }
__device__ __forceinline__ float bflo(unsigned w) { return __uint_as_float(w << 16); }
__device__ __forceinline__ float bfhi(unsigned w) { return __uint_as_float(w & 0xffff0000u); }
__device__ __forceinline__ float wave_sum(float v) {
#pragma unroll
    for (int o = 1; o < 64; o <<= 1) v += __shfl_xor(v, o);
    return v;
}
#define LDS_WAIT() asm volatile("s_waitcnt lgkmcnt(0)" ::: "memory")
__device__ __forceinline__ float gelu_erf(float v) { return 0.5f * v * (1.0f + erff(v * 0.70710678118654752f)); }
__device__ __forceinline__ u32 f2ord(float f) { const u32 u = __float_as_uint(f); return (u & 0x80000000u) ? ~u : (u | 0x80000000u); }
__device__ __forceinline__ float ord2f(u32 o) { const u32 u = (o & 0x80000000u) ? (o & 0x7fffffffu) : ~o; return __uint_as_float(u); }
#define MFMA16(a, b, c) __builtin_amdgcn_mfma_f32_16x16x32_bf16((a), (b), (c), 0, 0, 0)
#define MFMA32(a, b, c) __builtin_amdgcn_mfma_f32_32x32x16_bf16((a), (b), (c), 0, 0, 0)

#define CEX(x, i, j) do { const u32 _a = x[i], _b = x[j]; x[i] = _a > _b ? _a : _b; x[j] = _a > _b ? _b : _a; } while (0)
__device__ __forceinline__ void sort16_desc(u32 (&x)[16]) {
#pragma unroll
    for (int k = 2; k <= 16; k <<= 1) {
#pragma unroll
        for (int j = k >> 1; j > 0; j >>= 1) {
#pragma unroll
            for (int i = 0; i < 16; ++i) { const int l = i ^ j; if (l > i) { if ((i & k) == 0) CEX(x, i, l); else CEX(x, l, i); } }
        }
    }
}
__device__ __forceinline__ void bmerge16_desc(u32 (&x)[16]) {
#pragma unroll
    for (int j = 8; j > 0; j >>= 1) {
#pragma unroll
        for (int i = 0; i < 16; ++i) { const int l = i ^ j; if (l > i) CEX(x, i, l); }
    }
}
__device__ __forceinline__ void merge_top16(u32 (&a)[16], const u32 (&b)[16]) {
#pragma unroll
    for (int i = 0; i < 16; ++i) a[i] = a[i] > b[15 - i] ? a[i] : b[15 - i];
    bmerge16_desc(a);
}
__device__ __forceinline__ void top16_of_64(u32 (&g0)[16], u32 (&g1)[16], u32 (&g2)[16], u32 (&g3)[16]) {
    sort16_desc(g0); sort16_desc(g1); sort16_desc(g2); sort16_desc(g3);
    merge_top16(g0, g1); merge_top16(g2, g3); merge_top16(g0, g2);
}
__device__ const unsigned char CAND_AB[64] = {0, 1, 2, 3, 4, 5, 6, 7, 8, 9, 10, 11, 12, 13, 14, 15, 16, 17, 18, 19, 20, 21, 22, 23, 32, 33, 34, 35, 36, 48, 49, 50, 51, 64, 65, 66, 80, 81, 96, 97, 112, 113, 128, 144, 160, 176, 192, 208, 224, 240, 0, 0, 0, 0, 0, 0, 0, 0, 0, 0, 0, 0, 0, 0};

struct Ctx { LAS unsigned char* lds; int tid, lane, wave, G, bid; };

__device__ __forceinline__ void transpose_item(const float* W, int K, int N, bf16_t* WT, LAS float* scr, int item, int lane, const float* ks0 = nullptr, const float* ks1 = nullptr, int ksplit = 0) {
    const int nblk = N / 32, kb = item / nblk, nb = item % nblk, k0 = 64 * kb, n0 = 32 * nb;
#pragma unroll 8
    for (int i = 0; i < 32; ++i) { const int kk = 2 * i + (lane >> 5); float w = W[(size_t)(k0 + kk) * N + n0 + (lane & 31)];
        if (ks0) { const int k = k0 + kk; w *= (ksplit && k >= ksplit) ? ks1[k - ksplit] : ks0[k]; }
        scr[kk * 33 + (lane & 31)] = w; }
    LDS_WAIT();
    const int c = lane & 7;
#pragma unroll
    for (int j = 0; j < 4; ++j) { const int n = (lane >> 3) + 8 * j; const LAS float* s = scr + (8 * c) * 33 + n;
        u32x4 o; o.x = pk2(s[0 * 33], s[1 * 33]); o.y = pk2(s[2 * 33], s[3 * 33]); o.z = pk2(s[4 * 33], s[5 * 33]); o.w = pk2(s[6 * 33], s[7 * 33]);
        *(u32x4*)(WT + (size_t)(n0 + n) * K + k0 + 8 * c) = o; }
    LDS_WAIT();
}

__device__ __forceinline__ void ssm_tables(const Ctx& C, const Params& P, int g) {
    LAS float* pwr = (LAS float*)C.lds;
    LAS float* pwi = pwr + 33 * 64;
    LAS float* bbr = pwi + 33 * 64;
    LAS float* bbi = bbr + 1024;
    LAS float* ccr = bbi + 1024;
    LAS float* cci = ccr + 1024;
    LAS float* cfr = cci + 1024;
    LAS float* cfi = cfr + 64;
    const int tid = C.tid;
    const float dt = expf(P.in[I_LDT][g]);
    for (int e = tid; e < 33 * 64; e += NTHR) {
        const int l = e >> 6, n = e & 63;
        const float lr = P.in[I_ARE][g * 64 + n], li = P.in[I_AIM][g * 64 + n];
        const float x = lr * dt * (float)l, th = li * dt * (float)l, mag = expf(x);
        float s, c; sincosf(th, &s, &c);
        pwr[e] = mag * c; pwi[e] = mag * s;
        if (l == 32) { float* abt = (float*)(P.ws + WS_ABART) + (g * 64 + n) * 2; abt[0] = mag * c; abt[1] = mag * s; }
    }
    if (tid < 64) {
        const int n = tid;
        const float lr = P.in[I_ARE][g * 64 + n], li = P.in[I_AIM][g * 64 + n];
        const float x1 = lr * dt, th1 = li * dt, em1 = expm1f(x1);
        float s1, c1; sincosf(th1, &s1, &c1);
        const float sh = sinf(0.5f * th1);
        const float nr = em1 * c1 - 2.0f * sh * sh, ni = (em1 + 1.0f) * s1;
        const float den = lr * lr + li * li;
        cfr[n] = (nr * lr + ni * li) / den; cfi[n] = (ni * lr - nr * li) / den;
    }
    __syncthreads();
    for (int e = tid; e < 1024; e += NTHR) {
        const int n = e >> 4;
        const float br = P.in[I_BRE][g * 1024 + e], bi = P.in[I_BIM][g * 1024 + e];
        bbr[e] = cfr[n] * br - cfi[n] * bi; bbi[e] = cfr[n] * bi + cfi[n] * br;
        ccr[e] = P.in[I_CRE][g * 1024 + e]; cci[e] = P.in[I_CIM][g * 1024 + e];
    }
    __syncthreads();
    bf16_t* Kt = (bf16_t*)(P.ws + WS_KT) + (size_t)g * 8448;
    {
        const int pq = tid & 255, p = pq >> 4, q = pq & 15, l0 = (tid >> 8) * 16;
        float val[16];
#pragma unroll
        for (int i = 0; i < 16; ++i) val[i] = 0.f;
#pragma unroll
        for (int n0 = 0; n0 < 64; n0 += 16) {
            float cbr[16], cbi[16];
#pragma unroll
            for (int n = 0; n < 16; ++n) { const float cr = ccr[p * 64 + n0 + n], ci = cci[p * 64 + n0 + n], br = bbr[(n0 + n) * 16 + q], bi = bbi[(n0 + n) * 16 + q]; cbr[n] = cr * br - ci * bi; cbi[n] = cr * bi + ci * br; }
#pragma unroll
            for (int i = 0; i < 16; ++i) {
                const int lg = l0 + i;
#pragma unroll
                for (int n = 0; n < 16; n += 4) {
                    const f32x4 ar = *(const LAS f32x4*)(pwr + lg * 64 + n0 + n), ai = *(const LAS f32x4*)(pwi + lg * 64 + n0 + n);
                    val[i] += cbr[n] * ar.x - cbi[n] * ai.x; val[i] += cbr[n + 1] * ar.y - cbi[n + 1] * ai.y; val[i] += cbr[n + 2] * ar.z - cbi[n + 2] * ai.z; val[i] += cbr[n + 3] * ar.w - cbi[n + 3] * ai.w;
                }
            }
        }
#pragma unroll
        for (int i = 0; i < 16; ++i) Kt[(l0 + i + 1) * 256 + pq] = (bf16_t)(pk2(val[i], 0.f) & 0xffffu);
        if (tid < 256) Kt[tid] = 0;
    }
    bf16_t* F = (bf16_t*)(P.ws + WS_F) + (size_t)g * 65536;
    for (int e8 = tid; e8 < 8192; e8 += NTHR) {
        const int n2 = e8 >> 6, k0 = (e8 & 63) * 8, j = k0 >> 4, q0 = k0 & 15, n = n2 & 63, l = 31 - j;
        const float ar = pwr[l * 64 + n], ai = pwi[l * 64 + n];
        float w[8];
#pragma unroll
        for (int i = 0; i < 8; ++i) { const float br = bbr[n * 16 + q0 + i], bi = bbi[n * 16 + q0 + i]; w[i] = (n2 < 64) ? (ar * br - ai * bi) : (ar * bi + ai * br); }
        u32x4 o; o.x = pk2(w[0], w[1]); o.y = pk2(w[2], w[3]); o.z = pk2(w[4], w[5]); o.w = pk2(w[6], w[7]);
        *(u32x4*)(F + (size_t)e8 * 8) = o;
    }
    bf16_t* E = (bf16_t*)(P.ws + WS_E) + (size_t)g * 65536;
    for (int e8 = tid; e8 < 8192; e8 += NTHR) {
        const int row = e8 >> 4, n20 = (e8 & 15) * 8, t = row >> 4, p = row & 15, n0 = n20 & 63;
        float w[8];
#pragma unroll
        for (int i = 0; i < 8; ++i) { const int n = n0 + i; const float pr = pwr[(t + 1) * 64 + n], pi = pwi[(t + 1) * 64 + n], cr = ccr[p * 64 + n], ci = cci[p * 64 + n];
            w[i] = (n20 < 64) ? (cr * pr - ci * pi) : -(cr * pi + ci * pr); }
        u32x4 o; o.x = pk2(w[0], w[1]); o.y = pk2(w[2], w[3]); o.z = pk2(w[4], w[5]); o.w = pk2(w[6], w[7]);
        *(u32x4*)(E + (size_t)e8 * 8) = o;
    }
    __syncthreads();
}

__device__ __forceinline__ void norm_row_to_bf16(const float* src, const float* gam, bf16_t* dst, int lane) {
    const f32x4* xr = (const f32x4*)src + lane; const f32x4* gr = (const f32x4*)gam + lane;
    f32x4 v[4]; float s = 0.f;
#pragma unroll
    for (int j = 0; j < 4; ++j) { v[j] = xr[64 * j]; s += (v[j].x * v[j].x + v[j].y * v[j].y) + (v[j].z * v[j].z + v[j].w * v[j].w); }
    const float rinv = 1.0f / sqrtf(wave_sum(s) * (1.0f / DM) + EPS);
    u32x2* o = (u32x2*)dst + lane;
#pragma unroll
    for (int j = 0; j < 4; ++j) { const f32x4 g = gr[64 * j]; u32x2 w; w.x = pk2(v[j].x * rinv * g.x, v[j].y * rinv * g.y); w.y = pk2(v[j].z * rinv * g.z, v[j].w * rinv * g.w); o[64 * j] = w; }
}

__device__ __forceinline__ void cvt8(const float* src, bf16_t* dst, size_t i) {
    const f32x4 a = ((const f32x4*)src)[2 * i], b = ((const f32x4*)src)[2 * i + 1];
    u32x4 o; o.x = pk2(a.x, a.y); o.y = pk2(a.z, a.w); o.z = pk2(b.x, b.y); o.w = pk2(b.z, b.w);
    ((u32x4*)dst)[i] = o;
}

__device__ __forceinline__ float wave_max(float m) {
    m = fmaxf(m, __builtin_bit_cast(float, __builtin_amdgcn_update_dpp(0, __builtin_bit_cast(int, m), 0xB1, 0xf, 0xf, true)));
    m = fmaxf(m, __builtin_bit_cast(float, __builtin_amdgcn_update_dpp(0, __builtin_bit_cast(int, m), 0x4E, 0xf, 0xf, true)));
    m = fmaxf(m, __builtin_bit_cast(float, __builtin_amdgcn_update_dpp(0, __builtin_bit_cast(int, m), 0x141, 0xf, 0xf, true)));
    m = fmaxf(m, __builtin_bit_cast(float, __builtin_amdgcn_update_dpp(0, __builtin_bit_cast(int, m), 0x140, 0xf, 0xf, true)));
    u32 x = __builtin_bit_cast(u32, m);
    { u32 b = x; asm volatile("" : "+v"(b)); const auto p = __builtin_amdgcn_permlane16_swap(x, b, false, false); x = p[0] > p[1] ? p[0] : p[1]; }
    { u32 b = x; asm volatile("" : "+v"(b)); const auto p = __builtin_amdgcn_permlane32_swap(x, b, false, false); x = p[0] > p[1] ? p[0] : p[1]; }
    m = __builtin_bit_cast(float, x);
    return m;
}
template <int NR> __device__ __forceinline__ void quant_rows(const Params& P, const int (&rr)[NR], int lane) {
    f32x4 v[NR][4]; float m[NR];
#pragma unroll
    for (int i = 0; i < NR; ++i) {
        const bool isv = rr[i] >= 16384; const int row = isv ? rr[i] - 16384 : rr[i];
        const f32x4* src = (const f32x4*)((isv ? P.in[I_PV] : P.in[I_PU]) + (size_t)row * DM) + lane;
#pragma unroll
        for (int j = 0; j < 4; ++j) v[i][j] = __builtin_nontemporal_load(src + 64 * j);
    }
#pragma unroll
    for (int i = 0; i < NR; ++i) {
        float mm = 0.f;
#pragma unroll
        for (int j = 0; j < 4; ++j) mm = fmaxf(mm, fmaxf(fmaxf(fabsf(v[i][j].x), fabsf(v[i][j].y)), fmaxf(fabsf(v[i][j].z), fabsf(v[i][j].w))));
        m[i] = wave_max(mm);
    }
#pragma unroll
    for (int i = 0; i < NR; ++i) {
        const bool isv = rr[i] >= 16384; const int row = isv ? rr[i] - 16384 : rr[i];
        const float top = isv ? 416.0f : 127.0f;
        const float sc = (m[i] > 0.f) ? m[i] / top : 1.0f, inv = (m[i] > 0.f) ? top / m[i] : 0.f;
        u32x4 w;
#pragma unroll
        for (int j = 0; j < 4; ++j) {
            if (isv) {
                int t = __builtin_amdgcn_cvt_pk_fp8_f32(v[i][j].x * inv, v[i][j].y * inv, 0, false);
                t = __builtin_amdgcn_cvt_pk_fp8_f32(v[i][j].z * inv, v[i][j].w * inv, t, true);
                w[j] = (u32)t;
            } else {
                const int q0 = (int)rintf(v[i][j].x * inv), q1 = (int)rintf(v[i][j].y * inv), q2 = (int)rintf(v[i][j].z * inv), q3 = (int)rintf(v[i][j].w * inv);
                w[j] = (u32)(q0 & 255) | ((u32)(q1 & 255) << 8) | ((u32)(q2 & 255) << 16) | ((u32)(q3 & 255) << 24);
            }
        }
        *(u32x4*)(P.ws + (isv ? WS_PV : WS_PU) + (size_t)row * 1024 + 16 * lane) = w;
        if (lane == 0) ((float*)(P.ws + (isv ? WS_SV : WS_SU)))[row] = sc;
    }
}
template <int NR> __device__ __forceinline__ void xn_rows(const Params& P, const int (&mm)[NR], int lane) {
    bf16_t* xn = (bf16_t*)(P.ws + WS_BUFA);
    f32x4 v[NR][4]; f32x4 g[4];
#pragma unroll
    for (int j = 0; j < 4; ++j) g[j] = ((const f32x4*)P.in[I_N1G])[64 * j + lane];
#pragma unroll
    for (int i = 0; i < NR; ++i) {
        const int m = mm[i];
        const float* src = (m < SEQ) ? P.in[I_X] + (size_t)m * DM : P.in[I_META] + (size_t)((m < SEQ + NMETA) ? (m - SEQ) : 0) * DM;
#pragma unroll
        for (int j = 0; j < 4; ++j) v[i][j] = ((const f32x4*)src)[64 * j + lane];
    }
#pragma unroll
    for (int i = 0; i < NR; ++i) {
        const int m = mm[i];
        float ss = 0.f;
#pragma unroll
        for (int j = 0; j < 4; ++j) ss += (v[i][j].x * v[i][j].x + v[i][j].y * v[i][j].y) + (v[i][j].z * v[i][j].z + v[i][j].w * v[i][j].w);
        float rinv = 1.0f / sqrtf(wave_sum(ss) * (1.0f / DM) + EPS);
        if (m >= SEQ + NMETA) rinv = 0.f;
        u32x2* o = (u32x2*)(xn + (size_t)m * DM) + lane;
#pragma unroll
        for (int j = 0; j < 4; ++j) { u32x2 w; w.x = pk2(v[i][j].x * rinv * g[j].x, v[i][j].y * rinv * g[j].y); w.y = pk2(v[i][j].z * rinv * g[j].z, v[i][j].w * rinv * g[j].w); o[64 * j] = w; }
    }
}
__device__ __forceinline__ void phase_prologue(const Ctx& C, const Params& P) {
    LAS float* scr = (LAS float*)(C.lds + C.wave * 16384);
    const int gw = C.bid * NWAVES + C.wave, NGW = C.G * NWAVES;
    for (int it = gw; it < 16 * 40; it += NGW) transpose_item(P.in[I_WIN], 1024, 1280, (bf16_t*)(P.ws + WS_WIN_T), scr, it, C.lane);
    for (int m = gw; m < MPAD; m += 4 * NGW) {
        if (m + 3 * NGW < MPAD) { const int mm[4] = {m, m + NGW, m + 2 * NGW, m + 3 * NGW}; xn_rows<4>(P, mm, C.lane); }
        else { for (int q = m; q < MPAD; q += NGW) { const int mm[1] = {q}; xn_rows<1>(P, mm, C.lane); } }
    }
}
__device__ __forceinline__ void deferred_a(const Ctx& C0, const Params& P, int ib, int nib) {
    Ctx C = C0; asm volatile("" : "+v"(C.tid), "+v"(C.lane));
    __syncthreads();
    const int nssm = (nib >= 64) ? 32 : 0;
    if (!nssm || ib < 32) { for (int g = ib; g < 32; g += (nssm ? 32 : nib)) ssm_tables(C, P, g); }
    if (nssm && ib < 32) return;
    __syncthreads();
    LAS float* scr = (LAS float*)(C.lds + C.wave * 16384);
    const int gw = (ib - nssm) * NWAVES + C.wave, NGW = (nib - nssm) * NWAVES;
    for (int it = gw; it < 8 * 16; it += NGW) transpose_item(P.in[I_GLUW], 512, 512, (bf16_t*)(P.ws + WS_GLU_T), scr, it, C.lane);
    for (int r = gw; r < 2 * 16384; r += 4 * NGW) {
        if (r + 3 * NGW < 2 * 16384) { const int rr[4] = {r, r + NGW, r + 2 * NGW, r + 3 * NGW}; quant_rows<4>(P, rr, C.lane); }
        else { for (int q = r; q < 2 * 16384; q += NGW) { const int rr[1] = {q}; quant_rows<1>(P, rr, C.lane); } }
    }
    const size_t gt = (size_t)(ib - nssm) * NTHR + C.tid, NT = (size_t)(nib - nssm) * NTHR;
    for (size_t i = gt; i < 262144 / 8; i += NT) cvt8(P.in[I_SUBK], (bf16_t*)(P.ws + WS_SUBK), i);
}
__device__ __forceinline__ void deferred_b(const Ctx& C0, const Params& P, int ib, int nib) {
    Ctx C = C0; asm volatile("" : "+v"(C.tid), "+v"(C.lane));
    __syncthreads();
    LAS float* scr = (LAS float*)(C.lds + C.wave * 16384);
    const int gw = ib * NWAVES + C.wave, NGW = nib * NWAVES;
    constexpr int I_OUT = 16 * 32, I_Q = 16 * 64;
    for (int it = gw; it < I_OUT + I_Q; it += NGW) {
        if (it < I_OUT) transpose_item(P.in[I_WOUT], 1024, 1024, (bf16_t*)(P.ws + WS_WOUT_T), scr, it, C.lane, P.in[I_AOG], P.in[I_SOG], 512);
        else transpose_item(P.in[I_WQ], 1024, 2048, (bf16_t*)(P.ws + WS_WQ_T), scr, it - I_OUT, C.lane, P.in[I_N2G]);
    }
}

__device__ __forceinline__ bf16x8 u_frag(const bf16_t* proj, int ci, int j, int g, int half) {
    const bool ok = (ci == 0) ? (j >= 16) : (ci < NCH);
    int row = (ci == 0) ? (SEQ + j - 16) : ((ci - 1) * 32 + j);
    row = ok ? row : 0;
    const u32x4 w = *(const u32x4*)(proj + (size_t)row * INW + O_U + g * 16 + half * 8);
    u32x4 z; z.x = ok ? w.x : 0u; z.y = ok ? w.y : 0u; z.z = ok ? w.z : 0u; z.w = ok ? w.w : 0u;
    return __builtin_bit_cast(bf16x8, z);
}

constexpr int F_PITCH = 1040;
__device__ __forceinline__ void phase_sloc(const Ctx& C, const Params& P) {
    const bf16_t* proj = (const bf16_t*)(P.ws + WS_PROJ);
    float* SL = (float*)(P.ws + WS_SLOC);
    const int n = C.lane & 15, kq = C.lane >> 4;
    for (int bu = C.bid; bu < 160; bu += C.G) {
        const int g = bu / 5, qtr = bu % 5, s = qtr * 8 + C.wave, ci = 16 * s + n;
        bf16x8 Bf[16];
#pragma unroll
        for (int ks = 0; ks < 16; ++ks) Bf[ks] = u_frag(proj, (s < 33) ? ci : NCH, 2 * ks + (kq >> 1), g, kq & 1);
        __syncthreads();
        { const u32x4* src = (const u32x4*)((const bf16_t*)(P.ws + WS_F) + (size_t)g * 65536);
          u32x4 t[16];
#pragma unroll
          for (int i = 0; i < 16; ++i) t[i] = src[C.tid + NTHR * i];
#pragma unroll
          for (int i = 0; i < 16; ++i) { const int e = C.tid + NTHR * i; *(LAS u32x4*)(C.lds + (e >> 6) * F_PITCH + (e & 63) * 16) = t[i]; } }
        __syncthreads();
        if (s < 33) {
#pragma unroll 1
            for (int mt = 0; mt < 8; ++mt) {
                f32x4 acc = {0.f, 0.f, 0.f, 0.f};
#pragma unroll
                for (int ks = 0; ks < 16; ++ks) {
                    const bf16x8 A = *(const LAS bf16x8*)(C.lds + (mt * 16 + n) * F_PITCH + (32 * ks + 8 * kq) * 2);
                    acc = MFMA16(A, Bf[ks], acc);
                }
                if (ci < NCH) *(f32x4*)(SL + ((size_t)ci * 32 + g) * 128 + mt * 16 + 4 * kq) = acc;
            }
        }
    }
}

__device__ __forceinline__ void carry_scan_block(const Ctx& C, const Params& P, int bk) {
    const float* SL = (const float*)(P.ws + WS_SLOC);
    float* CA = (float*)(P.ws + WS_CARRY);
    LAS float* Lr = (LAS float*)C.lds;
    LAS float* Li = Lr + 512;
    const int chan = bk * 32 + (C.tid & 31), g = chan >> 6, n = chan & 63, sg = C.tid >> 5;
    const float* abt = (const float*)(P.ws + WS_ABART) + (g * 64 + n) * 2;
    const float ar = abt[0], ai = abt[1];
    float sr = 0.f, si = 0.f;
#pragma unroll 8
    for (int i = 0; i < 32; ++i) {
        const int ci = 32 * sg + i; const size_t o = ((size_t)ci * 32 + g) * 128 + n;
        const float br = SL[o], bi = SL[o + 64];
        const float tr = ar * sr - ai * si + br, ti = ar * si + ai * sr + bi; sr = tr; si = ti;
    }
    Lr[sg * 32 + (C.tid & 31)] = sr; Li[sg * 32 + (C.tid & 31)] = si;
    float pr = ar, pi = ai;
#pragma unroll
    for (int k = 0; k < 5; ++k) { const float tr = pr * pr - pi * pi, ti = 2.f * pr * pi; pr = tr; pi = ti; }
    __syncthreads();
    float cr = 0.f, ci_ = 0.f;
    for (int s2 = 0; s2 < sg; ++s2) { const float lr = Lr[s2 * 32 + (C.tid & 31)], li = Li[s2 * 32 + (C.tid & 31)];
        const float tr = pr * cr - pi * ci_ + lr, ti = pr * ci_ + pi * cr + li; cr = tr; ci_ = ti; }
    sr = cr; si = ci_;
#pragma unroll 8
    for (int i = 0; i < 32; ++i) {
        const int ci = 32 * sg + i; const size_t o = ((size_t)ci * 32 + g) * 128 + n;
        CA[o] = sr; CA[o + 64] = si;
        const float br = SL[o], bi = SL[o + 64];
        const float tr = ar * sr - ai * si + br, ti = ar * si + ai * sr + bi; sr = tr; si = ti;
    }
    if (sg == 15) { const size_t o = ((size_t)512 * 32 + g) * 128 + n; CA[o] = sr; CA[o + 64] = si; }
    __syncthreads();
}

constexpr int E_OFF = 16896, E_PITCH = 272;
__device__ __forceinline__ void phase_ssm_y(const Ctx& C, const Params& P) {
    const bf16_t* proj = (const bf16_t*)(P.ws + WS_PROJ);
    const float* CA = (const float*)(P.ws + WS_CARRY);
    bf16_t* Z = (bf16_t*)(P.ws + WS_Z);
    const int n = C.lane & 15, kq = C.lane >> 4;
    for (int bu = C.bid; bu < 256; bu += C.G) {
        const int g = bu >> 3, cq = bu & 7;
        __syncthreads();
        { const u32x4* src = (const u32x4*)((const bf16_t*)(P.ws + WS_KT) + (size_t)g * 8448); LAS u32x4* dst = (LAS u32x4*)C.lds;
          for (int e = C.tid; e < 1056; e += NTHR) dst[e] = src[e];
          const u32x4* esrc = (const u32x4*)((const bf16_t*)(P.ws + WS_E) + (size_t)g * 65536);
          u32x4 t[16];
#pragma unroll
          for (int i = 0; i < 16; ++i) t[i] = esrc[C.tid + NTHR * i];
#pragma unroll
          for (int i = 0; i < 16; ++i) { const int e = C.tid + NTHR * i; *(LAS u32x4*)(C.lds + E_OFF + (e >> 4) * E_PITCH + (e & 15) * 16) = t[i]; } }
        __syncthreads();
        const int ci = 1 + 64 * cq + 16 * (C.wave >> 1) + n, par = C.wave & 1;
        bf16x8 Uf[16], Cf[4];
#pragma unroll
        for (int ks = 0; ks < 16; ++ks) Uf[ks] = u_frag(proj, ci, 2 * ks + (kq >> 1), g, kq & 1);
#pragma unroll
        for (int k2 = 0; k2 < 4; ++k2) {
            const float* cp = CA + ((size_t)ci * 32 + g) * 128 + 32 * k2 + 8 * kq;
            const f32x4 a = *(const f32x4*)cp, b = *(const f32x4*)(cp + 4);
            u32x4 w; w.x = pk2(a.x, a.y); w.y = pk2(a.z, a.w); w.z = pk2(b.x, b.y); w.w = pk2(b.z, b.w);
            Cf[k2] = __builtin_bit_cast(bf16x8, w);
        }
        const f32x4 dv = *(const f32x4*)(P.in[I_SD] + g * 16 + 4 * kq);
#pragma unroll 1
        for (int tt = 0; tt < 16; ++tt) {
            const int t = 2 * tt + par;
            f32x4 acc = {0.f, 0.f, 0.f, 0.f};
#pragma unroll
            for (int k2 = 0; k2 < 4; ++k2) {
                const bf16x8 A = *(const LAS bf16x8*)(C.lds + E_OFF + (t * 16 + n) * E_PITCH + (32 * k2 + 8 * kq) * 2);
                acc = MFMA16(A, Cf[k2], acc);
            }
#pragma unroll
            for (int ks = 0; ks < 16; ++ks) {
                if (ks <= tt) {
                    const int li = t - 2 * ks - (kq >> 1) + 1;
                    const bf16x8 A = *(const LAS bf16x8*)(C.lds + ((li * 16 + n) * 16 + 8 * (kq & 1)) * 2);
                    acc = MFMA16(A, Uf[ks], acc);
                }
            }
            const int row = (ci - 1) * 32 + t, ch = g * 16 + 4 * kq;
            const u32x2 uw = *(const u32x2*)(proj + (size_t)row * INW + O_U + ch);
            const float y0 = acc.x + dv.x * bflo(uw.x), y1 = acc.y + dv.y * bfhi(uw.x), y2 = acc.z + dv.z * bflo(uw.y), y3 = acc.w + dv.w * bfhi(uw.y);
            const pg8::f32x2 ga = pg8::gelu_pk((pg8::f32x2){y0, y1}), gb = pg8::gelu_pk((pg8::f32x2){y2, y3});
            u32x2 o; o.x = pk2(ga.x, ga.y); o.y = pk2(gb.x, gb.y);
            *(u32x2*)(Z + (size_t)row * 512 + ch) = o;
        }
    }
}

constexpr int VT_PITCH = 296;
__device__ __forceinline__ void attn_unit(const Ctx& C, const Params& P, int b, int hk) {
    const bf16_t* proj = (const bf16_t*)(P.ws + WS_PROJ);
    bf16_t* AO = (bf16_t*)(P.ws + WS_BUFA);
    float* SSA = (float*)(P.ws + WS_SSA);
    LAS unsigned char* Ks = C.lds;
    LAS bf16_t* Vt = (LAS bf16_t*)(C.lds + 288 * 128);
    __syncthreads();
    for (int e = C.tid; e < 288 * 8; e += NTHR) {
        const int key = e >> 3, ch = e & 7;
        int row = -1;
        if (key < 256) { const int j = (b - 1) * 128 + key; if (j >= 0) row = j; } else if (key < 272) row = SEQ + key - 256;
        u32x4 kw = {0u, 0u, 0u, 0u}, vw = {0u, 0u, 0u, 0u};
        if (row >= 0) { kw = *(const u32x4*)(proj + (size_t)row * INW + O_K + hk * 64 + ch * 8); vw = *(const u32x4*)(proj + (size_t)row * INW + O_V + hk * 64 + ch * 8); }
        float kf[8] = {bflo(kw.x), bfhi(kw.x), bflo(kw.y), bfhi(kw.y), bflo(kw.z), bfhi(kw.z), bflo(kw.w), bfhi(kw.w)};
        float ss = 0.f;
#pragma unroll
        for (int i = 0; i < 8; ++i) ss += kf[i] * kf[i];
        ss += __shfl_xor(ss, 1); ss += __shfl_xor(ss, 2); ss += __shfl_xor(ss, 4);
        const float rinv = 1.0f / sqrtf(ss * (1.0f / 64.0f) + EPS);
        const f32x4 g0 = *(const f32x4*)(P.in[I_KNG] + ch * 8), g1 = *(const f32x4*)(P.in[I_KNG] + ch * 8 + 4);
        u32x4 o; o.x = pk2(kf[0] * rinv * g0.x, kf[1] * rinv * g0.y); o.y = pk2(kf[2] * rinv * g0.z, kf[3] * rinv * g0.w);
        o.z = pk2(kf[4] * rinv * g1.x, kf[5] * rinv * g1.y); o.w = pk2(kf[6] * rinv * g1.z, kf[7] * rinv * g1.w);
        *(LAS u32x4*)(Ks + key * 128 + ((ch ^ (key & 7)) * 16)) = o;
        const unsigned vv[4] = {vw.x, vw.y, vw.z, vw.w};
#pragma unroll
        for (int i = 0; i < 4; ++i) { Vt[(ch * 8 + 2 * i) * VT_PITCH + key] = (bf16_t)(vv[i] & 0xffffu); Vt[(ch * 8 + 2 * i + 1) * VT_PITCH + key] = (bf16_t)(vv[i] >> 16); }
    }
    __syncthreads();
    const int c = C.lane & 31, h = C.lane >> 5;
#pragma unroll 1
    for (int ti = C.wave; ti < 16; ti += NWAVES) {
        const int hql = ti >> 2, wq = ti & 3, hq = hk * 4 + hql;
        const int qi = wq * 32 + c, tok = b * 128 + qi;
        bf16x8 qf[4];
        {
            u32x4 qw[4]; float ss = 0.f;
#pragma unroll
            for (int ks = 0; ks < 4; ++ks) { qw[ks] = *(const u32x4*)(proj + (size_t)tok * INW + hq * 64 + 16 * ks + 8 * h);
                const unsigned w[4] = {qw[ks].x, qw[ks].y, qw[ks].z, qw[ks].w};
#pragma unroll
                for (int i = 0; i < 4; ++i) { const float a = bflo(w[i]), bb = bfhi(w[i]); ss += a * a + bb * bb; } }
            ss += __shfl_xor(ss, 32);
            const float rinv = (1.0f / sqrtf(ss * (1.0f / 64.0f) + EPS)) * (0.125f * LOG2E);
#pragma unroll
            for (int ks = 0; ks < 4; ++ks) {
                const f32x4 g0 = *(const f32x4*)(P.in[I_QNG] + 16 * ks + 8 * h), g1 = *(const f32x4*)(P.in[I_QNG] + 16 * ks + 8 * h + 4);
                u32x4 o; o.x = pk2(bflo(qw[ks].x) * rinv * g0.x, bfhi(qw[ks].x) * rinv * g0.y); o.y = pk2(bflo(qw[ks].y) * rinv * g0.z, bfhi(qw[ks].y) * rinv * g0.w);
                o.z = pk2(bflo(qw[ks].z) * rinv * g1.x, bfhi(qw[ks].z) * rinv * g1.y); o.w = pk2(bflo(qw[ks].w) * rinv * g1.z, bfhi(qw[ks].w) * rinv * g1.w);
                qf[ks] = __builtin_bit_cast(bf16x8, o);
            }
        }
        f32x16 S[6];
#pragma unroll
        for (int rb = 0; rb < 6; ++rb) {
            const int kb = (rb < 5) ? (wq + rb) : 8;
            const int key = kb * 32 + c;
            f32x16 acc = {0.f, 0.f, 0.f, 0.f, 0.f, 0.f, 0.f, 0.f, 0.f, 0.f, 0.f, 0.f, 0.f, 0.f, 0.f, 0.f};
#pragma unroll
            for (int ks = 0; ks < 4; ++ks) {
                const bf16x8 A = *(const LAS bf16x8*)(Ks + key * 128 + (((2 * ks + h) ^ (key & 7)) * 16));
                acc = MFMA32(A, qf[ks], acc);
            }
            S[rb] = acc;
            __builtin_amdgcn_sched_barrier(0);
        }
        const float sl = P.in[I_SINK][hq] * LOG2E;
        float mx = sl;
#pragma unroll
        for (int r = 0; r < 16; ++r) {
            const int kr = (r & 3) + 8 * (r >> 2) + 4 * h;
            const bool gt = kr > c;
            S[0][r] = gt ? S[0][r] : -1e30f;
            S[4][r] = gt ? -1e30f : S[4][r];
            if (r >= 8) S[5][r] = -1e30f;
        }
        if (b == 0) {
#pragma unroll
            for (int rb = 0; rb < 4; ++rb) if (wq + rb < 4) {
#pragma unroll
                for (int r = 0; r < 16; ++r) S[rb][r] = -1e30f;
            }
        }
#pragma unroll
        for (int rb = 0; rb < 6; ++rb)
#pragma unroll
            for (int r = 0; r < 16; ++r) mx = fmaxf(mx, S[rb][r]);
        mx = fmaxf(mx, __shfl_xor(mx, 32));
        float lsum = 0.f;
#pragma unroll
        for (int rb = 0; rb < 6; ++rb)
#pragma unroll
            for (int r = 0; r < 16; ++r) { const float p = __builtin_amdgcn_exp2f(S[rb][r] - mx); S[rb][r] = p; lsum += p; }
        lsum += __shfl_xor(lsum, 32);
        lsum += __builtin_amdgcn_exp2f(sl - mx);
        const float linv = 1.0f / lsum;
        f32x16 O[2];
#pragma unroll
        for (int db = 0; db < 2; ++db) O[db] = (f32x16){0.f, 0.f, 0.f, 0.f, 0.f, 0.f, 0.f, 0.f, 0.f, 0.f, 0.f, 0.f, 0.f, 0.f, 0.f, 0.f};
#pragma unroll
        for (int rb = 0; rb < 6; ++rb) {
            const int kb = (rb < 5) ? (wq + rb) : 8;
#pragma unroll
            for (int s = 0; s < 2; ++s) {
                if (rb == 5 && s == 1) continue;
                u32x4 pw; pw.x = pk2(S[rb][8 * s + 0], S[rb][8 * s + 1]); pw.y = pk2(S[rb][8 * s + 2], S[rb][8 * s + 3]);
                pw.z = pk2(S[rb][8 * s + 4], S[rb][8 * s + 5]); pw.w = pk2(S[rb][8 * s + 6], S[rb][8 * s + 7]);
                const bf16x8 Pf = __builtin_bit_cast(bf16x8, pw);
#pragma unroll
                for (int db = 0; db < 2; ++db) {
                    const LAS bf16_t* vp = Vt + (db * 32 + c) * VT_PITCH + kb * 32 + 16 * s + 4 * h;
                    const u32x2 lo = *(const LAS u32x2*)vp, hi2 = *(const LAS u32x2*)(vp + 8);
                    u32x4 vw; vw.x = lo.x; vw.y = lo.y; vw.z = hi2.x; vw.w = hi2.y;
                    O[db] = MFMA32(__builtin_bit_cast(bf16x8, vw), Pf, O[db]);
                }
                __builtin_amdgcn_sched_barrier(0);
            }
        }
        float ssq = 0.f;
#pragma unroll
        for (int db = 0; db < 2; ++db)
#pragma unroll
            for (int gq = 0; gq < 4; ++gq) {
                const float o0 = O[db][4 * gq] * linv, o1 = O[db][4 * gq + 1] * linv, o2 = O[db][4 * gq + 2] * linv, o3 = O[db][4 * gq + 3] * linv;
                ssq += (o0 * o0 + o1 * o1) + (o2 * o2 + o3 * o3);
                u32x2 o; o.x = pk2(o0, o1); o.y = pk2(o2, o3);
                *(u32x2*)(AO + (size_t)tok * 1024 + hq * 64 + db * 32 + 8 * gq + 4 * h) = o;
            }
        ssq += __shfl_xor(ssq, 32);
        if (h == 0) SSA[(size_t)tok * 8 + hq] = ssq;
    }
}

struct EpiGlu {
    static constexpr bool PERM = true, AFTER_DRAIN = false, HAS_MID = false;
    const bf16_t* Z; bf16_t* O; const float* bias; float* SSS;
    __device__ __forceinline__ void operator()(const pg8::f32x4 (&acc)[2][2][4][2], const pg8::Unit& u, int wr, int wc, int fr, int fq) const {
        const int row0 = u.pm * 256 + wr * 64 + fr, col0 = u.pn * 256 + wc * 32 + 8 * fq;
        f32x4 bb[2][2];
#pragma unroll
        for (int bj = 0; bj < 2; ++bj) { bb[bj][0] = *(const f32x4*)(bias + col0 + bj * 128); bb[bj][1] = *(const f32x4*)(bias + col0 + bj * 128 + 4); }
#pragma unroll
        for (int ai = 0; ai < 2; ++ai) {
            u32x4 zw[4][2];
#pragma unroll
            for (int m = 0; m < 4; ++m)
#pragma unroll
                for (int bj = 0; bj < 2; ++bj) zw[m][bj] = *(const u32x4*)(Z + (size_t)(row0 + ai * 128 + m * 16) * 512 + col0 + bj * 128);
#pragma unroll
            for (int m = 0; m < 4; ++m) {
                const int row = row0 + ai * 128 + m * 16; float ssq = 0.f;
#pragma unroll
                for (int bj = 0; bj < 2; ++bj) {
                    const f32x4 b0 = bb[bj][0], b1 = bb[bj][1]; const u32x4 z4 = zw[m][bj];
                    const pg8::f32x4 v0 = acc[ai][bj][m][0], v1 = acc[ai][bj][m][1];
                    const float zf[8] = {bflo(z4.x), bfhi(z4.x), bflo(z4.y), bfhi(z4.y), bflo(z4.z), bfhi(z4.z), bflo(z4.w), bfhi(z4.w)};
                    const float pre[8] = {v0[0] + b0.x, v0[1] + b0.y, v0[2] + b0.z, v0[3] + b0.w, v1[0] + b1.x, v1[1] + b1.y, v1[2] + b1.z, v1[3] + b1.w};
                    float r[8];
#pragma unroll
                    for (int i = 0; i < 8; ++i) { r[i] = zf[i] * __builtin_amdgcn_rcpf(1.0f + __expf(-pre[i])); ssq += r[i] * r[i]; }
                    u32x4 o; o.x = pk2(r[0], r[1]); o.y = pk2(r[2], r[3]); o.z = pk2(r[4], r[5]); o.w = pk2(r[6], r[7]);
                    *(u32x4*)(O + (size_t)row * 1024 + 512 + col0 + bj * 128) = o;
                }
                ssq += __shfl_xor(ssq, 16); ssq += __shfl_xor(ssq, 32);
                if (fq == 0) SSS[(size_t)row * 8 + u.pn * 4 + wc] = ssq;
            }
        }
    }
};
constexpr int FAC_OFF = 131072;
struct EpiMix {
    static constexpr bool PERM = true, AFTER_DRAIN = false, HAS_MID = true;
    const float* X; bf16_t* HB; float* SSH;
    __device__ __forceinline__ void mid(pg8::f32x4 (&acc)[2][2][4][2], const pg8::Unit& u, int wr, int wc, int fr, int fq, LAS unsigned char* lds) const {
#pragma unroll
        for (int ai = 0; ai < 2; ++ai)
#pragma unroll
            for (int m = 0; m < 4; ++m) {
                const float f = ((const LAS float*)(lds + FAC_OFF))[2 * (ai * 128 + wr * 64 + m * 16 + fr)];
#pragma unroll
                for (int bj = 0; bj < 2; ++bj)
#pragma unroll
                    for (int n = 0; n < 2; ++n) acc[ai][bj][m][n] *= f;
            }
    }
    __device__ __forceinline__ void operator()(const pg8::f32x4 (&acc)[2][2][4][2], const pg8::Unit& u, int wr, int wc, int fr, int fq) const {
        extern __shared__ __attribute__((aligned(16))) unsigned char lds_raw_[];
        const LAS float* fac = (const LAS float*)((LAS unsigned char*)lds_raw_ + FAC_OFF);
        const int col0 = u.pn * 256 + wc * 32 + 8 * fq;
#pragma unroll
        for (int ai = 0; ai < 2; ++ai) {
            f32x4 xv[4][2][2];
#pragma unroll
            for (int m = 0; m < 4; ++m)
#pragma unroll
                for (int bj = 0; bj < 2; ++bj) { const size_t off = (size_t)(u.pm * 256 + ai * 128 + wr * 64 + m * 16 + fr) * 1024 + col0 + bj * 128;
                    xv[m][bj][0] = *(const f32x4*)(X + off); xv[m][bj][1] = *(const f32x4*)(X + off + 4); }
#pragma unroll
            for (int m = 0; m < 4; ++m) {
                const int rl = ai * 128 + wr * 64 + m * 16 + fr, row = u.pm * 256 + rl;
                const float rs = fac[2 * rl + 1]; float ssq = 0.f;
#pragma unroll
                for (int bj = 0; bj < 2; ++bj) {
                    const size_t off = (size_t)row * 1024 + col0 + bj * 128;
                    const f32x4 x0 = xv[m][bj][0], x1 = xv[m][bj][1];
                    const pg8::f32x4 v0 = acc[ai][bj][m][0], v1 = acc[ai][bj][m][1];
                    const float hv[8] = {x0.x + rs * v0[0], x0.y + rs * v0[1], x0.z + rs * v0[2], x0.w + rs * v0[3], x1.x + rs * v1[0], x1.y + rs * v1[1], x1.z + rs * v1[2], x1.w + rs * v1[3]};
#pragma unroll
                    for (int i = 0; i < 8; ++i) ssq += hv[i] * hv[i];
                    u32x4 o; o.x = pk2(hv[0], hv[1]); o.y = pk2(hv[2], hv[3]); o.z = pk2(hv[4], hv[5]); o.w = pk2(hv[6], hv[7]);
                    *(u32x4*)(HB + off) = o;
                }
                ssq += __shfl_xor(ssq, 16); ssq += __shfl_xor(ssq, 32);
                if (fq == 0) SSH[(size_t)row * 16 + u.pn * 4 + wc] = ssq;
            }
        }
    }
};
struct EpiQ {
    static constexpr bool PERM = true, AFTER_DRAIN = false, HAS_MID = false;
    bf16_t* O; const float* SSH;
    __device__ __forceinline__ void operator()(const pg8::f32x4 (&acc)[2][2][4][2], const pg8::Unit& u, int wr, int wc, int fr, int fq) const {
        const int col0 = u.pn * 256 + wc * 32 + 8 * fq;
        float ri[2][4];
#pragma unroll
        for (int ai = 0; ai < 2; ++ai)
#pragma unroll
            for (int m = 0; m < 4; ++m) {
                const int row = u.pm * 256 + ai * 128 + wr * 64 + m * 16 + fr;
                const f32x4* sp = (const f32x4*)(SSH + (size_t)row * 16);
                const f32x4 s0 = sp[0], s1 = sp[1], s2 = sp[2], s3 = sp[3];
                const float ss = ((s0.x + s0.y) + (s0.z + s0.w)) + ((s1.x + s1.y) + (s1.z + s1.w)) + ((s2.x + s2.y) + (s2.z + s2.w)) + ((s3.x + s3.y) + (s3.z + s3.w));
                ri[ai][m] = 1.0f / sqrtf(ss * (1.0f / 1024.0f) + EPS);
            }
#pragma unroll
        for (int ai = 0; ai < 2; ++ai)
#pragma unroll
            for (int m = 0; m < 4; ++m) {
                const int row = u.pm * 256 + ai * 128 + wr * 64 + m * 16 + fr; const float r = ri[ai][m];
#pragma unroll
                for (int bj = 0; bj < 2; ++bj) {
                    const pg8::f32x4 v0 = acc[ai][bj][m][0], v1 = acc[ai][bj][m][1];
                    u32x4 o; o.x = pk2(v0[0] * r, v0[1] * r); o.y = pk2(v0[2] * r, v0[3] * r); o.z = pk2(v1[0] * r, v1[1] * r); o.w = pk2(v1[2] * r, v1[3] * r);
                    *(u32x4*)(O + (size_t)row * 2048 + col0 + bj * 128) = o;
                }
            }
    }
};

__device__ __forceinline__ void peer_topk_tile(const Ctx& C, const Params& P, int tok0) {
    const bf16_t* QP = (const bf16_t*)(P.ws + WS_QP);
    const bf16_t* SK = (const bf16_t*)(P.ws + WS_SUBK);
    int* IDX = (int*)(P.ws + WS_IDX); float* GW = (float*)(P.ws + WS_GW);
    LAS u32* lists = (LAS u32*)C.lds;
    const int c = C.lane & 31, h = C.lane >> 5;
    __syncthreads();
#pragma unroll 1
    for (int hs = C.wave; hs < 16; hs += NWAVES) {
        bf16x8 qf[2][8];
#pragma unroll
        for (int tg = 0; tg < 2; ++tg) { const bf16_t* qrow = QP + (size_t)(tok0 + tg * 32 + c) * 2048 + hs * 128;
#pragma unroll
            for (int ks = 0; ks < 8; ++ks) qf[tg][ks] = *(const bf16x8*)(qrow + 16 * ks + 8 * h); }
        u32 best[2][16];
#pragma unroll 1
        for (int kb = 0; kb < 4; ++kb) {
            bf16x8 kf[8];
            const bf16_t* krow = SK + (size_t)(hs * 128 + kb * 32 + c) * 128;
#pragma unroll
            for (int ks = 0; ks < 8; ++ks) kf[ks] = *(const bf16x8*)(krow + 16 * ks + 8 * h);
            f32x16 acc0 = {0.f, 0.f, 0.f, 0.f, 0.f, 0.f, 0.f, 0.f, 0.f, 0.f, 0.f, 0.f, 0.f, 0.f, 0.f, 0.f}, acc1 = acc0;
#pragma unroll
            for (int ks = 0; ks < 8; ++ks) { acc0 = MFMA32(kf[ks], qf[0][ks], acc0); acc1 = MFMA32(kf[ks], qf[1][ks], acc1); }
            u32 g0[16], g1[16];
#pragma unroll
            for (int r = 0; r < 16; ++r) { const u32 kx = (u32)(127 - (kb * 32 + (r & 3) + 8 * (r >> 2) + 4 * h));
                g0[r] = (f2ord(acc0[r]) & ~0x7Fu) | kx; g1[r] = (f2ord(acc1[r]) & ~0x7Fu) | kx; }
            sort16_desc(g0); sort16_desc(g1);
            if (kb == 0) {
#pragma unroll
                for (int i = 0; i < 16; ++i) { best[0][i] = g0[i]; best[1][i] = g1[i]; }
            } else { merge_top16(best[0], g0); merge_top16(best[1], g1); }
        }
#pragma unroll
        for (int tg = 0; tg < 2; ++tg) {
            u32 pb[16];
#pragma unroll
            for (int i = 0; i < 16; ++i) pb[i] = (u32)__shfl_xor((int)best[tg][i], 32);
            merge_top16(best[tg], pb);
            if (h == 0) {
                LAS u32x4* dst = (LAS u32x4*)(lists + (tg * 32 + c) * 260 + hs * 16);
#pragma unroll
                for (int i = 0; i < 4; ++i) { u32x4 w; w.x = best[tg][4 * i]; w.y = best[tg][4 * i + 1]; w.z = best[tg][4 * i + 2]; w.w = best[tg][4 * i + 3]; dst[i] = w; }
            }
        }
    }
    __syncthreads();
    {
        const int tl = C.tid & 63, hd = C.tid >> 6;
        const LAS u32* L1 = lists + tl * 260 + hd * 32; const LAS u32* L2 = L1 + 16;
        float v1[16], v2[16];
#pragma unroll
        for (int i = 0; i < 16; ++i) { v1[i] = ord2f(L1[i] & ~0x7Fu); v2[i] = ord2f(L2[i] & ~0x7Fu); }
        u32 cd[4][16];
        { int cid = 0;
#pragma unroll
          for (int a = 0; a < 16; ++a)
#pragma unroll
              for (int b = 0; b < 16; ++b) if ((a + 1) * (b + 1) <= 16) { cd[cid >> 4][cid & 15] = (f2ord(v1[a] + v2[b]) & ~0x3Fu) | (u32)(63 - cid); ++cid; }
#pragma unroll
          for (int k = 50; k < 64; ++k) cd[k >> 4][k & 15] = 0u; }
        top16_of_64(cd[0], cd[1], cd[2], cd[3]);
        float sc[16]; int ix[16]; float mx = -1e30f;
#pragma unroll
        for (int k = 0; k < 16; ++k) {
            const int cid = 63 - (int)(cd[0][k] & 63u); const int ab = CAND_AB[cid];
            const u32 k1 = L1[ab >> 4], k2 = L2[ab & 15];
            sc[k] = ord2f(k1 & ~0x7Fu) + ord2f(k2 & ~0x7Fu);
            ix[k] = (127 - (int)(k1 & 0x7Fu)) * 128 + (127 - (int)(k2 & 0x7Fu));
            mx = fmaxf(mx, sc[k]);
        }
        float sum = 0.f;
#pragma unroll
        for (int k = 0; k < 16; ++k) { sc[k] = __expf(sc[k] - mx); sum += sc[k]; }
        const float inv = 1.0f / sum;
        int* io = IDX + (size_t)(tok0 + tl) * 128 + hd * 16; float* go = GW + (size_t)(tok0 + tl) * 128 + hd * 16;
#pragma unroll
        for (int k = 0; k < 16; k += 4) {
            *(int4*)(io + k) = make_int4(ix[k], ix[k + 1], ix[k + 2], ix[k + 3]);
            f32x4 gv = {sc[k] * inv, sc[k + 1] * inv, sc[k + 2] * inv, sc[k + 3] * inv}; *(f32x4*)(go + k) = gv;
        }
    }
    __syncthreads();
}

template <int J> __device__ __forceinline__ u32 xor_lane(u32 v, int lane) {
    if constexpr (J == 1) return (u32)__builtin_amdgcn_update_dpp(0, (int)v, 0xB1, 0xf, 0xf, true);
    else if constexpr (J == 2) return (u32)__builtin_amdgcn_update_dpp(0, (int)v, 0x4E, 0xf, 0xf, true);
    else if constexpr (J == 4) { int t = __builtin_amdgcn_update_dpp(0, (int)v, 0x104, 0xf, 0x5, false); return (u32)__builtin_amdgcn_update_dpp(t, (int)v, 0x114, 0xf, 0xA, false); }
    else if constexpr (J == 8) return (u32)__builtin_amdgcn_update_dpp(0, (int)v, 0x128, 0xf, 0xf, true);
    else if constexpr (J == 16) { u32 b = v; asm volatile("" : "+v"(b)); const auto p = __builtin_amdgcn_permlane16_swap(v, b, false, false); return (lane & 16) ? p[0] : p[1]; }
    else { u32 b = v; asm volatile("" : "+v"(b)); const auto p = __builtin_amdgcn_permlane32_swap(v, b, false, false); return (lane & 32) ? p[0] : p[1]; }
}
__device__ __forceinline__ int reduce64(int (&r)[64], int lane) {
#pragma unroll
    for (int e = 0; e < 32; ++e) { const auto p = __builtin_amdgcn_permlane32_swap((u32)r[e], (u32)r[e + 32], false, false); r[e] = (int)p[0] + (int)p[1]; }
#pragma unroll
    for (int e = 0; e < 16; ++e) { const auto p = __builtin_amdgcn_permlane16_swap((u32)r[e], (u32)r[e + 16], false, false); r[e] = (int)p[0] + (int)p[1]; }
    const bool b3 = (lane & 8) != 0, b2 = (lane & 4) != 0, b1 = (lane & 2) != 0, b0 = (lane & 1) != 0;
#pragma unroll
    for (int e = 0; e < 8; ++e) { const int keep = b3 ? r[e + 8] : r[e], send = b3 ? r[e] : r[e + 8]; r[e] = keep + __builtin_amdgcn_update_dpp(0, send, 0x128, 0xf, 0xf, true); }
#pragma unroll
    for (int e = 0; e < 4; ++e) { const int keep = b2 ? r[e + 4] : r[e], send = b2 ? r[e] : r[e + 4];
        int t = __builtin_amdgcn_update_dpp(0, send, 0x104, 0xf, 0x5, false);
        t = __builtin_amdgcn_update_dpp(t, send, 0x114, 0xf, 0xA, false);
        r[e] = keep + t; }
#pragma unroll
    for (int e = 0; e < 2; ++e) { const int keep = b1 ? r[e + 2] : r[e], send = b1 ? r[e] : r[e + 2]; r[e] = keep + __builtin_amdgcn_update_dpp(0, send, 0x4E, 0xf, 0xf, true); }
    { const int keep = b0 ? r[1] : r[0], send = b0 ? r[0] : r[1]; r[0] = keep + __builtin_amdgcn_update_dpp(0, send, 0xB1, 0xf, 0xf, true); }
    return r[0];
}
constexpr int GQ_LDS_PER_WAVE = 8192;
#define GQ_FMA16(A, ce, w) do { _Pragma("unroll") for (int j_ = 0; j_ < 4; ++j_) { \
        const f32x2_t lo_ = __builtin_amdgcn_cvt_pk_f32_fp8((int)(w)[j_], false), hi_ = __builtin_amdgcn_cvt_pk_f32_fp8((int)(w)[j_], true); \
        A[4 * j_ + 0] += (ce) * lo_.x; A[4 * j_ + 1] += (ce) * lo_.y; A[4 * j_ + 2] += (ce) * hi_.x; A[4 * j_ + 3] += (ce) * hi_.y; } } while (0)
__device__ __forceinline__ void peer_gather_quad(const Ctx& C, const Params& P, int tokq) {
    const bf16_t* HN = (const bf16_t*)(P.ws + WS_HB); const float* SSH = (const float*)(P.ws + WS_SSH);
    const unsigned char* PU = P.ws + WS_PU; const unsigned char* PV = P.ws + WS_PV;
    const float* SU = (const float*)(P.ws + WS_SU); const float* SV = (const float*)(P.ws + WS_SV);
    const int* IDX = (const int*)(P.ws + WS_IDX); const float* GW = (const float*)(P.ws + WS_GW);
    const int lane = C.lane;
    LAS unsigned char* qhl = C.lds + C.wave * GQ_LDS_PER_WAVE;
    LAS u32* keyl = (LAS u32*)(qhl + 4096);
    u32 k[8];
#pragma unroll
    for (int s = 0; s < 4; ++s)
#pragma unroll
        for (int hb = 0; hb < 2; ++hb) k[2 * s + hb] = ((u32)IDX[(size_t)(tokq + s) * 128 + 64 * hb + lane] << 9) | (u32)(s << 7) | (u32)(64 * hb + lane);
#pragma unroll
    for (int size = 2; size <= 512; size <<= 1) {
#pragma unroll
        for (int j = size >> 1; j > 0; j >>= 1) {
            u32 nk[8];
#pragma unroll
            for (int r = 0; r < 8; ++r) {
                const int ii = lane + 64 * r;
                const bool asc = (ii & size) == 0, lower = (ii & j) == 0;
                const u32 mine = k[r];
                u32 other;
                if (j >= 64) other = k[r ^ (j >> 6)];
                else if (j == 1) other = xor_lane<1>(mine, lane); else if (j == 2) other = xor_lane<2>(mine, lane); else if (j == 4) other = xor_lane<4>(mine, lane);
                else if (j == 8) other = xor_lane<8>(mine, lane); else if (j == 16) other = xor_lane<16>(mine, lane); else other = xor_lane<32>(mine, lane);
                const u32 mn = mine < other ? mine : other, mx = mine < other ? other : mine;
                nk[r] = (lower == asc) ? mn : mx;
            }
#pragma unroll
            for (int r = 0; r < 8; ++r) k[r] = nk[r];
        }
    }
#pragma unroll
    for (int r = 0; r < 8; ++r) keyl[64 * r + lane] = k[r];
    float shs[4];
    f32x4 g2v[4];
#pragma unroll
    for (int j = 0; j < 4; ++j) g2v[j] = *(const f32x4*)(P.in[I_N2G] + 256 * j + 4 * lane);
#pragma unroll
    for (int s = 0; s < 4; ++s) {
        float hf[16]; float m = 0.f;
        const float ssp = (lane < 16) ? SSH[(size_t)(tokq + s) * 16 + lane] : 0.f;
#pragma unroll
        for (int j = 0; j < 4; ++j) { const u32x2 w = *(const u32x2*)(HN + (size_t)(tokq + s) * DM + 256 * j + 4 * lane);
            hf[4 * j] = bflo(w.x) * g2v[j].x; hf[4 * j + 1] = bfhi(w.x) * g2v[j].y; hf[4 * j + 2] = bflo(w.y) * g2v[j].z; hf[4 * j + 3] = bfhi(w.y) * g2v[j].w; }
        const float rinv_t = 1.0f / sqrtf(wave_sum(ssp) * (1.0f / 1024.0f) + EPS);
#pragma unroll
        for (int d = 0; d < 16; ++d) m = fmaxf(m, fabsf(hf[d]));
#pragma unroll
        for (int o = 1; o < 64; o <<= 1) m = fmaxf(m, __shfl_xor(m, o));
        shs[s] = ((m > 0.f) ? m * (1.0f / 127.0f) : 1.0f) * rinv_t; const float inv = (m > 0.f) ? 127.0f / m : 0.f;
        u32x4 q;
#pragma unroll
        for (int j = 0; j < 4; ++j) {
            const int q0 = (int)rintf(hf[4 * j] * inv), q1 = (int)rintf(hf[4 * j + 1] * inv), q2 = (int)rintf(hf[4 * j + 2] * inv), q3 = (int)rintf(hf[4 * j + 3] * inv);
            q[j] = (u32)(q0 & 255) | ((u32)(q1 & 255) << 8) | ((u32)(q2 & 255) << 16) | ((u32)(q3 & 255) << 24);
        }
        *(LAS u32x4*)(qhl + s * 1024 + 16 * lane) = q;
    }
    LDS_WAIT();
    LAS float* cvl = (LAS float*)(qhl + 6144);
#pragma unroll 1
    for (int c = 0; c < 8; ++c) {
        const u32 kk = keyl[64 * c + lane];
        const int e_l = (int)(kk >> 9), slot_l = (int)((kk >> 7) & 3u), pos_l = (int)(kk & 127u);
        const float g_l = GW[(size_t)(tokq + slot_l) * 128 + pos_l], su_l = SU[e_l], sv_l = SV[e_l];
        int r[64];
#pragma unroll
        for (int p = 0; p < 64; ++p) {
            const u32 kp = (u32)__builtin_amdgcn_readlane((int)kk, p);
            const u32x4 w = *(const u32x4*)(PU + (size_t)(kp >> 9) * 1024 + 16 * lane);
            const u32x4 hq = *(const LAS u32x4*)(qhl + ((kp >> 7) & 3u) * 1024 + 16 * lane);
            int a = __builtin_amdgcn_sdot4((int)w.x, (int)hq.x, 0, false);
            a = __builtin_amdgcn_sdot4((int)w.y, (int)hq.y, a, false);
            a = __builtin_amdgcn_sdot4((int)w.z, (int)hq.z, a, false);
            a = __builtin_amdgcn_sdot4((int)w.w, (int)hq.w, a, false);
            r[p] = a;
        }
        const int isum = reduce64(r, lane);
        const float sh_l = (slot_l == 0) ? shs[0] : (slot_l == 1) ? shs[1] : (slot_l == 2) ? shs[2] : shs[3];
        const float z = (float)isum * su_l * sh_l;
        const float c_l = gelu_erf(z) * g_l * sv_l;
        cvl[64 * c + lane] = c_l;
    }
    LDS_WAIT();
    float acc0[16], acc1[16], acc2[16], acc3[16];
#pragma unroll
    for (int d = 0; d < 16; ++d) { acc0[d] = 0.f; acc1[d] = 0.f; acc2[d] = 0.f; acc3[d] = 0.f; }
#define GQ_ISSUE(W, KP, CE, kreg, creg, p0) do { _Pragma("unroll") for (int q = 0; q < 8; ++q) { \
        KP[q] = (u32)__builtin_amdgcn_readlane((int)(kreg), (p0) + q); CE[q] = __uint_as_float((u32)__builtin_amdgcn_readlane((int)__float_as_uint(creg), (p0) + q)); \
        W[q] = *(const u32x4*)(PV + (size_t)(KP[q] >> 9) * 1024 + 16 * lane); } } while (0)
#define GQ_CONSUME(W, KP, CE) do { _Pragma("unroll") for (int q = 0; q < 8; ++q) { const u32 sl = (KP[q] >> 7) & 3u; \
        if (sl == 0u) GQ_FMA16(acc0, CE[q], W[q]); else if (sl == 1u) GQ_FMA16(acc1, CE[q], W[q]); else if (sl == 2u) GQ_FMA16(acc2, CE[q], W[q]); else GQ_FMA16(acc3, CE[q], W[q]); } } while (0)
    {
        u32x4 wA[8], wB[8]; u32 kA[8], kB[8]; float cA[8], cB[8];
        u32 kk = keyl[lane]; float cc = cvl[lane];
        GQ_ISSUE(wA, kA, cA, kk, cc, 0);
#pragma unroll 1
        for (int c = 0; c < 8; ++c) {
            const int cn = (c < 7) ? c + 1 : 7;
            const u32 kkn = keyl[64 * cn + lane]; const float ccn = cvl[64 * cn + lane];
#pragma unroll 1
            for (int p0 = 0; p0 < 64; p0 += 16) {
                GQ_ISSUE(wB, kB, cB, kk, cc, p0 + 8);
                GQ_CONSUME(wA, kA, cA);
                if (p0 < 48) GQ_ISSUE(wA, kA, cA, kk, cc, p0 + 16); else GQ_ISSUE(wA, kA, cA, kkn, ccn, 0);
                GQ_CONSUME(wB, kB, cB);
            }
            kk = kkn; cc = ccn;
        }
    }
#undef GQ_ISSUE
#undef GQ_CONSUME
    u32x2 hw[4][4];
#pragma unroll
    for (int s = 0; s < 4; ++s)
#pragma unroll
        for (int j = 0; j < 4; ++j) hw[s][j] = *(const u32x2*)(HN + (size_t)(tokq + s) * DM + 256 * j + 4 * lane);
#define GQ_OUT(s, A) do { float* orow = P.out + (size_t)(tokq + (s)) * DM; _Pragma("unroll") for (int j = 0; j < 4; ++j) { f32x4* p = (f32x4*)(orow + 256 * j + 4 * lane); \
        f32x4 v; v.x = bflo(hw[s][j].x) + A[4 * j]; v.y = bfhi(hw[s][j].x) + A[4 * j + 1]; v.z = bflo(hw[s][j].y) + A[4 * j + 2]; v.w = bfhi(hw[s][j].y) + A[4 * j + 3]; *p = v; } } while (0)
    GQ_OUT(0, acc0); GQ_OUT(1, acc1); GQ_OUT(2, acc2); GQ_OUT(3, acc3);
#undef GQ_OUT
}
__device__ __forceinline__ void peer_gather_tile(const Ctx& C, const Params& P, int tok0) {
    __syncthreads();
#pragma unroll 1
    for (int hq = 0; hq < 2; ++hq) peer_gather_quad(C, P, tok0 + 32 * hq + 4 * C.wave);
}

#define GAS __attribute__((address_space(1)))
typedef GAS unsigned gu32;
#define RLX_AGENT __ATOMIC_RELAXED, __HIP_MEMORY_SCOPE_AGENT
#define XB_TMO      128
#define XB_XCNT(j)  (256  + 64 * (j))
#define XB_XSUB(j)  (1280 + 64 * (j))
#define XB_XGEN(j)  (2304 + 64 * (j))
#define XB_TOP      3328
#define XB_TOPGEN   3392
#define XCD_BAR_WORDS 3456
#define XB_SPIN_CAP (1u << 18)

__device__ __forceinline__ unsigned xb_ld(unsigned* p)              { return __hip_atomic_load(p, __ATOMIC_RELAXED, __HIP_MEMORY_SCOPE_AGENT); }
__device__ __forceinline__ unsigned xb_add(unsigned* p, unsigned v) { return __hip_atomic_fetch_add(p, v, __ATOMIC_RELAXED, __HIP_MEMORY_SCOPE_AGENT); }
__device__ __forceinline__ unsigned xb_xcc_id() { return (unsigned)__builtin_amdgcn_s_getreg((3 << 11) | 20) & 0xFu; }
#define XB_SPIN(cond, bar) do { unsigned _sp = 0; while (cond) { __builtin_amdgcn_s_sleep(1); \
    if ((++_sp & 255u) == 0u) { if (xb_ld(&(bar)[XB_TMO])) break; if (_sp > XB_SPIN_CAP) { atomicAdd(&(bar)[XB_TMO], 1u); break; } } } } while (0)

struct XcdBarrier {
    unsigned* bar; unsigned x;
    volatile LAS unsigned* st;
};

__device__ __forceinline__ XcdBarrier xcd_barrier_post(unsigned* bar, volatile LAS unsigned* st) {
    XcdBarrier b; b.bar = bar; b.x = xb_xcc_id(); b.st = st;
    if (threadIdx.x == 0) (void)xb_add(&bar[XB_XCNT(b.x)], 1u);
    return b;
}
__device__ __forceinline__ void xcd_barrier_complete(unsigned* bar, unsigned x, unsigned& nloc, unsigned& nx) {
    const unsigned G = gridDim.x * gridDim.y * gridDim.z;
    unsigned sum, cnt, mine, sp = 0u;
    for (;;) {
        sum = 0u; cnt = 0u; mine = 0u;
#pragma unroll
        for (unsigned j = 0; j < 16; ++j) { const unsigned c = xb_ld(&bar[XB_XCNT(j)]); sum += c; cnt += (c > 0u) ? 1u : 0u; mine = (j == x) ? c : mine; }
        if (sum == G) break;
        __builtin_amdgcn_s_sleep(1);
        if ((++sp & 255u) == 0u) { if (xb_ld(&bar[XB_TMO])) break; if (sp > XB_SPIN_CAP) { atomicAdd(&bar[XB_TMO], 1u); break; } }
    }
    nloc = mine > 0u ? mine : 1u; nx = cnt > 0u ? cnt : 1u;
}

__device__ __forceinline__ void xcd_barrier(const XcdBarrier& b) {
    asm volatile("s_waitcnt vmcnt(0)" ::: "memory");
    __syncthreads();
    if (threadIdx.x == 0) {
        unsigned* bar = b.bar;
        __builtin_amdgcn_s_waitcnt(0);
        unsigned nloc = b.st[0], nx = b.st[1];
        if (nloc == 0u) { xcd_barrier_complete(bar, b.x, nloc, nx); b.st[0] = nloc; b.st[1] = nx; }
        const unsigned old = xb_add(&bar[XB_XSUB(b.x)], 1u);
        const unsigned gen = old / nloc;
        if (old + 1u == (gen + 1u) * nloc) {
            __builtin_amdgcn_fence(__ATOMIC_RELEASE, "agent");
            asm volatile("s_waitcnt vmcnt(0)" ::: "memory");
            const unsigned og = xb_add(&bar[XB_TOP], 1u);
            const unsigned tg = og / nx;
            if (og + 1u == (tg + 1u) * nx) xb_add(&bar[XB_TOPGEN], 1u);
            else XB_SPIN(xb_ld(&bar[XB_TOPGEN]) == tg, bar);
            __builtin_amdgcn_fence(__ATOMIC_ACQUIRE, "agent");
            xb_add(&bar[XB_XGEN(b.x)], 1u);
            asm volatile("s_waitcnt vmcnt(0)" ::: "memory");
        } else {
            XB_SPIN(xb_ld(&bar[XB_XGEN(b.x)]) == gen, bar);
            __builtin_amdgcn_fence(__ATOMIC_ACQUIRE, "agent");
            asm volatile("s_waitcnt vmcnt(0)" ::: "memory");
        }
    }
    __syncthreads();
}

constexpr int NPHASE = 9;
__global__ void __launch_bounds__(NTHR, 2) mk_fwd(Params P) {
    extern __shared__ __attribute__((aligned(16))) unsigned char lds_raw[];
    Ctx C; C.lds = (LAS unsigned char*)lds_raw; C.tid = threadIdx.x; C.lane = C.tid & 63; C.wave = __builtin_amdgcn_readfirstlane(C.tid >> 6); C.G = gridDim.x; C.bid = blockIdx.x;
    unsigned char* ws = P.ws;
    volatile LAS unsigned* MISC = (volatile LAS unsigned*)(C.lds + MISC_OFF);
    if (C.tid < 32) MISC[C.tid] = 0u;
    __syncthreads();
    XcdBarrier bar = xcd_barrier_post((unsigned*)(ws + WS_CTL) + 4096, MISC + 8);
#define SEAM(k) do { if (IN(k) && IN((k) + 1)) xcd_barrier(bar); FRESH(); } while (0)
#define FRESH() do { int t_ = (int)threadIdx.x; asm volatile("" : "+v"(t_)); C.tid = t_; C.lane = t_ & 63; } while (0)
#ifdef ONLY_PHASE
#define IN(k) ((k) == ONLY_PHASE && P.ph_lo <= (k) && (k) < P.ph_hi)
#else
#define IN(k) (P.ph_lo <= (k) && (k) < P.ph_hi)
#endif
    if (IN(0)) phase_prologue(C, P);
    SEAM(0);
    if (IN(1)) {
        pg8::Gemm g{(const bf16_t*)(ws + WS_BUFA), (const bf16_t*)(ws + WS_WIN_T), MPAD, INW, DM}; pg8::StaticOrder S; S.init(MPAD, INW, C.G, C.bid);
        pg8::EpiBf16<0> E{(bf16_t*)(ws + WS_PROJ), INW, nullptr, 0, 0, 1.f};
        pg8::gemm_phase<pg8::EpiBf16<0>, pg8::StaticOrder, true, true>(C.lds, g, S, E);
        { const int ntile = (MPAD / 256) * (INW / 256), nbusy = ntile % C.G;
          if (ntile > C.G && nbusy > 0) { if (C.bid >= nbusy) deferred_a(C, P, C.bid - nbusy, C.G - nbusy); }
          else deferred_a(C, P, C.bid, C.G); }
    }
    SEAM(1);
    if (IN(2)) phase_sloc(C, P);
    SEAM(2);
    if (IN(3)) {
        for (int bk = C.bid; bk < 64; bk += C.G) carry_scan_block(C, P, bk);
        for (int u = C.bid; u < 256; u += C.G) attn_unit(C, P, u >> 1, u & 1);
    }
    SEAM(3);
    if (IN(4)) phase_ssm_y(C, P);
    SEAM(4);
    if (IN(5)) {
        pg8::Gemm g{(const bf16_t*)(ws + WS_Z), (const bf16_t*)(ws + WS_GLU_T), SEQ, 512, 512}; pg8::StaticOrder S; S.init(SEQ, 512, C.G, C.bid);
        EpiGlu E{(const bf16_t*)(ws + WS_Z), (bf16_t*)(ws + WS_BUFA), P.in[I_GLUB], (float*)(ws + WS_SSS)};
        pg8::gemm_phase<EpiGlu, pg8::StaticOrder, true, true>(C.lds, g, S, E);
        { const int ntile = (SEQ / 256) * 2;
          if (ntile < C.G) { if (C.bid >= ntile) deferred_b(C, P, C.bid - ntile, C.G - ntile); }
          else deferred_b(C, P, C.bid, C.G); }
    }
    SEAM(5);
    if (IN(6)) {
        __syncthreads();
        if (C.tid < 256) {
            pg8::StaticOrder S0; S0.init(SEQ, DM, C.G, C.bid); pg8::Unit u0; S0.next(0, u0);
            const int row = u0.pm * 256 + C.tid;
            const f32x4* pa = (const f32x4*)((const float*)(ws + WS_SSA) + (size_t)row * 8); const f32x4* ps = (const f32x4*)((const float*)(ws + WS_SSS) + (size_t)row * 8);
            const f32x4 a0 = pa[0], a1 = pa[1], s0 = ps[0], s1 = ps[1];
            const float ra = 1.0f / sqrtf((((a0.x + a0.y) + (a0.z + a0.w)) + ((a1.x + a1.y) + (a1.z + a1.w))) * (1.0f / 512.0f) + EPS);
            const float rs = 1.0f / sqrtf((((s0.x + s0.y) + (s0.z + s0.w)) + ((s1.x + s1.y) + (s1.z + s1.w))) * (1.0f / 512.0f) + EPS);
            LAS float* fac = (LAS float*)(C.lds + FAC_OFF); fac[2 * C.tid] = ra / rs; fac[2 * C.tid + 1] = rs;
        }
        __syncthreads();
        pg8::Gemm g{(const bf16_t*)(ws + WS_BUFA), (const bf16_t*)(ws + WS_WOUT_T), SEQ, DM, DM}; pg8::StaticOrder S; S.init(SEQ, DM, C.G, C.bid);
        EpiMix E{P.in[I_X], (bf16_t*)(ws + WS_HB), (float*)(ws + WS_SSH)};
        pg8::gemm_phase<EpiMix, pg8::StaticOrder, true, true>(C.lds, g, S, E);
    }
    SEAM(6);
    if (IN(7)) {
        pg8::Gemm g{(const bf16_t*)(ws + WS_HB), (const bf16_t*)(ws + WS_WQ_T), SEQ, 2048, DM}; pg8::StaticOrder S; S.init(SEQ, 2048, C.G, C.bid);
        EpiQ E{(bf16_t*)(ws + WS_QP), (const float*)(ws + WS_SSH)};
        pg8::gemm_phase<EpiQ, pg8::StaticOrder, true, true>(C.lds, g, S, E);
    }
    SEAM(7);
    {
    if (IN(8)) {
        for (int tile = C.bid; tile < SEQ / 64; tile += C.G) {
            peer_topk_tile(C, P, tile * 64);
            peer_gather_tile(C, P, tile * 64);
        }
    }
    }
#undef IN
#undef SEAM
}
}

extern "C" void kernel_launch(void* const* d_in, const int* in_sizes, int n_in, void* d_out, int out_size, void* d_ws, size_t ws_size, hipStream_t stream) {
    static int state = 0, grid = 0;
    if (state == 0) {
        if (n_in != 25 || out_size != mk::SEQ * mk::DM || ws_size < mk::WS_END) { fprintf(stderr, "kernel_launch: unexpected shapes (n_in %d out %d ws %zu)\n", n_in, out_size, ws_size); state = -1; return; }
        if (hipFuncSetAttribute((const void*)mk::mk_fwd, hipFuncAttributeMaxDynamicSharedMemorySize, mk::LDS_BYTES) != hipSuccess) { fprintf(stderr, "kernel_launch: hipFuncSetAttribute failed\n"); state = -1; return; }
        int dev = 0, cus = 0, per_cu = 0;
        if (hipGetDevice(&dev) != hipSuccess || hipDeviceGetAttribute(&cus, hipDeviceAttributeMultiprocessorCount, dev) != hipSuccess) { fprintf(stderr, "kernel_launch: device query failed\n"); state = -1; return; }
        if (hipOccupancyMaxActiveBlocksPerMultiprocessor(&per_cu, (const void*)mk::mk_fwd, mk::NTHR, mk::LDS_BYTES) != hipSuccess || per_cu < 1) { fprintf(stderr, "kernel_launch: occupancy query failed (%d)\n", per_cu); state = -1; return; }
        grid = cus;
        state = 1;
    }
    if (state < 0) return;
    mk::Params p{};
    for (int i = 0; i < 25; ++i) p.in[i] = (const float*)d_in[i];
    p.out = (float*)d_out; p.ws = (unsigned char*)d_ws;
    if (hipMemsetAsync((char*)d_ws + mk::WS_CTL, 0, 65536, stream) != hipSuccess) { fprintf(stderr, "kernel_launch: memset failed\n"); return; }
    p.ph_lo = 0; p.ph_hi = mk::NPHASE;
    void* args[] = {&p};
    hipError_t e = hipLaunchCooperativeKernel((const void*)mk::mk_fwd, dim3(grid), dim3(mk::NTHR), args, mk::LDS_BYTES, stream);
    if (e != hipSuccess) fprintf(stderr, "kernel_launch: cooperative launch failed: %s (grid %d)\n", hipGetErrorString(e), grid);
}
```

```cpp
#include <hip/hip_runtime.h>
#include <cstdio>
#include <cstdint>
#include <cmath>
namespace pg8 {
#define PG8_LAS __attribute__((address_space(3)))
typedef unsigned short bf16_t;
typedef short bf16x8 __attribute__((ext_vector_type(8)));
typedef float f32x4 __attribute__((ext_vector_type(4)));
typedef unsigned u32x4 __attribute__((ext_vector_type(4)));
constexpr int BM = 256, BK = 64, HALF = 128, HTB = HALF * BK * 2  , STAGE_BYTES = 8 * HTB, NXCD = 8, WGM = 8;

__host__ __device__ __forceinline__ int lds_byte(int r, int c) { const int st = (r >> 4) * 2 + (c >> 5), rr = r & 15, cc = c & 31, ob = rr * 64 + cc * 2; return st * 1024 + (ob ^ (((ob >> 9) & 1) << 5)); }
__host__ __device__ __forceinline__ void stage_rc(int b, int& R, int& C) { const int st = b / 1024, sb = b % 1024, swz = sb ^ (((sb >> 9) & 1) << 5); R = (st >> 1) * 16 + swz / 64; C = (st & 1) * 32 + (swz % 64) / 2; }
__host__ __device__ __forceinline__ int perm32(int rho) { const int n = rho >> 4, i = rho & 15; return 8 * (i >> 2) + 4 * n + (i & 3); }

struct Unit { int pm, pn; };
struct Gemm { const bf16_t* A; const bf16_t* Bt; int M, N, K; };

struct StaticOrder {
    int nM, nN, nwg, G, c;
    __host__ __device__ __forceinline__ void init(int M, int N, int G_, int c_) { nM = M / BM; nN = N / BM; nwg = nM * nN; G = G_; c = c_; }
    __host__ __device__ __forceinline__ bool next(int i, Unit& u) const {
        const long L = (long)i * G + c; if (L >= nwg) return false;
        int wgid = (int)L; { const int q = nwg / NXCD, r = nwg % NXCD, xcd = wgid % NXCD, off = wgid / NXCD; wgid = (xcd < r ? xcd * (q + 1) : r * (q + 1) + (xcd - r) * q) + off; }
        const int nig = WGM * nN, gid = wgid / nig, fm = gid * WGM, gsz = (nM - fm) < WGM ? (nM - fm) : WGM;
        u.pm = fm + ((wgid % nig) % gsz); u.pn = (wgid % nig) / gsz; return true;
    }
    __device__ __forceinline__ void a_ready(const Unit&) const {}
    __device__ __forceinline__ void done(const Unit&) const {}
};

__device__ __forceinline__ unsigned cvt_pk_bf16(float lo, float hi) { unsigned r; asm volatile("v_cvt_pk_bf16_f32 %0, %1, %2" : "=v"(r) : "v"(lo), "v"(hi)); return r; }
typedef float f32x2 __attribute__((ext_vector_type(2)));
__device__ __forceinline__ f32x2 gelu_pk(f32x2 v) {
    const f32x2 av = __builtin_elementwise_abs(v), d = av * 0.2316418882f + 1.0f;
    f32x2 t; t.x = __builtin_amdgcn_rcpf(d.x); t.y = __builtin_amdgcn_rcpf(d.y);
    f32x2 q = t * 0.5307027145f + (-0.7265760135f); q = q * t + 0.7107068705f; q = q * t + (-0.142248368f); q = q * t + 0.127414796f; q = q * t;
    const f32x2 s = (v * v) * (-0.72134752044f);
    f32x2 e; e.x = __builtin_amdgcn_exp2f(s.x); e.y = __builtin_amdgcn_exp2f(s.y);
    const f32x2 m = v * (q * e), r = v - m;
    f32x2 o; o.x = v.x < 0.f ? m.x : r.x; o.y = v.y < 0.f ? m.y : r.y; return o;
}

template <int ACT  > struct EpiBf16 {
    static constexpr bool PERM = true, AFTER_DRAIN = false, HAS_MID = false; static_assert(ACT == 0 || ACT == 1, "EpiBf16: ACT is 0 (none) or 1 (gelu_pk)");
    bf16_t* O; int ldc; const float* bias; int split_cols; size_t split_stride; float scale0;
    __device__ __forceinline__ void operator()(const f32x4 (&acc)[2][2][4][2], const Unit& u, int wr, int wc, int fr, int fq) const {
        const int row0 = u.pm * BM + wr * 64 + fr; int colt = u.pn * BM; bf16_t* base = O;
        float sc = 1.f; if (split_cols) { const int t = colt / split_cols; base += (size_t)t * split_stride; colt -= t * split_cols; if (t == 0) sc = scale0; }
        const int col0 = colt + wc * 32 + 8 * fq, bcol0 = u.pn * BM + wc * 32 + 8 * fq;
        f32x4 bv[2][2];
#pragma unroll
        for (int bj = 0; bj < 2; ++bj)
#pragma unroll
            for (int n = 0; n < 2; ++n) bv[bj][n] = bias ? *(const f32x4*)(bias + bcol0 + bj * HALF + 4 * n) : (f32x4){0.f, 0.f, 0.f, 0.f};
#pragma unroll
        for (int ai = 0; ai < 2; ++ai)
#pragma unroll
            for (int m = 0; m < 4; ++m) { bf16_t* rowp = base + (size_t)(row0 + ai * HALF + m * 16) * ldc + col0;
#pragma unroll
                for (int bj = 0; bj < 2; ++bj) { f32x4 v0 = acc[ai][bj][m][0] + bv[bj][0], v1 = acc[ai][bj][m][1] + bv[bj][1];
                    if (ACT == 1) { f32x2 a = gelu_pk((f32x2){v0[0], v0[1]}), b = gelu_pk((f32x2){v0[2], v0[3]}), c = gelu_pk((f32x2){v1[0], v1[1]}), d = gelu_pk((f32x2){v1[2], v1[3]});
                        v0 = (f32x4){a.x, a.y, b.x, b.y}; v1 = (f32x4){c.x, c.y, d.x, d.y}; }
                    v0 = v0 * sc; v1 = v1 * sc; u32x4 w; w.x = cvt_pk_bf16(v0[0], v0[1]); w.y = cvt_pk_bf16(v0[2], v0[3]); w.z = cvt_pk_bf16(v1[0], v1[1]); w.w = cvt_pk_bf16(v1[2], v1[3]);
                    *(u32x4*)(rowp + bj * HALF) = w; } }
    }
};
template <class Epi, class Sched, bool ALIGN_EPI = false, bool SP2 = false>
__device__ __forceinline__ void gemm_phase(PG8_LAS unsigned char* lds, const Gemm g, const Sched& S, const Epi& E) {
    const int tid = threadIdx.x, wid = __builtin_amdgcn_readfirstlane(tid >> 6), lane = tid & 63, wr = wid >> 2, wc = wid & 3, fr = lane & 15, fq = lane >> 4;
    const int K = g.K, nt = K / BK;
    unsigned voffA[2], voffB[2];
#pragma unroll
    for (int i = 0; i < 2; ++i) { int R, C; stage_rc(tid * 16 + i * 8192, R, C); const int Rb = Epi::PERM ? ((R & ~31) + perm32(R & 31)) : R;
        voffA[i] = (unsigned)(R * K + C) * 2u; voffB[i] = (unsigned)(Rb * K + C) * 2u; }
    const size_t kstep = (size_t)(BK * 2);
    const size_t hstep = (size_t)HALF * K * 2;
    const size_t tstep = 2 * hstep;
    const unsigned ldsw = (unsigned)wid * 1024u;
    const int aoff = lds_byte(wr * 64 + fr, fq * 8), boff = lds_byte(wc * 32 + fr, fq * 8);
#define PG8_SA(b, h) (((b) * 2 + (h)) * HTB)
#define PG8_SB(b, h) ((4 + (b) * 2 + (h)) * HTB)
#define PG8_STAGE(bufoff, gbase, voff) do { _Pragma("unroll") for (int _i = 0; _i < 2; ++_i) \
        __builtin_amdgcn_global_load_lds((const unsigned*)((const char*)(gbase) + (voff)[_i]), (PG8_LAS unsigned*)(lds + (bufoff) + ldsw + _i * 8192), 16, 0, 0); } while (0)
#define PG8_LDA(dst, b, h) do { _Pragma("unroll") for (int m = 0; m < 4; ++m) _Pragma("unroll") for (int k = 0; k < 2; ++k) dst[m][k] = *(const PG8_LAS bf16x8*)(lds + PG8_SA(b, h) + aoff + m * 2048 + k * 1024); } while (0)
#define PG8_LDB(dst, b, h) do { _Pragma("unroll") for (int n = 0; n < 2; ++n) _Pragma("unroll") for (int k = 0; k < 2; ++k) dst[n][k] = *(const PG8_LAS bf16x8*)(lds + PG8_SB(b, h) + boff + n * 2048 + k * 1024); } while (0)
#define PG8_MMA(ai, bj, At, Bt) do { __builtin_amdgcn_s_setprio(1); _Pragma("unroll") for (int m = 0; m < 4; ++m) _Pragma("unroll") for (int n = 0; n < 2; ++n) _Pragma("unroll") for (int k = 0; k < 2; ++k) \
        acc[ai][bj][m][n] = __builtin_amdgcn_mfma_f32_16x16x32_bf16(Bt[n][k], At[m][k], acc[ai][bj][m][n], 0, 0, 0); __builtin_amdgcn_s_setprio(0); } while (0)
#define PG8_WAIT_V(n) asm volatile("s_waitcnt vmcnt(" #n ")" ::: "memory")
#define PG8_WAIT_L(n) asm volatile("s_waitcnt lgkmcnt(" #n ")" ::: "memory")
#define PG8_BAR __builtin_amdgcn_s_barrier()
#define PG8_SCHED __builtin_amdgcn_sched_barrier(0)
    Unit cur, nxt; int ui = 0;
    if (!S.next(0, cur)) return;
    f32x4 acc[2][2][4][2];
#pragma unroll
    for (int a = 0; a < 2; ++a)
#pragma unroll
        for (int b = 0; b < 2; ++b)
#pragma unroll
            for (int m = 0; m < 4; ++m)
#pragma unroll
                for (int n = 0; n < 2; ++n) acc[a][b][m][n] = (f32x4){0.f, 0.f, 0.f, 0.f};
    bf16x8 At[4][2], B0[2][2], B1[2][2];
    const char* cA = (const char*)g.A + (size_t)cur.pm * tstep; const char* cB = (const char*)g.Bt + (size_t)cur.pn * tstep;
    S.a_ready(cur);
    if constexpr (SP2) {
        PG8_STAGE(PG8_SB(0, 0), cB, voffB); PG8_STAGE(PG8_SB(0, 1), cB + hstep, voffB); PG8_STAGE(PG8_SA(0, 0), cA, voffA); PG8_STAGE(PG8_SA(0, 1), cA + hstep, voffA);
        if (wr == 1) PG8_BAR;
        PG8_WAIT_V(2); PG8_BAR;
        PG8_STAGE(PG8_SB(1, 0), cB + kstep, voffB); PG8_STAGE(PG8_SA(1, 0), cA + kstep, voffA); PG8_STAGE(PG8_SB(1, 1), cB + hstep + kstep, voffB);
        PG8_WAIT_V(6); PG8_BAR;
    } else {
        PG8_STAGE(PG8_SB(0, 0), cB, voffB); PG8_STAGE(PG8_SA(0, 0), cA, voffA); PG8_STAGE(PG8_SB(0, 1), cB + hstep, voffB); PG8_STAGE(PG8_SA(0, 1), cA + hstep, voffA);
        if (wr == 1) PG8_BAR;
        PG8_WAIT_V(4); PG8_BAR;
        PG8_STAGE(PG8_SB(1, 0), cB + kstep, voffB); PG8_STAGE(PG8_SA(1, 0), cA + kstep, voffA); PG8_STAGE(PG8_SB(1, 1), cB + hstep + kstep, voffB);
        PG8_WAIT_V(6); PG8_BAR;
    }
    for (;;) {
        const bool has_next = S.next(ui + 1, nxt);
        const char* nA = has_next ? (const char*)g.A + (size_t)nxt.pm * tstep : cA; const char* nB = has_next ? (const char*)g.Bt + (size_t)nxt.pn * tstep : cB;
        for (int t = 0; t < nt; t += 2) {
            const bool last = (t == nt - 2);
            if constexpr (Epi::HAS_MID) { if (t == nt / 2) E.mid(acc, cur, wr, wc, fr, fq, lds); }
            const char* a1 = cA + (size_t)(t + 1) * kstep;
            const char* a2 = last ? nA : cA + (size_t)(t + 2) * kstep; const char* b2 = last ? nB : cB + (size_t)(t + 2) * kstep;
            const char* a3 = a2 + kstep; const char* b3 = b2 + kstep;
            if (last && has_next) S.a_ready(nxt);
            if constexpr (SP2) {
            PG8_LDB(B0, 0, 0); PG8_LDB(B1, 0, 1); PG8_SCHED; PG8_LDA(At, 0, 0); PG8_STAGE(PG8_SA(1, 1), a1 + hstep, voffA);
            PG8_WAIT_V(8); PG8_WAIT_L(0); PG8_BAR; PG8_MMA(0, 0, At, B0); PG8_MMA(0, 1, At, B1); PG8_BAR; PG8_SCHED;
            PG8_LDA(At, 0, 1); PG8_STAGE(PG8_SB(0, 0), b2, voffB); PG8_STAGE(PG8_SB(0, 1), b2 + hstep, voffB); PG8_STAGE(PG8_SA(0, 0), a2, voffA);
            PG8_WAIT_V(8); PG8_WAIT_L(0); PG8_BAR; PG8_MMA(1, 0, At, B0); PG8_MMA(1, 1, At, B1); PG8_BAR; PG8_SCHED;
            PG8_LDB(B0, 1, 0); PG8_LDB(B1, 1, 1); PG8_SCHED; PG8_LDA(At, 1, 0); PG8_STAGE(PG8_SA(0, 1), a2 + hstep, voffA);
            PG8_WAIT_V(8); PG8_WAIT_L(0); PG8_BAR; PG8_MMA(0, 0, At, B0); PG8_MMA(0, 1, At, B1); PG8_BAR; PG8_SCHED;
            PG8_LDA(At, 1, 1); PG8_STAGE(PG8_SB(1, 0), b3, voffB); PG8_STAGE(PG8_SB(1, 1), b3 + hstep, voffB); PG8_STAGE(PG8_SA(1, 0), a3, voffA);
            PG8_WAIT_V(8); PG8_WAIT_L(0); PG8_BAR; PG8_MMA(1, 0, At, B0); PG8_MMA(1, 1, At, B1); PG8_BAR; PG8_SCHED;
            } else {
            PG8_LDB(B0, 0, 0); PG8_SCHED; PG8_LDA(At, 0, 0); PG8_STAGE(PG8_SA(1, 1), a1 + hstep, voffA);
            PG8_WAIT_L(8); PG8_BAR; PG8_WAIT_L(0); PG8_MMA(0, 0, At, B0); PG8_BAR; PG8_SCHED;
            PG8_LDB(B1, 0, 1); PG8_STAGE(PG8_SB(0, 0), b2, voffB);
            PG8_BAR; PG8_WAIT_L(0); PG8_MMA(0, 1, At, B1); PG8_BAR;
            PG8_LDA(At, 0, 1); PG8_STAGE(PG8_SA(0, 0), a2, voffA);
            PG8_BAR; PG8_WAIT_L(0); PG8_MMA(1, 0, At, B0); PG8_BAR; PG8_SCHED;
            PG8_STAGE(PG8_SB(0, 1), b2 + hstep, voffB);
            PG8_WAIT_V(6); PG8_BAR; PG8_MMA(1, 1, At, B1); PG8_BAR;
            PG8_LDB(B0, 1, 0); PG8_SCHED; PG8_LDA(At, 1, 0); PG8_STAGE(PG8_SA(0, 1), a2 + hstep, voffA);
            PG8_WAIT_L(8); PG8_BAR; PG8_WAIT_L(0); PG8_MMA(0, 0, At, B0); PG8_BAR; PG8_SCHED;
            PG8_LDB(B1, 1, 1); PG8_STAGE(PG8_SB(1, 0), b3, voffB);
            PG8_BAR; PG8_WAIT_L(0); PG8_MMA(0, 1, At, B1); PG8_BAR;
            PG8_LDA(At, 1, 1); PG8_STAGE(PG8_SA(1, 0), a3, voffA);
            PG8_BAR; PG8_WAIT_L(0); PG8_MMA(1, 0, At, B0); PG8_BAR; PG8_SCHED;
            PG8_STAGE(PG8_SB(1, 1), b3 + hstep, voffB);
            PG8_WAIT_V(6); PG8_BAR; PG8_MMA(1, 1, At, B1); PG8_BAR;
            }
        }
        if constexpr (ALIGN_EPI) { if (wr == 0) PG8_BAR; }
        if constexpr (!Epi::AFTER_DRAIN) { E(acc, cur, wr, wc, fr, fq); S.done(cur); }
        if (!has_next) break;
#pragma unroll
        for (int a = 0; a < 2; ++a)
#pragma unroll
            for (int b = 0; b < 2; ++b)
#pragma unroll
                for (int m = 0; m < 4; ++m)
#pragma unroll
                    for (int n = 0; n < 2; ++n) acc[a][b][m][n] = (f32x4){0.f, 0.f, 0.f, 0.f};
        cur = nxt; cA = nA; cB = nB; ++ui;
        if constexpr (ALIGN_EPI) { if (wr == 1) PG8_BAR; }
    }
    PG8_WAIT_V(0);
    if constexpr (!ALIGN_EPI) { if (wr == 0) PG8_BAR; }
    PG8_BAR;
    if constexpr (Epi::AFTER_DRAIN) { E.fused(acc, cur, wr, wc, fr, fq, lds, wid, lane); S.done(cur); }
#undef PG8_SA
#undef PG8_SB
#undef PG8_STAGE
#undef PG8_LDA
#undef PG8_LDB
#undef PG8_MMA
#undef PG8_WAIT_V
#undef PG8_WAIT_L
#undef PG8_BAR
#undef PG8_SCHED
}
}

namespace mk {
#define LAS __attribute__((address_space(3)))
typedef unsigned short bf16_t;
typedef short bf16x8 __attribute__((ext_vector_type(8)));
typedef float f32x4 __attribute__((ext_vector_type(4)));
typedef float f32x16 __attribute__((ext_vector_type(16)));
typedef unsigned u32x4 __attribute__((ext_vector_type(4)));
typedef unsigned u32x2 __attribute__((ext_vector_type(2)));
typedef __bf16 bf16x2_t __attribute__((ext_vector_type(2)));
typedef float f32x2_t __attribute__((ext_vector_type(2)));
typedef unsigned u32;

constexpr int DM = 1024, SEQ = 16384, NMETA = 16, MPAD = 16640, INW = 1280;
constexpr int O_K = 512, O_V = 640, O_U = 768;
constexpr int NCH = 513;
constexpr float EPS = 1e-6f;
constexpr float LOG2E = 1.4426950408889634f;
constexpr int NWAVES = 8, NTHR = 512;
constexpr int LDS_BYTES = 163840;
constexpr int MISC_OFF = LDS_BYTES - 128;

constexpr size_t MiB = 1u << 20;
constexpr size_t WS_CTL = 0, CTL_BYTES = 1 * MiB;
constexpr size_t WS_WIN_T = 1 * MiB;
constexpr size_t WS_WOUT_T = 4 * MiB;
constexpr size_t WS_WQ_T = 6 * MiB;
constexpr size_t WS_GLU_T = 10 * MiB;
constexpr size_t WS_SUBK = 10 * MiB + 512 * 1024;
constexpr size_t WS_KT = 11 * MiB;
constexpr size_t WS_F = 12 * MiB;
constexpr size_t WS_E = 16 * MiB;
constexpr size_t WS_ABART = 20 * MiB;
constexpr size_t WS_SLOC = 21 * MiB;
constexpr size_t WS_CARRY = 30 * MiB;
constexpr size_t WS_BUFA = 39 * MiB;
constexpr size_t WS_PROJ = 72 * MiB;
constexpr size_t WS_ATTN = 113 * MiB;
constexpr size_t WS_Z = 129 * MiB;
constexpr size_t WS_SSMO = 145 * MiB;
constexpr size_t WS_QP = 72 * MiB;
constexpr size_t WS_IDX = 161 * MiB;
constexpr size_t WS_GW = 169 * MiB;
constexpr size_t WS_PU = 177 * MiB;
constexpr size_t WS_PV = 193 * MiB;
constexpr size_t WS_SU = 209 * MiB;
constexpr size_t WS_SV = 209 * MiB + 65536;
constexpr size_t WS_HB = 210 * MiB;
constexpr size_t WS_SSA = 242 * MiB;
constexpr size_t WS_SSS = 242 * MiB + 512 * 1024;
constexpr size_t WS_SSH = 243 * MiB;
constexpr size_t WS_END = 245 * MiB;

struct Params { const float* in[25]; float* out; unsigned char* ws; int ph_lo, ph_hi; };
enum { I_X = 0, I_META, I_N1G, I_WIN, I_QNG, I_KNG, I_SINK, I_ARE, I_AIM, I_LDT, I_BRE, I_BIM, I_CRE, I_CIM, I_SD, I_GLUW, I_GLUB, I_AOG, I_SOG, I_WOUT, I_N2G, I_WQ, I_SUBK, I_PU, I_PV };

__device__ __forceinline__ unsigned pk2(float lo, float hi) { f32x2_t v = {lo, hi}; return __builtin_bit_cast(unsigned, __builtin_convertvector(v, bf16x2_t)); }
__device__ __forceinline__ float bflo(unsigned w) { return __uint_as_float(w << 16); }
__device__ __forceinline__ float bfhi(unsigned w) { return __uint_as_float(w & 0xffff0000u); }
__device__ __forceinline__ float wave_sum(float v) {
#pragma unroll
    for (int o = 1; o < 64; o <<= 1) v += __shfl_xor(v, o);
    return v;
}
#define LDS_WAIT() asm volatile("s_waitcnt lgkmcnt(0)" ::: "memory")
__device__ __forceinline__ float gelu_erf(float v) { return 0.5f * v * (1.0f + erff(v * 0.70710678118654752f)); }
__device__ __forceinline__ u32 f2ord(float f) { const u32 u = __float_as_uint(f); return (u & 0x80000000u) ? ~u : (u | 0x80000000u); }
__device__ __forceinline__ float ord2f(u32 o) { const u32 u = (o & 0x80000000u) ? (o & 0x7fffffffu) : ~o; return __uint_as_float(u); }
#define MFMA16(a, b, c) __builtin_amdgcn_mfma_f32_16x16x32_bf16((a), (b), (c), 0, 0, 0)
#define MFMA32(a, b, c) __builtin_amdgcn_mfma_f32_32x32x16_bf16((a), (b), (c), 0, 0, 0)

#define CEX(x, i, j) do { const u32 _a = x[i], _b = x[j]; x[i] = _a > _b ? _a : _b; x[j] = _a > _b ? _b : _a; } while (0)
__device__ __forceinline__ void sort16_desc(u32 (&x)[16]) {
#pragma unroll
    for (int k = 2; k <= 16; k <<= 1) {
#pragma unroll
        for (int j = k >> 1; j > 0; j >>= 1) {
#pragma unroll
            for (int i = 0; i < 16; ++i) { const int l = i ^ j; if (l > i) { if ((i & k) == 0) CEX(x, i, l); else CEX(x, l, i); } }
        }
    }
}
__device__ __forceinline__ void bmerge16_desc(u32 (&x)[16]) {
#pragma unroll
    for (int j = 8; j > 0; j >>= 1) {
#pragma unroll
        for (int i = 0; i < 16; ++i) { const int l = i ^ j; if (l > i) CEX(x, i, l); }
    }
}
__device__ __forceinline__ void merge_top16(u32 (&a)[16], const u32 (&b)[16]) {
#pragma unroll
    for (int i = 0; i < 16; ++i) a[i] = a[i] > b[15 - i] ? a[i] : b[15 - i];
    bmerge16_desc(a);
}
__device__ __forceinline__ void top16_of_64(u32 (&g0)[16], u32 (&g1)[16], u32 (&g2)[16], u32 (&g3)[16]) {
    sort16_desc(g0); sort16_desc(g1); sort16_desc(g2); sort16_desc(g3);
    merge_top16(g0, g1); merge_top16(g2, g3); merge_top16(g0, g2);
}
__device__ const unsigned char CAND_AB[64] = {0, 1, 2, 3, 4, 5, 6, 7, 8, 9, 10, 11, 12, 13, 14, 15, 16, 17, 18, 19, 20, 21, 22, 23, 32, 33, 34, 35, 36, 48, 49, 50, 51, 64, 65, 66, 80, 81, 96, 97, 112, 113, 128, 144, 160, 176, 192, 208, 224, 240, 0, 0, 0, 0, 0, 0, 0, 0, 0, 0, 0, 0, 0, 0};

struct Ctx { LAS unsigned char* lds; int tid, lane, wave, G, bid; };

__device__ __forceinline__ void transpose_item(const float* W, int K, int N, bf16_t* WT, LAS float* scr, int item, int lane, const float* ks0 = nullptr, const float* ks1 = nullptr, int ksplit = 0) {
    const int nblk = N / 32, kb = item / nblk, nb = item % nblk, k0 = 64 * kb, n0 = 32 * nb;
#pragma unroll 8
    for (int i = 0; i < 32; ++i) { const int kk = 2 * i + (lane >> 5); float w = W[(size_t)(k0 + kk) * N + n0 + (lane & 31)];
        if (ks0) { const int k = k0 + kk; w *= (ksplit && k >= ksplit) ? ks1[k - ksplit] : ks0[k]; }
        scr[kk * 33 + (lane & 31)] = w; }
    LDS_WAIT();
    const int c = lane & 7;
#pragma unroll
    for (int j = 0; j < 4; ++j) { const int n = (lane >> 3) + 8 * j; const LAS float* s = scr + (8 * c) * 33 + n;
        u32x4 o; o.x = pk2(s[0 * 33], s[1 * 33]); o.y = pk2(s[2 * 33], s[3 * 33]); o.z = pk2(s[4 * 33], s[5 * 33]); o.w = pk2(s[6 * 33], s[7 * 33]);
        *(u32x4*)(WT + (size_t)(n0 + n) * K + k0 + 8 * c) = o; }
    LDS_WAIT();
}

__device__ __forceinline__ void ssm_tables(const Ctx& C, const Params& P, int g) {
    LAS float* pwr = (LAS float*)C.lds;
    LAS float* pwi = pwr + 33 * 64;
    LAS float* bbr = pwi + 33 * 64;
    LAS float* bbi = bbr + 1024;
    LAS float* ccr = bbi + 1024;
    LAS float* cci = ccr + 1024;
    LAS float* cfr = cci + 1024;
    LAS float* cfi = cfr + 64;
    const int tid = C.tid;
    const float dt = expf(P.in[I_LDT][g]);
    for (int e = tid; e < 33 * 64; e += NTHR) {
        const int l = e >> 6, n = e & 63;
        const float lr = P.in[I_ARE][g * 64 + n], li = P.in[I_AIM][g * 64 + n];
        const float x = lr * dt * (float)l, th = li * dt * (float)l, mag = expf(x);
        float s, c; sincosf(th, &s, &c);
        pwr[e] = mag * c; pwi[e] = mag * s;
        if (l == 32) { float* abt = (float*)(P.ws + WS_ABART) + (g * 64 + n) * 2; abt[0] = mag * c; abt[1] = mag * s; }
    }
    if (tid < 64) {
        const int n = tid;
        const float lr = P.in[I_ARE][g * 64 + n], li = P.in[I_AIM][g * 64 + n];
        const float x1 = lr * dt, th1 = li * dt, em1 = expm1f(x1);
        float s1, c1; sincosf(th1, &s1, &c1);
        const float sh = sinf(0.5f * th1);
        const float nr = em1 * c1 - 2.0f * sh * sh, ni = (em1 + 1.0f) * s1;
        const float den = lr * lr + li * li;
        cfr[n] = (nr * lr + ni * li) / den; cfi[n] = (ni * lr - nr * li) / den;
    }
    __syncthreads();
    for (int e = tid; e < 1024; e += NTHR) {
        const int n = e >> 4;
        const float br = P.in[I_BRE][g * 1024 + e], bi = P.in[I_BIM][g * 1024 + e];
        bbr[e] = cfr[n] * br - cfi[n] * bi; bbi[e] = cfr[n] * bi + cfi[n] * br;
        ccr[e] = P.in[I_CRE][g * 1024 + e]; cci[e] = P.in[I_CIM][g * 1024 + e];
    }
    __syncthreads();
    bf16_t* Kt = (bf16_t*)(P.ws + WS_KT) + (size_t)g * 8448;
    {
        const int pq = tid & 255, p = pq >> 4, q = pq & 15, l0 = (tid >> 8) * 16;
        float val[16];
#pragma unroll
        for (int i = 0; i < 16; ++i) val[i] = 0.f;
#pragma unroll
        for (int n0 = 0; n0 < 64; n0 += 16) {
            float cbr[16], cbi[16];
#pragma unroll
            for (int n = 0; n < 16; ++n) { const float cr = ccr[p * 64 + n0 + n], ci = cci[p * 64 + n0 + n], br = bbr[(n0 + n) * 16 + q], bi = bbi[(n0 + n) * 16 + q]; cbr[n] = cr * br - ci * bi; cbi[n] = cr * bi + ci * br; }
#pragma unroll
            for (int i = 0; i < 16; ++i) {
                const int lg = l0 + i;
#pragma unroll
                for (int n = 0; n < 16; n += 4) {
                    const f32x4 ar = *(const LAS f32x4*)(pwr + lg * 64 + n0 + n), ai = *(const LAS f32x4*)(pwi + lg * 64 + n0 + n);
                    val[i] += cbr[n] * ar.x - cbi[n] * ai.x; val[i] += cbr[n + 1] * ar.y - cbi[n + 1] * ai.y; val[i] += cbr[n + 2] * ar.z - cbi[n + 2] * ai.z; val[i] += cbr[n + 3] * ar.w - cbi[n + 3] * ai.w;
                }
            }
        }
#pragma unroll
        for (int i = 0; i < 16; ++i) Kt[(l0 + i + 1) * 256 + pq] = (bf16_t)(pk2(val[i], 0.f) & 0xffffu);
        if (tid < 256) Kt[tid] = 0;
    }
    bf16_t* F = (bf16_t*)(P.ws + WS_F) + (size_t)g * 65536;
    for (int e8 = tid; e8 < 8192; e8 += NTHR) {
        const int n2 = e8 >> 6, k0 = (e8 & 63) * 8, j = k0 >> 4, q0 = k0 & 15, n = n2 & 63, l = 31 - j;
        const float ar = pwr[l * 64 + n], ai = pwi[l * 64 + n];
        float w[8];
#pragma unroll
        for (int i = 0; i < 8; ++i) { const float br = bbr[n * 16 + q0 + i], bi = bbi[n * 16 + q0 + i]; w[i] = (n2 < 64) ? (ar * br - ai * bi) : (ar * bi + ai * br); }
        u32x4 o; o.x = pk2(w[0], w[1]); o.y = pk2(w[2], w[3]); o.z = pk2(w[4], w[5]); o.w = pk2(w[6], w[7]);
        *(u32x4*)(F + (size_t)e8 * 8) = o;
    }
    bf16_t* E = (bf16_t*)(P.ws + WS_E) + (size_t)g * 65536;
    for (int e8 = tid; e8 < 8192; e8 += NTHR) {
        const int row = e8 >> 4, n20 = (e8 & 15) * 8, t = row >> 4, p = row & 15, n0 = n20 & 63;
        float w[8];
#pragma unroll
        for (int i = 0; i < 8; ++i) { const int n = n0 + i; const float pr = pwr[(t + 1) * 64 + n], pi = pwi[(t + 1) * 64 + n], cr = ccr[p * 64 + n], ci = cci[p * 64 + n];
            w[i] = (n20 < 64) ? (cr * pr - ci * pi) : -(cr * pi + ci * pr); }
        u32x4 o; o.x = pk2(w[0], w[1]); o.y = pk2(w[2], w[3]); o.z = pk2(w[4], w[5]); o.w = pk2(w[6], w[7]);
        *(u32x4*)(E + (size_t)e8 * 8) = o;
    }
    __syncthreads();
}

__device__ __forceinline__ void norm_row_to_bf16(const float* src, const float* gam, bf16_t* dst, int lane) {
    const f32x4* xr = (const f32x4*)src + lane; const f32x4* gr = (const f32x4*)gam + lane;
    f32x4 v[4]; float s = 0.f;
#pragma unroll
    for (int j = 0; j < 4; ++j) { v[j] = xr[64 * j]; s += (v[j].x * v[j].x + v[j].y * v[j].y) + (v[j].z * v[j].z + v[j].w * v[j].w); }
    const float rinv = 1.0f / sqrtf(wave_sum(s) * (1.0f / DM) + EPS);
    u32x2* o = (u32x2*)dst + lane;
#pragma unroll
    for (int j = 0; j < 4; ++j) { const f32x4 g = gr[64 * j]; u32x2 w; w.x = pk2(v[j].x * rinv * g.x, v[j].y * rinv * g.y); w.y = pk2(v[j].z * rinv * g.z, v[j].w * rinv * g.w); o[64 * j] = w; }
}

__device__ __forceinline__ void cvt8(const float* src, bf16_t* dst, size_t i) {
    const f32x4 a = ((const f32x4*)src)[2 * i], b = ((const f32x4*)src)[2 * i + 1];
    u32x4 o; o.x = pk2(a.x, a.y); o.y = pk2(a.z, a.w); o.z = pk2(b.x, b.y); o.w = pk2(b.z, b.w);
    ((u32x4*)dst)[i] = o;
}

__device__ __forceinline__ float wave_max(float m) {
    m = fmaxf(m, __builtin_bit_cast(float, __builtin_amdgcn_update_dpp(0, __builtin_bit_cast(int, m), 0xB1, 0xf, 0xf, true)));
    m = fmaxf(m, __builtin_bit_cast(float, __builtin_amdgcn_update_dpp(0, __builtin_bit_cast(int, m), 0x4E, 0xf, 0xf, true)));
    m = fmaxf(m, __builtin_bit_cast(float, __builtin_amdgcn_update_dpp(0, __builtin_bit_cast(int, m), 0x141, 0xf, 0xf, true)));
    m = fmaxf(m, __builtin_bit_cast(float, __builtin_amdgcn_update_dpp(0, __builtin_bit_cast(int, m), 0x140, 0xf, 0xf, true)));
    u32 x = __builtin_bit_cast(u32, m);
    { u32 b = x; asm volatile("" : "+v"(b)); const auto p = __builtin_amdgcn_permlane16_swap(x, b, false, false); x = p[0] > p[1] ? p[0] : p[1]; }
    { u32 b = x; asm volatile("" : "+v"(b)); const auto p = __builtin_amdgcn_permlane32_swap(x, b, false, false); x = p[0] > p[1] ? p[0] : p[1]; }
    m = __builtin_bit_cast(float, x);
    return m;
}
template <int NR> __device__ __forceinline__ void quant_rows(const Params& P, const int (&rr)[NR], int lane) {
    f32x4 v[NR][4]; float m[NR];
#pragma unroll
    for (int i = 0; i < NR; ++i) {
        const bool isv = rr[i] >= 16384; const int row = isv ? rr[i] - 16384 : rr[i];
        const f32x4* src = (const f32x4*)((isv ? P.in[I_PV] : P.in[I_PU]) + (size_t)row * DM) + lane;
#pragma unroll
        for (int j = 0; j < 4; ++j) v[i][j] = __builtin_nontemporal_load(src + 64 * j);
    }
#pragma unroll
    for (int i = 0; i < NR; ++i) {
        float mm = 0.f;
#pragma unroll
        for (int j = 0; j < 4; ++j) mm = fmaxf(mm, fmaxf(fmaxf(fabsf(v[i][j].x), fabsf(v[i][j].y)), fmaxf(fabsf(v[i][j].z), fabsf(v[i][j].w))));
        m[i] = wave_max(mm);
    }
#pragma unroll
    for (int i = 0; i < NR; ++i) {
        const bool isv = rr[i] >= 16384; const int row = isv ? rr[i] - 16384 : rr[i];
        const float top = isv ? 416.0f : 127.0f;
        const float sc = (m[i] > 0.f) ? m[i] / top : 1.0f, inv = (m[i] > 0.f) ? top / m[i] : 0.f;
        u32x4 w;
#pragma unroll
        for (int j = 0; j < 4; ++j) {
            if (isv) {
                int t = __builtin_amdgcn_cvt_pk_fp8_f32(v[i][j].x * inv, v[i][j].y * inv, 0, false);
                t = __builtin_amdgcn_cvt_pk_fp8_f32(v[i][j].z * inv, v[i][j].w * inv, t, true);
                w[j] = (u32)t;
            } else {
                const int q0 = (int)rintf(v[i][j].x * inv), q1 = (int)rintf(v[i][j].y * inv), q2 = (int)rintf(v[i][j].z * inv), q3 = (int)rintf(v[i][j].w * inv);
                w[j] = (u32)(q0 & 255) | ((u32)(q1 & 255) << 8) | ((u32)(q2 & 255) << 16) | ((u32)(q3 & 255) << 24);
            }
        }
        *(u32x4*)(P.ws + (isv ? WS_PV : WS_PU) + (size_t)row * 1024 + 16 * lane) = w;
        if (lane == 0) ((float*)(P.ws + (isv ? WS_SV : WS_SU)))[row] = sc;
    }
}
template <int NR> __device__ __forceinline__ void xn_rows(const Params& P, const int (&mm)[NR], int lane) {
    bf16_t* xn = (bf16_t*)(P.ws + WS_BUFA);
    f32x4 v[NR][4]; f32x4 g[4];
#pragma unroll
    for (int j = 0; j < 4; ++j) g[j] = ((const f32x4*)P.in[I_N1G])[64 * j + lane];
#pragma unroll
    for (int i = 0; i < NR; ++i) {
        const int m = mm[i];
        const float* src = (m < SEQ) ? P.in[I_X] + (size_t)m * DM : P.in[I_META] + (size_t)((m < SEQ + NMETA) ? (m - SEQ) : 0) * DM;
#pragma unroll
        for (int j = 0; j < 4; ++j) v[i][j] = ((const f32x4*)src)[64 * j + lane];
    }
#pragma unroll
    for (int i = 0; i < NR; ++i) {
        const int m = mm[i];
        float ss = 0.f;
#pragma unroll
        for (int j = 0; j < 4; ++j) ss += (v[i][j].x * v[i][j].x + v[i][j].y * v[i][j].y) + (v[i][j].z * v[i][j].z + v[i][j].w * v[i][j].w);
        float rinv = 1.0f / sqrtf(wave_sum(ss) * (1.0f / DM) + EPS);
        if (m >= SEQ + NMETA) rinv = 0.f;
        u32x2* o = (u32x2*)(xn + (size_t)m * DM) + lane;
#pragma unroll
        for (int j = 0; j < 4; ++j) { u32x2 w; w.x = pk2(v[i][j].x * rinv * g[j].x, v[i][j].y * rinv * g[j].y); w.y = pk2(v[i][j].z * rinv * g[j].z, v[i][j].w * rinv * g[j].w); o[64 * j] = w; }
    }
}
__device__ __forceinline__ void phase_prologue(const Ctx& C, const Params& P) {
    LAS float* scr = (LAS float*)(C.lds + C.wave * 16384);
    const int gw = C.bid * NWAVES + C.wave, NGW = C.G * NWAVES;
    for (int it = gw; it < 16 * 40; it += NGW) transpose_item(P.in[I_WIN], 1024, 1280, (bf16_t*)(P.ws + WS_WIN_T), scr, it, C.lane);
    for (int m = gw; m < MPAD; m += 4 * NGW) {
        if (m + 3 * NGW < MPAD) { const int mm[4] = {m, m + NGW, m + 2 * NGW, m + 3 * NGW}; xn_rows<4>(P, mm, C.lane); }
        else { for (int q = m; q < MPAD; q += NGW) { const int mm[1] = {q}; xn_rows<1>(P, mm, C.lane); } }
    }
}
__device__ __forceinline__ void deferred_a(const Ctx& C0, const Params& P, int ib, int nib) {
    Ctx C = C0; asm volatile("" : "+v"(C.tid), "+v"(C.lane));
    __syncthreads();
    const int nssm = (nib >= 64) ? 32 : 0;
    if (!nssm || ib < 32) { for (int g = ib; g < 32; g += (nssm ? 32 : nib)) ssm_tables(C, P, g); }
    if (nssm && ib < 32) return;
    __syncthreads();
    LAS float* scr = (LAS float*)(C.lds + C.wave * 16384);
    const int gw = (ib - nssm) * NWAVES + C.wave, NGW = (nib - nssm) * NWAVES;
    for (int it = gw; it < 8 * 16; it += NGW) transpose_item(P.in[I_GLUW], 512, 512, (bf16_t*)(P.ws + WS_GLU_T), scr, it, C.lane);
    for (int r = gw; r < 2 * 16384; r += 4 * NGW) {
        if (r + 3 * NGW < 2 * 16384) { const int rr[4] = {r, r + NGW, r + 2 * NGW, r + 3 * NGW}; quant_rows<4>(P, rr, C.lane); }
        else { for (int q = r; q < 2 * 16384; q += NGW) { const int rr[1] = {q}; quant_rows<1>(P, rr, C.lane); } }
    }
    const size_t gt = (size_t)(ib - nssm) * NTHR + C.tid, NT = (size_t)(nib - nssm) * NTHR;
    for (size_t i = gt; i < 262144 / 8; i += NT) cvt8(P.in[I_SUBK], (bf16_t*)(P.ws + WS_SUBK), i);
}
__device__ __forceinline__ void deferred_b(const Ctx& C0, const Params& P, int ib, int nib) {
    Ctx C = C0; asm volatile("" : "+v"(C.tid), "+v"(C.lane));
    __syncthreads();
    LAS float* scr = (LAS float*)(C.lds + C.wave * 16384);
    const int gw = ib * NWAVES + C.wave, NGW = nib * NWAVES;
    constexpr int I_OUT = 16 * 32, I_Q = 16 * 64;
    for (int it = gw; it < I_OUT + I_Q; it += NGW) {
        if (it < I_OUT) transpose_item(P.in[I_WOUT], 1024, 1024, (bf16_t*)(P.ws + WS_WOUT_T), scr, it, C.lane, P.in[I_AOG], P.in[I_SOG], 512);
        else transpose_item(P.in[I_WQ], 1024, 2048, (bf16_t*)(P.ws + WS_WQ_T), scr, it - I_OUT, C.lane, P.in[I_N2G]);
    }
}

__device__ __forceinline__ bf16x8 u_frag(const bf16_t* proj, int ci, int j, int g, int half) {
    const bool ok = (ci == 0) ? (j >= 16) : (ci < NCH);
    int row = (ci == 0) ? (SEQ + j - 16) : ((ci - 1) * 32 + j);
    row = ok ? row : 0;
    const u32x4 w = *(const u32x4*)(proj + (size_t)row * INW + O_U + g * 16 + half * 8);
    u32x4 z; z.x = ok ? w.x : 0u; z.y = ok ? w.y : 0u; z.z = ok ? w.z : 0u; z.w = ok ? w.w : 0u;
    return __builtin_bit_cast(bf16x8, z);
}

constexpr int F_PITCH = 1040;
__device__ __forceinline__ void phase_sloc(const Ctx& C, const Params& P) {
    const bf16_t* proj = (const bf16_t*)(P.ws + WS_PROJ);
    float* SL = (float*)(P.ws + WS_SLOC);
    const int n = C.lane & 15, kq = C.lane >> 4;
    for (int bu = C.bid; bu < 160; bu += C.G) {
        const int g = bu / 5, qtr = bu % 5, s = qtr * 8 + C.wave, ci = 16 * s + n;
        bf16x8 Bf[16];
#pragma unroll
        for (int ks = 0; ks < 16; ++ks) Bf[ks] = u_frag(proj, (s < 33) ? ci : NCH, 2 * ks + (kq >> 1), g, kq & 1);
        __syncthreads();
        { const u32x4* src = (const u32x4*)((const bf16_t*)(P.ws + WS_F) + (size_t)g * 65536);
          u32x4 t[16];
#pragma unroll
          for (int i = 0; i < 16; ++i) t[i] = src[C.tid + NTHR * i];
#pragma unroll
          for (int i = 0; i < 16; ++i) { const int e = C.tid + NTHR * i; *(LAS u32x4*)(C.lds + (e >> 6) * F_PITCH + (e & 63) * 16) = t[i]; } }
        __syncthreads();
        if (s < 33) {
#pragma unroll 1
            for (int mt = 0; mt < 8; ++mt) {
                f32x4 acc = {0.f, 0.f, 0.f, 0.f};
#pragma unroll
                for (int ks = 0; ks < 16; ++ks) {
                    const bf16x8 A = *(const LAS bf16x8*)(C.lds + (mt * 16 + n) * F_PITCH + (32 * ks + 8 * kq) * 2);
                    acc = MFMA16(A, Bf[ks], acc);
                }
                if (ci < NCH) *(f32x4*)(SL + ((size_t)ci * 32 + g) * 128 + mt * 16 + 4 * kq) = acc;
            }
        }
    }
}

__device__ __forceinline__ void carry_scan_block(const Ctx& C, const Params& P, int bk) {
    const float* SL = (const float*)(P.ws + WS_SLOC);
    float* CA = (float*)(P.ws + WS_CARRY);
    LAS float* Lr = (LAS float*)C.lds;
    LAS float* Li = Lr + 512;
    const int chan = bk * 32 + (C.tid & 31), g = chan >> 6, n = chan & 63, sg = C.tid >> 5;
    const float* abt = (const float*)(P.ws + WS_ABART) + (g * 64 + n) * 2;
    const float ar = abt[0], ai = abt[1];
    float sr = 0.f, si = 0.f;
#pragma unroll 8
    for (int i = 0; i < 32; ++i) {
        const int ci = 32 * sg + i; const size_t o = ((size_t)ci * 32 + g) * 128 + n;
        const float br = SL[o], bi = SL[o + 64];
        const float tr = ar * sr - ai * si + br, ti = ar * si + ai * sr + bi; sr = tr; si = ti;
    }
    Lr[sg * 32 + (C.tid & 31)] = sr; Li[sg * 32 + (C.tid & 31)] = si;
    float pr = ar, pi = ai;
#pragma unroll
    for (int k = 0; k < 5; ++k) { const float tr = pr * pr - pi * pi, ti = 2.f * pr * pi; pr = tr; pi = ti; }
    __syncthreads();
    float cr = 0.f, ci_ = 0.f;
    for (int s2 = 0; s2 < sg; ++s2) { const float lr = Lr[s2 * 32 + (C.tid & 31)], li = Li[s2 * 32 + (C.tid & 31)];
        const float tr = pr * cr - pi * ci_ + lr, ti = pr * ci_ + pi * cr + li; cr = tr; ci_ = ti; }
    sr = cr; si = ci_;
#pragma unroll 8
    for (int i = 0; i < 32; ++i) {
        const int ci = 32 * sg + i; const size_t o = ((size_t)ci * 32 + g) * 128 + n;
        CA[o] = sr; CA[o + 64] = si;
        const float br = SL[o], bi = SL[o + 64];
        const float tr = ar * sr - ai * si + br, ti = ar * si + ai * sr + bi; sr = tr; si = ti;
    }
    if (sg == 15) { const size_t o = ((size_t)512 * 32 + g) * 128 + n; CA[o] = sr; CA[o + 64] = si; }
    __syncthreads();
}

constexpr int E_OFF = 16896, E_PITCH = 272;
__device__ __forceinline__ void phase_ssm_y(const Ctx& C, const Params& P) {
    const bf16_t* proj = (const bf16_t*)(P.ws + WS_PROJ);
    const float* CA = (const float*)(P.ws + WS_CARRY);
    bf16_t* Z = (bf16_t*)(P.ws + WS_Z);
    const int n = C.lane & 15, kq = C.lane >> 4;
    for (int bu = C.bid; bu < 256; bu += C.G) {
        const int g = bu >> 3, cq = bu & 7;
        __syncthreads();
        { const u32x4* src = (const u32x4*)((const bf16_t*)(P.ws + WS_KT) + (size_t)g * 8448); LAS u32x4* dst = (LAS u32x4*)C.lds;
          for (int e = C.tid; e < 1056; e += NTHR) dst[e] = src[e];
          const u32x4* esrc = (const u32x4*)((const bf16_t*)(P.ws + WS_E) + (size_t)g * 65536);
          u32x4 t[16];
#pragma unroll
          for (int i = 0; i < 16; ++i) t[i] = esrc[C.tid + NTHR * i];
#pragma unroll
          for (int i = 0; i < 16; ++i) { const int e = C.tid + NTHR * i; *(LAS u32x4*)(C.lds + E_OFF + (e >> 4) * E_PITCH + (e & 15) * 16) = t[i]; } }
        __syncthreads();
        const int ci = 1 + 64 * cq + 16 * (C.wave >> 1) + n, par = C.wave & 1;
        bf16x8 Uf[16], Cf[4];
#pragma unroll
        for (int ks = 0; ks < 16; ++ks) Uf[ks] = u_frag(proj, ci, 2 * ks + (kq >> 1), g, kq & 1);
#pragma unroll
        for (int k2 = 0; k2 < 4; ++k2) {
            const float* cp = CA + ((size_t)ci * 32 + g) * 128 + 32 * k2 + 8 * kq;
            const f32x4 a = *(const f32x4*)cp, b = *(const f32x4*)(cp + 4);
            u32x4 w; w.x = pk2(a.x, a.y); w.y = pk2(a.z, a.w); w.z = pk2(b.x, b.y); w.w = pk2(b.z, b.w);
            Cf[k2] = __builtin_bit_cast(bf16x8, w);
        }
        const f32x4 dv = *(const f32x4*)(P.in[I_SD] + g * 16 + 4 * kq);
        u32x2 uwp[16];
#pragma unroll
        for (int tt = 0; tt < 16; ++tt) uwp[tt] = *(const u32x2*)(proj + (size_t)((ci - 1) * 32 + 2 * tt + par) * INW + O_U + g * 16 + 4 * kq);
        const LAS unsigned char* eb0 = C.lds + E_OFF + (par * 16 + n) * E_PITCH + 16 * kq;
        const LAS unsigned char* eb1 = eb0 + 8 * 2 * 16 * E_PITCH;
        const LAS unsigned char* kb0 = C.lds + ((par - (kq >> 1) + 1) * 16 + n) * 32 + 16 * (kq & 1);
#pragma unroll
        for (int tt = 0; tt < 16; ++tt) {
            const int t = 2 * tt + par;
            f32x4 acc = {0.f, 0.f, 0.f, 0.f};
#pragma unroll
            for (int k2 = 0; k2 < 4; ++k2) {
                const bf16x8 A = *(const LAS bf16x8*)((tt < 8 ? eb0 + tt * 2 * 16 * E_PITCH : eb1 + (tt - 8) * 2 * 16 * E_PITCH) + 64 * k2);
                acc = MFMA16(A, Cf[k2], acc);
            }
#pragma unroll
            for (int ks = 0; ks < 16; ++ks) {
                if (ks <= tt) {
                    const bf16x8 A = *(const LAS bf16x8*)(kb0 + (tt - ks) * 1024);
                    acc = MFMA16(A, Uf[ks], acc);
                }
            }
            const int row = (ci - 1) * 32 + t, ch = g * 16 + 4 * kq;
            const u32x2 uw = uwp[tt];
            const float y0 = acc.x + dv.x * bflo(uw.x), y1 = acc.y + dv.y * bfhi(uw.x), y2 = acc.z + dv.z * bflo(uw.y), y3 = acc.w + dv.w * bfhi(uw.y);
            const pg8::f32x2 ga = pg8::gelu_pk((pg8::f32x2){y0, y1}), gb = pg8::gelu_pk((pg8::f32x2){y2, y3});
            u32x2 o; o.x = pk2(ga.x, ga.y); o.y = pk2(gb.x, gb.y);
            *(u32x2*)(Z + (size_t)row * 512 + ch) = o;
            __builtin_amdgcn_sched_barrier(0);
        }
    }
}

constexpr int VT_PITCH = 296;
__device__ __forceinline__ void attn_unit(const Ctx& C, const Params& P, int b, int hk) {
    const bf16_t* proj = (const bf16_t*)(P.ws + WS_PROJ);
    bf16_t* AO = (bf16_t*)(P.ws + WS_BUFA);
    float* SSA = (float*)(P.ws + WS_SSA);
    LAS unsigned char* Ks = C.lds;
    LAS bf16_t* Vt = (LAS bf16_t*)(C.lds + 288 * 128);
    __syncthreads();
    for (int e = C.tid; e < 288 * 8; e += NTHR) {
        const int key = e >> 3, ch = e & 7;
        int row = -1;
        if (key < 256) { const int j = (b - 1) * 128 + key; if (j >= 0) row = j; } else if (key < 272) row = SEQ + key - 256;
        u32x4 kw = {0u, 0u, 0u, 0u}, vw = {0u, 0u, 0u, 0u};
        if (row >= 0) { kw = *(const u32x4*)(proj + (size_t)row * INW + O_K + hk * 64 + ch * 8); vw = *(const u32x4*)(proj + (size_t)row * INW + O_V + hk * 64 + ch * 8); }
        float kf[8] = {bflo(kw.x), bfhi(kw.x), bflo(kw.y), bfhi(kw.y), bflo(kw.z), bfhi(kw.z), bflo(kw.w), bfhi(kw.w)};
        float ss = 0.f;
#pragma unroll
        for (int i = 0; i < 8; ++i) ss += kf[i] * kf[i];
        ss += __shfl_xor(ss, 1); ss += __shfl_xor(ss, 2); ss += __shfl_xor(ss, 4);
        const float rinv = 1.0f / sqrtf(ss * (1.0f / 64.0f) + EPS);
        const f32x4 g0 = *(const f32x4*)(P.in[I_KNG] + ch * 8), g1 = *(const f32x4*)(P.in[I_KNG] + ch * 8 + 4);
        u32x4 o; o.x = pk2(kf[0] * rinv * g0.x, kf[1] * rinv * g0.y); o.y = pk2(kf[2] * rinv * g0.z, kf[3] * rinv * g0.w);
        o.z = pk2(kf[4] * rinv * g1.x, kf[5] * rinv * g1.y); o.w = pk2(kf[6] * rinv * g1.z, kf[7] * rinv * g1.w);
        *(LAS u32x4*)(Ks + key * 128 + ((ch ^ (key & 7)) * 16)) = o;
        const unsigned vv[4] = {vw.x, vw.y, vw.z, vw.w};
#pragma unroll
        for (int i = 0; i < 4; ++i) { Vt[(ch * 8 + 2 * i) * VT_PITCH + key] = (bf16_t)(vv[i] & 0xffffu); Vt[(ch * 8 + 2 * i + 1) * VT_PITCH + key] = (bf16_t)(vv[i] >> 16); }
    }
    __syncthreads();
    const int c = C.lane & 31, h = C.lane >> 5;
#pragma unroll 1
    for (int ti = C.wave; ti < 16; ti += NWAVES) {
        const int hql = ti >> 2, wq = ti & 3, hq = hk * 4 + hql;
        const int qi = wq * 32 + c, tok = b * 128 + qi;
        bf16x8 qf[4];
        {
            u32x4 qw[4]; float ss = 0.f;
#pragma unroll
            for (int ks = 0; ks < 4; ++ks) { qw[ks] = *(const u32x4*)(proj + (size_t)tok * INW + hq * 64 + 16 * ks + 8 * h);
                const unsigned w[4] = {qw[ks].x, qw[ks].y, qw[ks].z, qw[ks].w};
#pragma unroll
                for (int i = 0; i < 4; ++i) { const float a = bflo(w[i]), bb = bfhi(w[i]); ss += a * a + bb * bb; } }
            ss += __shfl_xor(ss, 32);
            const float rinv = (1.0f / sqrtf(ss * (1.0f / 64.0f) + EPS)) * (0.125f * LOG2E);
#pragma unroll
            for (int ks = 0; ks < 4; ++ks) {
                const f32x4 g0 = *(const f32x4*)(P.in[I_QNG] + 16 * ks + 8 * h), g1 = *(const f32x4*)(P.in[I_QNG] + 16 * ks + 8 * h + 4);
                u32x4 o; o.x = pk2(bflo(qw[ks].x) * rinv * g0.x, bfhi(qw[ks].x) * rinv * g0.y); o.y = pk2(bflo(qw[ks].y) * rinv * g0.z, bfhi(qw[ks].y) * rinv * g0.w);
                o.z = pk2(bflo(qw[ks].z) * rinv * g1.x, bfhi(qw[ks].z) * rinv * g1.y); o.w = pk2(bflo(qw[ks].w) * rinv * g1.z, bfhi(qw[ks].w) * rinv * g1.w);
                qf[ks] = __builtin_bit_cast(bf16x8, o);
            }
        }
        f32x16 S[6];
#pragma unroll
        for (int rb = 0; rb < 6; ++rb) {
            const int kb = (rb < 5) ? (wq + rb) : 8;
            const int key = kb * 32 + c;
            f32x16 acc = {0.f, 0.f, 0.f, 0.f, 0.f, 0.f, 0.f, 0.f, 0.f, 0.f, 0.f, 0.f, 0.f, 0.f, 0.f, 0.f};
#pragma unroll
            for (int ks = 0; ks < 4; ++ks) {
                const bf16x8 A = *(const LAS bf16x8*)(Ks + key * 128 + (((2 * ks + h) ^ (key & 7)) * 16));
                acc = MFMA32(A, qf[ks], acc);
            }
            S[rb] = acc;
            __builtin_amdgcn_sched_barrier(0);
        }
        const float sl = P.in[I_SINK][hq] * LOG2E;
        float mx = sl;
#pragma unroll
        for (int r = 0; r < 16; ++r) {
            const int kr = (r & 3) + 8 * (r >> 2) + 4 * h;
            const bool gt = kr > c;
            S[0][r] = gt ? S[0][r] : -1e30f;
            S[4][r] = gt ? -1e30f : S[4][r];
            if (r >= 8) S[5][r] = -1e30f;
        }
        if (b == 0) {
#pragma unroll
            for (int rb = 0; rb < 4; ++rb) if (wq + rb < 4) {
#pragma unroll
                for (int r = 0; r < 16; ++r) S[rb][r] = -1e30f;
            }
        }
#pragma unroll
        for (int rb = 0; rb < 6; ++rb)
#pragma unroll
            for (int r = 0; r < 16; ++r) mx = fmaxf(mx, S[rb][r]);
        mx = fmaxf(mx, __shfl_xor(mx, 32));
        float lsum = 0.f;
#pragma unroll
        for (int rb = 0; rb < 6; ++rb)
#pragma unroll
            for (int r = 0; r < 16; ++r) { const float p = __builtin_amdgcn_exp2f(S[rb][r] - mx); S[rb][r] = p; lsum += p; }
        lsum += __shfl_xor(lsum, 32);
        lsum += __builtin_amdgcn_exp2f(sl - mx);
        const float linv = 1.0f / lsum;
        f32x16 O[2];
#pragma unroll
        for (int db = 0; db < 2; ++db) O[db] = (f32x16){0.f, 0.f, 0.f, 0.f, 0.f, 0.f, 0.f, 0.f, 0.f, 0.f, 0.f, 0.f, 0.f, 0.f, 0.f, 0.f};
#pragma unroll
        for (int rb = 0; rb < 6; ++rb) {
            const int kb = (rb < 5) ? (wq + rb) : 8;
#pragma unroll
            for (int s = 0; s < 2; ++s) {
                if (rb == 5 && s == 1) continue;
                u32x4 pw; pw.x = pk2(S[rb][8 * s + 0], S[rb][8 * s + 1]); pw.y = pk2(S[rb][8 * s + 2], S[rb][8 * s + 3]);
                pw.z = pk2(S[rb][8 * s + 4], S[rb][8 * s + 5]); pw.w = pk2(S[rb][8 * s + 6], S[rb][8 * s + 7]);
                const bf16x8 Pf = __builtin_bit_cast(bf16x8, pw);
#pragma unroll
                for (int db = 0; db < 2; ++db) {
                    const LAS bf16_t* vp = Vt + (db * 32 + c) * VT_PITCH + kb * 32 + 16 * s + 4 * h;
                    const u32x2 lo = *(const LAS u32x2*)vp, hi2 = *(const LAS u32x2*)(vp + 8);
                    u32x4 vw; vw.x = lo.x; vw.y = lo.y; vw.z = hi2.x; vw.w = hi2.y;
                    O[db] = MFMA32(__builtin_bit_cast(bf16x8, vw), Pf, O[db]);
                }
                __builtin_amdgcn_sched_barrier(0);
            }
        }
        float ssq = 0.f;
#pragma unroll
        for (int db = 0; db < 2; ++db)
#pragma unroll
            for (int gq = 0; gq < 4; ++gq) {
                const float o0 = O[db][4 * gq] * linv, o1 = O[db][4 * gq + 1] * linv, o2 = O[db][4 * gq + 2] * linv, o3 = O[db][4 * gq + 3] * linv;
                ssq += (o0 * o0 + o1 * o1) + (o2 * o2 + o3 * o3);
                u32x2 o; o.x = pk2(o0, o1); o.y = pk2(o2, o3);
                *(u32x2*)(AO + (size_t)tok * 1024 + hq * 64 + db * 32 + 8 * gq + 4 * h) = o;
            }
        ssq += __shfl_xor(ssq, 32);
        if (h == 0) SSA[(size_t)tok * 8 + hq] = ssq;
    }
}

struct EpiGlu {
    static constexpr bool PERM = true, AFTER_DRAIN = false, HAS_MID = false;
    const bf16_t* Z; bf16_t* O; const float* bias; float* SSS;
    __device__ __forceinline__ void operator()(const pg8::f32x4 (&acc)[2][2][4][2], const pg8::Unit& u, int wr, int wc, int fr, int fq) const {
        const int row0 = u.pm * 256 + wr * 64 + fr, col0 = u.pn * 256 + wc * 32 + 8 * fq;
        f32x4 bb[2][2];
#pragma unroll
        for (int bj = 0; bj < 2; ++bj) { bb[bj][0] = *(const f32x4*)(bias + col0 + bj * 128); bb[bj][1] = *(const f32x4*)(bias + col0 + bj * 128 + 4); }
#pragma unroll
        for (int ai = 0; ai < 2; ++ai) {
            u32x4 zw[4][2];
#pragma unroll
            for (int m = 0; m < 4; ++m)
#pragma unroll
                for (int bj = 0; bj < 2; ++bj) zw[m][bj] = *(const u32x4*)(Z + (size_t)(row0 + ai * 128 + m * 16) * 512 + col0 + bj * 128);
#pragma unroll
            for (int m = 0; m < 4; ++m) {
                const int row = row0 + ai * 128 + m * 16; float ssq = 0.f;
#pragma unroll
                for (int bj = 0; bj < 2; ++bj) {
                    const f32x4 b0 = bb[bj][0], b1 = bb[bj][1]; const u32x4 z4 = zw[m][bj];
                    const pg8::f32x4 v0 = acc[ai][bj][m][0], v1 = acc[ai][bj][m][1];
                    const float zf[8] = {bflo(z4.x), bfhi(z4.x), bflo(z4.y), bfhi(z4.y), bflo(z4.z), bfhi(z4.z), bflo(z4.w), bfhi(z4.w)};
                    const float pre[8] = {v0[0] + b0.x, v0[1] + b0.y, v0[2] + b0.z, v0[3] + b0.w, v1[0] + b1.x, v1[1] + b1.y, v1[2] + b1.z, v1[3] + b1.w};
                    float r[8];
#pragma unroll
                    for (int i = 0; i < 8; ++i) { r[i] = zf[i] * __builtin_amdgcn_rcpf(1.0f + __expf(-pre[i])); ssq += r[i] * r[i]; }
                    u32x4 o; o.x = pk2(r[0], r[1]); o.y = pk2(r[2], r[3]); o.z = pk2(r[4], r[5]); o.w = pk2(r[6], r[7]);
                    *(u32x4*)(O + (size_t)row * 1024 + 512 + col0 + bj * 128) = o;
                }
                ssq += __shfl_xor(ssq, 16); ssq += __shfl_xor(ssq, 32);
                if (fq == 0) SSS[(size_t)row * 8 + u.pn * 4 + wc] = ssq;
            }
        }
    }
};
constexpr int FAC_OFF = 131072;
struct EpiMix {
    static constexpr bool PERM = true, AFTER_DRAIN = false, HAS_MID = true;
    const float* X; bf16_t* HB; float* SSH;
    __device__ __forceinline__ void mid(pg8::f32x4 (&acc)[2][2][4][2], const pg8::Unit& u, int wr, int wc, int fr, int fq, LAS unsigned char* lds) const {
#pragma unroll
        for (int ai = 0; ai < 2; ++ai)
#pragma unroll
            for (int m = 0; m < 4; ++m) {
                const float f = ((const LAS float*)(lds + FAC_OFF))[2 * (ai * 128 + wr * 64 + m * 16 + fr)];
#pragma unroll
                for (int bj = 0; bj < 2; ++bj)
#pragma unroll
                    for (int n = 0; n < 2; ++n) acc[ai][bj][m][n] *= f;
            }
    }
    __device__ __forceinline__ void operator()(const pg8::f32x4 (&acc)[2][2][4][2], const pg8::Unit& u, int wr, int wc, int fr, int fq) const {
        extern __shared__ __attribute__((aligned(16))) unsigned char lds_raw_[];
        const LAS float* fac = (const LAS float*)((LAS unsigned char*)lds_raw_ + FAC_OFF);
        const int col0 = u.pn * 256 + wc * 32 + 8 * fq;
#pragma unroll
        for (int ai = 0; ai < 2; ++ai) {
            f32x4 xv[4][2][2];
#pragma unroll
            for (int m = 0; m < 4; ++m)
#pragma unroll
                for (int bj = 0; bj < 2; ++bj) { const size_t off = (size_t)(u.pm * 256 + ai * 128 + wr * 64 + m * 16 + fr) * 1024 + col0 + bj * 128;
                    xv[m][bj][0] = *(const f32x4*)(X + off); xv[m][bj][1] = *(const f32x4*)(X + off + 4); }
#pragma unroll
            for (int m = 0; m < 4; ++m) {
                const int rl = ai * 128 + wr * 64 + m * 16 + fr, row = u.pm * 256 + rl;
                const float rs = fac[2 * rl + 1]; float ssq = 0.f;
#pragma unroll
                for (int bj = 0; bj < 2; ++bj) {
                    const size_t off = (size_t)row * 1024 + col0 + bj * 128;
                    const f32x4 x0 = xv[m][bj][0], x1 = xv[m][bj][1];
                    const pg8::f32x4 v0 = acc[ai][bj][m][0], v1 = acc[ai][bj][m][1];
                    const float hv[8] = {x0.x + rs * v0[0], x0.y + rs * v0[1], x0.z + rs * v0[2], x0.w + rs * v0[3], x1.x + rs * v1[0], x1.y + rs * v1[1], x1.z + rs * v1[2], x1.w + rs * v1[3]};
#pragma unroll
                    for (int i = 0; i < 8; ++i) ssq += hv[i] * hv[i];
                    u32x4 o; o.x = pk2(hv[0], hv[1]); o.y = pk2(hv[2], hv[3]); o.z = pk2(hv[4], hv[5]); o.w = pk2(hv[6], hv[7]);
                    *(u32x4*)(HB + off) = o;
                }
                ssq += __shfl_xor(ssq, 16); ssq += __shfl_xor(ssq, 32);
                if (fq == 0) SSH[(size_t)row * 16 + u.pn * 4 + wc] = ssq;
            }
        }
    }
};
struct EpiQ {
    static constexpr bool PERM = true, AFTER_DRAIN = false, HAS_MID = false;
    bf16_t* O; const float* SSH;
    __device__ __forceinline__ void operator()(const pg8::f32x4 (&acc)[2][2][4][2], const pg8::Unit& u, int wr, int wc, int fr, int fq) const {
        const int col0 = u.pn * 256 + wc * 32 + 8 * fq;
        float ri[2][4];
#pragma unroll
        for (int ai = 0; ai < 2; ++ai)
#pragma unroll
            for (int m = 0; m < 4; ++m) {
                const int row = u.pm * 256 + ai * 128 + wr * 64 + m * 16 + fr;
                const f32x4* sp = (const f32x4*)(SSH + (size_t)row * 16);
                const f32x4 s0 = sp[0], s1 = sp[1], s2 = sp[2], s3 = sp[3];
                const float ss = ((s0.x + s0.y) + (s0.z + s0.w)) + ((s1.x + s1.y) + (s1.z + s1.w)) + ((s2.x + s2.y) + (s2.z + s2.w)) + ((s3.x + s3.y) + (s3.z + s3.w));
                ri[ai][m] = 1.0f / sqrtf(ss * (1.0f / 1024.0f) + EPS);
            }
#pragma unroll
        for (int ai = 0; ai < 2; ++ai)
#pragma unroll
            for (int m = 0; m < 4; ++m) {
                const int row = u.pm * 256 + ai * 128 + wr * 64 + m * 16 + fr; const float r = ri[ai][m];
#pragma unroll
                for (int bj = 0; bj < 2; ++bj) {
                    const pg8::f32x4 v0 = acc[ai][bj][m][0], v1 = acc[ai][bj][m][1];
                    u32x4 o; o.x = pk2(v0[0] * r, v0[1] * r); o.y = pk2(v0[2] * r, v0[3] * r); o.z = pk2(v1[0] * r, v1[1] * r); o.w = pk2(v1[2] * r, v1[3] * r);
                    *(u32x4*)(O + (size_t)row * 2048 + col0 + bj * 128) = o;
                }
            }
    }
};

__device__ __forceinline__ void peer_topk_tile(const Ctx& C, const Params& P, int tok0) {
    const bf16_t* QP = (const bf16_t*)(P.ws + WS_QP);
    const bf16_t* SK = (const bf16_t*)(P.ws + WS_SUBK);
    int* IDX = (int*)(P.ws + WS_IDX); float* GW = (float*)(P.ws + WS_GW);
    LAS u32* lists = (LAS u32*)C.lds;
    const int c = C.lane & 31, h = C.lane >> 5;
    __syncthreads();
#pragma unroll 1
    for (int hs = C.wave; hs < 16; hs += NWAVES) {
        bf16x8 qf[2][8];
#pragma unroll
        for (int tg = 0; tg < 2; ++tg) { const bf16_t* qrow = QP + (size_t)(tok0 + tg * 32 + c) * 2048 + hs * 128;
#pragma unroll
            for (int ks = 0; ks < 8; ++ks) qf[tg][ks] = *(const bf16x8*)(qrow + 16 * ks + 8 * h); }
        u32 best[2][16];
#pragma unroll 1
        for (int kb = 0; kb < 4; ++kb) {
            bf16x8 kf[8];
            const bf16_t* krow = SK + (size_t)(hs * 128 + kb * 32 + c) * 128;
#pragma unroll
            for (int ks = 0; ks < 8; ++ks) kf[ks] = *(const bf16x8*)(krow + 16 * ks + 8 * h);
            f32x16 acc0 = {0.f, 0.f, 0.f, 0.f, 0.f, 0.f, 0.f, 0.f, 0.f, 0.f, 0.f, 0.f, 0.f, 0.f, 0.f, 0.f}, acc1 = acc0;
#pragma unroll
            for (int ks = 0; ks < 8; ++ks) { acc0 = MFMA32(kf[ks], qf[0][ks], acc0); acc1 = MFMA32(kf[ks], qf[1][ks], acc1); }
            u32 g0[16], g1[16];
#pragma unroll
            for (int r = 0; r < 16; ++r) { const u32 kx = (u32)(127 - (kb * 32 + (r & 3) + 8 * (r >> 2) + 4 * h));
                g0[r] = (f2ord(acc0[r]) & ~0x7Fu) | kx; g1[r] = (f2ord(acc1[r]) & ~0x7Fu) | kx; }
            sort16_desc(g0); sort16_desc(g1);
            if (kb == 0) {
#pragma unroll
                for (int i = 0; i < 16; ++i) { best[0][i] = g0[i]; best[1][i] = g1[i]; }
            } else { merge_top16(best[0], g0); merge_top16(best[1], g1); }
        }
#pragma unroll
        for (int tg = 0; tg < 2; ++tg) {
            u32 pb[16];
#pragma unroll
            for (int i = 0; i < 16; ++i) pb[i] = (u32)__shfl_xor((int)best[tg][i], 32);
            merge_top16(best[tg], pb);
            if (h == 0) {
                LAS u32x4* dst = (LAS u32x4*)(lists + (tg * 32 + c) * 260 + hs * 16);
#pragma unroll
                for (int i = 0; i < 4; ++i) { u32x4 w; w.x = best[tg][4 * i]; w.y = best[tg][4 * i + 1]; w.z = best[tg][4 * i + 2]; w.w = best[tg][4 * i + 3]; dst[i] = w; }
            }
        }
    }
    __syncthreads();
    {
        const int tl = C.tid & 63, hd = C.tid >> 6;
        const LAS u32* L1 = lists + tl * 260 + hd * 32; const LAS u32* L2 = L1 + 16;
        float v1[16], v2[16];
#pragma unroll
        for (int i = 0; i < 16; ++i) { v1[i] = ord2f(L1[i] & ~0x7Fu); v2[i] = ord2f(L2[i] & ~0x7Fu); }
        u32 cd[4][16];
        { int cid = 0;
#pragma unroll
          for (int a = 0; a < 16; ++a)
#pragma unroll
              for (int b = 0; b < 16; ++b) if ((a + 1) * (b + 1) <= 16) { cd[cid >> 4][cid & 15] = (f2ord(v1[a] + v2[b]) & ~0x3Fu) | (u32)(63 - cid); ++cid; }
#pragma unroll
          for (int k = 50; k < 64; ++k) cd[k >> 4][k & 15] = 0u; }
        top16_of_64(cd[0], cd[1], cd[2], cd[3]);
        float sc[16]; int ix[16]; float mx = -1e30f;
#pragma unroll
        for (int k = 0; k < 16; ++k) {
            const int cid = 63 - (int)(cd[0][k] & 63u); const int ab = CAND_AB[cid];
            const u32 k1 = L1[ab >> 4], k2 = L2[ab & 15];
            sc[k] = ord2f(k1 & ~0x7Fu) + ord2f(k2 & ~0x7Fu);
            ix[k] = (127 - (int)(k1 & 0x7Fu)) * 128 + (127 - (int)(k2 & 0x7Fu));
            mx = fmaxf(mx, sc[k]);
        }
        float sum = 0.f;
#pragma unroll
        for (int k = 0; k < 16; ++k) { sc[k] = __expf(sc[k] - mx); sum += sc[k]; }
        const float inv = 1.0f / sum;
        int* io = IDX + (size_t)(tok0 + tl) * 128 + hd * 16; float* go = GW + (size_t)(tok0 + tl) * 128 + hd * 16;
#pragma unroll
        for (int k = 0; k < 16; k += 4) {
            *(int4*)(io + k) = make_int4(ix[k], ix[k + 1], ix[k + 2], ix[k + 3]);
            f32x4 gv = {sc[k] * inv, sc[k + 1] * inv, sc[k + 2] * inv, sc[k + 3] * inv}; *(f32x4*)(go + k) = gv;
        }
    }
    __syncthreads();
}

template <int J> __device__ __forceinline__ u32 xor_lane(u32 v, int lane) {
    if constexpr (J == 1) return (u32)__builtin_amdgcn_update_dpp(0, (int)v, 0xB1, 0xf, 0xf, true);
    else if constexpr (J == 2) return (u32)__builtin_amdgcn_update_dpp(0, (int)v, 0x4E, 0xf, 0xf, true);
    else if constexpr (J == 4) { int t = __builtin_amdgcn_update_dpp(0, (int)v, 0x104, 0xf, 0x5, false); return (u32)__builtin_amdgcn_update_dpp(t, (int)v, 0x114, 0xf, 0xA, false); }
    else if constexpr (J == 8) return (u32)__builtin_amdgcn_update_dpp(0, (int)v, 0x128, 0xf, 0xf, true);
    else if constexpr (J == 16) { u32 b = v; asm volatile("" : "+v"(b)); const auto p = __builtin_amdgcn_permlane16_swap(v, b, false, false); return (lane & 16) ? p[0] : p[1]; }
    else { u32 b = v; asm volatile("" : "+v"(b)); const auto p = __builtin_amdgcn_permlane32_swap(v, b, false, false); return (lane & 32) ? p[0] : p[1]; }
}
__device__ __forceinline__ int reduce64(int (&r)[64], int lane) {
#pragma unroll
    for (int e = 0; e < 32; ++e) { const auto p = __builtin_amdgcn_permlane32_swap((u32)r[e], (u32)r[e + 32], false, false); r[e] = (int)p[0] + (int)p[1]; }
#pragma unroll
    for (int e = 0; e < 16; ++e) { const auto p = __builtin_amdgcn_permlane16_swap((u32)r[e], (u32)r[e + 16], false, false); r[e] = (int)p[0] + (int)p[1]; }
    const bool b3 = (lane & 8) != 0, b2 = (lane & 4) != 0, b1 = (lane & 2) != 0, b0 = (lane & 1) != 0;
#pragma unroll
    for (int e = 0; e < 8; ++e) { const int keep = b3 ? r[e + 8] : r[e], send = b3 ? r[e] : r[e + 8]; r[e] = keep + __builtin_amdgcn_update_dpp(0, send, 0x128, 0xf, 0xf, true); }
#pragma unroll
    for (int e = 0; e < 4; ++e) { const int keep = b2 ? r[e + 4] : r[e], send = b2 ? r[e] : r[e + 4];
        int t = __builtin_amdgcn_update_dpp(0, send, 0x104, 0xf, 0x5, false);
        t = __builtin_amdgcn_update_dpp(t, send, 0x114, 0xf, 0xA, false);
        r[e] = keep + t; }
#pragma unroll
    for (int e = 0; e < 2; ++e) { const int keep = b1 ? r[e + 2] : r[e], send = b1 ? r[e] : r[e + 2]; r[e] = keep + __builtin_amdgcn_update_dpp(0, send, 0x4E, 0xf, 0xf, true); }
    { const int keep = b0 ? r[1] : r[0], send = b0 ? r[0] : r[1]; r[0] = keep + __builtin_amdgcn_update_dpp(0, send, 0xB1, 0xf, 0xf, true); }
    return r[0];
}
constexpr int GQ_LDS_PER_WAVE = 8192;
#define GQ_FMA16(A, ce, w) do { _Pragma("unroll") for (int j_ = 0; j_ < 4; ++j_) { \
        const f32x2_t lo_ = __builtin_amdgcn_cvt_pk_f32_fp8((int)(w)[j_], false), hi_ = __builtin_amdgcn_cvt_pk_f32_fp8((int)(w)[j_], true); \
        A[4 * j_ + 0] += (ce) * lo_.x; A[4 * j_ + 1] += (ce) * lo_.y; A[4 * j_ + 2] += (ce) * hi_.x; A[4 * j_ + 3] += (ce) * hi_.y; } } while (0)
__device__ __forceinline__ void peer_gather_quad(const Ctx& C, const Params& P, int tokq) {
    const bf16_t* HN = (const bf16_t*)(P.ws + WS_HB); const float* SSH = (const float*)(P.ws + WS_SSH);
    const unsigned char* PU = P.ws + WS_PU; const unsigned char* PV = P.ws + WS_PV;
    const float* SU = (const float*)(P.ws + WS_SU); const float* SV = (const float*)(P.ws + WS_SV);
    const int* IDX = (const int*)(P.ws + WS_IDX); const float* GW = (const float*)(P.ws + WS_GW);
    const int lane = C.lane;
    LAS unsigned char* qhl = C.lds + C.wave * GQ_LDS_PER_WAVE;
    LAS u32* keyl = (LAS u32*)(qhl + 4096);
    u32 k[8];
#pragma unroll
    for (int s = 0; s < 4; ++s)
#pragma unroll
        for (int hb = 0; hb < 2; ++hb) k[2 * s + hb] = ((u32)IDX[(size_t)(tokq + s) * 128 + 64 * hb + lane] << 9) | (u32)(s << 7) | (u32)(64 * hb + lane);
#pragma unroll
    for (int size = 2; size <= 512; size <<= 1) {
#pragma unroll
        for (int j = size >> 1; j > 0; j >>= 1) {
            u32 nk[8];
#pragma unroll
            for (int r = 0; r < 8; ++r) {
                const int ii = lane + 64 * r;
                const bool asc = (ii & size) == 0, lower = (ii & j) == 0;
                const u32 mine = k[r];
                u32 other;
                if (j >= 64) other = k[r ^ (j >> 6)];
                else if (j == 1) other = xor_lane<1>(mine, lane); else if (j == 2) other = xor_lane<2>(mine, lane); else if (j == 4) other = xor_lane<4>(mine, lane);
                else if (j == 8) other = xor_lane<8>(mine, lane); else if (j == 16) other = xor_lane<16>(mine, lane); else other = xor_lane<32>(mine, lane);
                const u32 mn = mine < other ? mine : other, mx = mine < other ? other : mine;
                nk[r] = (lower == asc) ? mn : mx;
            }
#pragma unroll
            for (int r = 0; r < 8; ++r) k[r] = nk[r];
        }
    }
#pragma unroll
    for (int r = 0; r < 8; ++r) keyl[64 * r + lane] = k[r];
    float shs[4];
    f32x4 g2v[4];
#pragma unroll
    for (int j = 0; j < 4; ++j) g2v[j] = *(const f32x4*)(P.in[I_N2G] + 256 * j + 4 * lane);
#pragma unroll
    for (int s = 0; s < 4; ++s) {
        float hf[16]; float m = 0.f;
        const float ssp = (lane < 16) ? SSH[(size_t)(tokq + s) * 16 + lane] : 0.f;
#pragma unroll
        for (int j = 0; j < 4; ++j) { const u32x2 w = *(const u32x2*)(HN + (size_t)(tokq + s) * DM + 256 * j + 4 * lane);
            hf[4 * j] = bflo(w.x) * g2v[j].x; hf[4 * j + 1] = bfhi(w.x) * g2v[j].y; hf[4 * j + 2] = bflo(w.y) * g2v[j].z; hf[4 * j + 3] = bfhi(w.y) * g2v[j].w; }
        const float rinv_t = 1.0f / sqrtf(wave_sum(ssp) * (1.0f / 1024.0f) + EPS);
#pragma unroll
        for (int d = 0; d < 16; ++d) m = fmaxf(m, fabsf(hf[d]));
#pragma unroll
        for (int o = 1; o < 64; o <<= 1) m = fmaxf(m, __shfl_xor(m, o));
        shs[s] = ((m > 0.f) ? m * (1.0f / 127.0f) : 1.0f) * rinv_t; const float inv = (m > 0.f) ? 127.0f / m : 0.f;
        u32x4 q;
#pragma unroll
        for (int j = 0; j < 4; ++j) {
            const int q0 = (int)rintf(hf[4 * j] * inv), q1 = (int)rintf(hf[4 * j + 1] * inv), q2 = (int)rintf(hf[4 * j + 2] * inv), q3 = (int)rintf(hf[4 * j + 3] * inv);
            q[j] = (u32)(q0 & 255) | ((u32)(q1 & 255) << 8) | ((u32)(q2 & 255) << 16) | ((u32)(q3 & 255) << 24);
        }
        *(LAS u32x4*)(qhl + s * 1024 + 16 * lane) = q;
    }
    LDS_WAIT();
    LAS float* cvl = (LAS float*)(qhl + 6144);
#pragma unroll 1
    for (int c = 0; c < 8; ++c) {
        const u32 kk = keyl[64 * c + lane];
        const int e_l = (int)(kk >> 9), slot_l = (int)((kk >> 7) & 3u), pos_l = (int)(kk & 127u);
        const float g_l = GW[(size_t)(tokq + slot_l) * 128 + pos_l], su_l = SU[e_l], sv_l = SV[e_l];
        int r[64];
#pragma unroll
        for (int p = 0; p < 64; ++p) {
            const u32 kp = (u32)__builtin_amdgcn_readlane((int)kk, p);
            const u32x4 w = *(const u32x4*)(PU + (size_t)(kp >> 9) * 1024 + 16 * lane);
            const u32x4 hq = *(const LAS u32x4*)(qhl + ((kp >> 7) & 3u) * 1024 + 16 * lane);
            int a = __builtin_amdgcn_sdot4((int)w.x, (int)hq.x, 0, false);
            a = __builtin_amdgcn_sdot4((int)w.y, (int)hq.y, a, false);
            a = __builtin_amdgcn_sdot4((int)w.z, (int)hq.z, a, false);
            a = __builtin_amdgcn_sdot4((int)w.w, (int)hq.w, a, false);
            r[p] = a;
        }
        const int isum = reduce64(r, lane);
        const float sh_l = (slot_l == 0) ? shs[0] : (slot_l == 1) ? shs[1] : (slot_l == 2) ? shs[2] : shs[3];
        const float z = (float)isum * su_l * sh_l;
        const float c_l = gelu_erf(z) * g_l * sv_l;
        cvl[64 * c + lane] = c_l;
    }
    LDS_WAIT();
    float acc0[16], acc1[16], acc2[16], acc3[16];
#pragma unroll
    for (int d = 0; d < 16; ++d) { acc0[d] = 0.f; acc1[d] = 0.f; acc2[d] = 0.f; acc3[d] = 0.f; }
#define GQ_ISSUE(W, KP, CE, kreg, creg, p0) do { _Pragma("unroll") for (int q = 0; q < 8; ++q) { \
        KP[q] = (u32)__builtin_amdgcn_readlane((int)(kreg), (p0) + q); CE[q] = __uint_as_float((u32)__builtin_amdgcn_readlane((int)__float_as_uint(creg), (p0) + q)); \
        W[q] = *(const u32x4*)(PV + (size_t)(KP[q] >> 9) * 1024 + 16 * lane); } } while (0)
#define GQ_CONSUME(W, KP, CE) do { _Pragma("unroll") for (int q = 0; q < 8; ++q) { const u32 sl = (KP[q] >> 7) & 3u; \
        if (sl == 0u) GQ_FMA16(acc0, CE[q], W[q]); else if (sl == 1u) GQ_FMA16(acc1, CE[q], W[q]); else if (sl == 2u) GQ_FMA16(acc2, CE[q], W[q]); else GQ_FMA16(acc3, CE[q], W[q]); } } while (0)
    {
        u32x4 wA[8], wB[8]; u32 kA[8], kB[8]; float cA[8], cB[8];
        u32 kk = keyl[lane]; float cc = cvl[lane];
        GQ_ISSUE(wA, kA, cA, kk, cc, 0);
#pragma unroll 1
        for (int c = 0; c < 8; ++c) {
            const int cn = (c < 7) ? c + 1 : 7;
            const u32 kkn = keyl[64 * cn + lane]; const float ccn = cvl[64 * cn + lane];
#pragma unroll 1
            for (int p0 = 0; p0 < 64; p0 += 16) {
                GQ_ISSUE(wB, kB, cB, kk, cc, p0 + 8);
                GQ_CONSUME(wA, kA, cA);
                if (p0 < 48) GQ_ISSUE(wA, kA, cA, kk, cc, p0 + 16); else GQ_ISSUE(wA, kA, cA, kkn, ccn, 0);
                GQ_CONSUME(wB, kB, cB);
            }
            kk = kkn; cc = ccn;
        }
    }
#undef GQ_ISSUE
#undef GQ_CONSUME
    u32x2 hw[4][4];
#pragma unroll
    for (int s = 0; s < 4; ++s)
#pragma unroll
        for (int j = 0; j < 4; ++j) hw[s][j] = *(const u32x2*)(HN + (size_t)(tokq + s) * DM + 256 * j + 4 * lane);
#define GQ_OUT(s, A) do { float* orow = P.out + (size_t)(tokq + (s)) * DM; _Pragma("unroll") for (int j = 0; j < 4; ++j) { f32x4* p = (f32x4*)(orow + 256 * j + 4 * lane); \
        f32x4 v; v.x = bflo(hw[s][j].x) + A[4 * j]; v.y = bfhi(hw[s][j].x) + A[4 * j + 1]; v.z = bflo(hw[s][j].y) + A[4 * j + 2]; v.w = bfhi(hw[s][j].y) + A[4 * j + 3]; *p = v; } } while (0)
    GQ_OUT(0, acc0); GQ_OUT(1, acc1); GQ_OUT(2, acc2); GQ_OUT(3, acc3);
#undef GQ_OUT
}
__device__ __forceinline__ void peer_gather_tile(const Ctx& C, const Params& P, int tok0) {
    __syncthreads();
#pragma unroll 1
    for (int hq = 0; hq < 2; ++hq) peer_gather_quad(C, P, tok0 + 32 * hq + 4 * C.wave);
}

#define GAS __attribute__((address_space(1)))
typedef GAS unsigned gu32;
#define RLX_AGENT __ATOMIC_RELAXED, __HIP_MEMORY_SCOPE_AGENT
#define XB_TMO      128
#define XB_XCNT(j)  (256  + 64 * (j))
#define XB_XSUB(j)  (1280 + 64 * (j))
#define XB_XGEN(j)  (2304 + 64 * (j))
#define XB_TOP      3328
#define XB_TOPGEN   3392
#define XCD_BAR_WORDS 3456
#define XB_SPIN_CAP (1u << 18)

__device__ __forceinline__ unsigned xb_ld(unsigned* p)              { return __hip_atomic_load(p, __ATOMIC_RELAXED, __HIP_MEMORY_SCOPE_AGENT); }
__device__ __forceinline__ unsigned xb_add(unsigned* p, unsigned v) { return __hip_atomic_fetch_add(p, v, __ATOMIC_RELAXED, __HIP_MEMORY_SCOPE_AGENT); }
__device__ __forceinline__ unsigned xb_xcc_id() { return (unsigned)__builtin_amdgcn_s_getreg((3 << 11) | 20) & 0xFu; }
#define XB_SPIN(cond, bar) do { unsigned _sp = 0; while (cond) { __builtin_amdgcn_s_sleep(1); \
    if ((++_sp & 255u) == 0u) { if (xb_ld(&(bar)[XB_TMO])) break; if (_sp > XB_SPIN_CAP) { atomicAdd(&(bar)[XB_TMO], 1u); break; } } } } while (0)

struct XcdBarrier {
    unsigned* bar; unsigned x;
    volatile LAS unsigned* st;
};

__device__ __forceinline__ XcdBarrier xcd_barrier_post(unsigned* bar, volatile LAS unsigned* st) {
    XcdBarrier b; b.bar = bar; b.x = xb_xcc_id(); b.st = st;
    if (threadIdx.x == 0) (void)xb_add(&bar[XB_XCNT(b.x)], 1u);
    return b;
}
__device__ __forceinline__ void xcd_barrier_complete(unsigned* bar, unsigned x, unsigned& nloc, unsigned& nx) {
    const unsigned G = gridDim.x * gridDim.y * gridDim.z;
    unsigned sum, cnt, mine, sp = 0u;
    for (;;) {
        sum = 0u; cnt = 0u; mine = 0u;
#pragma unroll
        for (unsigned j = 0; j < 16; ++j) { const unsigned c = xb_ld(&bar[XB_XCNT(j)]); sum += c; cnt += (c > 0u) ? 1u : 0u; mine = (j == x) ? c : mine; }
        if (sum == G) break;
        __builtin_amdgcn_s_sleep(1);
        if ((++sp & 255u) == 0u) { if (xb_ld(&bar[XB_TMO])) break; if (sp > XB_SPIN_CAP) { atomicAdd(&bar[XB_TMO], 1u); break; } }
    }
    nloc = mine > 0u ? mine : 1u; nx = cnt > 0u ? cnt : 1u;
}

__device__ __forceinline__ void xcd_barrier(const XcdBarrier& b) {
    asm volatile("s_waitcnt vmcnt(0)" ::: "memory");
    __syncthreads();
    if (threadIdx.x == 0) {
        unsigned* bar = b.bar;
        __builtin_amdgcn_s_waitcnt(0);
        unsigned nloc = b.st[0], nx = b.st[1];
        if (nloc == 0u) { xcd_barrier_complete(bar, b.x, nloc, nx); b.st[0] = nloc; b.st[1] = nx; }
        const unsigned old = xb_add(&bar[XB_XSUB(b.x)], 1u);
        const unsigned gen = old / nloc;
        if (old + 1u == (gen + 1u) * nloc) {
            __builtin_amdgcn_fence(__ATOMIC_RELEASE, "agent");
            asm volatile("s_waitcnt vmcnt(0)" ::: "memory");
            const unsigned og = xb_add(&bar[XB_TOP], 1u);
            const unsigned tg = og / nx;
            if (og + 1u == (tg + 1u) * nx) xb_add(&bar[XB_TOPGEN], 1u);
            else XB_SPIN(xb_ld(&bar[XB_TOPGEN]) == tg, bar);
            __builtin_amdgcn_fence(__ATOMIC_ACQUIRE, "agent");
            xb_add(&bar[XB_XGEN(b.x)], 1u);
            asm volatile("s_waitcnt vmcnt(0)" ::: "memory");
        } else {
            XB_SPIN(xb_ld(&bar[XB_XGEN(b.x)]) == gen, bar);
            __builtin_amdgcn_fence(__ATOMIC_ACQUIRE, "agent");
            asm volatile("s_waitcnt vmcnt(0)" ::: "memory");
        }
    }
    __syncthreads();
}

constexpr int NPHASE = 9;
__global__ void __launch_bounds__(NTHR, 2) mk_fwd(Params P) {
    extern __shared__ __attribute__((aligned(16))) unsigned char lds_raw[];
    Ctx C; C.lds = (LAS unsigned char*)lds_raw; C.tid = threadIdx.x; C.lane = C.tid & 63; C.wave = __builtin_amdgcn_readfirstlane(C.tid >> 6); C.G = gridDim.x; C.bid = blockIdx.x;
    unsigned char* ws = P.ws;
    volatile LAS unsigned* MISC = (volatile LAS unsigned*)(C.lds + MISC_OFF);
    if (C.tid < 32) MISC[C.tid] = 0u;
    __syncthreads();
    XcdBarrier bar = xcd_barrier_post((unsigned*)(ws + WS_CTL) + 4096, MISC + 8);
#define SEAM(k) do { if (IN(k) && IN((k) + 1)) xcd_barrier(bar); FRESH(); } while (0)
#define FRESH() do { int t_ = (int)threadIdx.x; asm volatile("" : "+v"(t_)); C.tid = t_; C.lane = t_ & 63; } while (0)
#ifdef ONLY_PHASE
#define IN(k) ((k) == ONLY_PHASE && P.ph_lo <= (k) && (k) < P.ph_hi)
#else
#define IN(k) (P.ph_lo <= (k) && (k) < P.ph_hi)
#endif
    if (IN(0)) phase_prologue(C, P);
    SEAM(0);
    if (IN(1)) {
        pg8::Gemm g{(const bf16_t*)(ws + WS_BUFA), (const bf16_t*)(ws + WS_WIN_T), MPAD, INW, DM}; pg8::StaticOrder S; S.init(MPAD, INW, C.G, C.bid);
        pg8::EpiBf16<0> E{(bf16_t*)(ws + WS_PROJ), INW, nullptr, 0, 0, 1.f};
        pg8::gemm_phase<pg8::EpiBf16<0>, pg8::StaticOrder, true, true>(C.lds, g, S, E);
        { const int ntile = (MPAD / 256) * (INW / 256), nbusy = ntile % C.G;
          if (ntile > C.G && nbusy > 0) { if (C.bid >= nbusy) deferred_a(C, P, C.bid - nbusy, C.G - nbusy); }
          else deferred_a(C, P, C.bid, C.G); }
    }
    SEAM(1);
    if (IN(2)) phase_sloc(C, P);
    SEAM(2);
    if (IN(3)) {
        for (int bk = C.bid; bk < 64; bk += C.G) carry_scan_block(C, P, bk);
        for (int u = C.bid; u < 256; u += C.G) attn_unit(C, P, u >> 1, u & 1);
    }
    SEAM(3);
    if (IN(4)) phase_ssm_y(C, P);
    SEAM(4);
    if (IN(5)) {
        pg8::Gemm g{(const bf16_t*)(ws + WS_Z), (const bf16_t*)(ws + WS_GLU_T), SEQ, 512, 512}; pg8::StaticOrder S; S.init(SEQ, 512, C.G, C.bid);
        EpiGlu E{(const bf16_t*)(ws + WS_Z), (bf16_t*)(ws + WS_BUFA), P.in[I_GLUB], (float*)(ws + WS_SSS)};
        pg8::gemm_phase<EpiGlu, pg8::StaticOrder, true, true>(C.lds, g, S, E);
        { const int ntile = (SEQ / 256) * 2;
          if (ntile < C.G) { if (C.bid >= ntile) deferred_b(C, P, C.bid - ntile, C.G - ntile); }
          else deferred_b(C, P, C.bid, C.G); }
    }
    SEAM(5);
    if (IN(6)) {
        __syncthreads();
        if (C.tid < 256) {
            pg8::StaticOrder S0; S0.init(SEQ, DM, C.G, C.bid); pg8::Unit u0; S0.next(0, u0);
            const int row = u0.pm * 256 + C.tid;
            const f32x4* pa = (const f32x4*)((const float*)(ws + WS_SSA) + (size_t)row * 8); const f32x4* ps = (const f32x4*)((const float*)(ws + WS_SSS) + (size_t)row * 8);
            const f32x4 a0 = pa[0], a1 = pa[1], s0 = ps[0], s1 = ps[1];
            const float ra = 1.0f / sqrtf((((a0.x + a0.y) + (a0.z + a0.w)) + ((a1.x + a1.y) + (a1.z + a1.w))) * (1.0f / 512.0f) + EPS);
            const float rs = 1.0f / sqrtf((((s0.x + s0.y) + (s0.z + s0.w)) + ((s1.x + s1.y) + (s1.z + s1.w))) * (1.0f / 512.0f) + EPS);
            LAS float* fac = (LAS float*)(C.lds + FAC_OFF); fac[2 * C.tid] = ra / rs; fac[2 * C.tid + 1] = rs;
        }
        __syncthreads();
        pg8::Gemm g{(const bf16_t*)(ws + WS_BUFA), (const bf16_t*)(ws + WS_WOUT_T), SEQ, DM, DM}; pg8::StaticOrder S; S.init(SEQ, DM, C.G, C.bid);
        EpiMix E{P.in[I_X], (bf16_t*)(ws + WS_HB), (float*)(ws + WS_SSH)};
        pg8::gemm_phase<EpiMix, pg8::StaticOrder, true, true>(C.lds, g, S, E);
    }
    SEAM(6);
    if (IN(7)) {
        pg8::Gemm g{(const bf16_t*)(ws + WS_HB), (const bf16_t*)(ws + WS_WQ_T), SEQ, 2048, DM}; pg8::StaticOrder S; S.init(SEQ, 2048, C.G, C.bid);
        EpiQ E{(bf16_t*)(ws + WS_QP), (const float*)(ws + WS_SSH)};
        pg8::gemm_phase<EpiQ, pg8::StaticOrder, true, true>(C.lds, g, S, E);
    }
    SEAM(7);
    {
    if (IN(8)) {
        for (int tile = C.bid; tile < SEQ / 64; tile += C.G) {
            peer_topk_tile(C, P, tile * 64);
            peer_gather_tile(C, P, tile * 64);
        }
    }
    }
#undef IN
#undef SEAM
}
}

extern "C" void kernel_launch(void* const* d_in, const int* in_sizes, int n_in, void* d_out, int out_size, void* d_ws, size_t ws_size, hipStream_t stream) {
    static int state = 0, grid = 0;
    if (state == 0) {
        if (n_in != 25 || out_size != mk::SEQ * mk::DM || ws_size < mk::WS_END) { fprintf(stderr, "kernel_launch: unexpected shapes (n_in %d out %d ws %zu)\n", n_in, out_size, ws_size); state = -1; return; }
        if (hipFuncSetAttribute((const void*)mk::mk_fwd, hipFuncAttributeMaxDynamicSharedMemorySize, mk::LDS_BYTES) != hipSuccess) { fprintf(stderr, "kernel_launch: hipFuncSetAttribute failed\n"); state = -1; return; }
        int dev = 0, cus = 0, per_cu = 0;
        if (hipGetDevice(&dev) != hipSuccess || hipDeviceGetAttribute(&cus, hipDeviceAttributeMultiprocessorCount, dev) != hipSuccess) { fprintf(stderr, "kernel_launch: device query failed\n"); state = -1; return; }
        if (hipOccupancyMaxActiveBlocksPerMultiprocessor(&per_cu, (const void*)mk::mk_fwd, mk::NTHR, mk::LDS_BYTES) != hipSuccess || per_cu < 1) { fprintf(stderr, "kernel_launch: occupancy query failed (%d)\n", per_cu); state = -1; return; }
        grid = cus;
        state = 1;
    }
    if (state < 0) return;
    mk::Params p{};
    for (int i = 0; i < 25; ++i) p.in[i] = (const float*)d_in[i];
    p.out = (float*)d_out; p.ws = (unsigned char*)d_ws;
    if (hipMemsetAsync((char*)d_ws + mk::WS_CTL, 0, 65536, stream) != hipSuccess) { fprintf(stderr, "kernel_launch: memset failed\n"); return; }
    p.ph_lo = 0; p.ph_hi = mk::NPHASE;
    void* args[] = {&p};
    hipError_t e = hipLaunchCooperativeKernel((const void*)mk::mk_fwd, dim3(grid), dim3(mk::NTHR), args, mk::LDS_BYTES, stream);
    if (e != hipSuccess) fprintf(stderr, "kernel_launch: cooperative launch failed: %s (grid %d)\n", hipGetErrorString(e), grid);
}
```

```cpp
#include <hip/hip_runtime.h>
#include <cstdio>
#include <cstdint>
#include <cmath>
namespace pg8 {
#define PG8_LAS __attribute__((address_space(3)))
typedef unsigned short bf16_t;
typedef short bf16x8 __attribute__((ext_vector_type(8)));
typedef float f32x4 __attribute__((ext_vector_type(4)));
typedef unsigned u32x4 __attribute__((ext_vector_type(4)));
constexpr int BM = 256, BK = 64, HALF = 128, HTB = HALF * BK * 2  , STAGE_BYTES = 8 * HTB, NXCD = 8, WGM = 8;

__host__ __device__ __forceinline__ int lds_byte(int r, int c) { const int st = (r >> 4) * 2 + (c >> 5), rr = r & 15, cc = c & 31, ob = rr * 64 + cc * 2; return st * 1024 + (ob ^ (((ob >> 9) & 1) << 5)); }
__host__ __device__ __forceinline__ void stage_rc(int b, int& R, int& C) { const int st = b / 1024, sb = b % 1024, swz = sb ^ (((sb >> 9) & 1) << 5); R = (st >> 1) * 16 + swz / 64; C = (st & 1) * 32 + (swz % 64) / 2; }
__host__ __device__ __forceinline__ int perm32(int rho) { const int n = rho >> 4, i = rho & 15; return 8 * (i >> 2) + 4 * n + (i & 3); }

struct Unit { int pm, pn; };
struct Gemm { const bf16_t* A; const bf16_t* Bt; int M, N, K; };

struct StaticOrder {
    int nM, nN, nwg, G, c;
    __host__ __device__ __forceinline__ void init(int M, int N, int G_, int c_) { nM = M / BM; nN = N / BM; nwg = nM * nN; G = G_; c = c_; }
    __host__ __device__ __forceinline__ bool next(int i, Unit& u) const {
        const long L = (long)i * G + c; if (L >= nwg) return false;
        int wgid = (int)L; { const int q = nwg / NXCD, r = nwg % NXCD, xcd = wgid % NXCD, off = wgid / NXCD; wgid = (xcd < r ? xcd * (q + 1) : r * (q + 1) + (xcd - r) * q) + off; }
        const int nig = WGM * nN, gid = wgid / nig, fm = gid * WGM, gsz = (nM - fm) < WGM ? (nM - fm) : WGM;
        u.pm = fm + ((wgid % nig) % gsz); u.pn = (wgid % nig) / gsz; return true;
    }
    __device__ __forceinline__ void a_ready(const Unit&) const {}
    __device__ __forceinline__ void done(const Unit&) const {}
};

__device__ __forceinline__ unsigned cvt_pk_bf16(float lo, float hi) { unsigned r; asm volatile("v_cvt_pk_bf16_f32 %0, %1, %2" : "=v"(r) : "v"(lo), "v"(hi)); return r; }
typedef float f32x2 __attribute__((ext_vector_type(2)));
__device__ __forceinline__ f32x2 gelu_pk(f32x2 v) {
    const f32x2 av = __builtin_elementwise_abs(v), d = av * 0.2316418882f + 1.0f;
    f32x2 t; t.x = __builtin_amdgcn_rcpf(d.x); t.y = __builtin_amdgcn_rcpf(d.y);
    f32x2 q = t * 0.5307027145f + (-0.7265760135f); q = q * t + 0.7107068705f; q = q * t + (-0.142248368f); q = q * t + 0.127414796f; q = q * t;
    const f32x2 s = (v * v) * (-0.72134752044f);
    f32x2 e; e.x = __builtin_amdgcn_exp2f(s.x); e.y = __builtin_amdgcn_exp2f(s.y);
    const f32x2 m = v * (q * e), r = v - m;
    f32x2 o; o.x = v.x < 0.f ? m.x : r.x; o.y = v.y < 0.f ? m.y : r.y; return o;
}

template <int ACT  > struct EpiBf16 {
    static constexpr bool PERM = true, AFTER_DRAIN = false, HAS_MID = false; static_assert(ACT == 0 || ACT == 1, "EpiBf16: ACT is 0 (none) or 1 (gelu_pk)");
    bf16_t* O; int ldc; const float* bias; int split_cols; size_t split_stride; float scale0;
    __device__ __forceinline__ void operator()(const f32x4 (&acc)[2][2][4][2], const Unit& u, int wr, int wc, int fr, int fq) const {
        const int row0 = u.pm * BM + wr * 64 + fr; int colt = u.pn * BM; bf16_t* base = O;
        float sc = 1.f; if (split_cols) { const int t = colt / split_cols; base += (size_t)t * split_stride; colt -= t * split_cols; if (t == 0) sc = scale0; }
        const int col0 = colt + wc * 32 + 8 * fq, bcol0 = u.pn * BM + wc * 32 + 8 * fq;
        f32x4 bv[2][2];
#pragma unroll
        for (int bj = 0; bj < 2; ++bj)
#pragma unroll
            for (int n = 0; n < 2; ++n) bv[bj][n] = bias ? *(const f32x4*)(bias + bcol0 + bj * HALF + 4 * n) : (f32x4){0.f, 0.f, 0.f, 0.f};
#pragma unroll
        for (int ai = 0; ai < 2; ++ai)
#pragma unroll
            for (int m = 0; m < 4; ++m) { bf16_t* rowp = base + (size_t)(row0 + ai * HALF + m * 16) * ldc + col0;
#pragma unroll
                for (int bj = 0; bj < 2; ++bj) { f32x4 v0 = acc[ai][bj][m][0] + bv[bj][0], v1 = acc[ai][bj][m][1] + bv[bj][1];
                    if (ACT == 1) { f32x2 a = gelu_pk((f32x2){v0[0], v0[1]}), b = gelu_pk((f32x2){v0[2], v0[3]}), c = gelu_pk((f32x2){v1[0], v1[1]}), d = gelu_pk((f32x2){v1[2], v1[3]});
                        v0 = (f32x4){a.x, a.y, b.x, b.y}; v1 = (f32x4){c.x, c.y, d.x, d.y}; }
                    v0 = v0 * sc; v1 = v1 * sc; u32x4 w; w.x = cvt_pk_bf16(v0[0], v0[1]); w.y = cvt_pk_bf16(v0[2], v0[3]); w.z = cvt_pk_bf16(v1[0], v1[1]); w.w = cvt_pk_bf16(v1[2], v1[3]);
                    *(u32x4*)(rowp + bj * HALF) = w; } }
    }
};
template <class Epi, class Sched, bool ALIGN_EPI = false, bool SP2 = false>
__device__ __forceinline__ void gemm_phase(PG8_LAS unsigned char* lds, const Gemm g, const Sched& S, const Epi& E) {
    const int tid = threadIdx.x, wid = __builtin_amdgcn_readfirstlane(tid >> 6), lane = tid & 63, wr = wid >> 2, wc = wid & 3, fr = lane & 15, fq = lane >> 4;
    const int K = g.K, nt = K / BK;
    unsigned voffA[2], voffB[2];
#pragma unroll
    for (int i = 0; i < 2; ++i) { int R, C; stage_rc(tid * 16 + i * 8192, R, C); const int Rb = Epi::PERM ? ((R & ~31) + perm32(R & 31)) : R;
        voffA[i] = (unsigned)(R * K + C) * 2u; voffB[i] = (unsigned)(Rb * K + C) * 2u; }
    const size_t kstep = (size_t)(BK * 2);
    const size_t hstep = (size_t)HALF * K * 2;
    const size_t tstep = 2 * hstep;
    const unsigned ldsw = (unsigned)wid * 1024u;
    const int aoff = lds_byte(wr * 64 + fr, fq * 8), boff = lds_byte(wc * 32 + fr, fq * 8);
#define PG8_SA(b, h) (((b) * 2 + (h)) * HTB)
#define PG8_SB(b, h) ((4 + (b) * 2 + (h)) * HTB)
#define PG8_STAGE(bufoff, gbase, voff) do { _Pragma("unroll") for (int _i = 0; _i < 2; ++_i) \
        __builtin_amdgcn_global_load_lds((const unsigned*)((const char*)(gbase) + (voff)[_i]), (PG8_LAS unsigned*)(lds + (bufoff) + ldsw + _i * 8192), 16, 0, 0); } while (0)
#define PG8_LDA(dst, b, h) do { _Pragma("unroll") for (int m = 0; m < 4; ++m) _Pragma("unroll") for (int k = 0; k < 2; ++k) dst[m][k] = *(const PG8_LAS bf16x8*)(lds + PG8_SA(b, h) + aoff + m * 2048 + k * 1024); } while (0)
#define PG8_LDB(dst, b, h) do { _Pragma("unroll") for (int n = 0; n < 2; ++n) _Pragma("unroll") for (int k = 0; k < 2; ++k) dst[n][k] = *(const PG8_LAS bf16x8*)(lds + PG8_SB(b, h) + boff + n * 2048 + k * 1024); } while (0)
#define PG8_MMA(ai, bj, At, Bt) do { __builtin_amdgcn_s_setprio(1); _Pragma("unroll") for (int m = 0; m < 4; ++m) _Pragma("unroll") for (int n = 0; n < 2; ++n) _Pragma("unroll") for (int k = 0; k < 2; ++k) \
        acc[ai][bj][m][n] = __builtin_amdgcn_mfma_f32_16x16x32_bf16(Bt[n][k], At[m][k], acc[ai][bj][m][n], 0, 0, 0); __builtin_amdgcn_s_setprio(0); } while (0)
#define PG8_WAIT_V(n) asm volatile("s_waitcnt vmcnt(" #n ")" ::: "memory")
#define PG8_WAIT_L(n) asm volatile("s_waitcnt lgkmcnt(" #n ")" ::: "memory")
#define PG8_BAR __builtin_amdgcn_s_barrier()
#define PG8_SCHED __builtin_amdgcn_sched_barrier(0)
    Unit cur, nxt; int ui = 0;
    if (!S.next(0, cur)) return;
    f32x4 acc[2][2][4][2];
#pragma unroll
    for (int a = 0; a < 2; ++a)
#pragma unroll
        for (int b = 0; b < 2; ++b)
#pragma unroll
            for (int m = 0; m < 4; ++m)
#pragma unroll
                for (int n = 0; n < 2; ++n) acc[a][b][m][n] = (f32x4){0.f, 0.f, 0.f, 0.f};
    bf16x8 At[4][2], B0[2][2], B1[2][2];
    const char* cA = (const char*)g.A + (size_t)cur.pm * tstep; const char* cB = (const char*)g.Bt + (size_t)cur.pn * tstep;
    S.a_ready(cur);
    if constexpr (SP2) {
        PG8_STAGE(PG8_SB(0, 0), cB, voffB); PG8_STAGE(PG8_SB(0, 1), cB + hstep, voffB); PG8_STAGE(PG8_SA(0, 0), cA, voffA); PG8_STAGE(PG8_SA(0, 1), cA + hstep, voffA);
        if (wr == 1) PG8_BAR;
        PG8_WAIT_V(2); PG8_BAR;
        PG8_STAGE(PG8_SB(1, 0), cB + kstep, voffB); PG8_STAGE(PG8_SA(1, 0), cA + kstep, voffA); PG8_STAGE(PG8_SB(1, 1), cB + hstep + kstep, voffB);
        PG8_WAIT_V(6); PG8_BAR;
    } else {
        PG8_STAGE(PG8_SB(0, 0), cB, voffB); PG8_STAGE(PG8_SA(0, 0), cA, voffA); PG8_STAGE(PG8_SB(0, 1), cB + hstep, voffB); PG8_STAGE(PG8_SA(0, 1), cA + hstep, voffA);
        if (wr == 1) PG8_BAR;
        PG8_WAIT_V(4); PG8_BAR;
        PG8_STAGE(PG8_SB(1, 0), cB + kstep, voffB); PG8_STAGE(PG8_SA(1, 0), cA + kstep, voffA); PG8_STAGE(PG8_SB(1, 1), cB + hstep + kstep, voffB);
        PG8_WAIT_V(6); PG8_BAR;
    }
    for (;;) {
        const bool has_next = S.next(ui + 1, nxt);
        const char* nA = has_next ? (const char*)g.A + (size_t)nxt.pm * tstep : cA; const char* nB = has_next ? (const char*)g.Bt + (size_t)nxt.pn * tstep : cB;
        for (int t = 0; t < nt; t += 2) {
            const bool last = (t == nt - 2);
            if constexpr (Epi::HAS_MID) { if (t == nt / 2) E.mid(acc, cur, wr, wc, fr, fq, lds); }
            const char* a1 = cA + (size_t)(t + 1) * kstep;
            const char* a2 = last ? nA : cA + (size_t)(t + 2) * kstep; const char* b2 = last ? nB : cB + (size_t)(t + 2) * kstep;
            const char* a3 = a2 + kstep; const char* b3 = b2 + kstep;
            if (last && has_next) S.a_ready(nxt);
            if constexpr (SP2) {
            PG8_LDB(B0, 0, 0); PG8_LDB(B1, 0, 1); PG8_SCHED; PG8_LDA(At, 0, 0); PG8_STAGE(PG8_SA(1, 1), a1 + hstep, voffA);
            PG8_WAIT_V(8); PG8_WAIT_L(0); PG8_BAR; PG8_MMA(0, 0, At, B0); PG8_MMA(0, 1, At, B1); PG8_BAR; PG8_SCHED;
            PG8_LDA(At, 0, 1); PG8_STAGE(PG8_SB(0, 0), b2, voffB); PG8_STAGE(PG8_SB(0, 1), b2 + hstep, voffB); PG8_STAGE(PG8_SA(0, 0), a2, voffA);
            PG8_WAIT_V(8); PG8_WAIT_L(0); PG8_BAR; PG8_MMA(1, 0, At, B0); PG8_MMA(1, 1, At, B1); PG8_BAR; PG8_SCHED;
            PG8_LDB(B0, 1, 0); PG8_LDB(B1, 1, 1); PG8_SCHED; PG8_LDA(At, 1, 0); PG8_STAGE(PG8_SA(0, 1), a2 + hstep, voffA);
            PG8_WAIT_V(8); PG8_WAIT_L(0); PG8_BAR; PG8_MMA(0, 0, At, B0); PG8_MMA(0, 1, At, B1); PG8_BAR; PG8_SCHED;
            PG8_LDA(At, 1, 1); PG8_STAGE(PG8_SB(1, 0), b3, voffB); PG8_STAGE(PG8_SB(1, 1), b3 + hstep, voffB); PG8_STAGE(PG8_SA(1, 0), a3, voffA);
            PG8_WAIT_V(8); PG8_WAIT_L(0); PG8_BAR; PG8_MMA(1, 0, At, B0); PG8_MMA(1, 1, At, B1); PG8_BAR; PG8_SCHED;
            } else {
            PG8_LDB(B0, 0, 0); PG8_SCHED; PG8_LDA(At, 0, 0); PG8_STAGE(PG8_SA(1, 1), a1 + hstep, voffA);
            PG8_WAIT_L(8); PG8_BAR; PG8_WAIT_L(0); PG8_MMA(0, 0, At, B0); PG8_BAR; PG8_SCHED;
            PG8_LDB(B1, 0, 1); PG8_STAGE(PG8_SB(0, 0), b2, voffB);
            PG8_BAR; PG8_WAIT_L(0); PG8_MMA(0, 1, At, B1); PG8_BAR;
            PG8_LDA(At, 0, 1); PG8_STAGE(PG8_SA(0, 0), a2, voffA);
            PG8_BAR; PG8_WAIT_L(0); PG8_MMA(1, 0, At, B0); PG8_BAR; PG8_SCHED;
            PG8_STAGE(PG8_SB(0, 1), b2 + hstep, voffB);
            PG8_WAIT_V(6); PG8_BAR; PG8_MMA(1, 1, At, B1); PG8_BAR;
            PG8_LDB(B0, 1, 0); PG8_SCHED; PG8_LDA(At, 1, 0); PG8_STAGE(PG8_SA(0, 1), a2 + hstep, voffA);
            PG8_WAIT_L(8); PG8_BAR; PG8_WAIT_L(0); PG8_MMA(0, 0, At, B0); PG8_BAR; PG8_SCHED;
            PG8_LDB(B1, 1, 1); PG8_STAGE(PG8_SB(1, 0), b3, voffB);
            PG8_BAR; PG8_WAIT_L(0); PG8_MMA(0, 1, At, B1); PG8_BAR;
            PG8_LDA(At, 1, 1); PG8_STAGE(PG8_SA(1, 0), a3, voffA);
            PG8_BAR; PG8_WAIT_L(0); PG8_MMA(1, 0, At, B0); PG8_BAR; PG8_SCHED;
            PG8_STAGE(PG8_SB(1, 1), b3 + hstep, voffB);
            PG8_WAIT_V(6); PG8_BAR; PG8_MMA(1, 1, At, B1); PG8_BAR;
            }
        }
        if constexpr (ALIGN_EPI) { if (wr == 0) PG8_BAR; }
        if constexpr (!Epi::AFTER_DRAIN) { E(acc, cur, wr, wc, fr, fq); S.done(cur); }
        if (!has_next) break;
#pragma unroll
        for (int a = 0; a < 2; ++a)
#pragma unroll
            for (int b = 0; b < 2; ++b)
#pragma unroll
                for (int m = 0; m < 4; ++m)
#pragma unroll
                    for (int n = 0; n < 2; ++n) acc[a][b][m][n] = (f32x4){0.f, 0.f, 0.f, 0.f};
        cur = nxt; cA = nA; cB = nB; ++ui;
        if constexpr (ALIGN_EPI) { if (wr == 1) PG8_BAR; }
    }
    PG8_WAIT_V(0);
    if constexpr (!ALIGN_EPI) { if (wr == 0) PG8_BAR; }
    PG8_BAR;
    if constexpr (Epi::AFTER_DRAIN) { E.fused(acc, cur, wr, wc, fr, fq, lds, wid, lane); S.done(cur); }
#undef PG8_SA
#undef PG8_SB
#undef PG8_STAGE
#undef PG8_LDA
#undef PG8_LDB
#undef PG8_MMA
#undef PG8_WAIT_V
#undef PG8_WAIT_L
#undef PG8_BAR
#undef PG8_SCHED
}
}

namespace mk {
#define LAS __attribute__((address_space(3)))
typedef unsigned short bf16_t;
typedef short bf16x8 __attribute__((ext_vector_type(8)));
typedef float f32x4 __attribute__((ext_vector_type(4)));
typedef float f32x16 __attribute__((ext_vector_type(16)));
typedef unsigned u32x4 __attribute__((ext_vector_type(4)));
typedef unsigned u32x2 __attribute__((ext_vector_type(2)));
typedef __bf16 bf16x2_t __attribute__((ext_vector_type(2)));
typedef float f32x2_t __attribute__((ext_vector_type(2)));
typedef unsigned u32;

constexpr int DM = 1024, SEQ = 16384, NMETA = 16, MPAD = 16640, INW = 1280;
constexpr int O_K = 512, O_V = 640, O_U = 768;
constexpr int NCH = 513;
constexpr float EPS = 1e-6f;
constexpr float LOG2E = 1.4426950408889634f;
constexpr int NWAVES = 8, NTHR = 512;
constexpr int LDS_BYTES = 163840;
constexpr int MISC_OFF = LDS_BYTES - 128;

constexpr size_t MiB = 1u << 20;
constexpr size_t WS_CTL = 0, CTL_BYTES = 1 * MiB;
constexpr size_t WS_WIN_T = 1 * MiB;
constexpr size_t WS_WOUT_T = 4 * MiB;
constexpr size_t WS_WQ_T = 6 * MiB;
constexpr size_t WS_GLU_T = 10 * MiB;
constexpr size_t WS_SUBK = 10 * MiB + 512 * 1024;
constexpr size_t WS_KT = 11 * MiB;
constexpr size_t WS_F = 12 * MiB;
constexpr size_t WS_E = 16 * MiB;
constexpr size_t WS_ABART = 20 * MiB;
constexpr size_t WS_SLOC = 21 * MiB;
constexpr size_t WS_CARRY = 30 * MiB;
constexpr size_t WS_BUFA = 39 * MiB;
constexpr size_t WS_PROJ = 72 * MiB;
constexpr size_t WS_ATTN = 113 * MiB;
constexpr size_t WS_Z = 129 * MiB;
constexpr size_t WS_SSMO = 145 * MiB;
constexpr size_t WS_QP = 72 * MiB;
constexpr size_t WS_IDX = 161 * MiB;
constexpr size_t WS_GW = 169 * MiB;
constexpr size_t WS_PU = 177 * MiB;
constexpr size_t WS_PV = 193 * MiB;
constexpr size_t WS_SU = 209 * MiB;
constexpr size_t WS_SV = 209 * MiB + 65536;
constexpr size_t WS_HB = 210 * MiB;
constexpr size_t WS_SSA = 242 * MiB;
constexpr size_t WS_SSS = 242 * MiB + 512 * 1024;
constexpr size_t WS_SSH = 243 * MiB;
constexpr size_t WS_END = 245 * MiB;

struct Params { const float* in[25]; float* out; unsigned char* ws; int ph_lo, ph_hi; };
enum { I_X = 0, I_META, I_N1G, I_WIN, I_QNG, I_KNG, I_SINK, I_ARE, I_AIM, I_LDT, I_BRE, I_BIM, I_CRE, I_CIM, I_SD, I_GLUW, I_GLUB, I_AOG, I_SOG, I_WOUT, I_N2G, I_WQ, I_SUBK, I_PU, I_PV };

__device__ __forceinline__ unsigned pk2(float lo, float hi) { f32x2_t v = {lo, hi}; return __builtin_bit_cast(unsigned, __builtin_convertvector(v, bf16x2_t)); }
__device__ __forceinline__ float bflo(unsigned w) { return __uint_as_float(w << 16); }
__device__ __forceinline__ float bfhi(unsigned w) { return __uint_as_float(w & 0xffff0000u); }
__device__ __forceinline__ float wave_sum(float v) {
#pragma unroll
    for (int o = 1; o < 64; o <<= 1) v += __shfl_xor(v, o);
    return v;
}
#define LDS_WAIT() asm volatile("s_waitcnt lgkmcnt(0)" ::: "memory")
__device__ __forceinline__ float gelu_erf(float v) { return 0.5f * v * (1.0f + erff(v * 0.70710678118654752f)); }
__device__ __forceinline__ u32 f2ord(float f) { const u32 u = __float_as_uint(f); return (u & 0x80000000u) ? ~u : (u | 0x80000000u); }
__device__ __forceinline__ float ord2f(u32 o) { const u32 u = (o & 0x80000000u) ? (o & 0x7fffffffu) : ~o; return __uint_as_float(u); }
#define MFMA16(a, b, c) __builtin_amdgcn_mfma_f32_16x16x32_bf16((a), (b), (c), 0, 0, 0)
#define MFMA32(a, b, c) __builtin_amdgcn_mfma_f32_32x32x16_bf16((a), (b), (c), 0, 0, 0)

#define CEX(x, i, j) do { const u32 _a = x[i], _b = x[j]; x[i] = _a > _b ? _a : _b; x[j] = _a > _b ? _b : _a; } while (0)
__device__ __forceinline__ void sort16_desc(u32 (&x)[16]) {
#pragma unroll
    for (int k = 2; k <= 16; k <<= 1) {
#pragma unroll
        for (int j = k >> 1; j > 0; j >>= 1) {
#pragma unroll
            for (int i = 0; i < 16; ++i) { const int l = i ^ j; if (l > i) { if ((i & k) == 0) CEX(x, i, l); else CEX(x, l, i); } }
        }
    }
}
__device__ __forceinline__ void bmerge16_desc(u32 (&x)[16]) {
#pragma unroll
    for (int j = 8; j > 0; j >>= 1) {
#pragma unroll
        for (int i = 0; i < 16; ++i) { const int l = i ^ j; if (l > i) CEX(x, i, l); }
    }
}
__device__ __forceinline__ void merge_top16(u32 (&a)[16], const u32 (&b)[16]) {
#pragma unroll
    for (int i = 0; i < 16; ++i) a[i] = a[i] > b[15 - i] ? a[i] : b[15 - i];
    bmerge16_desc(a);
}
__device__ __forceinline__ void top16_of_64(u32 (&g0)[16], u32 (&g1)[16], u32 (&g2)[16], u32 (&g3)[16]) {
    sort16_desc(g0); sort16_desc(g1); sort16_desc(g2); sort16_desc(g3);
    merge_top16(g0, g1); merge_top16(g2, g3); merge_top16(g0, g2);
}
__device__ const unsigned char CAND_AB[64] = {0, 1, 2, 3, 4, 5, 6, 7, 8, 9, 10, 11, 12, 13, 14, 15, 16, 17, 18, 19, 20, 21, 22, 23, 32, 33, 34, 35, 36, 48, 49, 50, 51, 64, 65, 66, 80, 81, 96, 97, 112, 113, 128, 144, 160, 176, 192, 208, 224, 240, 0, 0, 0, 0, 0, 0, 0, 0, 0, 0, 0, 0, 0, 0};

struct Ctx { LAS unsigned char* lds; int tid, lane, wave, G, bid; };

__device__ __forceinline__ void transpose_item(const float* W, int K, int N, bf16_t* WT, LAS float* scr, int item, int lane, const float* ks0 = nullptr, const float* ks1 = nullptr, int ksplit = 0) {
    const int nblk = N / 32, kb = item / nblk, nb = item % nblk, k0 = 64 * kb, n0 = 32 * nb;
#pragma unroll 8
    for (int i = 0; i < 32; ++i) { const int kk = 2 * i + (lane >> 5); float w = W[(size_t)(k0 + kk) * N + n0 + (lane & 31)];
        if (ks0) { const int k = k0 + kk; w *= (ksplit && k >= ksplit) ? ks1[k - ksplit] : ks0[k]; }
        scr[kk * 33 + (lane & 31)] = w; }
    LDS_WAIT();
    const int c = lane & 7;
#pragma unroll
    for (int j = 0; j < 4; ++j) { const int n = (lane >> 3) + 8 * j; const LAS float* s = scr + (8 * c) * 33 + n;
        u32x4 o; o.x = pk2(s[0 * 33], s[1 * 33]); o.y = pk2(s[2 * 33], s[3 * 33]); o.z = pk2(s[4 * 33], s[5 * 33]); o.w = pk2(s[6 * 33], s[7 * 33]);
        *(u32x4*)(WT + (size_t)(n0 + n) * K + k0 + 8 * c) = o; }
    LDS_WAIT();
}

__device__ __forceinline__ void ssm_tables(const Ctx& C, const Params& P, int g) {
    LAS float* pwr = (LAS float*)C.lds;
    LAS float* pwi = pwr + 33 * 64;
    LAS float* bbr = pwi + 33 * 64;
    LAS float* bbi = bbr + 1024;
    LAS float* ccr = bbi + 1024;
    LAS float* cci = ccr + 1024;
    LAS float* cfr = cci + 1024;
    LAS float* cfi = cfr + 64;
    const int tid = C.tid;
    const float dt = expf(P.in[I_LDT][g]);
    for (int e = tid; e < 33 * 64; e += NTHR) {
        const int l = e >> 6, n = e & 63;
        const float lr = P.in[I_ARE][g * 64 + n], li = P.in[I_AIM][g * 64 + n];
        const float x = lr * dt * (float)l, th = li * dt * (float)l, mag = expf(x);
        float s, c; sincosf(th, &s, &c);
        pwr[e] = mag * c; pwi[e] = mag * s;
        if (l == 32) { float* abt = (float*)(P.ws + WS_ABART) + (g * 64 + n) * 2; abt[0] = mag * c; abt[1] = mag * s; }
    }
    if (tid < 64) {
        const int n = tid;
        const float lr = P.in[I_ARE][g * 64 + n], li = P.in[I_AIM][g * 64 + n];
        const float x1 = lr * dt, th1 = li * dt, em1 = expm1f(x1);
        float s1, c1; sincosf(th1, &s1, &c1);
        const float sh = sinf(0.5f * th1);
        const float nr = em1 * c1 - 2.0f * sh * sh, ni = (em1 + 1.0f) * s1;
        const float den = lr * lr + li * li;
        cfr[n] = (nr * lr + ni * li) / den; cfi[n] = (ni * lr - nr * li) / den;
    }
    __syncthreads();
    for (int e = tid; e < 1024; e += NTHR) {
        const int n = e >> 4;
        const float br = P.in[I_BRE][g * 1024 + e], bi = P.in[I_BIM][g * 1024 + e];
        bbr[e] = cfr[n] * br - cfi[n] * bi; bbi[e] = cfr[n] * bi + cfi[n] * br;
        ccr[e] = P.in[I_CRE][g * 1024 + e]; cci[e] = P.in[I_CIM][g * 1024 + e];
    }
    __syncthreads();
    bf16_t* Kt = (bf16_t*)(P.ws + WS_KT) + (size_t)g * 8448;
    {
        const int pq = tid & 255, p = pq >> 4, q = pq & 15, l0 = (tid >> 8) * 16;
        float val[16];
#pragma unroll
        for (int i = 0; i < 16; ++i) val[i] = 0.f;
#pragma unroll
        for (int n0 = 0; n0 < 64; n0 += 16) {
            float cbr[16], cbi[16];
#pragma unroll
            for (int n = 0; n < 16; ++n) { const float cr = ccr[p * 64 + n0 + n], ci = cci[p * 64 + n0 + n], br = bbr[(n0 + n) * 16 + q], bi = bbi[(n0 + n) * 16 + q]; cbr[n] = cr * br - ci * bi; cbi[n] = cr * bi + ci * br; }
#pragma unroll
            for (int i = 0; i < 16; ++i) {
                const int lg = l0 + i;
#pragma unroll
                for (int n = 0; n < 16; n += 4) {
                    const f32x4 ar = *(const LAS f32x4*)(pwr + lg * 64 + n0 + n), ai = *(const LAS f32x4*)(pwi + lg * 64 + n0 + n);
                    val[i] += cbr[n] * ar.x - cbi[n] * ai.x; val[i] += cbr[n + 1] * ar.y - cbi[n + 1] * ai.y; val[i] += cbr[n + 2] * ar.z - cbi[n + 2] * ai.z; val[i] += cbr[n + 3] * ar.w - cbi[n + 3] * ai.w;
                }
            }
        }
#pragma unroll
        for (int i = 0; i < 16; ++i) Kt[(l0 + i + 1) * 256 + pq] = (bf16_t)(pk2(val[i], 0.f) & 0xffffu);
        if (tid < 256) Kt[tid] = 0;
    }
    bf16_t* F = (bf16_t*)(P.ws + WS_F) + (size_t)g * 65536;
    for (int e8 = tid; e8 < 8192; e8 += NTHR) {
        const int n2 = e8 >> 6, k0 = (e8 & 63) * 8, j = k0 >> 4, q0 = k0 & 15, n = n2 & 63, l = 31 - j;
        const float ar = pwr[l * 64 + n], ai = pwi[l * 64 + n];
        float w[8];
#pragma unroll
        for (int i = 0; i < 8; ++i) { const float br = bbr[n * 16 + q0 + i], bi = bbi[n * 16 + q0 + i]; w[i] = (n2 < 64) ? (ar * br - ai * bi) : (ar * bi + ai * br); }
        u32x4 o; o.x = pk2(w[0], w[1]); o.y = pk2(w[2], w[3]); o.z = pk2(w[4], w[5]); o.w = pk2(w[6], w[7]);
        *(u32x4*)(F + (size_t)e8 * 8) = o;
    }
    bf16_t* E = (bf16_t*)(P.ws + WS_E) + (size_t)g * 65536;
    for (int e8 = tid; e8 < 8192; e8 += NTHR) {
        const int row = e8 >> 4, n20 = (e8 & 15) * 8, t = row >> 4, p = row & 15, n0 = n20 & 63;
        float w[8];
#pragma unroll
        for (int i = 0; i < 8; ++i) { const int n = n0 + i; const float pr = pwr[(t + 1) * 64 + n], pi = pwi[(t + 1) * 64 + n], cr = ccr[p * 64 + n], ci = cci[p * 64 + n];
            w[i] = (n20 < 64) ? (cr * pr - ci * pi) : -(cr * pi + ci * pr); }
        u32x4 o; o.x = pk2(w[0], w[1]); o.y = pk2(w[2], w[3]); o.z = pk2(w[4], w[5]); o.w = pk2(w[6], w[7]);
        *(u32x4*)(E + (size_t)e8 * 8) = o;
    }
    __syncthreads();
}

__device__ __forceinline__ void norm_row_to_bf16(const float* src, const float* gam, bf16_t* dst, int lane) {
    const f32x4* xr = (const f32x4*)src + lane; const f32x4* gr = (const f32x4*)gam + lane;
    f32x4 v[4]; float s = 0.f;
#pragma unroll
    for (int j = 0; j < 4; ++j) { v[j] = xr[64 * j]; s += (v[j].x * v[j].x + v[j].y * v[j].y) + (v[j].z * v[j].z + v[j].w * v[j].w); }
    const float rinv = 1.0f / sqrtf(wave_sum(s) * (1.0f / DM) + EPS);
    u32x2* o = (u32x2*)dst + lane;
#pragma unroll
    for (int j = 0; j < 4; ++j) { const f32x4 g = gr[64 * j]; u32x2 w; w.x = pk2(v[j].x * rinv * g.x, v[j].y * rinv * g.y); w.y = pk2(v[j].z * rinv * g.z, v[j].w * rinv * g.w); o[64 * j] = w; }
}

__device__ __forceinline__ void cvt8(const float* src, bf16_t* dst, size_t i) {
    const f32x4 a = ((const f32x4*)src)[2 * i], b = ((const f32x4*)src)[2 * i + 1];
    u32x4 o; o.x = pk2(a.x, a.y); o.y = pk2(a.z, a.w); o.z = pk2(b.x, b.y); o.w = pk2(b.z, b.w);
    ((u32x4*)dst)[i] = o;
}

__device__ __forceinline__ float wave_max(float m) {
    m = fmaxf(m, __builtin_bit_cast(float, __builtin_amdgcn_update_dpp(0, __builtin_bit_cast(int, m), 0xB1, 0xf, 0xf, true)));
    m = fmaxf(m, __builtin_bit_cast(float, __builtin_amdgcn_update_dpp(0, __builtin_bit_cast(int, m), 0x4E, 0xf, 0xf, true)));
    m = fmaxf(m, __builtin_bit_cast(float, __builtin_amdgcn_update_dpp(0, __builtin_bit_cast(int, m), 0x141, 0xf, 0xf, true)));
    m = fmaxf(m, __builtin_bit_cast(float, __builtin_amdgcn_update_dpp(0, __builtin_bit_cast(int, m), 0x140, 0xf, 0xf, true)));
    u32 x = __builtin_bit_cast(u32, m);
    { u32 b = x; asm volatile("" : "+v"(b)); const auto p = __builtin_amdgcn_permlane16_swap(x, b, false, false); x = p[0] > p[1] ? p[0] : p[1]; }
    { u32 b = x; asm volatile("" : "+v"(b)); const auto p = __builtin_amdgcn_permlane32_swap(x, b, false, false); x = p[0] > p[1] ? p[0] : p[1]; }
    m = __builtin_bit_cast(float, x);
    return m;
}
template <int NR> __device__ __forceinline__ void quant_rows(const Params& P, const int (&rr)[NR], int lane) {
    f32x4 v[NR][4]; float m[NR];
#pragma unroll
    for (int i = 0; i < NR; ++i) {
        const bool isv = rr[i] >= 16384; const int row = isv ? rr[i] - 16384 : rr[i];
        const f32x4* src = (const f32x4*)((isv ? P.in[I_PV] : P.in[I_PU]) + (size_t)row * DM) + lane;
#pragma unroll
        for (int j = 0; j < 4; ++j) v[i][j] = __builtin_nontemporal_load(src + 64 * j);
    }
#pragma unroll
    for (int i = 0; i < NR; ++i) {
        float mm = 0.f;
#pragma unroll
        for (int j = 0; j < 4; ++j) mm = fmaxf(mm, fmaxf(fmaxf(fabsf(v[i][j].x), fabsf(v[i][j].y)), fmaxf(fabsf(v[i][j].z), fabsf(v[i][j].w))));
        m[i] = wave_max(mm);
    }
#pragma unroll
    for (int i = 0; i < NR; ++i) {
        const bool isv = rr[i] >= 16384; const int row = isv ? rr[i] - 16384 : rr[i];
        const float top = isv ? 416.0f : 127.0f;
        const float sc = (m[i] > 0.f) ? m[i] / top : 1.0f, inv = (m[i] > 0.f) ? top / m[i] : 0.f;
        u32x4 w;
#pragma unroll
        for (int j = 0; j < 4; ++j) {
            if (isv) {
                int t = __builtin_amdgcn_cvt_pk_fp8_f32(v[i][j].x * inv, v[i][j].y * inv, 0, false);
                t = __builtin_amdgcn_cvt_pk_fp8_f32(v[i][j].z * inv, v[i][j].w * inv, t, true);
                w[j] = (u32)t;
            } else {
                const int q0 = (int)rintf(v[i][j].x * inv), q1 = (int)rintf(v[i][j].y * inv), q2 = (int)rintf(v[i][j].z * inv), q3 = (int)rintf(v[i][j].w * inv);
                w[j] = (u32)(q0 & 255) | ((u32)(q1 & 255) << 8) | ((u32)(q2 & 255) << 16) | ((u32)(q3 & 255) << 24);
            }
        }
        *(u32x4*)(P.ws + (isv ? WS_PV : WS_PU) + (size_t)row * 1024 + 16 * lane) = w;
        if (lane == 0) ((float*)(P.ws + (isv ? WS_SV : WS_SU)))[row] = sc;
    }
}
template <int NR> __device__ __forceinline__ void xn_rows(const Params& P, const int (&mm)[NR], int lane) {
    bf16_t* xn = (bf16_t*)(P.ws + WS_BUFA);
    f32x4 v[NR][4]; f32x4 g[4];
#pragma unroll
    for (int j = 0; j < 4; ++j) g[j] = ((const f32x4*)P.in[I_N1G])[64 * j + lane];
#pragma unroll
    for (int i = 0; i < NR; ++i) {
        const int m = mm[i];
        const float* src = (m < SEQ) ? P.in[I_X] + (size_t)m * DM : P.in[I_META] + (size_t)((m < SEQ + NMETA) ? (m - SEQ) : 0) * DM;
#pragma unroll
        for (int j = 0; j < 4; ++j) v[i][j] = ((const f32x4*)src)[64 * j + lane];
    }
#pragma unroll
    for (int i = 0; i < NR; ++i) {
        const int m = mm[i];
        float ss = 0.f;
#pragma unroll
        for (int j = 0; j < 4; ++j) ss += (v[i][j].x * v[i][j].x + v[i][j].y * v[i][j].y) + (v[i][j].z * v[i][j].z + v[i][j].w * v[i][j].w);
        float rinv = 1.0f / sqrtf(wave_sum(ss) * (1.0f / DM) + EPS);
        if (m >= SEQ + NMETA) rinv = 0.f;
        u32x2* o = (u32x2*)(xn + (size_t)m * DM) + lane;
#pragma unroll
        for (int j = 0; j < 4; ++j) { u32x2 w; w.x = pk2(v[i][j].x * rinv * g[j].x, v[i][j].y * rinv * g[j].y); w.y = pk2(v[i][j].z * rinv * g[j].z, v[i][j].w * rinv * g[j].w); o[64 * j] = w; }
    }
}
__device__ __forceinline__ void phase_prologue(const Ctx& C, const Params& P) {
    LAS float* scr = (LAS float*)(C.lds + C.wave * 16384);
    const int gw = C.bid * NWAVES + C.wave, NGW = C.G * NWAVES;
    for (int it = gw; it < 16 * 40; it += NGW) transpose_item(P.in[I_WIN], 1024, 1280, (bf16_t*)(P.ws + WS_WIN_T), scr, it, C.lane);
    for (int m = gw; m < MPAD; m += 4 * NGW) {
        if (m + 3 * NGW < MPAD) { const int mm[4] = {m, m + NGW, m + 2 * NGW, m + 3 * NGW}; xn_rows<4>(P, mm, C.lane); }
        else { for (int q = m; q < MPAD; q += NGW) { const int mm[1] = {q}; xn_rows<1>(P, mm, C.lane); } }
    }
}
__device__ __forceinline__ void deferred_a(const Ctx& C0, const Params& P, int ib, int nib) {
    Ctx C = C0; asm volatile("" : "+v"(C.tid), "+v"(C.lane));
    __syncthreads();
    const int nssm = (nib >= 64) ? 32 : 0;
    if (!nssm || ib < 32) { for (int g = ib; g < 32; g += (nssm ? 32 : nib)) ssm_tables(C, P, g); }
    if (nssm && ib < 32) return;
    __syncthreads();
    LAS float* scr = (LAS float*)(C.lds + C.wave * 16384);
    const int gw = (ib - nssm) * NWAVES + C.wave, NGW = (nib - nssm) * NWAVES;
    for (int it = gw; it < 8 * 16; it += NGW) transpose_item(P.in[I_GLUW], 512, 512, (bf16_t*)(P.ws + WS_GLU_T), scr, it, C.lane);
    for (int r = gw; r < 2 * 16384; r += 4 * NGW) {
        if (r + 3 * NGW < 2 * 16384) { const int rr[4] = {r, r + NGW, r + 2 * NGW, r + 3 * NGW}; quant_rows<4>(P, rr, C.lane); }
        else { for (int q = r; q < 2 * 16384; q += NGW) { const int rr[1] = {q}; quant_rows<1>(P, rr, C.lane); } }
    }
    const size_t gt = (size_t)(ib - nssm) * NTHR + C.tid, NT = (size_t)(nib - nssm) * NTHR;
    for (size_t i = gt; i < 262144 / 8; i += NT) cvt8(P.in[I_SUBK], (bf16_t*)(P.ws + WS_SUBK), i);
}
__device__ __forceinline__ void deferred_b(const Ctx& C0, const Params& P, int ib, int nib) {
    Ctx C = C0; asm volatile("" : "+v"(C.tid), "+v"(C.lane));
    __syncthreads();
    LAS float* scr = (LAS float*)(C.lds + C.wave * 16384);
    const int gw = ib * NWAVES + C.wave, NGW = nib * NWAVES;
    constexpr int I_OUT = 16 * 32, I_Q = 16 * 64;
    for (int it = gw; it < I_OUT + I_Q; it += NGW) {
        if (it < I_OUT) transpose_item(P.in[I_WOUT], 1024, 1024, (bf16_t*)(P.ws + WS_WOUT_T), scr, it, C.lane, P.in[I_AOG], P.in[I_SOG], 512);
        else transpose_item(P.in[I_WQ], 1024, 2048, (bf16_t*)(P.ws + WS_WQ_T), scr, it - I_OUT, C.lane, P.in[I_N2G]);
    }
}

__device__ __forceinline__ bf16x8 u_frag(const bf16_t* proj, int ci, int j, int g, int half) {
    const bool ok = (ci == 0) ? (j >= 16) : (ci < NCH);
    int row = (ci == 0) ? (SEQ + j - 16) : ((ci - 1) * 32 + j);
    row = ok ? row : 0;
    const u32x4 w = *(const u32x4*)(proj + (size_t)row * INW + O_U + g * 16 + half * 8);
    u32x4 z; z.x = ok ? w.x : 0u; z.y = ok ? w.y : 0u; z.z = ok ? w.z : 0u; z.w = ok ? w.w : 0u;
    return __builtin_bit_cast(bf16x8, z);
}

constexpr int F_PITCH = 1040;
__device__ __forceinline__ void phase_sloc(const Ctx& C, const Params& P) {
    const bf16_t* proj = (const bf16_t*)(P.ws + WS_PROJ);
    float* SL = (float*)(P.ws + WS_SLOC);
    const int n = C.lane & 15, kq = C.lane >> 4;
    for (int bu = C.bid; bu < 160; bu += C.G) {
        const int g = bu / 5, qtr = bu % 5, s = qtr * 8 + C.wave, ci = 16 * s + n;
        bf16x8 Bf[16];
#pragma unroll
        for (int ks = 0; ks < 16; ++ks) Bf[ks] = u_frag(proj, (s < 33) ? ci : NCH, 2 * ks + (kq >> 1), g, kq & 1);
        __syncthreads();
        { const u32x4* src = (const u32x4*)((const bf16_t*)(P.ws + WS_F) + (size_t)g * 65536);
          u32x4 t[16];
#pragma unroll
          for (int i = 0; i < 16; ++i) t[i] = src[C.tid + NTHR * i];
#pragma unroll
          for (int i = 0; i < 16; ++i) { const int e = C.tid + NTHR * i; *(LAS u32x4*)(C.lds + (e >> 6) * F_PITCH + (e & 63) * 16) = t[i]; } }
        __syncthreads();
        if (s < 33) {
#pragma unroll 1
            for (int mt = 0; mt < 8; ++mt) {
                f32x4 acc = {0.f, 0.f, 0.f, 0.f};
#pragma unroll
                for (int ks = 0; ks < 16; ++ks) {
                    const bf16x8 A = *(const LAS bf16x8*)(C.lds + (mt * 16 + n) * F_PITCH + (32 * ks + 8 * kq) * 2);
                    acc = MFMA16(A, Bf[ks], acc);
                }
                if (ci < NCH) *(f32x4*)(SL + ((size_t)ci * 32 + g) * 128 + mt * 16 + 4 * kq) = acc;
            }
        }
    }
}

__device__ __forceinline__ void carry_scan_block(const Ctx& C, const Params& P, int bk) {
    const float* SL = (const float*)(P.ws + WS_SLOC);
    float* CA = (float*)(P.ws + WS_CARRY);
    LAS float* Lr = (LAS float*)C.lds;
    LAS float* Li = Lr + 512;
    const int chan = bk * 32 + (C.tid & 31), g = chan >> 6, n = chan & 63, sg = C.tid >> 5;
    const float* abt = (const float*)(P.ws + WS_ABART) + (g * 64 + n) * 2;
    const float ar = abt[0], ai = abt[1];
    float sr = 0.f, si = 0.f;
#pragma unroll 8
    for (int i = 0; i < 32; ++i) {
        const int ci = 32 * sg + i; const size_t o = ((size_t)ci * 32 + g) * 128 + n;
        const float br = SL[o], bi = SL[o + 64];
        const float tr = ar * sr - ai * si + br, ti = ar * si + ai * sr + bi; sr = tr; si = ti;
    }
    Lr[sg * 32 + (C.tid & 31)] = sr; Li[sg * 32 + (C.tid & 31)] = si;
    float pr = ar, pi = ai;
#pragma unroll
    for (int k = 0; k < 5; ++k) { const float tr = pr * pr - pi * pi, ti = 2.f * pr * pi; pr = tr; pi = ti; }
    __syncthreads();
    float cr = 0.f, ci_ = 0.f;
    for (int s2 = 0; s2 < sg; ++s2) { const float lr = Lr[s2 * 32 + (C.tid & 31)], li = Li[s2 * 32 + (C.tid & 31)];
        const float tr = pr * cr - pi * ci_ + lr, ti = pr * ci_ + pi * cr + li; cr = tr; ci_ = ti; }
    sr = cr; si = ci_;
#pragma unroll 8
    for (int i = 0; i < 32; ++i) {
        const int ci = 32 * sg + i; const size_t o = ((size_t)ci * 32 + g) * 128 + n;
        CA[o] = sr; CA[o + 64] = si;
        const float br = SL[o], bi = SL[o + 64];
        const float tr = ar * sr - ai * si + br, ti = ar * si + ai * sr + bi; sr = tr; si = ti;
    }
    if (sg == 15) { const size_t o = ((size_t)512 * 32 + g) * 128 + n; CA[o] = sr; CA[o + 64] = si; }
    __syncthreads();
}

constexpr int E_OFF = 16896, E_PITCH = 272;
__device__ __forceinline__ void phase_ssm_y(const Ctx& C, const Params& P) {
    const bf16_t* proj = (const bf16_t*)(P.ws + WS_PROJ);
    const float* CA = (const float*)(P.ws + WS_CARRY);
    bf16_t* Z = (bf16_t*)(P.ws + WS_Z);
    const int n = C.lane & 15, kq = C.lane >> 4;
    for (int bu = C.bid; bu < 256; bu += C.G) {
        const int g = bu >> 3, cq = bu & 7;
        __syncthreads();
        { const u32x4* src = (const u32x4*)((const bf16_t*)(P.ws + WS_KT) + (size_t)g * 8448); LAS u32x4* dst = (LAS u32x4*)C.lds;
          for (int e = C.tid; e < 1056; e += NTHR) dst[e] = src[e];
          const u32x4* esrc = (const u32x4*)((const bf16_t*)(P.ws + WS_E) + (size_t)g * 65536);
          u32x4 t[16];
#pragma unroll
          for (int i = 0; i < 16; ++i) t[i] = esrc[C.tid + NTHR * i];
#pragma unroll
          for (int i = 0; i < 16; ++i) { const int e = C.tid + NTHR * i; *(LAS u32x4*)(C.lds + E_OFF + (e >> 4) * E_PITCH + (e & 15) * 16) = t[i]; } }
        __syncthreads();
        const int ci = 1 + 64 * cq + 16 * (C.wave >> 1) + n, par = C.wave & 1;
        bf16x8 Uf[16], Cf[4];
#pragma unroll
        for (int ks = 0; ks < 16; ++ks) Uf[ks] = u_frag(proj, ci, 2 * ks + (kq >> 1), g, kq & 1);
#pragma unroll
        for (int k2 = 0; k2 < 4; ++k2) {
            const float* cp = CA + ((size_t)ci * 32 + g) * 128 + 32 * k2 + 8 * kq;
            const f32x4 a = *(const f32x4*)cp, b = *(const f32x4*)(cp + 4);
            u32x4 w; w.x = pk2(a.x, a.y); w.y = pk2(a.z, a.w); w.z = pk2(b.x, b.y); w.w = pk2(b.z, b.w);
            Cf[k2] = __builtin_bit_cast(bf16x8, w);
        }
        const f32x4 dv = *(const f32x4*)(P.in[I_SD] + g * 16 + 4 * kq);
        u32x2 uwp[16];
#pragma unroll
        for (int tt = 0; tt < 16; ++tt) uwp[tt] = *(const u32x2*)(proj + (size_t)((ci - 1) * 32 + 2 * tt + par) * INW + O_U + g * 16 + 4 * kq);
        const LAS unsigned char* eb0 = C.lds + E_OFF + (par * 16 + n) * E_PITCH + 16 * kq;
        const LAS unsigned char* eb1 = eb0 + 8 * 2 * 16 * E_PITCH;
        const LAS unsigned char* kb0 = C.lds + ((par - (kq >> 1) + 1) * 16 + n) * 32 + 16 * (kq & 1);
#pragma unroll
        for (int tt = 0; tt < 16; ++tt) {
            const int t = 2 * tt + par;
            f32x4 acc = {0.f, 0.f, 0.f, 0.f};
#pragma unroll
            for (int k2 = 0; k2 < 4; ++k2) {
                const bf16x8 A = *(const LAS bf16x8*)((tt < 8 ? eb0 + tt * 2 * 16 * E_PITCH : eb1 + (tt - 8) * 2 * 16 * E_PITCH) + 64 * k2);
                acc = MFMA16(A, Cf[k2], acc);
            }
#pragma unroll
            for (int ks = 0; ks < 16; ++ks) {
                if (ks <= tt) {
                    const bf16x8 A = *(const LAS bf16x8*)(kb0 + (tt - ks) * 1024);
                    acc = MFMA16(A, Uf[ks], acc);
                }
            }
            const int row = (ci - 1) * 32 + t, ch = g * 16 + 4 * kq;
            const u32x2 uw = uwp[tt];
            const float y0 = acc.x + dv.x * bflo(uw.x), y1 = acc.y + dv.y * bfhi(uw.x), y2 = acc.z + dv.z * bflo(uw.y), y3 = acc.w + dv.w * bfhi(uw.y);
            const pg8::f32x2 ga = pg8::gelu_pk((pg8::f32x2){y0, y1}), gb = pg8::gelu_pk((pg8::f32x2){y2, y3});
            u32x2 o; o.x = pk2(ga.x, ga.y); o.y = pk2(gb.x, gb.y);
            *(u32x2*)(Z + (size_t)row * 512 + ch) = o;
            __builtin_amdgcn_sched_barrier(0);
        }
    }
}

constexpr int VT_PITCH = 296;
__device__ __forceinline__ void attn_unit(const Ctx& C, const Params& P, int b, int hk) {
    const bf16_t* proj = (const bf16_t*)(P.ws + WS_PROJ);
    bf16_t* AO = (bf16_t*)(P.ws + WS_BUFA);
    float* SSA = (float*)(P.ws + WS_SSA);
    LAS unsigned char* Ks = C.lds;
    LAS bf16_t* Vt = (LAS bf16_t*)(C.lds + 288 * 128);
    __syncthreads();
    for (int e = C.tid; e < 288 * 8; e += NTHR) {
        const int key = e >> 3, ch = e & 7;
        int row = -1;
        if (key < 256) { const int j = (b - 1) * 128 + key; if (j >= 0) row = j; } else if (key < 272) row = SEQ + key - 256;
        u32x4 kw = {0u, 0u, 0u, 0u}, vw = {0u, 0u, 0u, 0u};
        if (row >= 0) { kw = *(const u32x4*)(proj + (size_t)row * INW + O_K + hk * 64 + ch * 8); vw = *(const u32x4*)(proj + (size_t)row * INW + O_V + hk * 64 + ch * 8); }
        float kf[8] = {bflo(kw.x), bfhi(kw.x), bflo(kw.y), bfhi(kw.y), bflo(kw.z), bfhi(kw.z), bflo(kw.w), bfhi(kw.w)};
        float ss = 0.f;
#pragma unroll
        for (int i = 0; i < 8; ++i) ss += kf[i] * kf[i];
        ss += __shfl_xor(ss, 1); ss += __shfl_xor(ss, 2); ss += __shfl_xor(ss, 4);
        const float rinv = 1.0f / sqrtf(ss * (1.0f / 64.0f) + EPS);
        const f32x4 g0 = *(const f32x4*)(P.in[I_KNG] + ch * 8), g1 = *(const f32x4*)(P.in[I_KNG] + ch * 8 + 4);
        u32x4 o; o.x = pk2(kf[0] * rinv * g0.x, kf[1] * rinv * g0.y); o.y = pk2(kf[2] * rinv * g0.z, kf[3] * rinv * g0.w);
        o.z = pk2(kf[4] * rinv * g1.x, kf[5] * rinv * g1.y); o.w = pk2(kf[6] * rinv * g1.z, kf[7] * rinv * g1.w);
        *(LAS u32x4*)(Ks + key * 128 + ((ch ^ (key & 7)) * 16)) = o;
        const unsigned vv[4] = {vw.x, vw.y, vw.z, vw.w};
#pragma unroll
        for (int i = 0; i < 4; ++i) { Vt[(ch * 8 + 2 * i) * VT_PITCH + key] = (bf16_t)(vv[i] & 0xffffu); Vt[(ch * 8 + 2 * i + 1) * VT_PITCH + key] = (bf16_t)(vv[i] >> 16); }
    }
    __syncthreads();
    const int c = C.lane & 31, h = C.lane >> 5;
#pragma unroll 1
    for (int ti = C.wave; ti < 16; ti += NWAVES) {
        const int hql = ti >> 2, wq = ti & 3, hq = hk * 4 + hql;
        const int qi = wq * 32 + c, tok = b * 128 + qi;
        bf16x8 qf[4];
        {
            u32x4 qw[4]; float ss = 0.f;
#pragma unroll
            for (int ks = 0; ks < 4; ++ks) { qw[ks] = *(const u32x4*)(proj + (size_t)tok * INW + hq * 64 + 16 * ks + 8 * h);
                const unsigned w[4] = {qw[ks].x, qw[ks].y, qw[ks].z, qw[ks].w};
#pragma unroll
                for (int i = 0; i < 4; ++i) { const float a = bflo(w[i]), bb = bfhi(w[i]); ss += a * a + bb * bb; } }
            ss += __shfl_xor(ss, 32);
            const float rinv = (1.0f / sqrtf(ss * (1.0f / 64.0f) + EPS)) * (0.125f * LOG2E);
#pragma unroll
            for (int ks = 0; ks < 4; ++ks) {
                const f32x4 g0 = *(const f32x4*)(P.in[I_QNG] + 16 * ks + 8 * h), g1 = *(const f32x4*)(P.in[I_QNG] + 16 * ks + 8 * h + 4);
                u32x4 o; o.x = pk2(bflo(qw[ks].x) * rinv * g0.x, bfhi(qw[ks].x) * rinv * g0.y); o.y = pk2(bflo(qw[ks].y) * rinv * g0.z, bfhi(qw[ks].y) * rinv * g0.w);
                o.z = pk2(bflo(qw[ks].z) * rinv * g1.x, bfhi(qw[ks].z) * rinv * g1.y); o.w = pk2(bflo(qw[ks].w) * rinv * g1.z, bfhi(qw[ks].w) * rinv * g1.w);
                qf[ks] = __builtin_bit_cast(bf16x8, o);
            }
        }
        f32x16 S[6];
#pragma unroll
        for (int rb = 0; rb < 6; ++rb) {
            const int kb = (rb < 5) ? (wq + rb) : 8;
            const int key = kb * 32 + c;
            f32x16 acc = {0.f, 0.f, 0.f, 0.f, 0.f, 0.f, 0.f, 0.f, 0.f, 0.f, 0.f, 0.f, 0.f, 0.f, 0.f, 0.f};
#pragma unroll
            for (int ks = 0; ks < 4; ++ks) {
                const bf16x8 A = *(const LAS bf16x8*)(Ks + key * 128 + (((2 * ks + h) ^ (key & 7)) * 16));
                acc = MFMA32(A, qf[ks], acc);
            }
            S[rb] = acc;
            __builtin_amdgcn_sched_barrier(0);
        }
        const float sl = P.in[I_SINK][hq] * LOG2E;
        float mx = sl;
#pragma unroll
        for (int r = 0; r < 16; ++r) {
            const int kr = (r & 3) + 8 * (r >> 2) + 4 * h;
            const bool gt = kr > c;
            S[0][r] = gt ? S[0][r] : -1e30f;
            S[4][r] = gt ? -1e30f : S[4][r];
            if (r >= 8) S[5][r] = -1e30f;
        }
        if (b == 0) {
#pragma unroll
            for (int rb = 0; rb < 4; ++rb) if (wq + rb < 4) {
#pragma unroll
                for (int r = 0; r < 16; ++r) S[rb][r] = -1e30f;
            }
        }
#pragma unroll
        for (int rb = 0; rb < 6; ++rb)
#pragma unroll
            for (int r = 0; r < 16; ++r) mx = fmaxf(mx, S[rb][r]);
        mx = fmaxf(mx, __shfl_xor(mx, 32));
        float lsum = 0.f;
#pragma unroll
        for (int rb = 0; rb < 6; ++rb)
#pragma unroll
            for (int r = 0; r < 16; ++r) { const float p = __builtin_amdgcn_exp2f(S[rb][r] - mx); S[rb][r] = p; lsum += p; }
        lsum += __shfl_xor(lsum, 32);
        lsum += __builtin_amdgcn_exp2f(sl - mx);
        const float linv = 1.0f / lsum;
        f32x16 O[2];
#pragma unroll
        for (int db = 0; db < 2; ++db) O[db] = (f32x16){0.f, 0.f, 0.f, 0.f, 0.f, 0.f, 0.f, 0.f, 0.f, 0.f, 0.f, 0.f, 0.f, 0.f, 0.f, 0.f};
#pragma unroll
        for (int rb = 0; rb < 6; ++rb) {
            const int kb = (rb < 5) ? (wq + rb) : 8;
#pragma unroll
            for (int s = 0; s < 2; ++s) {
                if (rb == 5 && s == 1) continue;
                u32x4 pw; pw.x = pk2(S[rb][8 * s + 0], S[rb][8 * s + 1]); pw.y = pk2(S[rb][8 * s + 2], S[rb][8 * s + 3]);
                pw.z = pk2(S[rb][8 * s + 4], S[rb][8 * s + 5]); pw.w = pk2(S[rb][8 * s + 6], S[rb][8 * s + 7]);
                const bf16x8 Pf = __builtin_bit_cast(bf16x8, pw);
#pragma unroll
                for (int db = 0; db < 2; ++db) {
                    const LAS bf16_t* vp = Vt + (db * 32 + c) * VT_PITCH + kb * 32 + 16 * s + 4 * h;
                    const u32x2 lo = *(const LAS u32x2*)vp, hi2 = *(const LAS u32x2*)(vp + 8);
                    u32x4 vw; vw.x = lo.x; vw.y = lo.y; vw.z = hi2.x; vw.w = hi2.y;
                    O[db] = MFMA32(__builtin_bit_cast(bf16x8, vw), Pf, O[db]);
                }
                __builtin_amdgcn_sched_barrier(0);
            }
        }
        float ssq = 0.f;
#pragma unroll
        for (int db = 0; db < 2; ++db)
#pragma unroll
            for (int gq = 0; gq < 4; ++gq) {
                const float o0 = O[db][4 * gq] * linv, o1 = O[db][4 * gq + 1] * linv, o2 = O[db][4 * gq + 2] * linv, o3 = O[db][4 * gq + 3] * linv;
                ssq += (o0 * o0 + o1 * o1) + (o2 * o2 + o3 * o3);
                u32x2 o; o.x = pk2(o0, o1); o.y = pk2(o2, o3);
                *(u32x2*)(AO + (size_t)tok * 1024 + hq * 64 + db * 32 + 8 * gq + 4 * h) = o;
            }
        ssq += __shfl_xor(ssq, 32);
        if (h == 0) SSA[(size_t)tok * 8 + hq] = ssq;
    }
}

struct EpiGlu {
    static constexpr bool PERM = true, AFTER_DRAIN = false, HAS_MID = false;
    const bf16_t* Z; bf16_t* O; const float* bias; float* SSS;
    __device__ __forceinline__ void operator()(const pg8::f32x4 (&acc)[2][2][4][2], const pg8::Unit& u, int wr, int wc, int fr, int fq) const {
        const int row0 = u.pm * 256 + wr * 64 + fr, col0 = u.pn * 256 + wc * 32 + 8 * fq;
        f32x4 bb[2][2];
#pragma unroll
        for (int bj = 0; bj < 2; ++bj) { bb[bj][0] = *(const f32x4*)(bias + col0 + bj * 128); bb[bj][1] = *(const f32x4*)(bias + col0 + bj * 128 + 4); }
#pragma unroll
        for (int ai = 0; ai < 2; ++ai) {
            u32x4 zw[4][2];
#pragma unroll
            for (int m = 0; m < 4; ++m)
#pragma unroll
                for (int bj = 0; bj < 2; ++bj) zw[m][bj] = *(const u32x4*)(Z + (size_t)(row0 + ai * 128 + m * 16) * 512 + col0 + bj * 128);
#pragma unroll
            for (int m = 0; m < 4; ++m) {
                const int row = row0 + ai * 128 + m * 16; float ssq = 0.f;
#pragma unroll
                for (int bj = 0; bj < 2; ++bj) {
                    const f32x4 b0 = bb[bj][0], b1 = bb[bj][1]; const u32x4 z4 = zw[m][bj];
                    const pg8::f32x4 v0 = acc[ai][bj][m][0], v1 = acc[ai][bj][m][1];
                    const float zf[8] = {bflo(z4.x), bfhi(z4.x), bflo(z4.y), bfhi(z4.y), bflo(z4.z), bfhi(z4.z), bflo(z4.w), bfhi(z4.w)};
                    const float pre[8] = {v0[0] + b0.x, v0[1] + b0.y, v0[2] + b0.z, v0[3] + b0.w, v1[0] + b1.x, v1[1] + b1.y, v1[2] + b1.z, v1[3] + b1.w};
                    float r[8];
#pragma unroll
                    for (int i = 0; i < 8; ++i) { r[i] = zf[i] * __builtin_amdgcn_rcpf(1.0f + __expf(-pre[i])); ssq += r[i] * r[i]; }
                    u32x4 o; o.x = pk2(r[0], r[1]); o.y = pk2(r[2], r[3]); o.z = pk2(r[4], r[5]); o.w = pk2(r[6], r[7]);
                    *(u32x4*)(O + (size_t)row * 1024 + 512 + col0 + bj * 128) = o;
                }
                ssq += __shfl_xor(ssq, 16); ssq += __shfl_xor(ssq, 32);
                if (fq == 0) SSS[(size_t)row * 8 + u.pn * 4 + wc] = ssq;
            }
        }
    }
};
constexpr int FAC_OFF = 131072;
struct EpiMix {
    static constexpr bool PERM = true, AFTER_DRAIN = false, HAS_MID = true;
    const float* X; bf16_t* HB; float* SSH;
    __device__ __forceinline__ void mid(pg8::f32x4 (&acc)[2][2][4][2], const pg8::Unit& u, int wr, int wc, int fr, int fq, LAS unsigned char* lds) const {
#pragma unroll
        for (int ai = 0; ai < 2; ++ai)
#pragma unroll
            for (int m = 0; m < 4; ++m) {
                const float f = ((const LAS float*)(lds + FAC_OFF))[2 * (ai * 128 + wr * 64 + m * 16 + fr)];
#pragma unroll
                for (int bj = 0; bj < 2; ++bj)
#pragma unroll
                    for (int n = 0; n < 2; ++n) acc[ai][bj][m][n] *= f;
            }
    }
    __device__ __forceinline__ void operator()(const pg8::f32x4 (&acc)[2][2][4][2], const pg8::Unit& u, int wr, int wc, int fr, int fq) const {
        extern __shared__ __attribute__((aligned(16))) unsigned char lds_raw_[];
        const LAS float* fac = (const LAS float*)((LAS unsigned char*)lds_raw_ + FAC_OFF);
        const int col0 = u.pn * 256 + wc * 32 + 8 * fq;
#pragma unroll
        for (int ai = 0; ai < 2; ++ai) {
            f32x4 xv[4][2][2];
#pragma unroll
            for (int m = 0; m < 4; ++m)
#pragma unroll
                for (int bj = 0; bj < 2; ++bj) { const size_t off = (size_t)(u.pm * 256 + ai * 128 + wr * 64 + m * 16 + fr) * 1024 + col0 + bj * 128;
                    xv[m][bj][0] = *(const f32x4*)(X + off); xv[m][bj][1] = *(const f32x4*)(X + off + 4); }
#pragma unroll
            for (int m = 0; m < 4; ++m) {
                const int rl = ai * 128 + wr * 64 + m * 16 + fr, row = u.pm * 256 + rl;
                const float rs = fac[2 * rl + 1]; float ssq = 0.f;
#pragma unroll
                for (int bj = 0; bj < 2; ++bj) {
                    const size_t off = (size_t)row * 1024 + col0 + bj * 128;
                    const f32x4 x0 = xv[m][bj][0], x1 = xv[m][bj][1];
                    const pg8::f32x4 v0 = acc[ai][bj][m][0], v1 = acc[ai][bj][m][1];
                    const float hv[8] = {x0.x + rs * v0[0], x0.y + rs * v0[1], x0.z + rs * v0[2], x0.w + rs * v0[3], x1.x + rs * v1[0], x1.y + rs * v1[1], x1.z + rs * v1[2], x1.w + rs * v1[3]};
#pragma unroll
                    for (int i = 0; i < 8; ++i) ssq += hv[i] * hv[i];
                    u32x4 o; o.x = pk2(hv[0], hv[1]); o.y = pk2(hv[2], hv[3]); o.z = pk2(hv[4], hv[5]); o.w = pk2(hv[6], hv[7]);
                    *(u32x4*)(HB + off) = o;
                }
                ssq += __shfl_xor(ssq, 16); ssq += __shfl_xor(ssq, 32);
                if (fq == 0) SSH[(size_t)row * 16 + u.pn * 4 + wc] = ssq;
            }
        }
    }
};
struct EpiQ {
    static constexpr bool PERM = true, AFTER_DRAIN = false, HAS_MID = false;
    bf16_t* O; int pm0;
    __device__ __forceinline__ void operator()(const pg8::f32x4 (&acc)[2][2][4][2], const pg8::Unit& u, int wr, int wc, int fr, int fq) const {
        extern __shared__ __attribute__((aligned(16))) unsigned char lds_raw_q[];
        const LAS float* rq = (const LAS float*)((LAS unsigned char*)lds_raw_q + FAC_OFF) + ((u.pm == pm0) ? 0 : 256);
        const int col0 = u.pn * 256 + wc * 32 + 8 * fq;
#pragma unroll
        for (int ai = 0; ai < 2; ++ai)
#pragma unroll
            for (int m = 0; m < 4; ++m) {
                const int rl = ai * 128 + wr * 64 + m * 16 + fr, row = u.pm * 256 + rl; const float r = rq[rl];
#pragma unroll
                for (int bj = 0; bj < 2; ++bj) {
                    const pg8::f32x4 v0 = acc[ai][bj][m][0], v1 = acc[ai][bj][m][1];
                    u32x4 o; o.x = pk2(v0[0] * r, v0[1] * r); o.y = pk2(v0[2] * r, v0[3] * r); o.z = pk2(v1[0] * r, v1[1] * r); o.w = pk2(v1[2] * r, v1[3] * r);
                    *(u32x4*)(O + (size_t)row * 2048 + col0 + bj * 128) = o;
                }
            }
    }
};

__device__ __forceinline__ void peer_topk_tile(const Ctx& C, const Params& P, int tok0) {
    const bf16_t* QP = (const bf16_t*)(P.ws + WS_QP);
    const bf16_t* SK = (const bf16_t*)(P.ws + WS_SUBK);
    int* IDX = (int*)(P.ws + WS_IDX); float* GW = (float*)(P.ws + WS_GW);
    LAS u32* lists = (LAS u32*)C.lds;
    const int c = C.lane & 31, h = C.lane >> 5;
    __syncthreads();
#pragma unroll 1
    for (int hs = C.wave; hs < 16; hs += NWAVES) {
        bf16x8 qf[2][8];
#pragma unroll
        for (int tg = 0; tg < 2; ++tg) { const bf16_t* qrow = QP + (size_t)(tok0 + tg * 32 + c) * 2048 + hs * 128;
#pragma unroll
            for (int ks = 0; ks < 8; ++ks) qf[tg][ks] = *(const bf16x8*)(qrow + 16 * ks + 8 * h); }
        u32 best[2][16];
#pragma unroll 1
        for (int kb = 0; kb < 4; ++kb) {
            bf16x8 kf[8];
            const bf16_t* krow = SK + (size_t)(hs * 128 + kb * 32 + c) * 128;
#pragma unroll
            for (int ks = 0; ks < 8; ++ks) kf[ks] = *(const bf16x8*)(krow + 16 * ks + 8 * h);
            f32x16 acc0 = {0.f, 0.f, 0.f, 0.f, 0.f, 0.f, 0.f, 0.f, 0.f, 0.f, 0.f, 0.f, 0.f, 0.f, 0.f, 0.f}, acc1 = acc0;
#pragma unroll
            for (int ks = 0; ks < 8; ++ks) { acc0 = MFMA32(kf[ks], qf[0][ks], acc0); acc1 = MFMA32(kf[ks], qf[1][ks], acc1); }
            u32 g0[16], g1[16];
#pragma unroll
            for (int r = 0; r < 16; ++r) { const u32 kx = (u32)(127 - (kb * 32 + (r & 3) + 8 * (r >> 2) + 4 * h));
                g0[r] = (f2ord(acc0[r]) & ~0x7Fu) | kx; g1[r] = (f2ord(acc1[r]) & ~0x7Fu) | kx; }
            sort16_desc(g0); sort16_desc(g1);
            if (kb == 0) {
#pragma unroll
                for (int i = 0; i < 16; ++i) { best[0][i] = g0[i]; best[1][i] = g1[i]; }
            } else { merge_top16(best[0], g0); merge_top16(best[1], g1); }
        }
#pragma unroll
        for (int tg = 0; tg < 2; ++tg) {
            u32 pb[16];
#pragma unroll
            for (int i = 0; i < 16; ++i) pb[i] = (u32)__shfl_xor((int)best[tg][i], 32);
            merge_top16(best[tg], pb);
            if (h == 0) {
                LAS u32x4* dst = (LAS u32x4*)(lists + (tg * 32 + c) * 260 + hs * 16);
#pragma unroll
                for (int i = 0; i < 4; ++i) { u32x4 w; w.x = best[tg][4 * i]; w.y = best[tg][4 * i + 1]; w.z = best[tg][4 * i + 2]; w.w = best[tg][4 * i + 3]; dst[i] = w; }
            }
        }
    }
    __syncthreads();
    {
        const int tl = C.tid & 63, hd = C.tid >> 6;
        const LAS u32* L1 = lists + tl * 260 + hd * 32; const LAS u32* L2 = L1 + 16;
        float v1[16], v2[16];
#pragma unroll
        for (int i = 0; i < 16; ++i) { v1[i] = ord2f(L1[i] & ~0x7Fu); v2[i] = ord2f(L2[i] & ~0x7Fu); }
        u32 cd[4][16];
        { int cid = 0;
#pragma unroll
          for (int a = 0; a < 16; ++a)
#pragma unroll
              for (int b = 0; b < 16; ++b) if ((a + 1) * (b + 1) <= 16) { cd[cid >> 4][cid & 15] = (f2ord(v1[a] + v2[b]) & ~0x3Fu) | (u32)(63 - cid); ++cid; }
#pragma unroll
          for (int k = 50; k < 64; ++k) cd[k >> 4][k & 15] = 0u; }
        top16_of_64(cd[0], cd[1], cd[2], cd[3]);
        float sc[16]; int ix[16]; float mx = -1e30f;
#pragma unroll
        for (int k = 0; k < 16; ++k) {
            const int cid = 63 - (int)(cd[0][k] & 63u); const int ab = CAND_AB[cid];
            const u32 k1 = L1[ab >> 4], k2 = L2[ab & 15];
            sc[k] = ord2f(k1 & ~0x7Fu) + ord2f(k2 & ~0x7Fu);
            ix[k] = (127 - (int)(k1 & 0x7Fu)) * 128 + (127 - (int)(k2 & 0x7Fu));
            mx = fmaxf(mx, sc[k]);
        }
        float sum = 0.f;
#pragma unroll
        for (int k = 0; k < 16; ++k) { sc[k] = __expf(sc[k] - mx); sum += sc[k]; }
        const float inv = 1.0f / sum;
        int* io = IDX + (size_t)(tok0 + tl) * 128 + hd * 16; float* go = GW + (size_t)(tok0 + tl) * 128 + hd * 16;
#pragma unroll
        for (int k = 0; k < 16; k += 4) {
            *(int4*)(io + k) = make_int4(ix[k], ix[k + 1], ix[k + 2], ix[k + 3]);
            f32x4 gv = {sc[k] * inv, sc[k + 1] * inv, sc[k + 2] * inv, sc[k + 3] * inv}; *(f32x4*)(go + k) = gv;
        }
    }
    __syncthreads();
}

template <int J> __device__ __forceinline__ u32 xor_lane(u32 v, int lane) {
    if constexpr (J == 1) return (u32)__builtin_amdgcn_update_dpp(0, (int)v, 0xB1, 0xf, 0xf, true);
    else if constexpr (J == 2) return (u32)__builtin_amdgcn_update_dpp(0, (int)v, 0x4E, 0xf, 0xf, true);
    else if constexpr (J == 4) { int t = __builtin_amdgcn_update_dpp(0, (int)v, 0x104, 0xf, 0x5, false); return (u32)__builtin_amdgcn_update_dpp(t, (int)v, 0x114, 0xf, 0xA, false); }
    else if constexpr (J == 8) return (u32)__builtin_amdgcn_update_dpp(0, (int)v, 0x128, 0xf, 0xf, true);
    else if constexpr (J == 16) { u32 b = v; asm volatile("" : "+v"(b)); const auto p = __builtin_amdgcn_permlane16_swap(v, b, false, false); return (lane & 16) ? p[0] : p[1]; }
    else { u32 b = v; asm volatile("" : "+v"(b)); const auto p = __builtin_amdgcn_permlane32_swap(v, b, false, false); return (lane & 32) ? p[0] : p[1]; }
}
__device__ __forceinline__ int reduce64(int (&r)[64], int lane) {
#pragma unroll
    for (int e = 0; e < 32; ++e) { const auto p = __builtin_amdgcn_permlane32_swap((u32)r[e], (u32)r[e + 32], false, false); r[e] = (int)p[0] + (int)p[1]; }
#pragma unroll
    for (int e = 0; e < 16; ++e) { const auto p = __builtin_amdgcn_permlane16_swap((u32)r[e], (u32)r[e + 16], false, false); r[e] = (int)p[0] + (int)p[1]; }
    const bool b3 = (lane & 8) != 0, b2 = (lane & 4) != 0, b1 = (lane & 2) != 0, b0 = (lane & 1) != 0;
#pragma unroll
    for (int e = 0; e < 8; ++e) { const int keep = b3 ? r[e + 8] : r[e], send = b3 ? r[e] : r[e + 8]; r[e] = keep + __builtin_amdgcn_update_dpp(0, send, 0x128, 0xf, 0xf, true); }
#pragma unroll
    for (int e = 0; e < 4; ++e) { const int keep = b2 ? r[e + 4] : r[e], send = b2 ? r[e] : r[e + 4];
        int t = __builtin_amdgcn_update_dpp(0, send, 0x104, 0xf, 0x5, false);
        t = __builtin_amdgcn_update_dpp(t, send, 0x114, 0xf, 0xA, false);
        r[e] = keep + t; }
#pragma unroll
    for (int e = 0; e < 2; ++e) { const int keep = b1 ? r[e + 2] : r[e], send = b1 ? r[e] : r[e + 2]; r[e] = keep + __builtin_amdgcn_update_dpp(0, send, 0x4E, 0xf, 0xf, true); }
    { const int keep = b0 ? r[1] : r[0], send = b0 ? r[0] : r[1]; r[0] = keep + __builtin_amdgcn_update_dpp(0, send, 0xB1, 0xf, 0xf, true); }
    return r[0];
}
constexpr int GQ_LDS_PER_WAVE = 8192;
#define GQ_FMA16(A, ce, w) do { _Pragma("unroll") for (int j_ = 0; j_ < 4; ++j_) { \
        const f32x2_t lo_ = __builtin_amdgcn_cvt_pk_f32_fp8((int)(w)[j_], false), hi_ = __builtin_amdgcn_cvt_pk_f32_fp8((int)(w)[j_], true); \
        A[4 * j_ + 0] += (ce) * lo_.x; A[4 * j_ + 1] += (ce) * lo_.y; A[4 * j_ + 2] += (ce) * hi_.x; A[4 * j_ + 3] += (ce) * hi_.y; } } while (0)
__device__ __forceinline__ void peer_gather_quad(const Ctx& C, const Params& P, int tokq) {
    const bf16_t* HN = (const bf16_t*)(P.ws + WS_HB); const float* SSH = (const float*)(P.ws + WS_SSH);
    const unsigned char* PU = P.ws + WS_PU; const unsigned char* PV = P.ws + WS_PV;
    const float* SU = (const float*)(P.ws + WS_SU); const float* SV = (const float*)(P.ws + WS_SV);
    const int* IDX = (const int*)(P.ws + WS_IDX); const float* GW = (const float*)(P.ws + WS_GW);
    const int lane = C.lane;
    LAS unsigned char* qhl = C.lds + C.wave * GQ_LDS_PER_WAVE;
    LAS u32* keyl = (LAS u32*)(qhl + 4096);
    u32 k[8];
#pragma unroll
    for (int s = 0; s < 4; ++s)
#pragma unroll
        for (int hb = 0; hb < 2; ++hb) k[2 * s + hb] = ((u32)IDX[(size_t)(tokq + s) * 128 + 64 * hb + lane] << 9) | (u32)(s << 7) | (u32)(64 * hb + lane);
#pragma unroll
    for (int size = 2; size <= 512; size <<= 1) {
#pragma unroll
        for (int j = size >> 1; j > 0; j >>= 1) {
            u32 nk[8];
#pragma unroll
            for (int r = 0; r < 8; ++r) {
                const int ii = lane + 64 * r;
                const bool asc = (ii & size) == 0, lower = (ii & j) == 0;
                const u32 mine = k[r];
                u32 other;
                if (j >= 64) other = k[r ^ (j >> 6)];
                else if (j == 1) other = xor_lane<1>(mine, lane); else if (j == 2) other = xor_lane<2>(mine, lane); else if (j == 4) other = xor_lane<4>(mine, lane);
                else if (j == 8) other = xor_lane<8>(mine, lane); else if (j == 16) other = xor_lane<16>(mine, lane); else other = xor_lane<32>(mine, lane);
                const u32 mn = mine < other ? mine : other, mx = mine < other ? other : mine;
                nk[r] = (lower == asc) ? mn : mx;
            }
#pragma unroll
            for (int r = 0; r < 8; ++r) k[r] = nk[r];
        }
    }
#pragma unroll
    for (int r = 0; r < 8; ++r) keyl[64 * r + lane] = k[r];
    float shs[4];
    f32x4 g2v[4];
#pragma unroll
    for (int j = 0; j < 4; ++j) g2v[j] = *(const f32x4*)(P.in[I_N2G] + 256 * j + 4 * lane);
#pragma unroll
    for (int s = 0; s < 4; ++s) {
        float hf[16]; float m = 0.f;
        const float ssp = (lane < 16) ? SSH[(size_t)(tokq + s) * 16 + lane] : 0.f;
#pragma unroll
        for (int j = 0; j < 4; ++j) { const u32x2 w = *(const u32x2*)(HN + (size_t)(tokq + s) * DM + 256 * j + 4 * lane);
            hf[4 * j] = bflo(w.x) * g2v[j].x; hf[4 * j + 1] = bfhi(w.x) * g2v[j].y; hf[4 * j + 2] = bflo(w.y) * g2v[j].z; hf[4 * j + 3] = bfhi(w.y) * g2v[j].w; }
        const float rinv_t = 1.0f / sqrtf(wave_sum(ssp) * (1.0f / 1024.0f) + EPS);
#pragma unroll
        for (int d = 0; d < 16; ++d) m = fmaxf(m, fabsf(hf[d]));
#pragma unroll
        for (int o = 1; o < 64; o <<= 1) m = fmaxf(m, __shfl_xor(m, o));
        shs[s] = ((m > 0.f) ? m * (1.0f / 127.0f) : 1.0f) * rinv_t; const float inv = (m > 0.f) ? 127.0f / m : 0.f;
        u32x4 q;
#pragma unroll
        for (int j = 0; j < 4; ++j) {
            const int q0 = (int)rintf(hf[4 * j] * inv), q1 = (int)rintf(hf[4 * j + 1] * inv), q2 = (int)rintf(hf[4 * j + 2] * inv), q3 = (int)rintf(hf[4 * j + 3] * inv);
            q[j] = (u32)(q0 & 255) | ((u32)(q1 & 255) << 8) | ((u32)(q2 & 255) << 16) | ((u32)(q3 & 255) << 24);
        }
        *(LAS u32x4*)(qhl + s * 1024 + 16 * lane) = q;
    }
    LDS_WAIT();
    LAS float* cvl = (LAS float*)(qhl + 6144);
#pragma unroll 1
    for (int c = 0; c < 8; ++c) {
        const u32 kk = keyl[64 * c + lane];
        const int e_l = (int)(kk >> 9), slot_l = (int)((kk >> 7) & 3u), pos_l = (int)(kk & 127u);
        const float g_l = GW[(size_t)(tokq + slot_l) * 128 + pos_l], su_l = SU[e_l], sv_l = SV[e_l];
        int r[64];
#pragma unroll
        for (int p = 0; p < 64; ++p) {
            const u32 kp = (u32)__builtin_amdgcn_readlane((int)kk, p);
            const u32x4 w = *(const u32x4*)(PU + (size_t)(kp >> 9) * 1024 + 16 * lane);
            const u32x4 hq = *(const LAS u32x4*)(qhl + ((kp >> 7) & 3u) * 1024 + 16 * lane);
            int a = __builtin_amdgcn_sdot4((int)w.x, (int)hq.x, 0, false);
            a = __builtin_amdgcn_sdot4((int)w.y, (int)hq.y, a, false);
            a = __builtin_amdgcn_sdot4((int)w.z, (int)hq.z, a, false);
            a = __builtin_amdgcn_sdot4((int)w.w, (int)hq.w, a, false);
            r[p] = a;
        }
        const int isum = reduce64(r, lane);
        const float sh_l = (slot_l == 0) ? shs[0] : (slot_l == 1) ? shs[1] : (slot_l == 2) ? shs[2] : shs[3];
        const float z = (float)isum * su_l * sh_l;
        const float c_l = gelu_erf(z) * g_l * sv_l;
        cvl[64 * c + lane] = c_l;
    }
    LDS_WAIT();
    float acc0[16], acc1[16], acc2[16], acc3[16];
#pragma unroll
    for (int d = 0; d < 16; ++d) { acc0[d] = 0.f; acc1[d] = 0.f; acc2[d] = 0.f; acc3[d] = 0.f; }
#define GQ_ISSUE(W, KP, CE, kreg, creg, p0) do { _Pragma("unroll") for (int q = 0; q < 8; ++q) { \
        KP[q] = (u32)__builtin_amdgcn_readlane((int)(kreg), (p0) + q); CE[q] = __uint_as_float((u32)__builtin_amdgcn_readlane((int)__float_as_uint(creg), (p0) + q)); \
        W[q] = *(const u32x4*)(PV + (size_t)(KP[q] >> 9) * 1024 + 16 * lane); } } while (0)
#define GQ_CONSUME(W, KP, CE) do { _Pragma("unroll") for (int q = 0; q < 8; ++q) { const u32 sl = (KP[q] >> 7) & 3u; \
        if (sl == 0u) GQ_FMA16(acc0, CE[q], W[q]); else if (sl == 1u) GQ_FMA16(acc1, CE[q], W[q]); else if (sl == 2u) GQ_FMA16(acc2, CE[q], W[q]); else GQ_FMA16(acc3, CE[q], W[q]); } } while (0)
    {
        u32x4 wA[8], wB[8]; u32 kA[8], kB[8]; float cA[8], cB[8];
        u32 kk = keyl[lane]; float cc = cvl[lane];
        GQ_ISSUE(wA, kA, cA, kk, cc, 0);
#pragma unroll 1
        for (int c = 0; c < 8; ++c) {
            const int cn = (c < 7) ? c + 1 : 7;
            const u32 kkn = keyl[64 * cn + lane]; const float ccn = cvl[64 * cn + lane];
#pragma unroll 1
            for (int p0 = 0; p0 < 64; p0 += 16) {
                GQ_ISSUE(wB, kB, cB, kk, cc, p0 + 8);
                GQ_CONSUME(wA, kA, cA);
                if (p0 < 48) GQ_ISSUE(wA, kA, cA, kk, cc, p0 + 16); else GQ_ISSUE(wA, kA, cA, kkn, ccn, 0);
                GQ_CONSUME(wB, kB, cB);
            }
            kk = kkn; cc = ccn;
        }
    }
#undef GQ_ISSUE
#undef GQ_CONSUME
    u32x2 hw[4][4];
#pragma unroll
    for (int s = 0; s < 4; ++s)
#pragma unroll
        for (int j = 0; j < 4; ++j) hw[s][j] = *(const u32x2*)(HN + (size_t)(tokq + s) * DM + 256 * j + 4 * lane);
#define GQ_OUT(s, A) do { float* orow = P.out + (size_t)(tokq + (s)) * DM; _Pragma("unroll") for (int j = 0; j < 4; ++j) { f32x4* p = (f32x4*)(orow + 256 * j + 4 * lane); \
        f32x4 v; v.x = bflo(hw[s][j].x) + A[4 * j]; v.y = bfhi(hw[s][j].x) + A[4 * j + 1]; v.z = bflo(hw[s][j].y) + A[4 * j + 2]; v.w = bfhi(hw[s][j].y) + A[4 * j + 3]; *p = v; } } while (0)
    GQ_OUT(0, acc0); GQ_OUT(1, acc1); GQ_OUT(2, acc2); GQ_OUT(3, acc3);
#undef GQ_OUT
}
__device__ __forceinline__ void peer_gather_tile(const Ctx& C, const Params& P, int tok0) {
    __syncthreads();
#pragma unroll 1
    for (int hq = 0; hq < 2; ++hq) peer_gather_quad(C, P, tok0 + 32 * hq + 4 * C.wave);
}

#define GAS __attribute__((address_space(1)))
typedef GAS unsigned gu32;
#define RLX_AGENT __ATOMIC_RELAXED, __HIP_MEMORY_SCOPE_AGENT
#define XB_TMO      128
#define XB_XCNT(j)  (256  + 64 * (j))
#define XB_XSUB(j)  (1280 + 64 * (j))
#define XB_XGEN(j)  (2304 + 64 * (j))
#define XB_TOP      3328
#define XB_TOPGEN   3392
#define XCD_BAR_WORDS 3456
#define XB_SPIN_CAP (1u << 18)

__device__ __forceinline__ unsigned xb_ld(unsigned* p)              { return __hip_atomic_load(p, __ATOMIC_RELAXED, __HIP_MEMORY_SCOPE_AGENT); }
__device__ __forceinline__ unsigned xb_add(unsigned* p, unsigned v) { return __hip_atomic_fetch_add(p, v, __ATOMIC_RELAXED, __HIP_MEMORY_SCOPE_AGENT); }
__device__ __forceinline__ unsigned xb_xcc_id() { return (unsigned)__builtin_amdgcn_s_getreg((3 << 11) | 20) & 0xFu; }
#define XB_SPIN(cond, bar) do { unsigned _sp = 0; while (cond) { __builtin_amdgcn_s_sleep(1); \
    if ((++_sp & 255u) == 0u) { if (xb_ld(&(bar)[XB_TMO])) break; if (_sp > XB_SPIN_CAP) { atomicAdd(&(bar)[XB_TMO], 1u); break; } } } } while (0)

struct XcdBarrier {
    unsigned* bar; unsigned x;
    volatile LAS unsigned* st;
};

__device__ __forceinline__ XcdBarrier xcd_barrier_post(unsigned* bar, volatile LAS unsigned* st) {
    XcdBarrier b; b.bar = bar; b.x = xb_xcc_id(); b.st = st;
    if (threadIdx.x == 0) (void)xb_add(&bar[XB_XCNT(b.x)], 1u);
    return b;
}
__device__ __forceinline__ void xcd_barrier_complete(unsigned* bar, unsigned x, unsigned& nloc, unsigned& nx) {
    const unsigned G = gridDim.x * gridDim.y * gridDim.z;
    unsigned sum, cnt, mine, sp = 0u;
    for (;;) {
        sum = 0u; cnt = 0u; mine = 0u;
#pragma unroll
        for (unsigned j = 0; j < 16; ++j) { const unsigned c = xb_ld(&bar[XB_XCNT(j)]); sum += c; cnt += (c > 0u) ? 1u : 0u; mine = (j == x) ? c : mine; }
        if (sum == G) break;
        __builtin_amdgcn_s_sleep(1);
        if ((++sp & 255u) == 0u) { if (xb_ld(&bar[XB_TMO])) break; if (sp > XB_SPIN_CAP) { atomicAdd(&bar[XB_TMO], 1u); break; } }
    }
    nloc = mine > 0u ? mine : 1u; nx = cnt > 0u ? cnt : 1u;
}

__device__ __forceinline__ void xcd_barrier(const XcdBarrier& b) {
    asm volatile("s_waitcnt vmcnt(0)" ::: "memory");
    __syncthreads();
    if (threadIdx.x == 0) {
        unsigned* bar = b.bar;
        __builtin_amdgcn_s_waitcnt(0);
        unsigned nloc = b.st[0], nx = b.st[1];
        if (nloc == 0u) { xcd_barrier_complete(bar, b.x, nloc, nx); b.st[0] = nloc; b.st[1] = nx; }
        const unsigned old = xb_add(&bar[XB_XSUB(b.x)], 1u);
        const unsigned gen = old / nloc;
        if (old + 1u == (gen + 1u) * nloc) {
            __builtin_amdgcn_fence(__ATOMIC_RELEASE, "agent");
            asm volatile("s_waitcnt vmcnt(0)" ::: "memory");
            const unsigned og = xb_add(&bar[XB_TOP], 1u);
            const unsigned tg = og / nx;
            if (og + 1u == (tg + 1u) * nx) xb_add(&bar[XB_TOPGEN], 1u);
            else XB_SPIN(xb_ld(&bar[XB_TOPGEN]) == tg, bar);
            __builtin_amdgcn_fence(__ATOMIC_ACQUIRE, "agent");
            xb_add(&bar[XB_XGEN(b.x)], 1u);
            asm volatile("s_waitcnt vmcnt(0)" ::: "memory");
        } else {
            XB_SPIN(xb_ld(&bar[XB_XGEN(b.x)]) == gen, bar);
            __builtin_amdgcn_fence(__ATOMIC_ACQUIRE, "agent");
            asm volatile("s_waitcnt vmcnt(0)" ::: "memory");
        }
    }
    __syncthreads();
}

constexpr int NPHASE = 9;
__global__ void __launch_bounds__(NTHR, 2) mk_fwd(Params P) {
    extern __shared__ __attribute__((aligned(16))) unsigned char lds_raw[];
    Ctx C; C.lds = (LAS unsigned char*)lds_raw; C.tid = threadIdx.x; C.lane = C.tid & 63; C.wave = __builtin_amdgcn_readfirstlane(C.tid >> 6); C.G = gridDim.x; C.bid = blockIdx.x;
    unsigned char* ws = P.ws;
    volatile LAS unsigned* MISC = (volatile LAS unsigned*)(C.lds + MISC_OFF);
    if (C.tid < 32) MISC[C.tid] = 0u;
    __syncthreads();
    XcdBarrier bar = xcd_barrier_post((unsigned*)(ws + WS_CTL) + 4096, MISC + 8);
#define SEAM(k) do { if (IN(k) && IN((k) + 1)) xcd_barrier(bar); FRESH(); } while (0)
#define FRESH() do { int t_ = (int)threadIdx.x; asm volatile("" : "+v"(t_)); C.tid = t_; C.lane = t_ & 63; } while (0)
#ifdef ONLY_PHASE
#define IN(k) ((k) == ONLY_PHASE && P.ph_lo <= (k) && (k) < P.ph_hi)
#else
#define IN(k) (P.ph_lo <= (k) && (k) < P.ph_hi)
#endif
    if (IN(0)) phase_prologue(C, P);
    SEAM(0);
    if (IN(1)) {
        pg8::Gemm g{(const bf16_t*)(ws + WS_BUFA), (const bf16_t*)(ws + WS_WIN_T), MPAD, INW, DM}; pg8::StaticOrder S; S.init(MPAD, INW, C.G, C.bid);
        pg8::EpiBf16<0> E{(bf16_t*)(ws + WS_PROJ), INW, nullptr, 0, 0, 1.f};
        pg8::gemm_phase<pg8::EpiBf16<0>, pg8::StaticOrder, true, true>(C.lds, g, S, E);
        { const int ntile = (MPAD / 256) * (INW / 256), nbusy = ntile % C.G;
          if (ntile > C.G && nbusy > 0) { if (C.bid >= nbusy) deferred_a(C, P, C.bid - nbusy, C.G - nbusy); }
          else deferred_a(C, P, C.bid, C.G); }
    }
    SEAM(1);
    if (IN(2)) phase_sloc(C, P);
    SEAM(2);
    if (IN(3)) {
        for (int bk = C.bid; bk < 64; bk += C.G) carry_scan_block(C, P, bk);
        for (int u = C.bid; u < 256; u += C.G) attn_unit(C, P, u >> 1, u & 1);
    }
    SEAM(3);
    if (IN(4)) phase_ssm_y(C, P);
    SEAM(4);
    if (IN(5)) {
        pg8::Gemm g{(const bf16_t*)(ws + WS_Z), (const bf16_t*)(ws + WS_GLU_T), SEQ, 512, 512}; pg8::StaticOrder S; S.init(SEQ, 512, C.G, C.bid);
        EpiGlu E{(const bf16_t*)(ws + WS_Z), (bf16_t*)(ws + WS_BUFA), P.in[I_GLUB], (float*)(ws + WS_SSS)};
        pg8::gemm_phase<EpiGlu, pg8::StaticOrder, true, true>(C.lds, g, S, E);
        { const int ntile = (SEQ / 256) * 2;
          if (ntile < C.G) { if (C.bid >= ntile) deferred_b(C, P, C.bid - ntile, C.G - ntile); }
          else deferred_b(C, P, C.bid, C.G); }
    }
    SEAM(5);
    if (IN(6)) {
        __syncthreads();
        if (C.tid < 256) {
            pg8::StaticOrder S0; S0.init(SEQ, DM, C.G, C.bid); pg8::Unit u0; S0.next(0, u0);
            const int row = u0.pm * 256 + C.tid;
            const f32x4* pa = (const f32x4*)((const float*)(ws + WS_SSA) + (size_t)row * 8); const f32x4* ps = (const f32x4*)((const float*)(ws + WS_SSS) + (size_t)row * 8);
            const f32x4 a0 = pa[0], a1 = pa[1], s0 = ps[0], s1 = ps[1];
            const float ra = 1.0f / sqrtf((((a0.x + a0.y) + (a0.z + a0.w)) + ((a1.x + a1.y) + (a1.z + a1.w))) * (1.0f / 512.0f) + EPS);
            const float rs = 1.0f / sqrtf((((s0.x + s0.y) + (s0.z + s0.w)) + ((s1.x + s1.y) + (s1.z + s1.w))) * (1.0f / 512.0f) + EPS);
            LAS float* fac = (LAS float*)(C.lds + FAC_OFF); fac[2 * C.tid] = ra / rs; fac[2 * C.tid + 1] = rs;
        }
        __syncthreads();
        pg8::Gemm g{(const bf16_t*)(ws + WS_BUFA), (const bf16_t*)(ws + WS_WOUT_T), SEQ, DM, DM}; pg8::StaticOrder S; S.init(SEQ, DM, C.G, C.bid);
        EpiMix E{P.in[I_X], (bf16_t*)(ws + WS_HB), (float*)(ws + WS_SSH)};
        pg8::gemm_phase<EpiMix, pg8::StaticOrder, true, true>(C.lds, g, S, E);
    }
    SEAM(6);
    if (IN(7)) {
        pg8::Gemm g{(const bf16_t*)(ws + WS_HB), (const bf16_t*)(ws + WS_WQ_T), SEQ, 2048, DM}; pg8::StaticOrder S; S.init(SEQ, 2048, C.G, C.bid);
        pg8::Unit ua, ub; const bool ha = S.next(0, ua), hb = S.next(1, ub);
        __syncthreads();
        {
            const int which = C.tid >> 8, rl = C.tid & 255; const bool has = which ? hb : ha; const int pm = which ? ub.pm : ua.pm;
            if (has) {
                const f32x4* sp = (const f32x4*)((const float*)(ws + WS_SSH) + (size_t)(pm * 256 + rl) * 16);
                const f32x4 s0 = sp[0], s1 = sp[1], s2 = sp[2], s3 = sp[3];
                const float ss = ((s0.x + s0.y) + (s0.z + s0.w)) + ((s1.x + s1.y) + (s1.z + s1.w)) + ((s2.x + s2.y) + (s2.z + s2.w)) + ((s3.x + s3.y) + (s3.z + s3.w));
                ((LAS float*)(C.lds + FAC_OFF))[which * 256 + rl] = 1.0f / sqrtf(ss * (1.0f / 1024.0f) + EPS);
            }
        }
        __syncthreads();
        EpiQ E{(bf16_t*)(ws + WS_QP), ua.pm};
        pg8::gemm_phase<EpiQ, pg8::StaticOrder, true, true>(C.lds, g, S, E);
    }
    SEAM(7);
    {
    if (IN(8)) {
        for (int tile = C.bid; tile < SEQ / 64; tile += C.G) {
            peer_topk_tile(C, P, tile * 64);
            peer_gather_tile(C, P, tile * 64);
        }
    }
    }
#undef IN
#undef SEAM
}
}

extern "C" void kernel_launch(void* const* d_in, const int* in_sizes, int n_in, void* d_out, int out_size, void* d_ws, size_t ws_size, hipStream_t stream) {
    static int state = 0, grid = 0;
    if (state == 0) {
        if (n_in != 25 || out_size != mk::SEQ * mk::DM || ws_size < mk::WS_END) { fprintf(stderr, "kernel_launch: unexpected shapes (n_in %d out %d ws %zu)\n", n_in, out_size, ws_size); state = -1; return; }
        if (hipFuncSetAttribute((const void*)mk::mk_fwd, hipFuncAttributeMaxDynamicSharedMemorySize, mk::LDS_BYTES) != hipSuccess) { fprintf(stderr, "kernel_launch: hipFuncSetAttribute failed\n"); state = -1; return; }
        int dev = 0, cus = 0, per_cu = 0;
        if (hipGetDevice(&dev) != hipSuccess || hipDeviceGetAttribute(&cus, hipDeviceAttributeMultiprocessorCount, dev) != hipSuccess) { fprintf(stderr, "kernel_launch: device query failed\n"); state = -1; return; }
        if (hipOccupancyMaxActiveBlocksPerMultiprocessor(&per_cu, (const void*)mk::mk_fwd, mk::NTHR, mk::LDS_BYTES) != hipSuccess || per_cu < 1) { fprintf(stderr, "kernel_launch: occupancy query failed (%d)\n", per_cu); state = -1; return; }
        grid = cus;
        state = 1;
    }
    if (state < 0) return;
    mk::Params p{};
    for (int i = 0; i < 25; ++i) p.in[i] = (const float*)d_in[i];
    p.out = (float*)d_out; p.ws = (unsigned char*)d_ws;
    if (hipMemsetAsync((char*)d_ws + mk::WS_CTL, 0, 65536, stream) != hipSuccess) { fprintf(stderr, "kernel_launch: memset failed\n"); return; }
    p.ph_lo = 0; p.ph_hi = mk::NPHASE;
    void* args[] = {&p};
    hipError_t e = hipLaunchCooperativeKernel((const void*)mk::mk_fwd, dim3(grid), dim3(mk::NTHR), args, mk::LDS_BYTES, stream);
    if (e != hipSuccess) fprintf(stderr, "kernel_launch: cooperative launch failed: %s (grid %d)\n", hipGetErrorString(e), grid);
}
```

```cpp
#include <hip/hip_runtime.h>
#include <cstdio>
#include <cstdint>
#include <cmath>
namespace pg8 {
#define PG8_LAS __attribute__((address_space(3)))
typedef unsigned short bf16_t;
typedef short bf16x8 __attribute__((ext_vector_type(8)));
typedef float f32x4 __attribute__((ext_vector_type(4)));
typedef unsigned u32x4 __attribute__((ext_vector_type(4)));
constexpr int BM = 256, BK = 64, HALF = 128, HTB = HALF * BK * 2  , STAGE_BYTES = 8 * HTB, NXCD = 8, WGM = 8;

__host__ __device__ __forceinline__ int lds_byte(int r, int c) { const int st = (r >> 4) * 2 + (c >> 5), rr = r & 15, cc = c & 31, ob = rr * 64 + cc * 2; return st * 1024 + (ob ^ (((ob >> 9) & 1) << 5)); }
__host__ __device__ __forceinline__ void stage_rc(int b, int& R, int& C) { const int st = b / 1024, sb = b % 1024, swz = sb ^ (((sb >> 9) & 1) << 5); R = (st >> 1) * 16 + swz / 64; C = (st & 1) * 32 + (swz % 64) / 2; }
__host__ __device__ __forceinline__ int perm32(int rho) { const int n = rho >> 4, i = rho & 15; return 8 * (i >> 2) + 4 * n + (i & 3); }

struct Unit { int pm, pn; };
struct Gemm { const bf16_t* A; const bf16_t* Bt; int M, N, K; };

struct StaticOrder {
    int nM, nN, nwg, G, c;
    __host__ __device__ __forceinline__ void init(int M, int N, int G_, int c_) { nM = M / BM; nN = N / BM; nwg = nM * nN; G = G_; c = c_; }
    __host__ __device__ __forceinline__ bool next(int i, Unit& u) const {
        const long L = (long)i * G + c; if (L >= nwg) return false;
        int wgid = (int)L; { const int q = nwg / NXCD, r = nwg % NXCD, xcd = wgid % NXCD, off = wgid / NXCD; wgid = (xcd < r ? xcd * (q + 1) : r * (q + 1) + (xcd - r) * q) + off; }
        const int nig = WGM * nN, gid = wgid / nig, fm = gid * WGM, gsz = (nM - fm) < WGM ? (nM - fm) : WGM;
        u.pm = fm + ((wgid % nig) % gsz); u.pn = (wgid % nig) / gsz; return true;
    }
    __device__ __forceinline__ void a_ready(const Unit&) const {}
    __device__ __forceinline__ void done(const Unit&) const {}
};

__device__ __forceinline__ unsigned cvt_pk_bf16(float lo, float hi) { unsigned r; asm volatile("v_cvt_pk_bf16_f32 %0, %1, %2" : "=v"(r) : "v"(lo), "v"(hi)); return r; }
typedef float f32x2 __attribute__((ext_vector_type(2)));
__device__ __forceinline__ f32x2 gelu_pk(f32x2 v) {
    const f32x2 av = __builtin_elementwise_abs(v), d = av * 0.2316418882f + 1.0f;
    f32x2 t; t.x = __builtin_amdgcn_rcpf(d.x); t.y = __builtin_amdgcn_rcpf(d.y);
    f32x2 q = t * 0.5307027145f + (-0.7265760135f); q = q * t + 0.7107068705f; q = q * t + (-0.142248368f); q = q * t + 0.127414796f; q = q * t;
    const f32x2 s = (v * v) * (-0.72134752044f);
    f32x2 e; e.x = __builtin_amdgcn_exp2f(s.x); e.y = __builtin_amdgcn_exp2f(s.y);
    const f32x2 m = v * (q * e), r = v - m;
    f32x2 o; o.x = v.x < 0.f ? m.x : r.x; o.y = v.y < 0.f ? m.y : r.y; return o;
}

template <int ACT  > struct EpiBf16 {
    static constexpr bool PERM = true, AFTER_DRAIN = false, HAS_MID = false; static_assert(ACT == 0 || ACT == 1, "EpiBf16: ACT is 0 (none) or 1 (gelu_pk)");
    bf16_t* O; int ldc; const float* bias; int split_cols; size_t split_stride; float scale0;
    __device__ __forceinline__ void operator()(const f32x4 (&acc)[2][2][4][2], const Unit& u, int wr, int wc, int fr, int fq) const {
        const int row0 = u.pm * BM + wr * 64 + fr; int colt = u.pn * BM; bf16_t* base = O;
        float sc = 1.f; if (split_cols) { const int t = colt / split_cols; base += (size_t)t * split_stride; colt -= t * split_cols; if (t == 0) sc = scale0; }
        const int col0 = colt + wc * 32 + 8 * fq, bcol0 = u.pn * BM + wc * 32 + 8 * fq;
        f32x4 bv[2][2];
#pragma unroll
        for (int bj = 0; bj < 2; ++bj)
#pragma unroll
            for (int n = 0; n < 2; ++n) bv[bj][n] = bias ? *(const f32x4*)(bias + bcol0 + bj * HALF + 4 * n) : (f32x4){0.f, 0.f, 0.f, 0.f};
#pragma unroll
        for (int ai = 0; ai < 2; ++ai)
#pragma unroll
            for (int m = 0; m < 4; ++m) { bf16_t* rowp = base + (size_t)(row0 + ai * HALF + m * 16) * ldc + col0;
#pragma unroll
                for (int bj = 0; bj < 2; ++bj) { f32x4 v0 = acc[ai][bj][m][0] + bv[bj][0], v1 = acc[ai][bj][m][1] + bv[bj][1];
                    if (ACT == 1) { f32x2 a = gelu_pk((f32x2){v0[0], v0[1]}), b = gelu_pk((f32x2){v0[2], v0[3]}), c = gelu_pk((f32x2){v1[0], v1[1]}), d = gelu_pk((f32x2){v1[2], v1[3]});
                        v0 = (f32x4){a.x, a.y, b.x, b.y}; v1 = (f32x4){c.x, c.y, d.x, d.y}; }
                    v0 = v0 * sc; v1 = v1 * sc; u32x4 w; w.x = cvt_pk_bf16(v0[0], v0[1]); w.y = cvt_pk_bf16(v0[2], v0[3]); w.z = cvt_pk_bf16(v1[0], v1[1]); w.w = cvt_pk_bf16(v1[2], v1[3]);
                    *(u32x4*)(rowp + bj * HALF) = w; } }
    }
};
template <class Epi, class Sched, bool ALIGN_EPI = false, bool SP2 = false>
__device__ __forceinline__ void gemm_phase(PG8_LAS unsigned char* lds, const Gemm g, const Sched& S, const Epi& E) {
    const int tid = threadIdx.x, wid = __builtin_amdgcn_readfirstlane(tid >> 6), lane = tid & 63, wr = wid >> 2, wc = wid & 3, fr = lane & 15, fq = lane >> 4;
    const int K = g.K, nt = K / BK;
    unsigned voffA[2], voffB[2];
#pragma unroll
    for (int i = 0; i < 2; ++i) { int R, C; stage_rc(tid * 16 + i * 8192, R, C); const int Rb = Epi::PERM ? ((R & ~31) + perm32(R & 31)) : R;
        voffA[i] = (unsigned)(R * K + C) * 2u; voffB[i] = (unsigned)(Rb * K + C) * 2u; }
    const size_t kstep = (size_t)(BK * 2);
    const size_t hstep = (size_t)HALF * K * 2;
    const size_t tstep = 2 * hstep;
    const unsigned ldsw = (unsigned)wid * 1024u;
    const int aoff = lds_byte(wr * 64 + fr, fq * 8), boff = lds_byte(wc * 32 + fr, fq * 8);
#define PG8_SA(b, h) (((b) * 2 + (h)) * HTB)
#define PG8_SB(b, h) ((4 + (b) * 2 + (h)) * HTB)
#define PG8_STAGE(bufoff, gbase, voff) do { _Pragma("unroll") for (int _i = 0; _i < 2; ++_i) \
        __builtin_amdgcn_global_load_lds((const unsigned*)((const char*)(gbase) + (voff)[_i]), (PG8_LAS unsigned*)(lds + (bufoff) + ldsw + _i * 8192), 16, 0, 0); } while (0)
#define PG8_LDA(dst, b, h) do { _Pragma("unroll") for (int m = 0; m < 4; ++m) _Pragma("unroll") for (int k = 0; k < 2; ++k) dst[m][k] = *(const PG8_LAS bf16x8*)(lds + PG8_SA(b, h) + aoff + m * 2048 + k * 1024); } while (0)
#define PG8_LDB(dst, b, h) do { _Pragma("unroll") for (int n = 0; n < 2; ++n) _Pragma("unroll") for (int k = 0; k < 2; ++k) dst[n][k] = *(const PG8_LAS bf16x8*)(lds + PG8_SB(b, h) + boff + n * 2048 + k * 1024); } while (0)
#define PG8_MMA(ai, bj, At, Bt) do { __builtin_amdgcn_s_setprio(1); _Pragma("unroll") for (int m = 0; m < 4; ++m) _Pragma("unroll") for (int n = 0; n < 2; ++n) _Pragma("unroll") for (int k = 0; k < 2; ++k) \
        acc[ai][bj][m][n] = __builtin_amdgcn_mfma_f32_16x16x32_bf16(Bt[n][k], At[m][k], acc[ai][bj][m][n], 0, 0, 0); __builtin_amdgcn_s_setprio(0); } while (0)
#define PG8_WAIT_V(n) asm volatile("s_waitcnt vmcnt(" #n ")" ::: "memory")
#define PG8_WAIT_L(n) asm volatile("s_waitcnt lgkmcnt(" #n ")" ::: "memory")
#define PG8_BAR __builtin_amdgcn_s_barrier()
#define PG8_SCHED __builtin_amdgcn_sched_barrier(0)
    Unit cur, nxt; int ui = 0;
    if (!S.next(0, cur)) return;
    f32x4 acc[2][2][4][2];
#pragma unroll
    for (int a = 0; a < 2; ++a)
#pragma unroll
        for (int b = 0; b < 2; ++b)
#pragma unroll
            for (int m = 0; m < 4; ++m)
#pragma unroll
                for (int n = 0; n < 2; ++n) acc[a][b][m][n] = (f32x4){0.f, 0.f, 0.f, 0.f};
    bf16x8 At[4][2], B0[2][2], B1[2][2];
    const char* cA = (const char*)g.A + (size_t)cur.pm * tstep; const char* cB = (const char*)g.Bt + (size_t)cur.pn * tstep;
    S.a_ready(cur);
    if constexpr (SP2) {
        PG8_STAGE(PG8_SB(0, 0), cB, voffB); PG8_STAGE(PG8_SB(0, 1), cB + hstep, voffB); PG8_STAGE(PG8_SA(0, 0), cA, voffA); PG8_STAGE(PG8_SA(0, 1), cA + hstep, voffA);
        if (wr == 1) PG8_BAR;
        PG8_WAIT_V(2); PG8_BAR;
        PG8_STAGE(PG8_SB(1, 0), cB + kstep, voffB); PG8_STAGE(PG8_SA(1, 0), cA + kstep, voffA); PG8_STAGE(PG8_SB(1, 1), cB + hstep + kstep, voffB);
        PG8_WAIT_V(6); PG8_BAR;
    } else {
        PG8_STAGE(PG8_SB(0, 0), cB, voffB); PG8_STAGE(PG8_SA(0, 0), cA, voffA); PG8_STAGE(PG8_SB(0, 1), cB + hstep, voffB); PG8_STAGE(PG8_SA(0, 1), cA + hstep, voffA);
        if (wr == 1) PG8_BAR;
        PG8_WAIT_V(4); PG8_BAR;
        PG8_STAGE(PG8_SB(1, 0), cB + kstep, voffB); PG8_STAGE(PG8_SA(1, 0), cA + kstep, voffA); PG8_STAGE(PG8_SB(1, 1), cB + hstep + kstep, voffB);
        PG8_WAIT_V(6); PG8_BAR;
    }
    for (;;) {
        const bool has_next = S.next(ui + 1, nxt);
        const char* nA = has_next ? (const char*)g.A + (size_t)nxt.pm * tstep : cA; const char* nB = has_next ? (const char*)g.Bt + (size_t)nxt.pn * tstep : cB;
        for (int t = 0; t < nt; t += 2) {
            const bool last = (t == nt - 2);
            if constexpr (Epi::HAS_MID) { if (t == nt / 2) E.mid(acc, cur, wr, wc, fr, fq, lds); }
            const char* a1 = cA + (size_t)(t + 1) * kstep;
            const char* a2 = last ? nA : cA + (size_t)(t + 2) * kstep; const char* b2 = last ? nB : cB + (size_t)(t + 2) * kstep;
            const char* a3 = a2 + kstep; const char* b3 = b2 + kstep;
            if (last && has_next) S.a_ready(nxt);
            if constexpr (SP2) {
            PG8_LDB(B0, 0, 0); PG8_LDB(B1, 0, 1); PG8_SCHED; PG8_LDA(At, 0, 0); PG8_STAGE(PG8_SA(1, 1), a1 + hstep, voffA);
            PG8_WAIT_V(8); PG8_WAIT_L(0); PG8_BAR; PG8_MMA(0, 0, At, B0); PG8_MMA(0, 1, At, B1); PG8_BAR; PG8_SCHED;
            PG8_LDA(At, 0, 1); PG8_STAGE(PG8_SB(0, 0), b2, voffB); PG8_STAGE(PG8_SB(0, 1), b2 + hstep, voffB); PG8_STAGE(PG8_SA(0, 0), a2, voffA);
            PG8_WAIT_V(8); PG8_WAIT_L(0); PG8_BAR; PG8_MMA(1, 0, At, B0); PG8_MMA(1, 1, At, B1); PG8_BAR; PG8_SCHED;
            PG8_LDB(B0, 1, 0); PG8_LDB(B1, 1, 1); PG8_SCHED; PG8_LDA(At, 1, 0); PG8_STAGE(PG8_SA(0, 1), a2 + hstep, voffA);
            PG8_WAIT_V(8); PG8_WAIT_L(0); PG8_BAR; PG8_MMA(0, 0, At, B0); PG8_MMA(0, 1, At, B1); PG8_BAR; PG8_SCHED;
            PG8_LDA(At, 1, 1); PG8_STAGE(PG8_SB(1, 0), b3, voffB); PG8_STAGE(PG8_SB(1, 1), b3 + hstep, voffB); PG8_STAGE(PG8_SA(1, 0), a3, voffA);
            PG8_WAIT_V(8); PG8_WAIT_L(0); PG8_BAR; PG8_MMA(1, 0, At, B0); PG8_MMA(1, 1, At, B1); PG8_BAR; PG8_SCHED;
            } else {
            PG8_LDB(B0, 0, 0); PG8_SCHED; PG8_LDA(At, 0, 0); PG8_STAGE(PG8_SA(1, 1), a1 + hstep, voffA);
            PG8_WAIT_L(8); PG8_BAR; PG8_WAIT_L(0); PG8_MMA(0, 0, At, B0); PG8_BAR; PG8_SCHED;
            PG8_LDB(B1, 0, 1); PG8_STAGE(PG8_SB(0, 0), b2, voffB);
            PG8_BAR; PG8_WAIT_L(0); PG8_MMA(0, 1, At, B1); PG8_BAR;
            PG8_LDA(At, 0, 1); PG8_STAGE(PG8_SA(0, 0), a2, voffA);
            PG8_BAR; PG8_WAIT_L(0); PG8_MMA(1, 0, At, B0); PG8_BAR; PG8_SCHED;
            PG8_STAGE(PG8_SB(0, 1), b2 + hstep, voffB);
            PG8_WAIT_V(6); PG8_BAR; PG8_MMA(1, 1, At, B1); PG8_BAR;
            PG8_LDB(B0, 1, 0); PG8_SCHED; PG8_LDA(At, 1, 0); PG8_STAGE(PG8_SA(0, 1), a2 + hstep, voffA);
            PG8_WAIT_L(8); PG8_BAR; PG8_WAIT_L(0); PG8_MMA(0, 0, At, B0); PG8_BAR; PG8_SCHED;
            PG8_LDB(B1, 1, 1); PG8_STAGE(PG8_SB(1, 0), b3, voffB);
            PG8_BAR; PG8_WAIT_L(0); PG8_MMA(0, 1, At, B1); PG8_BAR;
            PG8_LDA(At, 1, 1); PG8_STAGE(PG8_SA(1, 0), a3, voffA);
            PG8_BAR; PG8_WAIT_L(0); PG8_MMA(1, 0, At, B0); PG8_BAR; PG8_SCHED;
            PG8_STAGE(PG8_SB(1, 1), b3 + hstep, voffB);
            PG8_WAIT_V(6); PG8_BAR; PG8_MMA(1, 1, At, B1); PG8_BAR;
            }
        }
        if constexpr (ALIGN_EPI) { if (wr == 0) PG8_BAR; }
        if constexpr (!Epi::AFTER_DRAIN) { E(acc, cur, wr, wc, fr, fq); S.done(cur); }
        if (!has_next) break;
#pragma unroll
        for (int a = 0; a < 2; ++a)
#pragma unroll
            for (int b = 0; b < 2; ++b)
#pragma unroll
                for (int m = 0; m < 4; ++m)
#pragma unroll
                    for (int n = 0; n < 2; ++n) acc[a][b][m][n] = (f32x4){0.f, 0.f, 0.f, 0.f};
        cur = nxt; cA = nA; cB = nB; ++ui;
        if constexpr (ALIGN_EPI) { if (wr == 1) PG8_BAR; }
    }
    PG8_WAIT_V(0);
    if constexpr (!ALIGN_EPI) { if (wr == 0) PG8_BAR; }
    PG8_BAR;
    if constexpr (Epi::AFTER_DRAIN) { E.fused(acc, cur, wr, wc, fr, fq, lds, wid, lane); S.done(cur); }
#undef PG8_SA
#undef PG8_SB
#undef PG8_STAGE
#undef PG8_LDA
#undef PG8_LDB
#undef PG8_MMA
#undef PG8_WAIT_V
#undef PG8_WAIT_L
#undef PG8_BAR
#undef PG8_SCHED
}
}

namespace mk {
#define LAS __attribute__((address_space(3)))
typedef unsigned short bf16_t;
typedef short bf16x8 __attribute__((ext_vector_type(8)));
typedef float f32x4 __attribute__((ext_vector_type(4)));
typedef float f32x16 __attribute__((ext_vector_type(16)));
typedef unsigned u32x4 __attribute__((ext_vector_type(4)));
typedef unsigned u32x2 __attribute__((ext_vector_type(2)));
typedef __bf16 bf16x2_t __attribute__((ext_vector_type(2)));
typedef float f32x2_t __attribute__((ext_vector_type(2)));
typedef unsigned u32;

constexpr int DM = 1024, SEQ = 16384, NMETA = 16, MPAD = 16640, INW = 1280;
constexpr int O_K = 512, O_V = 640, O_U = 768;
constexpr int NCH = 513;
constexpr float EPS = 1e-6f;
constexpr float LOG2E = 1.4426950408889634f;
constexpr int NWAVES = 8, NTHR = 512;
constexpr int LDS_BYTES = 163840;
constexpr int MISC_OFF = LDS_BYTES - 128;

constexpr size_t MiB = 1u << 20;
constexpr size_t WS_CTL = 0, CTL_BYTES = 1 * MiB;
constexpr size_t WS_WIN_T = 1 * MiB;
constexpr size_t WS_WOUT_T = 4 * MiB;
constexpr size_t WS_WQ_T = 6 * MiB;
constexpr size_t WS_GLU_T = 10 * MiB;
constexpr size_t WS_SUBK = 10 * MiB + 512 * 1024;
constexpr size_t WS_KT = 11 * MiB;
constexpr size_t WS_F = 12 * MiB;
constexpr size_t WS_E = 16 * MiB;
constexpr size_t WS_ABART = 20 * MiB;
constexpr size_t WS_SLOC = 21 * MiB;
constexpr size_t WS_CARRY = 30 * MiB;
constexpr size_t WS_BUFA = 39 * MiB;
constexpr size_t WS_PROJ = 72 * MiB;
constexpr size_t WS_ATTN = 113 * MiB;
constexpr size_t WS_Z = 129 * MiB;
constexpr size_t WS_SSMO = 145 * MiB;
constexpr size_t WS_QP = 72 * MiB;
constexpr size_t WS_IDX = 161 * MiB;
constexpr size_t WS_GW = 169 * MiB;
constexpr size_t WS_PU = 177 * MiB;
constexpr size_t WS_PV = 193 * MiB;
constexpr size_t WS_SU = 209 * MiB;
constexpr size_t WS_SV = 209 * MiB + 65536;
constexpr size_t WS_HB = 210 * MiB;
constexpr size_t WS_SSA = 242 * MiB;
constexpr size_t WS_SSS = 242 * MiB + 512 * 1024;
constexpr size_t WS_SSH = 243 * MiB;
constexpr size_t WS_END = 245 * MiB;

struct Params { const float* in[25]; float* out; unsigned char* ws; int ph_lo, ph_hi; };
enum { I_X = 0, I_META, I_N1G, I_WIN, I_QNG, I_KNG, I_SINK, I_ARE, I_AIM, I_LDT, I_BRE, I_BIM, I_CRE, I_CIM, I_SD, I_GLUW, I_GLUB, I_AOG, I_SOG, I_WOUT, I_N2G, I_WQ, I_SUBK, I_PU, I_PV };

__device__ __forceinline__ unsigned pk2(float lo, float hi) { f32x2_t v = {lo, hi}; return __builtin_bit_cast(unsigned, __builtin_convertvector(v, bf16x2_t)); }
__device__ __forceinline__ float bflo(unsigned w) { return __uint_as_float(w << 16); }
__device__ __forceinline__ float bfhi(unsigned w) { return __uint_as_float(w & 0xffff0000u); }
__device__ __forceinline__ float wave_sum(float v) {
#pragma unroll
    for (int o = 1; o < 64; o <<= 1) v += __shfl_xor(v, o);
    return v;
}
#define LDS_WAIT() asm volatile("s_waitcnt lgkmcnt(0)" ::: "memory")
__device__ __forceinline__ float gelu_erf(float v) { return 0.5f * v * (1.0f + erff(v * 0.70710678118654752f)); }
__device__ __forceinline__ u32 f2ord(float f) { const u32 u = __float_as_uint(f); return (u & 0x80000000u) ? ~u : (u | 0x80000000u); }
__device__ __forceinline__ float ord2f(u32 o) { const u32 u = (o & 0x80000000u) ? (o & 0x7fffffffu) : ~o; return __uint_as_float(u); }
#define MFMA16(a, b, c) __builtin_amdgcn_mfma_f32_16x16x32_bf16((a), (b), (c), 0, 0, 0)
#define MFMA32(a, b, c) __builtin_amdgcn_mfma_f32_32x32x16_bf16((a), (b), (c), 0, 0, 0)

#define CEX(x, i, j) do { const u32 _a = x[i], _b = x[j]; x[i] = _a > _b ? _a : _b; x[j] = _a > _b ? _b : _a; } while (0)
__device__ __forceinline__ void sort16_desc(u32 (&x)[16]) {
#pragma unroll
    for (int k = 2; k <= 16; k <<= 1) {
#pragma unroll
        for (int j = k >> 1; j > 0; j >>= 1) {
#pragma unroll
            for (int i = 0; i < 16; ++i) { const int l = i ^ j; if (l > i) { if ((i & k) == 0) CEX(x, i, l); else CEX(x, l, i); } }
        }
    }
}
__device__ __forceinline__ void bmerge16_desc(u32 (&x)[16]) {
#pragma unroll
    for (int j = 8; j > 0; j >>= 1) {
#pragma unroll
        for (int i = 0; i < 16; ++i) { const int l = i ^ j; if (l > i) CEX(x, i, l); }
    }
}
__device__ __forceinline__ void merge_top16(u32 (&a)[16], const u32 (&b)[16]) {
#pragma unroll
    for (int i = 0; i < 16; ++i) a[i] = a[i] > b[15 - i] ? a[i] : b[15 - i];
    bmerge16_desc(a);
}
__device__ __forceinline__ void top16_of_64(u32 (&g0)[16], u32 (&g1)[16], u32 (&g2)[16], u32 (&g3)[16]) {
    sort16_desc(g0); sort16_desc(g1); sort16_desc(g2); sort16_desc(g3);
    merge_top16(g0, g1); merge_top16(g2, g3); merge_top16(g0, g2);
}
__device__ const unsigned char CAND_AB[64] = {0, 1, 2, 3, 4, 5, 6, 7, 8, 9, 10, 11, 12, 13, 14, 15, 16, 17, 18, 19, 20, 21, 22, 23, 32, 33, 34, 35, 36, 48, 49, 50, 51, 64, 65, 66, 80, 81, 96, 97, 112, 113, 128, 144, 160, 176, 192, 208, 224, 240, 0, 0, 0, 0, 0, 0, 0, 0, 0, 0, 0, 0, 0, 0};

struct Ctx { LAS unsigned char* lds; int tid, lane, wave, G, bid; };

__device__ __forceinline__ void transpose_item(const float* W, int K, int N, bf16_t* WT, LAS float* scr, int item, int lane, const float* ks0 = nullptr, const float* ks1 = nullptr, int ksplit = 0) {
    const int nblk = N / 32, kb = item / nblk, nb = item % nblk, k0 = 64 * kb, n0 = 32 * nb;
#pragma unroll 8
    for (int i = 0; i < 32; ++i) { const int kk = 2 * i + (lane >> 5); float w = W[(size_t)(k0 + kk) * N + n0 + (lane & 31)];
        if (ks0) { const int k = k0 + kk; w *= (ksplit && k >= ksplit) ? ks1[k - ksplit] : ks0[k]; }
        scr[kk * 33 + (lane & 31)] = w; }
    LDS_WAIT();
    const int c = lane & 7;
#pragma unroll
    for (int j = 0; j < 4; ++j) { const int n = (lane >> 3) + 8 * j; const LAS float* s = scr + (8 * c) * 33 + n;
        u32x4 o; o.x = pk2(s[0 * 33], s[1 * 33]); o.y = pk2(s[2 * 33], s[3 * 33]); o.z = pk2(s[4 * 33], s[5 * 33]); o.w = pk2(s[6 * 33], s[7 * 33]);
        *(u32x4*)(WT + (size_t)(n0 + n) * K + k0 + 8 * c) = o; }
    LDS_WAIT();
}

__device__ __forceinline__ void ssm_tables(const Ctx& C, const Params& P, int g) {
    LAS float* pwr = (LAS float*)C.lds;
    LAS float* pwi = pwr + 33 * 64;
    LAS float* bbr = pwi + 33 * 64;
    LAS float* bbi = bbr + 1024;
    LAS float* ccr = bbi + 1024;
    LAS float* cci = ccr + 1024;
    LAS float* cfr = cci + 1024;
    LAS float* cfi = cfr + 64;
    const int tid = C.tid;
    const float dt = expf(P.in[I_LDT][g]);
    for (int e = tid; e < 33 * 64; e += NTHR) {
        const int l = e >> 6, n = e & 63;
        const float lr = P.in[I_ARE][g * 64 + n], li = P.in[I_AIM][g * 64 + n];
        const float x = lr * dt * (float)l, th = li * dt * (float)l, mag = expf(x);
        float s, c; sincosf(th, &s, &c);
        pwr[e] = mag * c; pwi[e] = mag * s;
        if (l == 32) { float* abt = (float*)(P.ws + WS_ABART) + (g * 64 + n) * 2; abt[0] = mag * c; abt[1] = mag * s; }
    }
    if (tid < 64) {
        const int n = tid;
        const float lr = P.in[I_ARE][g * 64 + n], li = P.in[I_AIM][g * 64 + n];
        const float x1 = lr * dt, th1 = li * dt, em1 = expm1f(x1);
        float s1, c1; sincosf(th1, &s1, &c1);
        const float sh = sinf(0.5f * th1);
        const float nr = em1 * c1 - 2.0f * sh * sh, ni = (em1 + 1.0f) * s1;
        const float den = lr * lr + li * li;
        cfr[n] = (nr * lr + ni * li) / den; cfi[n] = (ni * lr - nr * li) / den;
    }
    __syncthreads();
    for (int e = tid; e < 1024; e += NTHR) {
        const int n = e >> 4;
        const float br = P.in[I_BRE][g * 1024 + e], bi = P.in[I_BIM][g * 1024 + e];
        bbr[e] = cfr[n] * br - cfi[n] * bi; bbi[e] = cfr[n] * bi + cfi[n] * br;
        ccr[e] = P.in[I_CRE][g * 1024 + e]; cci[e] = P.in[I_CIM][g * 1024 + e];
    }
    __syncthreads();
    bf16_t* Kt = (bf16_t*)(P.ws + WS_KT) + (size_t)g * 8448;
    {
        const int pq = tid & 255, p = pq >> 4, q = pq & 15, l0 = (tid >> 8) * 16;
        float val[16];
#pragma unroll
        for (int i = 0; i < 16; ++i) val[i] = 0.f;
#pragma unroll
        for (int n0 = 0; n0 < 64; n0 += 16) {
            float cbr[16], cbi[16];
#pragma unroll
            for (int n = 0; n < 16; ++n) { const float cr = ccr[p * 64 + n0 + n], ci = cci[p * 64 + n0 + n], br = bbr[(n0 + n) * 16 + q], bi = bbi[(n0 + n) * 16 + q]; cbr[n] = cr * br - ci * bi; cbi[n] = cr * bi + ci * br; }
#pragma unroll
            for (int i = 0; i < 16; ++i) {
                const int lg = l0 + i;
#pragma unroll
                for (int n = 0; n < 16; n += 4) {
                    const f32x4 ar = *(const LAS f32x4*)(pwr + lg * 64 + n0 + n), ai = *(const LAS f32x4*)(pwi + lg * 64 + n0 + n);
                    val[i] += cbr[n] * ar.x - cbi[n] * ai.x; val[i] += cbr[n + 1] * ar.y - cbi[n + 1] * ai.y; val[i] += cbr[n + 2] * ar.z - cbi[n + 2] * ai.z; val[i] += cbr[n + 3] * ar.w - cbi[n + 3] * ai.w;
                }
            }
        }
#pragma unroll
        for (int i = 0; i < 16; ++i) Kt[(l0 + i + 1) * 256 + pq] = (bf16_t)(pk2(val[i], 0.f) & 0xffffu);
        if (tid < 256) Kt[tid] = 0;
    }
    bf16_t* F = (bf16_t*)(P.ws + WS_F) + (size_t)g * 65536;
    for (int e8 = tid; e8 < 8192; e8 += NTHR) {
        const int n2 = e8 >> 6, k0 = (e8 & 63) * 8, j = k0 >> 4, q0 = k0 & 15, n = n2 & 63, l = 31 - j;
        const float ar = pwr[l * 64 + n], ai = pwi[l * 64 + n];
        float w[8];
#pragma unroll
        for (int i = 0; i < 8; ++i) { const float br = bbr[n * 16 + q0 + i], bi = bbi[n * 16 + q0 + i]; w[i] = (n2 < 64) ? (ar * br - ai * bi) : (ar * bi + ai * br); }
        u32x4 o; o.x = pk2(w[0], w[1]); o.y = pk2(w[2], w[3]); o.z = pk2(w[4], w[5]); o.w = pk2(w[6], w[7]);
        *(u32x4*)(F + (size_t)e8 * 8) = o;
    }
    bf16_t* E = (bf16_t*)(P.ws + WS_E) + (size_t)g * 65536;
    for (int e8 = tid; e8 < 8192; e8 += NTHR) {
        const int row = e8 >> 4, n20 = (e8 & 15) * 8, t = row >> 4, p = row & 15, n0 = n20 & 63;
        float w[8];
#pragma unroll
        for (int i = 0; i < 8; ++i) { const int n = n0 + i; const float pr = pwr[(t + 1) * 64 + n], pi = pwi[(t + 1) * 64 + n], cr = ccr[p * 64 + n], ci = cci[p * 64 + n];
            w[i] = (n20 < 64) ? (cr * pr - ci * pi) : -(cr * pi + ci * pr); }
        u32x4 o; o.x = pk2(w[0], w[1]); o.y = pk2(w[2], w[3]); o.z = pk2(w[4], w[5]); o.w = pk2(w[6], w[7]);
        *(u32x4*)(E + (size_t)e8 * 8) = o;
    }
    __syncthreads();
}

__device__ __forceinline__ void norm_row_to_bf16(const float* src, const float* gam, bf16_t* dst, int lane) {
    const f32x4* xr = (const f32x4*)src + lane; const f32x4* gr = (const f32x4*)gam + lane;
    f32x4 v[4]; float s = 0.f;
#pragma unroll
    for (int j = 0; j < 4; ++j) { v[j] = xr[64 * j]; s += (v[j].x * v[j].x + v[j].y * v[j].y) + (v[j].z * v[j].z + v[j].w * v[j].w); }
    const float rinv = 1.0f / sqrtf(wave_sum(s) * (1.0f / DM) + EPS);
    u32x2* o = (u32x2*)dst + lane;
#pragma unroll
    for (int j = 0; j < 4; ++j) { const f32x4 g = gr[64 * j]; u32x2 w; w.x = pk2(v[j].x * rinv * g.x, v[j].y * rinv * g.y); w.y = pk2(v[j].z * rinv * g.z, v[j].w * rinv * g.w); o[64 * j] = w; }
}

__device__ __forceinline__ void cvt8(const float* src, bf16_t* dst, size_t i) {
    const f32x4 a = ((const f32x4*)src)[2 * i], b = ((const f32x4*)src)[2 * i + 1];
    u32x4 o; o.x = pk2(a.x, a.y); o.y = pk2(a.z, a.w); o.z = pk2(b.x, b.y); o.w = pk2(b.z, b.w);
    ((u32x4*)dst)[i] = o;
}

__device__ __forceinline__ float wave_max(float m) {
    m = fmaxf(m, __builtin_bit_cast(float, __builtin_amdgcn_update_dpp(0, __builtin_bit_cast(int, m), 0xB1, 0xf, 0xf, true)));
    m = fmaxf(m, __builtin_bit_cast(float, __builtin_amdgcn_update_dpp(0, __builtin_bit_cast(int, m), 0x4E, 0xf, 0xf, true)));
    m = fmaxf(m, __builtin_bit_cast(float, __builtin_amdgcn_update_dpp(0, __builtin_bit_cast(int, m), 0x141, 0xf, 0xf, true)));
    m = fmaxf(m, __builtin_bit_cast(float, __builtin_amdgcn_update_dpp(0, __builtin_bit_cast(int, m), 0x140, 0xf, 0xf, true)));
    u32 x = __builtin_bit_cast(u32, m);
    { u32 b = x; asm volatile("" : "+v"(b)); const auto p = __builtin_amdgcn_permlane16_swap(x, b, false, false); x = p[0] > p[1] ? p[0] : p[1]; }
    { u32 b = x; asm volatile("" : "+v"(b)); const auto p = __builtin_amdgcn_permlane32_swap(x, b, false, false); x = p[0] > p[1] ? p[0] : p[1]; }
    m = __builtin_bit_cast(float, x);
    return m;
}
template <int NR> __device__ __forceinline__ void quant_rows(const Params& P, const int (&rr)[NR], int lane) {
    f32x4 v[NR][4]; float m[NR];
#pragma unroll
    for (int i = 0; i < NR; ++i) {
        const bool isv = rr[i] >= 16384; const int row = isv ? rr[i] - 16384 : rr[i];
        const f32x4* src = (const f32x4*)((isv ? P.in[I_PV] : P.in[I_PU]) + (size_t)row * DM) + lane;
#pragma unroll
        for (int j = 0; j < 4; ++j) v[i][j] = __builtin_nontemporal_load(src + 64 * j);
    }
#pragma unroll
    for (int i = 0; i < NR; ++i) {
        float mm = 0.f;
#pragma unroll
        for (int j = 0; j < 4; ++j) mm = fmaxf(mm, fmaxf(fmaxf(fabsf(v[i][j].x), fabsf(v[i][j].y)), fmaxf(fabsf(v[i][j].z), fabsf(v[i][j].w))));
        m[i] = wave_max(mm);
    }
#pragma unroll
    for (int i = 0; i < NR; ++i) {
        const bool isv = rr[i] >= 16384; const int row = isv ? rr[i] - 16384 : rr[i];
        const float top = isv ? 416.0f : 127.0f;
        const float sc = (m[i] > 0.f) ? m[i] / top : 1.0f, inv = (m[i] > 0.f) ? top / m[i] : 0.f;
        u32x4 w;
#pragma unroll
        for (int j = 0; j < 4; ++j) {
            if (isv) {
                int t = __builtin_amdgcn_cvt_pk_fp8_f32(v[i][j].x * inv, v[i][j].y * inv, 0, false);
                t = __builtin_amdgcn_cvt_pk_fp8_f32(v[i][j].z * inv, v[i][j].w * inv, t, true);
                w[j] = (u32)t;
            } else {
                const int q0 = (int)rintf(v[i][j].x * inv), q1 = (int)rintf(v[i][j].y * inv), q2 = (int)rintf(v[i][j].z * inv), q3 = (int)rintf(v[i][j].w * inv);
                w[j] = (u32)(q0 & 255) | ((u32)(q1 & 255) << 8) | ((u32)(q2 & 255) << 16) | ((u32)(q3 & 255) << 24);
            }
        }
        *(u32x4*)(P.ws + (isv ? WS_PV : WS_PU) + (size_t)row * 1024 + 16 * lane) = w;
        if (lane == 0) ((float*)(P.ws + (isv ? WS_SV : WS_SU)))[row] = sc;
    }
}
template <int NR> __device__ __forceinline__ void xn_rows(const Params& P, const int (&mm)[NR], int lane) {
    bf16_t* xn = (bf16_t*)(P.ws + WS_BUFA);
    f32x4 v[NR][4]; f32x4 g[4];
#pragma unroll
    for (int j = 0; j < 4; ++j) g[j] = ((const f32x4*)P.in[I_N1G])[64 * j + lane];
#pragma unroll
    for (int i = 0; i < NR; ++i) {
        const int m = mm[i];
        const float* src = (m < SEQ) ? P.in[I_X] + (size_t)m * DM : P.in[I_META] + (size_t)((m < SEQ + NMETA) ? (m - SEQ) : 0) * DM;
#pragma unroll
        for (int j = 0; j < 4; ++j) v[i][j] = ((const f32x4*)src)[64 * j + lane];
    }
#pragma unroll
    for (int i = 0; i < NR; ++i) {
        const int m = mm[i];
        float ss = 0.f;
#pragma unroll
        for (int j = 0; j < 4; ++j) ss += (v[i][j].x * v[i][j].x + v[i][j].y * v[i][j].y) + (v[i][j].z * v[i][j].z + v[i][j].w * v[i][j].w);
        float rinv = 1.0f / sqrtf(wave_sum(ss) * (1.0f / DM) + EPS);
        if (m >= SEQ + NMETA) rinv = 0.f;
        u32x2* o = (u32x2*)(xn + (size_t)m * DM) + lane;
#pragma unroll
        for (int j = 0; j < 4; ++j) { u32x2 w; w.x = pk2(v[i][j].x * rinv * g[j].x, v[i][j].y * rinv * g[j].y); w.y = pk2(v[i][j].z * rinv * g[j].z, v[i][j].w * rinv * g[j].w); o[64 * j] = w; }
    }
}
__device__ __forceinline__ void phase_prologue(const Ctx& C, const Params& P) {
    LAS float* scr = (LAS float*)(C.lds + C.wave * 16384);
    const int gw = C.bid * NWAVES + C.wave, NGW = C.G * NWAVES;
    for (int it = gw; it < 16 * 40; it += NGW) transpose_item(P.in[I_WIN], 1024, 1280, (bf16_t*)(P.ws + WS_WIN_T), scr, it, C.lane);
    for (int m = gw; m < MPAD; m += 4 * NGW) {
        if (m + 3 * NGW < MPAD) { const int mm[4] = {m, m + NGW, m + 2 * NGW, m + 3 * NGW}; xn_rows<4>(P, mm, C.lane); }
        else { for (int q = m; q < MPAD; q += NGW) { const int mm[1] = {q}; xn_rows<1>(P, mm, C.lane); } }
    }
}
__device__ __forceinline__ void deferred_a(const Ctx& C0, const Params& P, int ib, int nib) {
    Ctx C = C0; asm volatile("" : "+v"(C.tid), "+v"(C.lane));
    __syncthreads();
    const int nssm = (nib >= 64) ? 32 : 0;
    if (!nssm || ib < 32) { for (int g = ib; g < 32; g += (nssm ? 32 : nib)) ssm_tables(C, P, g); }
    if (nssm && ib < 32) return;
    __syncthreads();
    LAS float* scr = (LAS float*)(C.lds + C.wave * 16384);
    const int gw = (ib - nssm) * NWAVES + C.wave, NGW = (nib - nssm) * NWAVES;
    for (int it = gw; it < 8 * 16; it += NGW) transpose_item(P.in[I_GLUW], 512, 512, (bf16_t*)(P.ws + WS_GLU_T), scr, it, C.lane);
    for (int r = gw; r < 2 * 16384; r += 4 * NGW) {
        if (r + 3 * NGW < 2 * 16384) { const int rr[4] = {r, r + NGW, r + 2 * NGW, r + 3 * NGW}; quant_rows<4>(P, rr, C.lane); }
        else { for (int q = r; q < 2 * 16384; q += NGW) { const int rr[1] = {q}; quant_rows<1>(P, rr, C.lane); } }
    }
    const size_t gt = (size_t)(ib - nssm) * NTHR + C.tid, NT = (size_t)(nib - nssm) * NTHR;
    for (size_t i = gt; i < 262144 / 8; i += NT) cvt8(P.in[I_SUBK], (bf16_t*)(P.ws + WS_SUBK), i);
}
__device__ __forceinline__ void deferred_b(const Ctx& C0, const Params& P, int ib, int nib) {
    Ctx C = C0; asm volatile("" : "+v"(C.tid), "+v"(C.lane));
    __syncthreads();
    LAS float* scr = (LAS float*)(C.lds + C.wave * 16384);
    const int gw = ib * NWAVES + C.wave, NGW = nib * NWAVES;
    constexpr int I_OUT = 16 * 32, I_Q = 16 * 64;
    for (int it = gw; it < I_OUT + I_Q; it += NGW) {
        if (it < I_OUT) transpose_item(P.in[I_WOUT], 1024, 1024, (bf16_t*)(P.ws + WS_WOUT_T), scr, it, C.lane, P.in[I_AOG], P.in[I_SOG], 512);
        else transpose_item(P.in[I_WQ], 1024, 2048, (bf16_t*)(P.ws + WS_WQ_T), scr, it - I_OUT, C.lane, P.in[I_N2G]);
    }
}

__device__ __forceinline__ bf16x8 u_frag(const bf16_t* proj, int ci, int j, int g, int half) {
    const bool ok = (ci == 0) ? (j >= 16) : (ci < NCH);
    int row = (ci == 0) ? (SEQ + j - 16) : ((ci - 1) * 32 + j);
    row = ok ? row : 0;
    const u32x4 w = *(const u32x4*)(proj + (size_t)row * INW + O_U + g * 16 + half * 8);
    u32x4 z; z.x = ok ? w.x : 0u; z.y = ok ? w.y : 0u; z.z = ok ? w.z : 0u; z.w = ok ? w.w : 0u;
    return __builtin_bit_cast(bf16x8, z);
}

constexpr int F_PITCH = 1040;
__device__ __forceinline__ void phase_sloc(const Ctx& C, const Params& P) {
    const bf16_t* proj = (const bf16_t*)(P.ws + WS_PROJ);
    float* SL = (float*)(P.ws + WS_SLOC);
    const int n = C.lane & 15, kq = C.lane >> 4;
    for (int bu = C.bid; bu < 160; bu += C.G) {
        const int g = bu / 5, qtr = bu % 5, s = qtr * 8 + C.wave, ci = 16 * s + n;
        bf16x8 Bf[16];
#pragma unroll
        for (int ks = 0; ks < 16; ++ks) Bf[ks] = u_frag(proj, (s < 33) ? ci : NCH, 2 * ks + (kq >> 1), g, kq & 1);
        __syncthreads();
        { const u32x4* src = (const u32x4*)((const bf16_t*)(P.ws + WS_F) + (size_t)g * 65536);
          u32x4 t[16];
#pragma unroll
          for (int i = 0; i < 16; ++i) t[i] = src[C.tid + NTHR * i];
#pragma unroll
          for (int i = 0; i < 16; ++i) { const int e = C.tid + NTHR * i; *(LAS u32x4*)(C.lds + (e >> 6) * F_PITCH + (e & 63) * 16) = t[i]; } }
        __syncthreads();
        if (s < 33) {
#pragma unroll 1
            for (int mt = 0; mt < 8; ++mt) {
                f32x4 acc = {0.f, 0.f, 0.f, 0.f};
#pragma unroll
                for (int ks = 0; ks < 16; ++ks) {
                    const bf16x8 A = *(const LAS bf16x8*)(C.lds + (mt * 16 + n) * F_PITCH + (32 * ks + 8 * kq) * 2);
                    acc = MFMA16(A, Bf[ks], acc);
                }
                if (ci < NCH) *(f32x4*)(SL + ((size_t)ci * 32 + g) * 128 + mt * 16 + 4 * kq) = acc;
            }
        }
    }
}

__device__ __forceinline__ void carry_scan_block(const Ctx& C, const Params& P, int bk) {
    const float* SL = (const float*)(P.ws + WS_SLOC);
    float* CA = (float*)(P.ws + WS_CARRY);
    LAS float* Lr = (LAS float*)C.lds;
    LAS float* Li = Lr + 512;
    const int chan = bk * 32 + (C.tid & 31), g = chan >> 6, n = chan & 63, sg = C.tid >> 5;
    const float* abt = (const float*)(P.ws + WS_ABART) + (g * 64 + n) * 2;
    const float ar = abt[0], ai = abt[1];
    float sr = 0.f, si = 0.f;
#pragma unroll 8
    for (int i = 0; i < 32; ++i) {
        const int ci = 32 * sg + i; const size_t o = ((size_t)ci * 32 + g) * 128 + n;
        const float br = SL[o], bi = SL[o + 64];
        const float tr = ar * sr - ai * si + br, ti = ar * si + ai * sr + bi; sr = tr; si = ti;
    }
    Lr[sg * 32 + (C.tid & 31)] = sr; Li[sg * 32 + (C.tid & 31)] = si;
    float pr = ar, pi = ai;
#pragma unroll
    for (int k = 0; k < 5; ++k) { const float tr = pr * pr - pi * pi, ti = 2.f * pr * pi; pr = tr; pi = ti; }
    __syncthreads();
    float cr = 0.f, ci_ = 0.f;
    for (int s2 = 0; s2 < sg; ++s2) { const float lr = Lr[s2 * 32 + (C.tid & 31)], li = Li[s2 * 32 + (C.tid & 31)];
        const float tr = pr * cr - pi * ci_ + lr, ti = pr * ci_ + pi * cr + li; cr = tr; ci_ = ti; }
    sr = cr; si = ci_;
#pragma unroll 8
    for (int i = 0; i < 32; ++i) {
        const int ci = 32 * sg + i; const size_t o = ((size_t)ci * 32 + g) * 128 + n;
        CA[o] = sr; CA[o + 64] = si;
        const float br = SL[o], bi = SL[o + 64];
        const float tr = ar * sr - ai * si + br, ti = ar * si + ai * sr + bi; sr = tr; si = ti;
    }
    if (sg == 15) { const size_t o = ((size_t)512 * 32 + g) * 128 + n; CA[o] = sr; CA[o + 64] = si; }
    __syncthreads();
}

constexpr int E_OFF = 16896, E_PITCH = 272;
__device__ __forceinline__ void phase_ssm_y(const Ctx& C, const Params& P) {
    const bf16_t* proj = (const bf16_t*)(P.ws + WS_PROJ);
    const float* CA = (const float*)(P.ws + WS_CARRY);
    bf16_t* Z = (bf16_t*)(P.ws + WS_Z);
    const int n = C.lane & 15, kq = C.lane >> 4;
    for (int bu = C.bid; bu < 256; bu += C.G) {
        const int g = bu >> 3, cq = bu & 7;
        __syncthreads();
        { const u32x4* src = (const u32x4*)((const bf16_t*)(P.ws + WS_KT) + (size_t)g * 8448); LAS u32x4* dst = (LAS u32x4*)C.lds;
          for (int e = C.tid; e < 1056; e += NTHR) dst[e] = src[e];
          const u32x4* esrc = (const u32x4*)((const bf16_t*)(P.ws + WS_E) + (size_t)g * 65536);
          u32x4 t[16];
#pragma unroll
          for (int i = 0; i < 16; ++i) t[i] = esrc[C.tid + NTHR * i];
#pragma unroll
          for (int i = 0; i < 16; ++i) { const int e = C.tid + NTHR * i; *(LAS u32x4*)(C.lds + E_OFF + (e >> 4) * E_PITCH + (e & 15) * 16) = t[i]; } }
        __syncthreads();
        const int ci = 1 + 64 * cq + 16 * (C.wave >> 1) + n, par = C.wave & 1;
        bf16x8 Uf[16], Cf[4];
#pragma unroll
        for (int ks = 0; ks < 16; ++ks) Uf[ks] = u_frag(proj, ci, 2 * ks + (kq >> 1), g, kq & 1);
#pragma unroll
        for (int k2 = 0; k2 < 4; ++k2) {
            const float* cp = CA + ((size_t)ci * 32 + g) * 128 + 32 * k2 + 8 * kq;
            const f32x4 a = *(const f32x4*)cp, b = *(const f32x4*)(cp + 4);
            u32x4 w; w.x = pk2(a.x, a.y); w.y = pk2(a.z, a.w); w.z = pk2(b.x, b.y); w.w = pk2(b.z, b.w);
            Cf[k2] = __builtin_bit_cast(bf16x8, w);
        }
        const f32x4 dv = *(const f32x4*)(P.in[I_SD] + g * 16 + 4 * kq);
        u32x2 uwp[16];
#pragma unroll
        for (int tt = 0; tt < 16; ++tt) uwp[tt] = *(const u32x2*)(proj + (size_t)((ci - 1) * 32 + 2 * tt + par) * INW + O_U + g * 16 + 4 * kq);
        const LAS unsigned char* eb0 = C.lds + E_OFF + (par * 16 + n) * E_PITCH + 16 * kq;
        const LAS unsigned char* eb1 = eb0 + 8 * 2 * 16 * E_PITCH;
        const LAS unsigned char* kb0 = C.lds + ((par - (kq >> 1) + 1) * 16 + n) * 32 + 16 * (kq & 1);
#pragma unroll
        for (int tt = 0; tt < 16; ++tt) {
            const int t = 2 * tt + par;
            f32x4 acc = {0.f, 0.f, 0.f, 0.f};
#pragma unroll
            for (int k2 = 0; k2 < 4; ++k2) {
                const bf16x8 A = *(const LAS bf16x8*)((tt < 8 ? eb0 + tt * 2 * 16 * E_PITCH : eb1 + (tt - 8) * 2 * 16 * E_PITCH) + 64 * k2);
                acc = MFMA16(A, Cf[k2], acc);
            }
#pragma unroll
            for (int ks = 0; ks < 16; ++ks) {
                if (ks <= tt) {
                    const bf16x8 A = *(const LAS bf16x8*)(kb0 + (tt - ks) * 1024);
                    acc = MFMA16(A, Uf[ks], acc);
                }
            }
            const int row = (ci - 1) * 32 + t, ch = g * 16 + 4 * kq;
            const u32x2 uw = uwp[tt];
            const float y0 = acc.x + dv.x * bflo(uw.x), y1 = acc.y + dv.y * bfhi(uw.x), y2 = acc.z + dv.z * bflo(uw.y), y3 = acc.w + dv.w * bfhi(uw.y);
            const pg8::f32x2 ga = pg8::gelu_pk((pg8::f32x2){y0, y1}), gb = pg8::gelu_pk((pg8::f32x2){y2, y3});
            u32x2 o; o.x = pk2(ga.x, ga.y); o.y = pk2(gb.x, gb.y);
            *(u32x2*)(Z + (size_t)row * 512 + ch) = o;
            __builtin_amdgcn_sched_barrier(0);
        }
    }
}

constexpr int VT_PITCH = 296;
__device__ __forceinline__ void attn_unit(const Ctx& C, const Params& P, int b, int hk) {
    const bf16_t* proj = (const bf16_t*)(P.ws + WS_PROJ);
    bf16_t* AO = (bf16_t*)(P.ws + WS_BUFA);
    float* SSA = (float*)(P.ws + WS_SSA);
    LAS unsigned char* Ks = C.lds;
    LAS bf16_t* Vt = (LAS bf16_t*)(C.lds + 288 * 128);
    __syncthreads();
    for (int e = C.tid; e < 288 * 8; e += NTHR) {
        const int key = e >> 3, ch = e & 7;
        int row = -1;
        if (key < 256) { const int j = (b - 1) * 128 + key; if (j >= 0) row = j; } else if (key < 272) row = SEQ + key - 256;
        u32x4 kw = {0u, 0u, 0u, 0u}, vw = {0u, 0u, 0u, 0u};
        if (row >= 0) { kw = *(const u32x4*)(proj + (size_t)row * INW + O_K + hk * 64 + ch * 8); vw = *(const u32x4*)(proj + (size_t)row * INW + O_V + hk * 64 + ch * 8); }
        float kf[8] = {bflo(kw.x), bfhi(kw.x), bflo(kw.y), bfhi(kw.y), bflo(kw.z), bfhi(kw.z), bflo(kw.w), bfhi(kw.w)};
        float ss = 0.f;
#pragma unroll
        for (int i = 0; i < 8; ++i) ss += kf[i] * kf[i];
        ss += __shfl_xor(ss, 1); ss += __shfl_xor(ss, 2); ss += __shfl_xor(ss, 4);
        const float rinv = 1.0f / sqrtf(ss * (1.0f / 64.0f) + EPS);
        const f32x4 g0 = *(const f32x4*)(P.in[I_KNG] + ch * 8), g1 = *(const f32x4*)(P.in[I_KNG] + ch * 8 + 4);
        u32x4 o; o.x = pk2(kf[0] * rinv * g0.x, kf[1] * rinv * g0.y); o.y = pk2(kf[2] * rinv * g0.z, kf[3] * rinv * g0.w);
        o.z = pk2(kf[4] * rinv * g1.x, kf[5] * rinv * g1.y); o.w = pk2(kf[6] * rinv * g1.z, kf[7] * rinv * g1.w);
        *(LAS u32x4*)(Ks + key * 128 + ((ch ^ (key & 7)) * 16)) = o;
        const unsigned vv[4] = {vw.x, vw.y, vw.z, vw.w};
#pragma unroll
        for (int i = 0; i < 4; ++i) { Vt[(ch * 8 + 2 * i) * VT_PITCH + key] = (bf16_t)(vv[i] & 0xffffu); Vt[(ch * 8 + 2 * i + 1) * VT_PITCH + key] = (bf16_t)(vv[i] >> 16); }
    }
    __syncthreads();
    const int c = C.lane & 31, h = C.lane >> 5;
#pragma unroll 1
    for (int ti = C.wave; ti < 16; ti += NWAVES) {
        const int hql = ti >> 2, wq = ti & 3, hq = hk * 4 + hql;
        const int qi = wq * 32 + c, tok = b * 128 + qi;
        bf16x8 qf[4];
        {
            u32x4 qw[4]; float ss = 0.f;
#pragma unroll
            for (int ks = 0; ks < 4; ++ks) { qw[ks] = *(const u32x4*)(proj + (size_t)tok * INW + hq * 64 + 16 * ks + 8 * h);
                const unsigned w[4] = {qw[ks].x, qw[ks].y, qw[ks].z, qw[ks].w};
#pragma unroll
                for (int i = 0; i < 4; ++i) { const float a = bflo(w[i]), bb = bfhi(w[i]); ss += a * a + bb * bb; } }
            ss += __shfl_xor(ss, 32);
            const float rinv = (1.0f / sqrtf(ss * (1.0f / 64.0f) + EPS)) * (0.125f * LOG2E);
#pragma unroll
            for (int ks = 0; ks < 4; ++ks) {
                const f32x4 g0 = *(const f32x4*)(P.in[I_QNG] + 16 * ks + 8 * h), g1 = *(const f32x4*)(P.in[I_QNG] + 16 * ks + 8 * h + 4);
                u32x4 o; o.x = pk2(bflo(qw[ks].x) * rinv * g0.x, bfhi(qw[ks].x) * rinv * g0.y); o.y = pk2(bflo(qw[ks].y) * rinv * g0.z, bfhi(qw[ks].y) * rinv * g0.w);
                o.z = pk2(bflo(qw[ks].z) * rinv * g1.x, bfhi(qw[ks].z) * rinv * g1.y); o.w = pk2(bflo(qw[ks].w) * rinv * g1.z, bfhi(qw[ks].w) * rinv * g1.w);
                qf[ks] = __builtin_bit_cast(bf16x8, o);
            }
        }
        f32x16 S[6];
#pragma unroll
        for (int rb = 0; rb < 6; ++rb) {
            const int kb = (rb < 5) ? (wq + rb) : 8;
            const int key = kb * 32 + c;
            f32x16 acc = {0.f, 0.f, 0.f, 0.f, 0.f, 0.f, 0.f, 0.f, 0.f, 0.f, 0.f, 0.f, 0.f, 0.f, 0.f, 0.f};
#pragma unroll
            for (int ks = 0; ks < 4; ++ks) {
                const bf16x8 A = *(const LAS bf16x8*)(Ks + key * 128 + (((2 * ks + h) ^ (key & 7)) * 16));
                acc = MFMA32(A, qf[ks], acc);
            }
            S[rb] = acc;
            __builtin_amdgcn_sched_barrier(0);
        }
        const float sl = P.in[I_SINK][hq] * LOG2E;
        float mx = sl;
#pragma unroll
        for (int r = 0; r < 16; ++r) {
            const int kr = (r & 3) + 8 * (r >> 2) + 4 * h;
            const bool gt = kr > c;
            S[0][r] = gt ? S[0][r] : -1e30f;
            S[4][r] = gt ? -1e30f : S[4][r];
            if (r >= 8) S[5][r] = -1e30f;
        }
        if (b == 0) {
#pragma unroll
            for (int rb = 0; rb < 4; ++rb) if (wq + rb < 4) {
#pragma unroll
                for (int r = 0; r < 16; ++r) S[rb][r] = -1e30f;
            }
        }
#pragma unroll
        for (int rb = 0; rb < 6; ++rb)
#pragma unroll
            for (int r = 0; r < 16; ++r) mx = fmaxf(mx, S[rb][r]);
        mx = fmaxf(mx, __shfl_xor(mx, 32));
        float lsum = 0.f;
#pragma unroll
        for (int rb = 0; rb < 6; ++rb)
#pragma unroll
            for (int r = 0; r < 16; ++r) { const float p = __builtin_amdgcn_exp2f(S[rb][r] - mx); S[rb][r] = p; lsum += p; }
        lsum += __shfl_xor(lsum, 32);
        lsum += __builtin_amdgcn_exp2f(sl - mx);
        const float linv = 1.0f / lsum;
        f32x16 O[2];
#pragma unroll
        for (int db = 0; db < 2; ++db) O[db] = (f32x16){0.f, 0.f, 0.f, 0.f, 0.f, 0.f, 0.f, 0.f, 0.f, 0.f, 0.f, 0.f, 0.f, 0.f, 0.f, 0.f};
#pragma unroll
        for (int rb = 0; rb < 6; ++rb) {
            const int kb = (rb < 5) ? (wq + rb) : 8;
#pragma unroll
            for (int s = 0; s < 2; ++s) {
                if (rb == 5 && s == 1) continue;
                u32x4 pw; pw.x = pk2(S[rb][8 * s + 0], S[rb][8 * s + 1]); pw.y = pk2(S[rb][8 * s + 2], S[rb][8 * s + 3]);
                pw.z = pk2(S[rb][8 * s + 4], S[rb][8 * s + 5]); pw.w = pk2(S[rb][8 * s + 6], S[rb][8 * s + 7]);
                const bf16x8 Pf = __builtin_bit_cast(bf16x8, pw);
#pragma unroll
                for (int db = 0; db < 2; ++db) {
                    const LAS bf16_t* vp = Vt + (db * 32 + c) * VT_PITCH + kb * 32 + 16 * s + 4 * h;
                    const u32x2 lo = *(const LAS u32x2*)vp, hi2 = *(const LAS u32x2*)(vp + 8);
                    u32x4 vw; vw.x = lo.x; vw.y = lo.y; vw.z = hi2.x; vw.w = hi2.y;
                    O[db] = MFMA32(__builtin_bit_cast(bf16x8, vw), Pf, O[db]);
                }
                __builtin_amdgcn_sched_barrier(0);
            }
        }
        float ssq = 0.f;
#pragma unroll
        for (int db = 0; db < 2; ++db)
#pragma unroll
            for (int gq = 0; gq < 4; ++gq) {
                const float o0 = O[db][4 * gq] * linv, o1 = O[db][4 * gq + 1] * linv, o2 = O[db][4 * gq + 2] * linv, o3 = O[db][4 * gq + 3] * linv;
                ssq += (o0 * o0 + o1 * o1) + (o2 * o2 + o3 * o3);
                u32x2 o; o.x = pk2(o0, o1); o.y = pk2(o2, o3);
                *(u32x2*)(AO + (size_t)tok * 1024 + hq * 64 + db * 32 + 8 * gq + 4 * h) = o;
            }
        ssq += __shfl_xor(ssq, 32);
        if (h == 0) SSA[(size_t)tok * 8 + hq] = ssq;
    }
}

struct EpiGlu {
    static constexpr bool PERM = true, AFTER_DRAIN = false, HAS_MID = false;
    const bf16_t* Z; bf16_t* O; const float* bias; float* SSS;
    __device__ __forceinline__ void operator()(const pg8::f32x4 (&acc)[2][2][4][2], const pg8::Unit& u, int wr, int wc, int fr, int fq) const {
        const int row0 = u.pm * 256 + wr * 64 + fr, col0 = u.pn * 256 + wc * 32 + 8 * fq;
        f32x4 bb[2][2];
#pragma unroll
        for (int bj = 0; bj < 2; ++bj) { bb[bj][0] = *(const f32x4*)(bias + col0 + bj * 128); bb[bj][1] = *(const f32x4*)(bias + col0 + bj * 128 + 4); }
#pragma unroll
        for (int ai = 0; ai < 2; ++ai) {
            u32x4 zw[4][2];
#pragma unroll
            for (int m = 0; m < 4; ++m)
#pragma unroll
                for (int bj = 0; bj < 2; ++bj) zw[m][bj] = *(const u32x4*)(Z + (size_t)(row0 + ai * 128 + m * 16) * 512 + col0 + bj * 128);
#pragma unroll
            for (int m = 0; m < 4; ++m) {
                const int row = row0 + ai * 128 + m * 16; float ssq = 0.f;
#pragma unroll
                for (int bj = 0; bj < 2; ++bj) {
                    const f32x4 b0 = bb[bj][0], b1 = bb[bj][1]; const u32x4 z4 = zw[m][bj];
                    const pg8::f32x4 v0 = acc[ai][bj][m][0], v1 = acc[ai][bj][m][1];
                    const float zf[8] = {bflo(z4.x), bfhi(z4.x), bflo(z4.y), bfhi(z4.y), bflo(z4.z), bfhi(z4.z), bflo(z4.w), bfhi(z4.w)};
                    const float pre[8] = {v0[0] + b0.x, v0[1] + b0.y, v0[2] + b0.z, v0[3] + b0.w, v1[0] + b1.x, v1[1] + b1.y, v1[2] + b1.z, v1[3] + b1.w};
                    float r[8];
#pragma unroll
                    for (int i = 0; i < 8; ++i) { r[i] = zf[i] * __builtin_amdgcn_rcpf(1.0f + __expf(-pre[i])); ssq += r[i] * r[i]; }
                    u32x4 o; o.x = pk2(r[0], r[1]); o.y = pk2(r[2], r[3]); o.z = pk2(r[4], r[5]); o.w = pk2(r[6], r[7]);
                    *(u32x4*)(O + (size_t)row * 1024 + 512 + col0 + bj * 128) = o;
                }
                ssq += __shfl_xor(ssq, 16); ssq += __shfl_xor(ssq, 32);
                if (fq == 0) SSS[(size_t)row * 8 + u.pn * 4 + wc] = ssq;
            }
        }
    }
};
constexpr int FAC_OFF = 131072;
struct EpiMix {
    static constexpr bool PERM = true, AFTER_DRAIN = false, HAS_MID = true;
    const float* X; bf16_t* HB; float* SSH;
    __device__ __forceinline__ void mid(pg8::f32x4 (&acc)[2][2][4][2], const pg8::Unit& u, int wr, int wc, int fr, int fq, LAS unsigned char* lds) const {
#pragma unroll
        for (int ai = 0; ai < 2; ++ai)
#pragma unroll
            for (int m = 0; m < 4; ++m) {
                const float f = ((const LAS float*)(lds + FAC_OFF))[2 * (ai * 128 + wr * 64 + m * 16 + fr)];
#pragma unroll
                for (int bj = 0; bj < 2; ++bj)
#pragma unroll
                    for (int n = 0; n < 2; ++n) acc[ai][bj][m][n] *= f;
            }
    }
    __device__ __forceinline__ void operator()(const pg8::f32x4 (&acc)[2][2][4][2], const pg8::Unit& u, int wr, int wc, int fr, int fq) const {
        extern __shared__ __attribute__((aligned(16))) unsigned char lds_raw_[];
        const LAS float* fac = (const LAS float*)((LAS unsigned char*)lds_raw_ + FAC_OFF);
        const int col0 = u.pn * 256 + wc * 32 + 8 * fq;
#pragma unroll
        for (int ai = 0; ai < 2; ++ai) {
            f32x4 xv[4][2][2];
#pragma unroll
            for (int m = 0; m < 4; ++m)
#pragma unroll
                for (int bj = 0; bj < 2; ++bj) { const size_t off = (size_t)(u.pm * 256 + ai * 128 + wr * 64 + m * 16 + fr) * 1024 + col0 + bj * 128;
                    xv[m][bj][0] = *(const f32x4*)(X + off); xv[m][bj][1] = *(const f32x4*)(X + off + 4); }
#pragma unroll
            for (int m = 0; m < 4; ++m) {
                const int rl = ai * 128 + wr * 64 + m * 16 + fr, row = u.pm * 256 + rl;
                const float rs = fac[2 * rl + 1]; float ssq = 0.f;
#pragma unroll
                for (int bj = 0; bj < 2; ++bj) {
                    const size_t off = (size_t)row * 1024 + col0 + bj * 128;
                    const f32x4 x0 = xv[m][bj][0], x1 = xv[m][bj][1];
                    const pg8::f32x4 v0 = acc[ai][bj][m][0], v1 = acc[ai][bj][m][1];
                    const float hv[8] = {x0.x + rs * v0[0], x0.y + rs * v0[1], x0.z + rs * v0[2], x0.w + rs * v0[3], x1.x + rs * v1[0], x1.y + rs * v1[1], x1.z + rs * v1[2], x1.w + rs * v1[3]};
#pragma unroll
                    for (int i = 0; i < 8; ++i) ssq += hv[i] * hv[i];
                    u32x4 o; o.x = pk2(hv[0], hv[1]); o.y = pk2(hv[2], hv[3]); o.z = pk2(hv[4], hv[5]); o.w = pk2(hv[6], hv[7]);
                    *(u32x4*)(HB + off) = o;
                }
                ssq += __shfl_xor(ssq, 16); ssq += __shfl_xor(ssq, 32);
                if (fq == 0) SSH[(size_t)row * 16 + u.pn * 4 + wc] = ssq;
            }
        }
    }
};
struct EpiQ {
    static constexpr bool PERM = true, AFTER_DRAIN = false, HAS_MID = false;
    bf16_t* O; int pm0;
    __device__ __forceinline__ void operator()(const pg8::f32x4 (&acc)[2][2][4][2], const pg8::Unit& u, int wr, int wc, int fr, int fq) const {
        extern __shared__ __attribute__((aligned(16))) unsigned char lds_raw_q[];
        const LAS float* rq = (const LAS float*)((LAS unsigned char*)lds_raw_q + FAC_OFF) + ((u.pm == pm0) ? 0 : 256);
        const int col0 = u.pn * 256 + wc * 32 + 8 * fq;
#pragma unroll
        for (int ai = 0; ai < 2; ++ai)
#pragma unroll
            for (int m = 0; m < 4; ++m) {
                const int rl = ai * 128 + wr * 64 + m * 16 + fr, row = u.pm * 256 + rl; const float r = rq[rl];
#pragma unroll
                for (int bj = 0; bj < 2; ++bj) {
                    const pg8::f32x4 v0 = acc[ai][bj][m][0], v1 = acc[ai][bj][m][1];
                    u32x4 o; o.x = pk2(v0[0] * r, v0[1] * r); o.y = pk2(v0[2] * r, v0[3] * r); o.z = pk2(v1[0] * r, v1[1] * r); o.w = pk2(v1[2] * r, v1[3] * r);
                    *(u32x4*)(O + (size_t)row * 2048 + col0 + bj * 128) = o;
                }
            }
    }
};

constexpr int IG_OFF = 67584;
__device__ __forceinline__ void peer_topk_tile(const Ctx& C, const Params& P, int tok0) {
    const bf16_t* QP = (const bf16_t*)(P.ws + WS_QP);
    const bf16_t* SK = (const bf16_t*)(P.ws + WS_SUBK);
    LAS int* IDXL = (LAS int*)(C.lds + IG_OFF); LAS float* GWL = (LAS float*)(C.lds + IG_OFF + 32768);
    LAS u32* lists = (LAS u32*)C.lds;
    const int c = C.lane & 31, h = C.lane >> 5;
    __syncthreads();
#pragma unroll 1
    for (int hs = C.wave; hs < 16; hs += NWAVES) {
        bf16x8 qf[2][8];
#pragma unroll
        for (int tg = 0; tg < 2; ++tg) { const bf16_t* qrow = QP + (size_t)(tok0 + tg * 32 + c) * 2048 + hs * 128;
#pragma unroll
            for (int ks = 0; ks < 8; ++ks) qf[tg][ks] = *(const bf16x8*)(qrow + 16 * ks + 8 * h); }
        u32 best[2][16];
#pragma unroll 1
        for (int kb = 0; kb < 4; ++kb) {
            bf16x8 kf[8];
            const bf16_t* krow = SK + (size_t)(hs * 128 + kb * 32 + c) * 128;
#pragma unroll
            for (int ks = 0; ks < 8; ++ks) kf[ks] = *(const bf16x8*)(krow + 16 * ks + 8 * h);
            f32x16 acc0 = {0.f, 0.f, 0.f, 0.f, 0.f, 0.f, 0.f, 0.f, 0.f, 0.f, 0.f, 0.f, 0.f, 0.f, 0.f, 0.f}, acc1 = acc0;
#pragma unroll
            for (int ks = 0; ks < 8; ++ks) { acc0 = MFMA32(kf[ks], qf[0][ks], acc0); acc1 = MFMA32(kf[ks], qf[1][ks], acc1); }
            u32 g0[16], g1[16];
#pragma unroll
            for (int r = 0; r < 16; ++r) { const u32 kx = (u32)(127 - (kb * 32 + (r & 3) + 8 * (r >> 2) + 4 * h));
                g0[r] = (f2ord(acc0[r]) & ~0x7Fu) | kx; g1[r] = (f2ord(acc1[r]) & ~0x7Fu) | kx; }
            sort16_desc(g0); sort16_desc(g1);
            if (kb == 0) {
#pragma unroll
                for (int i = 0; i < 16; ++i) { best[0][i] = g0[i]; best[1][i] = g1[i]; }
            } else { merge_top16(best[0], g0); merge_top16(best[1], g1); }
        }
#pragma unroll
        for (int tg = 0; tg < 2; ++tg) {
            u32 pb[16];
#pragma unroll
            for (int i = 0; i < 16; ++i) pb[i] = (u32)__shfl_xor((int)best[tg][i], 32);
            merge_top16(best[tg], pb);
            if (h == 0) {
                LAS u32x4* dst = (LAS u32x4*)(lists + (tg * 32 + c) * 260 + hs * 16);
#pragma unroll
                for (int i = 0; i < 4; ++i) { u32x4 w; w.x = best[tg][4 * i]; w.y = best[tg][4 * i + 1]; w.z = best[tg][4 * i + 2]; w.w = best[tg][4 * i + 3]; dst[i] = w; }
            }
        }
    }
    __syncthreads();
    {
        const int tl = C.tid & 63, hd = C.tid >> 6;
        const LAS u32* L1 = lists + tl * 260 + hd * 32; const LAS u32* L2 = L1 + 16;
        float v1[16], v2[16];
#pragma unroll
        for (int i = 0; i < 16; ++i) { v1[i] = ord2f(L1[i] & ~0x7Fu); v2[i] = ord2f(L2[i] & ~0x7Fu); }
        u32 cd[4][16];
        { int cid = 0;
#pragma unroll
          for (int a = 0; a < 16; ++a)
#pragma unroll
              for (int b = 0; b < 16; ++b) if ((a + 1) * (b + 1) <= 16) { cd[cid >> 4][cid & 15] = (f2ord(v1[a] + v2[b]) & ~0x3Fu) | (u32)(63 - cid); ++cid; }
#pragma unroll
          for (int k = 50; k < 64; ++k) cd[k >> 4][k & 15] = 0u; }
        top16_of_64(cd[0], cd[1], cd[2], cd[3]);
        float sc[16]; int ix[16]; float mx = -1e30f;
#pragma unroll
        for (int k = 0; k < 16; ++k) {
            const int cid = 63 - (int)(cd[0][k] & 63u); const int ab = CAND_AB[cid];
            const u32 k1 = L1[ab >> 4], k2 = L2[ab & 15];
            sc[k] = ord2f(k1 & ~0x7Fu) + ord2f(k2 & ~0x7Fu);
            ix[k] = (127 - (int)(k1 & 0x7Fu)) * 128 + (127 - (int)(k2 & 0x7Fu));
            mx = fmaxf(mx, sc[k]);
        }
        float sum = 0.f;
#pragma unroll
        for (int k = 0; k < 16; ++k) { sc[k] = __expf(sc[k] - mx); sum += sc[k]; }
        const float inv = 1.0f / sum;
        LAS int* io = IDXL + tl * 128 + hd * 16; LAS float* go = GWL + tl * 128 + hd * 16;
#pragma unroll
        for (int k = 0; k < 16; ++k) { io[k] = ix[k]; go[k] = sc[k] * inv; }
    }
    __syncthreads();
}

template <int J> __device__ __forceinline__ u32 xor_lane(u32 v, int lane) {
    if constexpr (J == 1) return (u32)__builtin_amdgcn_update_dpp(0, (int)v, 0xB1, 0xf, 0xf, true);
    else if constexpr (J == 2) return (u32)__builtin_amdgcn_update_dpp(0, (int)v, 0x4E, 0xf, 0xf, true);
    else if constexpr (J == 4) { int t = __builtin_amdgcn_update_dpp(0, (int)v, 0x104, 0xf, 0x5, false); return (u32)__builtin_amdgcn_update_dpp(t, (int)v, 0x114, 0xf, 0xA, false); }
    else if constexpr (J == 8) return (u32)__builtin_amdgcn_update_dpp(0, (int)v, 0x128, 0xf, 0xf, true);
    else if constexpr (J == 16) { u32 b = v; asm volatile("" : "+v"(b)); const auto p = __builtin_amdgcn_permlane16_swap(v, b, false, false); return (lane & 16) ? p[0] : p[1]; }
    else { u32 b = v; asm volatile("" : "+v"(b)); const auto p = __builtin_amdgcn_permlane32_swap(v, b, false, false); return (lane & 32) ? p[0] : p[1]; }
}
__device__ __forceinline__ int reduce64(int (&r)[64], int lane) {
#pragma unroll
    for (int e = 0; e < 32; ++e) { const auto p = __builtin_amdgcn_permlane32_swap((u32)r[e], (u32)r[e + 32], false, false); r[e] = (int)p[0] + (int)p[1]; }
#pragma unroll
    for (int e = 0; e < 16; ++e) { const auto p = __builtin_amdgcn_permlane16_swap((u32)r[e], (u32)r[e + 16], false, false); r[e] = (int)p[0] + (int)p[1]; }
    const bool b3 = (lane & 8) != 0, b2 = (lane & 4) != 0, b1 = (lane & 2) != 0, b0 = (lane & 1) != 0;
#pragma unroll
    for (int e = 0; e < 8; ++e) { const int keep = b3 ? r[e + 8] : r[e], send = b3 ? r[e] : r[e + 8]; r[e] = keep + __builtin_amdgcn_update_dpp(0, send, 0x128, 0xf, 0xf, true); }
#pragma unroll
    for (int e = 0; e < 4; ++e) { const int keep = b2 ? r[e + 4] : r[e], send = b2 ? r[e] : r[e + 4];
        int t = __builtin_amdgcn_update_dpp(0, send, 0x104, 0xf, 0x5, false);
        t = __builtin_amdgcn_update_dpp(t, send, 0x114, 0xf, 0xA, false);
        r[e] = keep + t; }
#pragma unroll
    for (int e = 0; e < 2; ++e) { const int keep = b1 ? r[e + 2] : r[e], send = b1 ? r[e] : r[e + 2]; r[e] = keep + __builtin_amdgcn_update_dpp(0, send, 0x4E, 0xf, 0xf, true); }
    { const int keep = b0 ? r[1] : r[0], send = b0 ? r[0] : r[1]; r[0] = keep + __builtin_amdgcn_update_dpp(0, send, 0xB1, 0xf, 0xf, true); }
    return r[0];
}
constexpr int GQ_LDS_PER_WAVE = 8192;
#define GQ_FMA16(A, ce, w) do { _Pragma("unroll") for (int j_ = 0; j_ < 4; ++j_) { \
        const f32x2_t lo_ = __builtin_amdgcn_cvt_pk_f32_fp8((int)(w)[j_], false), hi_ = __builtin_amdgcn_cvt_pk_f32_fp8((int)(w)[j_], true); \
        A[4 * j_ + 0] += (ce) * lo_.x; A[4 * j_ + 1] += (ce) * lo_.y; A[4 * j_ + 2] += (ce) * hi_.x; A[4 * j_ + 3] += (ce) * hi_.y; } } while (0)
__device__ __forceinline__ void peer_gather_quad(const Ctx& C, const Params& P, int tokq) {
    const bf16_t* HN = (const bf16_t*)(P.ws + WS_HB); const float* SSH = (const float*)(P.ws + WS_SSH);
    const unsigned char* PU = P.ws + WS_PU; const unsigned char* PV = P.ws + WS_PV;
    const float* SU = (const float*)(P.ws + WS_SU); const float* SV = (const float*)(P.ws + WS_SV);
    const LAS int* IDXL = (const LAS int*)(C.lds + IG_OFF); const LAS float* GWL = (const LAS float*)(C.lds + IG_OFF + 32768); const int tl0 = tokq & 63;
    const int lane = C.lane;
    LAS unsigned char* qhl = C.lds + C.wave * GQ_LDS_PER_WAVE;
    LAS u32* keyl = (LAS u32*)(qhl + 4096);
    u32 k[8];
#pragma unroll
    for (int s = 0; s < 4; ++s)
#pragma unroll
        for (int hb = 0; hb < 2; ++hb) k[2 * s + hb] = ((u32)IDXL[(tl0 + s) * 128 + 64 * hb + lane] << 9) | (u32)(s << 7) | (u32)(64 * hb + lane);
#pragma unroll
    for (int size = 2; size <= 512; size <<= 1) {
#pragma unroll
        for (int j = size >> 1; j > 0; j >>= 1) {
            u32 nk[8];
#pragma unroll
            for (int r = 0; r < 8; ++r) {
                const int ii = lane + 64 * r;
                const bool asc = (ii & size) == 0, lower = (ii & j) == 0;
                const u32 mine = k[r];
                u32 other;
                if (j >= 64) other = k[r ^ (j >> 6)];
                else if (j == 1) other = xor_lane<1>(mine, lane); else if (j == 2) other = xor_lane<2>(mine, lane); else if (j == 4) other = xor_lane<4>(mine, lane);
                else if (j == 8) other = xor_lane<8>(mine, lane); else if (j == 16) other = xor_lane<16>(mine, lane); else other = xor_lane<32>(mine, lane);
                const u32 mn = mine < other ? mine : other, mx = mine < other ? other : mine;
                nk[r] = (lower == asc) ? mn : mx;
            }
#pragma unroll
            for (int r = 0; r < 8; ++r) k[r] = nk[r];
        }
    }
#pragma unroll
    for (int r = 0; r < 8; ++r) keyl[64 * r + lane] = k[r];
    float shs[4];
    f32x4 g2v[4];
#pragma unroll
    for (int j = 0; j < 4; ++j) g2v[j] = *(const f32x4*)(P.in[I_N2G] + 256 * j + 4 * lane);
#pragma unroll
    for (int s = 0; s < 4; ++s) {
        float hf[16]; float m = 0.f;
        const float ssp = (lane < 16) ? SSH[(size_t)(tokq + s) * 16 + lane] : 0.f;
#pragma unroll
        for (int j = 0; j < 4; ++j) { const u32x2 w = *(const u32x2*)(HN + (size_t)(tokq + s) * DM + 256 * j + 4 * lane);
            hf[4 * j] = bflo(w.x) * g2v[j].x; hf[4 * j + 1] = bfhi(w.x) * g2v[j].y; hf[4 * j + 2] = bflo(w.y) * g2v[j].z; hf[4 * j + 3] = bfhi(w.y) * g2v[j].w; }
        const float rinv_t = 1.0f / sqrtf(wave_sum(ssp) * (1.0f / 1024.0f) + EPS);
#pragma unroll
        for (int d = 0; d < 16; ++d) m = fmaxf(m, fabsf(hf[d]));
#pragma unroll
        for (int o = 1; o < 64; o <<= 1) m = fmaxf(m, __shfl_xor(m, o));
        shs[s] = ((m > 0.f) ? m * (1.0f / 127.0f) : 1.0f) * rinv_t; const float inv = (m > 0.f) ? 127.0f / m : 0.f;
        u32x4 q;
#pragma unroll
        for (int j = 0; j < 4; ++j) {
            const int q0 = (int)rintf(hf[4 * j] * inv), q1 = (int)rintf(hf[4 * j + 1] * inv), q2 = (int)rintf(hf[4 * j + 2] * inv), q3 = (int)rintf(hf[4 * j + 3] * inv);
            q[j] = (u32)(q0 & 255) | ((u32)(q1 & 255) << 8) | ((u32)(q2 & 255) << 16) | ((u32)(q3 & 255) << 24);
        }
        *(LAS u32x4*)(qhl + s * 1024 + 16 * lane) = q;
    }
    LDS_WAIT();
    LAS float* cvl = (LAS float*)(qhl + 6144);
#pragma unroll 1
    for (int c = 0; c < 8; ++c) {
        const u32 kk = keyl[64 * c + lane];
        const int e_l = (int)(kk >> 9), slot_l = (int)((kk >> 7) & 3u), pos_l = (int)(kk & 127u);
        const float g_l = GWL[(tl0 + slot_l) * 128 + pos_l], su_l = SU[e_l], sv_l = SV[e_l];
        int r[64];
#pragma unroll
        for (int p = 0; p < 64; ++p) {
            const u32 kp = (u32)__builtin_amdgcn_readlane((int)kk, p);
            const u32x4 w = *(const u32x4*)(PU + (size_t)(kp >> 9) * 1024 + 16 * lane);
            const u32x4 hq = *(const LAS u32x4*)(qhl + ((kp >> 7) & 3u) * 1024 + 16 * lane);
            int a = __builtin_amdgcn_sdot4((int)w.x, (int)hq.x, 0, false);
            a = __builtin_amdgcn_sdot4((int)w.y, (int)hq.y, a, false);
            a = __builtin_amdgcn_sdot4((int)w.z, (int)hq.z, a, false);
            a = __builtin_amdgcn_sdot4((int)w.w, (int)hq.w, a, false);
            r[p] = a;
        }
        const int isum = reduce64(r, lane);
        const float sh_l = (slot_l == 0) ? shs[0] : (slot_l == 1) ? shs[1] : (slot_l == 2) ? shs[2] : shs[3];
        const float z = (float)isum * su_l * sh_l;
        const float c_l = gelu_erf(z) * g_l * sv_l;
        cvl[64 * c + lane] = c_l;
    }
    LDS_WAIT();
    float acc0[16], acc1[16], acc2[16], acc3[16];
#pragma unroll
    for (int d = 0; d < 16; ++d) { acc0[d] = 0.f; acc1[d] = 0.f; acc2[d] = 0.f; acc3[d] = 0.f; }
#define GQ_ISSUE(W, KP, CE, kreg, creg, p0) do { _Pragma("unroll") for (int q = 0; q < 8; ++q) { \
        KP[q] = (u32)__builtin_amdgcn_readlane((int)(kreg), (p0) + q); CE[q] = __uint_as_float((u32)__builtin_amdgcn_readlane((int)__float_as_uint(creg), (p0) + q)); \
        W[q] = *(const u32x4*)(PV + (size_t)(KP[q] >> 9) * 1024 + 16 * lane); } } while (0)
#define GQ_CONSUME(W, KP, CE) do { _Pragma("unroll") for (int q = 0; q < 8; ++q) { const u32 sl = (KP[q] >> 7) & 3u; \
        if (sl == 0u) GQ_FMA16(acc0, CE[q], W[q]); else if (sl == 1u) GQ_FMA16(acc1, CE[q], W[q]); else if (sl == 2u) GQ_FMA16(acc2, CE[q], W[q]); else GQ_FMA16(acc3, CE[q], W[q]); } } while (0)
    {
        u32x4 wA[8], wB[8]; u32 kA[8], kB[8]; float cA[8], cB[8];
        u32 kk = keyl[lane]; float cc = cvl[lane];
        GQ_ISSUE(wA, kA, cA, kk, cc, 0);
#pragma unroll 1
        for (int c = 0; c < 8; ++c) {
            const int cn = (c < 7) ? c + 1 : 7;
            const u32 kkn = keyl[64 * cn + lane]; const float ccn = cvl[64 * cn + lane];
#pragma unroll 1
            for (int p0 = 0; p0 < 64; p0 += 16) {
                GQ_ISSUE(wB, kB, cB, kk, cc, p0 + 8);
                GQ_CONSUME(wA, kA, cA);
                if (p0 < 48) GQ_ISSUE(wA, kA, cA, kk, cc, p0 + 16); else GQ_ISSUE(wA, kA, cA, kkn, ccn, 0);
                GQ_CONSUME(wB, kB, cB);
            }
            kk = kkn; cc = ccn;
        }
    }
#undef GQ_ISSUE
#undef GQ_CONSUME
    u32x2 hw[4][4];
#pragma unroll
    for (int s = 0; s < 4; ++s)
#pragma unroll
        for (int j = 0; j < 4; ++j) hw[s][j] = *(const u32x2*)(HN + (size_t)(tokq + s) * DM + 256 * j + 4 * lane);
#define GQ_OUT(s, A) do { float* orow = P.out + (size_t)(tokq + (s)) * DM; _Pragma("unroll") for (int j = 0; j < 4; ++j) { f32x4* p = (f32x4*)(orow + 256 * j + 4 * lane); \
        f32x4 v; v.x = bflo(hw[s][j].x) + A[4 * j]; v.y = bfhi(hw[s][j].x) + A[4 * j + 1]; v.z = bflo(hw[s][j].y) + A[4 * j + 2]; v.w = bfhi(hw[s][j].y) + A[4 * j + 3]; *p = v; } } while (0)
    GQ_OUT(0, acc0); GQ_OUT(1, acc1); GQ_OUT(2, acc2); GQ_OUT(3, acc3);
#undef GQ_OUT
}
__device__ __forceinline__ void peer_gather_tile(const Ctx& C, const Params& P, int tok0) {
    __syncthreads();
#pragma unroll 1
    for (int hq = 0; hq < 2; ++hq) peer_gather_quad(C, P, tok0 + 32 * hq + 4 * C.wave);
}

#define GAS __attribute__((address_space(1)))
typedef GAS unsigned gu32;
#define RLX_AGENT __ATOMIC_RELAXED, __HIP_MEMORY_SCOPE_AGENT
#define XB_TMO      128
#define XB_XCNT(j)  (256  + 64 * (j))
#define XB_XSUB(j)  (1280 + 64 * (j))
#define XB_XGEN(j)  (2304 + 64 * (j))
#define XB_TOP      3328
#define XB_TOPGEN   3392
#define XCD_BAR_WORDS 3456
#define XB_SPIN_CAP (1u << 18)

__device__ __forceinline__ unsigned xb_ld(unsigned* p)              { return __hip_atomic_load(p, __ATOMIC_RELAXED, __HIP_MEMORY_SCOPE_AGENT); }
__device__ __forceinline__ unsigned xb_add(unsigned* p, unsigned v) { return __hip_atomic_fetch_add(p, v, __ATOMIC_RELAXED, __HIP_MEMORY_SCOPE_AGENT); }
__device__ __forceinline__ unsigned xb_xcc_id() { return (unsigned)__builtin_amdgcn_s_getreg((3 << 11) | 20) & 0xFu; }
#define XB_SPIN(cond, bar) do { unsigned _sp = 0; while (cond) { __builtin_amdgcn_s_sleep(1); \
    if ((++_sp & 255u) == 0u) { if (xb_ld(&(bar)[XB_TMO])) break; if (_sp > XB_SPIN_CAP) { atomicAdd(&(bar)[XB_TMO], 1u); break; } } } } while (0)

struct XcdBarrier {
    unsigned* bar; unsigned x;
    volatile LAS unsigned* st;
};

__device__ __forceinline__ XcdBarrier xcd_barrier_post(unsigned* bar, volatile LAS unsigned* st) {
    XcdBarrier b; b.bar = bar; b.x = xb_xcc_id(); b.st = st;
    if (threadIdx.x == 0) (void)xb_add(&bar[XB_XCNT(b.x)], 1u);
    return b;
}
__device__ __forceinline__ void xcd_barrier_complete(unsigned* bar, unsigned x, unsigned& nloc, unsigned& nx) {
    const unsigned G = gridDim.x * gridDim.y * gridDim.z;
    unsigned sum, cnt, mine, sp = 0u;
    for (;;) {
        sum = 0u; cnt = 0u; mine = 0u;
#pragma unroll
        for (unsigned j = 0; j < 16; ++j) { const unsigned c = xb_ld(&bar[XB_XCNT(j)]); sum += c; cnt += (c > 0u) ? 1u : 0u; mine = (j == x) ? c : mine; }
        if (sum == G) break;
        __builtin_amdgcn_s_sleep(1);
        if ((++sp & 255u) == 0u) { if (xb_ld(&bar[XB_TMO])) break; if (sp > XB_SPIN_CAP) { atomicAdd(&bar[XB_TMO], 1u); break; } }
    }
    nloc = mine > 0u ? mine : 1u; nx = cnt > 0u ? cnt : 1u;
}

__device__ __forceinline__ void xcd_barrier(const XcdBarrier& b) {
    asm volatile("s_waitcnt vmcnt(0)" ::: "memory");
    __syncthreads();
    if (threadIdx.x == 0) {
        unsigned* bar = b.bar;
        __builtin_amdgcn_s_waitcnt(0);
        unsigned nloc = b.st[0], nx = b.st[1];
        if (nloc == 0u) { xcd_barrier_complete(bar, b.x, nloc, nx); b.st[0] = nloc; b.st[1] = nx; }
        const unsigned old = xb_add(&bar[XB_XSUB(b.x)], 1u);
        const unsigned gen = old / nloc;
        if (old + 1u == (gen + 1u) * nloc) {
            __builtin_amdgcn_fence(__ATOMIC_RELEASE, "agent");
            asm volatile("s_waitcnt vmcnt(0)" ::: "memory");
            const unsigned og = xb_add(&bar[XB_TOP], 1u);
            const unsigned tg = og / nx;
            if (og + 1u == (tg + 1u) * nx) xb_add(&bar[XB_TOPGEN], 1u);
            else XB_SPIN(xb_ld(&bar[XB_TOPGEN]) == tg, bar);
            __builtin_amdgcn_fence(__ATOMIC_ACQUIRE, "agent");
            xb_add(&bar[XB_XGEN(b.x)], 1u);
            asm volatile("s_waitcnt vmcnt(0)" ::: "memory");
        } else {
            XB_SPIN(xb_ld(&bar[XB_XGEN(b.x)]) == gen, bar);
            __builtin_amdgcn_fence(__ATOMIC_ACQUIRE, "agent");
            asm volatile("s_waitcnt vmcnt(0)" ::: "memory");
        }
    }
    __syncthreads();
}

constexpr int NPHASE = 9;
__global__ void __launch_bounds__(NTHR, 2) mk_fwd(Params P) {
    extern __shared__ __attribute__((aligned(16))) unsigned char lds_raw[];
    Ctx C; C.lds = (LAS unsigned char*)lds_raw; C.tid = threadIdx.x; C.lane = C.tid & 63; C.wave = __builtin_amdgcn_readfirstlane(C.tid >> 6); C.G = gridDim.x; C.bid = blockIdx.x;
    unsigned char* ws = P.ws;
    volatile LAS unsigned* MISC = (volatile LAS unsigned*)(C.lds + MISC_OFF);
    if (C.tid < 32) MISC[C.tid] = 0u;
    __syncthreads();
    XcdBarrier bar = xcd_barrier_post((unsigned*)(ws + WS_CTL) + 4096, MISC + 8);
#define SEAM(k) do { if (IN(k) && IN((k) + 1)) xcd_barrier(bar); FRESH(); } while (0)
#define FRESH() do { int t_ = (int)threadIdx.x; asm volatile("" : "+v"(t_)); C.tid = t_; C.lane = t_ & 63; } while (0)
#ifdef ONLY_PHASE
#define IN(k) ((k) == ONLY_PHASE && P.ph_lo <= (k) && (k) < P.ph_hi)
#else
#define IN(k) (P.ph_lo <= (k) && (k) < P.ph_hi)
#endif
    if (IN(0)) phase_prologue(C, P);
    SEAM(0);
    if (IN(1)) {
        pg8::Gemm g{(const bf16_t*)(ws + WS_BUFA), (const bf16_t*)(ws + WS_WIN_T), MPAD, INW, DM}; pg8::StaticOrder S; S.init(MPAD, INW, C.G, C.bid);
        pg8::EpiBf16<0> E{(bf16_t*)(ws + WS_PROJ), INW, nullptr, 0, 0, 1.f};
        pg8::gemm_phase<pg8::EpiBf16<0>, pg8::StaticOrder, true, true>(C.lds, g, S, E);
        { const int ntile = (MPAD / 256) * (INW / 256), nbusy = ntile % C.G;
          if (ntile > C.G && nbusy > 0) { if (C.bid >= nbusy) deferred_a(C, P, C.bid - nbusy, C.G - nbusy); }
          else deferred_a(C, P, C.bid, C.G); }
    }
    SEAM(1);
    if (IN(2)) phase_sloc(C, P);
    SEAM(2);
    if (IN(3)) {
        for (int bk = C.bid; bk < 64; bk += C.G) carry_scan_block(C, P, bk);
        for (int u = C.bid; u < 256; u += C.G) attn_unit(C, P, u >> 1, u & 1);
    }
    SEAM(3);
    if (IN(4)) phase_ssm_y(C, P);
    SEAM(4);
    if (IN(5)) {
        pg8::Gemm g{(const bf16_t*)(ws + WS_Z), (const bf16_t*)(ws + WS_GLU_T), SEQ, 512, 512}; pg8::StaticOrder S; S.init(SEQ, 512, C.G, C.bid);
        EpiGlu E{(const bf16_t*)(ws + WS_Z), (bf16_t*)(ws + WS_BUFA), P.in[I_GLUB], (float*)(ws + WS_SSS)};
        pg8::gemm_phase<EpiGlu, pg8::StaticOrder, true, true>(C.lds, g, S, E);
        { const int ntile = (SEQ / 256) * 2;
          if (ntile < C.G) { if (C.bid >= ntile) deferred_b(C, P, C.bid - ntile, C.G - ntile); }
          else deferred_b(C, P, C.bid, C.G); }
    }
    SEAM(5);
    if (IN(6)) {
        __syncthreads();
        if (C.tid < 256) {
            pg8::StaticOrder S0; S0.init(SEQ, DM, C.G, C.bid); pg8::Unit u0; S0.next(0, u0);
            const int row = u0.pm * 256 + C.tid;
            const f32x4* pa = (const f32x4*)((const float*)(ws + WS_SSA) + (size_t)row * 8); const f32x4* ps = (const f32x4*)((const float*)(ws + WS_SSS) + (size_t)row * 8);
            const f32x4 a0 = pa[0], a1 = pa[1], s0 = ps[0], s1 = ps[1];
            const float ra = 1.0f / sqrtf((((a0.x + a0.y) + (a0.z + a0.w)) + ((a1.x + a1.y) + (a1.z + a1.w))) * (1.0f / 512.0f) + EPS);
            const float rs = 1.0f / sqrtf((((s0.x + s0.y) + (s0.z + s0.w)) + ((s1.x + s1.y) + (s1.z + s1.w))) * (1.0f / 512.0f) + EPS);
            LAS float* fac = (LAS float*)(C.lds + FAC_OFF); fac[2 * C.tid] = ra / rs; fac[2 * C.tid + 1] = rs;
        }
        __syncthreads();
        pg8::Gemm g{(const bf16_t*)(ws + WS_BUFA), (const bf16_t*)(ws + WS_WOUT_T), SEQ, DM, DM}; pg8::StaticOrder S; S.init(SEQ, DM, C.G, C.bid);
        EpiMix E{P.in[I_X], (bf16_t*)(ws + WS_HB), (float*)(ws + WS_SSH)};
        pg8::gemm_phase<EpiMix, pg8::StaticOrder, true, true>(C.lds, g, S, E);
    }
    SEAM(6);
    if (IN(7)) {
        pg8::Gemm g{(const bf16_t*)(ws + WS_HB), (const bf16_t*)(ws + WS_WQ_T), SEQ, 2048, DM}; pg8::StaticOrder S; S.init(SEQ, 2048, C.G, C.bid);
        pg8::Unit ua, ub; const bool ha = S.next(0, ua), hb = S.next(1, ub);
        __syncthreads();
        {
            const int which = C.tid >> 8, rl = C.tid & 255; const bool has = which ? hb : ha; const int pm = which ? ub.pm : ua.pm;
            if (has) {
                const f32x4* sp = (const f32x4*)((const float*)(ws + WS_SSH) + (size_t)(pm * 256 + rl) * 16);
                const f32x4 s0 = sp[0], s1 = sp[1], s2 = sp[2], s3 = sp[3];
                const float ss = ((s0.x + s0.y) + (s0.z + s0.w)) + ((s1.x + s1.y) + (s1.z + s1.w)) + ((s2.x + s2.y) + (s2.z + s2.w)) + ((s3.x + s3.y) + (s3.z + s3.w));
                ((LAS float*)(C.lds + FAC_OFF))[which * 256 + rl] = 1.0f / sqrtf(ss * (1.0f / 1024.0f) + EPS);
            }
        }
        __syncthreads();
        EpiQ E{(bf16_t*)(ws + WS_QP), ua.pm};
        pg8::gemm_phase<EpiQ, pg8::StaticOrder, true, true>(C.lds, g, S, E);
    }
    SEAM(7);
    {
    if (IN(8)) {
        for (int tile = C.bid; tile < SEQ / 64; tile += C.G) {
            peer_topk_tile(C, P, tile * 64);
            peer_gather_tile(C, P, tile * 64);
        }
    }
    }
#undef IN
#undef SEAM
}
}

extern "C" void kernel_launch(void* const* d_in, const int* in_sizes, int n_in, void* d_out, int out_size, void* d_ws, size_t ws_size, hipStream_t stream) {
    static int state = 0, grid = 0;
    if (state == 0) {
        if (n_in != 25 || out_size != mk::SEQ * mk::DM || ws_size < mk::WS_END) { fprintf(stderr, "kernel_launch: unexpected shapes (n_in %d out %d ws %zu)\n", n_in, out_size, ws_size); state = -1; return; }
        if (hipFuncSetAttribute((const void*)mk::mk_fwd, hipFuncAttributeMaxDynamicSharedMemorySize, mk::LDS_BYTES) != hipSuccess) { fprintf(stderr, "kernel_launch: hipFuncSetAttribute failed\n"); state = -1; return; }
        int dev = 0, cus = 0, per_cu = 0;
        if (hipGetDevice(&dev) != hipSuccess || hipDeviceGetAttribute(&cus, hipDeviceAttributeMultiprocessorCount, dev) != hipSuccess) { fprintf(stderr, "kernel_launch: device query failed\n"); state = -1; return; }
        if (hipOccupancyMaxActiveBlocksPerMultiprocessor(&per_cu, (const void*)mk::mk_fwd, mk::NTHR, mk::LDS_BYTES) != hipSuccess || per_cu < 1) { fprintf(stderr, "kernel_launch: occupancy query failed (%d)\n", per_cu); state = -1; return; }
        grid = cus;
        state = 1;
    }
    if (state < 0) return;
    mk::Params p{};
    for (int i = 0; i < 25; ++i) p.in[i] = (const float*)d_in[i];
    p.out = (float*)d_out; p.ws = (unsigned char*)d_ws;
    if (hipMemsetAsync((char*)d_ws + mk::WS_CTL, 0, 65536, stream) != hipSuccess) { fprintf(stderr, "kernel_launch: memset failed\n"); return; }
    p.ph_lo = 0; p.ph_hi = mk::NPHASE;
    void* args[] = {&p};
    hipError_t e = hipLaunchCooperativeKernel((const void*)mk::mk_fwd, dim3(grid), dim3(mk::NTHR), args, mk::LDS_BYTES, stream);
    if (e != hipSuccess) fprintf(stderr, "kernel_launch: cooperative launch failed: %s (grid %d)\n", hipGetErrorString(e), grid);
}
```

```cpp
#include <hip/hip_runtime.h>
#include <cstdio>
#include <cstdint>
#include <cmath>
namespace pg8 {
#define PG8_LAS __attribute__((address_space(3)))
typedef unsigned short bf16_t;
typedef short bf16x8 __attribute__((ext_vector_type(8)));
typedef float f32x4 __attribute__((ext_vector_type(4)));
typedef unsigned u32x4 __attribute__((ext_vector_type(4)));
constexpr int BM = 256, BK = 64, HALF = 128, HTB = HALF * BK * 2  , STAGE_BYTES = 8 * HTB, NXCD = 8, WGM = 8;

__host__ __device__ __forceinline__ int lds_byte(int r, int c) { const int st = (r >> 4) * 2 + (c >> 5), rr = r & 15, cc = c & 31, ob = rr * 64 + cc * 2; return st * 1024 + (ob ^ (((ob >> 9) & 1) << 5)); }
__host__ __device__ __forceinline__ void stage_rc(int b, int& R, int& C) { const int st = b / 1024, sb = b % 1024, swz = sb ^ (((sb >> 9) & 1) << 5); R = (st >> 1) * 16 + swz / 64; C = (st & 1) * 32 + (swz % 64) / 2; }
__host__ __device__ __forceinline__ int perm32(int rho) { const int n = rho >> 4, i = rho & 15; return 8 * (i >> 2) + 4 * n + (i & 3); }

struct Unit { int pm, pn; };
struct Gemm { const bf16_t* A; const bf16_t* Bt; int M, N, K; };

struct StaticOrder {
    int nM, nN, nwg, G, c;
    __host__ __device__ __forceinline__ void init(int M, int N, int G_, int c_) { nM = M / BM; nN = N / BM; nwg = nM * nN; G = G_; c = c_; }
    __host__ __device__ __forceinline__ bool next(int i, Unit& u) const {
        const long L = (long)i * G + c; if (L >= nwg) return false;
        int wgid = (int)L; { const int q = nwg / NXCD, r = nwg % NXCD, xcd = wgid % NXCD, off = wgid / NXCD; wgid = (xcd < r ? xcd * (q + 1) : r * (q + 1) + (xcd - r) * q) + off; }
        const int nig = WGM * nN, gid = wgid / nig, fm = gid * WGM, gsz = (nM - fm) < WGM ? (nM - fm) : WGM;
        u.pm = fm + ((wgid % nig) % gsz); u.pn = (wgid % nig) / gsz; return true;
    }
    __device__ __forceinline__ void a_ready(const Unit&) const {}
    __device__ __forceinline__ void done(const Unit&) const {}
};

__device__ __forceinline__ unsigned cvt_pk_bf16(float lo, float hi) { unsigned r; asm volatile("v_cvt_pk_bf16_f32 %0, %1, %2" : "=v"(r) : "v"(lo), "v"(hi)); return r; }
typedef float f32x2 __attribute__((ext_vector_type(2)));
__device__ __forceinline__ f32x2 gelu_pk(f32x2 v) {
    const f32x2 av = __builtin_elementwise_abs(v), d = av * 0.2316418882f + 1.0f;
    f32x2 t; t.x = __builtin_amdgcn_rcpf(d.x); t.y = __builtin_amdgcn_rcpf(d.y);
    f32x2 q = t * 0.5307027145f + (-0.7265760135f); q = q * t + 0.7107068705f; q = q * t + (-0.142248368f); q = q * t + 0.127414796f; q = q * t;
    const f32x2 s = (v * v) * (-0.72134752044f);
    f32x2 e; e.x = __builtin_amdgcn_exp2f(s.x); e.y = __builtin_amdgcn_exp2f(s.y);
    const f32x2 m = v * (q * e), r = v - m;
    f32x2 o; o.x = v.x < 0.f ? m.x : r.x; o.y = v.y < 0.f ? m.y : r.y; return o;
}

template <int ACT  > struct EpiBf16 {
    static constexpr bool PERM = true, AFTER_DRAIN = false, HAS_MID = false; static_assert(ACT == 0 || ACT == 1, "EpiBf16: ACT is 0 (none) or 1 (gelu_pk)");
    bf16_t* O; int ldc; const float* bias; int split_cols; size_t split_stride; float scale0;
    __device__ __forceinline__ void operator()(const f32x4 (&acc)[2][2][4][2], const Unit& u, int wr, int wc, int fr, int fq) const {
        const int row0 = u.pm * BM + wr * 64 + fr; int colt = u.pn * BM; bf16_t* base = O;
        float sc = 1.f; if (split_cols) { const int t = colt / split_cols; base += (size_t)t * split_stride; colt -= t * split_cols; if (t == 0) sc = scale0; }
        const int col0 = colt + wc * 32 + 8 * fq, bcol0 = u.pn * BM + wc * 32 + 8 * fq;
        f32x4 bv[2][2];
#pragma unroll
        for (int bj = 0; bj < 2; ++bj)
#pragma unroll
            for (int n = 0; n < 2; ++n) bv[bj][n] = bias ? *(const f32x4*)(bias + bcol0 + bj * HALF + 4 * n) : (f32x4){0.f, 0.f, 0.f, 0.f};
#pragma unroll
        for (int ai = 0; ai < 2; ++ai)
#pragma unroll
            for (int m = 0; m < 4; ++m) { bf16_t* rowp = base + (size_t)(row0 + ai * HALF + m * 16) * ldc + col0;
#pragma unroll
                for (int bj = 0; bj < 2; ++bj) { f32x4 v0 = acc[ai][bj][m][0] + bv[bj][0], v1 = acc[ai][bj][m][1] + bv[bj][1];
                    if (ACT == 1) { f32x2 a = gelu_pk((f32x2){v0[0], v0[1]}), b = gelu_pk((f32x2){v0[2], v0[3]}), c = gelu_pk((f32x2){v1[0], v1[1]}), d = gelu_pk((f32x2){v1[2], v1[3]});
                        v0 = (f32x4){a.x, a.y, b.x, b.y}; v1 = (f32x4){c.x, c.y, d.x, d.y}; }
                    v0 = v0 * sc; v1 = v1 * sc; u32x4 w; w.x = cvt_pk_bf16(v0[0], v0[1]); w.y = cvt_pk_bf16(v0[2], v0[3]); w.z = cvt_pk_bf16(v1[0], v1[1]); w.w = cvt_pk_bf16(v1[2], v1[3]);
                    *(u32x4*)(rowp + bj * HALF) = w; } }
    }
};
template <class Epi, class Sched, bool ALIGN_EPI = false, bool SP2 = false>
__device__ __forceinline__ void gemm_phase(PG8_LAS unsigned char* lds, const Gemm g, const Sched& S, const Epi& E) {
    const int tid = threadIdx.x, wid = __builtin_amdgcn_readfirstlane(tid >> 6), lane = tid & 63, wr = wid >> 2, wc = wid & 3, fr = lane & 15, fq = lane >> 4;
    const int K = g.K, nt = K / BK;
    unsigned voffA[2], voffB[2];
#pragma unroll
    for (int i = 0; i < 2; ++i) { int R, C; stage_rc(tid * 16 + i * 8192, R, C); const int Rb = Epi::PERM ? ((R & ~31) + perm32(R & 31)) : R;
        voffA[i] = (unsigned)(R * K + C) * 2u; voffB[i] = (unsigned)(Rb * K + C) * 2u; }
    const size_t kstep = (size_t)(BK * 2);
    const size_t hstep = (size_t)HALF * K * 2;
    const size_t tstep = 2 * hstep;
    const unsigned ldsw = (unsigned)wid * 1024u;
    const int aoff = lds_byte(wr * 64 + fr, fq * 8), boff = lds_byte(wc * 32 + fr, fq * 8);
#define PG8_SA(b, h) (((b) * 2 + (h)) * HTB)
#define PG8_SB(b, h) ((4 + (b) * 2 + (h)) * HTB)
#define PG8_STAGE(bufoff, gbase, voff) do { _Pragma("unroll") for (int _i = 0; _i < 2; ++_i) \
        __builtin_amdgcn_global_load_lds((const unsigned*)((const char*)(gbase) + (voff)[_i]), (PG8_LAS unsigned*)(lds + (bufoff) + ldsw + _i * 8192), 16, 0, 0); } while (0)
#define PG8_LDA(dst, b, h) do { _Pragma("unroll") for (int m = 0; m < 4; ++m) _Pragma("unroll") for (int k = 0; k < 2; ++k) dst[m][k] = *(const PG8_LAS bf16x8*)(lds + PG8_SA(b, h) + aoff + m * 2048 + k * 1024); } while (0)
#define PG8_LDB(dst, b, h) do { _Pragma("unroll") for (int n = 0; n < 2; ++n) _Pragma("unroll") for (int k = 0; k < 2; ++k) dst[n][k] = *(const PG8_LAS bf16x8*)(lds + PG8_SB(b, h) + boff + n * 2048 + k * 1024); } while (0)
#define PG8_MMA(ai, bj, At, Bt) do { __builtin_amdgcn_s_setprio(1); _Pragma("unroll") for (int m = 0; m < 4; ++m) _Pragma("unroll") for (int n = 0; n < 2; ++n) _Pragma("unroll") for (int k = 0; k < 2; ++k) \
        acc[ai][bj][m][n] = __builtin_amdgcn_mfma_f32_16x16x32_bf16(Bt[n][k], At[m][k], acc[ai][bj][m][n], 0, 0, 0); __builtin_amdgcn_s_setprio(0); } while (0)
#define PG8_WAIT_V(n) asm volatile("s_waitcnt vmcnt(" #n ")" ::: "memory")
#define PG8_WAIT_L(n) asm volatile("s_waitcnt lgkmcnt(" #n ")" ::: "memory")
#define PG8_BAR __builtin_amdgcn_s_barrier()
#define PG8_SCHED __builtin_amdgcn_sched_barrier(0)
    Unit cur, nxt; int ui = 0;
    if (!S.next(0, cur)) return;
    f32x4 acc[2][2][4][2];
#pragma unroll
    for (int a = 0; a < 2; ++a)
#pragma unroll
        for (int b = 0; b < 2; ++b)
#pragma unroll
            for (int m = 0; m < 4; ++m)
#pragma unroll
                for (int n = 0; n < 2; ++n) acc[a][b][m][n] = (f32x4){0.f, 0.f, 0.f, 0.f};
    bf16x8 At[4][2], B0[2][2], B1[2][2];
    const char* cA = (const char*)g.A + (size_t)cur.pm * tstep; const char* cB = (const char*)g.Bt + (size_t)cur.pn * tstep;
    S.a_ready(cur);
    if constexpr (SP2) {
        PG8_STAGE(PG8_SB(0, 0), cB, voffB); PG8_STAGE(PG8_SB(0, 1), cB + hstep, voffB); PG8_STAGE(PG8_SA(0, 0), cA, voffA); PG8_STAGE(PG8_SA(0, 1), cA + hstep, voffA);
        if (wr == 1) PG8_BAR;
        PG8_WAIT_V(2); PG8_BAR;
        PG8_STAGE(PG8_SB(1, 0), cB + kstep, voffB); PG8_STAGE(PG8_SA(1, 0), cA + kstep, voffA); PG8_STAGE(PG8_SB(1, 1), cB + hstep + kstep, voffB);
        PG8_WAIT_V(6); PG8_BAR;
    } else {
        PG8_STAGE(PG8_SB(0, 0), cB, voffB); PG8_STAGE(PG8_SA(0, 0), cA, voffA); PG8_STAGE(PG8_SB(0, 1), cB + hstep, voffB); PG8_STAGE(PG8_SA(0, 1), cA + hstep, voffA);
        if (wr == 1) PG8_BAR;
        PG8_WAIT_V(4); PG8_BAR;
        PG8_STAGE(PG8_SB(1, 0), cB + kstep, voffB); PG8_STAGE(PG8_SA(1, 0), cA + kstep, voffA); PG8_STAGE(PG8_SB(1, 1), cB + hstep + kstep, voffB);
        PG8_WAIT_V(6); PG8_BAR;
    }
    for (;;) {
        const bool has_next = S.next(ui + 1, nxt);
        const char* nA = has_next ? (const char*)g.A + (size_t)nxt.pm * tstep : cA; const char* nB = has_next ? (const char*)g.Bt + (size_t)nxt.pn * tstep : cB;
        for (int t = 0; t < nt; t += 2) {
            const bool last = (t == nt - 2);
            if constexpr (Epi::HAS_MID) { if (t == nt / 2) E.mid(acc, cur, wr, wc, fr, fq, lds); }
            const char* a1 = cA + (size_t)(t + 1) * kstep;
            const char* a2 = last ? nA : cA + (size_t)(t + 2) * kstep; const char* b2 = last ? nB : cB + (size_t)(t + 2) * kstep;
            const char* a3 = a2 + kstep; const char* b3 = b2 + kstep;
            if (last && has_next) S.a_ready(nxt);
            if constexpr (SP2) {
            PG8_LDB(B0, 0, 0); PG8_LDB(B1, 0, 1); PG8_SCHED; PG8_LDA(At, 0, 0); PG8_STAGE(PG8_SA(1, 1), a1 + hstep, voffA);
            PG8_WAIT_V(8); PG8_WAIT_L(0); PG8_BAR; PG8_MMA(0, 0, At, B0); PG8_MMA(0, 1, At, B1); PG8_BAR; PG8_SCHED;
            PG8_LDA(At, 0, 1); PG8_STAGE(PG8_SB(0, 0), b2, voffB); PG8_STAGE(PG8_SB(0, 1), b2 + hstep, voffB); PG8_STAGE(PG8_SA(0, 0), a2, voffA);
            PG8_WAIT_V(8); PG8_WAIT_L(0); PG8_BAR; PG8_MMA(1, 0, At, B0); PG8_MMA(1, 1, At, B1); PG8_BAR; PG8_SCHED;
            PG8_LDB(B0, 1, 0); PG8_LDB(B1, 1, 1); PG8_SCHED; PG8_LDA(At, 1, 0); PG8_STAGE(PG8_SA(0, 1), a2 + hstep, voffA);
            PG8_WAIT_V(8); PG8_WAIT_L(0); PG8_BAR; PG8_MMA(0, 0, At, B0); PG8_MMA(0, 1, At, B1); PG8_BAR; PG8_SCHED;
            PG8_LDA(At, 1, 1); PG8_STAGE(PG8_SB(1, 0), b3, voffB); PG8_STAGE(PG8_SB(1, 1), b3 + hstep, voffB); PG8_STAGE(PG8_SA(1, 0), a3, voffA);
            PG8_WAIT_V(8); PG8_WAIT_L(0); PG8_BAR; PG8_MMA(1, 0, At, B0); PG8_MMA(1, 1, At, B1); PG8_BAR; PG8_SCHED;
            } else {
            PG8_LDB(B0, 0, 0); PG8_SCHED; PG8_LDA(At, 0, 0); PG8_STAGE(PG8_SA(1, 1), a1 + hstep, voffA);
            PG8_WAIT_L(8); PG8_BAR; PG8_WAIT_L(0); PG8_MMA(0, 0, At, B0); PG8_BAR; PG8_SCHED;
            PG8_LDB(B1, 0, 1); PG8_STAGE(PG8_SB(0, 0), b2, voffB);
            PG8_BAR; PG8_WAIT_L(0); PG8_MMA(0, 1, At, B1); PG8_BAR;
            PG8_LDA(At, 0, 1); PG8_STAGE(PG8_SA(0, 0), a2, voffA);
            PG8_BAR; PG8_WAIT_L(0); PG8_MMA(1, 0, At, B0); PG8_BAR; PG8_SCHED;
            PG8_STAGE(PG8_SB(0, 1), b2 + hstep, voffB);
            PG8_WAIT_V(6); PG8_BAR; PG8_MMA(1, 1, At, B1); PG8_BAR;
            PG8_LDB(B0, 1, 0); PG8_SCHED; PG8_LDA(At, 1, 0); PG8_STAGE(PG8_SA(0, 1), a2 + hstep, voffA);
            PG8_WAIT_L(8); PG8_BAR; PG8_WAIT_L(0); PG8_MMA(0, 0, At, B0); PG8_BAR; PG8_SCHED;
            PG8_LDB(B1, 1, 1); PG8_STAGE(PG8_SB(1, 0), b3, voffB);
            PG8_BAR; PG8_WAIT_L(0); PG8_MMA(0, 1, At, B1); PG8_BAR;
            PG8_LDA(At, 1, 1); PG8_STAGE(PG8_SA(1, 0), a3, voffA);
            PG8_BAR; PG8_WAIT_L(0); PG8_MMA(1, 0, At, B0); PG8_BAR; PG8_SCHED;
            PG8_STAGE(PG8_SB(1, 1), b3 + hstep, voffB);
            PG8_WAIT_V(6); PG8_BAR; PG8_MMA(1, 1, At, B1); PG8_BAR;
            }
        }
        if constexpr (ALIGN_EPI) { if (wr == 0) PG8_BAR; }
        if constexpr (!Epi::AFTER_DRAIN) { E(acc, cur, wr, wc, fr, fq); S.done(cur); }
        if (!has_next) break;
#pragma unroll
        for (int a = 0; a < 2; ++a)
#pragma unroll
            for (int b = 0; b < 2; ++b)
#pragma unroll
                for (int m = 0; m < 4; ++m)
#pragma unroll
                    for (int n = 0; n < 2; ++n) acc[a][b][m][n] = (f32x4){0.f, 0.f, 0.f, 0.f};
        cur = nxt; cA = nA; cB = nB; ++ui;
        if constexpr (ALIGN_EPI) { if (wr == 1) PG8_BAR; }
    }
    PG8_WAIT_V(0);
    if constexpr (!ALIGN_EPI) { if (wr == 0) PG8_BAR; }
    PG8_BAR;
    if constexpr (Epi::AFTER_DRAIN) { E.fused(acc, cur, wr, wc, fr, fq, lds, wid, lane); S.done(cur); }
#undef PG8_SA
#undef PG8_SB
#undef PG8_STAGE
#undef PG8_LDA
#undef PG8_LDB
#undef PG8_MMA
#undef PG8_WAIT_V
#undef PG8_WAIT_L
#undef PG8_BAR
#undef PG8_SCHED
}
}

namespace mk {
#define LAS __attribute__((address_space(3)))
typedef unsigned short bf16_t;
typedef short bf16x8 __attribute__((ext_vector_type(8)));
typedef float f32x4 __attribute__((ext_vector_type(4)));
typedef float f32x16 __attribute__((ext_vector_type(16)));
typedef unsigned u32x4 __attribute__((ext_vector_type(4)));
typedef unsigned u32x2 __attribute__((ext_vector_type(2)));
typedef __bf16 bf16x2_t __attribute__((ext_vector_type(2)));
typedef float f32x2_t __attribute__((ext_vector_type(2)));
typedef unsigned u32;

constexpr int DM = 1024, SEQ = 16384, NMETA = 16, MPAD = 16640, INW = 1280;
constexpr int O_K = 512, O_V = 640, O_U = 768;
constexpr int NCH = 513;
constexpr float EPS = 1e-6f;
constexpr float LOG2E = 1.4426950408889634f;
constexpr int NWAVES = 8, NTHR = 512;
constexpr int LDS_BYTES = 163840;
constexpr int MISC_OFF = LDS_BYTES - 128;

constexpr size_t MiB = 1u << 20;
constexpr size_t WS_CTL = 0, CTL_BYTES = 1 * MiB;
constexpr size_t WS_WIN_T = 1 * MiB;
constexpr size_t WS_WOUT_T = 4 * MiB;
constexpr size_t WS_WQ_T = 6 * MiB;
constexpr size_t WS_GLU_T = 10 * MiB;
constexpr size_t WS_SUBK = 10 * MiB + 512 * 1024;
constexpr size_t WS_KT = 11 * MiB;
constexpr size_t WS_F = 12 * MiB;
constexpr size_t WS_E = 16 * MiB;
constexpr size_t WS_ABART = 20 * MiB;
constexpr size_t WS_SLOC = 21 * MiB;
constexpr size_t WS_CARRY = 30 * MiB;
constexpr size_t WS_BUFA = 39 * MiB;
constexpr size_t WS_PROJ = 72 * MiB;
constexpr size_t WS_ATTN = 113 * MiB;
constexpr size_t WS_Z = 129 * MiB;
constexpr size_t WS_SSMO = 145 * MiB;
constexpr size_t WS_QP = 72 * MiB;
constexpr size_t WS_IDX = 161 * MiB;
constexpr size_t WS_GW = 169 * MiB;
constexpr size_t WS_PU = 177 * MiB;
constexpr size_t WS_PV = 193 * MiB;
constexpr size_t WS_SU = 209 * MiB;
constexpr size_t WS_SV = 209 * MiB + 65536;
constexpr size_t WS_HB = 210 * MiB;
constexpr size_t WS_SSA = 242 * MiB;
constexpr size_t WS_SSS = 242 * MiB + 512 * 1024;
constexpr size_t WS_SSH = 243 * MiB;
constexpr size_t WS_END = 245 * MiB;

struct Params { const float* in[25]; float* out; unsigned char* ws; int ph_lo, ph_hi; };
enum { I_X = 0, I_META, I_N1G, I_WIN, I_QNG, I_KNG, I_SINK, I_ARE, I_AIM, I_LDT, I_BRE, I_BIM, I_CRE, I_CIM, I_SD, I_GLUW, I_GLUB, I_AOG, I_SOG, I_WOUT, I_N2G, I_WQ, I_SUBK, I_PU, I_PV };

__device__ __forceinline__ unsigned pk2(float lo, float hi) { f32x2_t v = {lo, hi}; return __builtin_bit_cast(unsigned, __builtin_convertvector(v, bf16x2_t)); }
__device__ __forceinline__ float bflo(unsigned w) { return __uint_as_float(w << 16); }
__device__ __forceinline__ float bfhi(unsigned w) { return __uint_as_float(w & 0xffff0000u); }
__device__ __forceinline__ float wave_sum(float v) {
#pragma unroll
    for (int o = 1; o < 64; o <<= 1) v += __shfl_xor(v, o);
    return v;
}
#define LDS_WAIT() asm volatile("s_waitcnt lgkmcnt(0)" ::: "memory")
__device__ __forceinline__ float gelu_erf(float v) { return 0.5f * v * (1.0f + erff(v * 0.70710678118654752f)); }
__device__ __forceinline__ u32 f2ord(float f) { const u32 u = __float_as_uint(f); return (u & 0x80000000u) ? ~u : (u | 0x80000000u); }
__device__ __forceinline__ float ord2f(u32 o) { const u32 u = (o & 0x80000000u) ? (o & 0x7fffffffu) : ~o; return __uint_as_float(u); }
#define MFMA16(a, b, c) __builtin_amdgcn_mfma_f32_16x16x32_bf16((a), (b), (c), 0, 0, 0)
#define MFMA32(a, b, c) __builtin_amdgcn_mfma_f32_32x32x16_bf16((a), (b), (c), 0, 0, 0)

#define CEX(x, i, j) do { const u32 _a = x[i], _b = x[j]; x[i] = _a > _b ? _a : _b; x[j] = _a > _b ? _b : _a; } while (0)
__device__ __forceinline__ void sort16_desc(u32 (&x)[16]) {
#pragma unroll
    for (int k = 2; k <= 16; k <<= 1) {
#pragma unroll
        for (int j = k >> 1; j > 0; j >>= 1) {
#pragma unroll
            for (int i = 0; i < 16; ++i) { const int l = i ^ j; if (l > i) { if ((i & k) == 0) CEX(x, i, l); else CEX(x, l, i); } }
        }
    }
}
__device__ __forceinline__ void bmerge16_desc(u32 (&x)[16]) {
#pragma unroll
    for (int j = 8; j > 0; j >>= 1) {
#pragma unroll
        for (int i = 0; i < 16; ++i) { const int l = i ^ j; if (l > i) CEX(x, i, l); }
    }
}
__device__ __forceinline__ void merge_top16(u32 (&a)[16], const u32 (&b)[16]) {
#pragma unroll
    for (int i = 0; i < 16; ++i) a[i] = a[i] > b[15 - i] ? a[i] : b[15 - i];
    bmerge16_desc(a);
}
__device__ __forceinline__ void top16_of_64(u32 (&g0)[16], u32 (&g1)[16], u32 (&g2)[16], u32 (&g3)[16]) {
    sort16_desc(g0); sort16_desc(g1); sort16_desc(g2); sort16_desc(g3);
    merge_top16(g0, g1); merge_top16(g2, g3); merge_top16(g0, g2);
}
__device__ const unsigned char CAND_AB[64] = {0, 1, 2, 3, 4, 5, 6, 7, 8, 9, 10, 11, 12, 13, 14, 15, 16, 17, 18, 19, 20, 21, 22, 23, 32, 33, 34, 35, 36, 48, 49, 50, 51, 64, 65, 66, 80, 81, 96, 97, 112, 113, 128, 144, 160, 176, 192, 208, 224, 240, 0, 0, 0, 0, 0, 0, 0, 0, 0, 0, 0, 0, 0, 0};

struct Ctx { LAS unsigned char* lds; int tid, lane, wave, G, bid; };

__device__ __forceinline__ void transpose_item(const float* W, int K, int N, bf16_t* WT, LAS float* scr, int item, int lane, const float* ks0 = nullptr, const float* ks1 = nullptr, int ksplit = 0) {
    const int nblk = N / 32, kb = item / nblk, nb = item % nblk, k0 = 64 * kb, n0 = 32 * nb;
    f32x4 wv[8];
#pragma unroll
    for (int i = 0; i < 8; ++i) wv[i] = *(const f32x4*)(W + (size_t)(k0 + 8 * i + (lane >> 3)) * N + n0 + 4 * (lane & 7));
#pragma unroll
    for (int i = 0; i < 8; ++i) {
        const int kk = 8 * i + (lane >> 3); float sc = 1.0f;
        if (ks0) { const int k = k0 + kk; sc = (ksplit && k >= ksplit) ? ks1[k - ksplit] : ks0[k]; }
        LAS float* d = scr + kk * 33 + 4 * (lane & 7);
        d[0] = wv[i].x * sc; d[1] = wv[i].y * sc; d[2] = wv[i].z * sc; d[3] = wv[i].w * sc;
    }
    LDS_WAIT();
    const int c = lane & 7;
#pragma unroll
    for (int j = 0; j < 4; ++j) { const int n = (lane >> 3) + 8 * j; const LAS float* s = scr + (8 * c) * 33 + n;
        u32x4 o; o.x = pk2(s[0 * 33], s[1 * 33]); o.y = pk2(s[2 * 33], s[3 * 33]); o.z = pk2(s[4 * 33], s[5 * 33]); o.w = pk2(s[6 * 33], s[7 * 33]);
        *(u32x4*)(WT + (size_t)(n0 + n) * K + k0 + 8 * c) = o; }
    LDS_WAIT();
}

__device__ __forceinline__ void ssm_tables(const Ctx& C, const Params& P, int g) {
    LAS float* pwr = (LAS float*)C.lds;
    LAS float* pwi = pwr + 33 * 64;
    LAS float* bbr = pwi + 33 * 64;
    LAS float* bbi = bbr + 1024;
    LAS float* ccr = bbi + 1024;
    LAS float* cci = ccr + 1024;
    LAS float* cfr = cci + 1024;
    LAS float* cfi = cfr + 64;
    const int tid = C.tid;
    const float dt = expf(P.in[I_LDT][g]);
    for (int e = tid; e < 33 * 64; e += NTHR) {
        const int l = e >> 6, n = e & 63;
        const float lr = P.in[I_ARE][g * 64 + n], li = P.in[I_AIM][g * 64 + n];
        const float x = lr * dt * (float)l, th = li * dt * (float)l, mag = expf(x);
        float s, c; sincosf(th, &s, &c);
        pwr[e] = mag * c; pwi[e] = mag * s;
        if (l == 32) { float* abt = (float*)(P.ws + WS_ABART) + (g * 64 + n) * 2; abt[0] = mag * c; abt[1] = mag * s; }
    }
    if (tid < 64) {
        const int n = tid;
        const float lr = P.in[I_ARE][g * 64 + n], li = P.in[I_AIM][g * 64 + n];
        const float x1 = lr * dt, th1 = li * dt, em1 = expm1f(x1);
        float s1, c1; sincosf(th1, &s1, &c1);
        const float sh = sinf(0.5f * th1);
        const float nr = em1 * c1 - 2.0f * sh * sh, ni = (em1 + 1.0f) * s1;
        const float den = lr * lr + li * li;
        cfr[n] = (nr * lr + ni * li) / den; cfi[n] = (ni * lr - nr * li) / den;
    }
    __syncthreads();
    for (int e = tid; e < 1024; e += NTHR) {
        const int n = e >> 4;
        const float br = P.in[I_BRE][g * 1024 + e], bi = P.in[I_BIM][g * 1024 + e];
        bbr[e] = cfr[n] * br - cfi[n] * bi; bbi[e] = cfr[n] * bi + cfi[n] * br;
        ccr[e] = P.in[I_CRE][g * 1024 + e]; cci[e] = P.in[I_CIM][g * 1024 + e];
    }
    __syncthreads();
    bf16_t* Kt = (bf16_t*)(P.ws + WS_KT) + (size_t)g * 8448;
    {
        const int pq = tid & 255, p = pq >> 4, q = pq & 15, l0 = (tid >> 8) * 16;
        float val[16];
#pragma unroll
        for (int i = 0; i < 16; ++i) val[i] = 0.f;
#pragma unroll
        for (int n0 = 0; n0 < 64; n0 += 16) {
            float cbr[16], cbi[16];
#pragma unroll
            for (int n = 0; n < 16; ++n) { const float cr = ccr[p * 64 + n0 + n], ci = cci[p * 64 + n0 + n], br = bbr[(n0 + n) * 16 + q], bi = bbi[(n0 + n) * 16 + q]; cbr[n] = cr * br - ci * bi; cbi[n] = cr * bi + ci * br; }
#pragma unroll
            for (int i = 0; i < 16; ++i) {
                const int lg = l0 + i;
#pragma unroll
                for (int n = 0; n < 16; n += 4) {
                    const f32x4 ar = *(const LAS f32x4*)(pwr + lg * 64 + n0 + n), ai = *(const LAS f32x4*)(pwi + lg * 64 + n0 + n);
                    val[i] += cbr[n] * ar.x - cbi[n] * ai.x; val[i] += cbr[n + 1] * ar.y - cbi[n + 1] * ai.y; val[i] += cbr[n + 2] * ar.z - cbi[n + 2] * ai.z; val[i] += cbr[n + 3] * ar.w - cbi[n + 3] * ai.w;
                }
            }
        }
#pragma unroll
        for (int i = 0; i < 16; ++i) Kt[(l0 + i + 1) * 256 + pq] = (bf16_t)(pk2(val[i], 0.f) & 0xffffu);
        if (tid < 256) Kt[tid] = 0;
    }
    bf16_t* F = (bf16_t*)(P.ws + WS_F) + (size_t)g * 65536;
    for (int e8 = tid; e8 < 8192; e8 += NTHR) {
        const int n2 = e8 >> 6, k0 = (e8 & 63) * 8, j = k0 >> 4, q0 = k0 & 15, n = n2 & 63, l = 31 - j;
        const float ar = pwr[l * 64 + n], ai = pwi[l * 64 + n];
        float w[8];
#pragma unroll
        for (int i = 0; i < 8; ++i) { const float br = bbr[n * 16 + q0 + i], bi = bbi[n * 16 + q0 + i]; w[i] = (n2 < 64) ? (ar * br - ai * bi) : (ar * bi + ai * br); }
        u32x4 o; o.x = pk2(w[0], w[1]); o.y = pk2(w[2], w[3]); o.z = pk2(w[4], w[5]); o.w = pk2(w[6], w[7]);
        *(u32x4*)(F + (size_t)e8 * 8) = o;
    }
    bf16_t* E = (bf16_t*)(P.ws + WS_E) + (size_t)g * 65536;
    for (int e8 = tid; e8 < 8192; e8 += NTHR) {
        const int row = e8 >> 4, n20 = (e8 & 15) * 8, t = row >> 4, p = row & 15, n0 = n20 & 63;
        float w[8];
#pragma unroll
        for (int i = 0; i < 8; ++i) { const int n = n0 + i; const float pr = pwr[(t + 1) * 64 + n], pi = pwi[(t + 1) * 64 + n], cr = ccr[p * 64 + n], ci = cci[p * 64 + n];
            w[i] = (n20 < 64) ? (cr * pr - ci * pi) : -(cr * pi + ci * pr); }
        u32x4 o; o.x = pk2(w[0], w[1]); o.y = pk2(w[2], w[3]); o.z = pk2(w[4], w[5]); o.w = pk2(w[6], w[7]);
        *(u32x4*)(E + (size_t)e8 * 8) = o;
    }
    __syncthreads();
}

__device__ __forceinline__ void norm_row_to_bf16(const float* src, const float* gam, bf16_t* dst, int lane) {
    const f32x4* xr = (const f32x4*)src + lane; const f32x4* gr = (const f32x4*)gam + lane;
    f32x4 v[4]; float s = 0.f;
#pragma unroll
    for (int j = 0; j < 4; ++j) { v[j] = xr[64 * j]; s += (v[j].x * v[j].x + v[j].y * v[j].y) + (v[j].z * v[j].z + v[j].w * v[j].w); }
    const float rinv = 1.0f / sqrtf(wave_sum(s) * (1.0f / DM) + EPS);
    u32x2* o = (u32x2*)dst + lane;
#pragma unroll
    for (int j = 0; j < 4; ++j) { const f32x4 g = gr[64 * j]; u32x2 w; w.x = pk2(v[j].x * rinv * g.x, v[j].y * rinv * g.y); w.y = pk2(v[j].z * rinv * g.z, v[j].w * rinv * g.w); o[64 * j] = w; }
}

__device__ __forceinline__ void cvt8(const float* src, bf16_t* dst, size_t i) {
    const f32x4 a = ((const f32x4*)src)[2 * i], b = ((const f32x4*)src)[2 * i + 1];
    u32x4 o; o.x = pk2(a.x, a.y); o.y = pk2(a.z, a.w); o.z = pk2(b.x, b.y); o.w = pk2(b.z, b.w);
    ((u32x4*)dst)[i] = o;
}

__device__ __forceinline__ float wave_max(float m) {
    m = fmaxf(m, __builtin_bit_cast(float, __builtin_amdgcn_update_dpp(0, __builtin_bit_cast(int, m), 0xB1, 0xf, 0xf, true)));
    m = fmaxf(m, __builtin_bit_cast(float, __builtin_amdgcn_update_dpp(0, __builtin_bit_cast(int, m), 0x4E, 0xf, 0xf, true)));
    m = fmaxf(m, __builtin_bit_cast(float, __builtin_amdgcn_update_dpp(0, __builtin_bit_cast(int, m), 0x141, 0xf, 0xf, true)));
    m = fmaxf(m, __builtin_bit_cast(float, __builtin_amdgcn_update_dpp(0, __builtin_bit_cast(int, m), 0x140, 0xf, 0xf, true)));
    u32 x = __builtin_bit_cast(u32, m);
    { u32 b = x; asm volatile("" : "+v"(b)); const auto p = __builtin_amdgcn_permlane16_swap(x, b, false, false); x = p[0] > p[1] ? p[0] : p[1]; }
    { u32 b = x; asm volatile("" : "+v"(b)); const auto p = __builtin_amdgcn_permlane32_swap(x, b, false, false); x = p[0] > p[1] ? p[0] : p[1]; }
    m = __builtin_bit_cast(float, x);
    return m;
}
template <int NR> __device__ __forceinline__ void quant_rows(const Params& P, const int (&rr)[NR], int lane) {
    f32x4 v[NR][4]; float m[NR];
#pragma unroll
    for (int i = 0; i < NR; ++i) {
        const bool isv = rr[i] >= 16384; const int row = isv ? rr[i] - 16384 : rr[i];
        const f32x4* src = (const f32x4*)((isv ? P.in[I_PV] : P.in[I_PU]) + (size_t)row * DM) + lane;
#pragma unroll
        for (int j = 0; j < 4; ++j) v[i][j] = __builtin_nontemporal_load(src + 64 * j);
    }
#pragma unroll
    for (int i = 0; i < NR; ++i) {
        float mm = 0.f;
#pragma unroll
        for (int j = 0; j < 4; ++j) mm = fmaxf(mm, fmaxf(fmaxf(fabsf(v[i][j].x), fabsf(v[i][j].y)), fmaxf(fabsf(v[i][j].z), fabsf(v[i][j].w))));
        m[i] = wave_max(mm);
    }
#pragma unroll
    for (int i = 0; i < NR; ++i) {
        const bool isv = rr[i] >= 16384; const int row = isv ? rr[i] - 16384 : rr[i];
        const float top = isv ? 416.0f : 127.0f;
        const float sc = (m[i] > 0.f) ? m[i] / top : 1.0f, inv = (m[i] > 0.f) ? top / m[i] : 0.f;
        u32x4 w;
#pragma unroll
        for (int j = 0; j < 4; ++j) {
            if (isv) {
                int t = __builtin_amdgcn_cvt_pk_fp8_f32(v[i][j].x * inv, v[i][j].y * inv, 0, false);
                t = __builtin_amdgcn_cvt_pk_fp8_f32(v[i][j].z * inv, v[i][j].w * inv, t, true);
                w[j] = (u32)t;
            } else {
                const int q0 = (int)rintf(v[i][j].x * inv), q1 = (int)rintf(v[i][j].y * inv), q2 = (int)rintf(v[i][j].z * inv), q3 = (int)rintf(v[i][j].w * inv);
                w[j] = (u32)(q0 & 255) | ((u32)(q1 & 255) << 8) | ((u32)(q2 & 255) << 16) | ((u32)(q3 & 255) << 24);
            }
        }
        *(u32x4*)(P.ws + (isv ? WS_PV : WS_PU) + (size_t)row * 1024 + 16 * lane) = w;
        if (lane == 0) ((float*)(P.ws + (isv ? WS_SV : WS_SU)))[row] = sc;
    }
}
template <int NR> __device__ __forceinline__ void xn_rows(const Params& P, const int (&mm)[NR], int lane) {
    bf16_t* xn = (bf16_t*)(P.ws + WS_BUFA);
    f32x4 v[NR][4]; f32x4 g[4];
#pragma unroll
    for (int j = 0; j < 4; ++j) g[j] = ((const f32x4*)P.in[I_N1G])[64 * j + lane];
#pragma unroll
    for (int i = 0; i < NR; ++i) {
        const int m = mm[i];
        const float* src = (m < SEQ) ? P.in[I_X] + (size_t)m * DM : P.in[I_META] + (size_t)((m < SEQ + NMETA) ? (m - SEQ) : 0) * DM;
#pragma unroll
        for (int j = 0; j < 4; ++j) v[i][j] = ((const f32x4*)src)[64 * j + lane];
    }
#pragma unroll
    for (int i = 0; i < NR; ++i) {
        const int m = mm[i];
        float ss = 0.f;
#pragma unroll
        for (int j = 0; j < 4; ++j) ss += (v[i][j].x * v[i][j].x + v[i][j].y * v[i][j].y) + (v[i][j].z * v[i][j].z + v[i][j].w * v[i][j].w);
        float rinv = 1.0f / sqrtf(wave_sum(ss) * (1.0f / DM) + EPS);
        if (m >= SEQ + NMETA) rinv = 0.f;
        u32x2* o = (u32x2*)(xn + (size_t)m * DM) + lane;
#pragma unroll
        for (int j = 0; j < 4; ++j) { u32x2 w; w.x = pk2(v[i][j].x * rinv * g[j].x, v[i][j].y * rinv * g[j].y); w.y = pk2(v[i][j].z * rinv * g[j].z, v[i][j].w * rinv * g[j].w); o[64 * j] = w; }
    }
}
__device__ __forceinline__ void phase_prologue(const Ctx& C, const Params& P) {
    LAS float* scr = (LAS float*)(C.lds + C.wave * 16384);
    const int gw = C.bid * NWAVES + C.wave, NGW = C.G * NWAVES;
    for (int it = gw; it < 16 * 40; it += NGW) transpose_item(P.in[I_WIN], 1024, 1280, (bf16_t*)(P.ws + WS_WIN_T), scr, it, C.lane);
    for (int m = gw; m < MPAD; m += 4 * NGW) {
        if (m + 3 * NGW < MPAD) { const int mm[4] = {m, m + NGW, m + 2 * NGW, m + 3 * NGW}; xn_rows<4>(P, mm, C.lane); }
        else { for (int q = m; q < MPAD; q += NGW) { const int mm[1] = {q}; xn_rows<1>(P, mm, C.lane); } }
    }
}
__device__ __forceinline__ void deferred_a(const Ctx& C0, const Params& P, int ib, int nib) {
    Ctx C = C0; asm volatile("" : "+v"(C.tid), "+v"(C.lane));
    __syncthreads();
    const int nssm = (nib >= 64) ? 32 : 0;
    if (!nssm || ib < 32) { for (int g = ib; g < 32; g += (nssm ? 32 : nib)) ssm_tables(C, P, g); }
    if (nssm && ib < 32) return;
    __syncthreads();
    LAS float* scr = (LAS float*)(C.lds + C.wave * 16384);
    const int gw = (ib - nssm) * NWAVES + C.wave, NGW = (nib - nssm) * NWAVES;
    for (int it = gw; it < 8 * 16; it += NGW) transpose_item(P.in[I_GLUW], 512, 512, (bf16_t*)(P.ws + WS_GLU_T), scr, it, C.lane);
    for (int r = gw; r < 2 * 16384; r += 4 * NGW) {
        if (r + 3 * NGW < 2 * 16384) { const int rr[4] = {r, r + NGW, r + 2 * NGW, r + 3 * NGW}; quant_rows<4>(P, rr, C.lane); }
        else { for (int q = r; q < 2 * 16384; q += NGW) { const int rr[1] = {q}; quant_rows<1>(P, rr, C.lane); } }
    }
    const size_t gt = (size_t)(ib - nssm) * NTHR + C.tid, NT = (size_t)(nib - nssm) * NTHR;
    for (size_t i = gt; i < 262144 / 8; i += NT) cvt8(P.in[I_SUBK], (bf16_t*)(P.ws + WS_SUBK), i);
}
__device__ __forceinline__ void deferred_b(const Ctx& C0, const Params& P, int ib, int nib) {
    Ctx C = C0; asm volatile("" : "+v"(C.tid), "+v"(C.lane));
    __syncthreads();
    LAS float* scr = (LAS float*)(C.lds + C.wave * 16384);
    const int gw = ib * NWAVES + C.wave, NGW = nib * NWAVES;
    constexpr int I_OUT = 16 * 32, I_Q = 16 * 64;
    for (int it = gw; it < I_OUT + I_Q; it += NGW) {
        if (it < I_OUT) transpose_item(P.in[I_WOUT], 1024, 1024, (bf16_t*)(P.ws + WS_WOUT_T), scr, it, C.lane, P.in[I_AOG], P.in[I_SOG], 512);
        else transpose_item(P.in[I_WQ], 1024, 2048, (bf16_t*)(P.ws + WS_WQ_T), scr, it - I_OUT, C.lane, P.in[I_N2G]);
    }
}

__device__ __forceinline__ bf16x8 u_frag(const bf16_t* proj, int ci, int j, int g, int half) {
    const bool ok = (ci == 0) ? (j >= 16) : (ci < NCH);
    int row = (ci == 0) ? (SEQ + j - 16) : ((ci - 1) * 32 + j);
    row = ok ? row : 0;
    const u32x4 w = *(const u32x4*)(proj + (size_t)row * INW + O_U + g * 16 + half * 8);
    u32x4 z; z.x = ok ? w.x : 0u; z.y = ok ? w.y : 0u; z.z = ok ? w.z : 0u; z.w = ok ? w.w : 0u;
    return __builtin_bit_cast(bf16x8, z);
}

constexpr int F_PITCH = 1040;
__device__ __forceinline__ void phase_sloc(const Ctx& C, const Params& P) {
    const bf16_t* proj = (const bf16_t*)(P.ws + WS_PROJ);
    float* SL = (float*)(P.ws + WS_SLOC);
    const int n = C.lane & 15, kq = C.lane >> 4;
    for (int bu = C.bid; bu < 160; bu += C.G) {
        const int g = bu / 5, qtr = bu % 5, s = qtr * 8 + C.wave, ci = 16 * s + n;
        bf16x8 Bf[16];
#pragma unroll
        for (int ks = 0; ks < 16; ++ks) Bf[ks] = u_frag(proj, (s < 33) ? ci : NCH, 2 * ks + (kq >> 1), g, kq & 1);
        __syncthreads();
        { const u32x4* src = (const u32x4*)((const bf16_t*)(P.ws + WS_F) + (size_t)g * 65536);
          u32x4 t[16];
#pragma unroll
          for (int i = 0; i < 16; ++i) t[i] = src[C.tid + NTHR * i];
#pragma unroll
          for (int i = 0; i < 16; ++i) { const int e = C.tid + NTHR * i; *(LAS u32x4*)(C.lds + (e >> 6) * F_PITCH + (e & 63) * 16) = t[i]; } }
        __syncthreads();
        if (s < 33) {
#pragma unroll 1
            for (int mt = 0; mt < 8; ++mt) {
                f32x4 acc = {0.f, 0.f, 0.f, 0.f};
#pragma unroll
                for (int ks = 0; ks < 16; ++ks) {
                    const bf16x8 A = *(const LAS bf16x8*)(C.lds + (mt * 16 + n) * F_PITCH + (32 * ks + 8 * kq) * 2);
                    acc = MFMA16(A, Bf[ks], acc);
                }
                if (ci < NCH) *(f32x4*)(SL + ((size_t)ci * 32 + g) * 128 + mt * 16 + 4 * kq) = acc;
            }
        }
    }
}

__device__ __forceinline__ void carry_scan_block(const Ctx& C, const Params& P, int bk) {
    const float* SL = (const float*)(P.ws + WS_SLOC);
    float* CA = (float*)(P.ws + WS_CARRY);
    LAS float* Lr = (LAS float*)C.lds;
    LAS float* Li = Lr + 512;
    const int chan = bk * 32 + (C.tid & 31), g = chan >> 6, n = chan & 63, sg = C.tid >> 5;
    const float* abt = (const float*)(P.ws + WS_ABART) + (g * 64 + n) * 2;
    const float ar = abt[0], ai = abt[1];
    float sr = 0.f, si = 0.f;
#pragma unroll 8
    for (int i = 0; i < 32; ++i) {
        const int ci = 32 * sg + i; const size_t o = ((size_t)ci * 32 + g) * 128 + n;
        const float br = SL[o], bi = SL[o + 64];
        const float tr = ar * sr - ai * si + br, ti = ar * si + ai * sr + bi; sr = tr; si = ti;
    }
    Lr[sg * 32 + (C.tid & 31)] = sr; Li[sg * 32 + (C.tid & 31)] = si;
    float pr = ar, pi = ai;
#pragma unroll
    for (int k = 0; k < 5; ++k) { const float tr = pr * pr - pi * pi, ti = 2.f * pr * pi; pr = tr; pi = ti; }
    __syncthreads();
    float cr = 0.f, ci_ = 0.f;
    for (int s2 = 0; s2 < sg; ++s2) { const float lr = Lr[s2 * 32 + (C.tid & 31)], li = Li[s2 * 32 + (C.tid & 31)];
        const float tr = pr * cr - pi * ci_ + lr, ti = pr * ci_ + pi * cr + li; cr = tr; ci_ = ti; }
    sr = cr; si = ci_;
#pragma unroll 8
    for (int i = 0; i < 32; ++i) {
        const int ci = 32 * sg + i; const size_t o = ((size_t)ci * 32 + g) * 128 + n;
        CA[o] = sr; CA[o + 64] = si;
        const float br = SL[o], bi = SL[o + 64];
        const float tr = ar * sr - ai * si + br, ti = ar * si + ai * sr + bi; sr = tr; si = ti;
    }
    if (sg == 15) { const size_t o = ((size_t)512 * 32 + g) * 128 + n; CA[o] = sr; CA[o + 64] = si; }
    __syncthreads();
}

constexpr int E_OFF = 16896, E_PITCH = 272;
__device__ __forceinline__ void phase_ssm_y(const Ctx& C, const Params& P) {
    const bf16_t* proj = (const bf16_t*)(P.ws + WS_PROJ);
    const float* CA = (const float*)(P.ws + WS_CARRY);
    bf16_t* Z = (bf16_t*)(P.ws + WS_Z);
    const int n = C.lane & 15, kq = C.lane >> 4;
    for (int bu = C.bid; bu < 256; bu += C.G) {
        const int g = bu >> 3, cq = bu & 7;
        __syncthreads();
        { const u32x4* src = (const u32x4*)((const bf16_t*)(P.ws + WS_KT) + (size_t)g * 8448); LAS u32x4* dst = (LAS u32x4*)C.lds;
          for (int e = C.tid; e < 1056; e += NTHR) dst[e] = src[e];
          const u32x4* esrc = (const u32x4*)((const bf16_t*)(P.ws + WS_E) + (size_t)g * 65536);
          u32x4 t[16];
#pragma unroll
          for (int i = 0; i < 16; ++i) t[i] = esrc[C.tid + NTHR * i];
#pragma unroll
          for (int i = 0; i < 16; ++i) { const int e = C.tid + NTHR * i; *(LAS u32x4*)(C.lds + E_OFF + (e >> 4) * E_PITCH + (e & 15) * 16) = t[i]; } }
        __syncthreads();
        const int ci = 1 + 64 * cq + 16 * (C.wave >> 1) + n, par = C.wave & 1;
        bf16x8 Uf[16], Cf[4];
#pragma unroll
        for (int ks = 0; ks < 16; ++ks) Uf[ks] = u_frag(proj, ci, 2 * ks + (kq >> 1), g, kq & 1);
#pragma unroll
        for (int k2 = 0; k2 < 4; ++k2) {
            const float* cp = CA + ((size_t)ci * 32 + g) * 128 + 32 * k2 + 8 * kq;
            const f32x4 a = *(const f32x4*)cp, b = *(const f32x4*)(cp + 4);
            u32x4 w; w.x = pk2(a.x, a.y); w.y = pk2(a.z, a.w); w.z = pk2(b.x, b.y); w.w = pk2(b.z, b.w);
            Cf[k2] = __builtin_bit_cast(bf16x8, w);
        }
        const f32x4 dv = *(const f32x4*)(P.in[I_SD] + g * 16 + 4 * kq);
        u32x2 uwp[16];
#pragma unroll
        for (int tt = 0; tt < 16; ++tt) uwp[tt] = *(const u32x2*)(proj + (size_t)((ci - 1) * 32 + 2 * tt + par) * INW + O_U + g * 16 + 4 * kq);
        const LAS unsigned char* eb0 = C.lds + E_OFF + (par * 16 + n) * E_PITCH + 16 * kq;
        const LAS unsigned char* eb1 = eb0 + 8 * 2 * 16 * E_PITCH;
        const LAS unsigned char* kb0 = C.lds + ((par - (kq >> 1) + 1) * 16 + n) * 32 + 16 * (kq & 1);
#pragma unroll
        for (int tt = 0; tt < 16; ++tt) {
            const int t = 2 * tt + par;
            f32x4 acc = {0.f, 0.f, 0.f, 0.f};
#pragma unroll
            for (int k2 = 0; k2 < 4; ++k2) {
                const bf16x8 A = *(const LAS bf16x8*)((tt < 8 ? eb0 + tt * 2 * 16 * E_PITCH : eb1 + (tt - 8) * 2 * 16 * E_PITCH) + 64 * k2);
                acc = MFMA16(A, Cf[k2], acc);
            }
#pragma unroll
            for (int ks = 0; ks < 16; ++ks) {
                if (ks <= tt) {
                    const bf16x8 A = *(const LAS bf16x8*)(kb0 + (tt - ks) * 1024);
                    acc = MFMA16(A, Uf[ks], acc);
                }
            }
            const int row = (ci - 1) * 32 + t, ch = g * 16 + 4 * kq;
            const u32x2 uw = uwp[tt];
            const float y0 = acc.x + dv.x * bflo(uw.x), y1 = acc.y + dv.y * bfhi(uw.x), y2 = acc.z + dv.z * bflo(uw.y), y3 = acc.w + dv.w * bfhi(uw.y);
            const pg8::f32x2 ga = pg8::gelu_pk((pg8::f32x2){y0, y1}), gb = pg8::gelu_pk((pg8::f32x2){y2, y3});
            u32x2 o; o.x = pk2(ga.x, ga.y); o.y = pk2(gb.x, gb.y);
            *(u32x2*)(Z + (size_t)row * 512 + ch) = o;
            __builtin_amdgcn_sched_barrier(0);
        }
    }
}

constexpr int VT_PITCH = 296;
__device__ __forceinline__ void attn_unit(const Ctx& C, const Params& P, int b, int hk) {
    const bf16_t* proj = (const bf16_t*)(P.ws + WS_PROJ);
    bf16_t* AO = (bf16_t*)(P.ws + WS_BUFA);
    float* SSA = (float*)(P.ws + WS_SSA);
    LAS unsigned char* Ks = C.lds;
    LAS bf16_t* Vt = (LAS bf16_t*)(C.lds + 288 * 128);
    __syncthreads();
    for (int e = C.tid; e < 288 * 8; e += NTHR) {
        const int key = e >> 3, ch = e & 7;
        int row = -1;
        if (key < 256) { const int j = (b - 1) * 128 + key; if (j >= 0) row = j; } else if (key < 272) row = SEQ + key - 256;
        u32x4 kw = {0u, 0u, 0u, 0u}, vw = {0u, 0u, 0u, 0u};
        if (row >= 0) { kw = *(const u32x4*)(proj + (size_t)row * INW + O_K + hk * 64 + ch * 8); vw = *(const u32x4*)(proj + (size_t)row * INW + O_V + hk * 64 + ch * 8); }
        float kf[8] = {bflo(kw.x), bfhi(kw.x), bflo(kw.y), bfhi(kw.y), bflo(kw.z), bfhi(kw.z), bflo(kw.w), bfhi(kw.w)};
        float ss = 0.f;
#pragma unroll
        for (int i = 0; i < 8; ++i) ss += kf[i] * kf[i];
        ss += __shfl_xor(ss, 1); ss += __shfl_xor(ss, 2); ss += __shfl_xor(ss, 4);
        const float rinv = 1.0f / sqrtf(ss * (1.0f / 64.0f) + EPS);
        const f32x4 g0 = *(const f32x4*)(P.in[I_KNG] + ch * 8), g1 = *(const f32x4*)(P.in[I_KNG] + ch * 8 + 4);
        u32x4 o; o.x = pk2(kf[0] * rinv * g0.x, kf[1] * rinv * g0.y); o.y = pk2(kf[2] * rinv * g0.z, kf[3] * rinv * g0.w);
        o.z = pk2(kf[4] * rinv * g1.x, kf[5] * rinv * g1.y); o.w = pk2(kf[6] * rinv * g1.z, kf[7] * rinv * g1.w);
        *(LAS u32x4*)(Ks + key * 128 + ((ch ^ (key & 7)) * 16)) = o;
        const unsigned vv[4] = {vw.x, vw.y, vw.z, vw.w};
#pragma unroll
        for (int i = 0; i < 4; ++i) { Vt[(ch * 8 + 2 * i) * VT_PITCH + key] = (bf16_t)(vv[i] & 0xffffu); Vt[(ch * 8 + 2 * i + 1) * VT_PITCH + key] = (bf16_t)(vv[i] >> 16); }
    }
    __syncthreads();
    const int c = C.lane & 31, h = C.lane >> 5;
#pragma unroll 1
    for (int ti = C.wave; ti < 16; ti += NWAVES) {
        const int hql = ti >> 2, wq = ti & 3, hq = hk * 4 + hql;
        const int qi = wq * 32 + c, tok = b * 128 + qi;
        bf16x8 qf[4];
        {
            u32x4 qw[4]; float ss = 0.f;
#pragma unroll
            for (int ks = 0; ks < 4; ++ks) { qw[ks] = *(const u32x4*)(proj + (size_t)tok * INW + hq * 64 + 16 * ks + 8 * h);
                const unsigned w[4] = {qw[ks].x, qw[ks].y, qw[ks].z, qw[ks].w};
#pragma unroll
                for (int i = 0; i < 4; ++i) { const float a = bflo(w[i]), bb = bfhi(w[i]); ss += a * a + bb * bb; } }
            ss += __shfl_xor(ss, 32);
            const float rinv = (1.0f / sqrtf(ss * (1.0f / 64.0f) + EPS)) * (0.125f * LOG2E);
#pragma unroll
            for (int ks = 0; ks < 4; ++ks) {
                const f32x4 g0 = *(const f32x4*)(P.in[I_QNG] + 16 * ks + 8 * h), g1 = *(const f32x4*)(P.in[I_QNG] + 16 * ks + 8 * h + 4);
                u32x4 o; o.x = pk2(bflo(qw[ks].x) * rinv * g0.x, bfhi(qw[ks].x) * rinv * g0.y); o.y = pk2(bflo(qw[ks].y) * rinv * g0.z, bfhi(qw[ks].y) * rinv * g0.w);
                o.z = pk2(bflo(qw[ks].z) * rinv * g1.x, bfhi(qw[ks].z) * rinv * g1.y); o.w = pk2(bflo(qw[ks].w) * rinv * g1.z, bfhi(qw[ks].w) * rinv * g1.w);
                qf[ks] = __builtin_bit_cast(bf16x8, o);
            }
        }
        f32x16 S[6];
#pragma unroll
        for (int rb = 0; rb < 6; ++rb) {
            const int kb = (rb < 5) ? (wq + rb) : 8;
            const int key = kb * 32 + c;
            f32x16 acc = {0.f, 0.f, 0.f, 0.f, 0.f, 0.f, 0.f, 0.f, 0.f, 0.f, 0.f, 0.f, 0.f, 0.f, 0.f, 0.f};
#pragma unroll
            for (int ks = 0; ks < 4; ++ks) {
                const bf16x8 A = *(const LAS bf16x8*)(Ks + key * 128 + (((2 * ks + h) ^ (key & 7)) * 16));
                acc = MFMA32(A, qf[ks], acc);
            }
            S[rb] = acc;
            __builtin_amdgcn_sched_barrier(0);
        }
        const float sl = P.in[I_SINK][hq] * LOG2E;
        float mx = sl;
#pragma unroll
        for (int r = 0; r < 16; ++r) {
            const int kr = (r & 3) + 8 * (r >> 2) + 4 * h;
            const bool gt = kr > c;
            S[0][r] = gt ? S[0][r] : -1e30f;
            S[4][r] = gt ? -1e30f : S[4][r];
            if (r >= 8) S[5][r] = -1e30f;
        }
        if (b == 0) {
#pragma unroll
            for (int rb = 0; rb < 4; ++rb) if (wq + rb < 4) {
#pragma unroll
                for (int r = 0; r < 16; ++r) S[rb][r] = -1e30f;
            }
        }
#pragma unroll
        for (int rb = 0; rb < 6; ++rb)
#pragma unroll
            for (int r = 0; r < 16; ++r) mx = fmaxf(mx, S[rb][r]);
        mx = fmaxf(mx, __shfl_xor(mx, 32));
        float lsum = 0.f;
#pragma unroll
        for (int rb = 0; rb < 6; ++rb)
#pragma unroll
            for (int r = 0; r < 16; ++r) { const float p = __builtin_amdgcn_exp2f(S[rb][r] - mx); S[rb][r] = p; lsum += p; }
        lsum += __shfl_xor(lsum, 32);
        lsum += __builtin_amdgcn_exp2f(sl - mx);
        const float linv = 1.0f / lsum;
        f32x16 O[2];
#pragma unroll
        for (int db = 0; db < 2; ++db) O[db] = (f32x16){0.f, 0.f, 0.f, 0.f, 0.f, 0.f, 0.f, 0.f, 0.f, 0.f, 0.f, 0.f, 0.f, 0.f, 0.f, 0.f};
#pragma unroll
        for (int rb = 0; rb < 6; ++rb) {
            const int kb = (rb < 5) ? (wq + rb) : 8;
#pragma unroll
            for (int s = 0; s < 2; ++s) {
                if (rb == 5 && s == 1) continue;
                u32x4 pw; pw.x = pk2(S[rb][8 * s + 0], S[rb][8 * s + 1]); pw.y = pk2(S[rb][8 * s + 2], S[rb][8 * s + 3]);
                pw.z = pk2(S[rb][8 * s + 4], S[rb][8 * s + 5]); pw.w = pk2(S[rb][8 * s + 6], S[rb][8 * s + 7]);
                const bf16x8 Pf = __builtin_bit_cast(bf16x8, pw);
#pragma unroll
                for (int db = 0; db < 2; ++db) {
                    const LAS bf16_t* vp = Vt + (db * 32 + c) * VT_PITCH + kb * 32 + 16 * s + 4 * h;
                    const u32x2 lo = *(const LAS u32x2*)vp, hi2 = *(const LAS u32x2*)(vp + 8);
                    u32x4 vw; vw.x = lo.x; vw.y = lo.y; vw.z = hi2.x; vw.w = hi2.y;
                    O[db] = MFMA32(__builtin_bit_cast(bf16x8, vw), Pf, O[db]);
                }
                __builtin_amdgcn_sched_barrier(0);
            }
        }
        float ssq = 0.f;
#pragma unroll
        for (int db = 0; db < 2; ++db)
#pragma unroll
            for (int gq = 0; gq < 4; ++gq) {
                const float o0 = O[db][4 * gq] * linv, o1 = O[db][4 * gq + 1] * linv, o2 = O[db][4 * gq + 2] * linv, o3 = O[db][4 * gq + 3] * linv;
                ssq += (o0 * o0 + o1 * o1) + (o2 * o2 + o3 * o3);
                u32x2 o; o.x = pk2(o0, o1); o.y = pk2(o2, o3);
                *(u32x2*)(AO + (size_t)tok * 1024 + hq * 64 + db * 32 + 8 * gq + 4 * h) = o;
            }
        ssq += __shfl_xor(ssq, 32);
        if (h == 0) SSA[(size_t)tok * 8 + hq] = ssq;
    }
}

struct EpiGlu {
    static constexpr bool PERM = true, AFTER_DRAIN = false, HAS_MID = false;
    const bf16_t* Z; bf16_t* O; const float* bias; float* SSS;
    __device__ __forceinline__ void operator()(const pg8::f32x4 (&acc)[2][2][4][2], const pg8::Unit& u, int wr, int wc, int fr, int fq) const {
        const int row0 = u.pm * 256 + wr * 64 + fr, col0 = u.pn * 256 + wc * 32 + 8 * fq;
        f32x4 bb[2][2];
#pragma unroll
        for (int bj = 0; bj < 2; ++bj) { bb[bj][0] = *(const f32x4*)(bias + col0 + bj * 128); bb[bj][1] = *(const f32x4*)(bias + col0 + bj * 128 + 4); }
#pragma unroll
        for (int ai = 0; ai < 2; ++ai) {
            u32x4 zw[4][2];
#pragma unroll
            for (int m = 0; m < 4; ++m)
#pragma unroll
                for (int bj = 0; bj < 2; ++bj) zw[m][bj] = *(const u32x4*)(Z + (size_t)(row0 + ai * 128 + m * 16) * 512 + col0 + bj * 128);
#pragma unroll
            for (int m = 0; m < 4; ++m) {
                const int row = row0 + ai * 128 + m * 16; float ssq = 0.f;
#pragma unroll
                for (int bj = 0; bj < 2; ++bj) {
                    const f32x4 b0 = bb[bj][0], b1 = bb[bj][1]; const u32x4 z4 = zw[m][bj];
                    const pg8::f32x4 v0 = acc[ai][bj][m][0], v1 = acc[ai][bj][m][1];
                    const float zf[8] = {bflo(z4.x), bfhi(z4.x), bflo(z4.y), bfhi(z4.y), bflo(z4.z), bfhi(z4.z), bflo(z4.w), bfhi(z4.w)};
                    const float pre[8] = {v0[0] + b0.x, v0[1] + b0.y, v0[2] + b0.z, v0[3] + b0.w, v1[0] + b1.x, v1[1] + b1.y, v1[2] + b1.z, v1[3] + b1.w};
                    float r[8];
#pragma unroll
                    for (int i = 0; i < 8; ++i) { r[i] = zf[i] * __builtin_amdgcn_rcpf(1.0f + __expf(-pre[i])); ssq += r[i] * r[i]; }
                    u32x4 o; o.x = pk2(r[0], r[1]); o.y = pk2(r[2], r[3]); o.z = pk2(r[4], r[5]); o.w = pk2(r[6], r[7]);
                    *(u32x4*)(O + (size_t)row * 1024 + 512 + col0 + bj * 128) = o;
                }
                ssq += __shfl_xor(ssq, 16); ssq += __shfl_xor(ssq, 32);
                if (fq == 0) SSS[(size_t)row * 8 + u.pn * 4 + wc] = ssq;
            }
        }
    }
};
constexpr int FAC_OFF = 131072;
struct EpiMix {
    static constexpr bool PERM = true, AFTER_DRAIN = false, HAS_MID = true;
    const float* X; bf16_t* HB; float* SSH;
    __device__ __forceinline__ void mid(pg8::f32x4 (&acc)[2][2][4][2], const pg8::Unit& u, int wr, int wc, int fr, int fq, LAS unsigned char* lds) const {
#pragma unroll
        for (int ai = 0; ai < 2; ++ai)
#pragma unroll
            for (int m = 0; m < 4; ++m) {
                const float f = ((const LAS float*)(lds + FAC_OFF))[2 * (ai * 128 + wr * 64 + m * 16 + fr)];
#pragma unroll
                for (int bj = 0; bj < 2; ++bj)
#pragma unroll
                    for (int n = 0; n < 2; ++n) acc[ai][bj][m][n] *= f;
            }
    }
    __device__ __forceinline__ void operator()(const pg8::f32x4 (&acc)[2][2][4][2], const pg8::Unit& u, int wr, int wc, int fr, int fq) const {
        extern __shared__ __attribute__((aligned(16))) unsigned char lds_raw_[];
        const LAS float* fac = (const LAS float*)((LAS unsigned char*)lds_raw_ + FAC_OFF);
        const int col0 = u.pn * 256 + wc * 32 + 8 * fq;
#pragma unroll
        for (int ai = 0; ai < 2; ++ai) {
            f32x4 xv[4][2][2];
#pragma unroll
            for (int m = 0; m < 4; ++m)
#pragma unroll
                for (int bj = 0; bj < 2; ++bj) { const size_t off = (size_t)(u.pm * 256 + ai * 128 + wr * 64 + m * 16 + fr) * 1024 + col0 + bj * 128;
                    xv[m][bj][0] = *(const f32x4*)(X + off); xv[m][bj][1] = *(const f32x4*)(X + off + 4); }
#pragma unroll
            for (int m = 0; m < 4; ++m) {
                const int rl = ai * 128 + wr * 64 + m * 16 + fr, row = u.pm * 256 + rl;
                const float rs = fac[2 * rl + 1]; float ssq = 0.f;
#pragma unroll
                for (int bj = 0; bj < 2; ++bj) {
                    const size_t off = (size_t)row * 1024 + col0 + bj * 128;
                    const f32x4 x0 = xv[m][bj][0], x1 = xv[m][bj][1];
                    const pg8::f32x4 v0 = acc[ai][bj][m][0], v1 = acc[ai][bj][m][1];
                    const float hv[8] = {x0.x + rs * v0[0], x0.y + rs * v0[1], x0.z + rs * v0[2], x0.w + rs * v0[3], x1.x + rs * v1[0], x1.y + rs * v1[1], x1.z + rs * v1[2], x1.w + rs * v1[3]};
#pragma unroll
                    for (int i = 0; i < 8; ++i) ssq += hv[i] * hv[i];
                    u32x4 o; o.x = pk2(hv[0], hv[1]); o.y = pk2(hv[2], hv[3]); o.z = pk2(hv[4], hv[5]); o.w = pk2(hv[6], hv[7]);
                    *(u32x4*)(HB + off) = o;
                }
                ssq += __shfl_xor(ssq, 16); ssq += __shfl_xor(ssq, 32);
                if (fq == 0) SSH[(size_t)row * 16 + u.pn * 4 + wc] = ssq;
            }
        }
    }
};
struct EpiQ {
    static constexpr bool PERM = true, AFTER_DRAIN = false, HAS_MID = false;
    bf16_t* O; int pm0;
    __device__ __forceinline__ void operator()(const pg8::f32x4 (&acc)[2][2][4][2], const pg8::Unit& u, int wr, int wc, int fr, int fq) const {
        extern __shared__ __attribute__((aligned(16))) unsigned char lds_raw_q[];
        const LAS float* rq = (const LAS float*)((LAS unsigned char*)lds_raw_q + FAC_OFF) + ((u.pm == pm0) ? 0 : 256);
        const int col0 = u.pn * 256 + wc * 32 + 8 * fq;
#pragma unroll
        for (int ai = 0; ai < 2; ++ai)
#pragma unroll
            for (int m = 0; m < 4; ++m) {
                const int rl = ai * 128 + wr * 64 + m * 16 + fr, row = u.pm * 256 + rl; const float r = rq[rl];
#pragma unroll
                for (int bj = 0; bj < 2; ++bj) {
                    const pg8::f32x4 v0 = acc[ai][bj][m][0], v1 = acc[ai][bj][m][1];
                    u32x4 o; o.x = pk2(v0[0] * r, v0[1] * r); o.y = pk2(v0[2] * r, v0[3] * r); o.z = pk2(v1[0] * r, v1[1] * r); o.w = pk2(v1[2] * r, v1[3] * r);
                    *(u32x4*)(O + (size_t)row * 2048 + col0 + bj * 128) = o;
                }
            }
    }
};

constexpr int IG_OFF = 67584;
__device__ __forceinline__ void peer_topk_tile(const Ctx& C, const Params& P, int tok0) {
    const bf16_t* QP = (const bf16_t*)(P.ws + WS_QP);
    const bf16_t* SK = (const bf16_t*)(P.ws + WS_SUBK);
    LAS int* IDXL = (LAS int*)(C.lds + IG_OFF); LAS float* GWL = (LAS float*)(C.lds + IG_OFF + 32768);
    LAS u32* lists = (LAS u32*)C.lds;
    const int c = C.lane & 31, h = C.lane >> 5;
    __syncthreads();
#pragma unroll 1
    for (int hs = C.wave; hs < 16; hs += NWAVES) {
        bf16x8 qf[2][8];
#pragma unroll
        for (int tg = 0; tg < 2; ++tg) { const bf16_t* qrow = QP + (size_t)(tok0 + tg * 32 + c) * 2048 + hs * 128;
#pragma unroll
            for (int ks = 0; ks < 8; ++ks) qf[tg][ks] = *(const bf16x8*)(qrow + 16 * ks + 8 * h); }
        u32 best[2][16];
#pragma unroll 1
        for (int kb = 0; kb < 4; ++kb) {
            bf16x8 kf[8];
            const bf16_t* krow = SK + (size_t)(hs * 128 + kb * 32 + c) * 128;
#pragma unroll
            for (int ks = 0; ks < 8; ++ks) kf[ks] = *(const bf16x8*)(krow + 16 * ks + 8 * h);
            f32x16 acc0 = {0.f, 0.f, 0.f, 0.f, 0.f, 0.f, 0.f, 0.f, 0.f, 0.f, 0.f, 0.f, 0.f, 0.f, 0.f, 0.f}, acc1 = acc0;
#pragma unroll
            for (int ks = 0; ks < 8; ++ks) { acc0 = MFMA32(kf[ks], qf[0][ks], acc0); acc1 = MFMA32(kf[ks], qf[1][ks], acc1); }
            u32 g0[16], g1[16];
#pragma unroll
            for (int r = 0; r < 16; ++r) { const u32 kx = (u32)(127 - (kb * 32 + (r & 3) + 8 * (r >> 2) + 4 * h));
                g0[r] = (f2ord(acc0[r]) & ~0x7Fu) | kx; g1[r] = (f2ord(acc1[r]) & ~0x7Fu) | kx; }
            sort16_desc(g0); sort16_desc(g1);
            if (kb == 0) {
#pragma unroll
                for (int i = 0; i < 16; ++i) { best[0][i] = g0[i]; best[1][i] = g1[i]; }
            } else { merge_top16(best[0], g0); merge_top16(best[1], g1); }
        }
#pragma unroll
        for (int tg = 0; tg < 2; ++tg) {
            u32 pb[16];
#pragma unroll
            for (int i = 0; i < 16; ++i) pb[i] = (u32)__shfl_xor((int)best[tg][i], 32);
            merge_top16(best[tg], pb);
            if (h == 0) {
                LAS u32x4* dst = (LAS u32x4*)(lists + (tg * 32 + c) * 260 + hs * 16);
#pragma unroll
                for (int i = 0; i < 4; ++i) { u32x4 w; w.x = best[tg][4 * i]; w.y = best[tg][4 * i + 1]; w.z = best[tg][4 * i + 2]; w.w = best[tg][4 * i + 3]; dst[i] = w; }
            }
        }
    }
    __syncthreads();
    {
        const int tl = C.tid & 63, hd = C.tid >> 6;
        const LAS u32* L1 = lists + tl * 260 + hd * 32; const LAS u32* L2 = L1 + 16;
        float v1[16], v2[16];
#pragma unroll
        for (int i = 0; i < 16; ++i) { v1[i] = ord2f(L1[i] & ~0x7Fu); v2[i] = ord2f(L2[i] & ~0x7Fu); }
        u32 cd[4][16];
        { int cid = 0;
#pragma unroll
          for (int a = 0; a < 16; ++a)
#pragma unroll
              for (int b = 0; b < 16; ++b) if ((a + 1) * (b + 1) <= 16) { cd[cid >> 4][cid & 15] = (f2ord(v1[a] + v2[b]) & ~0x3Fu) | (u32)(63 - cid); ++cid; }
#pragma unroll
          for (int k = 50; k < 64; ++k) cd[k >> 4][k & 15] = 0u; }
        top16_of_64(cd[0], cd[1], cd[2], cd[3]);
        float sc[16]; int ix[16]; float mx = -1e30f;
#pragma unroll
        for (int k = 0; k < 16; ++k) {
            const int cid = 63 - (int)(cd[0][k] & 63u); const int ab = CAND_AB[cid];
            const u32 k1 = L1[ab >> 4], k2 = L2[ab & 15];
            sc[k] = ord2f(k1 & ~0x7Fu) + ord2f(k2 & ~0x7Fu);
            ix[k] = (127 - (int)(k1 & 0x7Fu)) * 128 + (127 - (int)(k2 & 0x7Fu));
            mx = fmaxf(mx, sc[k]);
        }
        float sum = 0.f;
#pragma unroll
        for (int k = 0; k < 16; ++k) { sc[k] = __expf(sc[k] - mx); sum += sc[k]; }
        const float inv = 1.0f / sum;
        LAS int* io = IDXL + tl * 128 + hd * 16; LAS float* go = GWL + tl * 128 + hd * 16;
#pragma unroll
        for (int k = 0; k < 16; ++k) { io[k] = ix[k]; go[k] = sc[k] * inv; }
    }
    __syncthreads();
}

template <int J> __device__ __forceinline__ u32 xor_lane(u32 v, int lane) {
    if constexpr (J == 1) return (u32)__builtin_amdgcn_update_dpp(0, (int)v, 0xB1, 0xf, 0xf, true);
    else if constexpr (J == 2) return (u32)__builtin_amdgcn_update_dpp(0, (int)v, 0x4E, 0xf, 0xf, true);
    else if constexpr (J == 4) { int t = __builtin_amdgcn_update_dpp(0, (int)v, 0x104, 0xf, 0x5, false); return (u32)__builtin_amdgcn_update_dpp(t, (int)v, 0x114, 0xf, 0xA, false); }
    else if constexpr (J == 8) return (u32)__builtin_amdgcn_update_dpp(0, (int)v, 0x128, 0xf, 0xf, true);
    else if constexpr (J == 16) { u32 b = v; asm volatile("" : "+v"(b)); const auto p = __builtin_amdgcn_permlane16_swap(v, b, false, false); return (lane & 16) ? p[0] : p[1]; }
    else { u32 b = v; asm volatile("" : "+v"(b)); const auto p = __builtin_amdgcn_permlane32_swap(v, b, false, false); return (lane & 32) ? p[0] : p[1]; }
}
__device__ __forceinline__ int reduce64(int (&r)[64], int lane) {
#pragma unroll
    for (int e = 0; e < 32; ++e) { const auto p = __builtin_amdgcn_permlane32_swap((u32)r[e], (u32)r[e + 32], false, false); r[e] = (int)p[0] + (int)p[1]; }
#pragma unroll
    for (int e = 0; e < 16; ++e) { const auto p = __builtin_amdgcn_permlane16_swap((u32)r[e], (u32)r[e + 16], false, false); r[e] = (int)p[0] + (int)p[1]; }
    const bool b3 = (lane & 8) != 0, b2 = (lane & 4) != 0, b1 = (lane & 2) != 0, b0 = (lane & 1) != 0;
#pragma unroll
    for (int e = 0; e < 8; ++e) { const int keep = b3 ? r[e + 8] : r[e], send = b3 ? r[e] : r[e + 8]; r[e] = keep + __builtin_amdgcn_update_dpp(0, send, 0x128, 0xf, 0xf, true); }
#pragma unroll
    for (int e = 0; e < 4; ++e) { const int keep = b2 ? r[e + 4] : r[e], send = b2 ? r[e] : r[e + 4];
        int t = __builtin_amdgcn_update_dpp(0, send, 0x104, 0xf, 0x5, false);
        t = __builtin_amdgcn_update_dpp(t, send, 0x114, 0xf, 0xA, false);
        r[e] = keep + t; }
#pragma unroll
    for (int e = 0; e < 2; ++e) { const int keep = b1 ? r[e + 2] : r[e], send = b1 ? r[e] : r[e + 2]; r[e] = keep + __builtin_amdgcn_update_dpp(0, send, 0x4E, 0xf, 0xf, true); }
    { const int keep = b0 ? r[1] : r[0], send = b0 ? r[0] : r[1]; r[0] = keep + __builtin_amdgcn_update_dpp(0, send, 0xB1, 0xf, 0xf, true); }
    return r[0];
}
constexpr int GQ_LDS_PER_WAVE = 8192;
#define GQ_FMA16(A, ce, w) do { _Pragma("unroll") for (int j_ = 0; j_ < 4; ++j_) { \
        const f32x2_t lo_ = __builtin_amdgcn_cvt_pk_f32_fp8((int)(w)[j_], false), hi_ = __builtin_amdgcn_cvt_pk_f32_fp8((int)(w)[j_], true); \
        A[4 * j_ + 0] += (ce) * lo_.x; A[4 * j_ + 1] += (ce) * lo_.y; A[4 * j_ + 2] += (ce) * hi_.x; A[4 * j_ + 3] += (ce) * hi_.y; } } while (0)
__device__ __forceinline__ void peer_gather_quad(const Ctx& C, const Params& P, int tokq) {
    const bf16_t* HN = (const bf16_t*)(P.ws + WS_HB); const float* SSH = (const float*)(P.ws + WS_SSH);
    const unsigned char* PU = P.ws + WS_PU; const unsigned char* PV = P.ws + WS_PV;
    const float* SU = (const float*)(P.ws + WS_SU); const float* SV = (const float*)(P.ws + WS_SV);
    const LAS int* IDXL = (const LAS int*)(C.lds + IG_OFF); const LAS float* GWL = (const LAS float*)(C.lds + IG_OFF + 32768); const int tl0 = tokq & 63;
    const int lane = C.lane;
    LAS unsigned char* qhl = C.lds + C.wave * GQ_LDS_PER_WAVE;
    LAS u32* keyl = (LAS u32*)(qhl + 4096);
    u32 k[8];
#pragma unroll
    for (int s = 0; s < 4; ++s)
#pragma unroll
        for (int hb = 0; hb < 2; ++hb) k[2 * s + hb] = ((u32)IDXL[(tl0 + s) * 128 + 64 * hb + lane] << 9) | (u32)(s << 7) | (u32)(64 * hb + lane);
#pragma unroll
    for (int size = 2; size <= 512; size <<= 1) {
#pragma unroll
        for (int j = size >> 1; j > 0; j >>= 1) {
            u32 nk[8];
#pragma unroll
            for (int r = 0; r < 8; ++r) {
                const int ii = lane + 64 * r;
                const bool asc = (ii & size) == 0, lower = (ii & j) == 0;
                const u32 mine = k[r];
                u32 other;
                if (j >= 64) other = k[r ^ (j >> 6)];
                else if (j == 1) other = xor_lane<1>(mine, lane); else if (j == 2) other = xor_lane<2>(mine, lane); else if (j == 4) other = xor_lane<4>(mine, lane);
                else if (j == 8) other = xor_lane<8>(mine, lane); else if (j == 16) other = xor_lane<16>(mine, lane); else other = xor_lane<32>(mine, lane);
                const u32 mn = mine < other ? mine : other, mx = mine < other ? other : mine;
                nk[r] = (lower == asc) ? mn : mx;
            }
#pragma unroll
            for (int r = 0; r < 8; ++r) k[r] = nk[r];
        }
    }
#pragma unroll
    for (int r = 0; r < 8; ++r) keyl[64 * r + lane] = k[r];
    float shs[4];
    f32x4 g2v[4];
#pragma unroll
    for (int j = 0; j < 4; ++j) g2v[j] = *(const f32x4*)(P.in[I_N2G] + 256 * j + 4 * lane);
#pragma unroll
    for (int s = 0; s < 4; ++s) {
        float hf[16]; float m = 0.f;
        const float ssp = (lane < 16) ? SSH[(size_t)(tokq + s) * 16 + lane] : 0.f;
#pragma unroll
        for (int j = 0; j < 4; ++j) { const u32x2 w = *(const u32x2*)(HN + (size_t)(tokq + s) * DM + 256 * j + 4 * lane);
            hf[4 * j] = bflo(w.x) * g2v[j].x; hf[4 * j + 1] = bfhi(w.x) * g2v[j].y; hf[4 * j + 2] = bflo(w.y) * g2v[j].z; hf[4 * j + 3] = bfhi(w.y) * g2v[j].w; }
        const float rinv_t = 1.0f / sqrtf(wave_sum(ssp) * (1.0f / 1024.0f) + EPS);
#pragma unroll
        for (int d = 0; d < 16; ++d) m = fmaxf(m, fabsf(hf[d]));
#pragma unroll
        for (int o = 1; o < 64; o <<= 1) m = fmaxf(m, __shfl_xor(m, o));
        shs[s] = ((m > 0.f) ? m * (1.0f / 127.0f) : 1.0f) * rinv_t; const float inv = (m > 0.f) ? 127.0f / m : 0.f;
        u32x4 q;
#pragma unroll
        for (int j = 0; j < 4; ++j) {
            const int q0 = (int)rintf(hf[4 * j] * inv), q1 = (int)rintf(hf[4 * j + 1] * inv), q2 = (int)rintf(hf[4 * j + 2] * inv), q3 = (int)rintf(hf[4 * j + 3] * inv);
            q[j] = (u32)(q0 & 255) | ((u32)(q1 & 255) << 8) | ((u32)(q2 & 255) << 16) | ((u32)(q3 & 255) << 24);
        }
        *(LAS u32x4*)(qhl + s * 1024 + 16 * lane) = q;
    }
    LDS_WAIT();
    LAS float* cvl = (LAS float*)(qhl + 6144);
#pragma unroll 1
    for (int c = 0; c < 8; ++c) {
        const u32 kk = keyl[64 * c + lane];
        const int e_l = (int)(kk >> 9), slot_l = (int)((kk >> 7) & 3u), pos_l = (int)(kk & 127u);
        const float g_l = GWL[(tl0 + slot_l) * 128 + pos_l], su_l = SU[e_l], sv_l = SV[e_l];
        int r[64];
#pragma unroll
        for (int p = 0; p < 64; ++p) {
            const u32 kp = (u32)__builtin_amdgcn_readlane((int)kk, p);
            const u32x4 w = *(const u32x4*)(PU + (size_t)(kp >> 9) * 1024 + 16 * lane);
            const u32x4 hq = *(const LAS u32x4*)(qhl + ((kp >> 7) & 3u) * 1024 + 16 * lane);
            int a = __builtin_amdgcn_sdot4((int)w.x, (int)hq.x, 0, false);
            a = __builtin_amdgcn_sdot4((int)w.y, (int)hq.y, a, false);
            a = __builtin_amdgcn_sdot4((int)w.z, (int)hq.z, a, false);
            a = __builtin_amdgcn_sdot4((int)w.w, (int)hq.w, a, false);
            r[p] = a;
        }
        const int isum = reduce64(r, lane);
        const float sh_l = (slot_l == 0) ? shs[0] : (slot_l == 1) ? shs[1] : (slot_l == 2) ? shs[2] : shs[3];
        const float z = (float)isum * su_l * sh_l;
        const float c_l = gelu_erf(z) * g_l * sv_l;
        cvl[64 * c + lane] = c_l;
    }
    LDS_WAIT();
    float acc0[16], acc1[16], acc2[16], acc3[16];
#pragma unroll
    for (int d = 0; d < 16; ++d) { acc0[d] = 0.f; acc1[d] = 0.f; acc2[d] = 0.f; acc3[d] = 0.f; }
#define GQ_ISSUE(W, KP, CE, kreg, creg, p0) do { _Pragma("unroll") for (int q = 0; q < 8; ++q) { \
        KP[q] = (u32)__builtin_amdgcn_readlane((int)(kreg), (p0) + q); CE[q] = __uint_as_float((u32)__builtin_amdgcn_readlane((int)__float_as_uint(creg), (p0) + q)); \
        W[q] = *(const u32x4*)(PV + (size_t)(KP[q] >> 9) * 1024 + 16 * lane); } } while (0)
#define GQ_CONSUME(W, KP, CE) do { _Pragma("unroll") for (int q = 0; q < 8; ++q) { const u32 sl = (KP[q] >> 7) & 3u; \
        if (sl == 0u) GQ_FMA16(acc0, CE[q], W[q]); else if (sl == 1u) GQ_FMA16(acc1, CE[q], W[q]); else if (sl == 2u) GQ_FMA16(acc2, CE[q], W[q]); else GQ_FMA16(acc3, CE[q], W[q]); } } while (0)
    {
        u32x4 wA[8], wB[8]; u32 kA[8], kB[8]; float cA[8], cB[8];
        u32 kk = keyl[lane]; float cc = cvl[lane];
        GQ_ISSUE(wA, kA, cA, kk, cc, 0);
#pragma unroll 1
        for (int c = 0; c < 8; ++c) {
            const int cn = (c < 7) ? c + 1 : 7;
            const u32 kkn = keyl[64 * cn + lane]; const float ccn = cvl[64 * cn + lane];
#pragma unroll 1
            for (int p0 = 0; p0 < 64; p0 += 16) {
                GQ_ISSUE(wB, kB, cB, kk, cc, p0 + 8);
                GQ_CONSUME(wA, kA, cA);
                if (p0 < 48) GQ_ISSUE(wA, kA, cA, kk, cc, p0 + 16); else GQ_ISSUE(wA, kA, cA, kkn, ccn, 0);
                GQ_CONSUME(wB, kB, cB);
            }
            kk = kkn; cc = ccn;
        }
    }
#undef GQ_ISSUE
#undef GQ_CONSUME
    u32x2 hw[4][4];
#pragma unroll
    for (int s = 0; s < 4; ++s)
#pragma unroll
        for (int j = 0; j < 4; ++j) hw[s][j] = *(const u32x2*)(HN + (size_t)(tokq + s) * DM + 256 * j + 4 * lane);
#define GQ_OUT(s, A) do { float* orow = P.out + (size_t)(tokq + (s)) * DM; _Pragma("unroll") for (int j = 0; j < 4; ++j) { f32x4* p = (f32x4*)(orow + 256 * j + 4 * lane); \
        f32x4 v; v.x = bflo(hw[s][j].x) + A[4 * j]; v.y = bfhi(hw[s][j].x) + A[4 * j + 1]; v.z = bflo(hw[s][j].y) + A[4 * j + 2]; v.w = bfhi(hw[s][j].y) + A[4 * j + 3]; *p = v; } } while (0)
    GQ_OUT(0, acc0); GQ_OUT(1, acc1); GQ_OUT(2, acc2); GQ_OUT(3, acc3);
#undef GQ_OUT
}
__device__ __forceinline__ void peer_gather_tile(const Ctx& C, const Params& P, int tok0) {
    __syncthreads();
#pragma unroll 1
    for (int hq = 0; hq < 2; ++hq) peer_gather_quad(C, P, tok0 + 32 * hq + 4 * C.wave);
}

#define GAS __attribute__((address_space(1)))
typedef GAS unsigned gu32;
#define RLX_AGENT __ATOMIC_RELAXED, __HIP_MEMORY_SCOPE_AGENT
#define XB_TMO      128
#define XB_XCNT(j)  (256  + 64 * (j))
#define XB_XSUB(j)  (1280 + 64 * (j))
#define XB_XGEN(j)  (2304 + 64 * (j))
#define XB_TOP      3328
#define XB_TOPGEN   3392
#define XCD_BAR_WORDS 3456
#define XB_SPIN_CAP (1u << 18)

__device__ __forceinline__ unsigned xb_ld(unsigned* p)              { return __hip_atomic_load(p, __ATOMIC_RELAXED, __HIP_MEMORY_SCOPE_AGENT); }
__device__ __forceinline__ unsigned xb_add(unsigned* p, unsigned v) { return __hip_atomic_fetch_add(p, v, __ATOMIC_RELAXED, __HIP_MEMORY_SCOPE_AGENT); }
__device__ __forceinline__ unsigned xb_xcc_id() { return (unsigned)__builtin_amdgcn_s_getreg((3 << 11) | 20) & 0xFu; }
#define XB_SPIN(cond, bar) do { unsigned _sp = 0; while (cond) { __builtin_amdgcn_s_sleep(1); \
    if ((++_sp & 255u) == 0u) { if (xb_ld(&(bar)[XB_TMO])) break; if (_sp > XB_SPIN_CAP) { atomicAdd(&(bar)[XB_TMO], 1u); break; } } } } while (0)

struct XcdBarrier {
    unsigned* bar; unsigned x;
    volatile LAS unsigned* st;
};

__device__ __forceinline__ XcdBarrier xcd_barrier_post(unsigned* bar, volatile LAS unsigned* st) {
    XcdBarrier b; b.bar = bar; b.x = xb_xcc_id(); b.st = st;
    if (threadIdx.x == 0) (void)xb_add(&bar[XB_XCNT(b.x)], 1u);
    return b;
}
__device__ __forceinline__ void xcd_barrier_complete(unsigned* bar, unsigned x, unsigned& nloc, unsigned& nx) {
    const unsigned G = gridDim.x * gridDim.y * gridDim.z;
    unsigned sum, cnt, mine, sp = 0u;
    for (;;) {
        sum = 0u; cnt = 0u; mine = 0u;
#pragma unroll
        for (unsigned j = 0; j < 16; ++j) { const unsigned c = xb_ld(&bar[XB_XCNT(j)]); sum += c; cnt += (c > 0u) ? 1u : 0u; mine = (j == x) ? c : mine; }
        if (sum == G) break;
        __builtin_amdgcn_s_sleep(1);
        if ((++sp & 255u) == 0u) { if (xb_ld(&bar[XB_TMO])) break; if (sp > XB_SPIN_CAP) { atomicAdd(&bar[XB_TMO], 1u); break; } }
    }
    nloc = mine > 0u ? mine : 1u; nx = cnt > 0u ? cnt : 1u;
}

__device__ __forceinline__ void xcd_barrier(const XcdBarrier& b) {
    asm volatile("s_waitcnt vmcnt(0)" ::: "memory");
    __syncthreads();
    if (threadIdx.x == 0) {
        unsigned* bar = b.bar;
        __builtin_amdgcn_s_waitcnt(0);
        unsigned nloc = b.st[0], nx = b.st[1];
        if (nloc == 0u) { xcd_barrier_complete(bar, b.x, nloc, nx); b.st[0] = nloc; b.st[1] = nx; }
        const unsigned old = xb_add(&bar[XB_XSUB(b.x)], 1u);
        const unsigned gen = old / nloc;
        if (old + 1u == (gen + 1u) * nloc) {
            __builtin_amdgcn_fence(__ATOMIC_RELEASE, "agent");
            asm volatile("s_waitcnt vmcnt(0)" ::: "memory");
            const unsigned og = xb_add(&bar[XB_TOP], 1u);
            const unsigned tg = og / nx;
            if (og + 1u == (tg + 1u) * nx) xb_add(&bar[XB_TOPGEN], 1u);
            else XB_SPIN(xb_ld(&bar[XB_TOPGEN]) == tg, bar);
            __builtin_amdgcn_fence(__ATOMIC_ACQUIRE, "agent");
            xb_add(&bar[XB_XGEN(b.x)], 1u);
            asm volatile("s_waitcnt vmcnt(0)" ::: "memory");
        } else {
            XB_SPIN(xb_ld(&bar[XB_XGEN(b.x)]) == gen, bar);
            __builtin_amdgcn_fence(__ATOMIC_ACQUIRE, "agent");
            asm volatile("s_waitcnt vmcnt(0)" ::: "memory");
        }
    }
    __syncthreads();
}

constexpr int NPHASE = 9;
__global__ void __launch_bounds__(NTHR, 2) mk_fwd(Params P) {
    extern __shared__ __attribute__((aligned(16))) unsigned char lds_raw[];
    Ctx C; C.lds = (LAS unsigned char*)lds_raw; C.tid = threadIdx.x; C.lane = C.tid & 63; C.wave = __builtin_amdgcn_readfirstlane(C.tid >> 6); C.G = gridDim.x; C.bid = blockIdx.x;
    unsigned char* ws = P.ws;
    volatile LAS unsigned* MISC = (volatile LAS unsigned*)(C.lds + MISC_OFF);
    if (C.tid < 32) MISC[C.tid] = 0u;
    __syncthreads();
    XcdBarrier bar = xcd_barrier_post((unsigned*)(ws + WS_CTL) + 4096, MISC + 8);
#define SEAM(k) do { if (IN(k) && IN((k) + 1)) xcd_barrier(bar); FRESH(); } while (0)
#define FRESH() do { int t_ = (int)threadIdx.x; asm volatile("" : "+v"(t_)); C.tid = t_; C.lane = t_ & 63; } while (0)
#ifdef ONLY_PHASE
#define IN(k) ((k) == ONLY_PHASE && P.ph_lo <= (k) && (k) < P.ph_hi)
#else
#define IN(k) (P.ph_lo <= (k) && (k) < P.ph_hi)
#endif
    if (IN(0)) phase_prologue(C, P);
    SEAM(0);
    if (IN(1)) {
        pg8::Gemm g{(const bf16_t*)(ws + WS_BUFA), (const bf16_t*)(ws + WS_WIN_T), MPAD, INW, DM}; pg8::StaticOrder S; S.init(MPAD, INW, C.G, C.bid);
        pg8::EpiBf16<0> E{(bf16_t*)(ws + WS_PROJ), INW, nullptr, 0, 0, 1.f};
        pg8::gemm_phase<pg8::EpiBf16<0>, pg8::StaticOrder, true, true>(C.lds, g, S, E);
        { const int ntile = (MPAD / 256) * (INW / 256), nbusy = ntile % C.G;
          if (ntile > C.G && nbusy > 0) { if (C.bid >= nbusy) deferred_a(C, P, C.bid - nbusy, C.G - nbusy); }
          else deferred_a(C, P, C.bid, C.G); }
    }
    SEAM(1);
    if (IN(2)) phase_sloc(C, P);
    SEAM(2);
    if (IN(3)) {
        for (int bk = C.bid; bk < 64; bk += C.G) carry_scan_block(C, P, bk);
        for (int u = C.bid; u < 256; u += C.G) attn_unit(C, P, u >> 1, u & 1);
    }
    SEAM(3);
    if (IN(4)) phase_ssm_y(C, P);
    SEAM(4);
    if (IN(5)) {
        pg8::Gemm g{(const bf16_t*)(ws + WS_Z), (const bf16_t*)(ws + WS_GLU_T), SEQ, 512, 512}; pg8::StaticOrder S; S.init(SEQ, 512, C.G, C.bid);
        EpiGlu E{(const bf16_t*)(ws + WS_Z), (bf16_t*)(ws + WS_BUFA), P.in[I_GLUB], (float*)(ws + WS_SSS)};
        pg8::gemm_phase<EpiGlu, pg8::StaticOrder, true, true>(C.lds, g, S, E);
        { const int ntile = (SEQ / 256) * 2;
          if (ntile < C.G) { if (C.bid >= ntile) deferred_b(C, P, C.bid - ntile, C.G - ntile); }
          else deferred_b(C, P, C.bid, C.G); }
    }
    SEAM(5);
    if (IN(6)) {
        __syncthreads();
        if (C.tid < 256) {
            pg8::StaticOrder S0; S0.init(SEQ, DM, C.G, C.bid); pg8::Unit u0; S0.next(0, u0);
            const int row = u0.pm * 256 + C.tid;
            const f32x4* pa = (const f32x4*)((const float*)(ws + WS_SSA) + (size_t)row * 8); const f32x4* ps = (const f32x4*)((const float*)(ws + WS_SSS) + (size_t)row * 8);
            const f32x4 a0 = pa[0], a1 = pa[1], s0 = ps[0], s1 = ps[1];
            const float ra = 1.0f / sqrtf((((a0.x + a0.y) + (a0.z + a0.w)) + ((a1.x + a1.y) + (a1.z + a1.w))) * (1.0f / 512.0f) + EPS);
            const float rs = 1.0f / sqrtf((((s0.x + s0.y) + (s0.z + s0.w)) + ((s1.x + s1.y) + (s1.z + s1.w))) * (1.0f / 512.0f) + EPS);
            LAS float* fac = (LAS float*)(C.lds + FAC_OFF); fac[2 * C.tid] = ra / rs; fac[2 * C.tid + 1] = rs;
        }
        __syncthreads();
        pg8::Gemm g{(const bf16_t*)(ws + WS_BUFA), (const bf16_t*)(ws + WS_WOUT_T), SEQ, DM, DM}; pg8::StaticOrder S; S.init(SEQ, DM, C.G, C.bid);
        EpiMix E{P.in[I_X], (bf16_t*)(ws + WS_HB), (float*)(ws + WS_SSH)};
        pg8::gemm_phase<EpiMix, pg8::StaticOrder, true, true>(C.lds, g, S, E);
    }
    SEAM(6);
    if (IN(7)) {
        pg8::Gemm g{(const bf16_t*)(ws + WS_HB), (const bf16_t*)(ws + WS_WQ_T), SEQ, 2048, DM}; pg8::StaticOrder S; S.init(SEQ, 2048, C.G, C.bid);
        pg8::Unit ua, ub; const bool ha = S.next(0, ua), hb = S.next(1, ub);
        __syncthreads();
        {
            const int which = C.tid >> 8, rl = C.tid & 255; const bool has = which ? hb : ha; const int pm = which ? ub.pm : ua.pm;
            if (has) {
                const f32x4* sp = (const f32x4*)((const float*)(ws + WS_SSH) + (size_t)(pm * 256 + rl) * 16);
                const f32x4 s0 = sp[0], s1 = sp[1], s2 = sp[2], s3 = sp[3];
                const float ss = ((s0.x + s0.y) + (s0.z + s0.w)) + ((s1.x + s1.y) + (s1.z + s1.w)) + ((s2.x + s2.y) + (s2.z + s2.w)) + ((s3.x + s3.y) + (s3.z + s3.w));
                ((LAS float*)(C.lds + FAC_OFF))[which * 256 + rl] = 1.0f / sqrtf(ss * (1.0f / 1024.0f) + EPS);
            }
        }
        __syncthreads();
        EpiQ E{(bf16_t*)(ws + WS_QP), ua.pm};
        pg8::gemm_phase<EpiQ, pg8::StaticOrder, true, true>(C.lds, g, S, E);
    }
    SEAM(7);
    {
    if (IN(8)) {
        for (int tile = C.bid; tile < SEQ / 64; tile += C.G) {
            peer_topk_tile(C, P, tile * 64);
            peer_gather_tile(C, P, tile * 64);
        }
    }
    }
#undef IN
#undef SEAM
}
}

extern "C" void kernel_launch(void* const* d_in, const int* in_sizes, int n_in, void* d_out, int out_size, void* d_ws, size_t ws_size, hipStream_t stream) {
    static int state = 0, grid = 0;
    if (state == 0) {
        if (n_in != 25 || out_size != mk::SEQ * mk::DM || ws_size < mk::WS_END) { fprintf(stderr, "kernel_launch: unexpected shapes (n_in %d out %d ws %zu)\n", n_in, out_size, ws_size); state = -1; return; }
        if (hipFuncSetAttribute((const void*)mk::mk_fwd, hipFuncAttributeMaxDynamicSharedMemorySize, mk::LDS_BYTES) != hipSuccess) { fprintf(stderr, "kernel_launch: hipFuncSetAttribute failed\n"); state = -1; return; }
        int dev = 0, cus = 0, per_cu = 0;
        if (hipGetDevice(&dev) != hipSuccess || hipDeviceGetAttribute(&cus, hipDeviceAttributeMultiprocessorCount, dev) != hipSuccess) { fprintf(stderr, "kernel_launch: device query failed\n"); state = -1; return; }
        if (hipOccupancyMaxActiveBlocksPerMultiprocessor(&per_cu, (const void*)mk::mk_fwd, mk::NTHR, mk::LDS_BYTES) != hipSuccess || per_cu < 1) { fprintf(stderr, "kernel_launch: occupancy query failed (%d)\n", per_cu); state = -1; return; }
        grid = cus;
        state = 1;
    }
    if (state < 0) return;
    mk::Params p{};
    for (int i = 0; i < 25; ++i) p.in[i] = (const float*)d_in[i];
    p.out = (float*)d_out; p.ws = (unsigned char*)d_ws;
    if (hipMemsetAsync((char*)d_ws + mk::WS_CTL, 0, 65536, stream) != hipSuccess) { fprintf(stderr, "kernel_launch: memset failed\n"); return; }
    p.ph_lo = 0; p.ph_hi = mk::NPHASE;
    void* args[] = {&p};
    hipError_t e = hipLaunchCooperativeKernel((const void*)mk::mk_fwd, dim3(grid), dim3(mk::NTHR), args, mk::LDS_BYTES, stream);
    if (e != hipSuccess) fprintf(stderr, "kernel_launch: cooperative launch failed: %s (grid %d)\n", hipGetErrorString(e), grid);
}
```
